# Optimizing an MI355X kernel written in HIP

```python
import math
import jax, jax.numpy as jnp
from jax import lax
import numpy as np

D_MODEL = 2048
BATCH = 1
SEQ = 16384
DEPTH = 2

EPS = 1e-6
D_MIX = D_MODEL
GDN_HEADS = 8
GDN_DK = 128
GDN_DV = 128
GDN_CONV = 4
GDN_CHUNK = 64
MLA_HEADS = 4
MLA_Q_RANK = 448
MLA_KV_RANK = 128
MLA_NOPE = 128
MLA_ROPE = 64
MLA_DV = 128
MLA_BLOCK = 128
ROPE_THETA = 10000.0
SWA_HEADS = 8
SWA_KV_HEADS = 2
SWA_DH = 64
SWA_WINDOW = 128
D_FF = 5632
FFN_CONV = 3

GDN_QK = GDN_HEADS * GDN_DK
GDN_V = GDN_HEADS * GDN_DV
MLA_OUT = MLA_HEADS * MLA_DV
SWA_OUT = SWA_HEADS * SWA_DH
SWA_KV = SWA_KV_HEADS * SWA_DH
IN_SIZES = (GDN_QK, GDN_QK, GDN_V, GDN_V, GDN_HEADS, GDN_HEADS,
            MLA_Q_RANK, MLA_KV_RANK, MLA_ROPE,
            SWA_OUT, SWA_KV, SWA_KV)
D_IN = int(sum(IN_SIZES))
IN_SPLITS = tuple(int(s) for s in np.cumsum(IN_SIZES)[:-1])
N_MOD = 6

kernel_name = 'hybrid_gdn_mla_swa_parallel_heads'


def rmsnorm(x, w):
    xf = x.astype(jnp.float32)
    y = xf * lax.rsqrt(jnp.mean(xf * xf, axis=-1, keepdims=True) + EPS)
    return (y * w.astype(jnp.float32)).astype(x.dtype)


def l2norm(x):
    xf = x.astype(jnp.float32)
    return xf * lax.rsqrt(jnp.sum(xf * xf, axis=-1, keepdims=True) + EPS)


def causal_dwconv(x, w):
    K = w.shape[0]
    S = x.shape[1]
    xp = jnp.pad(x, ((0, 0), (K - 1, 0), (0, 0)))
    return sum(xp[:, j:j + S] * w[j] for j in range(K))


def rope(x, positions):
    half = x.shape[-1] // 2
    inv = ROPE_THETA ** (-jnp.arange(half, dtype=jnp.float32) / half)
    ang = positions.astype(jnp.float32)[..., None, None] * inv
    cos, sin = jnp.cos(ang), jnp.sin(ang)
    xf = x.astype(jnp.float32)
    x1, x2 = xf[..., :half], xf[..., half:]
    return jnp.concatenate([x1 * cos - x2 * sin, x2 * cos + x1 * sin], axis=-1).astype(x.dtype)


def alibi_slopes(n):
    return 2.0 ** (-8.0 * (jnp.arange(n, dtype=jnp.float32) + 1.0) / n)


def gated_delta_rule_chunked(q, k, v, g, beta):
    B, S, H, DK = q.shape
    DV = v.shape[-1]
    C = GDN_CHUNK
    N = S // C

    def chunks(t):
        t = t.astype(jnp.float32).reshape((B, N, C, H) + t.shape[3:])
        return jnp.moveaxis(t, 3, 1)

    q = chunks(q) * (DK ** -0.5)
    k = chunks(k)
    v = chunks(v)
    beta = chunks(beta)
    gc = jnp.cumsum(chunks(g), axis=-1)
    incl = jnp.tril(jnp.ones((C, C), bool))
    strict = jnp.tril(jnp.ones((C, C), bool), -1)
    diff = gc[..., :, None] - gc[..., None, :]
    decay = jnp.where(incl, jnp.exp(jnp.where(incl, diff, 0.0)), 0.0)
    k_beta = k * beta[..., None]
    kk = jnp.einsum('bhnid,bhnjd->bhnij', k_beta, k)
    a_mat = jnp.eye(C, dtype=jnp.float32) + jnp.where(strict, kk * decay, 0.0)
    u = lax.linalg.triangular_solve(a_mat, v * beta[..., None], left_side=True, lower=True,
                                    unit_diagonal=True)
    w = lax.linalg.triangular_solve(a_mat, k_beta * jnp.exp(gc)[..., None], left_side=True,
                                    lower=True, unit_diagonal=True)
    qk = jnp.einsum('bhnid,bhnjd->bhnij', q, k) * decay
    q_dec = q * jnp.exp(gc)[..., None]
    k_tail = k * jnp.exp(gc[..., -1:] - gc)[..., None]
    g_tot = jnp.exp(gc[..., -1])
    xs = tuple(jnp.moveaxis(t, 2, 0) for t in (u, w, qk, q_dec, k_tail, g_tot))

    def step(state, inp):
        u_n, w_n, qk_n, qd_n, kt_n, gt_n = inp
        v_new = u_n - jnp.einsum('bhck,bhkv->bhcv', w_n, state)
        o_n = (jnp.einsum('bhck,bhkv->bhcv', qd_n, state)
               + jnp.einsum('bhij,bhjv->bhiv', qk_n, v_new))
        state = state * gt_n[..., None, None] + jnp.einsum('bhck,bhcv->bhkv', kt_n, v_new)
        return state, o_n

    s0 = jnp.zeros((B, H, DK, DV), jnp.float32)
    _, o = lax.scan(step, s0, xs)
    return o.transpose(1, 0, 3, 2, 4).reshape(B, S, H, DV)


def gdn_mixer(q, k, v, z, a, b, conv_w, a_log, dt_bias, norm_w):
    B, S, _ = q.shape
    qkv = jax.nn.silu(causal_dwconv(jnp.concatenate([q, k, v], axis=-1), conv_w))
    q, k, v = jnp.split(qkv, (GDN_QK, 2 * GDN_QK), axis=-1)
    q = l2norm(q.reshape(B, S, GDN_HEADS, GDN_DK))
    k = l2norm(k.reshape(B, S, GDN_HEADS, GDN_DK))
    v = v.reshape(B, S, GDN_HEADS, GDN_DV)
    g = -jnp.exp(a_log.astype(jnp.float32)) * jax.nn.softplus(
        a.astype(jnp.float32) + dt_bias.astype(jnp.float32))
    beta = jax.nn.sigmoid(b.astype(jnp.float32))
    o = gated_delta_rule_chunked(q, k, v, g, beta)
    o = rmsnorm(o, norm_w) * jax.nn.silu(z.astype(jnp.float32).reshape(B, S, GDN_HEADS, GDN_DV))
    return o.reshape(B, S, GDN_V).astype(z.dtype)


def mla_mixer(c_q, c_kv, k_rope_raw, positions, q_norm_w, w_uq, kv_norm_w, w_ukv):
    B, S, _ = c_q.shape
    H = MLA_HEADS
    dqk = MLA_NOPE + MLA_ROPE
    q = (rmsnorm(c_q, q_norm_w) @ w_uq).reshape(B, S, H, dqk)
    q = jnp.concatenate([q[..., :MLA_NOPE], rope(q[..., MLA_NOPE:], positions)], axis=-1)
    q = q * (dqk ** -0.5)
    kv = (rmsnorm(c_kv, kv_norm_w) @ w_ukv).reshape(B, S, H, MLA_NOPE + MLA_DV)
    k_nope, v = kv[..., :MLA_NOPE], kv[..., MLA_NOPE:]
    k_pe = rope(k_rope_raw[:, :, None, :], positions)
    k = jnp.concatenate([k_nope, jnp.broadcast_to(k_pe, (B, S, H, MLA_ROPE))], axis=-1)
    nb = S // MLA_BLOCK
    q_blocks = q.reshape(B, nb, MLA_BLOCK, H, dqk).transpose(1, 0, 2, 3, 4)
    key_idx = jnp.arange(S)

    def block(args):
        qb, n = args
        s = jnp.einsum('bqhd,bkhd->bhqk', qb, k).astype(jnp.float32)
        q_idx = n * MLA_BLOCK + jnp.arange(MLA_BLOCK)
        s = jnp.where(key_idx[None, :] <= q_idx[:, None], s, -jnp.inf)
        p = jax.nn.softmax(s, axis=-1).astype(v.dtype)
        return jnp.einsum('bhqk,bkhd->bqhd', p, v)

    out = lax.map(block, (q_blocks, jnp.arange(nb)))
    return out.transpose(1, 0, 2, 3, 4).reshape(B, S, MLA_OUT)


def swa_mixer(q, k, v, sinks):
    B, S, _ = q.shape
    W = SWA_WINDOW
    nb = S // W
    G = SWA_HEADS // SWA_KV_HEADS
    qb = q.reshape(B, nb, W, SWA_KV_HEADS, G, SWA_DH)
    kb = k.reshape(B, nb, W, SWA_KV_HEADS, SWA_DH)
    vb = v.reshape(B, nb, W, SWA_KV_HEADS, SWA_DH)

    def with_prev(t):
        prev = jnp.concatenate([jnp.zeros_like(t[:, :1]), t[:, :-1]], axis=1)
        return jnp.concatenate([prev, t], axis=2)

    kk, vv = with_prev(kb), with_prev(vb)
    s = jnp.einsum('bnqhgd,bnkhd->bnhgqk', qb, kk).astype(jnp.float32) * (SWA_DH ** -0.5)
    qi = jnp.arange(W)[:, None]
    kj = jnp.arange(2 * W)[None, :]
    dist = (qi + W - kj).astype(jnp.float32)
    key_pos = jnp.arange(nb)[:, None] * W - W + kj
    valid = ((dist >= 0) & (dist < W))[None] & (key_pos >= 0)[:, None, :]
    slopes = alibi_slopes(SWA_HEADS).reshape(SWA_KV_HEADS, G)
    s = s - slopes[:, :, None, None] * dist
    s = jnp.where(valid[None, :, None, None], s, -jnp.inf)
    sink = jnp.broadcast_to(sinks.astype(jnp.float32).reshape(SWA_KV_HEADS, G)[:, :, None, None],
                            s.shape[:-1] + (1,))
    p = jax.nn.softmax(jnp.concatenate([s, sink], axis=-1), axis=-1)[..., :-1]
    o = jnp.einsum('bnhgqk,bnkhd->bnqhgd', p.astype(v.dtype), vv)
    return o.reshape(B, S, SWA_OUT)


def setup_inputs(seed: int = 0) -> dict:
    key = jax.random.key(seed)
    ks = jax.random.split(key, 24)
    f32 = jnp.float32
    L = DEPTH

    def nrm(k, shape, scale):
        return jax.random.normal(k, shape, f32) * scale

    def gain(k, shape):
        return 1.0 + 0.05 * jax.random.normal(k, shape, f32)

    x = nrm(ks[0], (BATCH, SEQ, D_MODEL), 1.0)
    c = nrm(ks[1], (BATCH, D_MODEL), 1.0)
    start = jax.random.randint(ks[2], (BATCH, 1), 0, 1024, jnp.int32)
    positions = start + jnp.arange(SEQ, dtype=jnp.int32)[None, :]
    dt = jnp.exp(jax.random.uniform(ks[11], (L, GDN_HEADS), f32, math.log(1e-3), math.log(1e-1)))
    return {
        'x': x,
        'c': c,
        'positions': positions,
        'ada_w': nrm(ks[3], (L, D_MODEL, N_MOD * D_MODEL), 0.5 * D_MODEL ** -0.5),
        'ada_b': nrm(ks[4], (L, N_MOD * D_MODEL), 0.02),
        'mix_pre_norm': gain(ks[5], (L, D_MODEL)),
        'mix_post_norm': gain(ks[6], (L, D_MODEL)),
        'w_in': nrm(ks[7], (L, D_MODEL, D_IN), D_MODEL ** -0.5),
        'w_out': nrm(ks[8], (L, D_MIX, D_MODEL), D_MIX ** -0.5),
        'gdn_conv': nrm(ks[9], (L, GDN_CONV, 2 * GDN_QK + GDN_V), GDN_CONV ** -0.5),
        'gdn_a_log': jnp.log(jax.random.uniform(ks[10], (L, GDN_HEADS), f32, 1.0, 16.0)),
        'gdn_dt_bias': dt + jnp.log(-jnp.expm1(-dt)),
        'gdn_norm': gain(ks[12], (L, GDN_DV)),
        'mla_q_norm': gain(ks[13], (L, MLA_Q_RANK)),
        'mla_w_uq': nrm(ks[14], (L, MLA_Q_RANK, MLA_HEADS * (MLA_NOPE + MLA_ROPE)), MLA_Q_RANK ** -0.5),
        'mla_kv_norm': gain(ks[15], (L, MLA_KV_RANK)),
        'mla_w_ukv': nrm(ks[16], (L, MLA_KV_RANK, MLA_HEADS * (MLA_NOPE + MLA_DV)), MLA_KV_RANK ** -0.5),
        'swa_sinks': nrm(ks[17], (L, SWA_HEADS), 1.0),
        'ffn_pre_norm': gain(ks[18], (L, D_MODEL)),
        'ffn_post_norm': gain(ks[19], (L, D_MODEL)),
        'ffn_w_up': nrm(ks[20], (L, D_MODEL, 2 * D_FF), D_MODEL ** -0.5),
        'ffn_conv': nrm(ks[21], (L, FFN_CONV, 2 * D_FF), FFN_CONV ** -0.5),
        'ffn_conv_b': nrm(ks[22], (L, 2 * D_FF), 0.02),
        'ffn_w_down': nrm(ks[23], (L, D_FF, D_MODEL), D_FF ** -0.5),
    }


def reference(x, c, positions, ada_w, ada_b, mix_pre_norm, mix_post_norm, w_in, w_out,
              gdn_conv, gdn_a_log, gdn_dt_bias, gdn_norm, mla_q_norm, mla_w_uq, mla_kv_norm,
              mla_w_ukv, swa_sinks, ffn_pre_norm, ffn_post_norm, ffn_w_up, ffn_conv, ffn_conv_b,
              ffn_w_down):
    B, S, D = x.shape
    c_act = jax.nn.silu(c)
    for l in range(DEPTH):
        mod = (c_act @ ada_w[l] + ada_b[l]).reshape(B, N_MOD, D)
        shift1, scale1, gate1, shift2, scale2, gate2 = (mod[:, i][:, None, :] for i in range(N_MOD))

        h = rmsnorm(x, mix_pre_norm[l]) * (1.0 + scale1) + shift1
        (a_q, a_k, a_v, a_z, a_a, a_b, b_cq, b_ckv, b_krope,
         c_q, c_k, c_v) = jnp.split(h @ w_in[l], IN_SPLITS, axis=-1)
        o_a = gdn_mixer(a_q, a_k, a_v, a_z, a_a, a_b, gdn_conv[l], gdn_a_log[l], gdn_dt_bias[l],
                        gdn_norm[l])
        o_b = mla_mixer(b_cq, b_ckv, b_krope, positions, mla_q_norm[l], mla_w_uq[l],
                        mla_kv_norm[l], mla_w_ukv[l])
        o_c = swa_mixer(c_q, c_k, c_v, swa_sinks[l])
        mix = jnp.concatenate([o_a, o_b, o_c], axis=-1) @ w_out[l]
        x = x + gate1 * rmsnorm(mix, mix_post_norm[l])

        h = rmsnorm(x, ffn_pre_norm[l]) * (1.0 + scale2) + shift2
        u = causal_dwconv(h @ ffn_w_up[l], ffn_conv[l]) + ffn_conv_b[l]
        gate_br, up = u[..., :D_FF], u[..., D_FF:]
        y = (jax.nn.gelu(gate_br, approximate=True) * up) @ ffn_w_down[l]
        x = x + gate2 * rmsnorm(y, ffn_post_norm[l])
    return x
```

```cpp
#include <hip/hip_runtime.h>
#include <hip/hip_cooperative_groups.h>
#include <cstdio>
#include <cstdint>
namespace cg = cooperative_groups;

#define DI __device__ __forceinline__
typedef unsigned short bf16_t;
typedef short bf16x8 __attribute__((ext_vector_type(8)));
typedef float f32x2 __attribute__((ext_vector_type(2)));
typedef float f32x4 __attribute__((ext_vector_type(4)));
typedef float f32x16 __attribute__((ext_vector_type(16)));
typedef unsigned u32x2 __attribute__((ext_vector_type(2)));
typedef unsigned u32x4 __attribute__((ext_vector_type(4)));
typedef __bf16 bf2_t __attribute__((ext_vector_type(2)));

constexpr int S_ = 16384, D_ = 2048, DINP = 5632, DFF = 5632, DFF2 = 11264;
constexpr int NT = 512;
constexpr float EPS = 1e-6f;
constexpr float LOG2E = 1.4426950408889634f;

constexpr size_t OFF_CTRL = 0;
constexpr size_t OFF_MODP = 4096;
constexpr size_t OFF_W = 2097152;
constexpr size_t W_IN = 0, W_OUT = W_IN + (size_t)5632 * 2048 * 2, W_UP = W_OUT + (size_t)2048 * 2048 * 2,
                 W_DOWN = W_UP + (size_t)11264 * 2048 * 2, W_UQ = W_DOWN + (size_t)2048 * 5632 * 2,
                 W_UKV = W_UQ + (size_t)768 * 448 * 2, W_END = W_UKV + (size_t)1024 * 128 * 2;
constexpr size_t OFF_H = OFF_W + W_END;
constexpr size_t OFF_MIXF = OFF_H + (size_t)S_ * 2048 * 2;
constexpr size_t OFF_QRAW = OFF_MIXF;
constexpr size_t OFF_KMLA = OFF_QRAW + (size_t)S_ * 768 * 4;
constexpr size_t OFF_VT = OFF_KMLA + (size_t)4 * S_ * 192 * 2;
constexpr size_t OFF_BIG = OFF_MIXF + (size_t)S_ * 2048 * 4;
constexpr size_t OFF_PROJ = OFF_BIG;
constexpr size_t OFF_WP = OFF_PROJ + (size_t)S_ * DINP * 2;
constexpr size_t OFF_QD = OFF_WP + (size_t)S_ * 1024 * 2;
constexpr size_t OFF_KT = OFF_QD + (size_t)S_ * 1024 * 2;
constexpr size_t OFF_ZT = OFF_KT + (size_t)S_ * 1024 * 2;
constexpr size_t OFF_QK = OFF_ZT + (size_t)S_ * 1024 * 2;
constexpr size_t OFF_AB = OFF_QK + (size_t)S_ * 512 * 2;
constexpr size_t OFF_GTOT = OFF_AB + (size_t)S_ * 16 * 4;
constexpr size_t OFF_Y = OFF_BIG;
constexpr size_t OFF_ACT = OFF_H;
constexpr size_t OFF_UT = OFF_BIG + (size_t)S_ * DFF2 * 2;
constexpr size_t OFF_END = OFF_UT + (size_t)S_ * 1024 * 4;
static_assert(OFF_GTOT + 8192 <= OFF_UT, "overlay");
static_assert(OFF_VT + (size_t)4 * 128 * S_ * 2 <= OFF_BIG, "overlay2");

constexpr int C_AQ = 0, C_AK = 1024, C_AV = 2048, C_AZ = 3072, C_AA = 4096, C_BCQ = 4112, C_BCKV = 4560,
              C_BKR = 4688, C_CQ = 4752, C_CK = 5264, C_CV = 5392;

__constant__ double kInvFreq2Pi[32] = {
    0.15915494309189535, 0.11934937021124886, 0.08949940160889101, 0.06711508300522726, 0.050329212104487035, 0.03774158471741977,
    0.0283021958306234, 0.02122365276477766, 0.015915494309189534, 0.011934937021124886, 0.008949940160889102, 0.006711508300522725,
    0.005032921210448704, 0.003774158471741977, 0.00283021958306234, 0.0021223652764777662, 0.0015915494309189536, 0.0011934937021124885,
    0.0008949940160889102, 0.0006711508300522726, 0.0005032921210448703, 0.00037741584717419774, 0.00028302195830623395, 0.0002122365276477766,
    0.00015915494309189535, 0.00011934937021124886, 8.949940160889102e-05, 6.711508300522725e-05, 5.0329212104487035e-05, 3.774158471741978e-05,
    2.8302195830623396e-05, 2.122365276477766e-05};

struct Params {
  const float* x; const float* c; const int* pos;
  const float *ada_w, *ada_b, *mix_pre, *mix_post, *w_in, *w_out, *gdn_conv, *gdn_a_log, *gdn_dt_bias, *gdn_norm, *mla_q_norm, *mla_w_uq,
      *mla_kv_norm, *mla_w_ukv, *swa_sinks, *ffn_pre, *ffn_post, *ffn_w_up, *ffn_conv, *ffn_conv_b, *ffn_w_down;
  float* out; char* ws;
};

DI unsigned pack2(float lo, float hi) { f32x2 v = {lo, hi}; bf2_t b = __builtin_convertvector(v, bf2_t); return __builtin_bit_cast(unsigned, b); }
DI bf16_t f2bf(float x) { return (bf16_t)(pack2(x, 0.f) & 0xffffu); }
DI float bflo(unsigned u) { return __uint_as_float(u << 16); }
DI float bfhi(unsigned u) { return __uint_as_float(u & 0xffff0000u); }
DI void unpack8(const u32x4& v, float* f) { f[0] = bflo(v.x); f[1] = bfhi(v.x); f[2] = bflo(v.y); f[3] = bfhi(v.y); f[4] = bflo(v.z); f[5] = bfhi(v.z); f[6] = bflo(v.w); f[7] = bfhi(v.w); }
DI bf16x8 pack8(float a0, float a1, float a2, float a3, float a4, float a5, float a6, float a7) {
  u32x4 p = {pack2(a0, a1), pack2(a2, a3), pack2(a4, a5), pack2(a6, a7)}; return __builtin_bit_cast(bf16x8, p); }
DI float silu_f(float x) { return x / (1.f + __expf(-x)); }
DI float wave_sum(float v) { v += __shfl_xor(v, 32); v += __shfl_xor(v, 16); v += __shfl_xor(v, 8); v += __shfl_xor(v, 4); v += __shfl_xor(v, 2); v += __shfl_xor(v, 1); return v; }
DI int opaque_tid() { int t = threadIdx.x; asm volatile("" : "+v"(t)); return t; }
DI int crow(int r, int h) { return (r & 3) + 8 * (r >> 2) + 4 * h; }
DI int perm32(int k) { return 8 * ((k >> 2) & 3) + 4 * (k >> 4) + (k & 3); }
#define MFMA32(a, b, c) __builtin_amdgcn_mfma_f32_32x32x16_bf16((a), (b), (c), 0, 0, 0)
#define MFMA16(a, b, c) __builtin_amdgcn_mfma_f32_16x16x32_bf16((a), (b), (c), 0, 0, 0)

template <class Epi>
DI void gemm_tile(const bf16_t* __restrict__ A, int lda, const bf16_t* __restrict__ Bt, int ldb, int K, int m0, int n0, char* smem, const Epi& epi) {
  const int tid = opaque_tid(), lane = tid & 63, w = tid >> 6, wm = w >> 2, wn = w & 3, lq = lane & 31, h = lane >> 5;
  f32x16 acc[2][4];
#pragma unroll
  for (int i = 0; i < 2; ++i)
#pragma unroll
    for (int j = 0; j < 4; ++j)
#pragma unroll
      for (int r = 0; r < 16; ++r) acc[i][j][r] = 0.f;
  const int r0 = tid >> 3, c0 = tid & 7;
  const bf16_t* ag = A + (size_t)(m0 + r0) * lda + c0 * 8;
  const bf16_t* bg = Bt + (size_t)(n0 + r0) * ldb + c0 * 8;
  const int wofs = r0 * 128 + ((c0 ^ ((r0 >> 1) & 7)) << 4);
  char* sA = smem; char* sB = smem + 32768;
  u32x4 ra[4], rb[4];
#pragma unroll
  for (int i = 0; i < 4; ++i) { ra[i] = *(const u32x4*)(ag + (size_t)i * 64 * lda); rb[i] = *(const u32x4*)(bg + (size_t)i * 64 * ldb); }
#pragma unroll
  for (int i = 0; i < 4; ++i) { *(u32x4*)(sA + wofs + i * 8192) = ra[i]; *(u32x4*)(sB + wofs + i * 8192) = rb[i]; }
  __syncthreads();
  const int nk = K >> 6, swz = (lane >> 1) & 7;
  const int aoff = (64 * wn + lq) * 128, boff = (128 * wm + lq) * 128;
  for (int kt = 0; kt < nk; ++kt) {
    const char* cA = sA + (kt & 1) * 65536; const char* cB = sB + (kt & 1) * 65536;
    const bool more = (kt + 1 < nk);
    if (more) { ag += 64; bg += 64;
#pragma unroll
      for (int i = 0; i < 4; ++i) { ra[i] = *(const u32x4*)(ag + (size_t)i * 64 * lda); rb[i] = *(const u32x4*)(bg + (size_t)i * 64 * ldb); } }
#pragma unroll
    for (int s = 0; s < 4; ++s) {
      const int co = (((2 * s + h) ^ swz) << 4);
      bf16x8 fa[2], fb[4];
#pragma unroll
      for (int ni = 0; ni < 2; ++ni) fa[ni] = *(const bf16x8*)(cB + aoff + ni * 4096 + co);
#pragma unroll
      for (int mi = 0; mi < 4; ++mi) fb[mi] = *(const bf16x8*)(cA + boff + mi * 4096 + co);
#pragma unroll
      for (int ni = 0; ni < 2; ++ni)
#pragma unroll
        for (int mi = 0; mi < 4; ++mi) acc[ni][mi] = MFMA32(fa[ni], fb[mi], acc[ni][mi]);
    }
    if (more) { char* dA = sA + ((kt + 1) & 1) * 65536; char* dB = sB + ((kt + 1) & 1) * 65536;
#pragma unroll
      for (int i = 0; i < 4; ++i) { *(u32x4*)(dA + wofs + i * 8192) = ra[i]; *(u32x4*)(dB + wofs + i * 8192) = rb[i]; } }
    __syncthreads();
  }
#pragma unroll
  for (int ni = 0; ni < 2; ++ni)
#pragma unroll
    for (int mi = 0; mi < 4; ++mi)
#pragma unroll
      for (int rg = 0; rg < 4; ++rg) {
        const int m = m0 + 128 * wm + 32 * mi + lq, n = n0 + 64 * wn + 32 * ni + 8 * rg + 4 * h;
        epi(m, n, acc[ni][mi][4 * rg], acc[ni][mi][4 * rg + 1], acc[ni][mi][4 * rg + 2], acc[ni][mi][4 * rg + 3]);
      }
}

DI void tile_coord(int t, int npn, int& pm, int& pn) { const int g = t / (16 * npn), r = t % (16 * npn); pn = r >> 4; pm = g * 16 + (r & 15); }

struct EpiProj { bf16_t* proj; float* ab;
  DI void operator()(int m, int n, float v0, float v1, float v2, float v3) const {
    u32x2 pk = {pack2(v0, v1), pack2(v2, v3)}; *(u32x2*)(proj + (size_t)m * DINP + n) = pk;
    if (n >= C_AA && n < C_AA + 16) { f32x4 v = {v0, v1, v2, v3}; *(f32x4*)(ab + (size_t)m * 16 + (n - C_AA)) = v; } } };
struct EpiF32 { float* out; int ldc;
  DI void operator()(int m, int n, float v0, float v1, float v2, float v3) const { f32x4 v = {v0, v1, v2, v3}; *(f32x4*)(out + (size_t)m * ldc + n) = v; } };
struct EpiBf { bf16_t* out; int ldc;
  DI void operator()(int m, int n, float v0, float v1, float v2, float v3) const { u32x2 pk = {pack2(v0, v1), pack2(v2, v3)}; *(u32x2*)(out + (size_t)m * ldc + n) = pk; } };
struct EpiMlaQ { float* qraw; const float* rs; int m0;
  DI void operator()(int m, int n, float v0, float v1, float v2, float v3) const { const float r = rs[m - m0]; f32x4 v = {v0 * r, v1 * r, v2 * r, v3 * r}; *(f32x4*)(qraw + (size_t)m * 768 + n) = v; } };
struct EpiMlaKV { bf16_t* kmla; bf16_t* vt; const float* rs; int m0;
  DI void operator()(int m, int n, float v0, float v1, float v2, float v3) const {
    const float r = rs[m - m0]; const int hd = n >> 8, wi = n & 255;
    if (wi < 128) { u32x2 pk = {pack2(v0 * r, v1 * r), pack2(v2 * r, v3 * r)}; *(u32x2*)(kmla + ((size_t)hd * S_ + m) * 192 + wi) = pk; }
    else { bf16_t* p = vt + ((size_t)hd * 128 + (wi - 128)) * S_ + m; p[0] = f2bf(v0 * r); p[S_] = f2bf(v1 * r); p[2 * (size_t)S_] = f2bf(v2 * r); p[3 * (size_t)S_] = f2bf(v3 * r); } } };

template <class Epi>
DI void gemm_phase(const bf16_t* A, int lda, const bf16_t* Bt, int ldb, int K, int npm, int npn, char* smem, const Epi& epi) {
  for (int t = blockIdx.x; t < npm * npn; t += gridDim.x) { int pm, pn; tile_coord(t, npn, pm, pn); gemm_tile(A, lda, Bt, ldb, K, pm * 256, pn * 256, smem, epi); }
}

DI void mod_item(const Params& P, int item) {
  const int tid = opaque_tid(); const int l = item / 96, r = item % 96, ks = r / 6, nc = r % 6;
  const int n = nc * 2048 + tid * 4;
  const float* wp = P.ada_w + ((size_t)l * 2048 + ks * 128) * 12288 + n;
  f32x4 acc = {0.f, 0.f, 0.f, 0.f};
  for (int k = 0; k < 128; ++k) { const float cv = P.c[ks * 128 + k]; const float ca = silu_f(cv); const f32x4 wv = *(const f32x4*)(wp + (size_t)k * 12288); acc += wv * ca; }
  float* modp = (float*)(P.ws + OFF_MODP);
  *(f32x4*)(modp + ((size_t)l * 16 + ks) * 12288 + n) = acc;
}
DI void convert_tile(const float* __restrict__ src, int K, int N, int Npad, bf16_t* __restrict__ dst, int tk, int tn, const float* rowscale, char* smem) {
  float* sm = (float*)smem; const int tid = opaque_tid(); const int k0 = tk * 64, n0 = tn * 64;
  { const int r = tid >> 4, c4 = tid & 15;
#pragma unroll
    for (int rr = 0; rr < 2; ++rr) { const int kk = r + 32 * rr; const int n = n0 + 4 * c4; f32x4 v = {0.f, 0.f, 0.f, 0.f};
      if (n < N) { v = *(const f32x4*)(src + (size_t)(k0 + kk) * N + n); if (rowscale) v *= rowscale[k0 + kk]; }
      sm[kk * 65 + 4 * c4 + 0] = v.x; sm[kk * 65 + 4 * c4 + 1] = v.y; sm[kk * 65 + 4 * c4 + 2] = v.z; sm[kk * 65 + 4 * c4 + 3] = v.w; } }
  __syncthreads();
  { const int n = tid >> 3, kc = tid & 7;
    if (n0 + n < Npad) { float f[8];
#pragma unroll
      for (int i = 0; i < 8; ++i) f[i] = sm[(kc * 8 + i) * 65 + n];
      u32x4 pk = {pack2(f[0], f[1]), pack2(f[2], f[3]), pack2(f[4], f[5]), pack2(f[6], f[7])};
      *(u32x4*)(dst + (size_t)(n0 + n) * K + k0 + kc * 8) = pk; } }
  __syncthreads();
}
constexpr int CV_T0 = 32 * 88, CV_T1 = CV_T0 + 32 * 32, CV_T2 = CV_T1 + 32 * 176, CV_T3 = CV_T2 + 88 * 32, CV_T4 = CV_T3 + 7 * 12, CV_T5 = CV_T4 + 2 * 16;
DI void convert_item(const Params& P, int l, int it, char* smem) {
  char* wb = P.ws + OFF_W;
  if (it < CV_T0) convert_tile(P.w_in + (size_t)l * 2048 * 5520, 2048, 5520, 5632, (bf16_t*)(wb + W_IN), it / 88, it % 88, nullptr, smem);
  else if (it < CV_T1) { it -= CV_T0; convert_tile(P.w_out + (size_t)l * 2048 * 2048, 2048, 2048, 2048, (bf16_t*)(wb + W_OUT), it / 32, it % 32, nullptr, smem); }
  else if (it < CV_T2) { it -= CV_T1; convert_tile(P.ffn_w_up + (size_t)l * 2048 * 11264, 2048, 11264, 11264, (bf16_t*)(wb + W_UP), it / 176, it % 176, nullptr, smem); }
  else if (it < CV_T3) { it -= CV_T2; convert_tile(P.ffn_w_down + (size_t)l * 5632 * 2048, 5632, 2048, 2048, (bf16_t*)(wb + W_DOWN), it / 32, it % 32, nullptr, smem); }
  else if (it < CV_T4) { it -= CV_T3; convert_tile(P.mla_w_uq + (size_t)l * 448 * 768, 448, 768, 768, (bf16_t*)(wb + W_UQ), it / 12, it % 12, P.mla_q_norm + l * 448, smem); }
  else { it -= CV_T4; convert_tile(P.mla_w_ukv + (size_t)l * 128 * 1024, 128, 1024, 1024, (bf16_t*)(wb + W_UKV), it / 16, it % 16, P.mla_kv_norm + l * 128, smem); }
}

DI float mod_val(const float* modp_l, const float* ada_b_l, int idx) { float s = ada_b_l[idx];
#pragma unroll
  for (int k = 0; k < 16; ++k) s += modp_l[(size_t)k * 12288 + idx]; return s; }
DI void rownorm_phase(const Params& P, const float* xin, const float* yin, float* xout, bf16_t* hout, int lg, int gate_idx, const float* w_post,
                      int lh, int scale_idx, int shift_idx, const float* w_pre, char* smem) {
  float* A1 = (float*)smem; float* A2 = A1 + 2048; float* B2 = A2 + 2048;
  const int tid = opaque_tid(), lane = tid & 63, w = tid >> 6;
  const float* modp = (const float*)(P.ws + OFF_MODP);
  for (int cidx = tid; cidx < 2048; cidx += NT) {
    if (yin) A1[cidx] = mod_val(modp + (size_t)lg * 16 * 12288, P.ada_b + (size_t)lg * 12288, gate_idx * 2048 + cidx) * w_post[cidx];
    if (hout) { A2[cidx] = w_pre[cidx] * (1.f + mod_val(modp + (size_t)lh * 16 * 12288, P.ada_b + (size_t)lh * 12288, scale_idx * 2048 + cidx));
      B2[cidx] = mod_val(modp + (size_t)lh * 16 * 12288, P.ada_b + (size_t)lh * 12288, shift_idx * 2048 + cidx); }
  }
  __syncthreads();
  for (int row = blockIdx.x * 8 + w; row < S_; row += gridDim.x * 8) {
    f32x4 xv[8];
#pragma unroll
    for (int j = 0; j < 8; ++j) xv[j] = *(const f32x4*)(xin + (size_t)row * 2048 + (j * 64 + lane) * 4);
    if (yin) {
      f32x4 yv[8]; float ss = 0.f;
#pragma unroll
      for (int j = 0; j < 8; ++j) { yv[j] = *(const f32x4*)(yin + (size_t)row * 2048 + (j * 64 + lane) * 4); ss += yv[j].x * yv[j].x + yv[j].y * yv[j].y + yv[j].z * yv[j].z + yv[j].w * yv[j].w; }
      ss = wave_sum(ss); const float r = rsqrtf(ss * (1.f / 2048.f) + EPS);
#pragma unroll
      for (int j = 0; j < 8; ++j) { const f32x4 a = *(const f32x4*)(A1 + (j * 64 + lane) * 4); xv[j] += a * (yv[j] * r); }
    }
    if (yin || xout != xin) {
#pragma unroll
      for (int j = 0; j < 8; ++j) *(f32x4*)(xout + (size_t)row * 2048 + (j * 64 + lane) * 4) = xv[j];
    }
    if (hout) {
      float ss = 0.f;
#pragma unroll
      for (int j = 0; j < 8; ++j) ss += xv[j].x * xv[j].x + xv[j].y * xv[j].y + xv[j].z * xv[j].z + xv[j].w * xv[j].w;
      ss = wave_sum(ss); const float r = rsqrtf(ss * (1.f / 2048.f) + EPS);
#pragma unroll
      for (int j = 0; j < 8; ++j) { const f32x4 a = *(const f32x4*)(A2 + (j * 64 + lane) * 4), b = *(const f32x4*)(B2 + (j * 64 + lane) * 4);
        const f32x4 hv = xv[j] * r * a + b; u32x2 pk = {pack2(hv.x, hv.y), pack2(hv.z, hv.w)};
        *(u32x2*)(hout + (size_t)row * 2048 + (j * 64 + lane) * 4) = pk; }
    }
  }
  __syncthreads();
}

DI void mla_q_tile(const Params& P, int pm, int pn, char* smem) {
  const bf16_t* proj = (const bf16_t*)(P.ws + OFF_PROJ); const int tid = opaque_tid(), m0 = pm * 256; float* rs = (float*)(smem + 131072);
  { const int row = tid >> 1, half = tid & 1; const bf16_t* p = proj + (size_t)(m0 + row) * DINP + C_BCQ + half * 224; float ss = 0.f;
    for (int i = 0; i < 28; ++i) { const u32x4 v = *(const u32x4*)(p + i * 8); float f[8]; unpack8(v, f);
#pragma unroll
      for (int e = 0; e < 8; ++e) ss += f[e] * f[e]; }
    ss += __shfl_xor(ss, 1); if (half == 0) rs[row] = rsqrtf(ss * (1.f / 448.f) + EPS); }
  EpiMlaQ epi{(float*)(P.ws + OFF_QRAW), rs, m0};
  gemm_tile(proj + C_BCQ, DINP, (const bf16_t*)(P.ws + OFF_W + W_UQ), 448, 448, m0, pn * 256, smem, epi);
  __syncthreads();
}
DI void mla_kv_tile(const Params& P, int pm, int pn, char* smem) {
  const bf16_t* proj = (const bf16_t*)(P.ws + OFF_PROJ); const int tid = opaque_tid(), m0 = pm * 256; float* rs = (float*)(smem + 131072);
  { const int row = tid >> 1, half = tid & 1; const bf16_t* p = proj + (size_t)(m0 + row) * DINP + C_BCKV + half * 64; float ss = 0.f;
#pragma unroll
    for (int i = 0; i < 8; ++i) { const u32x4 v = *(const u32x4*)(p + i * 8); float f[8]; unpack8(v, f);
#pragma unroll
      for (int e = 0; e < 8; ++e) ss += f[e] * f[e]; }
    ss += __shfl_xor(ss, 1); if (half == 0) rs[row] = rsqrtf(ss * (1.f / 128.f) + EPS); }
  bf16_t* kmla = (bf16_t*)(P.ws + OFF_KMLA);
  EpiMlaKV epi{kmla, (bf16_t*)(P.ws + OFF_VT), rs, m0};
  gemm_tile(proj + C_BCKV, DINP, (const bf16_t*)(P.ws + OFF_W + W_UKV), 128, 128, m0, pn * 256, smem, epi);
  if (pn == 0) {
    for (int i = 0; i < 16; ++i) { const int idx = tid + NT * i, row = idx >> 5, pi = idx & 31, m = m0 + row;
      const float x1 = bflo((unsigned)proj[(size_t)m * DINP + C_BKR + pi]), x2 = bflo((unsigned)proj[(size_t)m * DINP + C_BKR + 32 + pi]);
      double fr = (double)P.pos[m] * kInvFreq2Pi[pi]; fr -= floor(fr); const float ff = (float)fr;
      const float sn = __builtin_amdgcn_sinf(ff), cs = __builtin_amdgcn_cosf(ff);
      const bf16_t o1 = f2bf(x1 * cs - x2 * sn), o2 = f2bf(x2 * cs + x1 * sn);
#pragma unroll
      for (int hd = 0; hd < 4; ++hd) { bf16_t* kp = kmla + ((size_t)hd * S_ + m) * 192 + 128; kp[pi] = o1; kp[32 + pi] = o2; } }
  }
  __syncthreads();
}

DI void gdn_prep_item(const Params& P, int l, int n, int hh, char* smem) {
  const int tid = opaque_tid(), lane = tid & 63, w = tid >> 6, lq = lane & 31, h = lane >> 5;
  const bf16_t* proj = (const bf16_t*)(P.ws + OFF_PROJ); const float* ab = (const float*)(P.ws + OFF_AB);
  char* kb16 = smem; char* qb16 = smem + 17408;
  float* kf = (float*)(smem + 34816); float* vf = kf + 8192; float* Lm = vf + 8192; float* gcs = Lm + 4096;
  const size_t tile = (size_t)hh * 256 + n; const int t0 = n * 64;
  bf16_t* Wp = (bf16_t*)(P.ws + OFF_WP) + tile * 8192; bf16_t* Qd = (bf16_t*)(P.ws + OFF_QD) + tile * 8192;
  bf16_t* Kt = (bf16_t*)(P.ws + OFF_KT) + tile * 8192; bf16_t* Zt = (bf16_t*)(P.ws + OFF_ZT) + tile * 8192;
  bf16_t* QK = (bf16_t*)(P.ws + OFF_QK) + tile * 4096; float* Ut = (float*)(P.ws + OFF_UT) + tile * 8192;
  if (w == 0) {
    const int t = lane; const float a_raw = ab[(size_t)(t0 + t) * 16 + hh], b_raw = ab[(size_t)(t0 + t) * 16 + 8 + hh];
    const float Aa = expf(P.gdn_a_log[l * 8 + hh]); const float xb = a_raw + P.gdn_dt_bias[l * 8 + hh];
    const float sp = xb > 20.f ? xb : log1pf(expf(xb));
    float g = -Aa * sp;
#pragma unroll
    for (int d = 1; d < 64; d <<= 1) { const float v = __shfl_up(g, d); if (lane >= d) g += v; }
    const float bt = 1.f / (1.f + expf(-b_raw)), eg = expf(g); gcs[t] = g; gcs[64 + t] = bt; gcs[128 + t] = eg; gcs[192 + t] = bt * eg;
    if (t == 63) ((float*)(P.ws + OFF_GTOT))[tile] = expf(g);
  }
  __syncthreads();
  {
    const int t = tid >> 3, part = tid & 7, tabs = t0 + t;
    const float gct = gcs[t], egct = gcs[128 + t], ktl = expf(gcs[63] - gct);
    const int pjt = 32 * (t >> 5) + perm32(t & 31);
#pragma unroll
    for (int X = 0; X < 3; ++X) {
      const int cb = X * 1024 + hh * 128 + part * 16;
      float y[16];
#pragma unroll
      for (int e = 0; e < 16; ++e) y[e] = 0.f;
#pragma unroll
      for (int j = 0; j < 4; ++j) { const int row = tabs - 3 + j;
        if (row >= 0) { const u32x4 v0 = *(const u32x4*)(proj + (size_t)row * DINP + cb), v1 = *(const u32x4*)(proj + (size_t)row * DINP + cb + 8);
          float xv[16]; unpack8(v0, xv); unpack8(v1, xv + 8); const float* cw = P.gdn_conv + ((size_t)l * 4 + j) * 3072 + cb;
#pragma unroll
          for (int e4 = 0; e4 < 4; ++e4) { const f32x4 wv = *(const f32x4*)(cw + 4 * e4); y[4 * e4] += wv.x * xv[4 * e4]; y[4 * e4 + 1] += wv.y * xv[4 * e4 + 1]; y[4 * e4 + 2] += wv.z * xv[4 * e4 + 2]; y[4 * e4 + 3] += wv.w * xv[4 * e4 + 3]; } } }
#pragma unroll
      for (int e = 0; e < 16; ++e) y[e] = silu_f(y[e]);
      if (X < 2) { float ss = 0.f;
#pragma unroll
        for (int e = 0; e < 16; ++e) ss += y[e] * y[e];
        ss += __shfl_xor(ss, 1); ss += __shfl_xor(ss, 2); ss += __shfl_xor(ss, 4);
        const float rn = rsqrtf(ss + EPS) * (X == 0 ? 0.08838834764831845f : 1.f);
#pragma unroll
        for (int e = 0; e < 16; ++e) y[e] *= rn; }
      if (X == 0) {
        u32x4 p0 = {pack2(y[0], y[1]), pack2(y[2], y[3]), pack2(y[4], y[5]), pack2(y[6], y[7])}, p1 = {pack2(y[8], y[9]), pack2(y[10], y[11]), pack2(y[12], y[13]), pack2(y[14], y[15])};
        *(u32x4*)(qb16 + t * 272 + part * 32) = p0; *(u32x4*)(qb16 + t * 272 + part * 32 + 16) = p1;
#pragma unroll
        for (int b = 0; b < 4; ++b) { u32x2 pk = {pack2(y[4 * b] * egct, y[4 * b + 1] * egct), pack2(y[4 * b + 2] * egct, y[4 * b + 3] * egct)};
          *(u32x2*)(Qd + t * 128 + 32 * (part >> 1) + 8 * b + 4 * (part & 1)) = pk; }
      } else if (X == 1) {
        u32x4 p0 = {pack2(y[0], y[1]), pack2(y[2], y[3]), pack2(y[4], y[5]), pack2(y[6], y[7])}, p1 = {pack2(y[8], y[9]), pack2(y[10], y[11]), pack2(y[12], y[13]), pack2(y[14], y[15])};
        *(u32x4*)(kb16 + t * 272 + part * 32) = p0; *(u32x4*)(kb16 + t * 272 + part * 32 + 16) = p1;
#pragma unroll
        for (int e4 = 0; e4 < 4; ++e4) { f32x4 v = {y[4 * e4], y[4 * e4 + 1], y[4 * e4 + 2], y[4 * e4 + 3]}; *(f32x4*)(kf + t * 128 + part * 16 + 4 * e4) = v; }
#pragma unroll
        for (int e = 0; e < 16; ++e) Kt[(part * 16 + e) * 64 + pjt] = f2bf(y[e] * ktl);
      } else {
#pragma unroll
        for (int e4 = 0; e4 < 4; ++e4) { f32x4 v = {y[4 * e4], y[4 * e4 + 1], y[4 * e4 + 2], y[4 * e4 + 3]}; *(f32x4*)(vf + t * 128 + part * 16 + 4 * e4) = v; }
      }
    }
    { const int cb = C_AZ + hh * 128 + part * 16; const u32x4 v0 = *(const u32x4*)(proj + (size_t)tabs * DINP + cb), v1 = *(const u32x4*)(proj + (size_t)tabs * DINP + cb + 8);
      float zv[16]; unpack8(v0, zv); unpack8(v1, zv + 8);
#pragma unroll
      for (int e = 0; e < 16; ++e) Zt[(part * 16 + e) * 64 + t] = f2bf(silu_f(zv[e])); }
  }
  __syncthreads();
  {
    const int which = w >> 2, ti = (w >> 1) & 1, tj = w & 1; const char* Ab = which ? qb16 : kb16;
    f32x16 acc;
#pragma unroll
    for (int r = 0; r < 16; ++r) acc[r] = 0.f;
#pragma unroll
    for (int s = 0; s < 8; ++s) { const bf16x8 a = *(const bf16x8*)(Ab + (32 * ti + lq) * 272 + (16 * s + 8 * h) * 2), b = *(const bf16x8*)(kb16 + (32 * tj + lq) * 272 + (16 * s + 8 * h) * 2);
      acc = MFMA32(a, b, acc); }
    const int j = 32 * tj + lq; const float gj = gcs[j]; const int pj = 32 * (j >> 5) + perm32(j & 31);
#pragma unroll
    for (int r = 0; r < 16; ++r) { const int i = 32 * ti + crow(r, h); const float dec = __expf(fminf(gcs[i] - gj, 0.f));
      if (which == 0) Lm[i * 64 + j] = (j < i) ? gcs[64 + i] * acc[r] * dec : 0.f;
      else QK[i * 64 + pj] = f2bf((j <= i) ? acc[r] * dec : 0.f); }
  }
  __syncthreads();
  if (tid < 256) {
    const int c = tid; const bool isu = c < 128; const int cc = c & 127;
    const float* rp = (isu ? vf : kf) + cc; const float* sp = gcs + (isu ? 64 : 192);
    float x[64];
#pragma unroll
    for (int i = 0; i < 64; ++i) {
      float r = sp[i] * rp[i * 128];
#pragma unroll
      for (int j = 0; j < i; ++j) r = fmaf(-Lm[i * 64 + j], x[j], r);
      x[i] = r;
    }
    if (isu) {
#pragma unroll
      for (int i4 = 0; i4 < 16; ++i4) { f32x4 v = {x[4 * i4], x[4 * i4 + 1], x[4 * i4 + 2], x[4 * i4 + 3]}; *(f32x4*)(Ut + cc * 64 + 4 * i4) = v; }
    } else {
      const int pp = 32 * (cc >> 5) + perm32(cc & 31);
#pragma unroll
      for (int i = 0; i < 64; ++i) Wp[i * 128 + pp] = f2bf(x[i]);
    }
  }
  __syncthreads();
}

DI bf16x8 pack_tiles(const f32x4& a, const f32x4& b) { return pack8(a.x, a.y, a.z, a.w, b.x, b.y, b.z, b.w); }
DI void gdn_scan_item(const Params& P, int l, int hh, char* smem) {
  const int tid = opaque_tid(), lane = tid & 63, w = tid >> 6, l15 = lane & 15, q4 = lane >> 4;
  char* sWp = smem; char* sQd = smem + 17408; char* sKt = smem + 34816; char* sQK = smem + 53248;
  float* sPart = (float*)(smem + 62464); float* sRstd = sPart + 512 + w * 64;
  const size_t hb = (size_t)hh * 256;
  const bf16_t* Wp = (const bf16_t*)(P.ws + OFF_WP) + hb * 8192; const bf16_t* Qd = (const bf16_t*)(P.ws + OFF_QD) + hb * 8192;
  const bf16_t* Kt = (const bf16_t*)(P.ws + OFF_KT) + hb * 8192; const bf16_t* Zt = (const bf16_t*)(P.ws + OFF_ZT) + hb * 8192;
  const bf16_t* QK = (const bf16_t*)(P.ws + OFF_QK) + hb * 4096; const float* Ut = (const float*)(P.ws + OFF_UT) + hb * 8192;
  const float* gt = (const float*)(P.ws + OFF_GTOT) + hb;
  bf16_t* mixin = (bf16_t*)(P.ws + OFF_H);
  const int dvc = 16 * w + l15; const float nw = P.gdn_norm[l * 128 + dvc];
  const int g256 = (tid >> 4) * 128 + (tid & 15) * 8, l256 = (tid >> 4) * 272 + (tid & 15) * 16;
  const int g128 = (tid >> 3) * 64 + (tid & 7) * 8, l128 = (tid >> 3) * 144 + (tid & 7) * 16;
  f32x4 St[8];
#pragma unroll
  for (int t = 0; t < 8; ++t) St[t] = (f32x4){0.f, 0.f, 0.f, 0.f};
  u32x4 pw[2], pq[2], pk[2], pqk; f32x4 uc[4], un[4]; u32x2 zc[4], zn[4]; float gcur, gn = 0.f;
#pragma unroll
  for (int i = 0; i < 2; ++i) { pw[i] = *(const u32x4*)(Wp + g256 + i * 4096); pq[i] = *(const u32x4*)(Qd + g256 + i * 4096); pk[i] = *(const u32x4*)(Kt + g128 + i * 4096); }
  pqk = *(const u32x4*)(QK + g128);
#pragma unroll
  for (int it = 0; it < 4; ++it) { uc[it] = *(const f32x4*)(Ut + dvc * 64 + 16 * it + 4 * q4); zc[it] = *(const u32x2*)(Zt + dvc * 64 + 16 * it + 4 * q4); un[it] = uc[it]; zn[it] = zc[it]; }
  gcur = gt[0];
#pragma unroll
  for (int i = 0; i < 2; ++i) { *(u32x4*)(sWp + l256 + i * 8704) = pw[i]; *(u32x4*)(sQd + l256 + i * 8704) = pq[i]; *(u32x4*)(sKt + l128 + i * 9216) = pk[i]; }
  *(u32x4*)(sQK + l128) = pqk;
  __syncthreads();
  for (int n = 0; n < 256; ++n) {
    const bool more = (n + 1 < 256);
    if (more) { const size_t o8 = (size_t)(n + 1) * 8192, o4 = (size_t)(n + 1) * 4096;
#pragma unroll
      for (int i = 0; i < 2; ++i) { pw[i] = *(const u32x4*)(Wp + o8 + g256 + i * 4096); pq[i] = *(const u32x4*)(Qd + o8 + g256 + i * 4096); pk[i] = *(const u32x4*)(Kt + o8 + g128 + i * 4096); }
      pqk = *(const u32x4*)(QK + o4 + g128);
#pragma unroll
      for (int it = 0; it < 4; ++it) { un[it] = *(const f32x4*)(Ut + o8 + dvc * 64 + 16 * it + 4 * q4); zn[it] = *(const u32x2*)(Zt + o8 + dvc * 64 + 16 * it + 4 * q4); }
      gn = gt[n + 1]; }
    bf16x8 sb[4];
#pragma unroll
    for (int ks = 0; ks < 4; ++ks) sb[ks] = pack_tiles(St[2 * ks], St[2 * ks + 1]);
    f32x4 wsv[4], qs[4];
#pragma unroll
    for (int it = 0; it < 4; ++it) { wsv[it] = (f32x4){0.f, 0.f, 0.f, 0.f}; qs[it] = (f32x4){0.f, 0.f, 0.f, 0.f}; }
#pragma unroll
    for (int it = 0; it < 4; ++it)
#pragma unroll
      for (int ks = 0; ks < 4; ++ks) { const int o = (16 * it + l15) * 272 + 64 * ks + 16 * q4;
        const bf16x8 a = *(const bf16x8*)(sWp + o), a2 = *(const bf16x8*)(sQd + o);
        wsv[it] = MFMA16(a, sb[ks], wsv[it]); qs[it] = MFMA16(a2, sb[ks], qs[it]); }
    f32x4 vn[4];
#pragma unroll
    for (int it = 0; it < 4; ++it) vn[it] = uc[it] - wsv[it];
    bf16x8 vb[2];
#pragma unroll
    for (int ks = 0; ks < 2; ++ks) vb[ks] = pack_tiles(vn[2 * ks], vn[2 * ks + 1]);
#pragma unroll
    for (int it = 0; it < 4; ++it)
#pragma unroll
      for (int ks = 0; ks < 2; ++ks) { const bf16x8 a = *(const bf16x8*)(sQK + (16 * it + l15) * 144 + 64 * ks + 16 * q4); qs[it] = MFMA16(a, vb[ks], qs[it]); }
#pragma unroll
    for (int t = 0; t < 8; ++t) { St[t] *= gcur;
#pragma unroll
      for (int ks = 0; ks < 2; ++ks) { const bf16x8 a = *(const bf16x8*)(sKt + (16 * t + l15) * 144 + 64 * ks + 16 * q4); St[t] = MFMA16(a, vb[ks], St[t]); } }
#pragma unroll
    for (int it = 0; it < 4; ++it) {
      f32x4 ss = qs[it] * qs[it];
#pragma unroll
      for (int d = 1; d < 16; d <<= 1) { ss.x += __shfl_xor(ss.x, d); ss.y += __shfl_xor(ss.y, d); ss.z += __shfl_xor(ss.z, d); ss.w += __shfl_xor(ss.w, d); }
      if (l15 == 0) *(f32x4*)(sPart + w * 64 + 16 * it + 4 * q4) = ss;
    }
    __syncthreads();
    { float tot = 0.f;
#pragma unroll
      for (int ww = 0; ww < 8; ++ww) tot += sPart[ww * 64 + lane];
      sRstd[lane] = rsqrtf(tot * (1.f / 128.f) + EPS); }
#pragma unroll
    for (int it = 0; it < 4; ++it) {
      const f32x4 rs = *(const f32x4*)(sRstd + 16 * it + 4 * q4);
      const float z0 = bflo(zc[it].x), z1 = bfhi(zc[it].x), z2 = bflo(zc[it].y), z3 = bfhi(zc[it].y);
      bf16_t* op = mixin + (size_t)(64 * n + 16 * it + 4 * q4) * 2048 + hh * 128 + dvc;
      op[0] = f2bf(qs[it].x * rs.x * nw * z0); op[2048] = f2bf(qs[it].y * rs.y * nw * z1);
      op[4096] = f2bf(qs[it].z * rs.z * nw * z2); op[6144] = f2bf(qs[it].w * rs.w * nw * z3);
    }
    if (more) {
#pragma unroll
      for (int i = 0; i < 2; ++i) { *(u32x4*)(sWp + l256 + i * 8704) = pw[i]; *(u32x4*)(sQd + l256 + i * 8704) = pq[i]; *(u32x4*)(sKt + l128 + i * 9216) = pk[i]; }
      *(u32x4*)(sQK + l128) = pqk;
#pragma unroll
      for (int it = 0; it < 4; ++it) { uc[it] = un[it]; zc[it] = zn[it]; }
      gcur = gn;
    }
    __syncthreads();
  }
}

DI void mla_attn_item(const Params& P, int hd, int b, char* smem) {
  const int tid = opaque_tid(), lane = tid & 63, w = tid >> 6, wq = w & 3, hk = w >> 2, lq = lane & 31, h = lane >> 5;
  const float* qraw = (const float*)(P.ws + OFF_QRAW);
  const bf16_t* Kg = (const bf16_t*)(P.ws + OFF_KMLA) + (size_t)hd * S_ * 192;
  const bf16_t* Vg = (const bf16_t*)(P.ws + OFF_VT) + (size_t)hd * 128 * S_;
  bf16_t* mixin = (bf16_t*)(P.ws + OFF_H);
  const int q = 128 * b + 32 * wq + lq;
  bf16x8 qf[12];
  {
    const float* qp = qraw + (size_t)q * 768 + hd * 192 + 8 * h;
    const float sc = 0.07216878364870322f * LOG2E;
#pragma unroll
    for (int s = 0; s < 8; ++s) { const f32x4 a = *(const f32x4*)(qp + 16 * s), c = *(const f32x4*)(qp + 16 * s + 4);
      qf[s] = pack8(a.x * sc, a.y * sc, a.z * sc, a.w * sc, c.x * sc, c.y * sc, c.z * sc, c.w * sc); }
    const double pq = (double)P.pos[q];
#pragma unroll
    for (int s2 = 0; s2 < 2; ++s2) {
      const f32x4 a0 = *(const f32x4*)(qp + 128 + 16 * s2), a1 = *(const f32x4*)(qp + 128 + 16 * s2 + 4);
      const f32x4 b0 = *(const f32x4*)(qp + 160 + 16 * s2), b1 = *(const f32x4*)(qp + 160 + 16 * s2 + 4);
      float x1[8] = {a0.x, a0.y, a0.z, a0.w, a1.x, a1.y, a1.z, a1.w}, x2[8] = {b0.x, b0.y, b0.z, b0.w, b1.x, b1.y, b1.z, b1.w}, o1[8], o2[8];
#pragma unroll
      for (int j = 0; j < 8; ++j) { double fr = pq * kInvFreq2Pi[16 * s2 + 8 * h + j]; fr -= floor(fr); const float ff = (float)fr;
        const float sn = __builtin_amdgcn_sinf(ff), cs = __builtin_amdgcn_cosf(ff);
        o1[j] = (x1[j] * cs - x2[j] * sn) * sc; o2[j] = (x2[j] * cs + x1[j] * sn) * sc; }
      qf[8 + s2] = pack8(o1[0], o1[1], o1[2], o1[3], o1[4], o1[5], o1[6], o1[7]);
      qf[10 + s2] = pack8(o2[0], o2[1], o2[2], o2[3], o2[4], o2[5], o2[6], o2[7]);
    }
  }
  constexpr int KST = 64 * 400, VST = 128 * 144, STG = KST + VST;
  f32x16 O[4];
#pragma unroll
  for (int i = 0; i < 4; ++i)
#pragma unroll
    for (int r = 0; r < 16; ++r) O[i][r] = 0.f;
  float m_i = -1e30f, l_i = 0.f;
  const int nt = 2 * b + 2;
  u32x4 rk[3], rv[2];
  const int vrow = tid >> 3, vcc = tid & 7;
#pragma unroll
  for (int i = 0; i < 3; ++i) { const int id = tid + NT * i, row = id / 24, cc = id % 24; rk[i] = *(const u32x4*)(Kg + row * 192 + cc * 8); }
#pragma unroll
  for (int i = 0; i < 2; ++i) rv[i] = *(const u32x4*)(Vg + (size_t)(vrow + 64 * i) * S_ + vcc * 8);
#pragma unroll
  for (int i = 0; i < 3; ++i) { const int id = tid + NT * i, row = id / 24, cc = id % 24; *(u32x4*)(smem + row * 400 + cc * 16) = rk[i]; }
#pragma unroll
  for (int i = 0; i < 2; ++i) *(u32x4*)(smem + KST + (vrow + 64 * i) * 144 + vcc * 16) = rv[i];
  __syncthreads();
  for (int kt = 0; kt < nt; ++kt) {
    const char* sK = smem + (kt & 1) * STG; const char* sV = sK + KST;
    const bool more = (kt + 1 < nt);
    if (more) { const size_t ko = (size_t)(kt + 1) * 64 * 192; const int vo = (kt + 1) * 64;
#pragma unroll
      for (int i = 0; i < 3; ++i) { const int id = tid + NT * i, row = id / 24, cc = id % 24; rk[i] = *(const u32x4*)(Kg + ko + row * 192 + cc * 8); }
#pragma unroll
      for (int i = 0; i < 2; ++i) rv[i] = *(const u32x4*)(Vg + (size_t)(vrow + 64 * i) * S_ + vo + vcc * 8); }
    const int key0 = 64 * kt + 32 * hk;
    if (key0 <= 128 * b + 32 * wq) {
      f32x16 st;
#pragma unroll
      for (int r = 0; r < 16; ++r) st[r] = 0.f;
#pragma unroll
      for (int s = 0; s < 12; ++s) { const bf16x8 kf = *(const bf16x8*)(sK + (32 * hk + lq) * 400 + (2 * s + h) * 16); st = MFMA32(kf, qf[s], st); }
      if (key0 + 31 > 128 * b + 32 * wq) {
        int qrel = q - key0 - 4 * h; asm volatile("" : "+v"(qrel));
#pragma unroll
        for (int r = 0; r < 16; ++r) if ((r & 3) + 8 * (r >> 2) > qrel) st[r] = -1e30f;
      }
      float mx = st[0];
#pragma unroll
      for (int r = 1; r < 16; ++r) mx = fmaxf(mx, st[r]);
      mx = fmaxf(mx, __shfl_xor(mx, 32));
      const float m_new = fmaxf(m_i, mx), alpha = exp2f(m_i - m_new);
      float ps = 0.f;
#pragma unroll
      for (int r = 0; r < 16; ++r) { st[r] = exp2f(st[r] - m_new); ps += st[r]; }
      l_i = l_i * alpha + ps; m_i = m_new;
#pragma unroll
      for (int i = 0; i < 4; ++i)
#pragma unroll
        for (int r = 0; r < 16; ++r) O[i][r] *= alpha;
      bf16x8 pf[2];
#pragma unroll
      for (int s = 0; s < 2; ++s) pf[s] = pack8(st[8 * s], st[8 * s + 1], st[8 * s + 2], st[8 * s + 3], st[8 * s + 4], st[8 * s + 5], st[8 * s + 6], st[8 * s + 7]);
#pragma unroll
      for (int i = 0; i < 4; ++i)
#pragma unroll
        for (int s = 0; s < 2; ++s) { const char* vp = sV + (32 * i + lq) * 144 + (32 * hk + 16 * s + 4 * h) * 2;
          const u32x2 lo = *(const u32x2*)vp, hi = *(const u32x2*)(vp + 16); u32x4 vv = {lo.x, lo.y, hi.x, hi.y};
          O[i] = MFMA32(__builtin_bit_cast(bf16x8, vv), pf[s], O[i]); }
    }
    if (more) { char* dK = smem + ((kt + 1) & 1) * STG;
#pragma unroll
      for (int i = 0; i < 3; ++i) { const int id = tid + NT * i, row = id / 24, cc = id % 24; *(u32x4*)(dK + row * 400 + cc * 16) = rk[i]; }
#pragma unroll
      for (int i = 0; i < 2; ++i) *(u32x4*)(dK + KST + (vrow + 64 * i) * 144 + vcc * 16) = rv[i]; }
    __syncthreads();
  }
  float* cO = (float*)smem; float* cm = cO + 4 * 4096; float* cl = cm + 256;
  if (hk == 1) {
#pragma unroll
    for (int i = 0; i < 4; ++i)
#pragma unroll
      for (int r = 0; r < 16; ++r) cO[wq * 4096 + (i * 16 + r) * 64 + lane] = O[i][r];
    cm[wq * 64 + lane] = m_i; cl[wq * 64 + lane] = l_i;
  }
  __syncthreads();
  if (hk == 0) {
    const float m1 = cm[wq * 64 + lane], l1 = cl[wq * 64 + lane];
    const float m = fmaxf(m_i, m1), a0 = exp2f(m_i - m), a1 = exp2f(m1 - m);
    float lt = l_i * a0 + l1 * a1; lt += __shfl_xor(lt, 32);
    const float inv = 1.f / lt;
    bf16_t* op = mixin + (size_t)q * 2048 + 1024 + hd * 128;
#pragma unroll
    for (int i = 0; i < 4; ++i)
#pragma unroll
      for (int rg = 0; rg < 4; ++rg) { float v[4];
#pragma unroll
        for (int e = 0; e < 4; ++e) v[e] = (O[i][4 * rg + e] * a0 + cO[wq * 4096 + (i * 16 + 4 * rg + e) * 64 + lane] * a1) * inv;
        u32x2 pk = {pack2(v[0], v[1]), pack2(v[2], v[3])}; *(u32x2*)(op + 32 * i + 8 * rg + 4 * h) = pk; }
  }
  __syncthreads();
}

DI void swa_item(const Params& P, int l, int n, int hk2, char* smem) {
  const int tid = opaque_tid(), lane = tid & 63, w = tid >> 6, lq = lane & 31, h = lane >> 5;
  const bf16_t* proj = (const bf16_t*)(P.ws + OFF_PROJ); bf16_t* mixin = (bf16_t*)(P.ws + OFF_H);
  bf16_t* sVt = (bf16_t*)smem;
#pragma unroll
  for (int i = 0; i < 4; ++i) { const int id = tid + NT * i, key = id >> 3, dc = id & 7; const int kp = 128 * (n - 1) + key;
    u32x4 v = {0u, 0u, 0u, 0u}; if (kp >= 0) v = *(const u32x4*)(proj + (size_t)kp * DINP + C_CV + hk2 * 64 + dc * 8);
    sVt[(8 * dc + 0) * 264 + key] = (bf16_t)(v.x & 0xffff); sVt[(8 * dc + 1) * 264 + key] = (bf16_t)(v.x >> 16);
    sVt[(8 * dc + 2) * 264 + key] = (bf16_t)(v.y & 0xffff); sVt[(8 * dc + 3) * 264 + key] = (bf16_t)(v.y >> 16);
    sVt[(8 * dc + 4) * 264 + key] = (bf16_t)(v.z & 0xffff); sVt[(8 * dc + 5) * 264 + key] = (bf16_t)(v.z >> 16);
    sVt[(8 * dc + 6) * 264 + key] = (bf16_t)(v.w & 0xffff); sVt[(8 * dc + 7) * 264 + key] = (bf16_t)(v.w >> 16); }
  __syncthreads();
  const int g = w >> 1, hq = hk2 * 4 + g;
  const float slope = exp2f(-(float)(hq + 1)) * LOG2E, sinkv = P.swa_sinks[l * 8 + hq] * LOG2E;
#pragma unroll 1
  for (int jj = 0; jj < 2; ++jj) {
    const int j = 2 * (w & 1) + jj; const int qrow = 128 * n + 32 * j + lq;
    bf16x8 qf[4];
#pragma unroll
    for (int s = 0; s < 4; ++s) qf[s] = *(const bf16x8*)(proj + (size_t)qrow * DINP + C_CQ + hq * 64 + 16 * s + 8 * h);
    f32x16 st[5];
    bf16x8 kf[2][4];
    { const int kp = 128 * (n - 1) + 32 * j + lq;
#pragma unroll
      for (int s = 0; s < 4; ++s) { kf[0][s] = (bf16x8){0, 0, 0, 0, 0, 0, 0, 0}; if (kp >= 0) kf[0][s] = *(const bf16x8*)(proj + (size_t)kp * DINP + C_CK + hk2 * 64 + 16 * s + 8 * h); } }
#pragma unroll
    for (int tt = 0; tt < 5; ++tt) {
      if (tt + 1 < 5) { const int kp = 128 * (n - 1) + 32 * (j + tt + 1) + lq;
#pragma unroll
        for (int s = 0; s < 4; ++s) { kf[(tt + 1) & 1][s] = (bf16x8){0, 0, 0, 0, 0, 0, 0, 0}; if (kp >= 0) kf[(tt + 1) & 1][s] = *(const bf16x8*)(proj + (size_t)kp * DINP + C_CK + hk2 * 64 + 16 * s + 8 * h); } }
      __builtin_amdgcn_sched_barrier(0);
#pragma unroll
      for (int r = 0; r < 16; ++r) st[tt][r] = 0.f;
#pragma unroll
      for (int s = 0; s < 4; ++s) st[tt] = MFMA32(kf[tt & 1][s], qf[s], st[tt]);
      __builtin_amdgcn_sched_barrier(0);
    }
    float mx = sinkv;
    int dbase = 128 + lq - 4 * h, kbase = 128 * (n - 1) + 32 * j + 4 * h;
    asm volatile("" : "+v"(dbase), "+v"(kbase));
#pragma unroll
    for (int tt = 0; tt < 5; ++tt)
#pragma unroll
      for (int r = 0; r < 16; ++r) { const int cst = 32 * tt + (r & 3) + 8 * (r >> 2); const int dist = dbase - cst; const int kpos = kbase + cst;
        const bool valid = (dist >= 0) && (dist < 128) && (kpos >= 0);
        const float sv = valid ? st[tt][r] * (0.125f * LOG2E) - slope * (float)dist : -1e30f; st[tt][r] = sv; mx = fmaxf(mx, sv); }
    mx = fmaxf(mx, __shfl_xor(mx, 32));
    float den = 0.f;
#pragma unroll
    for (int tt = 0; tt < 5; ++tt)
#pragma unroll
      for (int r = 0; r < 16; ++r) { const float p = exp2f(st[tt][r] - mx); st[tt][r] = p; den += p; }
    den += __shfl_xor(den, 32); den += exp2f(sinkv - mx);
    f32x16 O[2];
#pragma unroll
    for (int i = 0; i < 2; ++i)
#pragma unroll
      for (int r = 0; r < 16; ++r) O[i][r] = 0.f;
#pragma unroll
    for (int tt = 0; tt < 5; ++tt)
#pragma unroll
      for (int s = 0; s < 2; ++s) { const bf16x8 pf = pack8(st[tt][8 * s], st[tt][8 * s + 1], st[tt][8 * s + 2], st[tt][8 * s + 3], st[tt][8 * s + 4], st[tt][8 * s + 5], st[tt][8 * s + 6], st[tt][8 * s + 7]);
#pragma unroll
        for (int i = 0; i < 2; ++i) { const char* vp = (const char*)sVt + (32 * i + lq) * 528 + (32 * (j + tt) + 16 * s + 4 * h) * 2;
          const u32x2 lo = *(const u32x2*)vp, hi = *(const u32x2*)(vp + 16); u32x4 vv = {lo.x, lo.y, hi.x, hi.y};
          O[i] = MFMA32(__builtin_bit_cast(bf16x8, vv), pf, O[i]); }
        __builtin_amdgcn_sched_barrier(0); }
    const float inv = 1.f / den;
    bf16_t* op = mixin + (size_t)qrow * 2048 + 1536 + hq * 64;
#pragma unroll
    for (int i = 0; i < 2; ++i)
#pragma unroll
      for (int rg = 0; rg < 4; ++rg) { u32x2 pk = {pack2(O[i][4 * rg] * inv, O[i][4 * rg + 1] * inv), pack2(O[i][4 * rg + 2] * inv, O[i][4 * rg + 3] * inv)};
        *(u32x2*)(op + 32 * i + 8 * rg + 4 * h) = pk; }
  }
  __syncthreads();
}

DI float gelu_tanh(float x) { const float y = 0.7978845608028654f * (x + 0.044715f * x * x * x); const float t = 1.f - 2.f / (1.f + __expf(2.f * y)); return 0.5f * x * (1.f + t); }
DI void ffn_act_phase(const Params& P, int l) {
  const int tid = opaque_tid(), lane = tid & 63, w = tid >> 6;
  const bf16_t* u = (const bf16_t*)(P.ws + OFF_BIG); bf16_t* act = (bf16_t*)(P.ws + OFF_ACT);
  const float* cw = P.ffn_conv + (size_t)l * 3 * DFF2; const float* cb = P.ffn_conv_b + (size_t)l * DFF2;
  for (int item = blockIdx.x * 8 + w; item < 512 * 11; item += gridDim.x * 8) {
    const int cbk = item % 11, rr = item / 11; const int ch = cbk * 512 + lane * 8, r0 = rr * 32;
    float wg[3][8], wu[3][8], bg[8], bu[8];
#pragma unroll
    for (int j = 0; j < 3; ++j)
#pragma unroll
      for (int e4 = 0; e4 < 2; ++e4) { const f32x4 a = *(const f32x4*)(cw + (size_t)j * DFF2 + ch + 4 * e4), b = *(const f32x4*)(cw + (size_t)j * DFF2 + DFF + ch + 4 * e4);
        wg[j][4 * e4] = a.x; wg[j][4 * e4 + 1] = a.y; wg[j][4 * e4 + 2] = a.z; wg[j][4 * e4 + 3] = a.w; wu[j][4 * e4] = b.x; wu[j][4 * e4 + 1] = b.y; wu[j][4 * e4 + 2] = b.z; wu[j][4 * e4 + 3] = b.w; }
#pragma unroll
    for (int e4 = 0; e4 < 2; ++e4) { const f32x4 a = *(const f32x4*)(cb + ch + 4 * e4), b = *(const f32x4*)(cb + DFF + ch + 4 * e4);
      bg[4 * e4] = a.x; bg[4 * e4 + 1] = a.y; bg[4 * e4 + 2] = a.z; bg[4 * e4 + 3] = a.w; bu[4 * e4] = b.x; bu[4 * e4 + 1] = b.y; bu[4 * e4 + 2] = b.z; bu[4 * e4 + 3] = b.w; }
    float g2[8], g1[8], u2[8], u1[8];
#pragma unroll
    for (int e = 0; e < 8; ++e) { g2[e] = 0.f; g1[e] = 0.f; u2[e] = 0.f; u1[e] = 0.f; }
    if (r0 >= 2) { unpack8(*(const u32x4*)(u + (size_t)(r0 - 2) * DFF2 + ch), g2); unpack8(*(const u32x4*)(u + (size_t)(r0 - 2) * DFF2 + DFF + ch), u2);
      unpack8(*(const u32x4*)(u + (size_t)(r0 - 1) * DFF2 + ch), g1); unpack8(*(const u32x4*)(u + (size_t)(r0 - 1) * DFF2 + DFF + ch), u1); }
    for (int r = r0; r < r0 + 32; ++r) {
      float g0[8], u0[8]; unpack8(*(const u32x4*)(u + (size_t)r * DFF2 + ch), g0); unpack8(*(const u32x4*)(u + (size_t)r * DFF2 + DFF + ch), u0);
      float o[8];
#pragma unroll
      for (int e = 0; e < 8; ++e) { const float yg = wg[0][e] * g2[e] + wg[1][e] * g1[e] + wg[2][e] * g0[e] + bg[e]; const float yu = wu[0][e] * u2[e] + wu[1][e] * u1[e] + wu[2][e] * u0[e] + bu[e];
        o[e] = gelu_tanh(yg) * yu; g2[e] = g1[e]; g1[e] = g0[e]; u2[e] = u1[e]; u1[e] = u0[e]; }
      u32x4 pk = {pack2(o[0], o[1]), pack2(o[2], o[3]), pack2(o[4], o[5]), pack2(o[6], o[7])};
      *(u32x4*)(act + (size_t)r * DFF + ch) = pk;
    }
  }
}

__global__ void __launch_bounds__(NT) fwd_megakernel(Params P0) {
  cg::grid_group grid = cg::this_grid();
  __shared__ __attribute__((aligned(16))) char smem[132352];
  const int tid = threadIdx.x;
  char* ws = P0.ws;
  int* ctrl = (int*)(ws + OFF_CTRL);
  if (blockIdx.x == 0 && tid < 64) ctrl[tid] = 0;
  if (blockIdx.x == 0 && tid == 0) *(Params*)(ws + OFF_CTRL + 1024) = P0;
  bf16_t* Hb = (bf16_t*)(ws + OFF_H);
  for (int it = blockIdx.x; it < 192 + CV_T5; it += gridDim.x) { if (it < 192) mod_item(P0, it); else convert_item(P0, 0, it - 192, smem); }
  grid.sync();
  const Params& P = *(const Params*)(ws + OFF_CTRL + 1024);
  rownorm_phase(P, P.x, nullptr, P.out, Hb, 0, 0, nullptr, 0, 1, 0, P.mix_pre, smem);
  grid.sync();
  for (int l = 0; l < 2; ++l) {
    { EpiProj epi{(bf16_t*)(ws + OFF_PROJ), (float*)(ws + OFF_AB)}; gemm_phase(Hb, 2048, (const bf16_t*)(ws + OFF_W + W_IN), 2048, 2048, 64, 22, smem, epi); }
    grid.sync();
    for (int it = blockIdx.x; it < 448 + 2048; it += gridDim.x) {
      if (it < 192) mla_q_tile(P, it / 3, it % 3, smem);
      else if (it < 448) mla_kv_tile(P, (it - 192) >> 2, (it - 192) & 3, smem);
      else { const int id = it - 448; gdn_prep_item(P, l, id >> 3, id & 7, smem); }
    }
    grid.sync();
    {
      int* sitem = (int*)(smem + 132096);
      for (;;) {
        if (tid == 0) *sitem = atomicAdd(ctrl + 16 * l, 1);
        __syncthreads(); const int item = *sitem; __syncthreads();
        if (item >= 8 + 512 + 256) break;
        if (item < 8) gdn_scan_item(P, l, item, smem);
        else if (item < 520) { const int idx = item - 8; mla_attn_item(P, idx & 3, 127 - (idx >> 2), smem); }
        else { const int idx = item - 520; swa_item(P, l, idx >> 1, idx & 1, smem); }
      }
    }
    grid.sync();
    { EpiF32 epi{(float*)(ws + OFF_MIXF), 2048}; gemm_phase(Hb, 2048, (const bf16_t*)(ws + OFF_W + W_OUT), 2048, 2048, 64, 8, smem, epi); }
    grid.sync();
    rownorm_phase(P, P.out, (const float*)(ws + OFF_MIXF), P.out, Hb, l, 2, P.mix_post + l * 2048, l, 4, 3, P.ffn_pre + l * 2048, smem);
    grid.sync();
    { EpiBf epi{(bf16_t*)(ws + OFF_BIG), DFF2}; gemm_phase(Hb, 2048, (const bf16_t*)(ws + OFF_W + W_UP), 2048, 2048, 64, 44, smem, epi); }
    grid.sync();
    ffn_act_phase(P, l);
    grid.sync();
    { EpiF32 epi{(float*)(ws + OFF_Y), 2048}; gemm_phase((const bf16_t*)(ws + OFF_ACT), DFF, (const bf16_t*)(ws + OFF_W + W_DOWN), DFF, DFF, 64, 8, smem, epi); }
    grid.sync();
    if (l == 0) {
      for (int it = blockIdx.x; it < CV_T5; it += gridDim.x) convert_item(P, 1, it, smem);
      rownorm_phase(P, P.out, (const float*)(ws + OFF_Y), P.out, Hb, 0, 5, P.ffn_post, 1, 1, 0, P.mix_pre + 2048, smem);
      grid.sync();
    } else {
      rownorm_phase(P, P.out, (const float*)(ws + OFF_Y), P.out, nullptr, 1, 5, P.ffn_post + 2048, 1, 1, 0, nullptr, smem);
    }
  }
}

extern "C" void kernel_launch(void* const* d_in, const int* in_sizes, int n_in, void* d_out, int out_size, void* d_ws, size_t ws_size, hipStream_t stream) {
  static int grid_blocks = 0;
  if (!grid_blocks) {
    int dev = 0, cus = 0, per = 0;
    (void)hipGetDevice(&dev); (void)hipDeviceGetAttribute(&cus, hipDeviceAttributeMultiprocessorCount, dev);
    (void)hipOccupancyMaxActiveBlocksPerMultiprocessor(&per, fwd_megakernel, NT, 0);
    if (per > 1) per = 1;
    grid_blocks = cus * per; if (grid_blocks <= 0) grid_blocks = 256;
  }
  if (ws_size < OFF_END) { fprintf(stderr, "workspace too small: %zu < %zu\n", ws_size, (size_t)OFF_END); return; }
  Params p{};
  p.x = (const float*)d_in[0]; p.c = (const float*)d_in[1]; p.pos = (const int*)d_in[2];
  p.ada_w = (const float*)d_in[3]; p.ada_b = (const float*)d_in[4]; p.mix_pre = (const float*)d_in[5]; p.mix_post = (const float*)d_in[6];
  p.w_in = (const float*)d_in[7]; p.w_out = (const float*)d_in[8]; p.gdn_conv = (const float*)d_in[9]; p.gdn_a_log = (const float*)d_in[10];
  p.gdn_dt_bias = (const float*)d_in[11]; p.gdn_norm = (const float*)d_in[12]; p.mla_q_norm = (const float*)d_in[13]; p.mla_w_uq = (const float*)d_in[14];
  p.mla_kv_norm = (const float*)d_in[15]; p.mla_w_ukv = (const float*)d_in[16]; p.swa_sinks = (const float*)d_in[17]; p.ffn_pre = (const float*)d_in[18];
  p.ffn_post = (const float*)d_in[19]; p.ffn_w_up = (const float*)d_in[20]; p.ffn_conv = (const float*)d_in[21]; p.ffn_conv_b = (const float*)d_in[22];
  p.ffn_w_down = (const float*)d_in[23];
  p.out = (float*)d_out; p.ws = (char*)d_ws;
  void* args[] = {&p};
  hipError_t e = hipLaunchCooperativeKernel((void*)fwd_megakernel, dim3(grid_blocks), dim3(NT), args, 0, stream);
  if (e != hipSuccess) fprintf(stderr, "cooperative launch failed: %s (grid %d)\n", hipGetErrorString(e), grid_blocks);
}
```

```cpp
#include <hip/hip_runtime.h>
#include <hip/hip_cooperative_groups.h>
#include <cstdio>
#include <cstdint>
namespace cg = cooperative_groups;

#define DI __device__ __forceinline__
typedef unsigned short bf16_t;
typedef short bf16x8 __attribute__((ext_vector_type(8)));
typedef float f32x2 __attribute__((ext_vector_type(2)));
typedef float f32x4 __attribute__((ext_vector_type(4)));
typedef float f32x16 __attribute__((ext_vector_type(16)));
typedef unsigned u32x2 __attribute__((ext_vector_type(2)));
typedef unsigned u32x4 __attribute__((ext_vector_type(4)));
typedef __bf16 bf2_t __attribute__((ext_vector_type(2)));

constexpr int S_ = 16384, D_ = 2048, DINP = 5632, DFF = 5632, DFF2 = 11264;
constexpr int NT = 512;
constexpr float EPS = 1e-6f;
constexpr float LOG2E = 1.4426950408889634f;

constexpr size_t OFF_CTRL = 0;
constexpr size_t OFF_MODP = 4096;
constexpr size_t OFF_W = 2097152;
constexpr size_t W_IN = 0, W_OUT = W_IN + (size_t)5632 * 2048 * 2, W_UP = W_OUT + (size_t)2048 * 2048 * 2,
                 W_DOWN = W_UP + (size_t)11264 * 2048 * 2, W_UQ = W_DOWN + (size_t)2048 * 5632 * 2,
                 W_UKV = W_UQ + (size_t)768 * 448 * 2, W_END = W_UKV + (size_t)1024 * 128 * 2;
constexpr size_t OFF_H = OFF_W + W_END;
constexpr size_t OFF_MIXF = OFF_H + (size_t)S_ * 2048 * 2;
constexpr size_t OFF_QRAW = OFF_MIXF;
constexpr size_t OFF_KMLA = OFF_QRAW + (size_t)S_ * 768 * 4;
constexpr size_t OFF_VT = OFF_KMLA + (size_t)4 * S_ * 192 * 2;
constexpr size_t OFF_BIG = OFF_MIXF + (size_t)S_ * 2048 * 4;
constexpr size_t OFF_PROJ = OFF_BIG;
constexpr size_t OFF_WP = OFF_PROJ + (size_t)S_ * DINP * 2;
constexpr size_t OFF_QD = OFF_WP + (size_t)S_ * 1024 * 2;
constexpr size_t OFF_KT = OFF_QD + (size_t)S_ * 1024 * 2;
constexpr size_t OFF_ZT = OFF_KT + (size_t)S_ * 1024 * 2;
constexpr size_t OFF_QK = OFF_ZT + (size_t)S_ * 1024 * 2;
constexpr size_t OFF_AB = OFF_QK + (size_t)S_ * 512 * 2;
constexpr size_t OFF_GTOT = OFF_AB + (size_t)S_ * 16 * 4;
constexpr size_t OFF_Y = OFF_BIG;
constexpr size_t OFF_ACT = OFF_H;
constexpr size_t OFF_UT = OFF_BIG + (size_t)S_ * DFF2 * 2;
constexpr size_t OFF_END = OFF_UT + (size_t)S_ * 1024 * 4;
static_assert(OFF_GTOT + 8192 <= OFF_UT, "overlay");
static_assert(OFF_VT + (size_t)4 * 128 * S_ * 2 <= OFF_BIG, "overlay2");

constexpr int C_AQ = 0, C_AK = 1024, C_AV = 2048, C_AZ = 3072, C_AA = 4096, C_BCQ = 4112, C_BCKV = 4560,
              C_BKR = 4688, C_CQ = 4752, C_CK = 5264, C_CV = 5392;

__constant__ double kInvFreq2Pi[32] = {
    0.15915494309189535, 0.11934937021124886, 0.08949940160889101, 0.06711508300522726, 0.050329212104487035, 0.03774158471741977,
    0.0283021958306234, 0.02122365276477766, 0.015915494309189534, 0.011934937021124886, 0.008949940160889102, 0.006711508300522725,
    0.005032921210448704, 0.003774158471741977, 0.00283021958306234, 0.0021223652764777662, 0.0015915494309189536, 0.0011934937021124885,
    0.0008949940160889102, 0.0006711508300522726, 0.0005032921210448703, 0.00037741584717419774, 0.00028302195830623395, 0.0002122365276477766,
    0.00015915494309189535, 0.00011934937021124886, 8.949940160889102e-05, 6.711508300522725e-05, 5.0329212104487035e-05, 3.774158471741978e-05,
    2.8302195830623396e-05, 2.122365276477766e-05};

struct Params {
  const float* x; const float* c; const int* pos;
  const float *ada_w, *ada_b, *mix_pre, *mix_post, *w_in, *w_out, *gdn_conv, *gdn_a_log, *gdn_dt_bias, *gdn_norm, *mla_q_norm, *mla_w_uq,
      *mla_kv_norm, *mla_w_ukv, *swa_sinks, *ffn_pre, *ffn_post, *ffn_w_up, *ffn_conv, *ffn_conv_b, *ffn_w_down;
  float* out; char* ws;
};

DI unsigned pack2(float lo, float hi) { f32x2 v = {lo, hi}; bf2_t b = __builtin_convertvector(v, bf2_t); return __builtin_bit_cast(unsigned, b); }
DI bf16_t f2bf(float x) { return (bf16_t)(pack2(x, 0.f) & 0xffffu); }
DI float bflo(unsigned u) { return __uint_as_float(u << 16); }
DI float bfhi(unsigned u) { return __uint_as_float(u & 0xffff0000u); }
DI void unpack8(const u32x4& v, float* f) { f[0] = bflo(v.x); f[1] = bfhi(v.x); f[2] = bflo(v.y); f[3] = bfhi(v.y); f[4] = bflo(v.z); f[5] = bfhi(v.z); f[6] = bflo(v.w); f[7] = bfhi(v.w); }
DI bf16x8 pack8(float a0, float a1, float a2, float a3, float a4, float a5, float a6, float a7) {
  u32x4 p = {pack2(a0, a1), pack2(a2, a3), pack2(a4, a5), pack2(a6, a7)}; return __builtin_bit_cast(bf16x8, p); }
DI float silu_f(float x) { return x / (1.f + __expf(-x)); }
DI float wave_sum(float v) { v += __shfl_xor(v, 32); v += __shfl_xor(v, 16); v += __shfl_xor(v, 8); v += __shfl_xor(v, 4); v += __shfl_xor(v, 2); v += __shfl_xor(v, 1); return v; }
DI int opaque_tid() { int t = threadIdx.x; asm volatile("" : "+v"(t)); return t; }
DI int crow(int r, int h) { return (r & 3) + 8 * (r >> 2) + 4 * h; }
DI int perm32(int k) { return 8 * ((k >> 2) & 3) + 4 * (k >> 4) + (k & 3); }
#define MFMA32(a, b, c) __builtin_amdgcn_mfma_f32_32x32x16_bf16((a), (b), (c), 0, 0, 0)
#define MFMA16(a, b, c) __builtin_amdgcn_mfma_f32_16x16x32_bf16((a), (b), (c), 0, 0, 0)

template <class Epi>
DI void gemm_tile(const bf16_t* __restrict__ A, int lda, const bf16_t* __restrict__ Bt, int ldb, int K, int m0, int n0, char* smem, const Epi& epi) {
  const int tid = opaque_tid(), lane = tid & 63, w = tid >> 6, wm = w >> 2, wn = w & 3, lq = lane & 31, h = lane >> 5;
  f32x16 acc[2][4];
#pragma unroll
  for (int i = 0; i < 2; ++i)
#pragma unroll
    for (int j = 0; j < 4; ++j)
#pragma unroll
      for (int r = 0; r < 16; ++r) acc[i][j][r] = 0.f;
  const int r0 = tid >> 3, c0 = tid & 7;
  const bf16_t* ag = A + (size_t)(m0 + r0) * lda + c0 * 8;
  const bf16_t* bg = Bt + (size_t)(n0 + r0) * ldb + c0 * 8;
  const int wofs = r0 * 128 + ((c0 ^ ((r0 >> 1) & 7)) << 4);
  char* sA = smem; char* sB = smem + 32768;
  u32x4 ra[4], rb[4];
#pragma unroll
  for (int i = 0; i < 4; ++i) { ra[i] = *(const u32x4*)(ag + (size_t)i * 64 * lda); rb[i] = *(const u32x4*)(bg + (size_t)i * 64 * ldb); }
#pragma unroll
  for (int i = 0; i < 4; ++i) { *(u32x4*)(sA + wofs + i * 8192) = ra[i]; *(u32x4*)(sB + wofs + i * 8192) = rb[i]; }
  __syncthreads();
  const int nk = K >> 6, swz = (lane >> 1) & 7;
  const int aoff = (64 * wn + lq) * 128, boff = (128 * wm + lq) * 128;
  for (int kt = 0; kt < nk; ++kt) {
    const char* cA = sA + (kt & 1) * 65536; const char* cB = sB + (kt & 1) * 65536;
    const bool more = (kt + 1 < nk);
    if (more) { ag += 64; bg += 64;
#pragma unroll
      for (int i = 0; i < 4; ++i) { ra[i] = *(const u32x4*)(ag + (size_t)i * 64 * lda); rb[i] = *(const u32x4*)(bg + (size_t)i * 64 * ldb); } }
#pragma unroll
    for (int s = 0; s < 4; ++s) {
      const int co = (((2 * s + h) ^ swz) << 4);
      bf16x8 fa[2], fb[4];
#pragma unroll
      for (int ni = 0; ni < 2; ++ni) fa[ni] = *(const bf16x8*)(cB + aoff + ni * 4096 + co);
#pragma unroll
      for (int mi = 0; mi < 4; ++mi) fb[mi] = *(const bf16x8*)(cA + boff + mi * 4096 + co);
#pragma unroll
      for (int ni = 0; ni < 2; ++ni)
#pragma unroll
        for (int mi = 0; mi < 4; ++mi) acc[ni][mi] = MFMA32(fa[ni], fb[mi], acc[ni][mi]);
    }
    if (more) { char* dA = sA + ((kt + 1) & 1) * 65536; char* dB = sB + ((kt + 1) & 1) * 65536;
#pragma unroll
      for (int i = 0; i < 4; ++i) { *(u32x4*)(dA + wofs + i * 8192) = ra[i]; *(u32x4*)(dB + wofs + i * 8192) = rb[i]; } }
    __syncthreads();
  }
#pragma unroll
  for (int ni = 0; ni < 2; ++ni)
#pragma unroll
    for (int mi = 0; mi < 4; ++mi)
#pragma unroll
      for (int rg = 0; rg < 4; ++rg) {
        const int m = m0 + 128 * wm + 32 * mi + lq, n = n0 + 64 * wn + 32 * ni + 8 * rg + 4 * h;
        epi(m, n, acc[ni][mi][4 * rg], acc[ni][mi][4 * rg + 1], acc[ni][mi][4 * rg + 2], acc[ni][mi][4 * rg + 3]);
      }
}

DI void tile_coord(int t, int npn, int& pm, int& pn) { const int g = t / (16 * npn), r = t % (16 * npn); pn = r >> 4; pm = g * 16 + (r & 15); }

struct EpiProj { bf16_t* proj; float* ab;
  DI void operator()(int m, int n, float v0, float v1, float v2, float v3) const {
    u32x2 pk = {pack2(v0, v1), pack2(v2, v3)}; *(u32x2*)(proj + (size_t)m * DINP + n) = pk;
    if (n >= C_AA && n < C_AA + 16) { f32x4 v = {v0, v1, v2, v3}; *(f32x4*)(ab + (size_t)m * 16 + (n - C_AA)) = v; } } };
struct EpiF32 { float* out; int ldc;
  DI void operator()(int m, int n, float v0, float v1, float v2, float v3) const { f32x4 v = {v0, v1, v2, v3}; *(f32x4*)(out + (size_t)m * ldc + n) = v; } };
struct EpiBf { bf16_t* out; int ldc;
  DI void operator()(int m, int n, float v0, float v1, float v2, float v3) const { u32x2 pk = {pack2(v0, v1), pack2(v2, v3)}; *(u32x2*)(out + (size_t)m * ldc + n) = pk; } };
struct EpiMlaQ { float* qraw; const float* rs; int m0;
  DI void operator()(int m, int n, float v0, float v1, float v2, float v3) const { const float r = rs[m - m0]; f32x4 v = {v0 * r, v1 * r, v2 * r, v3 * r}; *(f32x4*)(qraw + (size_t)m * 768 + n) = v; } };
struct EpiMlaKV { bf16_t* kmla; bf16_t* vt; const float* rs; int m0;
  DI void operator()(int m, int n, float v0, float v1, float v2, float v3) const {
    const float r = rs[m - m0]; const int hd = n >> 8, wi = n & 255;
    if (wi < 128) { u32x2 pk = {pack2(v0 * r, v1 * r), pack2(v2 * r, v3 * r)}; *(u32x2*)(kmla + ((size_t)hd * S_ + m) * 192 + wi) = pk; }
    else { bf16_t* p = vt + ((size_t)hd * 128 + (wi - 128)) * S_ + m; p[0] = f2bf(v0 * r); p[S_] = f2bf(v1 * r); p[2 * (size_t)S_] = f2bf(v2 * r); p[3 * (size_t)S_] = f2bf(v3 * r); } } };

template <class Epi>
DI void gemm_phase(const bf16_t* A, int lda, const bf16_t* Bt, int ldb, int K, int npm, int npn, char* smem, const Epi& epi) {
  for (int t = blockIdx.x; t < npm * npn; t += gridDim.x) { int pm, pn; tile_coord(t, npn, pm, pn); gemm_tile(A, lda, Bt, ldb, K, pm * 256, pn * 256, smem, epi); }
}

DI void mod_item(const Params& P, int item) {
  const int tid = opaque_tid(); const int l = item / 96, r = item % 96, ks = r / 6, nc = r % 6;
  const int n = nc * 2048 + tid * 4;
  const float* wp = P.ada_w + ((size_t)l * 2048 + ks * 128) * 12288 + n;
  f32x4 acc = {0.f, 0.f, 0.f, 0.f};
#pragma unroll 8
  for (int k = 0; k < 128; ++k) { const float cv = P.c[ks * 128 + k]; const float ca = silu_f(cv); const f32x4 wv = *(const f32x4*)(wp + (size_t)k * 12288); acc += wv * ca; }
  float* modp = (float*)(P.ws + OFF_MODP);
  *(f32x4*)(modp + ((size_t)l * 16 + ks) * 12288 + n) = acc;
}
DI void convert_tile(const float* __restrict__ src, int K, int N, bf16_t* __restrict__ dst, int tk, int tn, const float* rowscale, char* smem) {
  float* sm = (float*)smem; const int tid = opaque_tid(); const int k0 = tk * 64, n0 = tn * 256;
  { const int r = tid >> 6, c4 = tid & 63; const int n = n0 + 4 * c4;
    f32x4 v[8];
#pragma unroll
    for (int i = 0; i < 8; ++i) { v[i] = (f32x4){0.f, 0.f, 0.f, 0.f}; if (n < N) v[i] = *(const f32x4*)(src + (size_t)(k0 + r + 8 * i) * N + n); }
#pragma unroll
    for (int i = 0; i < 8; ++i) { const int kk = r + 8 * i; if (rowscale) v[i] *= rowscale[k0 + kk];
      sm[kk * 257 + 4 * c4 + 0] = v[i].x; sm[kk * 257 + 4 * c4 + 1] = v[i].y; sm[kk * 257 + 4 * c4 + 2] = v[i].z; sm[kk * 257 + 4 * c4 + 3] = v[i].w; } }
  __syncthreads();
  { const int n = tid >> 1, kh = tid & 1;
#pragma unroll
    for (int j = 0; j < 4; ++j) { float f[8];
#pragma unroll
      for (int i = 0; i < 8; ++i) f[i] = sm[(32 * kh + 8 * j + i) * 257 + n];
      u32x4 pk = {pack2(f[0], f[1]), pack2(f[2], f[3]), pack2(f[4], f[5]), pack2(f[6], f[7])};
      *(u32x4*)(dst + (size_t)(n0 + n) * K + k0 + 32 * kh + 8 * j) = pk; } }
  __syncthreads();
}
constexpr int CV_T0 = 32 * 22, CV_T1 = CV_T0 + 32 * 8, CV_T2 = CV_T1 + 32 * 44, CV_T3 = CV_T2 + 88 * 8, CV_T4 = CV_T3 + 7 * 3, CV_T5 = CV_T4 + 2 * 4;
DI void convert_item(const Params& P, int l, int it, char* smem) {
  char* wb = P.ws + OFF_W;
  if (it < CV_T0) convert_tile(P.w_in + (size_t)l * 2048 * 5520, 2048, 5520, (bf16_t*)(wb + W_IN), it / 22, it % 22, nullptr, smem);
  else if (it < CV_T1) { it -= CV_T0; convert_tile(P.w_out + (size_t)l * 2048 * 2048, 2048, 2048, (bf16_t*)(wb + W_OUT), it / 8, it % 8, nullptr, smem); }
  else if (it < CV_T2) { it -= CV_T1; convert_tile(P.ffn_w_up + (size_t)l * 2048 * 11264, 2048, 11264, (bf16_t*)(wb + W_UP), it / 44, it % 44, nullptr, smem); }
  else if (it < CV_T3) { it -= CV_T2; convert_tile(P.ffn_w_down + (size_t)l * 5632 * 2048, 5632, 2048, (bf16_t*)(wb + W_DOWN), it / 8, it % 8, nullptr, smem); }
  else if (it < CV_T4) { it -= CV_T3; convert_tile(P.mla_w_uq + (size_t)l * 448 * 768, 448, 768, (bf16_t*)(wb + W_UQ), it / 3, it % 3, P.mla_q_norm + l * 448, smem); }
  else { it -= CV_T4; convert_tile(P.mla_w_ukv + (size_t)l * 128 * 1024, 128, 1024, (bf16_t*)(wb + W_UKV), it / 4, it % 4, P.mla_kv_norm + l * 128, smem); }
}

DI float mod_val(const float* modp_l, const float* ada_b_l, int idx) { float s = ada_b_l[idx];
#pragma unroll
  for (int k = 0; k < 16; ++k) s += modp_l[(size_t)k * 12288 + idx]; return s; }
DI void rownorm_phase(const Params& P, const float* xin, const float* yin, float* xout, bf16_t* hout, int lg, int gate_idx, const float* w_post,
                      int lh, int scale_idx, int shift_idx, const float* w_pre, char* smem) {
  float* A1 = (float*)smem; float* A2 = A1 + 2048; float* B2 = A2 + 2048;
  const int tid = opaque_tid(), lane = tid & 63, w = tid >> 6;
  const float* modp = (const float*)(P.ws + OFF_MODP);
  for (int cidx = tid; cidx < 2048; cidx += NT) {
    if (yin) A1[cidx] = mod_val(modp + (size_t)lg * 16 * 12288, P.ada_b + (size_t)lg * 12288, gate_idx * 2048 + cidx) * w_post[cidx];
    if (hout) { A2[cidx] = w_pre[cidx] * (1.f + mod_val(modp + (size_t)lh * 16 * 12288, P.ada_b + (size_t)lh * 12288, scale_idx * 2048 + cidx));
      B2[cidx] = mod_val(modp + (size_t)lh * 16 * 12288, P.ada_b + (size_t)lh * 12288, shift_idx * 2048 + cidx); }
  }
  __syncthreads();
  for (int row = blockIdx.x * 8 + w; row < S_; row += gridDim.x * 8) {
    f32x4 xv[8];
#pragma unroll
    for (int j = 0; j < 8; ++j) xv[j] = *(const f32x4*)(xin + (size_t)row * 2048 + (j * 64 + lane) * 4);
    if (yin) {
      f32x4 yv[8]; float ss = 0.f;
#pragma unroll
      for (int j = 0; j < 8; ++j) { yv[j] = *(const f32x4*)(yin + (size_t)row * 2048 + (j * 64 + lane) * 4); ss += yv[j].x * yv[j].x + yv[j].y * yv[j].y + yv[j].z * yv[j].z + yv[j].w * yv[j].w; }
      ss = wave_sum(ss); const float r = rsqrtf(ss * (1.f / 2048.f) + EPS);
#pragma unroll
      for (int j = 0; j < 8; ++j) { const f32x4 a = *(const f32x4*)(A1 + (j * 64 + lane) * 4); xv[j] += a * (yv[j] * r); }
    }
    if (yin || xout != xin) {
#pragma unroll
      for (int j = 0; j < 8; ++j) *(f32x4*)(xout + (size_t)row * 2048 + (j * 64 + lane) * 4) = xv[j];
    }
    if (hout) {
      float ss = 0.f;
#pragma unroll
      for (int j = 0; j < 8; ++j) ss += xv[j].x * xv[j].x + xv[j].y * xv[j].y + xv[j].z * xv[j].z + xv[j].w * xv[j].w;
      ss = wave_sum(ss); const float r = rsqrtf(ss * (1.f / 2048.f) + EPS);
#pragma unroll
      for (int j = 0; j < 8; ++j) { const f32x4 a = *(const f32x4*)(A2 + (j * 64 + lane) * 4), b = *(const f32x4*)(B2 + (j * 64 + lane) * 4);
        const f32x4 hv = xv[j] * r * a + b; u32x2 pk = {pack2(hv.x, hv.y), pack2(hv.z, hv.w)};
        *(u32x2*)(hout + (size_t)row * 2048 + (j * 64 + lane) * 4) = pk; }
    }
  }
  __syncthreads();
}

DI void mla_q_tile(const Params& P, int pm, int pn, char* smem) {
  const bf16_t* proj = (const bf16_t*)(P.ws + OFF_PROJ); const int tid = opaque_tid(), m0 = pm * 256; float* rs = (float*)(smem + 131072);
  { const int row = tid >> 1, half = tid & 1; const bf16_t* p = proj + (size_t)(m0 + row) * DINP + C_BCQ + half * 224; float ss = 0.f;
    for (int i = 0; i < 28; ++i) { const u32x4 v = *(const u32x4*)(p + i * 8); float f[8]; unpack8(v, f);
#pragma unroll
      for (int e = 0; e < 8; ++e) ss += f[e] * f[e]; }
    ss += __shfl_xor(ss, 1); if (half == 0) rs[row] = rsqrtf(ss * (1.f / 448.f) + EPS); }
  EpiMlaQ epi{(float*)(P.ws + OFF_QRAW), rs, m0};
  gemm_tile(proj + C_BCQ, DINP, (const bf16_t*)(P.ws + OFF_W + W_UQ), 448, 448, m0, pn * 256, smem, epi);
  __syncthreads();
}
DI void mla_kv_tile(const Params& P, int pm, int pn, char* smem) {
  const bf16_t* proj = (const bf16_t*)(P.ws + OFF_PROJ); const int tid = opaque_tid(), m0 = pm * 256; float* rs = (float*)(smem + 131072);
  { const int row = tid >> 1, half = tid & 1; const bf16_t* p = proj + (size_t)(m0 + row) * DINP + C_BCKV + half * 64; float ss = 0.f;
#pragma unroll
    for (int i = 0; i < 8; ++i) { const u32x4 v = *(const u32x4*)(p + i * 8); float f[8]; unpack8(v, f);
#pragma unroll
      for (int e = 0; e < 8; ++e) ss += f[e] * f[e]; }
    ss += __shfl_xor(ss, 1); if (half == 0) rs[row] = rsqrtf(ss * (1.f / 128.f) + EPS); }
  bf16_t* kmla = (bf16_t*)(P.ws + OFF_KMLA);
  EpiMlaKV epi{kmla, (bf16_t*)(P.ws + OFF_VT), rs, m0};
  gemm_tile(proj + C_BCKV, DINP, (const bf16_t*)(P.ws + OFF_W + W_UKV), 128, 128, m0, pn * 256, smem, epi);
  if (pn == 0) {
    for (int i = 0; i < 16; ++i) { const int idx = tid + NT * i, row = idx >> 5, pi = idx & 31, m = m0 + row;
      const float x1 = bflo((unsigned)proj[(size_t)m * DINP + C_BKR + pi]), x2 = bflo((unsigned)proj[(size_t)m * DINP + C_BKR + 32 + pi]);
      double fr = (double)P.pos[m] * kInvFreq2Pi[pi]; fr -= floor(fr); const float ff = (float)fr;
      const float sn = __builtin_amdgcn_sinf(ff), cs = __builtin_amdgcn_cosf(ff);
      const bf16_t o1 = f2bf(x1 * cs - x2 * sn), o2 = f2bf(x2 * cs + x1 * sn);
#pragma unroll
      for (int hd = 0; hd < 4; ++hd) { bf16_t* kp = kmla + ((size_t)hd * S_ + m) * 192 + 128; kp[pi] = o1; kp[32 + pi] = o2; } }
  }
  __syncthreads();
}

DI void gdn_prep_item(const Params& P, int l, int n, int hh, char* smem) {
  const int tid = opaque_tid(), lane = tid & 63, w = tid >> 6, lq = lane & 31, h = lane >> 5;
  const bf16_t* proj = (const bf16_t*)(P.ws + OFF_PROJ); const float* ab = (const float*)(P.ws + OFF_AB);
  char* kb16 = smem; char* qb16 = smem + 17408;
  float* kf = (float*)(smem + 34816); float* vf = kf + 8192; float* Lm = vf + 8192; float* gcs = Lm + 4096;
  const size_t tile = (size_t)hh * 256 + n; const int t0 = n * 64;
  bf16_t* Wp = (bf16_t*)(P.ws + OFF_WP) + tile * 8192; bf16_t* Qd = (bf16_t*)(P.ws + OFF_QD) + tile * 8192;
  bf16_t* Kt = (bf16_t*)(P.ws + OFF_KT) + tile * 8192; bf16_t* Zt = (bf16_t*)(P.ws + OFF_ZT) + tile * 8192;
  bf16_t* QK = (bf16_t*)(P.ws + OFF_QK) + tile * 4096; float* Ut = (float*)(P.ws + OFF_UT) + tile * 8192;
  if (w == 0) {
    const int t = lane; const float a_raw = ab[(size_t)(t0 + t) * 16 + hh], b_raw = ab[(size_t)(t0 + t) * 16 + 8 + hh];
    const float Aa = expf(P.gdn_a_log[l * 8 + hh]); const float xb = a_raw + P.gdn_dt_bias[l * 8 + hh];
    const float sp = xb > 20.f ? xb : log1pf(expf(xb));
    float g = -Aa * sp;
#pragma unroll
    for (int d = 1; d < 64; d <<= 1) { const float v = __shfl_up(g, d); if (lane >= d) g += v; }
    const float bt = 1.f / (1.f + expf(-b_raw)), eg = expf(g); gcs[t] = g; gcs[64 + t] = bt; gcs[128 + t] = eg; gcs[192 + t] = bt * eg;
    if (t == 63) ((float*)(P.ws + OFF_GTOT))[tile] = expf(g);
  }
  __syncthreads();
  {
    const int t = tid >> 3, part = tid & 7, tabs = t0 + t;
    const float gct = gcs[t], egct = gcs[128 + t], ktl = expf(gcs[63] - gct);
    const int pjt = 32 * (t >> 5) + perm32(t & 31);
#pragma unroll
    for (int X = 0; X < 3; ++X) {
      const int cb = X * 1024 + hh * 128 + part * 16;
      float y[16];
#pragma unroll
      for (int e = 0; e < 16; ++e) y[e] = 0.f;
#pragma unroll
      for (int j = 0; j < 4; ++j) { const int row = tabs - 3 + j;
        if (row >= 0) { const u32x4 v0 = *(const u32x4*)(proj + (size_t)row * DINP + cb), v1 = *(const u32x4*)(proj + (size_t)row * DINP + cb + 8);
          float xv[16]; unpack8(v0, xv); unpack8(v1, xv + 8); const float* cw = P.gdn_conv + ((size_t)l * 4 + j) * 3072 + cb;
#pragma unroll
          for (int e4 = 0; e4 < 4; ++e4) { const f32x4 wv = *(const f32x4*)(cw + 4 * e4); y[4 * e4] += wv.x * xv[4 * e4]; y[4 * e4 + 1] += wv.y * xv[4 * e4 + 1]; y[4 * e4 + 2] += wv.z * xv[4 * e4 + 2]; y[4 * e4 + 3] += wv.w * xv[4 * e4 + 3]; } } }
#pragma unroll
      for (int e = 0; e < 16; ++e) y[e] = silu_f(y[e]);
      if (X < 2) { float ss = 0.f;
#pragma unroll
        for (int e = 0; e < 16; ++e) ss += y[e] * y[e];
        ss += __shfl_xor(ss, 1); ss += __shfl_xor(ss, 2); ss += __shfl_xor(ss, 4);
        const float rn = rsqrtf(ss + EPS) * (X == 0 ? 0.08838834764831845f : 1.f);
#pragma unroll
        for (int e = 0; e < 16; ++e) y[e] *= rn; }
      if (X == 0) {
        u32x4 p0 = {pack2(y[0], y[1]), pack2(y[2], y[3]), pack2(y[4], y[5]), pack2(y[6], y[7])}, p1 = {pack2(y[8], y[9]), pack2(y[10], y[11]), pack2(y[12], y[13]), pack2(y[14], y[15])};
        *(u32x4*)(qb16 + t * 272 + part * 32) = p0; *(u32x4*)(qb16 + t * 272 + part * 32 + 16) = p1;
#pragma unroll
        for (int b = 0; b < 4; ++b) { u32x2 pk = {pack2(y[4 * b] * egct, y[4 * b + 1] * egct), pack2(y[4 * b + 2] * egct, y[4 * b + 3] * egct)};
          *(u32x2*)(Qd + t * 128 + 32 * (part >> 1) + 8 * b + 4 * (part & 1)) = pk; }
      } else if (X == 1) {
        u32x4 p0 = {pack2(y[0], y[1]), pack2(y[2], y[3]), pack2(y[4], y[5]), pack2(y[6], y[7])}, p1 = {pack2(y[8], y[9]), pack2(y[10], y[11]), pack2(y[12], y[13]), pack2(y[14], y[15])};
        *(u32x4*)(kb16 + t * 272 + part * 32) = p0; *(u32x4*)(kb16 + t * 272 + part * 32 + 16) = p1;
#pragma unroll
        for (int e4 = 0; e4 < 4; ++e4) { f32x4 v = {y[4 * e4], y[4 * e4 + 1], y[4 * e4 + 2], y[4 * e4 + 3]}; *(f32x4*)(kf + t * 128 + part * 16 + 4 * e4) = v; }
#pragma unroll
        for (int e = 0; e < 16; ++e) Kt[(part * 16 + e) * 64 + pjt] = f2bf(y[e] * ktl);
      } else {
#pragma unroll
        for (int e4 = 0; e4 < 4; ++e4) { f32x4 v = {y[4 * e4], y[4 * e4 + 1], y[4 * e4 + 2], y[4 * e4 + 3]}; *(f32x4*)(vf + t * 128 + part * 16 + 4 * e4) = v; }
      }
    }
    { const int cb = C_AZ + hh * 128 + part * 16; const u32x4 v0 = *(const u32x4*)(proj + (size_t)tabs * DINP + cb), v1 = *(const u32x4*)(proj + (size_t)tabs * DINP + cb + 8);
      float zv[16]; unpack8(v0, zv); unpack8(v1, zv + 8);
#pragma unroll
      for (int e = 0; e < 16; ++e) Zt[(part * 16 + e) * 64 + t] = f2bf(silu_f(zv[e])); }
  }
  __syncthreads();
  {
    const int which = w >> 2, ti = (w >> 1) & 1, tj = w & 1; const char* Ab = which ? qb16 : kb16;
    f32x16 acc;
#pragma unroll
    for (int r = 0; r < 16; ++r) acc[r] = 0.f;
#pragma unroll
    for (int s = 0; s < 8; ++s) { const bf16x8 a = *(const bf16x8*)(Ab + (32 * ti + lq) * 272 + (16 * s + 8 * h) * 2), b = *(const bf16x8*)(kb16 + (32 * tj + lq) * 272 + (16 * s + 8 * h) * 2);
      acc = MFMA32(a, b, acc); }
    const int j = 32 * tj + lq; const float gj = gcs[j]; const int pj = 32 * (j >> 5) + perm32(j & 31);
#pragma unroll
    for (int r = 0; r < 16; ++r) { const int i = 32 * ti + crow(r, h); const float dec = __expf(fminf(gcs[i] - gj, 0.f));
      if (which == 0) Lm[i * 64 + j] = (j < i) ? gcs[64 + i] * acc[r] * dec : 0.f;
      else QK[i * 64 + pj] = f2bf((j <= i) ? acc[r] * dec : 0.f); }
  }
  __syncthreads();
  if (tid < 256) {
    const int c = tid; const bool isu = c < 128; const int cc = c & 127;
    const float* rp = (isu ? vf : kf) + cc; const float* sp = gcs + (isu ? 64 : 192);
    float x[64];
#pragma unroll
    for (int i = 0; i < 64; ++i) {
      float r = sp[i] * rp[i * 128];
#pragma unroll
      for (int j = 0; j < i; ++j) r = fmaf(-Lm[i * 64 + j], x[j], r);
      x[i] = r;
    }
    if (isu) {
#pragma unroll
      for (int i4 = 0; i4 < 16; ++i4) { f32x4 v = {x[4 * i4], x[4 * i4 + 1], x[4 * i4 + 2], x[4 * i4 + 3]}; *(f32x4*)(Ut + cc * 64 + 4 * i4) = v; }
    } else {
      const int pp = 32 * (cc >> 5) + perm32(cc & 31);
#pragma unroll
      for (int i = 0; i < 64; ++i) Wp[i * 128 + pp] = f2bf(x[i]);
    }
  }
  __syncthreads();
}

DI bf16x8 pack_tiles(const f32x4& a, const f32x4& b) { return pack8(a.x, a.y, a.z, a.w, b.x, b.y, b.z, b.w); }
DI void gdn_scan_item(const Params& P, int l, int hh, char* smem) {
  const int tid = opaque_tid(), lane = tid & 63, w = tid >> 6, l15 = lane & 15, q4 = lane >> 4;
  char* sWp = smem; char* sQd = smem + 17408; char* sKt = smem + 34816; char* sQK = smem + 53248;
  float* sPart = (float*)(smem + 62464); float* sRstd = sPart + 512 + w * 64;
  const size_t hb = (size_t)hh * 256;
  const bf16_t* Wp = (const bf16_t*)(P.ws + OFF_WP) + hb * 8192; const bf16_t* Qd = (const bf16_t*)(P.ws + OFF_QD) + hb * 8192;
  const bf16_t* Kt = (const bf16_t*)(P.ws + OFF_KT) + hb * 8192; const bf16_t* Zt = (const bf16_t*)(P.ws + OFF_ZT) + hb * 8192;
  const bf16_t* QK = (const bf16_t*)(P.ws + OFF_QK) + hb * 4096; const float* Ut = (const float*)(P.ws + OFF_UT) + hb * 8192;
  const float* gt = (const float*)(P.ws + OFF_GTOT) + hb;
  bf16_t* mixin = (bf16_t*)(P.ws + OFF_H);
  const int dvc = 16 * w + l15; const float nw = P.gdn_norm[l * 128 + dvc];
  const int g256 = (tid >> 4) * 128 + (tid & 15) * 8, l256 = (tid >> 4) * 272 + (tid & 15) * 16;
  const int g128 = (tid >> 3) * 64 + (tid & 7) * 8, l128 = (tid >> 3) * 144 + (tid & 7) * 16;
  f32x4 St[8];
#pragma unroll
  for (int t = 0; t < 8; ++t) St[t] = (f32x4){0.f, 0.f, 0.f, 0.f};
  u32x4 pw[2], pq[2], pk[2], pqk; f32x4 uc[4], un[4]; u32x2 zc[4], zn[4]; float gcur, gn = 0.f;
#pragma unroll
  for (int i = 0; i < 2; ++i) { pw[i] = *(const u32x4*)(Wp + g256 + i * 4096); pq[i] = *(const u32x4*)(Qd + g256 + i * 4096); pk[i] = *(const u32x4*)(Kt + g128 + i * 4096); }
  pqk = *(const u32x4*)(QK + g128);
#pragma unroll
  for (int it = 0; it < 4; ++it) { uc[it] = *(const f32x4*)(Ut + dvc * 64 + 16 * it + 4 * q4); zc[it] = *(const u32x2*)(Zt + dvc * 64 + 16 * it + 4 * q4); un[it] = uc[it]; zn[it] = zc[it]; }
  gcur = gt[0];
#pragma unroll
  for (int i = 0; i < 2; ++i) { *(u32x4*)(sWp + l256 + i * 8704) = pw[i]; *(u32x4*)(sQd + l256 + i * 8704) = pq[i]; *(u32x4*)(sKt + l128 + i * 9216) = pk[i]; }
  *(u32x4*)(sQK + l128) = pqk;
  __syncthreads();
  for (int n = 0; n < 256; ++n) {
    const bool more = (n + 1 < 256);
    if (more) { const size_t o8 = (size_t)(n + 1) * 8192, o4 = (size_t)(n + 1) * 4096;
#pragma unroll
      for (int i = 0; i < 2; ++i) { pw[i] = *(const u32x4*)(Wp + o8 + g256 + i * 4096); pq[i] = *(const u32x4*)(Qd + o8 + g256 + i * 4096); pk[i] = *(const u32x4*)(Kt + o8 + g128 + i * 4096); }
      pqk = *(const u32x4*)(QK + o4 + g128);
#pragma unroll
      for (int it = 0; it < 4; ++it) { un[it] = *(const f32x4*)(Ut + o8 + dvc * 64 + 16 * it + 4 * q4); zn[it] = *(const u32x2*)(Zt + o8 + dvc * 64 + 16 * it + 4 * q4); }
      gn = gt[n + 1]; }
    bf16x8 sb[4];
#pragma unroll
    for (int ks = 0; ks < 4; ++ks) sb[ks] = pack_tiles(St[2 * ks], St[2 * ks + 1]);
    f32x4 wsv[4], qs[4];
#pragma unroll
    for (int it = 0; it < 4; ++it) { wsv[it] = (f32x4){0.f, 0.f, 0.f, 0.f}; qs[it] = (f32x4){0.f, 0.f, 0.f, 0.f}; }
#pragma unroll
    for (int it = 0; it < 4; ++it)
#pragma unroll
      for (int ks = 0; ks < 4; ++ks) { const int o = (16 * it + l15) * 272 + 64 * ks + 16 * q4;
        const bf16x8 a = *(const bf16x8*)(sWp + o), a2 = *(const bf16x8*)(sQd + o);
        wsv[it] = MFMA16(a, sb[ks], wsv[it]); qs[it] = MFMA16(a2, sb[ks], qs[it]); }
    f32x4 vn[4];
#pragma unroll
    for (int it = 0; it < 4; ++it) vn[it] = uc[it] - wsv[it];
    bf16x8 vb[2];
#pragma unroll
    for (int ks = 0; ks < 2; ++ks) vb[ks] = pack_tiles(vn[2 * ks], vn[2 * ks + 1]);
#pragma unroll
    for (int it = 0; it < 4; ++it)
#pragma unroll
      for (int ks = 0; ks < 2; ++ks) { const bf16x8 a = *(const bf16x8*)(sQK + (16 * it + l15) * 144 + 64 * ks + 16 * q4); qs[it] = MFMA16(a, vb[ks], qs[it]); }
#pragma unroll
    for (int t = 0; t < 8; ++t) { St[t] *= gcur;
#pragma unroll
      for (int ks = 0; ks < 2; ++ks) { const bf16x8 a = *(const bf16x8*)(sKt + (16 * t + l15) * 144 + 64 * ks + 16 * q4); St[t] = MFMA16(a, vb[ks], St[t]); } }
#pragma unroll
    for (int it = 0; it < 4; ++it) {
      f32x4 ss = qs[it] * qs[it];
#pragma unroll
      for (int d = 1; d < 16; d <<= 1) { ss.x += __shfl_xor(ss.x, d); ss.y += __shfl_xor(ss.y, d); ss.z += __shfl_xor(ss.z, d); ss.w += __shfl_xor(ss.w, d); }
      if (l15 == 0) *(f32x4*)(sPart + w * 64 + 16 * it + 4 * q4) = ss;
    }
    __syncthreads();
    { float tot = 0.f;
#pragma unroll
      for (int ww = 0; ww < 8; ++ww) tot += sPart[ww * 64 + lane];
      sRstd[lane] = rsqrtf(tot * (1.f / 128.f) + EPS); }
#pragma unroll
    for (int it = 0; it < 4; ++it) {
      const f32x4 rs = *(const f32x4*)(sRstd + 16 * it + 4 * q4);
      const float z0 = bflo(zc[it].x), z1 = bfhi(zc[it].x), z2 = bflo(zc[it].y), z3 = bfhi(zc[it].y);
      bf16_t* op = mixin + (size_t)(64 * n + 16 * it + 4 * q4) * 2048 + hh * 128 + dvc;
      op[0] = f2bf(qs[it].x * rs.x * nw * z0); op[2048] = f2bf(qs[it].y * rs.y * nw * z1);
      op[4096] = f2bf(qs[it].z * rs.z * nw * z2); op[6144] = f2bf(qs[it].w * rs.w * nw * z3);
    }
    if (more) {
#pragma unroll
      for (int i = 0; i < 2; ++i) { *(u32x4*)(sWp + l256 + i * 8704) = pw[i]; *(u32x4*)(sQd + l256 + i * 8704) = pq[i]; *(u32x4*)(sKt + l128 + i * 9216) = pk[i]; }
      *(u32x4*)(sQK + l128) = pqk;
#pragma unroll
      for (int it = 0; it < 4; ++it) { uc[it] = un[it]; zc[it] = zn[it]; }
      gcur = gn;
    }
    __syncthreads();
  }
}

DI void mla_attn_item(const Params& P, int hd, int b, char* smem) {
  const int tid = opaque_tid(), lane = tid & 63, w = tid >> 6, wq = w & 3, hk = w >> 2, lq = lane & 31, h = lane >> 5;
  const float* qraw = (const float*)(P.ws + OFF_QRAW);
  const bf16_t* Kg = (const bf16_t*)(P.ws + OFF_KMLA) + (size_t)hd * S_ * 192;
  const bf16_t* Vg = (const bf16_t*)(P.ws + OFF_VT) + (size_t)hd * 128 * S_;
  bf16_t* mixin = (bf16_t*)(P.ws + OFF_H);
  const int q = 128 * b + 32 * wq + lq;
  bf16x8 qf[12];
  {
    const float* qp = qraw + (size_t)q * 768 + hd * 192 + 8 * h;
    const float sc = 0.07216878364870322f * LOG2E;
#pragma unroll
    for (int s = 0; s < 8; ++s) { const f32x4 a = *(const f32x4*)(qp + 16 * s), c = *(const f32x4*)(qp + 16 * s + 4);
      qf[s] = pack8(a.x * sc, a.y * sc, a.z * sc, a.w * sc, c.x * sc, c.y * sc, c.z * sc, c.w * sc); }
    const double pq = (double)P.pos[q];
#pragma unroll
    for (int s2 = 0; s2 < 2; ++s2) {
      const f32x4 a0 = *(const f32x4*)(qp + 128 + 16 * s2), a1 = *(const f32x4*)(qp + 128 + 16 * s2 + 4);
      const f32x4 b0 = *(const f32x4*)(qp + 160 + 16 * s2), b1 = *(const f32x4*)(qp + 160 + 16 * s2 + 4);
      float x1[8] = {a0.x, a0.y, a0.z, a0.w, a1.x, a1.y, a1.z, a1.w}, x2[8] = {b0.x, b0.y, b0.z, b0.w, b1.x, b1.y, b1.z, b1.w}, o1[8], o2[8];
#pragma unroll
      for (int j = 0; j < 8; ++j) { double fr = pq * kInvFreq2Pi[16 * s2 + 8 * h + j]; fr -= floor(fr); const float ff = (float)fr;
        const float sn = __builtin_amdgcn_sinf(ff), cs = __builtin_amdgcn_cosf(ff);
        o1[j] = (x1[j] * cs - x2[j] * sn) * sc; o2[j] = (x2[j] * cs + x1[j] * sn) * sc; }
      qf[8 + s2] = pack8(o1[0], o1[1], o1[2], o1[3], o1[4], o1[5], o1[6], o1[7]);
      qf[10 + s2] = pack8(o2[0], o2[1], o2[2], o2[3], o2[4], o2[5], o2[6], o2[7]);
    }
  }
  constexpr int KST = 64 * 400, VST = 128 * 144, STG = KST + VST;
  f32x16 O[4];
#pragma unroll
  for (int i = 0; i < 4; ++i)
#pragma unroll
    for (int r = 0; r < 16; ++r) O[i][r] = 0.f;
  float m_i = -1e30f, l_i = 0.f;
  const int nt = 2 * b + 2;
  u32x4 rk[3], rv[2];
  const int vrow = tid >> 3, vcc = tid & 7;
#pragma unroll
  for (int i = 0; i < 3; ++i) { const int id = tid + NT * i, row = id / 24, cc = id % 24; rk[i] = *(const u32x4*)(Kg + row * 192 + cc * 8); }
#pragma unroll
  for (int i = 0; i < 2; ++i) rv[i] = *(const u32x4*)(Vg + (size_t)(vrow + 64 * i) * S_ + vcc * 8);
#pragma unroll
  for (int i = 0; i < 3; ++i) { const int id = tid + NT * i, row = id / 24, cc = id % 24; *(u32x4*)(smem + row * 400 + cc * 16) = rk[i]; }
#pragma unroll
  for (int i = 0; i < 2; ++i) *(u32x4*)(smem + KST + (vrow + 64 * i) * 144 + vcc * 16) = rv[i];
  __syncthreads();
  for (int kt = 0; kt < nt; ++kt) {
    const char* sK = smem + (kt & 1) * STG; const char* sV = sK + KST;
    const bool more = (kt + 1 < nt);
    if (more) { const size_t ko = (size_t)(kt + 1) * 64 * 192; const int vo = (kt + 1) * 64;
#pragma unroll
      for (int i = 0; i < 3; ++i) { const int id = tid + NT * i, row = id / 24, cc = id % 24; rk[i] = *(const u32x4*)(Kg + ko + row * 192 + cc * 8); }
#pragma unroll
      for (int i = 0; i < 2; ++i) rv[i] = *(const u32x4*)(Vg + (size_t)(vrow + 64 * i) * S_ + vo + vcc * 8); }
    const int key0 = 64 * kt + 32 * hk;
    if (key0 <= 128 * b + 32 * wq) {
      f32x16 st;
#pragma unroll
      for (int r = 0; r < 16; ++r) st[r] = 0.f;
#pragma unroll
      for (int s = 0; s < 12; ++s) { const bf16x8 kf = *(const bf16x8*)(sK + (32 * hk + lq) * 400 + (2 * s + h) * 16); st = MFMA32(kf, qf[s], st); }
      if (key0 + 31 > 128 * b + 32 * wq) {
        int qrel = q - key0 - 4 * h; asm volatile("" : "+v"(qrel));
#pragma unroll
        for (int r = 0; r < 16; ++r) if ((r & 3) + 8 * (r >> 2) > qrel) st[r] = -1e30f;
      }
      float mx = st[0];
#pragma unroll
      for (int r = 1; r < 16; ++r) mx = fmaxf(mx, st[r]);
      mx = fmaxf(mx, __shfl_xor(mx, 32));
      const float m_new = fmaxf(m_i, mx), alpha = exp2f(m_i - m_new);
      float ps = 0.f;
#pragma unroll
      for (int r = 0; r < 16; ++r) { st[r] = exp2f(st[r] - m_new); ps += st[r]; }
      l_i = l_i * alpha + ps; m_i = m_new;
#pragma unroll
      for (int i = 0; i < 4; ++i)
#pragma unroll
        for (int r = 0; r < 16; ++r) O[i][r] *= alpha;
      bf16x8 pf[2];
#pragma unroll
      for (int s = 0; s < 2; ++s) pf[s] = pack8(st[8 * s], st[8 * s + 1], st[8 * s + 2], st[8 * s + 3], st[8 * s + 4], st[8 * s + 5], st[8 * s + 6], st[8 * s + 7]);
#pragma unroll
      for (int i = 0; i < 4; ++i)
#pragma unroll
        for (int s = 0; s < 2; ++s) { const char* vp = sV + (32 * i + lq) * 144 + (32 * hk + 16 * s + 4 * h) * 2;
          const u32x2 lo = *(const u32x2*)vp, hi = *(const u32x2*)(vp + 16); u32x4 vv = {lo.x, lo.y, hi.x, hi.y};
          O[i] = MFMA32(__builtin_bit_cast(bf16x8, vv), pf[s], O[i]); }
    }
    if (more) { char* dK = smem + ((kt + 1) & 1) * STG;
#pragma unroll
      for (int i = 0; i < 3; ++i) { const int id = tid + NT * i, row = id / 24, cc = id % 24; *(u32x4*)(dK + row * 400 + cc * 16) = rk[i]; }
#pragma unroll
      for (int i = 0; i < 2; ++i) *(u32x4*)(dK + KST + (vrow + 64 * i) * 144 + vcc * 16) = rv[i]; }
    __syncthreads();
  }
  float* cO = (float*)smem; float* cm = cO + 4 * 4096; float* cl = cm + 256;
  if (hk == 1) {
#pragma unroll
    for (int i = 0; i < 4; ++i)
#pragma unroll
      for (int r = 0; r < 16; ++r) cO[wq * 4096 + (i * 16 + r) * 64 + lane] = O[i][r];
    cm[wq * 64 + lane] = m_i; cl[wq * 64 + lane] = l_i;
  }
  __syncthreads();
  if (hk == 0) {
    const float m1 = cm[wq * 64 + lane], l1 = cl[wq * 64 + lane];
    const float m = fmaxf(m_i, m1), a0 = exp2f(m_i - m), a1 = exp2f(m1 - m);
    float lt = l_i * a0 + l1 * a1; lt += __shfl_xor(lt, 32);
    const float inv = 1.f / lt;
    bf16_t* op = mixin + (size_t)q * 2048 + 1024 + hd * 128;
#pragma unroll
    for (int i = 0; i < 4; ++i)
#pragma unroll
      for (int rg = 0; rg < 4; ++rg) { float v[4];
#pragma unroll
        for (int e = 0; e < 4; ++e) v[e] = (O[i][4 * rg + e] * a0 + cO[wq * 4096 + (i * 16 + 4 * rg + e) * 64 + lane] * a1) * inv;
        u32x2 pk = {pack2(v[0], v[1]), pack2(v[2], v[3])}; *(u32x2*)(op + 32 * i + 8 * rg + 4 * h) = pk; }
  }
  __syncthreads();
}

DI void swa_item(const Params& P, int l, int n, int hk2, char* smem) {
  const int tid = opaque_tid(), lane = tid & 63, w = tid >> 6, lq = lane & 31, h = lane >> 5;
  const bf16_t* proj = (const bf16_t*)(P.ws + OFF_PROJ); bf16_t* mixin = (bf16_t*)(P.ws + OFF_H);
  bf16_t* sVt = (bf16_t*)smem;
#pragma unroll
  for (int i = 0; i < 4; ++i) { const int id = tid + NT * i, key = id >> 3, dc = id & 7; const int kp = 128 * (n - 1) + key;
    u32x4 v = {0u, 0u, 0u, 0u}; if (kp >= 0) v = *(const u32x4*)(proj + (size_t)kp * DINP + C_CV + hk2 * 64 + dc * 8);
    sVt[(8 * dc + 0) * 264 + key] = (bf16_t)(v.x & 0xffff); sVt[(8 * dc + 1) * 264 + key] = (bf16_t)(v.x >> 16);
    sVt[(8 * dc + 2) * 264 + key] = (bf16_t)(v.y & 0xffff); sVt[(8 * dc + 3) * 264 + key] = (bf16_t)(v.y >> 16);
    sVt[(8 * dc + 4) * 264 + key] = (bf16_t)(v.z & 0xffff); sVt[(8 * dc + 5) * 264 + key] = (bf16_t)(v.z >> 16);
    sVt[(8 * dc + 6) * 264 + key] = (bf16_t)(v.w & 0xffff); sVt[(8 * dc + 7) * 264 + key] = (bf16_t)(v.w >> 16); }
  __syncthreads();
  const int g = w >> 1, hq = hk2 * 4 + g;
  const float slope = exp2f(-(float)(hq + 1)) * LOG2E, sinkv = P.swa_sinks[l * 8 + hq] * LOG2E;
#pragma unroll 1
  for (int jj = 0; jj < 2; ++jj) {
    const int j = 2 * (w & 1) + jj; const int qrow = 128 * n + 32 * j + lq;
    bf16x8 qf[4];
#pragma unroll
    for (int s = 0; s < 4; ++s) qf[s] = *(const bf16x8*)(proj + (size_t)qrow * DINP + C_CQ + hq * 64 + 16 * s + 8 * h);
    f32x16 st[5];
    bf16x8 kf[2][4];
    { const int kp = 128 * (n - 1) + 32 * j + lq;
#pragma unroll
      for (int s = 0; s < 4; ++s) { kf[0][s] = (bf16x8){0, 0, 0, 0, 0, 0, 0, 0}; if (kp >= 0) kf[0][s] = *(const bf16x8*)(proj + (size_t)kp * DINP + C_CK + hk2 * 64 + 16 * s + 8 * h); } }
#pragma unroll
    for (int tt = 0; tt < 5; ++tt) {
      if (tt + 1 < 5) { const int kp = 128 * (n - 1) + 32 * (j + tt + 1) + lq;
#pragma unroll
        for (int s = 0; s < 4; ++s) { kf[(tt + 1) & 1][s] = (bf16x8){0, 0, 0, 0, 0, 0, 0, 0}; if (kp >= 0) kf[(tt + 1) & 1][s] = *(const bf16x8*)(proj + (size_t)kp * DINP + C_CK + hk2 * 64 + 16 * s + 8 * h); } }
      __builtin_amdgcn_sched_barrier(0);
#pragma unroll
      for (int r = 0; r < 16; ++r) st[tt][r] = 0.f;
#pragma unroll
      for (int s = 0; s < 4; ++s) st[tt] = MFMA32(kf[tt & 1][s], qf[s], st[tt]);
      __builtin_amdgcn_sched_barrier(0);
    }
    float mx = sinkv;
    int dbase = 128 + lq - 4 * h, kbase = 128 * (n - 1) + 32 * j + 4 * h;
    asm volatile("" : "+v"(dbase), "+v"(kbase));
#pragma unroll
    for (int tt = 0; tt < 5; ++tt)
#pragma unroll
      for (int r = 0; r < 16; ++r) { const int cst = 32 * tt + (r & 3) + 8 * (r >> 2); const int dist = dbase - cst; const int kpos = kbase + cst;
        const bool valid = (dist >= 0) && (dist < 128) && (kpos >= 0);
        const float sv = valid ? st[tt][r] * (0.125f * LOG2E) - slope * (float)dist : -1e30f; st[tt][r] = sv; mx = fmaxf(mx, sv); }
    mx = fmaxf(mx, __shfl_xor(mx, 32));
    float den = 0.f;
#pragma unroll
    for (int tt = 0; tt < 5; ++tt)
#pragma unroll
      for (int r = 0; r < 16; ++r) { const float p = exp2f(st[tt][r] - mx); st[tt][r] = p; den += p; }
    den += __shfl_xor(den, 32); den += exp2f(sinkv - mx);
    f32x16 O[2];
#pragma unroll
    for (int i = 0; i < 2; ++i)
#pragma unroll
      for (int r = 0; r < 16; ++r) O[i][r] = 0.f;
#pragma unroll
    for (int tt = 0; tt < 5; ++tt)
#pragma unroll
      for (int s = 0; s < 2; ++s) { const bf16x8 pf = pack8(st[tt][8 * s], st[tt][8 * s + 1], st[tt][8 * s + 2], st[tt][8 * s + 3], st[tt][8 * s + 4], st[tt][8 * s + 5], st[tt][8 * s + 6], st[tt][8 * s + 7]);
#pragma unroll
        for (int i = 0; i < 2; ++i) { const char* vp = (const char*)sVt + (32 * i + lq) * 528 + (32 * (j + tt) + 16 * s + 4 * h) * 2;
          const u32x2 lo = *(const u32x2*)vp, hi = *(const u32x2*)(vp + 16); u32x4 vv = {lo.x, lo.y, hi.x, hi.y};
          O[i] = MFMA32(__builtin_bit_cast(bf16x8, vv), pf, O[i]); }
        __builtin_amdgcn_sched_barrier(0); }
    const float inv = 1.f / den;
    bf16_t* op = mixin + (size_t)qrow * 2048 + 1536 + hq * 64;
#pragma unroll
    for (int i = 0; i < 2; ++i)
#pragma unroll
      for (int rg = 0; rg < 4; ++rg) { u32x2 pk = {pack2(O[i][4 * rg] * inv, O[i][4 * rg + 1] * inv), pack2(O[i][4 * rg + 2] * inv, O[i][4 * rg + 3] * inv)};
        *(u32x2*)(op + 32 * i + 8 * rg + 4 * h) = pk; }
  }
  __syncthreads();
}

DI float gelu_tanh(float x) { const float y = 0.7978845608028654f * (x + 0.044715f * x * x * x); const float t = 1.f - 2.f / (1.f + __expf(2.f * y)); return 0.5f * x * (1.f + t); }
DI void ffn_act_phase(const Params& P, int l) {
  const int tid = opaque_tid(), lane = tid & 63, w = tid >> 6;
  const bf16_t* u = (const bf16_t*)(P.ws + OFF_BIG); bf16_t* act = (bf16_t*)(P.ws + OFF_ACT);
  const float* cw = P.ffn_conv + (size_t)l * 3 * DFF2; const float* cb = P.ffn_conv_b + (size_t)l * DFF2;
  for (int item = blockIdx.x * 8 + w; item < 512 * 11; item += gridDim.x * 8) {
    const int cbk = item % 11, rr = item / 11; const int ch = cbk * 512 + lane * 8, r0 = rr * 32;
    float wg[3][8], wu[3][8], bg[8], bu[8];
#pragma unroll
    for (int j = 0; j < 3; ++j)
#pragma unroll
      for (int e4 = 0; e4 < 2; ++e4) { const f32x4 a = *(const f32x4*)(cw + (size_t)j * DFF2 + ch + 4 * e4), b = *(const f32x4*)(cw + (size_t)j * DFF2 + DFF + ch + 4 * e4);
        wg[j][4 * e4] = a.x; wg[j][4 * e4 + 1] = a.y; wg[j][4 * e4 + 2] = a.z; wg[j][4 * e4 + 3] = a.w; wu[j][4 * e4] = b.x; wu[j][4 * e4 + 1] = b.y; wu[j][4 * e4 + 2] = b.z; wu[j][4 * e4 + 3] = b.w; }
#pragma unroll
    for (int e4 = 0; e4 < 2; ++e4) { const f32x4 a = *(const f32x4*)(cb + ch + 4 * e4), b = *(const f32x4*)(cb + DFF + ch + 4 * e4);
      bg[4 * e4] = a.x; bg[4 * e4 + 1] = a.y; bg[4 * e4 + 2] = a.z; bg[4 * e4 + 3] = a.w; bu[4 * e4] = b.x; bu[4 * e4 + 1] = b.y; bu[4 * e4 + 2] = b.z; bu[4 * e4 + 3] = b.w; }
    float g2[8], g1[8], u2[8], u1[8];
#pragma unroll
    for (int e = 0; e < 8; ++e) { g2[e] = 0.f; g1[e] = 0.f; u2[e] = 0.f; u1[e] = 0.f; }
    if (r0 >= 2) { unpack8(*(const u32x4*)(u + (size_t)(r0 - 2) * DFF2 + ch), g2); unpack8(*(const u32x4*)(u + (size_t)(r0 - 2) * DFF2 + DFF + ch), u2);
      unpack8(*(const u32x4*)(u + (size_t)(r0 - 1) * DFF2 + ch), g1); unpack8(*(const u32x4*)(u + (size_t)(r0 - 1) * DFF2 + DFF + ch), u1); }
#pragma unroll 1
    for (int rb = 0; rb < 4; ++rb) {
      u32x4 G[8], U[8];
#pragma unroll
      for (int i = 0; i < 8; ++i) { const size_t ro = (size_t)(r0 + rb * 8 + i) * DFF2 + ch; G[i] = *(const u32x4*)(u + ro); U[i] = *(const u32x4*)(u + ro + DFF); }
#pragma unroll
      for (int i = 0; i < 8; ++i) {
        float g0[8], u0[8]; unpack8(G[i], g0); unpack8(U[i], u0);
        float o[8];
#pragma unroll
        for (int e = 0; e < 8; ++e) { const float yg = wg[0][e] * g2[e] + wg[1][e] * g1[e] + wg[2][e] * g0[e] + bg[e]; const float yu = wu[0][e] * u2[e] + wu[1][e] * u1[e] + wu[2][e] * u0[e] + bu[e];
          o[e] = gelu_tanh(yg) * yu; g2[e] = g1[e]; g1[e] = g0[e]; u2[e] = u1[e]; u1[e] = u0[e]; }
        u32x4 pk = {pack2(o[0], o[1]), pack2(o[2], o[3]), pack2(o[4], o[5]), pack2(o[6], o[7])};
        *(u32x4*)(act + (size_t)(r0 + rb * 8 + i) * DFF + ch) = pk;
      }
    }
  }
}

__global__ void __launch_bounds__(NT) fwd_megakernel(Params P0) {
  cg::grid_group grid = cg::this_grid();
  __shared__ __attribute__((aligned(16))) char smem[132352];
  const int tid = threadIdx.x;
  char* ws = P0.ws;
  int* ctrl = (int*)(ws + OFF_CTRL);
  if (blockIdx.x == 0 && tid < 64) ctrl[tid] = 0;
  if (blockIdx.x == 0 && tid == 0) *(Params*)(ws + OFF_CTRL + 1024) = P0;
  bf16_t* Hb = (bf16_t*)(ws + OFF_H);
  for (int it = blockIdx.x; it < 192 + CV_T5; it += gridDim.x) { if (it < 192) mod_item(P0, it); else convert_item(P0, 0, it - 192, smem); }
  grid.sync();
  const Params& P = *(const Params*)(ws + OFF_CTRL + 1024);
  rownorm_phase(P, P.x, nullptr, P.out, Hb, 0, 0, nullptr, 0, 1, 0, P.mix_pre, smem);
  grid.sync();
  for (int l = 0; l < 2; ++l) {
    { EpiProj epi{(bf16_t*)(ws + OFF_PROJ), (float*)(ws + OFF_AB)}; gemm_phase(Hb, 2048, (const bf16_t*)(ws + OFF_W + W_IN), 2048, 2048, 64, 22, smem, epi); }
    grid.sync();
    for (int it = blockIdx.x; it < 448 + 2048; it += gridDim.x) {
      if (it < 192) mla_q_tile(P, it / 3, it % 3, smem);
      else if (it < 448) mla_kv_tile(P, (it - 192) >> 2, (it - 192) & 3, smem);
      else { const int id = it - 448; gdn_prep_item(P, l, id >> 3, id & 7, smem); }
    }
    grid.sync();
    {
      int* sitem = (int*)(smem + 132096);
      for (;;) {
        if (tid == 0) *sitem = atomicAdd(ctrl + 16 * l, 1);
        __syncthreads(); const int item = *sitem; __syncthreads();
        if (item >= 8 + 512 + 256) break;
        if (item < 8) gdn_scan_item(P, l, item, smem);
        else if (item < 520) { const int idx = item - 8; mla_attn_item(P, idx & 3, 127 - (idx >> 2), smem); }
        else { const int idx = item - 520; swa_item(P, l, idx >> 1, idx & 1, smem); }
      }
    }
    grid.sync();
    { EpiF32 epi{(float*)(ws + OFF_MIXF), 2048}; gemm_phase(Hb, 2048, (const bf16_t*)(ws + OFF_W + W_OUT), 2048, 2048, 64, 8, smem, epi); }
    grid.sync();
    rownorm_phase(P, P.out, (const float*)(ws + OFF_MIXF), P.out, Hb, l, 2, P.mix_post + l * 2048, l, 4, 3, P.ffn_pre + l * 2048, smem);
    grid.sync();
    { EpiBf epi{(bf16_t*)(ws + OFF_BIG), DFF2}; gemm_phase(Hb, 2048, (const bf16_t*)(ws + OFF_W + W_UP), 2048, 2048, 64, 44, smem, epi); }
    grid.sync();
    ffn_act_phase(P, l);
    grid.sync();
    { EpiF32 epi{(float*)(ws + OFF_Y), 2048}; gemm_phase((const bf16_t*)(ws + OFF_ACT), DFF, (const bf16_t*)(ws + OFF_W + W_DOWN), DFF, DFF, 64, 8, smem, epi); }
    grid.sync();
    if (l == 0) {
      for (int it = blockIdx.x; it < CV_T5; it += gridDim.x) convert_item(P, 1, it, smem);
      rownorm_phase(P, P.out, (const float*)(ws + OFF_Y), P.out, Hb, 0, 5, P.ffn_post, 1, 1, 0, P.mix_pre + 2048, smem);
      grid.sync();
    } else {
      rownorm_phase(P, P.out, (const float*)(ws + OFF_Y), P.out, nullptr, 1, 5, P.ffn_post + 2048, 1, 1, 0, nullptr, smem);
    }
  }
}

extern "C" void kernel_launch(void* const* d_in, const int* in_sizes, int n_in, void* d_out, int out_size, void* d_ws, size_t ws_size, hipStream_t stream) {
  static int grid_blocks = 0;
  if (!grid_blocks) {
    int dev = 0, cus = 0, per = 0;
    (void)hipGetDevice(&dev); (void)hipDeviceGetAttribute(&cus, hipDeviceAttributeMultiprocessorCount, dev);
    (void)hipOccupancyMaxActiveBlocksPerMultiprocessor(&per, fwd_megakernel, NT, 0);
    if (per > 1) per = 1;
    grid_blocks = cus * per; if (grid_blocks <= 0) grid_blocks = 256;
  }
  if (ws_size < OFF_END) { fprintf(stderr, "workspace too small: %zu < %zu\n", ws_size, (size_t)OFF_END); return; }
  Params p{};
  p.x = (const float*)d_in[0]; p.c = (const float*)d_in[1]; p.pos = (const int*)d_in[2];
  p.ada_w = (const float*)d_in[3]; p.ada_b = (const float*)d_in[4]; p.mix_pre = (const float*)d_in[5]; p.mix_post = (const float*)d_in[6];
  p.w_in = (const float*)d_in[7]; p.w_out = (const float*)d_in[8]; p.gdn_conv = (const float*)d_in[9]; p.gdn_a_log = (const float*)d_in[10];
  p.gdn_dt_bias = (const float*)d_in[11]; p.gdn_norm = (const float*)d_in[12]; p.mla_q_norm = (const float*)d_in[13]; p.mla_w_uq = (const float*)d_in[14];
  p.mla_kv_norm = (const float*)d_in[15]; p.mla_w_ukv = (const float*)d_in[16]; p.swa_sinks = (const float*)d_in[17]; p.ffn_pre = (const float*)d_in[18];
  p.ffn_post = (const float*)d_in[19]; p.ffn_w_up = (const float*)d_in[20]; p.ffn_conv = (const float*)d_in[21]; p.ffn_conv_b = (const float*)d_in[22];
  p.ffn_w_down = (const float*)d_in[23];
  p.out = (float*)d_out; p.ws = (char*)d_ws;
  void* args[] = {&p};
  hipError_t e = hipLaunchCooperativeKernel((void*)fwd_megakernel, dim3(grid_blocks), dim3(NT), args, 0, stream);
  if (e != hipSuccess) fprintf(stderr, "cooperative launch failed: %s (grid %d)\n", hipGetErrorString(e), grid_blocks);
}
```

```cpp
#include <hip/hip_runtime.h>
#include <hip/hip_cooperative_groups.h>
#include <cstdio>
#include <cstdint>
namespace cg = cooperative_groups;

#define DI __device__ __forceinline__
typedef unsigned short bf16_t;
typedef short bf16x8 __attribute__((ext_vector_type(8)));
typedef float f32x2 __attribute__((ext_vector_type(2)));
typedef float f32x4 __attribute__((ext_vector_type(4)));
typedef float f32x16 __attribute__((ext_vector_type(16)));
typedef unsigned u32x2 __attribute__((ext_vector_type(2)));
typedef unsigned u32x4 __attribute__((ext_vector_type(4)));
typedef __bf16 bf2_t __attribute__((ext_vector_type(2)));

constexpr int S_ = 16384, D_ = 2048, DINP = 5632, DFF = 5632, DFF2 = 11264;
constexpr int NT = 512;
constexpr float EPS = 1e-6f;
constexpr float LOG2E = 1.4426950408889634f;

constexpr size_t OFF_CTRL = 0;
constexpr size_t OFF_MODP = 4096;
constexpr size_t OFF_W = 2097152;
constexpr size_t W_IN = 0, W_OUT = W_IN + (size_t)5632 * 2048 * 2, W_UP = W_OUT + (size_t)2048 * 2048 * 2,
                 W_DOWN = W_UP + (size_t)11264 * 2048 * 2, W_UQ = W_DOWN + (size_t)2048 * 5632 * 2,
                 W_UKV = W_UQ + (size_t)768 * 448 * 2, W_END = W_UKV + (size_t)1024 * 128 * 2;
constexpr size_t OFF_H = OFF_W + W_END;
constexpr size_t OFF_MIXF = OFF_H + (size_t)S_ * 2048 * 2;
constexpr size_t OFF_QRAW = OFF_MIXF;
constexpr size_t OFF_KMLA = OFF_QRAW + (size_t)S_ * 768 * 4;
constexpr size_t OFF_VT = OFF_KMLA + (size_t)4 * S_ * 192 * 2;
constexpr size_t OFF_BIG = OFF_MIXF + (size_t)S_ * 2048 * 4;
constexpr size_t OFF_PROJ = OFF_BIG;
constexpr size_t OFF_WP = OFF_PROJ + (size_t)S_ * DINP * 2;
constexpr size_t OFF_QD = OFF_WP + (size_t)S_ * 1024 * 2;
constexpr size_t OFF_KT = OFF_QD + (size_t)S_ * 1024 * 2;
constexpr size_t OFF_ZT = OFF_KT + (size_t)S_ * 1024 * 2;
constexpr size_t OFF_QK = OFF_ZT + (size_t)S_ * 1024 * 2;
constexpr size_t OFF_AB = OFF_QK + (size_t)S_ * 512 * 2;
constexpr size_t OFF_GTOT = OFF_AB + (size_t)S_ * 16 * 4;
constexpr size_t OFF_Y = OFF_BIG;
constexpr size_t OFF_ACT = OFF_H;
constexpr size_t OFF_UT = OFF_BIG + (size_t)S_ * DFF2 * 2;
constexpr size_t OFF_END = OFF_UT + (size_t)S_ * 1024 * 4;
static_assert(OFF_GTOT + 8192 <= OFF_UT, "overlay");
static_assert(OFF_VT + (size_t)4 * 128 * S_ * 2 <= OFF_BIG, "overlay2");

constexpr int C_AQ = 0, C_AK = 1024, C_AV = 2048, C_AZ = 3072, C_AA = 4096, C_BCQ = 4112, C_BCKV = 4560,
              C_BKR = 4688, C_CQ = 4752, C_CK = 5264, C_CV = 5392;

__constant__ double kInvFreq2Pi[32] = {
    0.15915494309189535, 0.11934937021124886, 0.08949940160889101, 0.06711508300522726, 0.050329212104487035, 0.03774158471741977,
    0.0283021958306234, 0.02122365276477766, 0.015915494309189534, 0.011934937021124886, 0.008949940160889102, 0.006711508300522725,
    0.005032921210448704, 0.003774158471741977, 0.00283021958306234, 0.0021223652764777662, 0.0015915494309189536, 0.0011934937021124885,
    0.0008949940160889102, 0.0006711508300522726, 0.0005032921210448703, 0.00037741584717419774, 0.00028302195830623395, 0.0002122365276477766,
    0.00015915494309189535, 0.00011934937021124886, 8.949940160889102e-05, 6.711508300522725e-05, 5.0329212104487035e-05, 3.774158471741978e-05,
    2.8302195830623396e-05, 2.122365276477766e-05};

struct Params {
  const float* x; const float* c; const int* pos;
  const float *ada_w, *ada_b, *mix_pre, *mix_post, *w_in, *w_out, *gdn_conv, *gdn_a_log, *gdn_dt_bias, *gdn_norm, *mla_q_norm, *mla_w_uq,
      *mla_kv_norm, *mla_w_ukv, *swa_sinks, *ffn_pre, *ffn_post, *ffn_w_up, *ffn_conv, *ffn_conv_b, *ffn_w_down;
  float* out; char* ws;
};

DI unsigned pack2(float lo, float hi) { f32x2 v = {lo, hi}; bf2_t b = __builtin_convertvector(v, bf2_t); return __builtin_bit_cast(unsigned, b); }
DI bf16_t f2bf(float x) { return (bf16_t)(pack2(x, 0.f) & 0xffffu); }
DI float bflo(unsigned u) { return __uint_as_float(u << 16); }
DI float bfhi(unsigned u) { return __uint_as_float(u & 0xffff0000u); }
DI void unpack8(const u32x4& v, float* f) { f[0] = bflo(v.x); f[1] = bfhi(v.x); f[2] = bflo(v.y); f[3] = bfhi(v.y); f[4] = bflo(v.z); f[5] = bfhi(v.z); f[6] = bflo(v.w); f[7] = bfhi(v.w); }
DI bf16x8 pack8(float a0, float a1, float a2, float a3, float a4, float a5, float a6, float a7) {
  u32x4 p = {pack2(a0, a1), pack2(a2, a3), pack2(a4, a5), pack2(a6, a7)}; return __builtin_bit_cast(bf16x8, p); }
DI float silu_f(float x) { return x / (1.f + __expf(-x)); }
DI float wave_sum(float v) { v += __shfl_xor(v, 32); v += __shfl_xor(v, 16); v += __shfl_xor(v, 8); v += __shfl_xor(v, 4); v += __shfl_xor(v, 2); v += __shfl_xor(v, 1); return v; }
DI int opaque_tid() { int t = threadIdx.x; asm volatile("" : "+v"(t)); return t; }
DI int crow(int r, int h) { return (r & 3) + 8 * (r >> 2) + 4 * h; }
DI int perm32(int k) { return 8 * ((k >> 2) & 3) + 4 * (k >> 4) + (k & 3); }
#define MFMA32(a, b, c) __builtin_amdgcn_mfma_f32_32x32x16_bf16((a), (b), (c), 0, 0, 0)
#define MFMA16(a, b, c) __builtin_amdgcn_mfma_f32_16x16x32_bf16((a), (b), (c), 0, 0, 0)

template <class Epi>
DI void gemm_tile(const bf16_t* __restrict__ A, int lda, const bf16_t* __restrict__ Bt, int ldb, int K, int m0, int n0, char* smem, const Epi& epi) {
  const int tid = opaque_tid(), lane = tid & 63, w = tid >> 6, wm = w >> 2, wn = w & 3, lq = lane & 31, h = lane >> 5;
  f32x16 acc[2][4];
#pragma unroll
  for (int i = 0; i < 2; ++i)
#pragma unroll
    for (int j = 0; j < 4; ++j)
#pragma unroll
      for (int r = 0; r < 16; ++r) acc[i][j][r] = 0.f;
  const int r0 = tid >> 3, c0 = tid & 7;
  const bf16_t* ag = A + (size_t)(m0 + r0) * lda + c0 * 8;
  const bf16_t* bg = Bt + (size_t)(n0 + r0) * ldb + c0 * 8;
  const int wofs = r0 * 128 + ((c0 ^ ((r0 >> 1) & 7)) << 4);
  char* sA = smem; char* sB = smem + 32768;
  u32x4 ra[4], rb[4];
#pragma unroll
  for (int i = 0; i < 4; ++i) { ra[i] = *(const u32x4*)(ag + (size_t)i * 64 * lda); rb[i] = *(const u32x4*)(bg + (size_t)i * 64 * ldb); }
#pragma unroll
  for (int i = 0; i < 4; ++i) { *(u32x4*)(sA + wofs + i * 8192) = ra[i]; *(u32x4*)(sB + wofs + i * 8192) = rb[i]; }
  __syncthreads();
  const int nk = K >> 6, swz = (lane >> 1) & 7;
  const int aoff = (64 * wn + lq) * 128, boff = (128 * wm + lq) * 128;
  for (int kt = 0; kt < nk; ++kt) {
    const char* cA = sA + (kt & 1) * 65536; const char* cB = sB + (kt & 1) * 65536;
    const bool more = (kt + 1 < nk);
    if (more) { ag += 64; bg += 64;
#pragma unroll
      for (int i = 0; i < 4; ++i) { ra[i] = *(const u32x4*)(ag + (size_t)i * 64 * lda); rb[i] = *(const u32x4*)(bg + (size_t)i * 64 * ldb); } }
#pragma unroll
    for (int s = 0; s < 4; ++s) {
      const int co = (((2 * s + h) ^ swz) << 4);
      bf16x8 fa[2], fb[4];
#pragma unroll
      for (int ni = 0; ni < 2; ++ni) fa[ni] = *(const bf16x8*)(cB + aoff + ni * 4096 + co);
#pragma unroll
      for (int mi = 0; mi < 4; ++mi) fb[mi] = *(const bf16x8*)(cA + boff + mi * 4096 + co);
#pragma unroll
      for (int ni = 0; ni < 2; ++ni)
#pragma unroll
        for (int mi = 0; mi < 4; ++mi) acc[ni][mi] = MFMA32(fa[ni], fb[mi], acc[ni][mi]);
    }
    if (more) { char* dA = sA + ((kt + 1) & 1) * 65536; char* dB = sB + ((kt + 1) & 1) * 65536;
#pragma unroll
      for (int i = 0; i < 4; ++i) { *(u32x4*)(dA + wofs + i * 8192) = ra[i]; *(u32x4*)(dB + wofs + i * 8192) = rb[i]; } }
    __syncthreads();
  }
#pragma unroll
  for (int ni = 0; ni < 2; ++ni)
#pragma unroll
    for (int mi = 0; mi < 4; ++mi)
#pragma unroll
      for (int rg = 0; rg < 4; ++rg) {
        const int m = m0 + 128 * wm + 32 * mi + lq, n = n0 + 64 * wn + 32 * ni + 8 * rg + 4 * h;
        epi(m, n, acc[ni][mi][4 * rg], acc[ni][mi][4 * rg + 1], acc[ni][mi][4 * rg + 2], acc[ni][mi][4 * rg + 3]);
      }
}

DI void tile_coord(int t, int npn, int& pm, int& pn) { const int g = t / (16 * npn), r = t % (16 * npn); pn = r >> 4; pm = g * 16 + (r & 15); }

struct EpiProj { bf16_t* proj; float* ab;
  DI void operator()(int m, int n, float v0, float v1, float v2, float v3) const {
    u32x2 pk = {pack2(v0, v1), pack2(v2, v3)}; *(u32x2*)(proj + (size_t)m * DINP + n) = pk;
    if (n >= C_AA && n < C_AA + 16) { f32x4 v = {v0, v1, v2, v3}; *(f32x4*)(ab + (size_t)m * 16 + (n - C_AA)) = v; } } };
struct EpiF32 { float* out; int ldc;
  DI void operator()(int m, int n, float v0, float v1, float v2, float v3) const { f32x4 v = {v0, v1, v2, v3}; *(f32x4*)(out + (size_t)m * ldc + n) = v; } };
struct EpiBf { bf16_t* out; int ldc;
  DI void operator()(int m, int n, float v0, float v1, float v2, float v3) const { u32x2 pk = {pack2(v0, v1), pack2(v2, v3)}; *(u32x2*)(out + (size_t)m * ldc + n) = pk; } };
struct EpiMlaQ { float* qraw; const float* rs; int m0;
  DI void operator()(int m, int n, float v0, float v1, float v2, float v3) const { const float r = rs[m - m0]; f32x4 v = {v0 * r, v1 * r, v2 * r, v3 * r}; *(f32x4*)(qraw + (size_t)m * 768 + n) = v; } };
struct EpiMlaKV { bf16_t* kmla; bf16_t* vt; const float* rs; int m0;
  DI void operator()(int m, int n, float v0, float v1, float v2, float v3) const {
    const float r = rs[m - m0]; const int hd = n >> 8, wi = n & 255;
    if (wi < 128) { u32x2 pk = {pack2(v0 * r, v1 * r), pack2(v2 * r, v3 * r)}; *(u32x2*)(kmla + ((size_t)hd * S_ + m) * 192 + wi) = pk; }
    else { bf16_t* p = vt + ((size_t)hd * 128 + (wi - 128)) * S_ + m; p[0] = f2bf(v0 * r); p[S_] = f2bf(v1 * r); p[2 * (size_t)S_] = f2bf(v2 * r); p[3 * (size_t)S_] = f2bf(v3 * r); } } };

template <class Epi>
DI void gemm_phase(const bf16_t* A, int lda, const bf16_t* Bt, int ldb, int K, int npm, int npn, char* smem, const Epi& epi) {
  for (int t = blockIdx.x; t < npm * npn; t += gridDim.x) { int pm, pn; tile_coord(t, npn, pm, pn); gemm_tile(A, lda, Bt, ldb, K, pm * 256, pn * 256, smem, epi); }
}

DI void mod_item(const Params& P, int item) {
  const int tid = opaque_tid(); const int l = item / 96, r = item % 96, ks = r / 6, nc = r % 6;
  const int n = nc * 2048 + tid * 4;
  const float* wp = P.ada_w + ((size_t)l * 2048 + ks * 128) * 12288 + n;
  f32x4 acc = {0.f, 0.f, 0.f, 0.f};
#pragma unroll 8
  for (int k = 0; k < 128; ++k) { const float cv = P.c[ks * 128 + k]; const float ca = silu_f(cv); const f32x4 wv = *(const f32x4*)(wp + (size_t)k * 12288); acc += wv * ca; }
  float* modp = (float*)(P.ws + OFF_MODP);
  *(f32x4*)(modp + ((size_t)l * 16 + ks) * 12288 + n) = acc;
}
DI void convert_tile(const float* __restrict__ src, int K, int N, bf16_t* __restrict__ dst, int tk, int tn, const float* rowscale, char* smem) {
  float* sm = (float*)smem; const int tid = opaque_tid(); const int k0 = tk * 64, n0 = tn * 256;
  { const int r = tid >> 6, c4 = tid & 63; const int n = n0 + 4 * c4;
    f32x4 v[8];
#pragma unroll
    for (int i = 0; i < 8; ++i) { v[i] = (f32x4){0.f, 0.f, 0.f, 0.f}; if (n < N) v[i] = *(const f32x4*)(src + (size_t)(k0 + r + 8 * i) * N + n); }
#pragma unroll
    for (int i = 0; i < 8; ++i) { const int kk = r + 8 * i; if (rowscale) v[i] *= rowscale[k0 + kk];
      sm[kk * 257 + 4 * c4 + 0] = v[i].x; sm[kk * 257 + 4 * c4 + 1] = v[i].y; sm[kk * 257 + 4 * c4 + 2] = v[i].z; sm[kk * 257 + 4 * c4 + 3] = v[i].w; } }
  __syncthreads();
  { const int n = tid >> 1, kh = tid & 1;
#pragma unroll
    for (int j = 0; j < 4; ++j) { float f[8];
#pragma unroll
      for (int i = 0; i < 8; ++i) f[i] = sm[(32 * kh + 8 * j + i) * 257 + n];
      u32x4 pk = {pack2(f[0], f[1]), pack2(f[2], f[3]), pack2(f[4], f[5]), pack2(f[6], f[7])};
      *(u32x4*)(dst + (size_t)(n0 + n) * K + k0 + 32 * kh + 8 * j) = pk; } }
  __syncthreads();
}
constexpr int CV_T0 = 32 * 22, CV_T1 = CV_T0 + 32 * 8, CV_T2 = CV_T1 + 32 * 44, CV_T3 = CV_T2 + 88 * 8, CV_T4 = CV_T3 + 7 * 3, CV_T5 = CV_T4 + 2 * 4;
DI void convert_item(const Params& P, int l, int it, char* smem) {
  char* wb = P.ws + OFF_W;
  if (it < CV_T0) convert_tile(P.w_in + (size_t)l * 2048 * 5520, 2048, 5520, (bf16_t*)(wb + W_IN), it / 22, it % 22, nullptr, smem);
  else if (it < CV_T1) { it -= CV_T0; convert_tile(P.w_out + (size_t)l * 2048 * 2048, 2048, 2048, (bf16_t*)(wb + W_OUT), it / 8, it % 8, nullptr, smem); }
  else if (it < CV_T2) { it -= CV_T1; convert_tile(P.ffn_w_up + (size_t)l * 2048 * 11264, 2048, 11264, (bf16_t*)(wb + W_UP), it / 44, it % 44, nullptr, smem); }
  else if (it < CV_T3) { it -= CV_T2; convert_tile(P.ffn_w_down + (size_t)l * 5632 * 2048, 5632, 2048, (bf16_t*)(wb + W_DOWN), it / 8, it % 8, nullptr, smem); }
  else if (it < CV_T4) { it -= CV_T3; convert_tile(P.mla_w_uq + (size_t)l * 448 * 768, 448, 768, (bf16_t*)(wb + W_UQ), it / 3, it % 3, P.mla_q_norm + l * 448, smem); }
  else { it -= CV_T4; convert_tile(P.mla_w_ukv + (size_t)l * 128 * 1024, 128, 1024, (bf16_t*)(wb + W_UKV), it / 4, it % 4, P.mla_kv_norm + l * 128, smem); }
}

DI float mod_val(const float* modp_l, const float* ada_b_l, int idx) { float s = ada_b_l[idx];
#pragma unroll
  for (int k = 0; k < 16; ++k) s += modp_l[(size_t)k * 12288 + idx]; return s; }
DI void rownorm_phase(const Params& P, const float* xin, const float* yin, float* xout, bf16_t* hout, int lg, int gate_idx, const float* w_post,
                      int lh, int scale_idx, int shift_idx, const float* w_pre, char* smem) {
  float* A1 = (float*)smem; float* A2 = A1 + 2048; float* B2 = A2 + 2048;
  const int tid = opaque_tid(), lane = tid & 63, w = tid >> 6;
  const float* modp = (const float*)(P.ws + OFF_MODP);
  for (int cidx = tid; cidx < 2048; cidx += NT) {
    if (yin) A1[cidx] = mod_val(modp + (size_t)lg * 16 * 12288, P.ada_b + (size_t)lg * 12288, gate_idx * 2048 + cidx) * w_post[cidx];
    if (hout) { A2[cidx] = w_pre[cidx] * (1.f + mod_val(modp + (size_t)lh * 16 * 12288, P.ada_b + (size_t)lh * 12288, scale_idx * 2048 + cidx));
      B2[cidx] = mod_val(modp + (size_t)lh * 16 * 12288, P.ada_b + (size_t)lh * 12288, shift_idx * 2048 + cidx); }
  }
  __syncthreads();
  for (int row = blockIdx.x * 8 + w; row < S_; row += gridDim.x * 8) {
    f32x4 xv[8];
#pragma unroll
    for (int j = 0; j < 8; ++j) xv[j] = *(const f32x4*)(xin + (size_t)row * 2048 + (j * 64 + lane) * 4);
    if (yin) {
      f32x4 yv[8]; float ss = 0.f;
#pragma unroll
      for (int j = 0; j < 8; ++j) { yv[j] = *(const f32x4*)(yin + (size_t)row * 2048 + (j * 64 + lane) * 4); ss += yv[j].x * yv[j].x + yv[j].y * yv[j].y + yv[j].z * yv[j].z + yv[j].w * yv[j].w; }
      ss = wave_sum(ss); const float r = rsqrtf(ss * (1.f / 2048.f) + EPS);
#pragma unroll
      for (int j = 0; j < 8; ++j) { const f32x4 a = *(const f32x4*)(A1 + (j * 64 + lane) * 4); xv[j] += a * (yv[j] * r); }
    }
    if (yin || xout != xin) {
#pragma unroll
      for (int j = 0; j < 8; ++j) *(f32x4*)(xout + (size_t)row * 2048 + (j * 64 + lane) * 4) = xv[j];
    }
    if (hout) {
      float ss = 0.f;
#pragma unroll
      for (int j = 0; j < 8; ++j) ss += xv[j].x * xv[j].x + xv[j].y * xv[j].y + xv[j].z * xv[j].z + xv[j].w * xv[j].w;
      ss = wave_sum(ss); const float r = rsqrtf(ss * (1.f / 2048.f) + EPS);
#pragma unroll
      for (int j = 0; j < 8; ++j) { const f32x4 a = *(const f32x4*)(A2 + (j * 64 + lane) * 4), b = *(const f32x4*)(B2 + (j * 64 + lane) * 4);
        const f32x4 hv = xv[j] * r * a + b; u32x2 pk = {pack2(hv.x, hv.y), pack2(hv.z, hv.w)};
        *(u32x2*)(hout + (size_t)row * 2048 + (j * 64 + lane) * 4) = pk; }
    }
  }
  __syncthreads();
}

DI void mla_q_tile(const Params& P, int pm, int pn, char* smem) {
  const bf16_t* proj = (const bf16_t*)(P.ws + OFF_PROJ); const int tid = opaque_tid(), m0 = pm * 256; float* rs = (float*)(smem + 131072);
  { const int row = tid >> 1, half = tid & 1; const bf16_t* p = proj + (size_t)(m0 + row) * DINP + C_BCQ + half * 224; float ss = 0.f;
    for (int i = 0; i < 28; ++i) { const u32x4 v = *(const u32x4*)(p + i * 8); float f[8]; unpack8(v, f);
#pragma unroll
      for (int e = 0; e < 8; ++e) ss += f[e] * f[e]; }
    ss += __shfl_xor(ss, 1); if (half == 0) rs[row] = rsqrtf(ss * (1.f / 448.f) + EPS); }
  EpiMlaQ epi{(float*)(P.ws + OFF_QRAW), rs, m0};
  gemm_tile(proj + C_BCQ, DINP, (const bf16_t*)(P.ws + OFF_W + W_UQ), 448, 448, m0, pn * 256, smem, epi);
  __syncthreads();
}
DI void mla_kv_tile(const Params& P, int pm, int pn, char* smem) {
  const bf16_t* proj = (const bf16_t*)(P.ws + OFF_PROJ); const int tid = opaque_tid(), m0 = pm * 256; float* rs = (float*)(smem + 131072);
  { const int row = tid >> 1, half = tid & 1; const bf16_t* p = proj + (size_t)(m0 + row) * DINP + C_BCKV + half * 64; float ss = 0.f;
#pragma unroll
    for (int i = 0; i < 8; ++i) { const u32x4 v = *(const u32x4*)(p + i * 8); float f[8]; unpack8(v, f);
#pragma unroll
      for (int e = 0; e < 8; ++e) ss += f[e] * f[e]; }
    ss += __shfl_xor(ss, 1); if (half == 0) rs[row] = rsqrtf(ss * (1.f / 128.f) + EPS); }
  bf16_t* kmla = (bf16_t*)(P.ws + OFF_KMLA);
  EpiMlaKV epi{kmla, (bf16_t*)(P.ws + OFF_VT), rs, m0};
  gemm_tile(proj + C_BCKV, DINP, (const bf16_t*)(P.ws + OFF_W + W_UKV), 128, 128, m0, pn * 256, smem, epi);
  if (pn == 0) {
    for (int i = 0; i < 16; ++i) { const int idx = tid + NT * i, row = idx >> 5, pi = idx & 31, m = m0 + row;
      const float x1 = bflo((unsigned)proj[(size_t)m * DINP + C_BKR + pi]), x2 = bflo((unsigned)proj[(size_t)m * DINP + C_BKR + 32 + pi]);
      double fr = (double)P.pos[m] * kInvFreq2Pi[pi]; fr -= floor(fr); const float ff = (float)fr;
      const float sn = __builtin_amdgcn_sinf(ff), cs = __builtin_amdgcn_cosf(ff);
      const bf16_t o1 = f2bf(x1 * cs - x2 * sn), o2 = f2bf(x2 * cs + x1 * sn);
#pragma unroll
      for (int hd = 0; hd < 4; ++hd) { bf16_t* kp = kmla + ((size_t)hd * S_ + m) * 192 + 128; kp[pi] = o1; kp[32 + pi] = o2; } }
  }
  __syncthreads();
}

DI void gdn_prep_item(const Params& P, int l, int n, int hh, char* smem) {
  const int tid = opaque_tid(), lane = tid & 63, w = tid >> 6, lq = lane & 31, h = lane >> 5;
  const bf16_t* proj = (const bf16_t*)(P.ws + OFF_PROJ); const float* ab = (const float*)(P.ws + OFF_AB);
  char* kb16 = smem; char* qb16 = smem + 17408;
  float* kf = (float*)(smem + 34816); float* vf = kf + 8192; float* Lm = vf + 8192; float* gcs = Lm + 4096;
  const size_t tile = (size_t)hh * 256 + n; const int t0 = n * 64;
  bf16_t* Wp = (bf16_t*)(P.ws + OFF_WP) + tile * 8192; bf16_t* Qd = (bf16_t*)(P.ws + OFF_QD) + tile * 8192;
  bf16_t* Kt = (bf16_t*)(P.ws + OFF_KT) + tile * 8192; bf16_t* Zt = (bf16_t*)(P.ws + OFF_ZT) + tile * 8192;
  bf16_t* QK = (bf16_t*)(P.ws + OFF_QK) + tile * 4096; bf16_t* Ut = (bf16_t*)(P.ws + OFF_UT) + tile * 8192;
  if (w == 0) {
    const int t = lane; const float a_raw = ab[(size_t)(t0 + t) * 16 + hh], b_raw = ab[(size_t)(t0 + t) * 16 + 8 + hh];
    const float Aa = expf(P.gdn_a_log[l * 8 + hh]); const float xb = a_raw + P.gdn_dt_bias[l * 8 + hh];
    const float sp = xb > 20.f ? xb : log1pf(expf(xb));
    float g = -Aa * sp;
#pragma unroll
    for (int d = 1; d < 64; d <<= 1) { const float v = __shfl_up(g, d); if (lane >= d) g += v; }
    const float bt = 1.f / (1.f + expf(-b_raw)), eg = expf(g); gcs[t] = g; gcs[64 + t] = bt; gcs[128 + t] = eg; gcs[192 + t] = bt * eg;
    if (t == 63) ((float*)(P.ws + OFF_GTOT))[tile] = expf(g);
  }
  __syncthreads();
  {
    const int t = tid >> 3, part = tid & 7, tabs = t0 + t;
    const float gct = gcs[t], egct = gcs[128 + t], ktl = expf(gcs[63] - gct);
    const int pjt = 32 * (t >> 5) + perm32(t & 31);
#pragma unroll
    for (int X = 0; X < 3; ++X) {
      const int cb = X * 1024 + hh * 128 + part * 16;
      float y[16];
#pragma unroll
      for (int e = 0; e < 16; ++e) y[e] = 0.f;
#pragma unroll
      for (int j = 0; j < 4; ++j) { const int row = tabs - 3 + j;
        if (row >= 0) { const u32x4 v0 = *(const u32x4*)(proj + (size_t)row * DINP + cb), v1 = *(const u32x4*)(proj + (size_t)row * DINP + cb + 8);
          float xv[16]; unpack8(v0, xv); unpack8(v1, xv + 8); const float* cw = P.gdn_conv + ((size_t)l * 4 + j) * 3072 + cb;
#pragma unroll
          for (int e4 = 0; e4 < 4; ++e4) { const f32x4 wv = *(const f32x4*)(cw + 4 * e4); y[4 * e4] += wv.x * xv[4 * e4]; y[4 * e4 + 1] += wv.y * xv[4 * e4 + 1]; y[4 * e4 + 2] += wv.z * xv[4 * e4 + 2]; y[4 * e4 + 3] += wv.w * xv[4 * e4 + 3]; } } }
#pragma unroll
      for (int e = 0; e < 16; ++e) y[e] = silu_f(y[e]);
      if (X < 2) { float ss = 0.f;
#pragma unroll
        for (int e = 0; e < 16; ++e) ss += y[e] * y[e];
        ss += __shfl_xor(ss, 1); ss += __shfl_xor(ss, 2); ss += __shfl_xor(ss, 4);
        const float rn = rsqrtf(ss + EPS) * (X == 0 ? 0.08838834764831845f : 1.f);
#pragma unroll
        for (int e = 0; e < 16; ++e) y[e] *= rn; }
      if (X == 0) {
        u32x4 p0 = {pack2(y[0], y[1]), pack2(y[2], y[3]), pack2(y[4], y[5]), pack2(y[6], y[7])}, p1 = {pack2(y[8], y[9]), pack2(y[10], y[11]), pack2(y[12], y[13]), pack2(y[14], y[15])};
        *(u32x4*)(qb16 + t * 272 + part * 32) = p0; *(u32x4*)(qb16 + t * 272 + part * 32 + 16) = p1;
#pragma unroll
        for (int b = 0; b < 4; ++b) { u32x2 pk = {pack2(y[4 * b] * egct, y[4 * b + 1] * egct), pack2(y[4 * b + 2] * egct, y[4 * b + 3] * egct)};
          *(u32x2*)(Qd + t * 128 + 32 * (part >> 1) + 8 * b + 4 * (part & 1)) = pk; }
      } else if (X == 1) {
        u32x4 p0 = {pack2(y[0], y[1]), pack2(y[2], y[3]), pack2(y[4], y[5]), pack2(y[6], y[7])}, p1 = {pack2(y[8], y[9]), pack2(y[10], y[11]), pack2(y[12], y[13]), pack2(y[14], y[15])};
        *(u32x4*)(kb16 + t * 272 + part * 32) = p0; *(u32x4*)(kb16 + t * 272 + part * 32 + 16) = p1;
#pragma unroll
        for (int e4 = 0; e4 < 4; ++e4) { f32x4 v = {y[4 * e4], y[4 * e4 + 1], y[4 * e4 + 2], y[4 * e4 + 3]}; *(f32x4*)(kf + t * 128 + part * 16 + 4 * e4) = v; }
#pragma unroll
        for (int e = 0; e < 16; ++e) Kt[(part * 16 + e) * 64 + pjt] = f2bf(y[e] * ktl);
      } else {
#pragma unroll
        for (int e4 = 0; e4 < 4; ++e4) { f32x4 v = {y[4 * e4], y[4 * e4 + 1], y[4 * e4 + 2], y[4 * e4 + 3]}; *(f32x4*)(vf + t * 128 + part * 16 + 4 * e4) = v; }
      }
    }
    { const int cb = C_AZ + hh * 128 + part * 16; const u32x4 v0 = *(const u32x4*)(proj + (size_t)tabs * DINP + cb), v1 = *(const u32x4*)(proj + (size_t)tabs * DINP + cb + 8);
      float zv[16]; unpack8(v0, zv); unpack8(v1, zv + 8);
#pragma unroll
      for (int e = 0; e < 16; ++e) Zt[(part * 16 + e) * 64 + t] = f2bf(silu_f(zv[e])); }
  }
  __syncthreads();
  {
    const int which = w >> 2, ti = (w >> 1) & 1, tj = w & 1; const char* Ab = which ? qb16 : kb16;
    f32x16 acc;
#pragma unroll
    for (int r = 0; r < 16; ++r) acc[r] = 0.f;
#pragma unroll
    for (int s = 0; s < 8; ++s) { const bf16x8 a = *(const bf16x8*)(Ab + (32 * ti + lq) * 272 + (16 * s + 8 * h) * 2), b = *(const bf16x8*)(kb16 + (32 * tj + lq) * 272 + (16 * s + 8 * h) * 2);
      acc = MFMA32(a, b, acc); }
    const int j = 32 * tj + lq; const float gj = gcs[j]; const int pj = 32 * (j >> 5) + perm32(j & 31);
#pragma unroll
    for (int r = 0; r < 16; ++r) { const int i = 32 * ti + crow(r, h); const float dec = __expf(fminf(gcs[i] - gj, 0.f));
      if (which == 0) Lm[i * 64 + j] = (j < i) ? gcs[64 + i] * acc[r] * dec : 0.f;
      else QK[i * 64 + pj] = f2bf((j <= i) ? acc[r] * dec : 0.f); }
  }
  __syncthreads();
  if (tid < 256) {
    const int c = tid; const bool isu = c < 128; const int cc = c & 127;
    const float* rp = (isu ? vf : kf) + cc; const float* sp = gcs + (isu ? 64 : 192);
    float x[64];
#pragma unroll
    for (int i = 0; i < 64; ++i) {
      float r = sp[i] * rp[i * 128];
#pragma unroll
      for (int j = 0; j < i; ++j) r = fmaf(-Lm[i * 64 + j], x[j], r);
      x[i] = r;
    }
    if (isu) {
#pragma unroll
      for (int i8 = 0; i8 < 8; ++i8) { u32x4 v = {pack2(x[8 * i8], x[8 * i8 + 1]), pack2(x[8 * i8 + 2], x[8 * i8 + 3]), pack2(x[8 * i8 + 4], x[8 * i8 + 5]), pack2(x[8 * i8 + 6], x[8 * i8 + 7])}; *(u32x4*)(Ut + cc * 64 + 8 * i8) = v; }
    } else {
      const int pp = 32 * (cc >> 5) + perm32(cc & 31);
#pragma unroll
      for (int i = 0; i < 64; ++i) Wp[i * 128 + pp] = f2bf(x[i]);
    }
  }
  __syncthreads();
}

DI bf16x8 pack_tiles(const f32x4& a, const f32x4& b) { return pack8(a.x, a.y, a.z, a.w, b.x, b.y, b.z, b.w); }
template <int CTRL> DI float dppf(float v) { return __int_as_float(__builtin_amdgcn_update_dpp(0, __float_as_int(v), CTRL, 0xf, 0xf, true)); }
DI float row16_sum(float v) { v += dppf<0xB1>(v); v += dppf<0x4E>(v); v += dppf<0x141>(v); v += dppf<0x140>(v); return v; }
constexpr size_t OFF_SSQP = OFF_GTOT + 8192;
static_assert(OFF_SSQP + (size_t)2 * S_ * 8 * 4 <= OFF_UT, "overlay3");
DI void gdn_scan_item(const Params& P, int l, int hh, int half, char* smem) {
  const int tid = opaque_tid(), lane = tid & 63, w = tid >> 6, l15 = lane & 15, q4 = lane >> 4;
  constexpr int OPB = 62464;
  float* sPart = (float*)(smem + 2 * OPB);
  const size_t hb = (size_t)hh * 256;
  const bf16_t* Wp = (const bf16_t*)(P.ws + OFF_WP) + hb * 8192; const bf16_t* Qd = (const bf16_t*)(P.ws + OFF_QD) + hb * 8192;
  const bf16_t* Kt = (const bf16_t*)(P.ws + OFF_KT) + hb * 8192; const bf16_t* Zt = (const bf16_t*)(P.ws + OFF_ZT) + hb * 8192;
  const bf16_t* QK = (const bf16_t*)(P.ws + OFF_QK) + hb * 4096; const bf16_t* Ut = (const bf16_t*)(P.ws + OFF_UT) + hb * 8192;
  const float* gt = (const float*)(P.ws + OFF_GTOT) + hb;
  float* ssqp = (float*)(P.ws + OFF_SSQP) + (size_t)half * S_ * 8;
  bf16_t* mixin = (bf16_t*)(P.ws + OFF_H);
  if (w >= 4) {
    const int lt = tid - 256;
    const int g256 = (lt >> 4) * 128 + (lt & 15) * 8, l256 = (lt >> 4) * 272 + (lt & 15) * 16;
    const int g128 = (lt >> 3) * 64 + (lt & 7) * 8, l128 = (lt >> 3) * 144 + (lt & 7) * 16;
    u32x4 pw[4], pq[4], pk[4], pqk[2];
#pragma unroll
    for (int i = 0; i < 4; ++i) { pw[i] = *(const u32x4*)(Wp + g256 + i * 2048); pq[i] = *(const u32x4*)(Qd + g256 + i * 2048); pk[i] = *(const u32x4*)(Kt + g128 + i * 2048); }
#pragma unroll
    for (int i = 0; i < 2; ++i) pqk[i] = *(const u32x4*)(QK + g128 + i * 2048);
#pragma unroll
    for (int i = 0; i < 4; ++i) { *(u32x4*)(smem + l256 + i * 4352) = pw[i]; *(u32x4*)(smem + 17408 + l256 + i * 4352) = pq[i]; *(u32x4*)(smem + 34816 + l128 + i * 4608) = pk[i]; }
#pragma unroll
    for (int i = 0; i < 2; ++i) *(u32x4*)(smem + 53248 + l128 + i * 4608) = pqk[i];
#pragma unroll
    for (int i = 0; i < 4; ++i) { pw[i] = *(const u32x4*)(Wp + 8192 + g256 + i * 2048); pq[i] = *(const u32x4*)(Qd + 8192 + g256 + i * 2048); pk[i] = *(const u32x4*)(Kt + 8192 + g128 + i * 2048); }
#pragma unroll
    for (int i = 0; i < 2; ++i) pqk[i] = *(const u32x4*)(QK + 4096 + g128 + i * 2048);
    __syncthreads();
#pragma unroll 1
    for (int n = 0; n < 256; ++n) {
      char* nb = smem + ((n + 1) & 1) * OPB;
      if (n + 1 < 256) {
#pragma unroll
        for (int i = 0; i < 4; ++i) { *(u32x4*)(nb + l256 + i * 4352) = pw[i]; *(u32x4*)(nb + 17408 + l256 + i * 4352) = pq[i]; *(u32x4*)(nb + 34816 + l128 + i * 4608) = pk[i]; }
#pragma unroll
        for (int i = 0; i < 2; ++i) *(u32x4*)(nb + 53248 + l128 + i * 4608) = pqk[i];
      }
      if (n + 2 < 256) { const size_t o8 = (size_t)(n + 2) * 8192, o4 = (size_t)(n + 2) * 4096;
#pragma unroll
        for (int i = 0; i < 4; ++i) { pw[i] = *(const u32x4*)(Wp + o8 + g256 + i * 2048); pq[i] = *(const u32x4*)(Qd + o8 + g256 + i * 2048); pk[i] = *(const u32x4*)(Kt + o8 + g128 + i * 2048); }
#pragma unroll
        for (int i = 0; i < 2; ++i) pqk[i] = *(const u32x4*)(QK + o4 + g128 + i * 2048); }
      __syncthreads();
    }
  } else {
    const int dvc = 64 * half + 16 * w + l15; const float nw = P.gdn_norm[l * 128 + dvc];
    const int uoff = dvc * 64 + 4 * q4;
    f32x4 St[8];
#pragma unroll
    for (int t = 0; t < 8; ++t) St[t] = (f32x4){0.f, 0.f, 0.f, 0.f};
    u32x2 uc[4], un[4], zc[4], zn[4]; float gcur, gn = 0.f;
#pragma unroll
    for (int it = 0; it < 4; ++it) { uc[it] = *(const u32x2*)(Ut + uoff + 16 * it); zc[it] = *(const u32x2*)(Zt + uoff + 16 * it); un[it] = uc[it]; zn[it] = zc[it]; }
    gcur = gt[0];
    __syncthreads();
#pragma unroll 2
    for (int n = 0; n < 256; ++n) {
      const char* cb = smem + (n & 1) * OPB;
      const char* sWp = cb; const char* sQd = cb + 17408; const char* sKt = cb + 34816; const char* sQK = cb + 53248;
      if (n + 1 < 256) { const size_t o8 = (size_t)(n + 1) * 8192;
#pragma unroll
        for (int it = 0; it < 4; ++it) { un[it] = *(const u32x2*)(Ut + o8 + uoff + 16 * it); zn[it] = *(const u32x2*)(Zt + o8 + uoff + 16 * it); }
        gn = gt[n + 1]; }
      bf16x8 sb[4];
#pragma unroll
      for (int ks = 0; ks < 4; ++ks) sb[ks] = pack_tiles(St[2 * ks], St[2 * ks + 1]);
      f32x4 wsv[4], qs[4];
#pragma unroll
      for (int it = 0; it < 4; ++it) { wsv[it] = (f32x4){0.f, 0.f, 0.f, 0.f}; qs[it] = (f32x4){0.f, 0.f, 0.f, 0.f}; }
#pragma unroll
      for (int it = 0; it < 4; ++it)
#pragma unroll
        for (int ks = 0; ks < 4; ++ks) { const int o = (16 * it + l15) * 272 + 64 * ks + 16 * q4;
          const bf16x8 a = *(const bf16x8*)(sWp + o), a2 = *(const bf16x8*)(sQd + o);
          wsv[it] = MFMA16(a, sb[ks], wsv[it]); qs[it] = MFMA16(a2, sb[ks], qs[it]); }
      f32x4 vn[4];
#pragma unroll
      for (int it = 0; it < 4; ++it) { const f32x4 uf = {bflo(uc[it].x), bfhi(uc[it].x), bflo(uc[it].y), bfhi(uc[it].y)}; vn[it] = uf - wsv[it]; }
      bf16x8 vb[2];
#pragma unroll
      for (int ks = 0; ks < 2; ++ks) vb[ks] = pack_tiles(vn[2 * ks], vn[2 * ks + 1]);
#pragma unroll
      for (int it = 0; it < 4; ++it)
#pragma unroll
        for (int ks = 0; ks < 2; ++ks) { const bf16x8 a = *(const bf16x8*)(sQK + (16 * it + l15) * 144 + 64 * ks + 16 * q4); qs[it] = MFMA16(a, vb[ks], qs[it]); }
#pragma unroll
      for (int t = 0; t < 8; ++t) { St[t] *= gcur;
#pragma unroll
        for (int ks = 0; ks < 2; ++ks) { const bf16x8 a = *(const bf16x8*)(sKt + (16 * t + l15) * 144 + 64 * ks + 16 * q4); St[t] = MFMA16(a, vb[ks], St[t]); } }
      float* sp = sPart + (n & 1) * 256;
#pragma unroll
      for (int it = 0; it < 4; ++it) {
        f32x4 ss = qs[it] * qs[it];
        ss.x = row16_sum(ss.x); ss.y = row16_sum(ss.y); ss.z = row16_sum(ss.z); ss.w = row16_sum(ss.w);
        if (l15 == 0) *(f32x4*)(sp + w * 64 + 16 * it + 4 * q4) = ss;
      }
      __syncthreads();
      if (w == 0) ssqp[(size_t)(64 * n + lane) * 8 + hh] = (sp[lane] + sp[64 + lane]) + (sp[128 + lane] + sp[192 + lane]);
#pragma unroll
      for (int it = 0; it < 4; ++it) {
        const float z0 = bflo(zc[it].x), z1 = bfhi(zc[it].x), z2 = bflo(zc[it].y), z3 = bfhi(zc[it].y);
        bf16_t* op = mixin + (size_t)(64 * n + 16 * it + 4 * q4) * 2048 + hh * 128 + dvc;
        op[0] = f2bf(qs[it].x * nw * z0); op[2048] = f2bf(qs[it].y * nw * z1);
        op[4096] = f2bf(qs[it].z * nw * z2); op[6144] = f2bf(qs[it].w * nw * z3);
      }
#pragma unroll
      for (int it = 0; it < 4; ++it) { uc[it] = un[it]; zc[it] = zn[it]; }
      gcur = gn;
    }
  }
  __syncthreads();
}
DI void gdn_fix_phase(const Params& P) {
  const int tid = opaque_tid();
  bf16_t* mixin = (bf16_t*)(P.ws + OFF_H); const float* ssqp = (const float*)(P.ws + OFF_SSQP);
  for (int idx = blockIdx.x * NT + tid; idx < S_ * 128; idx += gridDim.x * NT) {
    const int t = idx >> 7, ck = idx & 127, h = ck >> 4;
    const float r = rsqrtf((ssqp[(size_t)t * 8 + h] + ssqp[(size_t)S_ * 8 + (size_t)t * 8 + h]) * (1.f / 128.f) + EPS);
    u32x4* p = (u32x4*)(mixin + (size_t)t * 2048 + ck * 8); const u32x4 v = *p; float f[8]; unpack8(v, f);
    u32x4 o = {pack2(f[0] * r, f[1] * r), pack2(f[2] * r, f[3] * r), pack2(f[4] * r, f[5] * r), pack2(f[6] * r, f[7] * r)}; *p = o;
  }
}

DI void mla_attn_item(const Params& P, int hd, int b, char* smem) {
  const int tid = opaque_tid(), lane = tid & 63, w = tid >> 6, wq = w & 3, hk = w >> 2, lq = lane & 31, h = lane >> 5;
  const float* qraw = (const float*)(P.ws + OFF_QRAW);
  const bf16_t* Kg = (const bf16_t*)(P.ws + OFF_KMLA) + (size_t)hd * S_ * 192;
  const bf16_t* Vg = (const bf16_t*)(P.ws + OFF_VT) + (size_t)hd * 128 * S_;
  bf16_t* mixin = (bf16_t*)(P.ws + OFF_H);
  const int q = 128 * b + 32 * wq + lq;
  bf16x8 qf[12];
  {
    const float* qp = qraw + (size_t)q * 768 + hd * 192 + 8 * h;
    const float sc = 0.07216878364870322f * LOG2E;
#pragma unroll
    for (int s = 0; s < 8; ++s) { const f32x4 a = *(const f32x4*)(qp + 16 * s), c = *(const f32x4*)(qp + 16 * s + 4);
      qf[s] = pack8(a.x * sc, a.y * sc, a.z * sc, a.w * sc, c.x * sc, c.y * sc, c.z * sc, c.w * sc); }
    const double pq = (double)P.pos[q];
#pragma unroll
    for (int s2 = 0; s2 < 2; ++s2) {
      const f32x4 a0 = *(const f32x4*)(qp + 128 + 16 * s2), a1 = *(const f32x4*)(qp + 128 + 16 * s2 + 4);
      const f32x4 b0 = *(const f32x4*)(qp + 160 + 16 * s2), b1 = *(const f32x4*)(qp + 160 + 16 * s2 + 4);
      float x1[8] = {a0.x, a0.y, a0.z, a0.w, a1.x, a1.y, a1.z, a1.w}, x2[8] = {b0.x, b0.y, b0.z, b0.w, b1.x, b1.y, b1.z, b1.w}, o1[8], o2[8];
#pragma unroll
      for (int j = 0; j < 8; ++j) { double fr = pq * kInvFreq2Pi[16 * s2 + 8 * h + j]; fr -= floor(fr); const float ff = (float)fr;
        const float sn = __builtin_amdgcn_sinf(ff), cs = __builtin_amdgcn_cosf(ff);
        o1[j] = (x1[j] * cs - x2[j] * sn) * sc; o2[j] = (x2[j] * cs + x1[j] * sn) * sc; }
      qf[8 + s2] = pack8(o1[0], o1[1], o1[2], o1[3], o1[4], o1[5], o1[6], o1[7]);
      qf[10 + s2] = pack8(o2[0], o2[1], o2[2], o2[3], o2[4], o2[5], o2[6], o2[7]);
    }
  }
  constexpr int KST = 64 * 400, VST = 128 * 144, STG = KST + VST;
  f32x16 O[4];
#pragma unroll
  for (int i = 0; i < 4; ++i)
#pragma unroll
    for (int r = 0; r < 16; ++r) O[i][r] = 0.f;
  float m_i = -1e30f, l_i = 0.f;
  const int nt = 2 * b + 2;
  u32x4 rk[3], rv[2];
  const int vrow = tid >> 3, vcc = tid & 7;
#pragma unroll
  for (int i = 0; i < 3; ++i) { const int id = tid + NT * i, row = id / 24, cc = id % 24; rk[i] = *(const u32x4*)(Kg + row * 192 + cc * 8); }
#pragma unroll
  for (int i = 0; i < 2; ++i) rv[i] = *(const u32x4*)(Vg + (size_t)(vrow + 64 * i) * S_ + vcc * 8);
#pragma unroll
  for (int i = 0; i < 3; ++i) { const int id = tid + NT * i, row = id / 24, cc = id % 24; *(u32x4*)(smem + row * 400 + cc * 16) = rk[i]; }
#pragma unroll
  for (int i = 0; i < 2; ++i) *(u32x4*)(smem + KST + (vrow + 64 * i) * 144 + vcc * 16) = rv[i];
  __syncthreads();
  for (int kt = 0; kt < nt; ++kt) {
    const char* sK = smem + (kt & 1) * STG; const char* sV = sK + KST;
    const bool more = (kt + 1 < nt);
    if (more) { const size_t ko = (size_t)(kt + 1) * 64 * 192; const int vo = (kt + 1) * 64;
#pragma unroll
      for (int i = 0; i < 3; ++i) { const int id = tid + NT * i, row = id / 24, cc = id % 24; rk[i] = *(const u32x4*)(Kg + ko + row * 192 + cc * 8); }
#pragma unroll
      for (int i = 0; i < 2; ++i) rv[i] = *(const u32x4*)(Vg + (size_t)(vrow + 64 * i) * S_ + vo + vcc * 8); }
    const int key0 = 64 * kt + 32 * hk;
    if (key0 <= 128 * b + 32 * wq) {
      f32x16 st;
#pragma unroll
      for (int r = 0; r < 16; ++r) st[r] = 0.f;
#pragma unroll
      for (int s = 0; s < 12; ++s) { const bf16x8 kf = *(const bf16x8*)(sK + (32 * hk + lq) * 400 + (2 * s + h) * 16); st = MFMA32(kf, qf[s], st); }
      if (key0 + 31 > 128 * b + 32 * wq) {
        int qrel = q - key0 - 4 * h; asm volatile("" : "+v"(qrel));
#pragma unroll
        for (int r = 0; r < 16; ++r) if ((r & 3) + 8 * (r >> 2) > qrel) st[r] = -1e30f;
      }
      float mx = st[0];
#pragma unroll
      for (int r = 1; r < 16; ++r) mx = fmaxf(mx, st[r]);
      mx = fmaxf(mx, __shfl_xor(mx, 32));
      const float m_new = fmaxf(m_i, mx), alpha = exp2f(m_i - m_new);
      float ps = 0.f;
#pragma unroll
      for (int r = 0; r < 16; ++r) { st[r] = exp2f(st[r] - m_new); ps += st[r]; }
      l_i = l_i * alpha + ps; m_i = m_new;
#pragma unroll
      for (int i = 0; i < 4; ++i)
#pragma unroll
        for (int r = 0; r < 16; ++r) O[i][r] *= alpha;
      bf16x8 pf[2];
#pragma unroll
      for (int s = 0; s < 2; ++s) pf[s] = pack8(st[8 * s], st[8 * s + 1], st[8 * s + 2], st[8 * s + 3], st[8 * s + 4], st[8 * s + 5], st[8 * s + 6], st[8 * s + 7]);
#pragma unroll
      for (int i = 0; i < 4; ++i)
#pragma unroll
        for (int s = 0; s < 2; ++s) { const char* vp = sV + (32 * i + lq) * 144 + (32 * hk + 16 * s + 4 * h) * 2;
          const u32x2 lo = *(const u32x2*)vp, hi = *(const u32x2*)(vp + 16); u32x4 vv = {lo.x, lo.y, hi.x, hi.y};
          O[i] = MFMA32(__builtin_bit_cast(bf16x8, vv), pf[s], O[i]); }
    }
    if (more) { char* dK = smem + ((kt + 1) & 1) * STG;
#pragma unroll
      for (int i = 0; i < 3; ++i) { const int id = tid + NT * i, row = id / 24, cc = id % 24; *(u32x4*)(dK + row * 400 + cc * 16) = rk[i]; }
#pragma unroll
      for (int i = 0; i < 2; ++i) *(u32x4*)(dK + KST + (vrow + 64 * i) * 144 + vcc * 16) = rv[i]; }
    __syncthreads();
  }
  float* cO = (float*)smem; float* cm = cO + 4 * 4096; float* cl = cm + 256;
  if (hk == 1) {
#pragma unroll
    for (int i = 0; i < 4; ++i)
#pragma unroll
      for (int r = 0; r < 16; ++r) cO[wq * 4096 + (i * 16 + r) * 64 + lane] = O[i][r];
    cm[wq * 64 + lane] = m_i; cl[wq * 64 + lane] = l_i;
  }
  __syncthreads();
  if (hk == 0) {
    const float m1 = cm[wq * 64 + lane], l1 = cl[wq * 64 + lane];
    const float m = fmaxf(m_i, m1), a0 = exp2f(m_i - m), a1 = exp2f(m1 - m);
    float lt = l_i * a0 + l1 * a1; lt += __shfl_xor(lt, 32);
    const float inv = 1.f / lt;
    bf16_t* op = mixin + (size_t)q * 2048 + 1024 + hd * 128;
#pragma unroll
    for (int i = 0; i < 4; ++i)
#pragma unroll
      for (int rg = 0; rg < 4; ++rg) { float v[4];
#pragma unroll
        for (int e = 0; e < 4; ++e) v[e] = (O[i][4 * rg + e] * a0 + cO[wq * 4096 + (i * 16 + 4 * rg + e) * 64 + lane] * a1) * inv;
        u32x2 pk = {pack2(v[0], v[1]), pack2(v[2], v[3])}; *(u32x2*)(op + 32 * i + 8 * rg + 4 * h) = pk; }
  }
  __syncthreads();
}

DI void swa_item(const Params& P, int l, int n, int hk2, char* smem) {
  const int tid = opaque_tid(), lane = tid & 63, w = tid >> 6, lq = lane & 31, h = lane >> 5;
  const bf16_t* proj = (const bf16_t*)(P.ws + OFF_PROJ); bf16_t* mixin = (bf16_t*)(P.ws + OFF_H);
  bf16_t* sVt = (bf16_t*)smem;
#pragma unroll
  for (int i = 0; i < 4; ++i) { const int id = tid + NT * i, key = id >> 3, dc = id & 7; const int kp = 128 * (n - 1) + key;
    u32x4 v = {0u, 0u, 0u, 0u}; if (kp >= 0) v = *(const u32x4*)(proj + (size_t)kp * DINP + C_CV + hk2 * 64 + dc * 8);
    sVt[(8 * dc + 0) * 264 + key] = (bf16_t)(v.x & 0xffff); sVt[(8 * dc + 1) * 264 + key] = (bf16_t)(v.x >> 16);
    sVt[(8 * dc + 2) * 264 + key] = (bf16_t)(v.y & 0xffff); sVt[(8 * dc + 3) * 264 + key] = (bf16_t)(v.y >> 16);
    sVt[(8 * dc + 4) * 264 + key] = (bf16_t)(v.z & 0xffff); sVt[(8 * dc + 5) * 264 + key] = (bf16_t)(v.z >> 16);
    sVt[(8 * dc + 6) * 264 + key] = (bf16_t)(v.w & 0xffff); sVt[(8 * dc + 7) * 264 + key] = (bf16_t)(v.w >> 16); }
  __syncthreads();
  const int g = w >> 1, hq = hk2 * 4 + g;
  const float slope = exp2f(-(float)(hq + 1)) * LOG2E, sinkv = P.swa_sinks[l * 8 + hq] * LOG2E;
#pragma unroll 1
  for (int jj = 0; jj < 2; ++jj) {
    const int j = 2 * (w & 1) + jj; const int qrow = 128 * n + 32 * j + lq;
    bf16x8 qf[4];
#pragma unroll
    for (int s = 0; s < 4; ++s) qf[s] = *(const bf16x8*)(proj + (size_t)qrow * DINP + C_CQ + hq * 64 + 16 * s + 8 * h);
    f32x16 st[5];
    bf16x8 kf[2][4];
    { const int kp = 128 * (n - 1) + 32 * j + lq;
#pragma unroll
      for (int s = 0; s < 4; ++s) { kf[0][s] = (bf16x8){0, 0, 0, 0, 0, 0, 0, 0}; if (kp >= 0) kf[0][s] = *(const bf16x8*)(proj + (size_t)kp * DINP + C_CK + hk2 * 64 + 16 * s + 8 * h); } }
#pragma unroll
    for (int tt = 0; tt < 5; ++tt) {
      if (tt + 1 < 5) { const int kp = 128 * (n - 1) + 32 * (j + tt + 1) + lq;
#pragma unroll
        for (int s = 0; s < 4; ++s) { kf[(tt + 1) & 1][s] = (bf16x8){0, 0, 0, 0, 0, 0, 0, 0}; if (kp >= 0) kf[(tt + 1) & 1][s] = *(const bf16x8*)(proj + (size_t)kp * DINP + C_CK + hk2 * 64 + 16 * s + 8 * h); } }
      __builtin_amdgcn_sched_barrier(0);
#pragma unroll
      for (int r = 0; r < 16; ++r) st[tt][r] = 0.f;
#pragma unroll
      for (int s = 0; s < 4; ++s) st[tt] = MFMA32(kf[tt & 1][s], qf[s], st[tt]);
      __builtin_amdgcn_sched_barrier(0);
    }
    float mx = sinkv;
    int dbase = 128 + lq - 4 * h, kbase = 128 * (n - 1) + 32 * j + 4 * h;
    asm volatile("" : "+v"(dbase), "+v"(kbase));
#pragma unroll
    for (int tt = 0; tt < 5; ++tt)
#pragma unroll
      for (int r = 0; r < 16; ++r) { const int cst = 32 * tt + (r & 3) + 8 * (r >> 2); const int dist = dbase - cst; const int kpos = kbase + cst;
        const bool valid = (dist >= 0) && (dist < 128) && (kpos >= 0);
        const float sv = valid ? st[tt][r] * (0.125f * LOG2E) - slope * (float)dist : -1e30f; st[tt][r] = sv; mx = fmaxf(mx, sv); }
    mx = fmaxf(mx, __shfl_xor(mx, 32));
    float den = 0.f;
#pragma unroll
    for (int tt = 0; tt < 5; ++tt)
#pragma unroll
      for (int r = 0; r < 16; ++r) { const float p = exp2f(st[tt][r] - mx); st[tt][r] = p; den += p; }
    den += __shfl_xor(den, 32); den += exp2f(sinkv - mx);
    f32x16 O[2];
#pragma unroll
    for (int i = 0; i < 2; ++i)
#pragma unroll
      for (int r = 0; r < 16; ++r) O[i][r] = 0.f;
#pragma unroll
    for (int tt = 0; tt < 5; ++tt)
#pragma unroll
      for (int s = 0; s < 2; ++s) { const bf16x8 pf = pack8(st[tt][8 * s], st[tt][8 * s + 1], st[tt][8 * s + 2], st[tt][8 * s + 3], st[tt][8 * s + 4], st[tt][8 * s + 5], st[tt][8 * s + 6], st[tt][8 * s + 7]);
#pragma unroll
        for (int i = 0; i < 2; ++i) { const char* vp = (const char*)sVt + (32 * i + lq) * 528 + (32 * (j + tt) + 16 * s + 4 * h) * 2;
          const u32x2 lo = *(const u32x2*)vp, hi = *(const u32x2*)(vp + 16); u32x4 vv = {lo.x, lo.y, hi.x, hi.y};
          O[i] = MFMA32(__builtin_bit_cast(bf16x8, vv), pf, O[i]); }
        __builtin_amdgcn_sched_barrier(0); }
    const float inv = 1.f / den;
    bf16_t* op = mixin + (size_t)qrow * 2048 + 1536 + hq * 64;
#pragma unroll
    for (int i = 0; i < 2; ++i)
#pragma unroll
      for (int rg = 0; rg < 4; ++rg) { u32x2 pk = {pack2(O[i][4 * rg] * inv, O[i][4 * rg + 1] * inv), pack2(O[i][4 * rg + 2] * inv, O[i][4 * rg + 3] * inv)};
        *(u32x2*)(op + 32 * i + 8 * rg + 4 * h) = pk; }
  }
  __syncthreads();
}

DI float gelu_tanh(float x) { const float y = 0.7978845608028654f * (x + 0.044715f * x * x * x); const float t = 1.f - 2.f / (1.f + __expf(2.f * y)); return 0.5f * x * (1.f + t); }
DI void ffn_act_phase(const Params& P, int l) {
  const int tid = opaque_tid(), lane = tid & 63, w = tid >> 6;
  const bf16_t* u = (const bf16_t*)(P.ws + OFF_BIG); bf16_t* act = (bf16_t*)(P.ws + OFF_ACT);
  const float* cw = P.ffn_conv + (size_t)l * 3 * DFF2; const float* cb = P.ffn_conv_b + (size_t)l * DFF2;
  for (int item = blockIdx.x * 8 + w; item < 512 * 11; item += gridDim.x * 8) {
    const int cbk = item % 11, rr = item / 11; const int ch = cbk * 512 + lane * 8, r0 = rr * 32;
    float wg[3][8], wu[3][8], bg[8], bu[8];
#pragma unroll
    for (int j = 0; j < 3; ++j)
#pragma unroll
      for (int e4 = 0; e4 < 2; ++e4) { const f32x4 a = *(const f32x4*)(cw + (size_t)j * DFF2 + ch + 4 * e4), b = *(const f32x4*)(cw + (size_t)j * DFF2 + DFF + ch + 4 * e4);
        wg[j][4 * e4] = a.x; wg[j][4 * e4 + 1] = a.y; wg[j][4 * e4 + 2] = a.z; wg[j][4 * e4 + 3] = a.w; wu[j][4 * e4] = b.x; wu[j][4 * e4 + 1] = b.y; wu[j][4 * e4 + 2] = b.z; wu[j][4 * e4 + 3] = b.w; }
#pragma unroll
    for (int e4 = 0; e4 < 2; ++e4) { const f32x4 a = *(const f32x4*)(cb + ch + 4 * e4), b = *(const f32x4*)(cb + DFF + ch + 4 * e4);
      bg[4 * e4] = a.x; bg[4 * e4 + 1] = a.y; bg[4 * e4 + 2] = a.z; bg[4 * e4 + 3] = a.w; bu[4 * e4] = b.x; bu[4 * e4 + 1] = b.y; bu[4 * e4 + 2] = b.z; bu[4 * e4 + 3] = b.w; }
    float g2[8], g1[8], u2[8], u1[8];
#pragma unroll
    for (int e = 0; e < 8; ++e) { g2[e] = 0.f; g1[e] = 0.f; u2[e] = 0.f; u1[e] = 0.f; }
    if (r0 >= 2) { unpack8(*(const u32x4*)(u + (size_t)(r0 - 2) * DFF2 + ch), g2); unpack8(*(const u32x4*)(u + (size_t)(r0 - 2) * DFF2 + DFF + ch), u2);
      unpack8(*(const u32x4*)(u + (size_t)(r0 - 1) * DFF2 + ch), g1); unpack8(*(const u32x4*)(u + (size_t)(r0 - 1) * DFF2 + DFF + ch), u1); }
#pragma unroll 1
    for (int rb = 0; rb < 4; ++rb) {
      u32x4 G[8], U[8];
#pragma unroll
      for (int i = 0; i < 8; ++i) { const size_t ro = (size_t)(r0 + rb * 8 + i) * DFF2 + ch; G[i] = *(const u32x4*)(u + ro); U[i] = *(const u32x4*)(u + ro + DFF); }
#pragma unroll
      for (int i = 0; i < 8; ++i) {
        float g0[8], u0[8]; unpack8(G[i], g0); unpack8(U[i], u0);
        float o[8];
#pragma unroll
        for (int e = 0; e < 8; ++e) { const float yg = wg[0][e] * g2[e] + wg[1][e] * g1[e] + wg[2][e] * g0[e] + bg[e]; const float yu = wu[0][e] * u2[e] + wu[1][e] * u1[e] + wu[2][e] * u0[e] + bu[e];
          o[e] = gelu_tanh(yg) * yu; g2[e] = g1[e]; g1[e] = g0[e]; u2[e] = u1[e]; u1[e] = u0[e]; }
        u32x4 pk = {pack2(o[0], o[1]), pack2(o[2], o[3]), pack2(o[4], o[5]), pack2(o[6], o[7])};
        *(u32x4*)(act + (size_t)(r0 + rb * 8 + i) * DFF + ch) = pk;
      }
    }
  }
}

__global__ void __launch_bounds__(NT) fwd_megakernel(Params P0) {
  cg::grid_group grid = cg::this_grid();
  __shared__ __attribute__((aligned(16))) char smem[132352];
  const int tid = threadIdx.x;
  char* ws = P0.ws;
  int* ctrl = (int*)(ws + OFF_CTRL);
  if (blockIdx.x == 0 && tid < 64) ctrl[tid] = 0;
  if (blockIdx.x == 0 && tid == 0) *(Params*)(ws + OFF_CTRL + 1024) = P0;
  bf16_t* Hb = (bf16_t*)(ws + OFF_H);
  for (int it = blockIdx.x; it < 192 + CV_T5; it += gridDim.x) { if (it < 192) mod_item(P0, it); else convert_item(P0, 0, it - 192, smem); }
  grid.sync();
  const Params& P = *(const Params*)(ws + OFF_CTRL + 1024);
  rownorm_phase(P, P.x, nullptr, P.out, Hb, 0, 0, nullptr, 0, 1, 0, P.mix_pre, smem);
  grid.sync();
  for (int l = 0; l < 2; ++l) {
    { EpiProj epi{(bf16_t*)(ws + OFF_PROJ), (float*)(ws + OFF_AB)}; gemm_phase(Hb, 2048, (const bf16_t*)(ws + OFF_W + W_IN), 2048, 2048, 64, 22, smem, epi); }
    grid.sync();
    for (int it = blockIdx.x; it < 448 + 2048; it += gridDim.x) {
      if (it < 192) mla_q_tile(P, it / 3, it % 3, smem);
      else if (it < 448) mla_kv_tile(P, (it - 192) >> 2, (it - 192) & 3, smem);
      else { const int id = it - 448; gdn_prep_item(P, l, id >> 3, id & 7, smem); }
    }
    grid.sync();
    {
      int* sitem = (int*)(smem + 132096);
      for (;;) {
        if (tid == 0) *sitem = atomicAdd(ctrl + 16 * l, 1);
        __syncthreads(); const int item = *sitem; __syncthreads();
        if (item >= 16 + 512 + 256) break;
        if (item < 16) gdn_scan_item(P, l, item >> 1, item & 1, smem);
        else if (item < 528) { const int idx = item - 16; mla_attn_item(P, idx & 3, 127 - (idx >> 2), smem); }
        else { const int idx = item - 528; swa_item(P, l, idx >> 1, idx & 1, smem); }
      }
    }
    grid.sync();
    gdn_fix_phase(P);
    grid.sync();
    { EpiF32 epi{(float*)(ws + OFF_MIXF), 2048}; gemm_phase(Hb, 2048, (const bf16_t*)(ws + OFF_W + W_OUT), 2048, 2048, 64, 8, smem, epi); }
    grid.sync();
    rownorm_phase(P, P.out, (const float*)(ws + OFF_MIXF), P.out, Hb, l, 2, P.mix_post + l * 2048, l, 4, 3, P.ffn_pre + l * 2048, smem);
    grid.sync();
    { EpiBf epi{(bf16_t*)(ws + OFF_BIG), DFF2}; gemm_phase(Hb, 2048, (const bf16_t*)(ws + OFF_W + W_UP), 2048, 2048, 64, 44, smem, epi); }
    grid.sync();
    ffn_act_phase(P, l);
    grid.sync();
    { EpiF32 epi{(float*)(ws + OFF_Y), 2048}; gemm_phase((const bf16_t*)(ws + OFF_ACT), DFF, (const bf16_t*)(ws + OFF_W + W_DOWN), DFF, DFF, 64, 8, smem, epi); }
    grid.sync();
    if (l == 0) {
      for (int it = blockIdx.x; it < CV_T5; it += gridDim.x) convert_item(P, 1, it, smem);
      rownorm_phase(P, P.out, (const float*)(ws + OFF_Y), P.out, Hb, 0, 5, P.ffn_post, 1, 1, 0, P.mix_pre + 2048, smem);
      grid.sync();
    } else {
      rownorm_phase(P, P.out, (const float*)(ws + OFF_Y), P.out, nullptr, 1, 5, P.ffn_post + 2048, 1, 1, 0, nullptr, smem);
    }
  }
}

extern "C" void kernel_launch(void* const* d_in, const int* in_sizes, int n_in, void* d_out, int out_size, void* d_ws, size_t ws_size, hipStream_t stream) {
  static int grid_blocks = 0;
  if (!grid_blocks) {
    int dev = 0, cus = 0, per = 0;
    (void)hipGetDevice(&dev); (void)hipDeviceGetAttribute(&cus, hipDeviceAttributeMultiprocessorCount, dev);
    (void)hipOccupancyMaxActiveBlocksPerMultiprocessor(&per, fwd_megakernel, NT, 0);
    if (per > 1) per = 1;
    grid_blocks = cus * per; if (grid_blocks <= 0) grid_blocks = 256;
  }
  if (ws_size < OFF_END) { fprintf(stderr, "workspace too small: %zu < %zu\n", ws_size, (size_t)OFF_END); return; }
  Params p{};
  p.x = (const float*)d_in[0]; p.c = (const float*)d_in[1]; p.pos = (const int*)d_in[2];
  p.ada_w = (const float*)d_in[3]; p.ada_b = (const float*)d_in[4]; p.mix_pre = (const float*)d_in[5]; p.mix_post = (const float*)d_in[6];
  p.w_in = (const float*)d_in[7]; p.w_out = (const float*)d_in[8]; p.gdn_conv = (const float*)d_in[9]; p.gdn_a_log = (const float*)d_in[10];
  p.gdn_dt_bias = (const float*)d_in[11]; p.gdn_norm = (const float*)d_in[12]; p.mla_q_norm = (const float*)d_in[13]; p.mla_w_uq = (const float*)d_in[14];
  p.mla_kv_norm = (const float*)d_in[15]; p.mla_w_ukv = (const float*)d_in[16]; p.swa_sinks = (const float*)d_in[17]; p.ffn_pre = (const float*)d_in[18];
  p.ffn_post = (const float*)d_in[19]; p.ffn_w_up = (const float*)d_in[20]; p.ffn_conv = (const float*)d_in[21]; p.ffn_conv_b = (const float*)d_in[22];
  p.ffn_w_down = (const float*)d_in[23];
  p.out = (float*)d_out; p.ws = (char*)d_ws;
  void* args[] = {&p};
  hipError_t e = hipLaunchCooperativeKernel((void*)fwd_megakernel, dim3(grid_blocks), dim3(NT), args, 0, stream);
  if (e != hipSuccess) fprintf(stderr, "cooperative launch failed: %s (grid %d)\n", hipGetErrorString(e), grid_blocks);
}
```

```cpp
#include <hip/hip_runtime.h>
#include <hip/hip_cooperative_groups.h>
#include <cstdio>
#include <cstdint>
namespace cg = cooperative_groups;

#define DI __device__ __forceinline__
typedef unsigned short bf16_t;
typedef short bf16x8 __attribute__((ext_vector_type(8)));
typedef float f32x2 __attribute__((ext_vector_type(2)));
typedef float f32x4 __attribute__((ext_vector_type(4)));
typedef float f32x16 __attribute__((ext_vector_type(16)));
typedef unsigned u32x2 __attribute__((ext_vector_type(2)));
typedef unsigned u32x4 __attribute__((ext_vector_type(4)));
typedef __bf16 bf2_t __attribute__((ext_vector_type(2)));

constexpr int S_ = 16384, D_ = 2048, DINP = 5632, DFF = 5632, DFF2 = 11264;
constexpr int NT = 512;
constexpr float EPS = 1e-6f;
constexpr float LOG2E = 1.4426950408889634f;

constexpr size_t OFF_CTRL = 0;
constexpr size_t OFF_MODP = 4096;
constexpr size_t OFF_W = 2097152;
constexpr size_t W_IN = 0, W_OUT = W_IN + (size_t)5632 * 2048 * 2, W_UP = W_OUT + (size_t)2048 * 2048 * 2,
                 W_DOWN = W_UP + (size_t)11264 * 2048 * 2, W_UQ = W_DOWN + (size_t)2048 * 5632 * 2,
                 W_UKV = W_UQ + (size_t)768 * 448 * 2, W_END = W_UKV + (size_t)1024 * 128 * 2;
constexpr size_t OFF_H = OFF_W + W_END;
constexpr size_t OFF_MIXF = OFF_H + (size_t)S_ * 2048 * 2;
constexpr size_t OFF_QRAW = OFF_MIXF;
constexpr size_t OFF_KMLA = OFF_QRAW + (size_t)S_ * 768 * 4;
constexpr size_t OFF_VT = OFF_KMLA + (size_t)4 * S_ * 192 * 2;
constexpr size_t OFF_BIG = OFF_MIXF + (size_t)S_ * 2048 * 4;
constexpr size_t OFF_PROJ = OFF_BIG;
constexpr size_t OFF_WP = OFF_PROJ + (size_t)S_ * DINP * 2;
constexpr size_t OFF_QD = OFF_WP + (size_t)S_ * 1024 * 2;
constexpr size_t OFF_KT = OFF_QD + (size_t)S_ * 1024 * 2;
constexpr size_t OFF_ZT = OFF_KT + (size_t)S_ * 1024 * 2;
constexpr size_t OFF_QK = OFF_ZT + (size_t)S_ * 1024 * 2;
constexpr size_t OFF_AB = OFF_QK + (size_t)S_ * 512 * 2;
constexpr size_t OFF_GTOT = OFF_AB + (size_t)S_ * 16 * 4;
constexpr size_t OFF_Y = OFF_BIG;
constexpr size_t OFF_ACT = OFF_H;
constexpr size_t OFF_UT = OFF_BIG + (size_t)S_ * DFF2 * 2;
constexpr size_t OFF_END = OFF_UT + (size_t)S_ * 1024 * 4;
static_assert(OFF_GTOT + 8192 <= OFF_UT, "overlay");
static_assert(OFF_VT + (size_t)4 * 128 * S_ * 2 <= OFF_BIG, "overlay2");

constexpr int C_AQ = 0, C_AK = 1024, C_AV = 2048, C_AZ = 3072, C_AA = 4096, C_BCQ = 4112, C_BCKV = 4560,
              C_BKR = 4688, C_CQ = 4752, C_CK = 5264, C_CV = 5392;

__constant__ double kInvFreq2Pi[32] = {
    0.15915494309189535, 0.11934937021124886, 0.08949940160889101, 0.06711508300522726, 0.050329212104487035, 0.03774158471741977,
    0.0283021958306234, 0.02122365276477766, 0.015915494309189534, 0.011934937021124886, 0.008949940160889102, 0.006711508300522725,
    0.005032921210448704, 0.003774158471741977, 0.00283021958306234, 0.0021223652764777662, 0.0015915494309189536, 0.0011934937021124885,
    0.0008949940160889102, 0.0006711508300522726, 0.0005032921210448703, 0.00037741584717419774, 0.00028302195830623395, 0.0002122365276477766,
    0.00015915494309189535, 0.00011934937021124886, 8.949940160889102e-05, 6.711508300522725e-05, 5.0329212104487035e-05, 3.774158471741978e-05,
    2.8302195830623396e-05, 2.122365276477766e-05};

struct Params {
  const float* x; const float* c; const int* pos;
  const float *ada_w, *ada_b, *mix_pre, *mix_post, *w_in, *w_out, *gdn_conv, *gdn_a_log, *gdn_dt_bias, *gdn_norm, *mla_q_norm, *mla_w_uq,
      *mla_kv_norm, *mla_w_ukv, *swa_sinks, *ffn_pre, *ffn_post, *ffn_w_up, *ffn_conv, *ffn_conv_b, *ffn_w_down;
  float* out; char* ws;
};

DI unsigned pack2(float lo, float hi) { f32x2 v = {lo, hi}; bf2_t b = __builtin_convertvector(v, bf2_t); return __builtin_bit_cast(unsigned, b); }
DI bf16_t f2bf(float x) { return (bf16_t)(pack2(x, 0.f) & 0xffffu); }
DI float bflo(unsigned u) { return __uint_as_float(u << 16); }
DI float bfhi(unsigned u) { return __uint_as_float(u & 0xffff0000u); }
DI void unpack8(const u32x4& v, float* f) { f[0] = bflo(v.x); f[1] = bfhi(v.x); f[2] = bflo(v.y); f[3] = bfhi(v.y); f[4] = bflo(v.z); f[5] = bfhi(v.z); f[6] = bflo(v.w); f[7] = bfhi(v.w); }
DI bf16x8 pack8(float a0, float a1, float a2, float a3, float a4, float a5, float a6, float a7) {
  u32x4 p = {pack2(a0, a1), pack2(a2, a3), pack2(a4, a5), pack2(a6, a7)}; return __builtin_bit_cast(bf16x8, p); }
DI float silu_f(float x) { return x / (1.f + __expf(-x)); }
DI float wave_sum(float v) { v += __shfl_xor(v, 32); v += __shfl_xor(v, 16); v += __shfl_xor(v, 8); v += __shfl_xor(v, 4); v += __shfl_xor(v, 2); v += __shfl_xor(v, 1); return v; }
DI int opaque_tid() { int t = threadIdx.x; asm volatile("" : "+v"(t)); return t; }
DI int crow(int r, int h) { return (r & 3) + 8 * (r >> 2) + 4 * h; }
DI int perm32(int k) { return 8 * ((k >> 2) & 3) + 4 * (k >> 4) + (k & 3); }
#define MFMA32(a, b, c) __builtin_amdgcn_mfma_f32_32x32x16_bf16((a), (b), (c), 0, 0, 0)
#define MFMA16(a, b, c) __builtin_amdgcn_mfma_f32_16x16x32_bf16((a), (b), (c), 0, 0, 0)

template <class Epi>
DI void gemm_tile(const bf16_t* __restrict__ A, int lda, const bf16_t* __restrict__ Bt, int ldb, int K, int m0, int n0, char* smem, const Epi& epi) {
  const int tid = opaque_tid(), lane = tid & 63, w = tid >> 6, wm = w >> 2, wn = w & 3, lq = lane & 31, h = lane >> 5;
  f32x16 acc[2][4];
#pragma unroll
  for (int i = 0; i < 2; ++i)
#pragma unroll
    for (int j = 0; j < 4; ++j)
#pragma unroll
      for (int r = 0; r < 16; ++r) acc[i][j][r] = 0.f;
  const int r0 = tid >> 3, c0 = tid & 7;
  const bf16_t* ag = A + (size_t)(m0 + r0) * lda + c0 * 8;
  const bf16_t* bg = Bt + (size_t)(n0 + r0) * ldb + c0 * 8;
  const int wofs = r0 * 128 + ((c0 ^ ((r0 >> 1) & 7)) << 4);
  char* sA = smem; char* sB = smem + 65536;
  u32x4 ra0[4], rb0[4], ra1[4], rb1[4];
  const int nk = K >> 6, swz = (lane >> 1) & 7;
  const int aoff = (64 * wn + lq) * 128, boff = (128 * wm + lq) * 128;
#define GLOAD(RA, RB, KT) { _Pragma("unroll") for (int i = 0; i < 4; ++i) { RA[i] = *(const u32x4*)(ag + (size_t)(KT) * 64 + (size_t)i * 64 * lda); RB[i] = *(const u32x4*)(bg + (size_t)(KT) * 64 + (size_t)i * 64 * ldb); } }
#define LWRITE(RA, RB, ST) { _Pragma("unroll") for (int i = 0; i < 4; ++i) { *(u32x4*)(sA + (ST) * 32768 + wofs + i * 8192) = RA[i]; *(u32x4*)(sB + (ST) * 32768 + wofs + i * 8192) = RB[i]; } }
#define COMPUTE(ST) { const char* cA = sA + (ST) * 32768; const char* cB = sB + (ST) * 32768; \
    _Pragma("unroll") for (int s = 0; s < 4; ++s) { const int co = (((2 * s + h) ^ swz) << 4); bf16x8 fa[2], fb[4]; \
      _Pragma("unroll") for (int ni = 0; ni < 2; ++ni) fa[ni] = *(const bf16x8*)(cB + aoff + ni * 4096 + co); \
      _Pragma("unroll") for (int mi = 0; mi < 4; ++mi) fb[mi] = *(const bf16x8*)(cA + boff + mi * 4096 + co); \
      _Pragma("unroll") for (int ni = 0; ni < 2; ++ni) _Pragma("unroll") for (int mi = 0; mi < 4; ++mi) acc[ni][mi] = MFMA32(fa[ni], fb[mi], acc[ni][mi]); } }
  GLOAD(ra0, rb0, 0);
  if (nk > 1) GLOAD(ra1, rb1, 1);
  LWRITE(ra0, rb0, 0);
  if (nk > 2) GLOAD(ra0, rb0, 2);
  __syncthreads();
  for (int kt = 0; kt < nk; kt += 2) {
    if (kt + 1 < nk) LWRITE(ra1, rb1, 1);
    if (kt + 3 < nk) GLOAD(ra1, rb1, kt + 3);
    COMPUTE(0);
    __syncthreads();
    if (kt + 1 < nk) {
      if (kt + 2 < nk) LWRITE(ra0, rb0, 0);
      if (kt + 4 < nk) GLOAD(ra0, rb0, kt + 4);
      COMPUTE(1);
      __syncthreads();
    }
  }
#undef GLOAD
#undef LWRITE
#undef COMPUTE
#pragma unroll
  for (int ni = 0; ni < 2; ++ni)
#pragma unroll
    for (int mi = 0; mi < 4; ++mi)
#pragma unroll
      for (int rg = 0; rg < 4; ++rg) {
        const int m = m0 + 128 * wm + 32 * mi + lq, n = n0 + 64 * wn + 32 * ni + 8 * rg + 4 * h;
        epi(m, n, acc[ni][mi][4 * rg], acc[ni][mi][4 * rg + 1], acc[ni][mi][4 * rg + 2], acc[ni][mi][4 * rg + 3]);
      }
}

DI void tile_coord(int t, int npn, int& pm, int& pn) { const int g = t / (16 * npn), r = t % (16 * npn); pn = r >> 4; pm = g * 16 + (r & 15); }

struct EpiProj { bf16_t* proj; float* ab;
  DI void operator()(int m, int n, float v0, float v1, float v2, float v3) const {
    u32x2 pk = {pack2(v0, v1), pack2(v2, v3)}; *(u32x2*)(proj + (size_t)m * DINP + n) = pk;
    if (n >= C_AA && n < C_AA + 16) { f32x4 v = {v0, v1, v2, v3}; *(f32x4*)(ab + (size_t)m * 16 + (n - C_AA)) = v; } } };
struct EpiF32 { float* out; int ldc;
  DI void operator()(int m, int n, float v0, float v1, float v2, float v3) const { f32x4 v = {v0, v1, v2, v3}; *(f32x4*)(out + (size_t)m * ldc + n) = v; } };
struct EpiBf { bf16_t* out; int ldc;
  DI void operator()(int m, int n, float v0, float v1, float v2, float v3) const { u32x2 pk = {pack2(v0, v1), pack2(v2, v3)}; *(u32x2*)(out + (size_t)m * ldc + n) = pk; } };
struct EpiMlaQ { float* qraw; const float* rs; int m0;
  DI void operator()(int m, int n, float v0, float v1, float v2, float v3) const { const float r = rs[m - m0]; f32x4 v = {v0 * r, v1 * r, v2 * r, v3 * r}; *(f32x4*)(qraw + (size_t)m * 768 + n) = v; } };
struct EpiMlaKV { bf16_t* kmla; bf16_t* vt; const float* rs; int m0;
  DI void operator()(int m, int n, float v0, float v1, float v2, float v3) const {
    const float r = rs[m - m0]; const int hd = n >> 8, wi = n & 255;
    if (wi < 128) { u32x2 pk = {pack2(v0 * r, v1 * r), pack2(v2 * r, v3 * r)}; *(u32x2*)(kmla + ((size_t)hd * S_ + m) * 192 + wi) = pk; }
    else { bf16_t* p = vt + ((size_t)hd * 128 + (wi - 128)) * S_ + m; p[0] = f2bf(v0 * r); p[S_] = f2bf(v1 * r); p[2 * (size_t)S_] = f2bf(v2 * r); p[3 * (size_t)S_] = f2bf(v3 * r); } } };

template <class Epi>
DI void gemm_phase(const bf16_t* A, int lda, const bf16_t* Bt, int ldb, int K, int npm, int npn, char* smem, const Epi& epi) {
  for (int t = blockIdx.x; t < npm * npn; t += gridDim.x) { int pm, pn; tile_coord(t, npn, pm, pn); gemm_tile(A, lda, Bt, ldb, K, pm * 256, pn * 256, smem, epi); }
}

DI void mod_item(const Params& P, int item) {
  const int tid = opaque_tid(); const int l = item / 96, r = item % 96, ks = r / 6, nc = r % 6;
  const int n = nc * 2048 + tid * 4;
  const float* wp = P.ada_w + ((size_t)l * 2048 + ks * 128) * 12288 + n;
  f32x4 acc = {0.f, 0.f, 0.f, 0.f};
#pragma unroll 8
  for (int k = 0; k < 128; ++k) { const float cv = P.c[ks * 128 + k]; const float ca = silu_f(cv); const f32x4 wv = *(const f32x4*)(wp + (size_t)k * 12288); acc += wv * ca; }
  float* modp = (float*)(P.ws + OFF_MODP);
  *(f32x4*)(modp + ((size_t)l * 16 + ks) * 12288 + n) = acc;
}
DI void convert_tile(const float* __restrict__ src, int K, int N, bf16_t* __restrict__ dst, int tk, int tn, const float* rowscale, char* smem) {
  float* sm = (float*)smem; const int tid = opaque_tid(); const int k0 = tk * 64, n0 = tn * 256;
  { const int r = tid >> 6, c4 = tid & 63; const int n = n0 + 4 * c4;
    f32x4 v[8];
#pragma unroll
    for (int i = 0; i < 8; ++i) { v[i] = (f32x4){0.f, 0.f, 0.f, 0.f}; if (n < N) v[i] = *(const f32x4*)(src + (size_t)(k0 + r + 8 * i) * N + n); }
#pragma unroll
    for (int i = 0; i < 8; ++i) { const int kk = r + 8 * i; if (rowscale) v[i] *= rowscale[k0 + kk];
      sm[kk * 257 + 4 * c4 + 0] = v[i].x; sm[kk * 257 + 4 * c4 + 1] = v[i].y; sm[kk * 257 + 4 * c4 + 2] = v[i].z; sm[kk * 257 + 4 * c4 + 3] = v[i].w; } }
  __syncthreads();
  { const int n = tid >> 1, kh = tid & 1;
#pragma unroll
    for (int j = 0; j < 4; ++j) { float f[8];
#pragma unroll
      for (int i = 0; i < 8; ++i) f[i] = sm[(32 * kh + 8 * j + i) * 257 + n];
      u32x4 pk = {pack2(f[0], f[1]), pack2(f[2], f[3]), pack2(f[4], f[5]), pack2(f[6], f[7])};
      *(u32x4*)(dst + (size_t)(n0 + n) * K + k0 + 32 * kh + 8 * j) = pk; } }
  __syncthreads();
}
constexpr int CV_T0 = 32 * 22, CV_T1 = CV_T0 + 32 * 8, CV_T2 = CV_T1 + 32 * 44, CV_T3 = CV_T2 + 88 * 8, CV_T4 = CV_T3 + 7 * 3, CV_T5 = CV_T4 + 2 * 4;
DI void convert_item(const Params& P, int l, int it, char* smem) {
  char* wb = P.ws + OFF_W;
  if (it < CV_T0) convert_tile(P.w_in + (size_t)l * 2048 * 5520, 2048, 5520, (bf16_t*)(wb + W_IN), it / 22, it % 22, nullptr, smem);
  else if (it < CV_T1) { it -= CV_T0; convert_tile(P.w_out + (size_t)l * 2048 * 2048, 2048, 2048, (bf16_t*)(wb + W_OUT), it / 8, it % 8, nullptr, smem); }
  else if (it < CV_T2) { it -= CV_T1; convert_tile(P.ffn_w_up + (size_t)l * 2048 * 11264, 2048, 11264, (bf16_t*)(wb + W_UP), it / 44, it % 44, nullptr, smem); }
  else if (it < CV_T3) { it -= CV_T2; convert_tile(P.ffn_w_down + (size_t)l * 5632 * 2048, 5632, 2048, (bf16_t*)(wb + W_DOWN), it / 8, it % 8, nullptr, smem); }
  else if (it < CV_T4) { it -= CV_T3; convert_tile(P.mla_w_uq + (size_t)l * 448 * 768, 448, 768, (bf16_t*)(wb + W_UQ), it / 3, it % 3, P.mla_q_norm + l * 448, smem); }
  else { it -= CV_T4; convert_tile(P.mla_w_ukv + (size_t)l * 128 * 1024, 128, 1024, (bf16_t*)(wb + W_UKV), it / 4, it % 4, P.mla_kv_norm + l * 128, smem); }
}

DI float mod_val(const float* modp_l, const float* ada_b_l, int idx) { float s = ada_b_l[idx];
#pragma unroll
  for (int k = 0; k < 16; ++k) s += modp_l[(size_t)k * 12288 + idx]; return s; }
DI void rownorm_phase(const Params& P, const float* xin, const float* yin, float* xout, bf16_t* hout, int lg, int gate_idx, const float* w_post,
                      int lh, int scale_idx, int shift_idx, const float* w_pre, char* smem) {
  float* A1 = (float*)smem; float* A2 = A1 + 2048; float* B2 = A2 + 2048;
  const int tid = opaque_tid(), lane = tid & 63, w = tid >> 6;
  const float* modp = (const float*)(P.ws + OFF_MODP);
  for (int cidx = tid; cidx < 2048; cidx += NT) {
    if (yin) A1[cidx] = mod_val(modp + (size_t)lg * 16 * 12288, P.ada_b + (size_t)lg * 12288, gate_idx * 2048 + cidx) * w_post[cidx];
    if (hout) { A2[cidx] = w_pre[cidx] * (1.f + mod_val(modp + (size_t)lh * 16 * 12288, P.ada_b + (size_t)lh * 12288, scale_idx * 2048 + cidx));
      B2[cidx] = mod_val(modp + (size_t)lh * 16 * 12288, P.ada_b + (size_t)lh * 12288, shift_idx * 2048 + cidx); }
  }
  __syncthreads();
  for (int row = blockIdx.x * 8 + w; row < S_; row += gridDim.x * 8) {
    f32x4 xv[8];
#pragma unroll
    for (int j = 0; j < 8; ++j) xv[j] = *(const f32x4*)(xin + (size_t)row * 2048 + (j * 64 + lane) * 4);
    if (yin) {
      f32x4 yv[8]; float ss = 0.f;
#pragma unroll
      for (int j = 0; j < 8; ++j) { yv[j] = *(const f32x4*)(yin + (size_t)row * 2048 + (j * 64 + lane) * 4); ss += yv[j].x * yv[j].x + yv[j].y * yv[j].y + yv[j].z * yv[j].z + yv[j].w * yv[j].w; }
      ss = wave_sum(ss); const float r = rsqrtf(ss * (1.f / 2048.f) + EPS);
#pragma unroll
      for (int j = 0; j < 8; ++j) { const f32x4 a = *(const f32x4*)(A1 + (j * 64 + lane) * 4); xv[j] += a * (yv[j] * r); }
    }
    if (yin || xout != xin) {
#pragma unroll
      for (int j = 0; j < 8; ++j) *(f32x4*)(xout + (size_t)row * 2048 + (j * 64 + lane) * 4) = xv[j];
    }
    if (hout) {
      float ss = 0.f;
#pragma unroll
      for (int j = 0; j < 8; ++j) ss += xv[j].x * xv[j].x + xv[j].y * xv[j].y + xv[j].z * xv[j].z + xv[j].w * xv[j].w;
      ss = wave_sum(ss); const float r = rsqrtf(ss * (1.f / 2048.f) + EPS);
#pragma unroll
      for (int j = 0; j < 8; ++j) { const f32x4 a = *(const f32x4*)(A2 + (j * 64 + lane) * 4), b = *(const f32x4*)(B2 + (j * 64 + lane) * 4);
        const f32x4 hv = xv[j] * r * a + b; u32x2 pk = {pack2(hv.x, hv.y), pack2(hv.z, hv.w)};
        *(u32x2*)(hout + (size_t)row * 2048 + (j * 64 + lane) * 4) = pk; }
    }
  }
  __syncthreads();
}

DI void mla_q_tile(const Params& P, int pm, int pn, char* smem) {
  const bf16_t* proj = (const bf16_t*)(P.ws + OFF_PROJ); const int tid = opaque_tid(), m0 = pm * 256; float* rs = (float*)(smem + 131072);
  { const int row = tid >> 1, half = tid & 1; const bf16_t* p = proj + (size_t)(m0 + row) * DINP + C_BCQ + half * 224; float ss = 0.f;
    for (int i = 0; i < 28; ++i) { const u32x4 v = *(const u32x4*)(p + i * 8); float f[8]; unpack8(v, f);
#pragma unroll
      for (int e = 0; e < 8; ++e) ss += f[e] * f[e]; }
    ss += __shfl_xor(ss, 1); if (half == 0) rs[row] = rsqrtf(ss * (1.f / 448.f) + EPS); }
  EpiMlaQ epi{(float*)(P.ws + OFF_QRAW), rs, m0};
  gemm_tile(proj + C_BCQ, DINP, (const bf16_t*)(P.ws + OFF_W + W_UQ), 448, 448, m0, pn * 256, smem, epi);
  __syncthreads();
}
DI void mla_kv_tile(const Params& P, int pm, int pn, char* smem) {
  const bf16_t* proj = (const bf16_t*)(P.ws + OFF_PROJ); const int tid = opaque_tid(), m0 = pm * 256; float* rs = (float*)(smem + 131072);
  { const int row = tid >> 1, half = tid & 1; const bf16_t* p = proj + (size_t)(m0 + row) * DINP + C_BCKV + half * 64; float ss = 0.f;
#pragma unroll
    for (int i = 0; i < 8; ++i) { const u32x4 v = *(const u32x4*)(p + i * 8); float f[8]; unpack8(v, f);
#pragma unroll
      for (int e = 0; e < 8; ++e) ss += f[e] * f[e]; }
    ss += __shfl_xor(ss, 1); if (half == 0) rs[row] = rsqrtf(ss * (1.f / 128.f) + EPS); }
  bf16_t* kmla = (bf16_t*)(P.ws + OFF_KMLA);
  EpiMlaKV epi{kmla, (bf16_t*)(P.ws + OFF_VT), rs, m0};
  gemm_tile(proj + C_BCKV, DINP, (const bf16_t*)(P.ws + OFF_W + W_UKV), 128, 128, m0, pn * 256, smem, epi);
  if (pn == 0) {
    for (int i = 0; i < 16; ++i) { const int idx = tid + NT * i, row = idx >> 5, pi = idx & 31, m = m0 + row;
      const float x1 = bflo((unsigned)proj[(size_t)m * DINP + C_BKR + pi]), x2 = bflo((unsigned)proj[(size_t)m * DINP + C_BKR + 32 + pi]);
      double fr = (double)P.pos[m] * kInvFreq2Pi[pi]; fr -= floor(fr); const float ff = (float)fr;
      const float sn = __builtin_amdgcn_sinf(ff), cs = __builtin_amdgcn_cosf(ff);
      const bf16_t o1 = f2bf(x1 * cs - x2 * sn), o2 = f2bf(x2 * cs + x1 * sn);
#pragma unroll
      for (int hd = 0; hd < 4; ++hd) { bf16_t* kp = kmla + ((size_t)hd * S_ + m) * 192 + 128; kp[pi] = o1; kp[32 + pi] = o2; } }
  }
  __syncthreads();
}

DI void gdn_prep_item(const Params& P, int l, int n, int hh, char* smem) {
  const int tid = opaque_tid(), lane = tid & 63, w = tid >> 6, lq = lane & 31, h = lane >> 5;
  const bf16_t* proj = (const bf16_t*)(P.ws + OFF_PROJ); const float* ab = (const float*)(P.ws + OFF_AB);
  char* kb16 = smem; char* qb16 = smem + 17408;
  float* kf = (float*)(smem + 34816); float* vf = kf + 8192; float* Lm = vf + 8192; float* gcs = Lm + 4096;
  const size_t tile = (size_t)hh * 256 + n; const int t0 = n * 64;
  bf16_t* Wp = (bf16_t*)(P.ws + OFF_WP) + tile * 8192; bf16_t* Qd = (bf16_t*)(P.ws + OFF_QD) + tile * 8192;
  bf16_t* Kt = (bf16_t*)(P.ws + OFF_KT) + tile * 8192; bf16_t* Zt = (bf16_t*)(P.ws + OFF_ZT) + tile * 8192;
  bf16_t* QK = (bf16_t*)(P.ws + OFF_QK) + tile * 4096; bf16_t* Ut = (bf16_t*)(P.ws + OFF_UT) + tile * 8192;
  if (w == 0) {
    const int t = lane; const float a_raw = ab[(size_t)(t0 + t) * 16 + hh], b_raw = ab[(size_t)(t0 + t) * 16 + 8 + hh];
    const float Aa = __expf(P.gdn_a_log[l * 8 + hh]); const float xb = a_raw + P.gdn_dt_bias[l * 8 + hh];
    const float ex = __expf(fminf(xb, 20.f));
    const float sp = xb > 20.f ? xb : (ex < 0.01f ? ex * (1.f - ex * (0.5f - ex * (1.f / 3.f))) : __logf(1.f + ex));
    float g = -Aa * sp;
#pragma unroll
    for (int d = 1; d < 64; d <<= 1) { const float v = __shfl_up(g, d); if (lane >= d) g += v; }
    const float bt = 1.f / (1.f + __expf(-b_raw)), eg = __expf(g); gcs[t] = g; gcs[64 + t] = bt; gcs[128 + t] = eg; gcs[192 + t] = bt * eg;
    if (t == 63) ((float*)(P.ws + OFF_GTOT))[tile] = eg;
  }
  __syncthreads();
  {
    const int t = tid >> 3, part = tid & 7, tabs = t0 + t;
    const float gct = gcs[t], egct = gcs[128 + t], ktl = __expf(gcs[63] - gct);
    const int pjt = 32 * (t >> 5) + perm32(t & 31);
#pragma unroll
    for (int X = 0; X < 3; ++X) {
      const int cb = X * 1024 + hh * 128 + part * 16;
      float y[16];
#pragma unroll
      for (int e = 0; e < 16; ++e) y[e] = 0.f;
#pragma unroll
      for (int j = 0; j < 4; ++j) { const int row = tabs - 3 + j;
        if (row >= 0) { const u32x4 v0 = *(const u32x4*)(proj + (size_t)row * DINP + cb), v1 = *(const u32x4*)(proj + (size_t)row * DINP + cb + 8);
          float xv[16]; unpack8(v0, xv); unpack8(v1, xv + 8); const float* cw = P.gdn_conv + ((size_t)l * 4 + j) * 3072 + cb;
#pragma unroll
          for (int e4 = 0; e4 < 4; ++e4) { const f32x4 wv = *(const f32x4*)(cw + 4 * e4); y[4 * e4] += wv.x * xv[4 * e4]; y[4 * e4 + 1] += wv.y * xv[4 * e4 + 1]; y[4 * e4 + 2] += wv.z * xv[4 * e4 + 2]; y[4 * e4 + 3] += wv.w * xv[4 * e4 + 3]; } } }
#pragma unroll
      for (int e = 0; e < 16; ++e) y[e] = silu_f(y[e]);
      if (X < 2) { float ss = 0.f;
#pragma unroll
        for (int e = 0; e < 16; ++e) ss += y[e] * y[e];
        ss += __shfl_xor(ss, 1); ss += __shfl_xor(ss, 2); ss += __shfl_xor(ss, 4);
        const float rn = rsqrtf(ss + EPS) * (X == 0 ? 0.08838834764831845f : 1.f);
#pragma unroll
        for (int e = 0; e < 16; ++e) y[e] *= rn; }
      if (X == 0) {
        u32x4 p0 = {pack2(y[0], y[1]), pack2(y[2], y[3]), pack2(y[4], y[5]), pack2(y[6], y[7])}, p1 = {pack2(y[8], y[9]), pack2(y[10], y[11]), pack2(y[12], y[13]), pack2(y[14], y[15])};
        *(u32x4*)(qb16 + t * 272 + part * 32) = p0; *(u32x4*)(qb16 + t * 272 + part * 32 + 16) = p1;
#pragma unroll
        for (int b = 0; b < 4; ++b) { u32x2 pk = {pack2(y[4 * b] * egct, y[4 * b + 1] * egct), pack2(y[4 * b + 2] * egct, y[4 * b + 3] * egct)};
          *(u32x2*)(Qd + t * 128 + 32 * (part >> 1) + 8 * b + 4 * (part & 1)) = pk; }
      } else if (X == 1) {
        u32x4 p0 = {pack2(y[0], y[1]), pack2(y[2], y[3]), pack2(y[4], y[5]), pack2(y[6], y[7])}, p1 = {pack2(y[8], y[9]), pack2(y[10], y[11]), pack2(y[12], y[13]), pack2(y[14], y[15])};
        *(u32x4*)(kb16 + t * 272 + part * 32) = p0; *(u32x4*)(kb16 + t * 272 + part * 32 + 16) = p1;
#pragma unroll
        for (int e4 = 0; e4 < 4; ++e4) { f32x4 v = {y[4 * e4], y[4 * e4 + 1], y[4 * e4 + 2], y[4 * e4 + 3]}; *(f32x4*)(kf + t * 128 + part * 16 + 4 * e4) = v; }
#pragma unroll
        for (int e = 0; e < 16; ++e) Kt[(part * 16 + e) * 64 + pjt] = f2bf(y[e] * ktl);
      } else {
#pragma unroll
        for (int e4 = 0; e4 < 4; ++e4) { f32x4 v = {y[4 * e4], y[4 * e4 + 1], y[4 * e4 + 2], y[4 * e4 + 3]}; *(f32x4*)(vf + t * 128 + part * 16 + 4 * e4) = v; }
      }
    }
    { const int cb = C_AZ + hh * 128 + part * 16; const u32x4 v0 = *(const u32x4*)(proj + (size_t)tabs * DINP + cb), v1 = *(const u32x4*)(proj + (size_t)tabs * DINP + cb + 8);
      float zv[16]; unpack8(v0, zv); unpack8(v1, zv + 8);
#pragma unroll
      for (int e = 0; e < 16; ++e) Zt[(part * 16 + e) * 64 + t] = f2bf(silu_f(zv[e])); }
  }
  __syncthreads();
  {
    const int which = w >> 2, ti = (w >> 1) & 1, tj = w & 1; const char* Ab = which ? qb16 : kb16;
    f32x16 acc;
#pragma unroll
    for (int r = 0; r < 16; ++r) acc[r] = 0.f;
#pragma unroll
    for (int s = 0; s < 8; ++s) { const bf16x8 a = *(const bf16x8*)(Ab + (32 * ti + lq) * 272 + (16 * s + 8 * h) * 2), b = *(const bf16x8*)(kb16 + (32 * tj + lq) * 272 + (16 * s + 8 * h) * 2);
      acc = MFMA32(a, b, acc); }
    const int j = 32 * tj + lq; const float gj = gcs[j]; const int pj = 32 * (j >> 5) + perm32(j & 31);
#pragma unroll
    for (int r = 0; r < 16; ++r) { const int i = 32 * ti + crow(r, h); const float dec = __expf(fminf(gcs[i] - gj, 0.f));
      if (which == 0) Lm[i * 64 + j] = (j < i) ? gcs[64 + i] * acc[r] * dec : 0.f;
      else QK[i * 64 + pj] = f2bf((j <= i) ? acc[r] * dec : 0.f); }
  }
  __syncthreads();
  if (tid < 256) {
    const int c = tid; const bool isu = c < 128; const int cc = c & 127;
    const float* rp = (isu ? vf : kf) + cc; const float* sp = gcs + (isu ? 64 : 192);
    float x[64];
#pragma unroll
    for (int i = 0; i < 64; ++i) {
      float r = sp[i] * rp[i * 128];
#pragma unroll
      for (int j = 0; j < i; ++j) r = fmaf(-Lm[i * 64 + j], x[j], r);
      x[i] = r;
    }
    if (isu) {
#pragma unroll
      for (int i8 = 0; i8 < 8; ++i8) { u32x4 v = {pack2(x[8 * i8], x[8 * i8 + 1]), pack2(x[8 * i8 + 2], x[8 * i8 + 3]), pack2(x[8 * i8 + 4], x[8 * i8 + 5]), pack2(x[8 * i8 + 6], x[8 * i8 + 7])}; *(u32x4*)(Ut + cc * 64 + 8 * i8) = v; }
    } else {
      const int pp = 32 * (cc >> 5) + perm32(cc & 31);
#pragma unroll
      for (int i = 0; i < 64; ++i) Wp[i * 128 + pp] = f2bf(x[i]);
    }
  }
  __syncthreads();
}

DI bf16x8 pack_tiles(const f32x4& a, const f32x4& b) { return pack8(a.x, a.y, a.z, a.w, b.x, b.y, b.z, b.w); }
template <int CTRL> DI float dppf(float v) { return __int_as_float(__builtin_amdgcn_update_dpp(0, __float_as_int(v), CTRL, 0xf, 0xf, true)); }
DI float row16_sum(float v) { v += dppf<0xB1>(v); v += dppf<0x4E>(v); v += dppf<0x141>(v); v += dppf<0x140>(v); return v; }
constexpr size_t OFF_SSQP = OFF_GTOT + 8192;
static_assert(OFF_SSQP + (size_t)2 * S_ * 8 * 4 <= OFF_UT, "overlay3");
DI void gdn_scan_item(const Params& P, int l, int hh, int half, char* smem) {
  const int tid = opaque_tid(), lane = tid & 63, w = tid >> 6, l15 = lane & 15, q4 = lane >> 4;
  constexpr int OPB = 62464;
  float* sPart = (float*)(smem + 2 * OPB);
  const size_t hb = (size_t)hh * 256;
  const bf16_t* Wp = (const bf16_t*)(P.ws + OFF_WP) + hb * 8192; const bf16_t* Qd = (const bf16_t*)(P.ws + OFF_QD) + hb * 8192;
  const bf16_t* Kt = (const bf16_t*)(P.ws + OFF_KT) + hb * 8192; const bf16_t* Zt = (const bf16_t*)(P.ws + OFF_ZT) + hb * 8192;
  const bf16_t* QK = (const bf16_t*)(P.ws + OFF_QK) + hb * 4096; const bf16_t* Ut = (const bf16_t*)(P.ws + OFF_UT) + hb * 8192;
  const float* gt = (const float*)(P.ws + OFF_GTOT) + hb;
  float* ssqp = (float*)(P.ws + OFF_SSQP) + (size_t)half * S_ * 8;
  bf16_t* mixin = (bf16_t*)(P.ws + OFF_H);
  if (w >= 4) {
    const int lt = tid - 256;
    const int g256 = (lt >> 4) * 128 + (lt & 15) * 8, l256 = (lt >> 4) * 272 + (lt & 15) * 16;
    const int g128 = (lt >> 3) * 64 + (lt & 7) * 8, l128 = (lt >> 3) * 144 + (lt & 7) * 16;
    u32x4 pw[4], pq[4], pk[4], pqk[2];
#pragma unroll
    for (int i = 0; i < 4; ++i) { pw[i] = *(const u32x4*)(Wp + g256 + i * 2048); pq[i] = *(const u32x4*)(Qd + g256 + i * 2048); pk[i] = *(const u32x4*)(Kt + g128 + i * 2048); }
#pragma unroll
    for (int i = 0; i < 2; ++i) pqk[i] = *(const u32x4*)(QK + g128 + i * 2048);
#pragma unroll
    for (int i = 0; i < 4; ++i) { *(u32x4*)(smem + l256 + i * 4352) = pw[i]; *(u32x4*)(smem + 17408 + l256 + i * 4352) = pq[i]; *(u32x4*)(smem + 34816 + l128 + i * 4608) = pk[i]; }
#pragma unroll
    for (int i = 0; i < 2; ++i) *(u32x4*)(smem + 53248 + l128 + i * 4608) = pqk[i];
#pragma unroll
    for (int i = 0; i < 4; ++i) { pw[i] = *(const u32x4*)(Wp + 8192 + g256 + i * 2048); pq[i] = *(const u32x4*)(Qd + 8192 + g256 + i * 2048); pk[i] = *(const u32x4*)(Kt + 8192 + g128 + i * 2048); }
#pragma unroll
    for (int i = 0; i < 2; ++i) pqk[i] = *(const u32x4*)(QK + 4096 + g128 + i * 2048);
    __syncthreads();
#pragma unroll 1
    for (int n = 0; n < 256; ++n) {
      char* nb = smem + ((n + 1) & 1) * OPB;
      if (n + 1 < 256) {
#pragma unroll
        for (int i = 0; i < 4; ++i) { *(u32x4*)(nb + l256 + i * 4352) = pw[i]; *(u32x4*)(nb + 17408 + l256 + i * 4352) = pq[i]; *(u32x4*)(nb + 34816 + l128 + i * 4608) = pk[i]; }
#pragma unroll
        for (int i = 0; i < 2; ++i) *(u32x4*)(nb + 53248 + l128 + i * 4608) = pqk[i];
      }
      if (n + 2 < 256) { const size_t o8 = (size_t)(n + 2) * 8192, o4 = (size_t)(n + 2) * 4096;
#pragma unroll
        for (int i = 0; i < 4; ++i) { pw[i] = *(const u32x4*)(Wp + o8 + g256 + i * 2048); pq[i] = *(const u32x4*)(Qd + o8 + g256 + i * 2048); pk[i] = *(const u32x4*)(Kt + o8 + g128 + i * 2048); }
#pragma unroll
        for (int i = 0; i < 2; ++i) pqk[i] = *(const u32x4*)(QK + o4 + g128 + i * 2048); }
      __syncthreads();
    }
  } else {
    const int dvc = 64 * half + 16 * w + l15; const float nw = P.gdn_norm[l * 128 + dvc];
    const int uoff = dvc * 64 + 4 * q4;
    f32x4 St[8];
#pragma unroll
    for (int t = 0; t < 8; ++t) St[t] = (f32x4){0.f, 0.f, 0.f, 0.f};
    u32x2 uc[4], un[4], zc[4], zn[4]; float gcur, gn = 0.f;
#pragma unroll
    for (int it = 0; it < 4; ++it) { uc[it] = *(const u32x2*)(Ut + uoff + 16 * it); zc[it] = *(const u32x2*)(Zt + uoff + 16 * it); un[it] = uc[it]; zn[it] = zc[it]; }
    gcur = gt[0];
    __syncthreads();
#pragma unroll 2
    for (int n = 0; n < 256; ++n) {
      const char* cb = smem + (n & 1) * OPB;
      const char* sWp = cb; const char* sQd = cb + 17408; const char* sKt = cb + 34816; const char* sQK = cb + 53248;
      if (n + 1 < 256) { const size_t o8 = (size_t)(n + 1) * 8192;
#pragma unroll
        for (int it = 0; it < 4; ++it) { un[it] = *(const u32x2*)(Ut + o8 + uoff + 16 * it); zn[it] = *(const u32x2*)(Zt + o8 + uoff + 16 * it); }
        gn = gt[n + 1]; }
      bf16x8 sb[4];
#pragma unroll
      for (int ks = 0; ks < 4; ++ks) sb[ks] = pack_tiles(St[2 * ks], St[2 * ks + 1]);
      f32x4 wsv[4], qs[4];
#pragma unroll
      for (int it = 0; it < 4; ++it) { wsv[it] = (f32x4){0.f, 0.f, 0.f, 0.f}; qs[it] = (f32x4){0.f, 0.f, 0.f, 0.f}; }
#pragma unroll
      for (int it = 0; it < 4; ++it)
#pragma unroll
        for (int ks = 0; ks < 4; ++ks) { const int o = (16 * it + l15) * 272 + 64 * ks + 16 * q4;
          const bf16x8 a = *(const bf16x8*)(sWp + o), a2 = *(const bf16x8*)(sQd + o);
          wsv[it] = MFMA16(a, sb[ks], wsv[it]); qs[it] = MFMA16(a2, sb[ks], qs[it]); }
      f32x4 vn[4];
#pragma unroll
      for (int it = 0; it < 4; ++it) { const f32x4 uf = {bflo(uc[it].x), bfhi(uc[it].x), bflo(uc[it].y), bfhi(uc[it].y)}; vn[it] = uf - wsv[it]; }
      bf16x8 vb[2];
#pragma unroll
      for (int ks = 0; ks < 2; ++ks) vb[ks] = pack_tiles(vn[2 * ks], vn[2 * ks + 1]);
#pragma unroll
      for (int it = 0; it < 4; ++it)
#pragma unroll
        for (int ks = 0; ks < 2; ++ks) { const bf16x8 a = *(const bf16x8*)(sQK + (16 * it + l15) * 144 + 64 * ks + 16 * q4); qs[it] = MFMA16(a, vb[ks], qs[it]); }
#pragma unroll
      for (int t = 0; t < 8; ++t) { St[t] *= gcur;
#pragma unroll
        for (int ks = 0; ks < 2; ++ks) { const bf16x8 a = *(const bf16x8*)(sKt + (16 * t + l15) * 144 + 64 * ks + 16 * q4); St[t] = MFMA16(a, vb[ks], St[t]); } }
      float* sp = sPart + (n & 1) * 256;
#pragma unroll
      for (int it = 0; it < 4; ++it) {
        f32x4 ss = qs[it] * qs[it];
        ss.x = row16_sum(ss.x); ss.y = row16_sum(ss.y); ss.z = row16_sum(ss.z); ss.w = row16_sum(ss.w);
        if (l15 == 0) *(f32x4*)(sp + w * 64 + 16 * it + 4 * q4) = ss;
      }
      __syncthreads();
      if (w == 0) ssqp[(size_t)(64 * n + lane) * 8 + hh] = (sp[lane] + sp[64 + lane]) + (sp[128 + lane] + sp[192 + lane]);
#pragma unroll
      for (int it = 0; it < 4; ++it) {
        const float z0 = bflo(zc[it].x), z1 = bfhi(zc[it].x), z2 = bflo(zc[it].y), z3 = bfhi(zc[it].y);
        bf16_t* op = mixin + (size_t)(64 * n + 16 * it + 4 * q4) * 2048 + hh * 128 + dvc;
        op[0] = f2bf(qs[it].x * nw * z0); op[2048] = f2bf(qs[it].y * nw * z1);
        op[4096] = f2bf(qs[it].z * nw * z2); op[6144] = f2bf(qs[it].w * nw * z3);
      }
#pragma unroll
      for (int it = 0; it < 4; ++it) { uc[it] = un[it]; zc[it] = zn[it]; }
      gcur = gn;
    }
  }
  __syncthreads();
}
DI void gdn_fix_phase(const Params& P) {
  const int tid = opaque_tid();
  bf16_t* mixin = (bf16_t*)(P.ws + OFF_H); const float* ssqp = (const float*)(P.ws + OFF_SSQP);
  for (int idx = blockIdx.x * NT + tid; idx < S_ * 128; idx += gridDim.x * NT) {
    const int t = idx >> 7, ck = idx & 127, h = ck >> 4;
    const float r = rsqrtf((ssqp[(size_t)t * 8 + h] + ssqp[(size_t)S_ * 8 + (size_t)t * 8 + h]) * (1.f / 128.f) + EPS);
    u32x4* p = (u32x4*)(mixin + (size_t)t * 2048 + ck * 8); const u32x4 v = *p; float f[8]; unpack8(v, f);
    u32x4 o = {pack2(f[0] * r, f[1] * r), pack2(f[2] * r, f[3] * r), pack2(f[4] * r, f[5] * r), pack2(f[6] * r, f[7] * r)}; *p = o;
  }
}

DI void mla_attn_item(const Params& P, int hd, int b, char* smem) {
  const int tid = opaque_tid(), lane = tid & 63, w = tid >> 6, wq = w & 3, hk = w >> 2, lq = lane & 31, h = lane >> 5;
  const float* qraw = (const float*)(P.ws + OFF_QRAW);
  const bf16_t* Kg = (const bf16_t*)(P.ws + OFF_KMLA) + (size_t)hd * S_ * 192;
  const bf16_t* Vg = (const bf16_t*)(P.ws + OFF_VT) + (size_t)hd * 128 * S_;
  bf16_t* mixin = (bf16_t*)(P.ws + OFF_H);
  const int q = 128 * b + 32 * wq + lq;
  bf16x8 qf[12];
  {
    const float* qp = qraw + (size_t)q * 768 + hd * 192 + 8 * h;
    const float sc = 0.07216878364870322f * LOG2E;
#pragma unroll
    for (int s = 0; s < 8; ++s) { const f32x4 a = *(const f32x4*)(qp + 16 * s), c = *(const f32x4*)(qp + 16 * s + 4);
      qf[s] = pack8(a.x * sc, a.y * sc, a.z * sc, a.w * sc, c.x * sc, c.y * sc, c.z * sc, c.w * sc); }
    const double pq = (double)P.pos[q];
#pragma unroll
    for (int s2 = 0; s2 < 2; ++s2) {
      const f32x4 a0 = *(const f32x4*)(qp + 128 + 16 * s2), a1 = *(const f32x4*)(qp + 128 + 16 * s2 + 4);
      const f32x4 b0 = *(const f32x4*)(qp + 160 + 16 * s2), b1 = *(const f32x4*)(qp + 160 + 16 * s2 + 4);
      float x1[8] = {a0.x, a0.y, a0.z, a0.w, a1.x, a1.y, a1.z, a1.w}, x2[8] = {b0.x, b0.y, b0.z, b0.w, b1.x, b1.y, b1.z, b1.w}, o1[8], o2[8];
#pragma unroll
      for (int j = 0; j < 8; ++j) { double fr = pq * kInvFreq2Pi[16 * s2 + 8 * h + j]; fr -= floor(fr); const float ff = (float)fr;
        const float sn = __builtin_amdgcn_sinf(ff), cs = __builtin_amdgcn_cosf(ff);
        o1[j] = (x1[j] * cs - x2[j] * sn) * sc; o2[j] = (x2[j] * cs + x1[j] * sn) * sc; }
      qf[8 + s2] = pack8(o1[0], o1[1], o1[2], o1[3], o1[4], o1[5], o1[6], o1[7]);
      qf[10 + s2] = pack8(o2[0], o2[1], o2[2], o2[3], o2[4], o2[5], o2[6], o2[7]);
    }
  }
  constexpr int KST = 64 * 400, VST = 128 * 144, STG = KST + VST;
  f32x16 O[4];
#pragma unroll
  for (int i = 0; i < 4; ++i)
#pragma unroll
    for (int r = 0; r < 16; ++r) O[i][r] = 0.f;
  float m_i = -1e30f, l_i = 0.f;
  const int nt = 2 * b + 2;
  u32x4 rk[3], rv[2];
  const int vrow = tid >> 3, vcc = tid & 7;
#pragma unroll
  for (int i = 0; i < 3; ++i) { const int id = tid + NT * i, row = id / 24, cc = id % 24; rk[i] = *(const u32x4*)(Kg + row * 192 + cc * 8); }
#pragma unroll
  for (int i = 0; i < 2; ++i) rv[i] = *(const u32x4*)(Vg + (size_t)(vrow + 64 * i) * S_ + vcc * 8);
#pragma unroll
  for (int i = 0; i < 3; ++i) { const int id = tid + NT * i, row = id / 24, cc = id % 24; *(u32x4*)(smem + row * 400 + cc * 16) = rk[i]; }
#pragma unroll
  for (int i = 0; i < 2; ++i) *(u32x4*)(smem + KST + (vrow + 64 * i) * 144 + vcc * 16) = rv[i];
  __syncthreads();
  for (int kt = 0; kt < nt; ++kt) {
    const char* sK = smem + (kt & 1) * STG; const char* sV = sK + KST;
    const bool more = (kt + 1 < nt);
    if (more) { const size_t ko = (size_t)(kt + 1) * 64 * 192; const int vo = (kt + 1) * 64;
#pragma unroll
      for (int i = 0; i < 3; ++i) { const int id = tid + NT * i, row = id / 24, cc = id % 24; rk[i] = *(const u32x4*)(Kg + ko + row * 192 + cc * 8); }
#pragma unroll
      for (int i = 0; i < 2; ++i) rv[i] = *(const u32x4*)(Vg + (size_t)(vrow + 64 * i) * S_ + vo + vcc * 8); }
    const int key0 = 64 * kt + 32 * hk;
    if (key0 <= 128 * b + 32 * wq) {
      f32x16 st;
#pragma unroll
      for (int r = 0; r < 16; ++r) st[r] = 0.f;
#pragma unroll
      for (int s = 0; s < 12; ++s) { const bf16x8 kf = *(const bf16x8*)(sK + (32 * hk + lq) * 400 + (2 * s + h) * 16); st = MFMA32(kf, qf[s], st); }
      if (key0 + 31 > 128 * b + 32 * wq) {
        int qrel = q - key0 - 4 * h; asm volatile("" : "+v"(qrel));
#pragma unroll
        for (int r = 0; r < 16; ++r) if ((r & 3) + 8 * (r >> 2) > qrel) st[r] = -1e30f;
      }
      float mx = st[0];
#pragma unroll
      for (int r = 1; r < 16; ++r) mx = fmaxf(mx, st[r]);
      mx = fmaxf(mx, __shfl_xor(mx, 32));
      const float m_new = fmaxf(m_i, mx), alpha = exp2f(m_i - m_new);
      float ps = 0.f;
#pragma unroll
      for (int r = 0; r < 16; ++r) { st[r] = exp2f(st[r] - m_new); ps += st[r]; }
      l_i = l_i * alpha + ps; m_i = m_new;
#pragma unroll
      for (int i = 0; i < 4; ++i)
#pragma unroll
        for (int r = 0; r < 16; ++r) O[i][r] *= alpha;
      bf16x8 pf[2];
#pragma unroll
      for (int s = 0; s < 2; ++s) pf[s] = pack8(st[8 * s], st[8 * s + 1], st[8 * s + 2], st[8 * s + 3], st[8 * s + 4], st[8 * s + 5], st[8 * s + 6], st[8 * s + 7]);
#pragma unroll
      for (int i = 0; i < 4; ++i)
#pragma unroll
        for (int s = 0; s < 2; ++s) { const char* vp = sV + (32 * i + lq) * 144 + (32 * hk + 16 * s + 4 * h) * 2;
          const u32x2 lo = *(const u32x2*)vp, hi = *(const u32x2*)(vp + 16); u32x4 vv = {lo.x, lo.y, hi.x, hi.y};
          O[i] = MFMA32(__builtin_bit_cast(bf16x8, vv), pf[s], O[i]); }
    }
    if (more) { char* dK = smem + ((kt + 1) & 1) * STG;
#pragma unroll
      for (int i = 0; i < 3; ++i) { const int id = tid + NT * i, row = id / 24, cc = id % 24; *(u32x4*)(dK + row * 400 + cc * 16) = rk[i]; }
#pragma unroll
      for (int i = 0; i < 2; ++i) *(u32x4*)(dK + KST + (vrow + 64 * i) * 144 + vcc * 16) = rv[i]; }
    __syncthreads();
  }
  float* cO = (float*)smem; float* cm = cO + 4 * 4096; float* cl = cm + 256;
  if (hk == 1) {
#pragma unroll
    for (int i = 0; i < 4; ++i)
#pragma unroll
      for (int r = 0; r < 16; ++r) cO[wq * 4096 + (i * 16 + r) * 64 + lane] = O[i][r];
    cm[wq * 64 + lane] = m_i; cl[wq * 64 + lane] = l_i;
  }
  __syncthreads();
  if (hk == 0) {
    const float m1 = cm[wq * 64 + lane], l1 = cl[wq * 64 + lane];
    const float m = fmaxf(m_i, m1), a0 = exp2f(m_i - m), a1 = exp2f(m1 - m);
    float lt = l_i * a0 + l1 * a1; lt += __shfl_xor(lt, 32);
    const float inv = 1.f / lt;
    bf16_t* op = mixin + (size_t)q * 2048 + 1024 + hd * 128;
#pragma unroll
    for (int i = 0; i < 4; ++i)
#pragma unroll
      for (int rg = 0; rg < 4; ++rg) { float v[4];
#pragma unroll
        for (int e = 0; e < 4; ++e) v[e] = (O[i][4 * rg + e] * a0 + cO[wq * 4096 + (i * 16 + 4 * rg + e) * 64 + lane] * a1) * inv;
        u32x2 pk = {pack2(v[0], v[1]), pack2(v[2], v[3])}; *(u32x2*)(op + 32 * i + 8 * rg + 4 * h) = pk; }
  }
  __syncthreads();
}

DI void swa_item(const Params& P, int l, int n, int hk2, char* smem) {
  const int tid = opaque_tid(), lane = tid & 63, w = tid >> 6, lq = lane & 31, h = lane >> 5;
  const bf16_t* proj = (const bf16_t*)(P.ws + OFF_PROJ); bf16_t* mixin = (bf16_t*)(P.ws + OFF_H);
  bf16_t* sVt = (bf16_t*)smem;
#pragma unroll
  for (int i = 0; i < 4; ++i) { const int id = tid + NT * i, key = id >> 3, dc = id & 7; const int kp = 128 * (n - 1) + key;
    u32x4 v = {0u, 0u, 0u, 0u}; if (kp >= 0) v = *(const u32x4*)(proj + (size_t)kp * DINP + C_CV + hk2 * 64 + dc * 8);
    sVt[(8 * dc + 0) * 264 + key] = (bf16_t)(v.x & 0xffff); sVt[(8 * dc + 1) * 264 + key] = (bf16_t)(v.x >> 16);
    sVt[(8 * dc + 2) * 264 + key] = (bf16_t)(v.y & 0xffff); sVt[(8 * dc + 3) * 264 + key] = (bf16_t)(v.y >> 16);
    sVt[(8 * dc + 4) * 264 + key] = (bf16_t)(v.z & 0xffff); sVt[(8 * dc + 5) * 264 + key] = (bf16_t)(v.z >> 16);
    sVt[(8 * dc + 6) * 264 + key] = (bf16_t)(v.w & 0xffff); sVt[(8 * dc + 7) * 264 + key] = (bf16_t)(v.w >> 16); }
  __syncthreads();
  const int g = w >> 1, hq = hk2 * 4 + g;
  const float slope = exp2f(-(float)(hq + 1)) * LOG2E, sinkv = P.swa_sinks[l * 8 + hq] * LOG2E;
#pragma unroll 1
  for (int jj = 0; jj < 2; ++jj) {
    const int j = 2 * (w & 1) + jj; const int qrow = 128 * n + 32 * j + lq;
    bf16x8 qf[4];
#pragma unroll
    for (int s = 0; s < 4; ++s) qf[s] = *(const bf16x8*)(proj + (size_t)qrow * DINP + C_CQ + hq * 64 + 16 * s + 8 * h);
    f32x16 st[5];
    bf16x8 kf[2][4];
    { const int kp = 128 * (n - 1) + 32 * j + lq;
#pragma unroll
      for (int s = 0; s < 4; ++s) { kf[0][s] = (bf16x8){0, 0, 0, 0, 0, 0, 0, 0}; if (kp >= 0) kf[0][s] = *(const bf16x8*)(proj + (size_t)kp * DINP + C_CK + hk2 * 64 + 16 * s + 8 * h); } }
#pragma unroll
    for (int tt = 0; tt < 5; ++tt) {
      if (tt + 1 < 5) { const int kp = 128 * (n - 1) + 32 * (j + tt + 1) + lq;
#pragma unroll
        for (int s = 0; s < 4; ++s) { kf[(tt + 1) & 1][s] = (bf16x8){0, 0, 0, 0, 0, 0, 0, 0}; if (kp >= 0) kf[(tt + 1) & 1][s] = *(const bf16x8*)(proj + (size_t)kp * DINP + C_CK + hk2 * 64 + 16 * s + 8 * h); } }
      __builtin_amdgcn_sched_barrier(0);
#pragma unroll
      for (int r = 0; r < 16; ++r) st[tt][r] = 0.f;
#pragma unroll
      for (int s = 0; s < 4; ++s) st[tt] = MFMA32(kf[tt & 1][s], qf[s], st[tt]);
      __builtin_amdgcn_sched_barrier(0);
    }
    float mx = sinkv;
    int dbase = 128 + lq - 4 * h, kbase = 128 * (n - 1) + 32 * j + 4 * h;
    asm volatile("" : "+v"(dbase), "+v"(kbase));
#pragma unroll
    for (int tt = 0; tt < 5; ++tt)
#pragma unroll
      for (int r = 0; r < 16; ++r) { const int cst = 32 * tt + (r & 3) + 8 * (r >> 2); const int dist = dbase - cst; const int kpos = kbase + cst;
        const bool valid = (dist >= 0) && (dist < 128) && (kpos >= 0);
        const float sv = valid ? st[tt][r] * (0.125f * LOG2E) - slope * (float)dist : -1e30f; st[tt][r] = sv; mx = fmaxf(mx, sv); }
    mx = fmaxf(mx, __shfl_xor(mx, 32));
    float den = 0.f;
#pragma unroll
    for (int tt = 0; tt < 5; ++tt)
#pragma unroll
      for (int r = 0; r < 16; ++r) { const float p = exp2f(st[tt][r] - mx); st[tt][r] = p; den += p; }
    den += __shfl_xor(den, 32); den += exp2f(sinkv - mx);
    f32x16 O[2];
#pragma unroll
    for (int i = 0; i < 2; ++i)
#pragma unroll
      for (int r = 0; r < 16; ++r) O[i][r] = 0.f;
#pragma unroll
    for (int tt = 0; tt < 5; ++tt)
#pragma unroll
      for (int s = 0; s < 2; ++s) { const bf16x8 pf = pack8(st[tt][8 * s], st[tt][8 * s + 1], st[tt][8 * s + 2], st[tt][8 * s + 3], st[tt][8 * s + 4], st[tt][8 * s + 5], st[tt][8 * s + 6], st[tt][8 * s + 7]);
#pragma unroll
        for (int i = 0; i < 2; ++i) { const char* vp = (const char*)sVt + (32 * i + lq) * 528 + (32 * (j + tt) + 16 * s + 4 * h) * 2;
          const u32x2 lo = *(const u32x2*)vp, hi = *(const u32x2*)(vp + 16); u32x4 vv = {lo.x, lo.y, hi.x, hi.y};
          O[i] = MFMA32(__builtin_bit_cast(bf16x8, vv), pf, O[i]); }
        __builtin_amdgcn_sched_barrier(0); }
    const float inv = 1.f / den;
    bf16_t* op = mixin + (size_t)qrow * 2048 + 1536 + hq * 64;
#pragma unroll
    for (int i = 0; i < 2; ++i)
#pragma unroll
      for (int rg = 0; rg < 4; ++rg) { u32x2 pk = {pack2(O[i][4 * rg] * inv, O[i][4 * rg + 1] * inv), pack2(O[i][4 * rg + 2] * inv, O[i][4 * rg + 3] * inv)};
        *(u32x2*)(op + 32 * i + 8 * rg + 4 * h) = pk; }
  }
  __syncthreads();
}

DI float gelu_tanh(float x) { const float y = 0.7978845608028654f * (x + 0.044715f * x * x * x); const float t = 1.f - 2.f / (1.f + __expf(2.f * y)); return 0.5f * x * (1.f + t); }
DI void ffn_act_phase(const Params& P, int l) {
  const int tid = opaque_tid(), lane = tid & 63, w = tid >> 6;
  const bf16_t* u = (const bf16_t*)(P.ws + OFF_BIG); bf16_t* act = (bf16_t*)(P.ws + OFF_ACT);
  const float* cw = P.ffn_conv + (size_t)l * 3 * DFF2; const float* cb = P.ffn_conv_b + (size_t)l * DFF2;
  for (int item = blockIdx.x * 8 + w; item < 512 * 11; item += gridDim.x * 8) {
    const int cbk = item % 11, rr = item / 11; const int ch = cbk * 512 + lane * 8, r0 = rr * 32;
    float wg[3][8], wu[3][8], bg[8], bu[8];
#pragma unroll
    for (int j = 0; j < 3; ++j)
#pragma unroll
      for (int e4 = 0; e4 < 2; ++e4) { const f32x4 a = *(const f32x4*)(cw + (size_t)j * DFF2 + ch + 4 * e4), b = *(const f32x4*)(cw + (size_t)j * DFF2 + DFF + ch + 4 * e4);
        wg[j][4 * e4] = a.x; wg[j][4 * e4 + 1] = a.y; wg[j][4 * e4 + 2] = a.z; wg[j][4 * e4 + 3] = a.w; wu[j][4 * e4] = b.x; wu[j][4 * e4 + 1] = b.y; wu[j][4 * e4 + 2] = b.z; wu[j][4 * e4 + 3] = b.w; }
#pragma unroll
    for (int e4 = 0; e4 < 2; ++e4) { const f32x4 a = *(const f32x4*)(cb + ch + 4 * e4), b = *(const f32x4*)(cb + DFF + ch + 4 * e4);
      bg[4 * e4] = a.x; bg[4 * e4 + 1] = a.y; bg[4 * e4 + 2] = a.z; bg[4 * e4 + 3] = a.w; bu[4 * e4] = b.x; bu[4 * e4 + 1] = b.y; bu[4 * e4 + 2] = b.z; bu[4 * e4 + 3] = b.w; }
    float g2[8], g1[8], u2[8], u1[8];
#pragma unroll
    for (int e = 0; e < 8; ++e) { g2[e] = 0.f; g1[e] = 0.f; u2[e] = 0.f; u1[e] = 0.f; }
    if (r0 >= 2) { unpack8(*(const u32x4*)(u + (size_t)(r0 - 2) * DFF2 + ch), g2); unpack8(*(const u32x4*)(u + (size_t)(r0 - 2) * DFF2 + DFF + ch), u2);
      unpack8(*(const u32x4*)(u + (size_t)(r0 - 1) * DFF2 + ch), g1); unpack8(*(const u32x4*)(u + (size_t)(r0 - 1) * DFF2 + DFF + ch), u1); }
#pragma unroll 1
    for (int rb = 0; rb < 4; ++rb) {
      u32x4 G[8], U[8];
#pragma unroll
      for (int i = 0; i < 8; ++i) { const size_t ro = (size_t)(r0 + rb * 8 + i) * DFF2 + ch; G[i] = *(const u32x4*)(u + ro); U[i] = *(const u32x4*)(u + ro + DFF); }
#pragma unroll
      for (int i = 0; i < 8; ++i) {
        float g0[8], u0[8]; unpack8(G[i], g0); unpack8(U[i], u0);
        float o[8];
#pragma unroll
        for (int e = 0; e < 8; ++e) { const float yg = wg[0][e] * g2[e] + wg[1][e] * g1[e] + wg[2][e] * g0[e] + bg[e]; const float yu = wu[0][e] * u2[e] + wu[1][e] * u1[e] + wu[2][e] * u0[e] + bu[e];
          o[e] = gelu_tanh(yg) * yu; g2[e] = g1[e]; g1[e] = g0[e]; u2[e] = u1[e]; u1[e] = u0[e]; }
        u32x4 pk = {pack2(o[0], o[1]), pack2(o[2], o[3]), pack2(o[4], o[5]), pack2(o[6], o[7])};
        *(u32x4*)(act + (size_t)(r0 + rb * 8 + i) * DFF + ch) = pk;
      }
    }
  }
}

__global__ void __launch_bounds__(NT) fwd_megakernel(Params P0) {
  cg::grid_group grid = cg::this_grid();
  __shared__ __attribute__((aligned(16))) char smem[132352];
  const int tid = threadIdx.x;
  char* ws = P0.ws;
  int* ctrl = (int*)(ws + OFF_CTRL);
  if (blockIdx.x == 0 && tid < 64) ctrl[tid] = 0;
  if (blockIdx.x == 0 && tid == 0) *(Params*)(ws + OFF_CTRL + 1024) = P0;
  bf16_t* Hb = (bf16_t*)(ws + OFF_H);
  for (int it = blockIdx.x; it < 192 + CV_T5; it += gridDim.x) { if (it < 192) mod_item(P0, it); else convert_item(P0, 0, it - 192, smem); }
  grid.sync();
  const Params& P = *(const Params*)(ws + OFF_CTRL + 1024);
  rownorm_phase(P, P.x, nullptr, P.out, Hb, 0, 0, nullptr, 0, 1, 0, P.mix_pre, smem);
  grid.sync();
  for (int l = 0; l < 2; ++l) {
    { EpiProj epi{(bf16_t*)(ws + OFF_PROJ), (float*)(ws + OFF_AB)}; gemm_phase(Hb, 2048, (const bf16_t*)(ws + OFF_W + W_IN), 2048, 2048, 64, 22, smem, epi); }
    grid.sync();
    for (int it = blockIdx.x; it < 448; it += gridDim.x) {
      if (it < 192) mla_q_tile(P, it / 3, it % 3, smem);
      else mla_kv_tile(P, (it - 192) >> 2, (it - 192) & 3, smem);
    }
    for (int id = (blockIdx.x + 64) % gridDim.x; id < 2048; id += gridDim.x) gdn_prep_item(P, l, id >> 3, id & 7, smem);
    grid.sync();
    {
      int* sitem = (int*)(smem + 132096);
      for (;;) {
        if (tid == 0) *sitem = atomicAdd(ctrl + 16 * l, 1);
        __syncthreads(); const int item = *sitem; __syncthreads();
        if (item >= 16 + 512 + 256) break;
        if (item < 16) gdn_scan_item(P, l, item >> 1, item & 1, smem);
        else if (item < 528) { const int idx = item - 16; mla_attn_item(P, idx & 3, 127 - (idx >> 2), smem); }
        else { const int idx = item - 528; swa_item(P, l, idx >> 1, idx & 1, smem); }
      }
    }
    grid.sync();
    gdn_fix_phase(P);
    grid.sync();
    { EpiF32 epi{(float*)(ws + OFF_MIXF), 2048}; gemm_phase(Hb, 2048, (const bf16_t*)(ws + OFF_W + W_OUT), 2048, 2048, 64, 8, smem, epi); }
    grid.sync();
    rownorm_phase(P, P.out, (const float*)(ws + OFF_MIXF), P.out, Hb, l, 2, P.mix_post + l * 2048, l, 4, 3, P.ffn_pre + l * 2048, smem);
    grid.sync();
    { EpiBf epi{(bf16_t*)(ws + OFF_BIG), DFF2}; gemm_phase(Hb, 2048, (const bf16_t*)(ws + OFF_W + W_UP), 2048, 2048, 64, 44, smem, epi); }
    grid.sync();
    ffn_act_phase(P, l);
    grid.sync();
    { EpiF32 epi{(float*)(ws + OFF_Y), 2048}; gemm_phase((const bf16_t*)(ws + OFF_ACT), DFF, (const bf16_t*)(ws + OFF_W + W_DOWN), DFF, DFF, 64, 8, smem, epi); }
    grid.sync();
    if (l == 0) {
      for (int it = blockIdx.x; it < CV_T5; it += gridDim.x) convert_item(P, 1, it, smem);
      rownorm_phase(P, P.out, (const float*)(ws + OFF_Y), P.out, Hb, 0, 5, P.ffn_post, 1, 1, 0, P.mix_pre + 2048, smem);
      grid.sync();
    } else {
      rownorm_phase(P, P.out, (const float*)(ws + OFF_Y), P.out, nullptr, 1, 5, P.ffn_post + 2048, 1, 1, 0, nullptr, smem);
    }
  }
}

extern "C" void kernel_launch(void* const* d_in, const int* in_sizes, int n_in, void* d_out, int out_size, void* d_ws, size_t ws_size, hipStream_t stream) {
  static int grid_blocks = 0;
  if (!grid_blocks) {
    int dev = 0, cus = 0, per = 0;
    (void)hipGetDevice(&dev); (void)hipDeviceGetAttribute(&cus, hipDeviceAttributeMultiprocessorCount, dev);
    (void)hipOccupancyMaxActiveBlocksPerMultiprocessor(&per, fwd_megakernel, NT, 0);
    if (per > 1) per = 1;
    grid_blocks = cus * per; if (grid_blocks <= 0) grid_blocks = 256;
  }
  if (ws_size < OFF_END) { fprintf(stderr, "workspace too small: %zu < %zu\n", ws_size, (size_t)OFF_END); return; }
  Params p{};
  p.x = (const float*)d_in[0]; p.c = (const float*)d_in[1]; p.pos = (const int*)d_in[2];
  p.ada_w = (const float*)d_in[3]; p.ada_b = (const float*)d_in[4]; p.mix_pre = (const float*)d_in[5]; p.mix_post = (const float*)d_in[6];
  p.w_in = (const float*)d_in[7]; p.w_out = (const float*)d_in[8]; p.gdn_conv = (const float*)d_in[9]; p.gdn_a_log = (const float*)d_in[10];
  p.gdn_dt_bias = (const float*)d_in[11]; p.gdn_norm = (const float*)d_in[12]; p.mla_q_norm = (const float*)d_in[13]; p.mla_w_uq = (const float*)d_in[14];
  p.mla_kv_norm = (const float*)d_in[15]; p.mla_w_ukv = (const float*)d_in[16]; p.swa_sinks = (const float*)d_in[17]; p.ffn_pre = (const float*)d_in[18];
  p.ffn_post = (const float*)d_in[19]; p.ffn_w_up = (const float*)d_in[20]; p.ffn_conv = (const float*)d_in[21]; p.ffn_conv_b = (const float*)d_in[22];
  p.ffn_w_down = (const float*)d_in[23];
  p.out = (float*)d_out; p.ws = (char*)d_ws;
  void* args[] = {&p};
  hipError_t e = hipLaunchCooperativeKernel((void*)fwd_megakernel, dim3(grid_blocks), dim3(NT), args, 0, stream);
  if (e != hipSuccess) fprintf(stderr, "cooperative launch failed: %s (grid %d)\n", hipGetErrorString(e), grid_blocks);
}
```

```cpp
#include <hip/hip_runtime.h>
#include <hip/hip_cooperative_groups.h>
#include <cstdio>
#include <cstdint>
namespace cg = cooperative_groups;

#define DI __device__ __forceinline__
typedef unsigned short bf16_t;
typedef short bf16x8 __attribute__((ext_vector_type(8)));
typedef float f32x2 __attribute__((ext_vector_type(2)));
typedef float f32x4 __attribute__((ext_vector_type(4)));
typedef float f32x16 __attribute__((ext_vector_type(16)));
typedef unsigned u32x2 __attribute__((ext_vector_type(2)));
typedef unsigned u32x4 __attribute__((ext_vector_type(4)));
typedef __bf16 bf2_t __attribute__((ext_vector_type(2)));

constexpr int S_ = 16384, D_ = 2048, DINP = 5632, DFF = 5632, DFF2 = 11264;
constexpr int NT = 512;
constexpr float EPS = 1e-6f;
constexpr float LOG2E = 1.4426950408889634f;

constexpr size_t OFF_CTRL = 0;
constexpr size_t OFF_MODP = 4096;
constexpr size_t OFF_W = 2097152;
constexpr size_t W_IN = 0, W_OUT = W_IN + (size_t)5632 * 2048 * 2, W_UP = W_OUT + (size_t)2048 * 2048 * 2,
                 W_DOWN = W_UP + (size_t)11264 * 2048 * 2, W_UQ = W_DOWN + (size_t)2048 * 5632 * 2,
                 W_UKV = W_UQ + (size_t)768 * 448 * 2, W_END = W_UKV + (size_t)1024 * 128 * 2;
constexpr size_t OFF_H = OFF_W + W_END;
constexpr size_t OFF_MIXF = OFF_H + (size_t)S_ * 2048 * 2;
constexpr size_t OFF_QRAW = OFF_MIXF;
constexpr size_t OFF_KMLA = OFF_QRAW + (size_t)S_ * 768 * 4;
constexpr size_t OFF_VT = OFF_KMLA + (size_t)4 * S_ * 192 * 2;
constexpr size_t OFF_BIG = OFF_MIXF + (size_t)S_ * 2048 * 4;
constexpr size_t OFF_PROJ = OFF_BIG;
constexpr size_t OFF_WP = OFF_PROJ + (size_t)S_ * DINP * 2;
constexpr size_t OFF_QD = OFF_WP + (size_t)S_ * 1024 * 2;
constexpr size_t OFF_KT = OFF_QD + (size_t)S_ * 1024 * 2;
constexpr size_t OFF_ZT = OFF_KT + (size_t)S_ * 1024 * 2;
constexpr size_t OFF_QK = OFF_ZT + (size_t)S_ * 1024 * 2;
constexpr size_t OFF_AB = OFF_QK + (size_t)S_ * 512 * 2;
constexpr size_t OFF_GTOT = OFF_AB + (size_t)S_ * 16 * 4;
constexpr size_t OFF_Y = OFF_BIG;
constexpr size_t OFF_ACT = OFF_H;
constexpr size_t OFF_UT = OFF_BIG + (size_t)S_ * DFF2 * 2;
constexpr size_t OFF_END = OFF_UT + (size_t)S_ * 1024 * 4;
static_assert(OFF_GTOT + 8192 <= OFF_UT, "overlay");
static_assert(OFF_VT + (size_t)4 * 128 * S_ * 2 <= OFF_BIG, "overlay2");

constexpr int C_AQ = 0, C_AK = 1024, C_AV = 2048, C_AZ = 3072, C_AA = 4096, C_BCQ = 4112, C_BCKV = 4560,
              C_BKR = 4688, C_CQ = 4752, C_CK = 5264, C_CV = 5392;

__constant__ double kInvFreq2Pi[32] = {
    0.15915494309189535, 0.11934937021124886, 0.08949940160889101, 0.06711508300522726, 0.050329212104487035, 0.03774158471741977,
    0.0283021958306234, 0.02122365276477766, 0.015915494309189534, 0.011934937021124886, 0.008949940160889102, 0.006711508300522725,
    0.005032921210448704, 0.003774158471741977, 0.00283021958306234, 0.0021223652764777662, 0.0015915494309189536, 0.0011934937021124885,
    0.0008949940160889102, 0.0006711508300522726, 0.0005032921210448703, 0.00037741584717419774, 0.00028302195830623395, 0.0002122365276477766,
    0.00015915494309189535, 0.00011934937021124886, 8.949940160889102e-05, 6.711508300522725e-05, 5.0329212104487035e-05, 3.774158471741978e-05,
    2.8302195830623396e-05, 2.122365276477766e-05};

struct Params {
  const float* x; const float* c; const int* pos;
  const float *ada_w, *ada_b, *mix_pre, *mix_post, *w_in, *w_out, *gdn_conv, *gdn_a_log, *gdn_dt_bias, *gdn_norm, *mla_q_norm, *mla_w_uq,
      *mla_kv_norm, *mla_w_ukv, *swa_sinks, *ffn_pre, *ffn_post, *ffn_w_up, *ffn_conv, *ffn_conv_b, *ffn_w_down;
  float* out; char* ws;
};

DI unsigned pack2(float lo, float hi) { f32x2 v = {lo, hi}; bf2_t b = __builtin_convertvector(v, bf2_t); return __builtin_bit_cast(unsigned, b); }
DI bf16_t f2bf(float x) { return (bf16_t)(pack2(x, 0.f) & 0xffffu); }
DI float bflo(unsigned u) { return __uint_as_float(u << 16); }
DI float bfhi(unsigned u) { return __uint_as_float(u & 0xffff0000u); }
DI void unpack8(const u32x4& v, float* f) { f[0] = bflo(v.x); f[1] = bfhi(v.x); f[2] = bflo(v.y); f[3] = bfhi(v.y); f[4] = bflo(v.z); f[5] = bfhi(v.z); f[6] = bflo(v.w); f[7] = bfhi(v.w); }
DI bf16x8 pack8(float a0, float a1, float a2, float a3, float a4, float a5, float a6, float a7) {
  u32x4 p = {pack2(a0, a1), pack2(a2, a3), pack2(a4, a5), pack2(a6, a7)}; return __builtin_bit_cast(bf16x8, p); }
DI float silu_f(float x) { return x / (1.f + __expf(-x)); }
DI float wave_sum(float v) { v += __shfl_xor(v, 32); v += __shfl_xor(v, 16); v += __shfl_xor(v, 8); v += __shfl_xor(v, 4); v += __shfl_xor(v, 2); v += __shfl_xor(v, 1); return v; }
DI int opaque_tid() { int t = threadIdx.x; asm volatile("" : "+v"(t)); return t; }
DI int crow(int r, int h) { return (r & 3) + 8 * (r >> 2) + 4 * h; }
DI int perm32(int k) { return 8 * ((k >> 2) & 3) + 4 * (k >> 4) + (k & 3); }
#define MFMA32(a, b, c) __builtin_amdgcn_mfma_f32_32x32x16_bf16((a), (b), (c), 0, 0, 0)
#define MFMA16(a, b, c) __builtin_amdgcn_mfma_f32_16x16x32_bf16((a), (b), (c), 0, 0, 0)

template <class Epi>
DI void gemm_tile(const bf16_t* __restrict__ A, int lda, const bf16_t* __restrict__ Bt, int ldb, int K, int m0, int n0, char* smem, const Epi& epi) {
  const int tid = opaque_tid(), lane = tid & 63, w = tid >> 6, wm = w >> 2, wn = w & 3, lq = lane & 31, h = lane >> 5;
  f32x16 acc[2][4];
#pragma unroll
  for (int i = 0; i < 2; ++i)
#pragma unroll
    for (int j = 0; j < 4; ++j)
#pragma unroll
      for (int r = 0; r < 16; ++r) acc[i][j][r] = 0.f;
  const int r0 = tid >> 3, c0 = tid & 7;
  const bf16_t* ag = A + (size_t)(m0 + r0) * lda + c0 * 8;
  const bf16_t* bg = Bt + (size_t)(n0 + r0) * ldb + c0 * 8;
  const int wofs = r0 * 128 + ((c0 ^ ((r0 >> 1) & 7)) << 4);
  char* sA = smem; char* sB = smem + 65536;
  u32x4 ra0[4], rb0[4], ra1[4], rb1[4];
  const int nk = K >> 6, swz = (lane >> 1) & 7;
  const int aoff = (64 * wn + lq) * 128, boff = (128 * wm + lq) * 128;
#define GLOAD(RA, RB, KT) { _Pragma("unroll") for (int i = 0; i < 4; ++i) { RA[i] = *(const u32x4*)(ag + (size_t)(KT) * 64 + (size_t)i * 64 * lda); RB[i] = *(const u32x4*)(bg + (size_t)(KT) * 64 + (size_t)i * 64 * ldb); } }
#define LWRITE(RA, RB, ST) { _Pragma("unroll") for (int i = 0; i < 4; ++i) { *(u32x4*)(sA + (ST) * 32768 + wofs + i * 8192) = RA[i]; *(u32x4*)(sB + (ST) * 32768 + wofs + i * 8192) = RB[i]; } }
#define KSTEP(ST, RA, RB, KN) { const char* cA = sA + (ST) * 32768; const char* cB = sB + (ST) * 32768; char* dA = sA + (1 - (ST)) * 32768; char* dB = sB + (1 - (ST)) * 32768; \
    const bf16_t* agn = ag + (size_t)(KN) * 64; const bf16_t* bgn = bg + (size_t)(KN) * 64; \
    _Pragma("unroll") for (int s = 0; s < 4; ++s) { const int co = (((2 * s + h) ^ swz) << 4); bf16x8 fa[2], fb[4]; \
      _Pragma("unroll") for (int ni = 0; ni < 2; ++ni) fa[ni] = *(const bf16x8*)(cB + aoff + ni * 4096 + co); \
      _Pragma("unroll") for (int mi = 0; mi < 4; ++mi) fb[mi] = *(const bf16x8*)(cA + boff + mi * 4096 + co); \
      *(u32x4*)(dA + wofs + s * 8192) = RA[s]; *(u32x4*)(dB + wofs + s * 8192) = RB[s]; \
      RA[s] = *(const u32x4*)(agn + (size_t)s * 64 * lda); RB[s] = *(const u32x4*)(bgn + (size_t)s * 64 * ldb); \
      _Pragma("unroll") for (int ni = 0; ni < 2; ++ni) _Pragma("unroll") for (int mi = 0; mi < 4; ++mi) acc[ni][mi] = MFMA32(fa[ni], fb[mi], acc[ni][mi]); \
      __builtin_amdgcn_sched_barrier(0); } }
  const int kl = nk - 1;
  GLOAD(ra0, rb0, 0);
  GLOAD(ra1, rb1, (1 < kl ? 1 : kl));
  LWRITE(ra0, rb0, 0);
  GLOAD(ra0, rb0, (2 < kl ? 2 : kl));
  __syncthreads();
  for (int kt = 0; kt < nk; kt += 2) {
    KSTEP(0, ra1, rb1, (kt + 3 < kl ? kt + 3 : kl));
    __syncthreads();
    if (kt + 1 < nk) {
      KSTEP(1, ra0, rb0, (kt + 4 < kl ? kt + 4 : kl));
      __syncthreads();
    }
  }
#undef GLOAD
#undef LWRITE
#undef KSTEP
#pragma unroll
  for (int ni = 0; ni < 2; ++ni)
#pragma unroll
    for (int mi = 0; mi < 4; ++mi)
#pragma unroll
      for (int rg = 0; rg < 4; ++rg) {
        const int m = m0 + 128 * wm + 32 * mi + lq, n = n0 + 64 * wn + 32 * ni + 8 * rg + 4 * h;
        epi(m, n, acc[ni][mi][4 * rg], acc[ni][mi][4 * rg + 1], acc[ni][mi][4 * rg + 2], acc[ni][mi][4 * rg + 3]);
      }
}

template <class Epi>
DI void gemm_tile_s(const bf16_t* __restrict__ A, int lda, const bf16_t* __restrict__ Bt, int ldb, int K, int m0, int n0, char* smem, const Epi& epi) {
  const int tid = opaque_tid(), lane = tid & 63, w = tid >> 6, wm = w >> 2, wn = w & 3, lq = lane & 31, h = lane >> 5;
  f32x16 acc[2][4];
#pragma unroll
  for (int i = 0; i < 2; ++i)
#pragma unroll
    for (int j = 0; j < 4; ++j)
#pragma unroll
      for (int r = 0; r < 16; ++r) acc[i][j][r] = 0.f;
  const int r0 = tid >> 3, c0 = tid & 7;
  const bf16_t* ag = A + (size_t)(m0 + r0) * lda + c0 * 8;
  const bf16_t* bg = Bt + (size_t)(n0 + r0) * ldb + c0 * 8;
  const int wofs = r0 * 128 + ((c0 ^ ((r0 >> 1) & 7)) << 4);
  char* sA = smem; char* sB = smem + 32768;
  u32x4 ra[4], rb[4];
#pragma unroll
  for (int i = 0; i < 4; ++i) { ra[i] = *(const u32x4*)(ag + (size_t)i * 64 * lda); rb[i] = *(const u32x4*)(bg + (size_t)i * 64 * ldb); }
#pragma unroll
  for (int i = 0; i < 4; ++i) { *(u32x4*)(sA + wofs + i * 8192) = ra[i]; *(u32x4*)(sB + wofs + i * 8192) = rb[i]; }
  __syncthreads();
  const int nk = K >> 6, swz = (lane >> 1) & 7;
  const int aoff = (64 * wn + lq) * 128, boff = (128 * wm + lq) * 128;
  for (int kt = 0; kt < nk; ++kt) {
    const char* cA = sA + (kt & 1) * 65536; const char* cB = sB + (kt & 1) * 65536;
    const bool more = (kt + 1 < nk);
    if (more) { ag += 64; bg += 64;
#pragma unroll
      for (int i = 0; i < 4; ++i) { ra[i] = *(const u32x4*)(ag + (size_t)i * 64 * lda); rb[i] = *(const u32x4*)(bg + (size_t)i * 64 * ldb); } }
#pragma unroll
    for (int s = 0; s < 4; ++s) {
      const int co = (((2 * s + h) ^ swz) << 4);
      bf16x8 fa[2], fb[4];
#pragma unroll
      for (int ni = 0; ni < 2; ++ni) fa[ni] = *(const bf16x8*)(cB + aoff + ni * 4096 + co);
#pragma unroll
      for (int mi = 0; mi < 4; ++mi) fb[mi] = *(const bf16x8*)(cA + boff + mi * 4096 + co);
#pragma unroll
      for (int ni = 0; ni < 2; ++ni)
#pragma unroll
        for (int mi = 0; mi < 4; ++mi) acc[ni][mi] = MFMA32(fa[ni], fb[mi], acc[ni][mi]);
    }
    if (more) { char* dA = sA + ((kt + 1) & 1) * 65536; char* dB = sB + ((kt + 1) & 1) * 65536;
#pragma unroll
      for (int i = 0; i < 4; ++i) { *(u32x4*)(dA + wofs + i * 8192) = ra[i]; *(u32x4*)(dB + wofs + i * 8192) = rb[i]; } }
    __syncthreads();
  }
#pragma unroll
  for (int ni = 0; ni < 2; ++ni)
#pragma unroll
    for (int mi = 0; mi < 4; ++mi)
#pragma unroll
      for (int rg = 0; rg < 4; ++rg) {
        const int m = m0 + 128 * wm + 32 * mi + lq, n = n0 + 64 * wn + 32 * ni + 8 * rg + 4 * h;
        epi(m, n, acc[ni][mi][4 * rg], acc[ni][mi][4 * rg + 1], acc[ni][mi][4 * rg + 2], acc[ni][mi][4 * rg + 3]);
      }
}

DI void tile_coord(int t, int npn, int& pm, int& pn) { const int g = t / (16 * npn), r = t % (16 * npn); pn = r >> 4; pm = g * 16 + (r & 15); }

struct EpiProj { bf16_t* proj; float* ab;
  DI void operator()(int m, int n, float v0, float v1, float v2, float v3) const {
    u32x2 pk = {pack2(v0, v1), pack2(v2, v3)}; *(u32x2*)(proj + (size_t)m * DINP + n) = pk;
    if (n >= C_AA && n < C_AA + 16) { f32x4 v = {v0, v1, v2, v3}; *(f32x4*)(ab + (size_t)m * 16 + (n - C_AA)) = v; } } };
struct EpiF32 { float* out; int ldc;
  DI void operator()(int m, int n, float v0, float v1, float v2, float v3) const { f32x4 v = {v0, v1, v2, v3}; *(f32x4*)(out + (size_t)m * ldc + n) = v; } };
struct EpiBf { bf16_t* out; int ldc;
  DI void operator()(int m, int n, float v0, float v1, float v2, float v3) const { u32x2 pk = {pack2(v0, v1), pack2(v2, v3)}; *(u32x2*)(out + (size_t)m * ldc + n) = pk; } };
struct EpiMlaQ { float* qraw; const float* rs; int m0;
  DI void operator()(int m, int n, float v0, float v1, float v2, float v3) const { const float r = rs[m - m0]; f32x4 v = {v0 * r, v1 * r, v2 * r, v3 * r}; *(f32x4*)(qraw + (size_t)m * 768 + n) = v; } };
struct EpiMlaKV { bf16_t* kmla; bf16_t* vt; const float* rs; int m0;
  DI void operator()(int m, int n, float v0, float v1, float v2, float v3) const {
    const float r = rs[m - m0]; const int hd = n >> 8, wi = n & 255;
    if (wi < 128) { u32x2 pk = {pack2(v0 * r, v1 * r), pack2(v2 * r, v3 * r)}; *(u32x2*)(kmla + ((size_t)hd * S_ + m) * 192 + wi) = pk; }
    else { bf16_t* p = vt + ((size_t)hd * 128 + (wi - 128)) * S_ + m; p[0] = f2bf(v0 * r); p[S_] = f2bf(v1 * r); p[2 * (size_t)S_] = f2bf(v2 * r); p[3 * (size_t)S_] = f2bf(v3 * r); } } };

template <class Epi>
DI void gemm_phase(const bf16_t* A, int lda, const bf16_t* Bt, int ldb, int K, int npm, int npn, char* smem, const Epi& epi) {
  for (int t = blockIdx.x; t < npm * npn; t += gridDim.x) { int pm, pn; tile_coord(t, npn, pm, pn); gemm_tile(A, lda, Bt, ldb, K, pm * 256, pn * 256, smem, epi); }
}

DI void mod_item(const Params& P, int item) {
  const int tid = opaque_tid(); const int l = item / 96, r = item % 96, ks = r / 6, nc = r % 6;
  const int n = nc * 2048 + tid * 4;
  const float* wp = P.ada_w + ((size_t)l * 2048 + ks * 128) * 12288 + n;
  f32x4 acc = {0.f, 0.f, 0.f, 0.f};
#pragma unroll 8
  for (int k = 0; k < 128; ++k) { const float cv = P.c[ks * 128 + k]; const float ca = silu_f(cv); const f32x4 wv = *(const f32x4*)(wp + (size_t)k * 12288); acc += wv * ca; }
  float* modp = (float*)(P.ws + OFF_MODP);
  *(f32x4*)(modp + ((size_t)l * 16 + ks) * 12288 + n) = acc;
}
DI void convert_tile(const float* __restrict__ src, int K, int N, bf16_t* __restrict__ dst, int tk, int tn, const float* rowscale, char* smem) {
  float* sm = (float*)smem; const int tid = opaque_tid(); const int k0 = tk * 64, n0 = tn * 256;
  { const int r = tid >> 6, c4 = tid & 63; const int n = n0 + 4 * c4;
    f32x4 v[8];
#pragma unroll
    for (int i = 0; i < 8; ++i) { v[i] = (f32x4){0.f, 0.f, 0.f, 0.f}; if (n < N) v[i] = *(const f32x4*)(src + (size_t)(k0 + r + 8 * i) * N + n); }
#pragma unroll
    for (int i = 0; i < 8; ++i) { const int kk = r + 8 * i; if (rowscale) v[i] *= rowscale[k0 + kk];
      sm[kk * 257 + 4 * c4 + 0] = v[i].x; sm[kk * 257 + 4 * c4 + 1] = v[i].y; sm[kk * 257 + 4 * c4 + 2] = v[i].z; sm[kk * 257 + 4 * c4 + 3] = v[i].w; } }
  __syncthreads();
  { const int n = tid >> 1, kh = tid & 1;
#pragma unroll
    for (int j = 0; j < 4; ++j) { float f[8];
#pragma unroll
      for (int i = 0; i < 8; ++i) f[i] = sm[(32 * kh + 8 * j + i) * 257 + n];
      u32x4 pk = {pack2(f[0], f[1]), pack2(f[2], f[3]), pack2(f[4], f[5]), pack2(f[6], f[7])};
      *(u32x4*)(dst + (size_t)(n0 + n) * K + k0 + 32 * kh + 8 * j) = pk; } }
  __syncthreads();
}
constexpr int CV_T0 = 32 * 22, CV_T1 = CV_T0 + 32 * 8, CV_T2 = CV_T1 + 32 * 44, CV_T3 = CV_T2 + 88 * 8, CV_T4 = CV_T3 + 7 * 3, CV_T5 = CV_T4 + 2 * 4;
DI void convert_item(const Params& P, int l, int it, char* smem) {
  char* wb = P.ws + OFF_W;
  if (it < CV_T0) convert_tile(P.w_in + (size_t)l * 2048 * 5520, 2048, 5520, (bf16_t*)(wb + W_IN), it / 22, it % 22, nullptr, smem);
  else if (it < CV_T1) { it -= CV_T0; convert_tile(P.w_out + (size_t)l * 2048 * 2048, 2048, 2048, (bf16_t*)(wb + W_OUT), it / 8, it % 8, nullptr, smem); }
  else if (it < CV_T2) { it -= CV_T1; convert_tile(P.ffn_w_up + (size_t)l * 2048 * 11264, 2048, 11264, (bf16_t*)(wb + W_UP), it / 44, it % 44, nullptr, smem); }
  else if (it < CV_T3) { it -= CV_T2; convert_tile(P.ffn_w_down + (size_t)l * 5632 * 2048, 5632, 2048, (bf16_t*)(wb + W_DOWN), it / 8, it % 8, nullptr, smem); }
  else if (it < CV_T4) { it -= CV_T3; convert_tile(P.mla_w_uq + (size_t)l * 448 * 768, 448, 768, (bf16_t*)(wb + W_UQ), it / 3, it % 3, P.mla_q_norm + l * 448, smem); }
  else { it -= CV_T4; convert_tile(P.mla_w_ukv + (size_t)l * 128 * 1024, 128, 1024, (bf16_t*)(wb + W_UKV), it / 4, it % 4, P.mla_kv_norm + l * 128, smem); }
}

DI float mod_val(const float* modp_l, const float* ada_b_l, int idx) { float s = ada_b_l[idx];
#pragma unroll
  for (int k = 0; k < 16; ++k) s += modp_l[(size_t)k * 12288 + idx]; return s; }
DI void rownorm_phase(const Params& P, const float* xin, const float* yin, float* xout, bf16_t* hout, int lg, int gate_idx, const float* w_post,
                      int lh, int scale_idx, int shift_idx, const float* w_pre, char* smem) {
  float* A1 = (float*)smem; float* A2 = A1 + 2048; float* B2 = A2 + 2048;
  const int tid = opaque_tid(), lane = tid & 63, w = tid >> 6;
  const float* modp = (const float*)(P.ws + OFF_MODP);
  for (int cidx = tid; cidx < 2048; cidx += NT) {
    if (yin) A1[cidx] = mod_val(modp + (size_t)lg * 16 * 12288, P.ada_b + (size_t)lg * 12288, gate_idx * 2048 + cidx) * w_post[cidx];
    if (hout) { A2[cidx] = w_pre[cidx] * (1.f + mod_val(modp + (size_t)lh * 16 * 12288, P.ada_b + (size_t)lh * 12288, scale_idx * 2048 + cidx));
      B2[cidx] = mod_val(modp + (size_t)lh * 16 * 12288, P.ada_b + (size_t)lh * 12288, shift_idx * 2048 + cidx); }
  }
  __syncthreads();
  for (int row = blockIdx.x * 8 + w; row < S_; row += gridDim.x * 8) {
    f32x4 xv[8];
#pragma unroll
    for (int j = 0; j < 8; ++j) xv[j] = *(const f32x4*)(xin + (size_t)row * 2048 + (j * 64 + lane) * 4);
    if (yin) {
      f32x4 yv[8]; float ss = 0.f;
#pragma unroll
      for (int j = 0; j < 8; ++j) { yv[j] = *(const f32x4*)(yin + (size_t)row * 2048 + (j * 64 + lane) * 4); ss += yv[j].x * yv[j].x + yv[j].y * yv[j].y + yv[j].z * yv[j].z + yv[j].w * yv[j].w; }
      ss = wave_sum(ss); const float r = rsqrtf(ss * (1.f / 2048.f) + EPS);
#pragma unroll
      for (int j = 0; j < 8; ++j) { const f32x4 a = *(const f32x4*)(A1 + (j * 64 + lane) * 4); xv[j] += a * (yv[j] * r); }
    }
    if (yin || xout != xin) {
#pragma unroll
      for (int j = 0; j < 8; ++j) *(f32x4*)(xout + (size_t)row * 2048 + (j * 64 + lane) * 4) = xv[j];
    }
    if (hout) {
      float ss = 0.f;
#pragma unroll
      for (int j = 0; j < 8; ++j) ss += xv[j].x * xv[j].x + xv[j].y * xv[j].y + xv[j].z * xv[j].z + xv[j].w * xv[j].w;
      ss = wave_sum(ss); const float r = rsqrtf(ss * (1.f / 2048.f) + EPS);
#pragma unroll
      for (int j = 0; j < 8; ++j) { const f32x4 a = *(const f32x4*)(A2 + (j * 64 + lane) * 4), b = *(const f32x4*)(B2 + (j * 64 + lane) * 4);
        const f32x4 hv = xv[j] * r * a + b; u32x2 pk = {pack2(hv.x, hv.y), pack2(hv.z, hv.w)};
        *(u32x2*)(hout + (size_t)row * 2048 + (j * 64 + lane) * 4) = pk; }
    }
  }
  __syncthreads();
}

DI void mla_q_tile(const Params& P, int pm, int pn, char* smem) {
  const bf16_t* proj = (const bf16_t*)(P.ws + OFF_PROJ); const int tid = opaque_tid(), m0 = pm * 256; float* rs = (float*)(smem + 131072);
  { const int row = tid >> 1, half = tid & 1; const bf16_t* p = proj + (size_t)(m0 + row) * DINP + C_BCQ + half * 224; float ss = 0.f;
    for (int i = 0; i < 28; ++i) { const u32x4 v = *(const u32x4*)(p + i * 8); float f[8]; unpack8(v, f);
#pragma unroll
      for (int e = 0; e < 8; ++e) ss += f[e] * f[e]; }
    ss += __shfl_xor(ss, 1); if (half == 0) rs[row] = rsqrtf(ss * (1.f / 448.f) + EPS); }
  EpiMlaQ epi{(float*)(P.ws + OFF_QRAW), rs, m0};
  gemm_tile_s(proj + C_BCQ, DINP, (const bf16_t*)(P.ws + OFF_W + W_UQ), 448, 448, m0, pn * 256, smem, epi);
  __syncthreads();
}
DI void mla_kv_tile(const Params& P, int pm, int pn, char* smem) {
  const bf16_t* proj = (const bf16_t*)(P.ws + OFF_PROJ); const int tid = opaque_tid(), m0 = pm * 256; float* rs = (float*)(smem + 131072);
  { const int row = tid >> 1, half = tid & 1; const bf16_t* p = proj + (size_t)(m0 + row) * DINP + C_BCKV + half * 64; float ss = 0.f;
#pragma unroll
    for (int i = 0; i < 8; ++i) { const u32x4 v = *(const u32x4*)(p + i * 8); float f[8]; unpack8(v, f);
#pragma unroll
      for (int e = 0; e < 8; ++e) ss += f[e] * f[e]; }
    ss += __shfl_xor(ss, 1); if (half == 0) rs[row] = rsqrtf(ss * (1.f / 128.f) + EPS); }
  bf16_t* kmla = (bf16_t*)(P.ws + OFF_KMLA);
  EpiMlaKV epi{kmla, (bf16_t*)(P.ws + OFF_VT), rs, m0};
  gemm_tile_s(proj + C_BCKV, DINP, (const bf16_t*)(P.ws + OFF_W + W_UKV), 128, 128, m0, pn * 256, smem, epi);
  if (pn == 0) {
    for (int i = 0; i < 16; ++i) { const int idx = tid + NT * i, row = idx >> 5, pi = idx & 31, m = m0 + row;
      const float x1 = bflo((unsigned)proj[(size_t)m * DINP + C_BKR + pi]), x2 = bflo((unsigned)proj[(size_t)m * DINP + C_BKR + 32 + pi]);
      double fr = (double)P.pos[m] * kInvFreq2Pi[pi]; fr -= floor(fr); const float ff = (float)fr;
      const float sn = __builtin_amdgcn_sinf(ff), cs = __builtin_amdgcn_cosf(ff);
      const bf16_t o1 = f2bf(x1 * cs - x2 * sn), o2 = f2bf(x2 * cs + x1 * sn);
#pragma unroll
      for (int hd = 0; hd < 4; ++hd) { bf16_t* kp = kmla + ((size_t)hd * S_ + m) * 192 + 128; kp[pi] = o1; kp[32 + pi] = o2; } }
  }
  __syncthreads();
}

DI void gdn_prep_item(const Params& P, int l, int n, int hh, char* smem) {
  const int tid = opaque_tid(), lane = tid & 63, w = tid >> 6, lq = lane & 31, h = lane >> 5;
  const bf16_t* proj = (const bf16_t*)(P.ws + OFF_PROJ); const float* ab = (const float*)(P.ws + OFF_AB);
  char* kb16 = smem; char* qb16 = smem + 17408;
  float* kf = (float*)(smem + 34816); float* vf = kf + 8192; float* Lm = vf + 8192; float* gcs = Lm + 4096;
  const size_t tile = (size_t)hh * 256 + n; const int t0 = n * 64;
  bf16_t* Wp = (bf16_t*)(P.ws + OFF_WP) + tile * 8192; bf16_t* Qd = (bf16_t*)(P.ws + OFF_QD) + tile * 8192;
  bf16_t* Kt = (bf16_t*)(P.ws + OFF_KT) + tile * 8192; bf16_t* Zt = (bf16_t*)(P.ws + OFF_ZT) + tile * 8192;
  bf16_t* QK = (bf16_t*)(P.ws + OFF_QK) + tile * 4096; bf16_t* Ut = (bf16_t*)(P.ws + OFF_UT) + tile * 8192;
  if (w == 0) {
    const int t = lane; const float a_raw = ab[(size_t)(t0 + t) * 16 + hh], b_raw = ab[(size_t)(t0 + t) * 16 + 8 + hh];
    const float Aa = __expf(P.gdn_a_log[l * 8 + hh]); const float xb = a_raw + P.gdn_dt_bias[l * 8 + hh];
    const float ex = __expf(fminf(xb, 20.f));
    const float sp = xb > 20.f ? xb : (ex < 0.01f ? ex * (1.f - ex * (0.5f - ex * (1.f / 3.f))) : __logf(1.f + ex));
    float g = -Aa * sp;
#pragma unroll
    for (int d = 1; d < 64; d <<= 1) { const float v = __shfl_up(g, d); if (lane >= d) g += v; }
    const float bt = 1.f / (1.f + __expf(-b_raw)), eg = __expf(g); gcs[t] = g; gcs[64 + t] = bt; gcs[128 + t] = eg; gcs[192 + t] = bt * eg;
    if (t == 63) ((float*)(P.ws + OFF_GTOT))[tile] = eg;
  }
  __syncthreads();
  {
    const int t = tid >> 3, part = tid & 7, tabs = t0 + t;
    const float gct = gcs[t], egct = gcs[128 + t], ktl = __expf(gcs[63] - gct);
    const int pjt = 32 * (t >> 5) + perm32(t & 31);
#pragma unroll
    for (int X = 0; X < 3; ++X) {
      const int cb = X * 1024 + hh * 128 + part * 16;
      float y[16];
#pragma unroll
      for (int e = 0; e < 16; ++e) y[e] = 0.f;
#pragma unroll
      for (int j = 0; j < 4; ++j) { const int row = tabs - 3 + j;
        if (row >= 0) { const u32x4 v0 = *(const u32x4*)(proj + (size_t)row * DINP + cb), v1 = *(const u32x4*)(proj + (size_t)row * DINP + cb + 8);
          float xv[16]; unpack8(v0, xv); unpack8(v1, xv + 8); const float* cw = P.gdn_conv + ((size_t)l * 4 + j) * 3072 + cb;
#pragma unroll
          for (int e4 = 0; e4 < 4; ++e4) { const f32x4 wv = *(const f32x4*)(cw + 4 * e4); y[4 * e4] += wv.x * xv[4 * e4]; y[4 * e4 + 1] += wv.y * xv[4 * e4 + 1]; y[4 * e4 + 2] += wv.z * xv[4 * e4 + 2]; y[4 * e4 + 3] += wv.w * xv[4 * e4 + 3]; } } }
#pragma unroll
      for (int e = 0; e < 16; ++e) y[e] = silu_f(y[e]);
      if (X < 2) { float ss = 0.f;
#pragma unroll
        for (int e = 0; e < 16; ++e) ss += y[e] * y[e];
        ss += __shfl_xor(ss, 1); ss += __shfl_xor(ss, 2); ss += __shfl_xor(ss, 4);
        const float rn = rsqrtf(ss + EPS) * (X == 0 ? 0.08838834764831845f : 1.f);
#pragma unroll
        for (int e = 0; e < 16; ++e) y[e] *= rn; }
      if (X == 0) {
        u32x4 p0 = {pack2(y[0], y[1]), pack2(y[2], y[3]), pack2(y[4], y[5]), pack2(y[6], y[7])}, p1 = {pack2(y[8], y[9]), pack2(y[10], y[11]), pack2(y[12], y[13]), pack2(y[14], y[15])};
        *(u32x4*)(qb16 + t * 272 + part * 32) = p0; *(u32x4*)(qb16 + t * 272 + part * 32 + 16) = p1;
#pragma unroll
        for (int b = 0; b < 4; ++b) { u32x2 pk = {pack2(y[4 * b] * egct, y[4 * b + 1] * egct), pack2(y[4 * b + 2] * egct, y[4 * b + 3] * egct)};
          *(u32x2*)(Qd + t * 128 + 32 * (part >> 1) + 8 * b + 4 * (part & 1)) = pk; }
      } else if (X == 1) {
        u32x4 p0 = {pack2(y[0], y[1]), pack2(y[2], y[3]), pack2(y[4], y[5]), pack2(y[6], y[7])}, p1 = {pack2(y[8], y[9]), pack2(y[10], y[11]), pack2(y[12], y[13]), pack2(y[14], y[15])};
        *(u32x4*)(kb16 + t * 272 + part * 32) = p0; *(u32x4*)(kb16 + t * 272 + part * 32 + 16) = p1;
#pragma unroll
        for (int e4 = 0; e4 < 4; ++e4) { f32x4 v = {y[4 * e4], y[4 * e4 + 1], y[4 * e4 + 2], y[4 * e4 + 3]}; *(f32x4*)(kf + t * 128 + part * 16 + 4 * e4) = v; }
#pragma unroll
        for (int e = 0; e < 16; ++e) Kt[(part * 16 + e) * 64 + pjt] = f2bf(y[e] * ktl);
      } else {
#pragma unroll
        for (int e4 = 0; e4 < 4; ++e4) { f32x4 v = {y[4 * e4], y[4 * e4 + 1], y[4 * e4 + 2], y[4 * e4 + 3]}; *(f32x4*)(vf + t * 128 + part * 16 + 4 * e4) = v; }
      }
    }
    { const int cb = C_AZ + hh * 128 + part * 16; const u32x4 v0 = *(const u32x4*)(proj + (size_t)tabs * DINP + cb), v1 = *(const u32x4*)(proj + (size_t)tabs * DINP + cb + 8);
      float zv[16]; unpack8(v0, zv); unpack8(v1, zv + 8);
#pragma unroll
      for (int e = 0; e < 16; ++e) Zt[(part * 16 + e) * 64 + t] = f2bf(silu_f(zv[e])); }
  }
  __syncthreads();
  {
    const int which = w >> 2, ti = (w >> 1) & 1, tj = w & 1; const char* Ab = which ? qb16 : kb16;
    f32x16 acc;
#pragma unroll
    for (int r = 0; r < 16; ++r) acc[r] = 0.f;
#pragma unroll
    for (int s = 0; s < 8; ++s) { const bf16x8 a = *(const bf16x8*)(Ab + (32 * ti + lq) * 272 + (16 * s + 8 * h) * 2), b = *(const bf16x8*)(kb16 + (32 * tj + lq) * 272 + (16 * s + 8 * h) * 2);
      acc = MFMA32(a, b, acc); }
    const int j = 32 * tj + lq; const float gj = gcs[j]; const int pj = 32 * (j >> 5) + perm32(j & 31);
#pragma unroll
    for (int r = 0; r < 16; ++r) { const int i = 32 * ti + crow(r, h); const float dec = __expf(fminf(gcs[i] - gj, 0.f));
      if (which == 0) Lm[i * 64 + j] = (j < i) ? gcs[64 + i] * acc[r] * dec : 0.f;
      else QK[i * 64 + pj] = f2bf((j <= i) ? acc[r] * dec : 0.f); }
  }
  __syncthreads();
  if (tid < 256) {
    const int c = tid; const bool isu = c < 128; const int cc = c & 127;
    const float* rp = (isu ? vf : kf) + cc; const float* sp = gcs + (isu ? 64 : 192);
    float x[64];
#pragma unroll
    for (int i = 0; i < 64; ++i) {
      float r = sp[i] * rp[i * 128];
#pragma unroll
      for (int j = 0; j < i; ++j) r = fmaf(-Lm[i * 64 + j], x[j], r);
      x[i] = r;
    }
    if (isu) {
#pragma unroll
      for (int i8 = 0; i8 < 8; ++i8) { u32x4 v = {pack2(x[8 * i8], x[8 * i8 + 1]), pack2(x[8 * i8 + 2], x[8 * i8 + 3]), pack2(x[8 * i8 + 4], x[8 * i8 + 5]), pack2(x[8 * i8 + 6], x[8 * i8 + 7])}; *(u32x4*)(Ut + cc * 64 + 8 * i8) = v; }
    } else {
      const int pp = 32 * (cc >> 5) + perm32(cc & 31);
#pragma unroll
      for (int i = 0; i < 64; ++i) Wp[i * 128 + pp] = f2bf(x[i]);
    }
  }
  __syncthreads();
}

DI bf16x8 pack_tiles(const f32x4& a, const f32x4& b) { return pack8(a.x, a.y, a.z, a.w, b.x, b.y, b.z, b.w); }
template <int CTRL> DI float dppf(float v) { return __int_as_float(__builtin_amdgcn_update_dpp(0, __float_as_int(v), CTRL, 0xf, 0xf, true)); }
DI float row16_sum(float v) { v += dppf<0xB1>(v); v += dppf<0x4E>(v); v += dppf<0x141>(v); v += dppf<0x140>(v); return v; }
constexpr size_t OFF_SSQP = OFF_GTOT + 8192;
static_assert(OFF_SSQP + (size_t)2 * S_ * 8 * 4 <= OFF_UT, "overlay3");
DI void gdn_scan_item(const Params& P, int l, int hh, int half, char* smem) {
  const int tid = opaque_tid(), lane = tid & 63, w = tid >> 6, l15 = lane & 15, q4 = lane >> 4;
  constexpr int OPB = 62464;
  float* sPart = (float*)(smem + 2 * OPB);
  const size_t hb = (size_t)hh * 256;
  const bf16_t* Wp = (const bf16_t*)(P.ws + OFF_WP) + hb * 8192; const bf16_t* Qd = (const bf16_t*)(P.ws + OFF_QD) + hb * 8192;
  const bf16_t* Kt = (const bf16_t*)(P.ws + OFF_KT) + hb * 8192; const bf16_t* Zt = (const bf16_t*)(P.ws + OFF_ZT) + hb * 8192;
  const bf16_t* QK = (const bf16_t*)(P.ws + OFF_QK) + hb * 4096; const bf16_t* Ut = (const bf16_t*)(P.ws + OFF_UT) + hb * 8192;
  const float* gt = (const float*)(P.ws + OFF_GTOT) + hb;
  float* ssqp = (float*)(P.ws + OFF_SSQP) + (size_t)half * S_ * 8;
  bf16_t* mixin = (bf16_t*)(P.ws + OFF_H);
  if (w >= 4) {
    const int lt = tid - 256;
    const int g256 = (lt >> 4) * 128 + (lt & 15) * 8, l256 = (lt >> 4) * 272 + (lt & 15) * 16;
    const int g128 = (lt >> 3) * 64 + (lt & 7) * 8, l128 = (lt >> 3) * 144 + (lt & 7) * 16;
    u32x4 pw[4], pq[4], pk[4], pqk[2];
#pragma unroll
    for (int i = 0; i < 4; ++i) { pw[i] = *(const u32x4*)(Wp + g256 + i * 2048); pq[i] = *(const u32x4*)(Qd + g256 + i * 2048); pk[i] = *(const u32x4*)(Kt + g128 + i * 2048); }
#pragma unroll
    for (int i = 0; i < 2; ++i) pqk[i] = *(const u32x4*)(QK + g128 + i * 2048);
#pragma unroll
    for (int i = 0; i < 4; ++i) { *(u32x4*)(smem + l256 + i * 4352) = pw[i]; *(u32x4*)(smem + 17408 + l256 + i * 4352) = pq[i]; *(u32x4*)(smem + 34816 + l128 + i * 4608) = pk[i]; }
#pragma unroll
    for (int i = 0; i < 2; ++i) *(u32x4*)(smem + 53248 + l128 + i * 4608) = pqk[i];
#pragma unroll
    for (int i = 0; i < 4; ++i) { pw[i] = *(const u32x4*)(Wp + 8192 + g256 + i * 2048); pq[i] = *(const u32x4*)(Qd + 8192 + g256 + i * 2048); pk[i] = *(const u32x4*)(Kt + 8192 + g128 + i * 2048); }
#pragma unroll
    for (int i = 0; i < 2; ++i) pqk[i] = *(const u32x4*)(QK + 4096 + g128 + i * 2048);
    __syncthreads();
#pragma unroll 1
    for (int n = 0; n < 256; ++n) {
      char* nb = smem + ((n + 1) & 1) * OPB;
      if (n + 1 < 256) {
#pragma unroll
        for (int i = 0; i < 4; ++i) { *(u32x4*)(nb + l256 + i * 4352) = pw[i]; *(u32x4*)(nb + 17408 + l256 + i * 4352) = pq[i]; *(u32x4*)(nb + 34816 + l128 + i * 4608) = pk[i]; }
#pragma unroll
        for (int i = 0; i < 2; ++i) *(u32x4*)(nb + 53248 + l128 + i * 4608) = pqk[i];
      }
      if (n + 2 < 256) { const size_t o8 = (size_t)(n + 2) * 8192, o4 = (size_t)(n + 2) * 4096;
#pragma unroll
        for (int i = 0; i < 4; ++i) { pw[i] = *(const u32x4*)(Wp + o8 + g256 + i * 2048); pq[i] = *(const u32x4*)(Qd + o8 + g256 + i * 2048); pk[i] = *(const u32x4*)(Kt + o8 + g128 + i * 2048); }
#pragma unroll
        for (int i = 0; i < 2; ++i) pqk[i] = *(const u32x4*)(QK + o4 + g128 + i * 2048); }
      __syncthreads();
    }
  } else {
    const int dvc = 64 * half + 16 * w + l15; const float nw = P.gdn_norm[l * 128 + dvc];
    const int uoff = dvc * 64 + 4 * q4;
    f32x4 St[8];
#pragma unroll
    for (int t = 0; t < 8; ++t) St[t] = (f32x4){0.f, 0.f, 0.f, 0.f};
    u32x2 uc[4], un[4], zc[4], zn[4]; float gcur, gn = 0.f;
#pragma unroll
    for (int it = 0; it < 4; ++it) { uc[it] = *(const u32x2*)(Ut + uoff + 16 * it); zc[it] = *(const u32x2*)(Zt + uoff + 16 * it); un[it] = uc[it]; zn[it] = zc[it]; }
    gcur = gt[0];
    __syncthreads();
#pragma unroll 2
    for (int n = 0; n < 256; ++n) {
      const char* cb = smem + (n & 1) * OPB;
      const char* sWp = cb; const char* sQd = cb + 17408; const char* sKt = cb + 34816; const char* sQK = cb + 53248;
      if (n + 1 < 256) { const size_t o8 = (size_t)(n + 1) * 8192;
#pragma unroll
        for (int it = 0; it < 4; ++it) { un[it] = *(const u32x2*)(Ut + o8 + uoff + 16 * it); zn[it] = *(const u32x2*)(Zt + o8 + uoff + 16 * it); }
        gn = gt[n + 1]; }
      bf16x8 sb[4];
#pragma unroll
      for (int ks = 0; ks < 4; ++ks) sb[ks] = pack_tiles(St[2 * ks], St[2 * ks + 1]);
      f32x4 wsv[4], qs[4];
#pragma unroll
      for (int it = 0; it < 4; ++it) { wsv[it] = (f32x4){0.f, 0.f, 0.f, 0.f}; qs[it] = (f32x4){0.f, 0.f, 0.f, 0.f}; }
#pragma unroll
      for (int it = 0; it < 4; ++it)
#pragma unroll
        for (int ks = 0; ks < 4; ++ks) { const int o = (16 * it + l15) * 272 + 64 * ks + 16 * q4;
          const bf16x8 a = *(const bf16x8*)(sWp + o), a2 = *(const bf16x8*)(sQd + o);
          wsv[it] = MFMA16(a, sb[ks], wsv[it]); qs[it] = MFMA16(a2, sb[ks], qs[it]); }
      f32x4 vn[4];
#pragma unroll
      for (int it = 0; it < 4; ++it) { const f32x4 uf = {bflo(uc[it].x), bfhi(uc[it].x), bflo(uc[it].y), bfhi(uc[it].y)}; vn[it] = uf - wsv[it]; }
      bf16x8 vb[2];
#pragma unroll
      for (int ks = 0; ks < 2; ++ks) vb[ks] = pack_tiles(vn[2 * ks], vn[2 * ks + 1]);
#pragma unroll
      for (int it = 0; it < 4; ++it)
#pragma unroll
        for (int ks = 0; ks < 2; ++ks) { const bf16x8 a = *(const bf16x8*)(sQK + (16 * it + l15) * 144 + 64 * ks + 16 * q4); qs[it] = MFMA16(a, vb[ks], qs[it]); }
#pragma unroll
      for (int t = 0; t < 8; ++t) { St[t] *= gcur;
#pragma unroll
        for (int ks = 0; ks < 2; ++ks) { const bf16x8 a = *(const bf16x8*)(sKt + (16 * t + l15) * 144 + 64 * ks + 16 * q4); St[t] = MFMA16(a, vb[ks], St[t]); } }
      float* sp = sPart + (n & 1) * 256;
#pragma unroll
      for (int it = 0; it < 4; ++it) {
        f32x4 ss = qs[it] * qs[it];
        ss.x = row16_sum(ss.x); ss.y = row16_sum(ss.y); ss.z = row16_sum(ss.z); ss.w = row16_sum(ss.w);
        if (l15 == 0) *(f32x4*)(sp + w * 64 + 16 * it + 4 * q4) = ss;
      }
      __syncthreads();
      if (w == 0) ssqp[(size_t)(64 * n + lane) * 8 + hh] = (sp[lane] + sp[64 + lane]) + (sp[128 + lane] + sp[192 + lane]);
#pragma unroll
      for (int it = 0; it < 4; ++it) {
        const float z0 = bflo(zc[it].x), z1 = bfhi(zc[it].x), z2 = bflo(zc[it].y), z3 = bfhi(zc[it].y);
        bf16_t* op = mixin + (size_t)(64 * n + 16 * it + 4 * q4) * 2048 + hh * 128 + dvc;
        op[0] = f2bf(qs[it].x * nw * z0); op[2048] = f2bf(qs[it].y * nw * z1);
        op[4096] = f2bf(qs[it].z * nw * z2); op[6144] = f2bf(qs[it].w * nw * z3);
      }
#pragma unroll
      for (int it = 0; it < 4; ++it) { uc[it] = un[it]; zc[it] = zn[it]; }
      gcur = gn;
    }
  }
  __syncthreads();
}
DI void gdn_fix_phase(const Params& P) {
  const int tid = opaque_tid();
  bf16_t* mixin = (bf16_t*)(P.ws + OFF_H); const float* ssqp = (const float*)(P.ws + OFF_SSQP);
  for (int idx = blockIdx.x * NT + tid; idx < S_ * 128; idx += gridDim.x * NT) {
    const int t = idx >> 7, ck = idx & 127, h = ck >> 4;
    const float r = rsqrtf((ssqp[(size_t)t * 8 + h] + ssqp[(size_t)S_ * 8 + (size_t)t * 8 + h]) * (1.f / 128.f) + EPS);
    u32x4* p = (u32x4*)(mixin + (size_t)t * 2048 + ck * 8); const u32x4 v = *p; float f[8]; unpack8(v, f);
    u32x4 o = {pack2(f[0] * r, f[1] * r), pack2(f[2] * r, f[3] * r), pack2(f[4] * r, f[5] * r), pack2(f[6] * r, f[7] * r)}; *p = o;
  }
}

DI void mla_attn_item(const Params& P, int hd, int b, char* smem) {
  const int tid = opaque_tid(), lane = tid & 63, w = tid >> 6, wq = w & 3, hk = w >> 2, lq = lane & 31, h = lane >> 5;
  const float* qraw = (const float*)(P.ws + OFF_QRAW);
  const bf16_t* Kg = (const bf16_t*)(P.ws + OFF_KMLA) + (size_t)hd * S_ * 192;
  const bf16_t* Vg = (const bf16_t*)(P.ws + OFF_VT) + (size_t)hd * 128 * S_;
  bf16_t* mixin = (bf16_t*)(P.ws + OFF_H);
  const int q = 128 * b + 32 * wq + lq;
  bf16x8 qf[12];
  {
    const float* qp = qraw + (size_t)q * 768 + hd * 192 + 8 * h;
    const float sc = 0.07216878364870322f * LOG2E;
#pragma unroll
    for (int s = 0; s < 8; ++s) { const f32x4 a = *(const f32x4*)(qp + 16 * s), c = *(const f32x4*)(qp + 16 * s + 4);
      qf[s] = pack8(a.x * sc, a.y * sc, a.z * sc, a.w * sc, c.x * sc, c.y * sc, c.z * sc, c.w * sc); }
    const double pq = (double)P.pos[q];
#pragma unroll
    for (int s2 = 0; s2 < 2; ++s2) {
      const f32x4 a0 = *(const f32x4*)(qp + 128 + 16 * s2), a1 = *(const f32x4*)(qp + 128 + 16 * s2 + 4);
      const f32x4 b0 = *(const f32x4*)(qp + 160 + 16 * s2), b1 = *(const f32x4*)(qp + 160 + 16 * s2 + 4);
      float x1[8] = {a0.x, a0.y, a0.z, a0.w, a1.x, a1.y, a1.z, a1.w}, x2[8] = {b0.x, b0.y, b0.z, b0.w, b1.x, b1.y, b1.z, b1.w}, o1[8], o2[8];
#pragma unroll
      for (int j = 0; j < 8; ++j) { double fr = pq * kInvFreq2Pi[16 * s2 + 8 * h + j]; fr -= floor(fr); const float ff = (float)fr;
        const float sn = __builtin_amdgcn_sinf(ff), cs = __builtin_amdgcn_cosf(ff);
        o1[j] = (x1[j] * cs - x2[j] * sn) * sc; o2[j] = (x2[j] * cs + x1[j] * sn) * sc; }
      qf[8 + s2] = pack8(o1[0], o1[1], o1[2], o1[3], o1[4], o1[5], o1[6], o1[7]);
      qf[10 + s2] = pack8(o2[0], o2[1], o2[2], o2[3], o2[4], o2[5], o2[6], o2[7]);
    }
  }
  constexpr int KST = 64 * 400, VST = 128 * 144, STG = KST + VST;
  f32x16 O[4];
#pragma unroll
  for (int i = 0; i < 4; ++i)
#pragma unroll
    for (int r = 0; r < 16; ++r) O[i][r] = 0.f;
  float m_i = -1e30f, l_i = 0.f;
  const int nt = 2 * b + 2;
  u32x4 rk[3], rv[2];
  const int vrow = tid >> 3, vcc = tid & 7;
#pragma unroll
  for (int i = 0; i < 3; ++i) { const int id = tid + NT * i, row = id / 24, cc = id % 24; rk[i] = *(const u32x4*)(Kg + row * 192 + cc * 8); }
#pragma unroll
  for (int i = 0; i < 2; ++i) rv[i] = *(const u32x4*)(Vg + (size_t)(vrow + 64 * i) * S_ + vcc * 8);
#pragma unroll
  for (int i = 0; i < 3; ++i) { const int id = tid + NT * i, row = id / 24, cc = id % 24; *(u32x4*)(smem + row * 400 + cc * 16) = rk[i]; }
#pragma unroll
  for (int i = 0; i < 2; ++i) *(u32x4*)(smem + KST + (vrow + 64 * i) * 144 + vcc * 16) = rv[i];
  __syncthreads();
  for (int kt = 0; kt < nt; ++kt) {
    const char* sK = smem + (kt & 1) * STG; const char* sV = sK + KST;
    const bool more = (kt + 1 < nt);
    if (more) { const size_t ko = (size_t)(kt + 1) * 64 * 192; const int vo = (kt + 1) * 64;
#pragma unroll
      for (int i = 0; i < 3; ++i) { const int id = tid + NT * i, row = id / 24, cc = id % 24; rk[i] = *(const u32x4*)(Kg + ko + row * 192 + cc * 8); }
#pragma unroll
      for (int i = 0; i < 2; ++i) rv[i] = *(const u32x4*)(Vg + (size_t)(vrow + 64 * i) * S_ + vo + vcc * 8); }
    const int key0 = 64 * kt + 32 * hk;
    if (key0 <= 128 * b + 32 * wq) {
      f32x16 st;
#pragma unroll
      for (int r = 0; r < 16; ++r) st[r] = 0.f;
#pragma unroll
      for (int s = 0; s < 12; ++s) { const bf16x8 kf = *(const bf16x8*)(sK + (32 * hk + lq) * 400 + (2 * s + h) * 16); st = MFMA32(kf, qf[s], st); }
      if (key0 + 31 > 128 * b + 32 * wq) {
        int qrel = q - key0 - 4 * h; asm volatile("" : "+v"(qrel));
#pragma unroll
        for (int r = 0; r < 16; ++r) if ((r & 3) + 8 * (r >> 2) > qrel) st[r] = -1e30f;
      }
      float mx = st[0];
#pragma unroll
      for (int r = 1; r < 16; ++r) mx = fmaxf(mx, st[r]);
      mx = fmaxf(mx, __shfl_xor(mx, 32));
      const float m_new = fmaxf(m_i, mx), alpha = exp2f(m_i - m_new);
      float ps = 0.f;
#pragma unroll
      for (int r = 0; r < 16; ++r) { st[r] = exp2f(st[r] - m_new); ps += st[r]; }
      l_i = l_i * alpha + ps; m_i = m_new;
#pragma unroll
      for (int i = 0; i < 4; ++i)
#pragma unroll
        for (int r = 0; r < 16; ++r) O[i][r] *= alpha;
      bf16x8 pf[2];
#pragma unroll
      for (int s = 0; s < 2; ++s) pf[s] = pack8(st[8 * s], st[8 * s + 1], st[8 * s + 2], st[8 * s + 3], st[8 * s + 4], st[8 * s + 5], st[8 * s + 6], st[8 * s + 7]);
#pragma unroll
      for (int i = 0; i < 4; ++i)
#pragma unroll
        for (int s = 0; s < 2; ++s) { const char* vp = sV + (32 * i + lq) * 144 + (32 * hk + 16 * s + 4 * h) * 2;
          const u32x2 lo = *(const u32x2*)vp, hi = *(const u32x2*)(vp + 16); u32x4 vv = {lo.x, lo.y, hi.x, hi.y};
          O[i] = MFMA32(__builtin_bit_cast(bf16x8, vv), pf[s], O[i]); }
    }
    if (more) { char* dK = smem + ((kt + 1) & 1) * STG;
#pragma unroll
      for (int i = 0; i < 3; ++i) { const int id = tid + NT * i, row = id / 24, cc = id % 24; *(u32x4*)(dK + row * 400 + cc * 16) = rk[i]; }
#pragma unroll
      for (int i = 0; i < 2; ++i) *(u32x4*)(dK + KST + (vrow + 64 * i) * 144 + vcc * 16) = rv[i]; }
    __syncthreads();
  }
  float* cO = (float*)smem; float* cm = cO + 4 * 4096; float* cl = cm + 256;
  if (hk == 1) {
#pragma unroll
    for (int i = 0; i < 4; ++i)
#pragma unroll
      for (int r = 0; r < 16; ++r) cO[wq * 4096 + (i * 16 + r) * 64 + lane] = O[i][r];
    cm[wq * 64 + lane] = m_i; cl[wq * 64 + lane] = l_i;
  }
  __syncthreads();
  if (hk == 0) {
    const float m1 = cm[wq * 64 + lane], l1 = cl[wq * 64 + lane];
    const float m = fmaxf(m_i, m1), a0 = exp2f(m_i - m), a1 = exp2f(m1 - m);
    float lt = l_i * a0 + l1 * a1; lt += __shfl_xor(lt, 32);
    const float inv = 1.f / lt;
    bf16_t* op = mixin + (size_t)q * 2048 + 1024 + hd * 128;
#pragma unroll
    for (int i = 0; i < 4; ++i)
#pragma unroll
      for (int rg = 0; rg < 4; ++rg) { float v[4];
#pragma unroll
        for (int e = 0; e < 4; ++e) v[e] = (O[i][4 * rg + e] * a0 + cO[wq * 4096 + (i * 16 + 4 * rg + e) * 64 + lane] * a1) * inv;
        u32x2 pk = {pack2(v[0], v[1]), pack2(v[2], v[3])}; *(u32x2*)(op + 32 * i + 8 * rg + 4 * h) = pk; }
  }
  __syncthreads();
}

DI void swa_item(const Params& P, int l, int n, int hk2, char* smem) {
  const int tid = opaque_tid(), lane = tid & 63, w = tid >> 6, lq = lane & 31, h = lane >> 5;
  const bf16_t* proj = (const bf16_t*)(P.ws + OFF_PROJ); bf16_t* mixin = (bf16_t*)(P.ws + OFF_H);
  bf16_t* sVt = (bf16_t*)smem;
#pragma unroll
  for (int i = 0; i < 4; ++i) { const int id = tid + NT * i, key = id >> 3, dc = id & 7; const int kp = 128 * (n - 1) + key;
    u32x4 v = {0u, 0u, 0u, 0u}; if (kp >= 0) v = *(const u32x4*)(proj + (size_t)kp * DINP + C_CV + hk2 * 64 + dc * 8);
    sVt[(8 * dc + 0) * 264 + key] = (bf16_t)(v.x & 0xffff); sVt[(8 * dc + 1) * 264 + key] = (bf16_t)(v.x >> 16);
    sVt[(8 * dc + 2) * 264 + key] = (bf16_t)(v.y & 0xffff); sVt[(8 * dc + 3) * 264 + key] = (bf16_t)(v.y >> 16);
    sVt[(8 * dc + 4) * 264 + key] = (bf16_t)(v.z & 0xffff); sVt[(8 * dc + 5) * 264 + key] = (bf16_t)(v.z >> 16);
    sVt[(8 * dc + 6) * 264 + key] = (bf16_t)(v.w & 0xffff); sVt[(8 * dc + 7) * 264 + key] = (bf16_t)(v.w >> 16); }
  __syncthreads();
  const int g = w >> 1, hq = hk2 * 4 + g;
  const float slope = exp2f(-(float)(hq + 1)) * LOG2E, sinkv = P.swa_sinks[l * 8 + hq] * LOG2E;
#pragma unroll 1
  for (int jj = 0; jj < 2; ++jj) {
    const int j = 2 * (w & 1) + jj; const int qrow = 128 * n + 32 * j + lq;
    bf16x8 qf[4];
#pragma unroll
    for (int s = 0; s < 4; ++s) qf[s] = *(const bf16x8*)(proj + (size_t)qrow * DINP + C_CQ + hq * 64 + 16 * s + 8 * h);
    f32x16 st[5];
    bf16x8 kf[2][4];
    { const int kp = 128 * (n - 1) + 32 * j + lq;
#pragma unroll
      for (int s = 0; s < 4; ++s) { kf[0][s] = (bf16x8){0, 0, 0, 0, 0, 0, 0, 0}; if (kp >= 0) kf[0][s] = *(const bf16x8*)(proj + (size_t)kp * DINP + C_CK + hk2 * 64 + 16 * s + 8 * h); } }
#pragma unroll
    for (int tt = 0; tt < 5; ++tt) {
      if (tt + 1 < 5) { const int kp = 128 * (n - 1) + 32 * (j + tt + 1) + lq;
#pragma unroll
        for (int s = 0; s < 4; ++s) { kf[(tt + 1) & 1][s] = (bf16x8){0, 0, 0, 0, 0, 0, 0, 0}; if (kp >= 0) kf[(tt + 1) & 1][s] = *(const bf16x8*)(proj + (size_t)kp * DINP + C_CK + hk2 * 64 + 16 * s + 8 * h); } }
      __builtin_amdgcn_sched_barrier(0);
#pragma unroll
      for (int r = 0; r < 16; ++r) st[tt][r] = 0.f;
#pragma unroll
      for (int s = 0; s < 4; ++s) st[tt] = MFMA32(kf[tt & 1][s], qf[s], st[tt]);
      __builtin_amdgcn_sched_barrier(0);
    }
    float mx = sinkv;
    int dbase = 128 + lq - 4 * h, kbase = 128 * (n - 1) + 32 * j + 4 * h;
    asm volatile("" : "+v"(dbase), "+v"(kbase));
#pragma unroll
    for (int tt = 0; tt < 5; ++tt)
#pragma unroll
      for (int r = 0; r < 16; ++r) { const int cst = 32 * tt + (r & 3) + 8 * (r >> 2); const int dist = dbase - cst; const int kpos = kbase + cst;
        const bool valid = (dist >= 0) && (dist < 128) && (kpos >= 0);
        const float sv = valid ? st[tt][r] * (0.125f * LOG2E) - slope * (float)dist : -1e30f; st[tt][r] = sv; mx = fmaxf(mx, sv); }
    mx = fmaxf(mx, __shfl_xor(mx, 32));
    float den = 0.f;
#pragma unroll
    for (int tt = 0; tt < 5; ++tt)
#pragma unroll
      for (int r = 0; r < 16; ++r) { const float p = exp2f(st[tt][r] - mx); st[tt][r] = p; den += p; }
    den += __shfl_xor(den, 32); den += exp2f(sinkv - mx);
    f32x16 O[2];
#pragma unroll
    for (int i = 0; i < 2; ++i)
#pragma unroll
      for (int r = 0; r < 16; ++r) O[i][r] = 0.f;
#pragma unroll
    for (int tt = 0; tt < 5; ++tt)
#pragma unroll
      for (int s = 0; s < 2; ++s) { const bf16x8 pf = pack8(st[tt][8 * s], st[tt][8 * s + 1], st[tt][8 * s + 2], st[tt][8 * s + 3], st[tt][8 * s + 4], st[tt][8 * s + 5], st[tt][8 * s + 6], st[tt][8 * s + 7]);
#pragma unroll
        for (int i = 0; i < 2; ++i) { const char* vp = (const char*)sVt + (32 * i + lq) * 528 + (32 * (j + tt) + 16 * s + 4 * h) * 2;
          const u32x2 lo = *(const u32x2*)vp, hi = *(const u32x2*)(vp + 16); u32x4 vv = {lo.x, lo.y, hi.x, hi.y};
          O[i] = MFMA32(__builtin_bit_cast(bf16x8, vv), pf, O[i]); }
        __builtin_amdgcn_sched_barrier(0); }
    const float inv = 1.f / den;
    bf16_t* op = mixin + (size_t)qrow * 2048 + 1536 + hq * 64;
#pragma unroll
    for (int i = 0; i < 2; ++i)
#pragma unroll
      for (int rg = 0; rg < 4; ++rg) { u32x2 pk = {pack2(O[i][4 * rg] * inv, O[i][4 * rg + 1] * inv), pack2(O[i][4 * rg + 2] * inv, O[i][4 * rg + 3] * inv)};
        *(u32x2*)(op + 32 * i + 8 * rg + 4 * h) = pk; }
  }
  __syncthreads();
}

DI float gelu_tanh(float x) { const float y = 0.7978845608028654f * (x + 0.044715f * x * x * x); const float t = 1.f - 2.f / (1.f + __expf(2.f * y)); return 0.5f * x * (1.f + t); }
DI void ffn_act_phase(const Params& P, int l) {
  const int tid = opaque_tid(), lane = tid & 63, w = tid >> 6;
  const bf16_t* u = (const bf16_t*)(P.ws + OFF_BIG); bf16_t* act = (bf16_t*)(P.ws + OFF_ACT);
  const float* cw = P.ffn_conv + (size_t)l * 3 * DFF2; const float* cb = P.ffn_conv_b + (size_t)l * DFF2;
  for (int item = blockIdx.x * 8 + w; item < 512 * 11; item += gridDim.x * 8) {
    const int cbk = item % 11, rr = item / 11; const int ch = cbk * 512 + lane * 8, r0 = rr * 32;
    float wg[3][8], wu[3][8], bg[8], bu[8];
#pragma unroll
    for (int j = 0; j < 3; ++j)
#pragma unroll
      for (int e4 = 0; e4 < 2; ++e4) { const f32x4 a = *(const f32x4*)(cw + (size_t)j * DFF2 + ch + 4 * e4), b = *(const f32x4*)(cw + (size_t)j * DFF2 + DFF + ch + 4 * e4);
        wg[j][4 * e4] = a.x; wg[j][4 * e4 + 1] = a.y; wg[j][4 * e4 + 2] = a.z; wg[j][4 * e4 + 3] = a.w; wu[j][4 * e4] = b.x; wu[j][4 * e4 + 1] = b.y; wu[j][4 * e4 + 2] = b.z; wu[j][4 * e4 + 3] = b.w; }
#pragma unroll
    for (int e4 = 0; e4 < 2; ++e4) { const f32x4 a = *(const f32x4*)(cb + ch + 4 * e4), b = *(const f32x4*)(cb + DFF + ch + 4 * e4);
      bg[4 * e4] = a.x; bg[4 * e4 + 1] = a.y; bg[4 * e4 + 2] = a.z; bg[4 * e4 + 3] = a.w; bu[4 * e4] = b.x; bu[4 * e4 + 1] = b.y; bu[4 * e4 + 2] = b.z; bu[4 * e4 + 3] = b.w; }
    float g2[8], g1[8], u2[8], u1[8];
#pragma unroll
    for (int e = 0; e < 8; ++e) { g2[e] = 0.f; g1[e] = 0.f; u2[e] = 0.f; u1[e] = 0.f; }
    if (r0 >= 2) { unpack8(*(const u32x4*)(u + (size_t)(r0 - 2) * DFF2 + ch), g2); unpack8(*(const u32x4*)(u + (size_t)(r0 - 2) * DFF2 + DFF + ch), u2);
      unpack8(*(const u32x4*)(u + (size_t)(r0 - 1) * DFF2 + ch), g1); unpack8(*(const u32x4*)(u + (size_t)(r0 - 1) * DFF2 + DFF + ch), u1); }
#pragma unroll 1
    for (int rb = 0; rb < 4; ++rb) {
      u32x4 G[8], U[8];
#pragma unroll
      for (int i = 0; i < 8; ++i) { const size_t ro = (size_t)(r0 + rb * 8 + i) * DFF2 + ch; G[i] = *(const u32x4*)(u + ro); U[i] = *(const u32x4*)(u + ro + DFF); }
#pragma unroll
      for (int i = 0; i < 8; ++i) {
        float g0[8], u0[8]; unpack8(G[i], g0); unpack8(U[i], u0);
        float o[8];
#pragma unroll
        for (int e = 0; e < 8; ++e) { const float yg = wg[0][e] * g2[e] + wg[1][e] * g1[e] + wg[2][e] * g0[e] + bg[e]; const float yu = wu[0][e] * u2[e] + wu[1][e] * u1[e] + wu[2][e] * u0[e] + bu[e];
          o[e] = gelu_tanh(yg) * yu; g2[e] = g1[e]; g1[e] = g0[e]; u2[e] = u1[e]; u1[e] = u0[e]; }
        u32x4 pk = {pack2(o[0], o[1]), pack2(o[2], o[3]), pack2(o[4], o[5]), pack2(o[6], o[7])};
        *(u32x4*)(act + (size_t)(r0 + rb * 8 + i) * DFF + ch) = pk;
      }
    }
  }
}

__global__ void __launch_bounds__(NT) fwd_megakernel(Params P0) {
  cg::grid_group grid = cg::this_grid();
  __shared__ __attribute__((aligned(16))) char smem[132352];
  const int tid = threadIdx.x;
  char* ws = P0.ws;
  int* ctrl = (int*)(ws + OFF_CTRL);
  if (blockIdx.x == 0 && tid < 64) ctrl[tid] = 0;
  if (blockIdx.x == 0 && tid == 0) *(Params*)(ws + OFF_CTRL + 1024) = P0;
  bf16_t* Hb = (bf16_t*)(ws + OFF_H);
  for (int it = blockIdx.x; it < 192 + CV_T5; it += gridDim.x) { if (it < 192) mod_item(P0, it); else convert_item(P0, 0, it - 192, smem); }
  grid.sync();
  const Params& P = *(const Params*)(ws + OFF_CTRL + 1024);
  rownorm_phase(P, P.x, nullptr, P.out, Hb, 0, 0, nullptr, 0, 1, 0, P.mix_pre, smem);
  grid.sync();
  for (int l = 0; l < 2; ++l) {
    { EpiProj epi{(bf16_t*)(ws + OFF_PROJ), (float*)(ws + OFF_AB)}; gemm_phase(Hb, 2048, (const bf16_t*)(ws + OFF_W + W_IN), 2048, 2048, 64, 22, smem, epi); }
    grid.sync();
    for (int it = blockIdx.x; it < 448; it += gridDim.x) {
      if (it < 192) mla_q_tile(P, it / 3, it % 3, smem);
      else mla_kv_tile(P, (it - 192) >> 2, (it - 192) & 3, smem);
    }
    for (int id = (blockIdx.x + 64) % gridDim.x; id < 2048; id += gridDim.x) gdn_prep_item(P, l, id >> 3, id & 7, smem);
    grid.sync();
    {
      int* sitem = (int*)(smem + 132096);
      for (;;) {
        if (tid == 0) *sitem = atomicAdd(ctrl + 16 * l, 1);
        __syncthreads(); const int item = *sitem; __syncthreads();
        if (item >= 16 + 512 + 256) break;
        if (item < 16) gdn_scan_item(P, l, item >> 1, item & 1, smem);
        else if (item < 528) { const int idx = item - 16; mla_attn_item(P, idx & 3, 127 - (idx >> 2), smem); }
        else { const int idx = item - 528; swa_item(P, l, idx >> 1, idx & 1, smem); }
      }
    }
    grid.sync();
    gdn_fix_phase(P);
    grid.sync();
    { EpiF32 epi{(float*)(ws + OFF_MIXF), 2048}; gemm_phase(Hb, 2048, (const bf16_t*)(ws + OFF_W + W_OUT), 2048, 2048, 64, 8, smem, epi); }
    grid.sync();
    rownorm_phase(P, P.out, (const float*)(ws + OFF_MIXF), P.out, Hb, l, 2, P.mix_post + l * 2048, l, 4, 3, P.ffn_pre + l * 2048, smem);
    grid.sync();
    { EpiBf epi{(bf16_t*)(ws + OFF_BIG), DFF2}; gemm_phase(Hb, 2048, (const bf16_t*)(ws + OFF_W + W_UP), 2048, 2048, 64, 44, smem, epi); }
    grid.sync();
    ffn_act_phase(P, l);
    grid.sync();
    { EpiF32 epi{(float*)(ws + OFF_Y), 2048}; gemm_phase((const bf16_t*)(ws + OFF_ACT), DFF, (const bf16_t*)(ws + OFF_W + W_DOWN), DFF, DFF, 64, 8, smem, epi); }
    grid.sync();
    if (l == 0) {
      for (int it = blockIdx.x; it < CV_T5; it += gridDim.x) convert_item(P, 1, it, smem);
      rownorm_phase(P, P.out, (const float*)(ws + OFF_Y), P.out, Hb, 0, 5, P.ffn_post, 1, 1, 0, P.mix_pre + 2048, smem);
      grid.sync();
    } else {
      rownorm_phase(P, P.out, (const float*)(ws + OFF_Y), P.out, nullptr, 1, 5, P.ffn_post + 2048, 1, 1, 0, nullptr, smem);
    }
  }
}

extern "C" void kernel_launch(void* const* d_in, const int* in_sizes, int n_in, void* d_out, int out_size, void* d_ws, size_t ws_size, hipStream_t stream) {
  static int grid_blocks = 0;
  if (!grid_blocks) {
    int dev = 0, cus = 0, per = 0;
    (void)hipGetDevice(&dev); (void)hipDeviceGetAttribute(&cus, hipDeviceAttributeMultiprocessorCount, dev);
    (void)hipOccupancyMaxActiveBlocksPerMultiprocessor(&per, fwd_megakernel, NT, 0);
    if (per > 1) per = 1;
    grid_blocks = cus * per; if (grid_blocks <= 0) grid_blocks = 256;
  }
  if (ws_size < OFF_END) { fprintf(stderr, "workspace too small: %zu < %zu\n", ws_size, (size_t)OFF_END); return; }
  Params p{};
  p.x = (const float*)d_in[0]; p.c = (const float*)d_in[1]; p.pos = (const int*)d_in[2];
  p.ada_w = (const float*)d_in[3]; p.ada_b = (const float*)d_in[4]; p.mix_pre = (const float*)d_in[5]; p.mix_post = (const float*)d_in[6];
  p.w_in = (const float*)d_in[7]; p.w_out = (const float*)d_in[8]; p.gdn_conv = (const float*)d_in[9]; p.gdn_a_log = (const float*)d_in[10];
  p.gdn_dt_bias = (const float*)d_in[11]; p.gdn_norm = (const float*)d_in[12]; p.mla_q_norm = (const float*)d_in[13]; p.mla_w_uq = (const float*)d_in[14];
  p.mla_kv_norm = (const float*)d_in[15]; p.mla_w_ukv = (const float*)d_in[16]; p.swa_sinks = (const float*)d_in[17]; p.ffn_pre = (const float*)d_in[18];
  p.ffn_post = (const float*)d_in[19]; p.ffn_w_up = (const float*)d_in[20]; p.ffn_conv = (const float*)d_in[21]; p.ffn_conv_b = (const float*)d_in[22];
  p.ffn_w_down = (const float*)d_in[23];
  p.out = (float*)d_out; p.ws = (char*)d_ws;
  void* args[] = {&p};
  hipError_t e = hipLaunchCooperativeKernel((void*)fwd_megakernel, dim3(grid_blocks), dim3(NT), args, 0, stream);
  if (e != hipSuccess) fprintf(stderr, "cooperative launch failed: %s (grid %d)\n", hipGetErrorString(e), grid_blocks);
}
```

```cpp
#include <hip/hip_runtime.h>
#include <hip/hip_cooperative_groups.h>
#include <cstdio>
#include <cstdint>
namespace cg = cooperative_groups;

#define DI __device__ __forceinline__
typedef unsigned short bf16_t;
typedef short bf16x8 __attribute__((ext_vector_type(8)));
typedef float f32x2 __attribute__((ext_vector_type(2)));
typedef float f32x4 __attribute__((ext_vector_type(4)));
typedef float f32x16 __attribute__((ext_vector_type(16)));
typedef unsigned u32x2 __attribute__((ext_vector_type(2)));
typedef unsigned u32x4 __attribute__((ext_vector_type(4)));
typedef __bf16 bf2_t __attribute__((ext_vector_type(2)));

constexpr int S_ = 16384, D_ = 2048, DINP = 5632, DFF = 5632, DFF2 = 11264;
constexpr int NT = 512;
constexpr float EPS = 1e-6f;
constexpr float LOG2E = 1.4426950408889634f;

constexpr size_t OFF_CTRL = 0;
constexpr size_t OFF_MODP = 4096;
constexpr size_t OFF_W = 2097152;
constexpr size_t W_IN = 0, W_OUT = W_IN + (size_t)5632 * 2048 * 2, W_UP = W_OUT + (size_t)2048 * 2048 * 2,
                 W_DOWN = W_UP + (size_t)11264 * 2048 * 2, W_UQ = W_DOWN + (size_t)2048 * 5632 * 2,
                 W_UKV = W_UQ + (size_t)768 * 448 * 2, W_END = W_UKV + (size_t)1024 * 128 * 2;
constexpr size_t OFF_H = OFF_W + W_END;
constexpr size_t OFF_MIXF = OFF_H + (size_t)S_ * 2048 * 2;
constexpr size_t OFF_QRAW = OFF_MIXF;
constexpr size_t OFF_KMLA = OFF_QRAW + (size_t)S_ * 768 * 4;
constexpr size_t OFF_VT = OFF_KMLA + (size_t)4 * S_ * 192 * 2;
constexpr size_t OFF_BIG = OFF_MIXF + (size_t)S_ * 2048 * 4;
constexpr size_t OFF_PROJ = OFF_BIG;
constexpr size_t OFF_WP = OFF_PROJ + (size_t)S_ * DINP * 2;
constexpr size_t OFF_QD = OFF_WP + (size_t)S_ * 1024 * 2;
constexpr size_t OFF_KT = OFF_QD + (size_t)S_ * 1024 * 2;
constexpr size_t OFF_ZT = OFF_KT + (size_t)S_ * 1024 * 2;
constexpr size_t OFF_QK = OFF_ZT + (size_t)S_ * 1024 * 2;
constexpr size_t OFF_AB = OFF_QK + (size_t)S_ * 512 * 2;
constexpr size_t OFF_GTOT = OFF_AB + (size_t)S_ * 16 * 4;
constexpr size_t OFF_Y = OFF_BIG;
constexpr size_t OFF_ACT = OFF_H;
constexpr size_t OFF_UT = OFF_BIG + (size_t)S_ * DFF2 * 2;
constexpr size_t OFF_END = OFF_UT + (size_t)S_ * 1024 * 4;
static_assert(OFF_GTOT + 8192 <= OFF_UT, "overlay");
static_assert(OFF_VT + (size_t)4 * 128 * S_ * 2 <= OFF_BIG, "overlay2");

constexpr int C_AQ = 0, C_AK = 1024, C_AV = 2048, C_AZ = 3072, C_AA = 4096, C_BCQ = 4112, C_BCKV = 4560,
              C_BKR = 4688, C_CQ = 4752, C_CK = 5264, C_CV = 5392;

__constant__ double kInvFreq2Pi[32] = {
    0.15915494309189535, 0.11934937021124886, 0.08949940160889101, 0.06711508300522726, 0.050329212104487035, 0.03774158471741977,
    0.0283021958306234, 0.02122365276477766, 0.015915494309189534, 0.011934937021124886, 0.008949940160889102, 0.006711508300522725,
    0.005032921210448704, 0.003774158471741977, 0.00283021958306234, 0.0021223652764777662, 0.0015915494309189536, 0.0011934937021124885,
    0.0008949940160889102, 0.0006711508300522726, 0.0005032921210448703, 0.00037741584717419774, 0.00028302195830623395, 0.0002122365276477766,
    0.00015915494309189535, 0.00011934937021124886, 8.949940160889102e-05, 6.711508300522725e-05, 5.0329212104487035e-05, 3.774158471741978e-05,
    2.8302195830623396e-05, 2.122365276477766e-05};

struct Params {
  const float* x; const float* c; const int* pos;
  const float *ada_w, *ada_b, *mix_pre, *mix_post, *w_in, *w_out, *gdn_conv, *gdn_a_log, *gdn_dt_bias, *gdn_norm, *mla_q_norm, *mla_w_uq,
      *mla_kv_norm, *mla_w_ukv, *swa_sinks, *ffn_pre, *ffn_post, *ffn_w_up, *ffn_conv, *ffn_conv_b, *ffn_w_down;
  float* out; char* ws;
};

DI unsigned pack2(float lo, float hi) { f32x2 v = {lo, hi}; bf2_t b = __builtin_convertvector(v, bf2_t); return __builtin_bit_cast(unsigned, b); }
DI bf16_t f2bf(float x) { return (bf16_t)(pack2(x, 0.f) & 0xffffu); }
DI float bflo(unsigned u) { return __uint_as_float(u << 16); }
DI float bfhi(unsigned u) { return __uint_as_float(u & 0xffff0000u); }
DI void unpack8(const u32x4& v, float* f) { f[0] = bflo(v.x); f[1] = bfhi(v.x); f[2] = bflo(v.y); f[3] = bfhi(v.y); f[4] = bflo(v.z); f[5] = bfhi(v.z); f[6] = bflo(v.w); f[7] = bfhi(v.w); }
DI bf16x8 pack8(float a0, float a1, float a2, float a3, float a4, float a5, float a6, float a7) {
  u32x4 p = {pack2(a0, a1), pack2(a2, a3), pack2(a4, a5), pack2(a6, a7)}; return __builtin_bit_cast(bf16x8, p); }
DI float silu_f(float x) { return x / (1.f + __expf(-x)); }
DI float wave_sum(float v) { v += __shfl_xor(v, 32); v += __shfl_xor(v, 16); v += __shfl_xor(v, 8); v += __shfl_xor(v, 4); v += __shfl_xor(v, 2); v += __shfl_xor(v, 1); return v; }
DI int opaque_tid() { int t = threadIdx.x; asm volatile("" : "+v"(t)); return t; }
DI int crow(int r, int h) { return (r & 3) + 8 * (r >> 2) + 4 * h; }
DI int perm32(int k) { return 8 * ((k >> 2) & 3) + 4 * (k >> 4) + (k & 3); }
#define MFMA32(a, b, c) __builtin_amdgcn_mfma_f32_32x32x16_bf16((a), (b), (c), 0, 0, 0)
#define MFMA16(a, b, c) __builtin_amdgcn_mfma_f32_16x16x32_bf16((a), (b), (c), 0, 0, 0)

template <class Epi>
DI void gemm_tile(const bf16_t* __restrict__ A, int lda, const bf16_t* __restrict__ Bt, int ldb, int K, int m0, int n0, char* smem, const Epi& epi) {
  const int tid = opaque_tid(), lane = tid & 63, w = tid >> 6, wm = w >> 2, wn = w & 3, lq = lane & 31, h = lane >> 5;
  f32x16 acc[2][4];
#pragma unroll
  for (int i = 0; i < 2; ++i)
#pragma unroll
    for (int j = 0; j < 4; ++j)
#pragma unroll
      for (int r = 0; r < 16; ++r) acc[i][j][r] = 0.f;
  const int r0 = tid >> 3, c0 = tid & 7;
  const bf16_t* ag = A + (size_t)(m0 + r0) * lda + c0 * 8;
  const bf16_t* bg = Bt + (size_t)(n0 + r0) * ldb + c0 * 8;
  const int wofs = r0 * 128 + ((c0 ^ ((r0 >> 1) & 7)) << 4);
  char* sA = smem; char* sB = smem + 65536;
  u32x4 ra0[4], rb0[4], ra1[4], rb1[4];
  const int nk = K >> 6, swz = (lane >> 1) & 7;
  const int aoff = (64 * wn + lq) * 128, boff = (128 * wm + lq) * 128;
#define GLOAD(RA, RB, KT) { _Pragma("unroll") for (int i = 0; i < 4; ++i) { RA[i] = *(const u32x4*)(ag + (size_t)(KT) * 64 + (size_t)i * 64 * lda); RB[i] = *(const u32x4*)(bg + (size_t)(KT) * 64 + (size_t)i * 64 * ldb); } }
#define LWRITE(RA, RB, ST) { _Pragma("unroll") for (int i = 0; i < 4; ++i) { *(u32x4*)(sA + (ST) * 32768 + wofs + i * 8192) = RA[i]; *(u32x4*)(sB + (ST) * 32768 + wofs + i * 8192) = RB[i]; } }
#define KSTEP(ST, RA, RB, KN) { const char* cA = sA + (ST) * 32768; const char* cB = sB + (ST) * 32768; char* dA = sA + (1 - (ST)) * 32768; char* dB = sB + (1 - (ST)) * 32768; \
    const bf16_t* agn = ag + (size_t)(KN) * 64; const bf16_t* bgn = bg + (size_t)(KN) * 64; \
    _Pragma("unroll") for (int s = 0; s < 4; ++s) { const int co = (((2 * s + h) ^ swz) << 4); bf16x8 fa[2], fb[4]; \
      _Pragma("unroll") for (int ni = 0; ni < 2; ++ni) fa[ni] = *(const bf16x8*)(cB + aoff + ni * 4096 + co); \
      _Pragma("unroll") for (int mi = 0; mi < 4; ++mi) fb[mi] = *(const bf16x8*)(cA + boff + mi * 4096 + co); \
      *(u32x4*)(dA + wofs + s * 8192) = RA[s]; *(u32x4*)(dB + wofs + s * 8192) = RB[s]; \
      RA[s] = *(const u32x4*)(agn + (size_t)s * 64 * lda); RB[s] = *(const u32x4*)(bgn + (size_t)s * 64 * ldb); \
      _Pragma("unroll") for (int ni = 0; ni < 2; ++ni) _Pragma("unroll") for (int mi = 0; mi < 4; ++mi) acc[ni][mi] = MFMA32(fa[ni], fb[mi], acc[ni][mi]); \
      __builtin_amdgcn_sched_barrier(0); } }
  const int kl = nk - 1;
  GLOAD(ra0, rb0, 0);
  GLOAD(ra1, rb1, (1 < kl ? 1 : kl));
  LWRITE(ra0, rb0, 0);
  GLOAD(ra0, rb0, (2 < kl ? 2 : kl));
  __syncthreads();
  for (int kt = 0; kt < nk; kt += 2) {
    KSTEP(0, ra1, rb1, (kt + 3 < kl ? kt + 3 : kl));
    __syncthreads();
    if (kt + 1 < nk) {
      KSTEP(1, ra0, rb0, (kt + 4 < kl ? kt + 4 : kl));
      __syncthreads();
    }
  }
#undef GLOAD
#undef LWRITE
#undef KSTEP
#pragma unroll
  for (int ni = 0; ni < 2; ++ni)
#pragma unroll
    for (int mi = 0; mi < 4; ++mi)
#pragma unroll
      for (int rg = 0; rg < 4; ++rg) {
        const int m = m0 + 128 * wm + 32 * mi + lq, n = n0 + 64 * wn + 32 * ni + 8 * rg + 4 * h;
        epi(m, n, acc[ni][mi][4 * rg], acc[ni][mi][4 * rg + 1], acc[ni][mi][4 * rg + 2], acc[ni][mi][4 * rg + 3]);
      }
}

template <class Epi>
DI void gemm_tile_s(const bf16_t* __restrict__ A, int lda, const bf16_t* __restrict__ Bt, int ldb, int K, int m0, int n0, char* smem, const Epi& epi) {
  const int tid = opaque_tid(), lane = tid & 63, w = tid >> 6, wm = w >> 2, wn = w & 3, lq = lane & 31, h = lane >> 5;
  f32x16 acc[2][4];
#pragma unroll
  for (int i = 0; i < 2; ++i)
#pragma unroll
    for (int j = 0; j < 4; ++j)
#pragma unroll
      for (int r = 0; r < 16; ++r) acc[i][j][r] = 0.f;
  const int r0 = tid >> 3, c0 = tid & 7;
  const bf16_t* ag = A + (size_t)(m0 + r0) * lda + c0 * 8;
  const bf16_t* bg = Bt + (size_t)(n0 + r0) * ldb + c0 * 8;
  const int wofs = r0 * 128 + ((c0 ^ ((r0 >> 1) & 7)) << 4);
  char* sA = smem; char* sB = smem + 32768;
  u32x4 ra[4], rb[4];
#pragma unroll
  for (int i = 0; i < 4; ++i) { ra[i] = *(const u32x4*)(ag + (size_t)i * 64 * lda); rb[i] = *(const u32x4*)(bg + (size_t)i * 64 * ldb); }
#pragma unroll
  for (int i = 0; i < 4; ++i) { *(u32x4*)(sA + wofs + i * 8192) = ra[i]; *(u32x4*)(sB + wofs + i * 8192) = rb[i]; }
  __syncthreads();
  const int nk = K >> 6, swz = (lane >> 1) & 7;
  const int aoff = (64 * wn + lq) * 128, boff = (128 * wm + lq) * 128;
  for (int kt = 0; kt < nk; ++kt) {
    const char* cA = sA + (kt & 1) * 65536; const char* cB = sB + (kt & 1) * 65536;
    const bool more = (kt + 1 < nk);
    if (more) { ag += 64; bg += 64;
#pragma unroll
      for (int i = 0; i < 4; ++i) { ra[i] = *(const u32x4*)(ag + (size_t)i * 64 * lda); rb[i] = *(const u32x4*)(bg + (size_t)i * 64 * ldb); } }
#pragma unroll
    for (int s = 0; s < 4; ++s) {
      const int co = (((2 * s + h) ^ swz) << 4);
      bf16x8 fa[2], fb[4];
#pragma unroll
      for (int ni = 0; ni < 2; ++ni) fa[ni] = *(const bf16x8*)(cB + aoff + ni * 4096 + co);
#pragma unroll
      for (int mi = 0; mi < 4; ++mi) fb[mi] = *(const bf16x8*)(cA + boff + mi * 4096 + co);
#pragma unroll
      for (int ni = 0; ni < 2; ++ni)
#pragma unroll
        for (int mi = 0; mi < 4; ++mi) acc[ni][mi] = MFMA32(fa[ni], fb[mi], acc[ni][mi]);
    }
    if (more) { char* dA = sA + ((kt + 1) & 1) * 65536; char* dB = sB + ((kt + 1) & 1) * 65536;
#pragma unroll
      for (int i = 0; i < 4; ++i) { *(u32x4*)(dA + wofs + i * 8192) = ra[i]; *(u32x4*)(dB + wofs + i * 8192) = rb[i]; } }
    __syncthreads();
  }
#pragma unroll
  for (int ni = 0; ni < 2; ++ni)
#pragma unroll
    for (int mi = 0; mi < 4; ++mi)
#pragma unroll
      for (int rg = 0; rg < 4; ++rg) {
        const int m = m0 + 128 * wm + 32 * mi + lq, n = n0 + 64 * wn + 32 * ni + 8 * rg + 4 * h;
        epi(m, n, acc[ni][mi][4 * rg], acc[ni][mi][4 * rg + 1], acc[ni][mi][4 * rg + 2], acc[ni][mi][4 * rg + 3]);
      }
}

DI void tile_coord(int t, int npn, int& pm, int& pn) { const int g = t / (16 * npn), r = t % (16 * npn); pn = r >> 4; pm = g * 16 + (r & 15); }

struct EpiProj { bf16_t* proj; float* ab;
  DI void operator()(int m, int n, float v0, float v1, float v2, float v3) const {
    u32x2 pk = {pack2(v0, v1), pack2(v2, v3)}; *(u32x2*)(proj + (size_t)m * DINP + n) = pk;
    if (n >= C_AA && n < C_AA + 16) { f32x4 v = {v0, v1, v2, v3}; *(f32x4*)(ab + (size_t)m * 16 + (n - C_AA)) = v; } } };
struct EpiF32 { float* out; int ldc;
  DI void operator()(int m, int n, float v0, float v1, float v2, float v3) const { f32x4 v = {v0, v1, v2, v3}; *(f32x4*)(out + (size_t)m * ldc + n) = v; } };
struct EpiBf { bf16_t* out; int ldc;
  DI void operator()(int m, int n, float v0, float v1, float v2, float v3) const { u32x2 pk = {pack2(v0, v1), pack2(v2, v3)}; *(u32x2*)(out + (size_t)m * ldc + n) = pk; } };
struct EpiMlaQ { float* qraw; const float* rs; int m0;
  DI void operator()(int m, int n, float v0, float v1, float v2, float v3) const { const float r = rs[m - m0]; f32x4 v = {v0 * r, v1 * r, v2 * r, v3 * r}; *(f32x4*)(qraw + (size_t)m * 768 + n) = v; } };
struct EpiMlaKV { bf16_t* kmla; bf16_t* vt; const float* rs; int m0;
  DI void operator()(int m, int n, float v0, float v1, float v2, float v3) const {
    const float r = rs[m - m0]; const int hd = n >> 8, wi = n & 255;
    if (wi < 128) { u32x2 pk = {pack2(v0 * r, v1 * r), pack2(v2 * r, v3 * r)}; *(u32x2*)(kmla + ((size_t)hd * S_ + m) * 192 + wi) = pk; }
    else { bf16_t* p = vt + ((size_t)hd * 128 + (wi - 128)) * S_ + m; p[0] = f2bf(v0 * r); p[S_] = f2bf(v1 * r); p[2 * (size_t)S_] = f2bf(v2 * r); p[3 * (size_t)S_] = f2bf(v3 * r); } } };

template <class Epi>
DI void gemm_phase(const bf16_t* A, int lda, const bf16_t* Bt, int ldb, int K, int npm, int npn, char* smem, const Epi& epi) {
  if (gridDim.x == 256 && npm == 64) {
    const int b = blockIdx.x, pm = 8 * (b & 7) + ((b >> 3) & 7), pj = b >> 6;
    for (int pn = pj; pn < npn; pn += 4) gemm_tile(A, lda, Bt, ldb, K, pm * 256, pn * 256, smem, epi);
  } else {
    for (int t = blockIdx.x; t < npm * npn; t += gridDim.x) { int pm, pn; tile_coord(t, npn, pm, pn); gemm_tile(A, lda, Bt, ldb, K, pm * 256, pn * 256, smem, epi); }
  }
}

DI void mod_item(const Params& P, int item) {
  const int tid = opaque_tid(); const int l = item / 96, r = item % 96, ks = r / 6, nc = r % 6;
  const int n = nc * 2048 + tid * 4;
  const float* wp = P.ada_w + ((size_t)l * 2048 + ks * 128) * 12288 + n;
  f32x4 acc = {0.f, 0.f, 0.f, 0.f};
#pragma unroll 8
  for (int k = 0; k < 128; ++k) { const float cv = P.c[ks * 128 + k]; const float ca = silu_f(cv); const f32x4 wv = *(const f32x4*)(wp + (size_t)k * 12288); acc += wv * ca; }
  float* modp = (float*)(P.ws + OFF_MODP);
  *(f32x4*)(modp + ((size_t)l * 16 + ks) * 12288 + n) = acc;
}
DI void convert_tile(const float* __restrict__ src, int K, int N, bf16_t* __restrict__ dst, int tk, int tn, const float* rowscale, char* smem) {
  float* sm = (float*)smem; const int tid = opaque_tid(); const int k0 = tk * 64, n0 = tn * 256;
  { const int r = tid >> 6, c4 = tid & 63; const int n = n0 + 4 * c4;
    f32x4 v[8];
#pragma unroll
    for (int i = 0; i < 8; ++i) { v[i] = (f32x4){0.f, 0.f, 0.f, 0.f}; if (n < N) v[i] = *(const f32x4*)(src + (size_t)(k0 + r + 8 * i) * N + n); }
#pragma unroll
    for (int i = 0; i < 8; ++i) { const int kk = r + 8 * i; if (rowscale) v[i] *= rowscale[k0 + kk];
      sm[kk * 257 + 4 * c4 + 0] = v[i].x; sm[kk * 257 + 4 * c4 + 1] = v[i].y; sm[kk * 257 + 4 * c4 + 2] = v[i].z; sm[kk * 257 + 4 * c4 + 3] = v[i].w; } }
  __syncthreads();
  { const int n = tid >> 1, kh = tid & 1;
#pragma unroll
    for (int j = 0; j < 4; ++j) { float f[8];
#pragma unroll
      for (int i = 0; i < 8; ++i) f[i] = sm[(32 * kh + 8 * j + i) * 257 + n];
      u32x4 pk = {pack2(f[0], f[1]), pack2(f[2], f[3]), pack2(f[4], f[5]), pack2(f[6], f[7])};
      *(u32x4*)(dst + (size_t)(n0 + n) * K + k0 + 32 * kh + 8 * j) = pk; } }
  __syncthreads();
}
constexpr int CV_T0 = 32 * 22, CV_T1 = CV_T0 + 32 * 8, CV_T2 = CV_T1 + 32 * 44, CV_T3 = CV_T2 + 88 * 8, CV_T4 = CV_T3 + 7 * 3, CV_T5 = CV_T4 + 2 * 4;
DI void convert_item(const Params& P, int l, int it, char* smem) {
  char* wb = P.ws + OFF_W;
  if (it < CV_T0) convert_tile(P.w_in + (size_t)l * 2048 * 5520, 2048, 5520, (bf16_t*)(wb + W_IN), it / 22, it % 22, nullptr, smem);
  else if (it < CV_T1) { it -= CV_T0; convert_tile(P.w_out + (size_t)l * 2048 * 2048, 2048, 2048, (bf16_t*)(wb + W_OUT), it / 8, it % 8, nullptr, smem); }
  else if (it < CV_T2) { it -= CV_T1; convert_tile(P.ffn_w_up + (size_t)l * 2048 * 11264, 2048, 11264, (bf16_t*)(wb + W_UP), it / 44, it % 44, nullptr, smem); }
  else if (it < CV_T3) { it -= CV_T2; convert_tile(P.ffn_w_down + (size_t)l * 5632 * 2048, 5632, 2048, (bf16_t*)(wb + W_DOWN), it / 8, it % 8, nullptr, smem); }
  else if (it < CV_T4) { it -= CV_T3; convert_tile(P.mla_w_uq + (size_t)l * 448 * 768, 448, 768, (bf16_t*)(wb + W_UQ), it / 3, it % 3, P.mla_q_norm + l * 448, smem); }
  else { it -= CV_T4; convert_tile(P.mla_w_ukv + (size_t)l * 128 * 1024, 128, 1024, (bf16_t*)(wb + W_UKV), it / 4, it % 4, P.mla_kv_norm + l * 128, smem); }
}

DI float mod_val(const float* modp_l, const float* ada_b_l, int idx) { float s = ada_b_l[idx];
#pragma unroll
  for (int k = 0; k < 16; ++k) s += modp_l[(size_t)k * 12288 + idx]; return s; }
DI void rownorm_phase(const Params& P, const float* xin, const bf16_t* yin, float* xout, bf16_t* hout, int lg, int gate_idx, const float* w_post,
                      int lh, int scale_idx, int shift_idx, const float* w_pre, char* smem) {
  float* A1 = (float*)smem; float* A2 = A1 + 2048; float* B2 = A2 + 2048;
  const int tid = opaque_tid(), lane = tid & 63, w = tid >> 6;
  const float* modp = (const float*)(P.ws + OFF_MODP);
  for (int cidx = tid; cidx < 2048; cidx += NT) {
    if (yin) A1[cidx] = mod_val(modp + (size_t)lg * 16 * 12288, P.ada_b + (size_t)lg * 12288, gate_idx * 2048 + cidx) * w_post[cidx];
    if (hout) { A2[cidx] = w_pre[cidx] * (1.f + mod_val(modp + (size_t)lh * 16 * 12288, P.ada_b + (size_t)lh * 12288, scale_idx * 2048 + cidx));
      B2[cidx] = mod_val(modp + (size_t)lh * 16 * 12288, P.ada_b + (size_t)lh * 12288, shift_idx * 2048 + cidx); }
  }
  __syncthreads();
  for (int row = blockIdx.x * 8 + w; row < S_; row += gridDim.x * 8) {
    f32x4 xv[8];
#pragma unroll
    for (int j = 0; j < 8; ++j) xv[j] = *(const f32x4*)(xin + (size_t)row * 2048 + (j * 64 + lane) * 4);
    if (yin) {
      f32x4 yv[8]; float ss = 0.f;
#pragma unroll
      for (int j = 0; j < 8; ++j) { const u32x2 yb = *(const u32x2*)(yin + (size_t)row * 2048 + (j * 64 + lane) * 4); yv[j] = (f32x4){bflo(yb.x), bfhi(yb.x), bflo(yb.y), bfhi(yb.y)};
        ss += yv[j].x * yv[j].x + yv[j].y * yv[j].y + yv[j].z * yv[j].z + yv[j].w * yv[j].w; }
      ss = wave_sum(ss); const float r = rsqrtf(ss * (1.f / 2048.f) + EPS);
#pragma unroll
      for (int j = 0; j < 8; ++j) { const f32x4 a = *(const f32x4*)(A1 + (j * 64 + lane) * 4); xv[j] += a * (yv[j] * r); }
    }
    if (yin || xout != xin) {
#pragma unroll
      for (int j = 0; j < 8; ++j) *(f32x4*)(xout + (size_t)row * 2048 + (j * 64 + lane) * 4) = xv[j];
    }
    if (hout) {
      float ss = 0.f;
#pragma unroll
      for (int j = 0; j < 8; ++j) ss += xv[j].x * xv[j].x + xv[j].y * xv[j].y + xv[j].z * xv[j].z + xv[j].w * xv[j].w;
      ss = wave_sum(ss); const float r = rsqrtf(ss * (1.f / 2048.f) + EPS);
#pragma unroll
      for (int j = 0; j < 8; ++j) { const f32x4 a = *(const f32x4*)(A2 + (j * 64 + lane) * 4), b = *(const f32x4*)(B2 + (j * 64 + lane) * 4);
        const f32x4 hv = xv[j] * r * a + b; u32x2 pk = {pack2(hv.x, hv.y), pack2(hv.z, hv.w)};
        *(u32x2*)(hout + (size_t)row * 2048 + (j * 64 + lane) * 4) = pk; }
    }
  }
  __syncthreads();
}

DI void mla_q_tile(const Params& P, int pm, int pn, char* smem) {
  const bf16_t* proj = (const bf16_t*)(P.ws + OFF_PROJ); const int tid = opaque_tid(), m0 = pm * 256; float* rs = (float*)(smem + 131072);
  { const int row = tid >> 1, half = tid & 1; const bf16_t* p = proj + (size_t)(m0 + row) * DINP + C_BCQ + half * 224; float ss = 0.f;
    for (int i = 0; i < 28; ++i) { const u32x4 v = *(const u32x4*)(p + i * 8); float f[8]; unpack8(v, f);
#pragma unroll
      for (int e = 0; e < 8; ++e) ss += f[e] * f[e]; }
    ss += __shfl_xor(ss, 1); if (half == 0) rs[row] = rsqrtf(ss * (1.f / 448.f) + EPS); }
  EpiMlaQ epi{(float*)(P.ws + OFF_QRAW), rs, m0};
  gemm_tile_s(proj + C_BCQ, DINP, (const bf16_t*)(P.ws + OFF_W + W_UQ), 448, 448, m0, pn * 256, smem, epi);
  __syncthreads();
}
DI void mla_kv_tile(const Params& P, int pm, int pn, char* smem) {
  const bf16_t* proj = (const bf16_t*)(P.ws + OFF_PROJ); const int tid = opaque_tid(), m0 = pm * 256; float* rs = (float*)(smem + 131072);
  { const int row = tid >> 1, half = tid & 1; const bf16_t* p = proj + (size_t)(m0 + row) * DINP + C_BCKV + half * 64; float ss = 0.f;
#pragma unroll
    for (int i = 0; i < 8; ++i) { const u32x4 v = *(const u32x4*)(p + i * 8); float f[8]; unpack8(v, f);
#pragma unroll
      for (int e = 0; e < 8; ++e) ss += f[e] * f[e]; }
    ss += __shfl_xor(ss, 1); if (half == 0) rs[row] = rsqrtf(ss * (1.f / 128.f) + EPS); }
  bf16_t* kmla = (bf16_t*)(P.ws + OFF_KMLA);
  EpiMlaKV epi{kmla, (bf16_t*)(P.ws + OFF_VT), rs, m0};
  gemm_tile_s(proj + C_BCKV, DINP, (const bf16_t*)(P.ws + OFF_W + W_UKV), 128, 128, m0, pn * 256, smem, epi);
  if (pn == 0) {
    for (int i = 0; i < 16; ++i) { const int idx = tid + NT * i, row = idx >> 5, pi = idx & 31, m = m0 + row;
      const float x1 = bflo((unsigned)proj[(size_t)m * DINP + C_BKR + pi]), x2 = bflo((unsigned)proj[(size_t)m * DINP + C_BKR + 32 + pi]);
      double fr = (double)P.pos[m] * kInvFreq2Pi[pi]; fr -= floor(fr); const float ff = (float)fr;
      const float sn = __builtin_amdgcn_sinf(ff), cs = __builtin_amdgcn_cosf(ff);
      const bf16_t o1 = f2bf(x1 * cs - x2 * sn), o2 = f2bf(x2 * cs + x1 * sn);
#pragma unroll
      for (int hd = 0; hd < 4; ++hd) { bf16_t* kp = kmla + ((size_t)hd * S_ + m) * 192 + 128; kp[pi] = o1; kp[32 + pi] = o2; } }
  }
  __syncthreads();
}

DI void gdn_prep_item(const Params& P, int l, int n, int hh, char* smem) {
  const int tid = opaque_tid(), lane = tid & 63, w = tid >> 6, lq = lane & 31, h = lane >> 5;
  const bf16_t* proj = (const bf16_t*)(P.ws + OFF_PROJ); const float* ab = (const float*)(P.ws + OFF_AB);
  char* kb16 = smem; char* qb16 = smem + 17408;
  float* kf = (float*)(smem + 34816); float* vf = kf + 8192; float* Lm = vf + 8192; float* gcs = Lm + 4096;
  const size_t tile = (size_t)hh * 256 + n; const int t0 = n * 64;
  bf16_t* Wp = (bf16_t*)(P.ws + OFF_WP) + tile * 8192; bf16_t* Qd = (bf16_t*)(P.ws + OFF_QD) + tile * 8192;
  bf16_t* Kt = (bf16_t*)(P.ws + OFF_KT) + tile * 8192; bf16_t* Zt = (bf16_t*)(P.ws + OFF_ZT) + tile * 8192;
  bf16_t* QK = (bf16_t*)(P.ws + OFF_QK) + tile * 4096; bf16_t* Ut = (bf16_t*)(P.ws + OFF_UT) + tile * 8192;
  if (w == 0) {
    const int t = lane; const float a_raw = ab[(size_t)(t0 + t) * 16 + hh], b_raw = ab[(size_t)(t0 + t) * 16 + 8 + hh];
    const float Aa = __expf(P.gdn_a_log[l * 8 + hh]); const float xb = a_raw + P.gdn_dt_bias[l * 8 + hh];
    const float ex = __expf(fminf(xb, 20.f));
    const float sp = xb > 20.f ? xb : (ex < 0.01f ? ex * (1.f - ex * (0.5f - ex * (1.f / 3.f))) : __logf(1.f + ex));
    float g = -Aa * sp;
#pragma unroll
    for (int d = 1; d < 64; d <<= 1) { const float v = __shfl_up(g, d); if (lane >= d) g += v; }
    const float bt = 1.f / (1.f + __expf(-b_raw)), eg = __expf(g); gcs[t] = g; gcs[64 + t] = bt; gcs[128 + t] = eg; gcs[192 + t] = bt * eg;
    if (t == 63) ((float*)(P.ws + OFF_GTOT))[tile] = eg;
  }
  __syncthreads();
  {
    const int t = tid >> 3, part = tid & 7, tabs = t0 + t;
    const float gct = gcs[t], egct = gcs[128 + t], ktl = __expf(gcs[63] - gct);
    const int pjt = 32 * (t >> 5) + perm32(t & 31);
#pragma unroll
    for (int X = 0; X < 3; ++X) {
      const int cb = X * 1024 + hh * 128 + part * 16;
      float y[16];
#pragma unroll
      for (int e = 0; e < 16; ++e) y[e] = 0.f;
#pragma unroll
      for (int j = 0; j < 4; ++j) { const int row = tabs - 3 + j;
        if (row >= 0) { const u32x4 v0 = *(const u32x4*)(proj + (size_t)row * DINP + cb), v1 = *(const u32x4*)(proj + (size_t)row * DINP + cb + 8);
          float xv[16]; unpack8(v0, xv); unpack8(v1, xv + 8); const float* cw = P.gdn_conv + ((size_t)l * 4 + j) * 3072 + cb;
#pragma unroll
          for (int e4 = 0; e4 < 4; ++e4) { const f32x4 wv = *(const f32x4*)(cw + 4 * e4); y[4 * e4] += wv.x * xv[4 * e4]; y[4 * e4 + 1] += wv.y * xv[4 * e4 + 1]; y[4 * e4 + 2] += wv.z * xv[4 * e4 + 2]; y[4 * e4 + 3] += wv.w * xv[4 * e4 + 3]; } } }
#pragma unroll
      for (int e = 0; e < 16; ++e) y[e] = silu_f(y[e]);
      if (X < 2) { float ss = 0.f;
#pragma unroll
        for (int e = 0; e < 16; ++e) ss += y[e] * y[e];
        ss += __shfl_xor(ss, 1); ss += __shfl_xor(ss, 2); ss += __shfl_xor(ss, 4);
        const float rn = rsqrtf(ss + EPS) * (X == 0 ? 0.08838834764831845f : 1.f);
#pragma unroll
        for (int e = 0; e < 16; ++e) y[e] *= rn; }
      if (X == 0) {
        u32x4 p0 = {pack2(y[0], y[1]), pack2(y[2], y[3]), pack2(y[4], y[5]), pack2(y[6], y[7])}, p1 = {pack2(y[8], y[9]), pack2(y[10], y[11]), pack2(y[12], y[13]), pack2(y[14], y[15])};
        *(u32x4*)(qb16 + t * 272 + part * 32) = p0; *(u32x4*)(qb16 + t * 272 + part * 32 + 16) = p1;
#pragma unroll
        for (int b = 0; b < 4; ++b) { u32x2 pk = {pack2(y[4 * b] * egct, y[4 * b + 1] * egct), pack2(y[4 * b + 2] * egct, y[4 * b + 3] * egct)};
          *(u32x2*)(Qd + t * 128 + 32 * (part >> 1) + 8 * b + 4 * (part & 1)) = pk; }
      } else if (X == 1) {
        u32x4 p0 = {pack2(y[0], y[1]), pack2(y[2], y[3]), pack2(y[4], y[5]), pack2(y[6], y[7])}, p1 = {pack2(y[8], y[9]), pack2(y[10], y[11]), pack2(y[12], y[13]), pack2(y[14], y[15])};
        *(u32x4*)(kb16 + t * 272 + part * 32) = p0; *(u32x4*)(kb16 + t * 272 + part * 32 + 16) = p1;
#pragma unroll
        for (int e4 = 0; e4 < 4; ++e4) { f32x4 v = {y[4 * e4], y[4 * e4 + 1], y[4 * e4 + 2], y[4 * e4 + 3]}; *(f32x4*)(kf + t * 128 + part * 16 + 4 * e4) = v; }
#pragma unroll
        for (int e = 0; e < 16; ++e) Kt[(part * 16 + e) * 64 + pjt] = f2bf(y[e] * ktl);
      } else {
#pragma unroll
        for (int e4 = 0; e4 < 4; ++e4) { f32x4 v = {y[4 * e4], y[4 * e4 + 1], y[4 * e4 + 2], y[4 * e4 + 3]}; *(f32x4*)(vf + t * 128 + part * 16 + 4 * e4) = v; }
      }
    }
    { const int cb = C_AZ + hh * 128 + part * 16; const u32x4 v0 = *(const u32x4*)(proj + (size_t)tabs * DINP + cb), v1 = *(const u32x4*)(proj + (size_t)tabs * DINP + cb + 8);
      float zv[16]; unpack8(v0, zv); unpack8(v1, zv + 8);
#pragma unroll
      for (int e = 0; e < 16; ++e) Zt[(part * 16 + e) * 64 + t] = f2bf(silu_f(zv[e])); }
  }
  __syncthreads();
  {
    const int which = w >> 2, ti = (w >> 1) & 1, tj = w & 1; const char* Ab = which ? qb16 : kb16;
    f32x16 acc;
#pragma unroll
    for (int r = 0; r < 16; ++r) acc[r] = 0.f;
#pragma unroll
    for (int s = 0; s < 8; ++s) { const bf16x8 a = *(const bf16x8*)(Ab + (32 * ti + lq) * 272 + (16 * s + 8 * h) * 2), b = *(const bf16x8*)(kb16 + (32 * tj + lq) * 272 + (16 * s + 8 * h) * 2);
      acc = MFMA32(a, b, acc); }
    const int j = 32 * tj + lq; const float gj = gcs[j]; const int pj = 32 * (j >> 5) + perm32(j & 31);
#pragma unroll
    for (int r = 0; r < 16; ++r) { const int i = 32 * ti + crow(r, h); const float dec = __expf(fminf(gcs[i] - gj, 0.f));
      if (which == 0) Lm[i * 64 + j] = (j < i) ? gcs[64 + i] * acc[r] * dec : 0.f;
      else QK[i * 64 + pj] = f2bf((j <= i) ? acc[r] * dec : 0.f); }
  }
  __syncthreads();
  if (tid < 256) {
    const int c = tid; const bool isu = c < 128; const int cc = c & 127;
    const float* rp = (isu ? vf : kf) + cc; const float* sp = gcs + (isu ? 64 : 192);
    float x[64];
#pragma unroll
    for (int i = 0; i < 64; ++i) {
      float r = sp[i] * rp[i * 128];
#pragma unroll
      for (int j = 0; j < i; ++j) r = fmaf(-Lm[i * 64 + j], x[j], r);
      x[i] = r;
    }
    if (isu) {
#pragma unroll
      for (int i8 = 0; i8 < 8; ++i8) { u32x4 v = {pack2(x[8 * i8], x[8 * i8 + 1]), pack2(x[8 * i8 + 2], x[8 * i8 + 3]), pack2(x[8 * i8 + 4], x[8 * i8 + 5]), pack2(x[8 * i8 + 6], x[8 * i8 + 7])}; *(u32x4*)(Ut + cc * 64 + 8 * i8) = v; }
    } else {
      const int pp = 32 * (cc >> 5) + perm32(cc & 31);
#pragma unroll
      for (int i = 0; i < 64; ++i) Wp[i * 128 + pp] = f2bf(x[i]);
    }
  }
  __syncthreads();
}

DI bf16x8 pack_tiles(const f32x4& a, const f32x4& b) { return pack8(a.x, a.y, a.z, a.w, b.x, b.y, b.z, b.w); }
template <int CTRL> DI float dppf(float v) { return __int_as_float(__builtin_amdgcn_update_dpp(0, __float_as_int(v), CTRL, 0xf, 0xf, true)); }
DI float row16_sum(float v) { v += dppf<0xB1>(v); v += dppf<0x4E>(v); v += dppf<0x141>(v); v += dppf<0x140>(v); return v; }
constexpr size_t OFF_SSQP = OFF_GTOT + 8192;
static_assert(OFF_SSQP + (size_t)2 * S_ * 8 * 4 <= OFF_UT, "overlay3");
DI void gdn_scan_item(const Params& P, int l, int hh, int half, char* smem) {
  const int tid = opaque_tid(), lane = tid & 63, w = tid >> 6, l15 = lane & 15, q4 = lane >> 4;
  constexpr int OPB = 62464;
  float* sPart = (float*)(smem + 2 * OPB);
  const size_t hb = (size_t)hh * 256;
  const bf16_t* Wp = (const bf16_t*)(P.ws + OFF_WP) + hb * 8192; const bf16_t* Qd = (const bf16_t*)(P.ws + OFF_QD) + hb * 8192;
  const bf16_t* Kt = (const bf16_t*)(P.ws + OFF_KT) + hb * 8192; const bf16_t* Zt = (const bf16_t*)(P.ws + OFF_ZT) + hb * 8192;
  const bf16_t* QK = (const bf16_t*)(P.ws + OFF_QK) + hb * 4096; const bf16_t* Ut = (const bf16_t*)(P.ws + OFF_UT) + hb * 8192;
  const float* gt = (const float*)(P.ws + OFF_GTOT) + hb;
  float* ssqp = (float*)(P.ws + OFF_SSQP) + (size_t)half * S_ * 8;
  bf16_t* mixin = (bf16_t*)(P.ws + OFF_H);
  if (w >= 4) {
    const int lt = tid - 256;
    const int g256 = (lt >> 4) * 128 + (lt & 15) * 8, l256 = (lt >> 4) * 272 + (lt & 15) * 16;
    const int g128 = (lt >> 3) * 64 + (lt & 7) * 8, l128 = (lt >> 3) * 144 + (lt & 7) * 16;
    u32x4 pw[4], pq[4], pk[4], pqk[2];
#pragma unroll
    for (int i = 0; i < 4; ++i) { pw[i] = *(const u32x4*)(Wp + g256 + i * 2048); pq[i] = *(const u32x4*)(Qd + g256 + i * 2048); pk[i] = *(const u32x4*)(Kt + g128 + i * 2048); }
#pragma unroll
    for (int i = 0; i < 2; ++i) pqk[i] = *(const u32x4*)(QK + g128 + i * 2048);
#pragma unroll
    for (int i = 0; i < 4; ++i) { *(u32x4*)(smem + l256 + i * 4352) = pw[i]; *(u32x4*)(smem + 17408 + l256 + i * 4352) = pq[i]; *(u32x4*)(smem + 34816 + l128 + i * 4608) = pk[i]; }
#pragma unroll
    for (int i = 0; i < 2; ++i) *(u32x4*)(smem + 53248 + l128 + i * 4608) = pqk[i];
#pragma unroll
    for (int i = 0; i < 4; ++i) { pw[i] = *(const u32x4*)(Wp + 8192 + g256 + i * 2048); pq[i] = *(const u32x4*)(Qd + 8192 + g256 + i * 2048); pk[i] = *(const u32x4*)(Kt + 8192 + g128 + i * 2048); }
#pragma unroll
    for (int i = 0; i < 2; ++i) pqk[i] = *(const u32x4*)(QK + 4096 + g128 + i * 2048);
    __syncthreads();
#pragma unroll 1
    for (int n = 0; n < 256; ++n) {
      char* nb = smem + ((n + 1) & 1) * OPB;
      if (n + 1 < 256) {
#pragma unroll
        for (int i = 0; i < 4; ++i) { *(u32x4*)(nb + l256 + i * 4352) = pw[i]; *(u32x4*)(nb + 17408 + l256 + i * 4352) = pq[i]; *(u32x4*)(nb + 34816 + l128 + i * 4608) = pk[i]; }
#pragma unroll
        for (int i = 0; i < 2; ++i) *(u32x4*)(nb + 53248 + l128 + i * 4608) = pqk[i];
      }
      if (n + 2 < 256) { const size_t o8 = (size_t)(n + 2) * 8192, o4 = (size_t)(n + 2) * 4096;
#pragma unroll
        for (int i = 0; i < 4; ++i) { pw[i] = *(const u32x4*)(Wp + o8 + g256 + i * 2048); pq[i] = *(const u32x4*)(Qd + o8 + g256 + i * 2048); pk[i] = *(const u32x4*)(Kt + o8 + g128 + i * 2048); }
#pragma unroll
        for (int i = 0; i < 2; ++i) pqk[i] = *(const u32x4*)(QK + o4 + g128 + i * 2048); }
      __syncthreads();
    }
  } else {
    const int dvc = 64 * half + 16 * w + l15; const float nw = P.gdn_norm[l * 128 + dvc];
    const int uoff = dvc * 64 + 4 * q4;
    f32x4 St[8];
#pragma unroll
    for (int t = 0; t < 8; ++t) St[t] = (f32x4){0.f, 0.f, 0.f, 0.f};
    u32x2 uc[4], un[4], zc[4], zn[4]; float gcur, gn = 0.f;
#pragma unroll
    for (int it = 0; it < 4; ++it) { uc[it] = *(const u32x2*)(Ut + uoff + 16 * it); zc[it] = *(const u32x2*)(Zt + uoff + 16 * it); un[it] = uc[it]; zn[it] = zc[it]; }
    gcur = gt[0];
    __syncthreads();
#pragma unroll 2
    for (int n = 0; n < 256; ++n) {
      const char* cb = smem + (n & 1) * OPB;
      const char* sWp = cb; const char* sQd = cb + 17408; const char* sKt = cb + 34816; const char* sQK = cb + 53248;
      if (n + 1 < 256) { const size_t o8 = (size_t)(n + 1) * 8192;
#pragma unroll
        for (int it = 0; it < 4; ++it) { un[it] = *(const u32x2*)(Ut + o8 + uoff + 16 * it); zn[it] = *(const u32x2*)(Zt + o8 + uoff + 16 * it); }
        gn = gt[n + 1]; }
      bf16x8 sb[4];
#pragma unroll
      for (int ks = 0; ks < 4; ++ks) sb[ks] = pack_tiles(St[2 * ks], St[2 * ks + 1]);
      f32x4 wsv[4], qs[4];
#pragma unroll
      for (int it = 0; it < 4; ++it) { wsv[it] = (f32x4){0.f, 0.f, 0.f, 0.f}; qs[it] = (f32x4){0.f, 0.f, 0.f, 0.f}; }
#pragma unroll
      for (int it = 0; it < 4; ++it)
#pragma unroll
        for (int ks = 0; ks < 4; ++ks) { const int o = (16 * it + l15) * 272 + 64 * ks + 16 * q4;
          const bf16x8 a = *(const bf16x8*)(sWp + o), a2 = *(const bf16x8*)(sQd + o);
          wsv[it] = MFMA16(a, sb[ks], wsv[it]); qs[it] = MFMA16(a2, sb[ks], qs[it]); }
      f32x4 vn[4];
#pragma unroll
      for (int it = 0; it < 4; ++it) { const f32x4 uf = {bflo(uc[it].x), bfhi(uc[it].x), bflo(uc[it].y), bfhi(uc[it].y)}; vn[it] = uf - wsv[it]; }
      bf16x8 vb[2];
#pragma unroll
      for (int ks = 0; ks < 2; ++ks) vb[ks] = pack_tiles(vn[2 * ks], vn[2 * ks + 1]);
#pragma unroll
      for (int it = 0; it < 4; ++it)
#pragma unroll
        for (int ks = 0; ks < 2; ++ks) { const bf16x8 a = *(const bf16x8*)(sQK + (16 * it + l15) * 144 + 64 * ks + 16 * q4); qs[it] = MFMA16(a, vb[ks], qs[it]); }
#pragma unroll
      for (int t = 0; t < 8; ++t) { St[t] *= gcur;
#pragma unroll
        for (int ks = 0; ks < 2; ++ks) { const bf16x8 a = *(const bf16x8*)(sKt + (16 * t + l15) * 144 + 64 * ks + 16 * q4); St[t] = MFMA16(a, vb[ks], St[t]); } }
      float* sp = sPart + (n & 1) * 256;
#pragma unroll
      for (int it = 0; it < 4; ++it) {
        f32x4 ss = qs[it] * qs[it];
        ss.x = row16_sum(ss.x); ss.y = row16_sum(ss.y); ss.z = row16_sum(ss.z); ss.w = row16_sum(ss.w);
        if (l15 == 0) *(f32x4*)(sp + w * 64 + 16 * it + 4 * q4) = ss;
      }
      __syncthreads();
      if (w == 0) ssqp[(size_t)(64 * n + lane) * 8 + hh] = (sp[lane] + sp[64 + lane]) + (sp[128 + lane] + sp[192 + lane]);
#pragma unroll
      for (int it = 0; it < 4; ++it) {
        const float z0 = bflo(zc[it].x), z1 = bfhi(zc[it].x), z2 = bflo(zc[it].y), z3 = bfhi(zc[it].y);
        bf16_t* op = mixin + (size_t)(64 * n + 16 * it + 4 * q4) * 2048 + hh * 128 + dvc;
        op[0] = f2bf(qs[it].x * nw * z0); op[2048] = f2bf(qs[it].y * nw * z1);
        op[4096] = f2bf(qs[it].z * nw * z2); op[6144] = f2bf(qs[it].w * nw * z3);
      }
#pragma unroll
      for (int it = 0; it < 4; ++it) { uc[it] = un[it]; zc[it] = zn[it]; }
      gcur = gn;
    }
  }
  __syncthreads();
}
DI void gdn_fix_phase(const Params& P) {
  const int tid = opaque_tid();
  bf16_t* mixin = (bf16_t*)(P.ws + OFF_H); const float* ssqp = (const float*)(P.ws + OFF_SSQP);
  for (int idx = blockIdx.x * NT + tid; idx < S_ * 128; idx += gridDim.x * NT) {
    const int t = idx >> 7, ck = idx & 127, h = ck >> 4;
    const float r = rsqrtf((ssqp[(size_t)t * 8 + h] + ssqp[(size_t)S_ * 8 + (size_t)t * 8 + h]) * (1.f / 128.f) + EPS);
    u32x4* p = (u32x4*)(mixin + (size_t)t * 2048 + ck * 8); const u32x4 v = *p; float f[8]; unpack8(v, f);
    u32x4 o = {pack2(f[0] * r, f[1] * r), pack2(f[2] * r, f[3] * r), pack2(f[4] * r, f[5] * r), pack2(f[6] * r, f[7] * r)}; *p = o;
  }
}

DI void mla_attn_item(const Params& P, int hd, int b, char* smem) {
  const int tid = opaque_tid(), lane = tid & 63, w = tid >> 6, wq = w & 3, hk = w >> 2, lq = lane & 31, h = lane >> 5;
  const float* qraw = (const float*)(P.ws + OFF_QRAW);
  const bf16_t* Kg = (const bf16_t*)(P.ws + OFF_KMLA) + (size_t)hd * S_ * 192;
  const bf16_t* Vg = (const bf16_t*)(P.ws + OFF_VT) + (size_t)hd * 128 * S_;
  bf16_t* mixin = (bf16_t*)(P.ws + OFF_H);
  const int q = 128 * b + 32 * wq + lq;
  bf16x8 qf[12];
  {
    const float* qp = qraw + (size_t)q * 768 + hd * 192 + 8 * h;
    const float sc = 0.07216878364870322f * LOG2E;
#pragma unroll
    for (int s = 0; s < 8; ++s) { const f32x4 a = *(const f32x4*)(qp + 16 * s), c = *(const f32x4*)(qp + 16 * s + 4);
      qf[s] = pack8(a.x * sc, a.y * sc, a.z * sc, a.w * sc, c.x * sc, c.y * sc, c.z * sc, c.w * sc); }
    const double pq = (double)P.pos[q];
#pragma unroll
    for (int s2 = 0; s2 < 2; ++s2) {
      const f32x4 a0 = *(const f32x4*)(qp + 128 + 16 * s2), a1 = *(const f32x4*)(qp + 128 + 16 * s2 + 4);
      const f32x4 b0 = *(const f32x4*)(qp + 160 + 16 * s2), b1 = *(const f32x4*)(qp + 160 + 16 * s2 + 4);
      float x1[8] = {a0.x, a0.y, a0.z, a0.w, a1.x, a1.y, a1.z, a1.w}, x2[8] = {b0.x, b0.y, b0.z, b0.w, b1.x, b1.y, b1.z, b1.w}, o1[8], o2[8];
#pragma unroll
      for (int j = 0; j < 8; ++j) { double fr = pq * kInvFreq2Pi[16 * s2 + 8 * h + j]; fr -= floor(fr); const float ff = (float)fr;
        const float sn = __builtin_amdgcn_sinf(ff), cs = __builtin_amdgcn_cosf(ff);
        o1[j] = (x1[j] * cs - x2[j] * sn) * sc; o2[j] = (x2[j] * cs + x1[j] * sn) * sc; }
      qf[8 + s2] = pack8(o1[0], o1[1], o1[2], o1[3], o1[4], o1[5], o1[6], o1[7]);
      qf[10 + s2] = pack8(o2[0], o2[1], o2[2], o2[3], o2[4], o2[5], o2[6], o2[7]);
    }
  }
  constexpr int KST = 64 * 400, VST = 128 * 144, STG = KST + VST;
  f32x16 O[4];
#pragma unroll
  for (int i = 0; i < 4; ++i)
#pragma unroll
    for (int r = 0; r < 16; ++r) O[i][r] = 0.f;
  float m_i = -1e30f, l_i = 0.f;
  const int nt = 2 * b + 2;
  u32x4 rk[3], rv[2];
  const int vrow = tid >> 3, vcc = tid & 7;
#pragma unroll
  for (int i = 0; i < 3; ++i) { const int id = tid + NT * i, row = id / 24, cc = id % 24; rk[i] = *(const u32x4*)(Kg + row * 192 + cc * 8); }
#pragma unroll
  for (int i = 0; i < 2; ++i) rv[i] = *(const u32x4*)(Vg + (size_t)(vrow + 64 * i) * S_ + vcc * 8);
#pragma unroll
  for (int i = 0; i < 3; ++i) { const int id = tid + NT * i, row = id / 24, cc = id % 24; *(u32x4*)(smem + row * 400 + cc * 16) = rk[i]; }
#pragma unroll
  for (int i = 0; i < 2; ++i) *(u32x4*)(smem + KST + (vrow + 64 * i) * 144 + vcc * 16) = rv[i];
  __syncthreads();
  for (int kt = 0; kt < nt; ++kt) {
    const char* sK = smem + (kt & 1) * STG; const char* sV = sK + KST;
    const bool more = (kt + 1 < nt);
    if (more) { const size_t ko = (size_t)(kt + 1) * 64 * 192; const int vo = (kt + 1) * 64;
#pragma unroll
      for (int i = 0; i < 3; ++i) { const int id = tid + NT * i, row = id / 24, cc = id % 24; rk[i] = *(const u32x4*)(Kg + ko + row * 192 + cc * 8); }
#pragma unroll
      for (int i = 0; i < 2; ++i) rv[i] = *(const u32x4*)(Vg + (size_t)(vrow + 64 * i) * S_ + vo + vcc * 8); }
    const int key0 = 64 * kt + 32 * hk;
    if (key0 <= 128 * b + 32 * wq) {
      f32x16 st;
#pragma unroll
      for (int r = 0; r < 16; ++r) st[r] = 0.f;
#pragma unroll
      for (int s = 0; s < 12; ++s) { const bf16x8 kf = *(const bf16x8*)(sK + (32 * hk + lq) * 400 + (2 * s + h) * 16); st = MFMA32(kf, qf[s], st); }
      if (key0 + 31 > 128 * b + 32 * wq) {
        int qrel = q - key0 - 4 * h; asm volatile("" : "+v"(qrel));
#pragma unroll
        for (int r = 0; r < 16; ++r) if ((r & 3) + 8 * (r >> 2) > qrel) st[r] = -1e30f;
      }
      float mx = st[0];
#pragma unroll
      for (int r = 1; r < 16; ++r) mx = fmaxf(mx, st[r]);
      mx = fmaxf(mx, __shfl_xor(mx, 32));
      const float m_new = fmaxf(m_i, mx), alpha = exp2f(m_i - m_new);
      float ps = 0.f;
#pragma unroll
      for (int r = 0; r < 16; ++r) { st[r] = exp2f(st[r] - m_new); ps += st[r]; }
      l_i = l_i * alpha + ps; m_i = m_new;
#pragma unroll
      for (int i = 0; i < 4; ++i)
#pragma unroll
        for (int r = 0; r < 16; ++r) O[i][r] *= alpha;
      bf16x8 pf[2];
#pragma unroll
      for (int s = 0; s < 2; ++s) pf[s] = pack8(st[8 * s], st[8 * s + 1], st[8 * s + 2], st[8 * s + 3], st[8 * s + 4], st[8 * s + 5], st[8 * s + 6], st[8 * s + 7]);
#pragma unroll
      for (int i = 0; i < 4; ++i)
#pragma unroll
        for (int s = 0; s < 2; ++s) { const char* vp = sV + (32 * i + lq) * 144 + (32 * hk + 16 * s + 4 * h) * 2;
          const u32x2 lo = *(const u32x2*)vp, hi = *(const u32x2*)(vp + 16); u32x4 vv = {lo.x, lo.y, hi.x, hi.y};
          O[i] = MFMA32(__builtin_bit_cast(bf16x8, vv), pf[s], O[i]); }
    }
    if (more) { char* dK = smem + ((kt + 1) & 1) * STG;
#pragma unroll
      for (int i = 0; i < 3; ++i) { const int id = tid + NT * i, row = id / 24, cc = id % 24; *(u32x4*)(dK + row * 400 + cc * 16) = rk[i]; }
#pragma unroll
      for (int i = 0; i < 2; ++i) *(u32x4*)(dK + KST + (vrow + 64 * i) * 144 + vcc * 16) = rv[i]; }
    __syncthreads();
  }
  float* cO = (float*)smem; float* cm = cO + 4 * 4096; float* cl = cm + 256;
  if (hk == 1) {
#pragma unroll
    for (int i = 0; i < 4; ++i)
#pragma unroll
      for (int r = 0; r < 16; ++r) cO[wq * 4096 + (i * 16 + r) * 64 + lane] = O[i][r];
    cm[wq * 64 + lane] = m_i; cl[wq * 64 + lane] = l_i;
  }
  __syncthreads();
  if (hk == 0) {
    const float m1 = cm[wq * 64 + lane], l1 = cl[wq * 64 + lane];
    const float m = fmaxf(m_i, m1), a0 = exp2f(m_i - m), a1 = exp2f(m1 - m);
    float lt = l_i * a0 + l1 * a1; lt += __shfl_xor(lt, 32);
    const float inv = 1.f / lt;
    bf16_t* op = mixin + (size_t)q * 2048 + 1024 + hd * 128;
#pragma unroll
    for (int i = 0; i < 4; ++i)
#pragma unroll
      for (int rg = 0; rg < 4; ++rg) { float v[4];
#pragma unroll
        for (int e = 0; e < 4; ++e) v[e] = (O[i][4 * rg + e] * a0 + cO[wq * 4096 + (i * 16 + 4 * rg + e) * 64 + lane] * a1) * inv;
        u32x2 pk = {pack2(v[0], v[1]), pack2(v[2], v[3])}; *(u32x2*)(op + 32 * i + 8 * rg + 4 * h) = pk; }
  }
  __syncthreads();
}

DI void swa_item(const Params& P, int l, int n, int hk2, char* smem) {
  const int tid = opaque_tid(), lane = tid & 63, w = tid >> 6, lq = lane & 31, h = lane >> 5;
  const bf16_t* proj = (const bf16_t*)(P.ws + OFF_PROJ); bf16_t* mixin = (bf16_t*)(P.ws + OFF_H);
  bf16_t* sVt = (bf16_t*)smem;
#pragma unroll
  for (int i = 0; i < 4; ++i) { const int id = tid + NT * i, key = id >> 3, dc = id & 7; const int kp = 128 * (n - 1) + key;
    u32x4 v = {0u, 0u, 0u, 0u}; if (kp >= 0) v = *(const u32x4*)(proj + (size_t)kp * DINP + C_CV + hk2 * 64 + dc * 8);
    sVt[(8 * dc + 0) * 264 + key] = (bf16_t)(v.x & 0xffff); sVt[(8 * dc + 1) * 264 + key] = (bf16_t)(v.x >> 16);
    sVt[(8 * dc + 2) * 264 + key] = (bf16_t)(v.y & 0xffff); sVt[(8 * dc + 3) * 264 + key] = (bf16_t)(v.y >> 16);
    sVt[(8 * dc + 4) * 264 + key] = (bf16_t)(v.z & 0xffff); sVt[(8 * dc + 5) * 264 + key] = (bf16_t)(v.z >> 16);
    sVt[(8 * dc + 6) * 264 + key] = (bf16_t)(v.w & 0xffff); sVt[(8 * dc + 7) * 264 + key] = (bf16_t)(v.w >> 16); }
  __syncthreads();
  const int g = w >> 1, hq = hk2 * 4 + g;
  const float slope = exp2f(-(float)(hq + 1)) * LOG2E, sinkv = P.swa_sinks[l * 8 + hq] * LOG2E;
#pragma unroll 1
  for (int jj = 0; jj < 2; ++jj) {
    const int j = 2 * (w & 1) + jj; const int qrow = 128 * n + 32 * j + lq;
    bf16x8 qf[4];
#pragma unroll
    for (int s = 0; s < 4; ++s) qf[s] = *(const bf16x8*)(proj + (size_t)qrow * DINP + C_CQ + hq * 64 + 16 * s + 8 * h);
    f32x16 st[5];
    bf16x8 kf[2][4];
    { const int kp = 128 * (n - 1) + 32 * j + lq;
#pragma unroll
      for (int s = 0; s < 4; ++s) { kf[0][s] = (bf16x8){0, 0, 0, 0, 0, 0, 0, 0}; if (kp >= 0) kf[0][s] = *(const bf16x8*)(proj + (size_t)kp * DINP + C_CK + hk2 * 64 + 16 * s + 8 * h); } }
#pragma unroll
    for (int tt = 0; tt < 5; ++tt) {
      if (tt + 1 < 5) { const int kp = 128 * (n - 1) + 32 * (j + tt + 1) + lq;
#pragma unroll
        for (int s = 0; s < 4; ++s) { kf[(tt + 1) & 1][s] = (bf16x8){0, 0, 0, 0, 0, 0, 0, 0}; if (kp >= 0) kf[(tt + 1) & 1][s] = *(const bf16x8*)(proj + (size_t)kp * DINP + C_CK + hk2 * 64 + 16 * s + 8 * h); } }
      __builtin_amdgcn_sched_barrier(0);
#pragma unroll
      for (int r = 0; r < 16; ++r) st[tt][r] = 0.f;
#pragma unroll
      for (int s = 0; s < 4; ++s) st[tt] = MFMA32(kf[tt & 1][s], qf[s], st[tt]);
      __builtin_amdgcn_sched_barrier(0);
    }
    float mx = sinkv;
    int dbase = 128 + lq - 4 * h, kbase = 128 * (n - 1) + 32 * j + 4 * h;
    asm volatile("" : "+v"(dbase), "+v"(kbase));
#pragma unroll
    for (int tt = 0; tt < 5; ++tt)
#pragma unroll
      for (int r = 0; r < 16; ++r) { const int cst = 32 * tt + (r & 3) + 8 * (r >> 2); const int dist = dbase - cst; const int kpos = kbase + cst;
        const bool valid = (dist >= 0) && (dist < 128) && (kpos >= 0);
        const float sv = valid ? st[tt][r] * (0.125f * LOG2E) - slope * (float)dist : -1e30f; st[tt][r] = sv; mx = fmaxf(mx, sv); }
    mx = fmaxf(mx, __shfl_xor(mx, 32));
    float den = 0.f;
#pragma unroll
    for (int tt = 0; tt < 5; ++tt)
#pragma unroll
      for (int r = 0; r < 16; ++r) { const float p = exp2f(st[tt][r] - mx); st[tt][r] = p; den += p; }
    den += __shfl_xor(den, 32); den += exp2f(sinkv - mx);
    f32x16 O[2];
#pragma unroll
    for (int i = 0; i < 2; ++i)
#pragma unroll
      for (int r = 0; r < 16; ++r) O[i][r] = 0.f;
#pragma unroll
    for (int tt = 0; tt < 5; ++tt)
#pragma unroll
      for (int s = 0; s < 2; ++s) { const bf16x8 pf = pack8(st[tt][8 * s], st[tt][8 * s + 1], st[tt][8 * s + 2], st[tt][8 * s + 3], st[tt][8 * s + 4], st[tt][8 * s + 5], st[tt][8 * s + 6], st[tt][8 * s + 7]);
#pragma unroll
        for (int i = 0; i < 2; ++i) { const char* vp = (const char*)sVt + (32 * i + lq) * 528 + (32 * (j + tt) + 16 * s + 4 * h) * 2;
          const u32x2 lo = *(const u32x2*)vp, hi = *(const u32x2*)(vp + 16); u32x4 vv = {lo.x, lo.y, hi.x, hi.y};
          O[i] = MFMA32(__builtin_bit_cast(bf16x8, vv), pf, O[i]); }
        __builtin_amdgcn_sched_barrier(0); }
    const float inv = 1.f / den;
    bf16_t* op = mixin + (size_t)qrow * 2048 + 1536 + hq * 64;
#pragma unroll
    for (int i = 0; i < 2; ++i)
#pragma unroll
      for (int rg = 0; rg < 4; ++rg) { u32x2 pk = {pack2(O[i][4 * rg] * inv, O[i][4 * rg + 1] * inv), pack2(O[i][4 * rg + 2] * inv, O[i][4 * rg + 3] * inv)};
        *(u32x2*)(op + 32 * i + 8 * rg + 4 * h) = pk; }
  }
  __syncthreads();
}

DI float gelu_tanh(float x) { const float y = 0.7978845608028654f * (x + 0.044715f * x * x * x); const float t = 1.f - 2.f / (1.f + __expf(2.f * y)); return 0.5f * x * (1.f + t); }
DI void ffn_act_phase(const Params& P, int l) {
  const int tid = opaque_tid(), lane = tid & 63, w = tid >> 6;
  const bf16_t* u = (const bf16_t*)(P.ws + OFF_BIG); bf16_t* act = (bf16_t*)(P.ws + OFF_ACT);
  const float* cw = P.ffn_conv + (size_t)l * 3 * DFF2; const float* cb = P.ffn_conv_b + (size_t)l * DFF2;
  for (int item = blockIdx.x * 8 + w; item < 512 * 11; item += gridDim.x * 8) {
    const int cbk = item % 11, rr = item / 11; const int ch = cbk * 512 + lane * 8, r0 = rr * 32;
    float wg[3][8], wu[3][8], bg[8], bu[8];
#pragma unroll
    for (int j = 0; j < 3; ++j)
#pragma unroll
      for (int e4 = 0; e4 < 2; ++e4) { const f32x4 a = *(const f32x4*)(cw + (size_t)j * DFF2 + ch + 4 * e4), b = *(const f32x4*)(cw + (size_t)j * DFF2 + DFF + ch + 4 * e4);
        wg[j][4 * e4] = a.x; wg[j][4 * e4 + 1] = a.y; wg[j][4 * e4 + 2] = a.z; wg[j][4 * e4 + 3] = a.w; wu[j][4 * e4] = b.x; wu[j][4 * e4 + 1] = b.y; wu[j][4 * e4 + 2] = b.z; wu[j][4 * e4 + 3] = b.w; }
#pragma unroll
    for (int e4 = 0; e4 < 2; ++e4) { const f32x4 a = *(const f32x4*)(cb + ch + 4 * e4), b = *(const f32x4*)(cb + DFF + ch + 4 * e4);
      bg[4 * e4] = a.x; bg[4 * e4 + 1] = a.y; bg[4 * e4 + 2] = a.z; bg[4 * e4 + 3] = a.w; bu[4 * e4] = b.x; bu[4 * e4 + 1] = b.y; bu[4 * e4 + 2] = b.z; bu[4 * e4 + 3] = b.w; }
    float g2[8], g1[8], u2[8], u1[8];
#pragma unroll
    for (int e = 0; e < 8; ++e) { g2[e] = 0.f; g1[e] = 0.f; u2[e] = 0.f; u1[e] = 0.f; }
    if (r0 >= 2) { unpack8(*(const u32x4*)(u + (size_t)(r0 - 2) * DFF2 + ch), g2); unpack8(*(const u32x4*)(u + (size_t)(r0 - 2) * DFF2 + DFF + ch), u2);
      unpack8(*(const u32x4*)(u + (size_t)(r0 - 1) * DFF2 + ch), g1); unpack8(*(const u32x4*)(u + (size_t)(r0 - 1) * DFF2 + DFF + ch), u1); }
#pragma unroll 1
    for (int rb = 0; rb < 4; ++rb) {
      u32x4 G[8], U[8];
#pragma unroll
      for (int i = 0; i < 8; ++i) { const size_t ro = (size_t)(r0 + rb * 8 + i) * DFF2 + ch; G[i] = *(const u32x4*)(u + ro); U[i] = *(const u32x4*)(u + ro + DFF); }
#pragma unroll
      for (int i = 0; i < 8; ++i) {
        float g0[8], u0[8]; unpack8(G[i], g0); unpack8(U[i], u0);
        float o[8];
#pragma unroll
        for (int e = 0; e < 8; ++e) { const float yg = wg[0][e] * g2[e] + wg[1][e] * g1[e] + wg[2][e] * g0[e] + bg[e]; const float yu = wu[0][e] * u2[e] + wu[1][e] * u1[e] + wu[2][e] * u0[e] + bu[e];
          o[e] = gelu_tanh(yg) * yu; g2[e] = g1[e]; g1[e] = g0[e]; u2[e] = u1[e]; u1[e] = u0[e]; }
        u32x4 pk = {pack2(o[0], o[1]), pack2(o[2], o[3]), pack2(o[4], o[5]), pack2(o[6], o[7])};
        *(u32x4*)(act + (size_t)(r0 + rb * 8 + i) * DFF + ch) = pk;
      }
    }
  }
}

__global__ void __launch_bounds__(NT) fwd_megakernel(Params P0) {
  cg::grid_group grid = cg::this_grid();
  __shared__ __attribute__((aligned(16))) char smem[132352];
  const int tid = threadIdx.x;
  char* ws = P0.ws;
  int* ctrl = (int*)(ws + OFF_CTRL);
  if (blockIdx.x == 0 && tid < 64) ctrl[tid] = 0;
  if (blockIdx.x == 0 && tid == 0) *(Params*)(ws + OFF_CTRL + 1024) = P0;
  bf16_t* Hb = (bf16_t*)(ws + OFF_H);
  for (int it = blockIdx.x; it < 192 + CV_T5; it += gridDim.x) { if (it < 192) mod_item(P0, it); else convert_item(P0, 0, it - 192, smem); }
  grid.sync();
  const Params& P = *(const Params*)(ws + OFF_CTRL + 1024);
  rownorm_phase(P, P.x, nullptr, P.out, Hb, 0, 0, nullptr, 0, 1, 0, P.mix_pre, smem);
  grid.sync();
  for (int l = 0; l < 2; ++l) {
    { EpiProj epi{(bf16_t*)(ws + OFF_PROJ), (float*)(ws + OFF_AB)}; gemm_phase(Hb, 2048, (const bf16_t*)(ws + OFF_W + W_IN), 2048, 2048, 64, 22, smem, epi); }
    grid.sync();
    for (int it = blockIdx.x; it < 448; it += gridDim.x) {
      if (it < 192) mla_q_tile(P, it / 3, it % 3, smem);
      else mla_kv_tile(P, (it - 192) >> 2, (it - 192) & 3, smem);
    }
    for (int id = (blockIdx.x + 64) % gridDim.x; id < 2048; id += gridDim.x) gdn_prep_item(P, l, id >> 3, id & 7, smem);
    grid.sync();
    {
      int* sitem = (int*)(smem + 132096);
      for (;;) {
        if (tid == 0) *sitem = atomicAdd(ctrl + 16 * l, 1);
        __syncthreads(); const int item = *sitem; __syncthreads();
        if (item >= 16 + 512 + 256) break;
        if (item < 16) gdn_scan_item(P, l, item >> 1, item & 1, smem);
        else if (item < 528) { const int idx = item - 16; mla_attn_item(P, idx & 3, 127 - (idx >> 2), smem); }
        else { const int idx = item - 528; swa_item(P, l, idx >> 1, idx & 1, smem); }
      }
    }
    grid.sync();
    gdn_fix_phase(P);
    grid.sync();
    { EpiBf epi{(bf16_t*)(ws + OFF_MIXF), 2048}; gemm_phase(Hb, 2048, (const bf16_t*)(ws + OFF_W + W_OUT), 2048, 2048, 64, 8, smem, epi); }
    grid.sync();
    rownorm_phase(P, P.out, (const bf16_t*)(ws + OFF_MIXF), P.out, Hb, l, 2, P.mix_post + l * 2048, l, 4, 3, P.ffn_pre + l * 2048, smem);
    grid.sync();
    { EpiBf epi{(bf16_t*)(ws + OFF_BIG), DFF2}; gemm_phase(Hb, 2048, (const bf16_t*)(ws + OFF_W + W_UP), 2048, 2048, 64, 44, smem, epi); }
    grid.sync();
    ffn_act_phase(P, l);
    grid.sync();
    { EpiBf epi{(bf16_t*)(ws + OFF_Y), 2048}; gemm_phase((const bf16_t*)(ws + OFF_ACT), DFF, (const bf16_t*)(ws + OFF_W + W_DOWN), DFF, DFF, 64, 8, smem, epi); }
    grid.sync();
    if (l == 0) {
      for (int it = blockIdx.x; it < CV_T5; it += gridDim.x) convert_item(P, 1, it, smem);
      rownorm_phase(P, P.out, (const bf16_t*)(ws + OFF_Y), P.out, Hb, 0, 5, P.ffn_post, 1, 1, 0, P.mix_pre + 2048, smem);
      grid.sync();
    } else {
      rownorm_phase(P, P.out, (const bf16_t*)(ws + OFF_Y), P.out, nullptr, 1, 5, P.ffn_post + 2048, 1, 1, 0, nullptr, smem);
    }
  }
}

extern "C" void kernel_launch(void* const* d_in, const int* in_sizes, int n_in, void* d_out, int out_size, void* d_ws, size_t ws_size, hipStream_t stream) {
  static int grid_blocks = 0;
  if (!grid_blocks) {
    int dev = 0, cus = 0, per = 0;
    (void)hipGetDevice(&dev); (void)hipDeviceGetAttribute(&cus, hipDeviceAttributeMultiprocessorCount, dev);
    (void)hipOccupancyMaxActiveBlocksPerMultiprocessor(&per, fwd_megakernel, NT, 0);
    if (per > 1) per = 1;
    grid_blocks = cus * per; if (grid_blocks <= 0) grid_blocks = 256;
  }
  if (ws_size < OFF_END) { fprintf(stderr, "workspace too small: %zu < %zu\n", ws_size, (size_t)OFF_END); return; }
  Params p{};
  p.x = (const float*)d_in[0]; p.c = (const float*)d_in[1]; p.pos = (const int*)d_in[2];
  p.ada_w = (const float*)d_in[3]; p.ada_b = (const float*)d_in[4]; p.mix_pre = (const float*)d_in[5]; p.mix_post = (const float*)d_in[6];
  p.w_in = (const float*)d_in[7]; p.w_out = (const float*)d_in[8]; p.gdn_conv = (const float*)d_in[9]; p.gdn_a_log = (const float*)d_in[10];
  p.gdn_dt_bias = (const float*)d_in[11]; p.gdn_norm = (const float*)d_in[12]; p.mla_q_norm = (const float*)d_in[13]; p.mla_w_uq = (const float*)d_in[14];
  p.mla_kv_norm = (const float*)d_in[15]; p.mla_w_ukv = (const float*)d_in[16]; p.swa_sinks = (const float*)d_in[17]; p.ffn_pre = (const float*)d_in[18];
  p.ffn_post = (const float*)d_in[19]; p.ffn_w_up = (const float*)d_in[20]; p.ffn_conv = (const float*)d_in[21]; p.ffn_conv_b = (const float*)d_in[22];
  p.ffn_w_down = (const float*)d_in[23];
  p.out = (float*)d_out; p.ws = (char*)d_ws;
  void* args[] = {&p};
  hipError_t e = hipLaunchCooperativeKernel((void*)fwd_megakernel, dim3(grid_blocks), dim3(NT), args, 0, stream);
  if (e != hipSuccess) fprintf(stderr, "cooperative launch failed: %s (grid %d)\n", hipGetErrorString(e), grid_blocks);
}
```

```cpp
#include <hip/hip_runtime.h>
#include <hip/hip_cooperative_groups.h>
#include <cstdio>
#include <cstdint>
namespace cg = cooperative_groups;

#define DI __device__ __forceinline__
typedef unsigned short bf16_t;
typedef short bf16x8 __attribute__((ext_vector_type(8)));
typedef float f32x2 __attribute__((ext_vector_type(2)));
typedef float f32x4 __attribute__((ext_vector_type(4)));
typedef float f32x16 __attribute__((ext_vector_type(16)));
typedef unsigned u32x2 __attribute__((ext_vector_type(2)));
typedef unsigned u32x4 __attribute__((ext_vector_type(4)));
typedef __bf16 bf2_t __attribute__((ext_vector_type(2)));

constexpr int S_ = 16384, D_ = 2048, DINP = 5632, DFF = 5632, DFF2 = 11264;
constexpr int NT = 512;
constexpr float EPS = 1e-6f;
constexpr float LOG2E = 1.4426950408889634f;

constexpr size_t OFF_CTRL = 0;
constexpr size_t OFF_MODP = 4096;
constexpr size_t OFF_XBAR = OFF_MODP + (size_t)2 * 16 * 12288 * 4;
constexpr size_t OFF_W = 2097152;
static_assert(OFF_XBAR + 3456 * 4 <= OFF_W, "xbar");
constexpr size_t W_IN = 0, W_OUT = W_IN + (size_t)5632 * 2048 * 2, W_UP = W_OUT + (size_t)2048 * 2048 * 2,
                 W_DOWN = W_UP + (size_t)11264 * 2048 * 2, W_UQ = W_DOWN + (size_t)2048 * 5632 * 2,
                 W_UKV = W_UQ + (size_t)768 * 448 * 2, W_END = W_UKV + (size_t)1024 * 128 * 2;
constexpr size_t OFF_H = OFF_W + W_END;
constexpr size_t OFF_MIXF = OFF_H + (size_t)S_ * 2048 * 2;
constexpr size_t OFF_QRAW = OFF_MIXF;
constexpr size_t OFF_KMLA = OFF_QRAW + (size_t)S_ * 768 * 4;
constexpr size_t OFF_VT = OFF_KMLA + (size_t)4 * S_ * 192 * 2;
constexpr size_t OFF_BIG = OFF_MIXF + (size_t)S_ * 2048 * 4;
constexpr size_t OFF_PROJ = OFF_BIG;
constexpr size_t OFF_WP = OFF_PROJ + (size_t)S_ * DINP * 2;
constexpr size_t OFF_QD = OFF_WP + (size_t)S_ * 1024 * 2;
constexpr size_t OFF_KT = OFF_QD + (size_t)S_ * 1024 * 2;
constexpr size_t OFF_ZT = OFF_KT + (size_t)S_ * 1024 * 2;
constexpr size_t OFF_QK = OFF_ZT + (size_t)S_ * 1024 * 2;
constexpr size_t OFF_AB = OFF_QK + (size_t)S_ * 512 * 2;
constexpr size_t OFF_GTOT = OFF_AB + (size_t)S_ * 16 * 4;
constexpr size_t OFF_Y = OFF_BIG;
constexpr size_t OFF_ACT = OFF_H;
constexpr size_t OFF_UT = OFF_BIG + (size_t)S_ * DFF2 * 2;
constexpr size_t OFF_END = OFF_UT + (size_t)S_ * 1024 * 4;
static_assert(OFF_GTOT + 8192 <= OFF_UT, "overlay");
static_assert(OFF_VT + (size_t)4 * 128 * S_ * 2 <= OFF_BIG, "overlay2");

constexpr int C_AQ = 0, C_AK = 1024, C_AV = 2048, C_AZ = 3072, C_AA = 4096, C_BCQ = 4112, C_BCKV = 4560,
              C_BKR = 4688, C_CQ = 4752, C_CK = 5264, C_CV = 5392;

__constant__ double kInvFreq2Pi[32] = {
    0.15915494309189535, 0.11934937021124886, 0.08949940160889101, 0.06711508300522726, 0.050329212104487035, 0.03774158471741977,
    0.0283021958306234, 0.02122365276477766, 0.015915494309189534, 0.011934937021124886, 0.008949940160889102, 0.006711508300522725,
    0.005032921210448704, 0.003774158471741977, 0.00283021958306234, 0.0021223652764777662, 0.0015915494309189536, 0.0011934937021124885,
    0.0008949940160889102, 0.0006711508300522726, 0.0005032921210448703, 0.00037741584717419774, 0.00028302195830623395, 0.0002122365276477766,
    0.00015915494309189535, 0.00011934937021124886, 8.949940160889102e-05, 6.711508300522725e-05, 5.0329212104487035e-05, 3.774158471741978e-05,
    2.8302195830623396e-05, 2.122365276477766e-05};

struct Params {
  const float* x; const float* c; const int* pos;
  const float *ada_w, *ada_b, *mix_pre, *mix_post, *w_in, *w_out, *gdn_conv, *gdn_a_log, *gdn_dt_bias, *gdn_norm, *mla_q_norm, *mla_w_uq,
      *mla_kv_norm, *mla_w_ukv, *swa_sinks, *ffn_pre, *ffn_post, *ffn_w_up, *ffn_conv, *ffn_conv_b, *ffn_w_down;
  float* out; char* ws;
};

DI unsigned pack2(float lo, float hi) { f32x2 v = {lo, hi}; bf2_t b = __builtin_convertvector(v, bf2_t); return __builtin_bit_cast(unsigned, b); }
DI bf16_t f2bf(float x) { return (bf16_t)(pack2(x, 0.f) & 0xffffu); }
DI float bflo(unsigned u) { return __uint_as_float(u << 16); }
DI float bfhi(unsigned u) { return __uint_as_float(u & 0xffff0000u); }
DI void unpack8(const u32x4& v, float* f) { f[0] = bflo(v.x); f[1] = bfhi(v.x); f[2] = bflo(v.y); f[3] = bfhi(v.y); f[4] = bflo(v.z); f[5] = bfhi(v.z); f[6] = bflo(v.w); f[7] = bfhi(v.w); }
DI bf16x8 pack8(float a0, float a1, float a2, float a3, float a4, float a5, float a6, float a7) {
  u32x4 p = {pack2(a0, a1), pack2(a2, a3), pack2(a4, a5), pack2(a6, a7)}; return __builtin_bit_cast(bf16x8, p); }
DI float silu_f(float x) { return x / (1.f + __expf(-x)); }
DI float wave_sum(float v) { v += __shfl_xor(v, 32); v += __shfl_xor(v, 16); v += __shfl_xor(v, 8); v += __shfl_xor(v, 4); v += __shfl_xor(v, 2); v += __shfl_xor(v, 1); return v; }
DI int opaque_tid() { int t = threadIdx.x; asm volatile("" : "+v"(t)); return t; }
DI int crow(int r, int h) { return (r & 3) + 8 * (r >> 2) + 4 * h; }
DI int perm32(int k) { return 8 * ((k >> 2) & 3) + 4 * (k >> 4) + (k & 3); }
#define MFMA32(a, b, c) __builtin_amdgcn_mfma_f32_32x32x16_bf16((a), (b), (c), 0, 0, 0)
#define MFMA16(a, b, c) __builtin_amdgcn_mfma_f32_16x16x32_bf16((a), (b), (c), 0, 0, 0)

template <class Epi>
DI void gemm_tile(const bf16_t* __restrict__ A, int lda, const bf16_t* __restrict__ Bt, int ldb, int K, int m0, int n0, char* smem, const Epi& epi) {
  const int tid = opaque_tid(), lane = tid & 63, w = tid >> 6, wm = w >> 2, wn = w & 3, lq = lane & 31, h = lane >> 5;
  f32x16 acc[2][4];
#pragma unroll
  for (int i = 0; i < 2; ++i)
#pragma unroll
    for (int j = 0; j < 4; ++j)
#pragma unroll
      for (int r = 0; r < 16; ++r) acc[i][j][r] = 0.f;
  const int r0 = tid >> 3, c0 = tid & 7;
  const bf16_t* ag = A + (size_t)(m0 + r0) * lda + c0 * 8;
  const bf16_t* bg = Bt + (size_t)(n0 + r0) * ldb + c0 * 8;
  const int wofs = r0 * 128 + ((c0 ^ ((r0 >> 1) & 7)) << 4);
  char* sA = smem; char* sB = smem + 65536;
  u32x4 ra0[4], rb0[4], ra1[4], rb1[4];
  const int nk = K >> 6, swz = (lane >> 1) & 7;
  const int aoff = (64 * wn + lq) * 128, boff = (128 * wm + lq) * 128;
#define GLOAD(RA, RB, KT) { _Pragma("unroll") for (int i = 0; i < 4; ++i) { RA[i] = *(const u32x4*)(ag + (size_t)(KT) * 64 + (size_t)i * 64 * lda); RB[i] = *(const u32x4*)(bg + (size_t)(KT) * 64 + (size_t)i * 64 * ldb); } }
#define LWRITE(RA, RB, ST) { _Pragma("unroll") for (int i = 0; i < 4; ++i) { *(u32x4*)(sA + (ST) * 32768 + wofs + i * 8192) = RA[i]; *(u32x4*)(sB + (ST) * 32768 + wofs + i * 8192) = RB[i]; } }
#define KSTEP(ST, RA, RB, KN) { const char* cA = sA + (ST) * 32768; const char* cB = sB + (ST) * 32768; char* dA = sA + (1 - (ST)) * 32768; char* dB = sB + (1 - (ST)) * 32768; \
    const bf16_t* agn = ag + (size_t)(KN) * 64; const bf16_t* bgn = bg + (size_t)(KN) * 64; \
    _Pragma("unroll") for (int s = 0; s < 4; ++s) { const int co = (((2 * s + h) ^ swz) << 4); bf16x8 fa[2], fb[4]; \
      _Pragma("unroll") for (int ni = 0; ni < 2; ++ni) fa[ni] = *(const bf16x8*)(cB + aoff + ni * 4096 + co); \
      _Pragma("unroll") for (int mi = 0; mi < 4; ++mi) fb[mi] = *(const bf16x8*)(cA + boff + mi * 4096 + co); \
      *(u32x4*)(dA + wofs + s * 8192) = RA[s]; *(u32x4*)(dB + wofs + s * 8192) = RB[s]; \
      RA[s] = *(const u32x4*)(agn + (size_t)s * 64 * lda); RB[s] = *(const u32x4*)(bgn + (size_t)s * 64 * ldb); \
      _Pragma("unroll") for (int ni = 0; ni < 2; ++ni) _Pragma("unroll") for (int mi = 0; mi < 4; ++mi) acc[ni][mi] = MFMA32(fa[ni], fb[mi], acc[ni][mi]); \
      __builtin_amdgcn_sched_barrier(0); } }
  const int kl = nk - 1;
  GLOAD(ra0, rb0, 0);
  GLOAD(ra1, rb1, (1 < kl ? 1 : kl));
  LWRITE(ra0, rb0, 0);
  GLOAD(ra0, rb0, (2 < kl ? 2 : kl));
  __syncthreads();
  for (int kt = 0; kt < nk; kt += 2) {
    KSTEP(0, ra1, rb1, (kt + 3 < kl ? kt + 3 : kl));
    __syncthreads();
    if (kt + 1 < nk) {
      KSTEP(1, ra0, rb0, (kt + 4 < kl ? kt + 4 : kl));
      __syncthreads();
    }
  }
#undef GLOAD
#undef LWRITE
#undef KSTEP
#pragma unroll
  for (int ni = 0; ni < 2; ++ni)
#pragma unroll
    for (int mi = 0; mi < 4; ++mi)
#pragma unroll
      for (int rg = 0; rg < 4; ++rg) {
        const int m = m0 + 128 * wm + 32 * mi + lq, n = n0 + 64 * wn + 32 * ni + 8 * rg + 4 * h;
        epi(m, n, acc[ni][mi][4 * rg], acc[ni][mi][4 * rg + 1], acc[ni][mi][4 * rg + 2], acc[ni][mi][4 * rg + 3]);
      }
}

template <class Epi>
DI void gemm_tile_s(const bf16_t* __restrict__ A, int lda, const bf16_t* __restrict__ Bt, int ldb, int K, int m0, int n0, char* smem, const Epi& epi) {
  const int tid = opaque_tid(), lane = tid & 63, w = tid >> 6, wm = w >> 2, wn = w & 3, lq = lane & 31, h = lane >> 5;
  f32x16 acc[2][4];
#pragma unroll
  for (int i = 0; i < 2; ++i)
#pragma unroll
    for (int j = 0; j < 4; ++j)
#pragma unroll
      for (int r = 0; r < 16; ++r) acc[i][j][r] = 0.f;
  const int r0 = tid >> 3, c0 = tid & 7;
  const bf16_t* ag = A + (size_t)(m0 + r0) * lda + c0 * 8;
  const bf16_t* bg = Bt + (size_t)(n0 + r0) * ldb + c0 * 8;
  const int wofs = r0 * 128 + ((c0 ^ ((r0 >> 1) & 7)) << 4);
  char* sA = smem; char* sB = smem + 32768;
  u32x4 ra[4], rb[4];
#pragma unroll
  for (int i = 0; i < 4; ++i) { ra[i] = *(const u32x4*)(ag + (size_t)i * 64 * lda); rb[i] = *(const u32x4*)(bg + (size_t)i * 64 * ldb); }
#pragma unroll
  for (int i = 0; i < 4; ++i) { *(u32x4*)(sA + wofs + i * 8192) = ra[i]; *(u32x4*)(sB + wofs + i * 8192) = rb[i]; }
  __syncthreads();
  const int nk = K >> 6, swz = (lane >> 1) & 7;
  const int aoff = (64 * wn + lq) * 128, boff = (128 * wm + lq) * 128;
  for (int kt = 0; kt < nk; ++kt) {
    const char* cA = sA + (kt & 1) * 65536; const char* cB = sB + (kt & 1) * 65536;
    const bool more = (kt + 1 < nk);
    if (more) { ag += 64; bg += 64;
#pragma unroll
      for (int i = 0; i < 4; ++i) { ra[i] = *(const u32x4*)(ag + (size_t)i * 64 * lda); rb[i] = *(const u32x4*)(bg + (size_t)i * 64 * ldb); } }
#pragma unroll
    for (int s = 0; s < 4; ++s) {
      const int co = (((2 * s + h) ^ swz) << 4);
      bf16x8 fa[2], fb[4];
#pragma unroll
      for (int ni = 0; ni < 2; ++ni) fa[ni] = *(const bf16x8*)(cB + aoff + ni * 4096 + co);
#pragma unroll
      for (int mi = 0; mi < 4; ++mi) fb[mi] = *(const bf16x8*)(cA + boff + mi * 4096 + co);
#pragma unroll
      for (int ni = 0; ni < 2; ++ni)
#pragma unroll
        for (int mi = 0; mi < 4; ++mi) acc[ni][mi] = MFMA32(fa[ni], fb[mi], acc[ni][mi]);
    }
    if (more) { char* dA = sA + ((kt + 1) & 1) * 65536; char* dB = sB + ((kt + 1) & 1) * 65536;
#pragma unroll
      for (int i = 0; i < 4; ++i) { *(u32x4*)(dA + wofs + i * 8192) = ra[i]; *(u32x4*)(dB + wofs + i * 8192) = rb[i]; } }
    __syncthreads();
  }
#pragma unroll
  for (int ni = 0; ni < 2; ++ni)
#pragma unroll
    for (int mi = 0; mi < 4; ++mi)
#pragma unroll
      for (int rg = 0; rg < 4; ++rg) {
        const int m = m0 + 128 * wm + 32 * mi + lq, n = n0 + 64 * wn + 32 * ni + 8 * rg + 4 * h;
        epi(m, n, acc[ni][mi][4 * rg], acc[ni][mi][4 * rg + 1], acc[ni][mi][4 * rg + 2], acc[ni][mi][4 * rg + 3]);
      }
}

DI void tile_coord(int t, int npn, int& pm, int& pn) { const int g = t / (16 * npn), r = t % (16 * npn); pn = r >> 4; pm = g * 16 + (r & 15); }

struct EpiProj { bf16_t* proj; float* ab;
  DI void operator()(int m, int n, float v0, float v1, float v2, float v3) const {
    u32x2 pk = {pack2(v0, v1), pack2(v2, v3)}; *(u32x2*)(proj + (size_t)m * DINP + n) = pk;
    if (n >= C_AA && n < C_AA + 16) { f32x4 v = {v0, v1, v2, v3}; *(f32x4*)(ab + (size_t)m * 16 + (n - C_AA)) = v; } } };
struct EpiF32 { float* out; int ldc;
  DI void operator()(int m, int n, float v0, float v1, float v2, float v3) const { f32x4 v = {v0, v1, v2, v3}; *(f32x4*)(out + (size_t)m * ldc + n) = v; } };
struct EpiBf { bf16_t* out; int ldc;
  DI void operator()(int m, int n, float v0, float v1, float v2, float v3) const { u32x2 pk = {pack2(v0, v1), pack2(v2, v3)}; *(u32x2*)(out + (size_t)m * ldc + n) = pk; } };
struct EpiMlaQ { float* qraw; const float* rs; int m0;
  DI void operator()(int m, int n, float v0, float v1, float v2, float v3) const { const float r = rs[m - m0]; f32x4 v = {v0 * r, v1 * r, v2 * r, v3 * r}; *(f32x4*)(qraw + (size_t)m * 768 + n) = v; } };
struct EpiMlaKV { bf16_t* kmla; bf16_t* vt; const float* rs; int m0;
  DI void operator()(int m, int n, float v0, float v1, float v2, float v3) const {
    const float r = rs[m - m0]; const int hd = n >> 8, wi = n & 255;
    if (wi < 128) { u32x2 pk = {pack2(v0 * r, v1 * r), pack2(v2 * r, v3 * r)}; *(u32x2*)(kmla + ((size_t)hd * S_ + m) * 192 + wi) = pk; }
    else { bf16_t* p = vt + ((size_t)hd * 128 + (wi - 128)) * S_ + m; p[0] = f2bf(v0 * r); p[S_] = f2bf(v1 * r); p[2 * (size_t)S_] = f2bf(v2 * r); p[3 * (size_t)S_] = f2bf(v3 * r); } } };

template <class Epi>
DI void gemm_phase(const bf16_t* A, int lda, const bf16_t* Bt, int ldb, int K, int npm, int npn, char* smem, const Epi& epi) {
  if (gridDim.x == 256 && npm == 64) {
    const int b = blockIdx.x, pm = 8 * (b & 7) + ((b >> 3) & 7), pj = b >> 6;
    for (int pn = pj; pn < npn; pn += 4) gemm_tile(A, lda, Bt, ldb, K, pm * 256, pn * 256, smem, epi);
  } else {
    for (int t = blockIdx.x; t < npm * npn; t += gridDim.x) { int pm, pn; tile_coord(t, npn, pm, pn); gemm_tile(A, lda, Bt, ldb, K, pm * 256, pn * 256, smem, epi); }
  }
}

DI void mod_item(const Params& P, int item) {
  const int tid = opaque_tid(); const int l = item / 96, r = item % 96, ks = r / 6, nc = r % 6;
  const int n = nc * 2048 + tid * 4;
  const float* wp = P.ada_w + ((size_t)l * 2048 + ks * 128) * 12288 + n;
  f32x4 acc = {0.f, 0.f, 0.f, 0.f};
#pragma unroll 8
  for (int k = 0; k < 128; ++k) { const float cv = P.c[ks * 128 + k]; const float ca = silu_f(cv); const f32x4 wv = *(const f32x4*)(wp + (size_t)k * 12288); acc += wv * ca; }
  float* modp = (float*)(P.ws + OFF_MODP);
  *(f32x4*)(modp + ((size_t)l * 16 + ks) * 12288 + n) = acc;
}
DI void convert_tile(const float* __restrict__ src, int K, int N, bf16_t* __restrict__ dst, int tk, int tn, const float* rowscale, char* smem) {
  float* sm = (float*)smem; const int tid = opaque_tid(); const int k0 = tk * 64, n0 = tn * 256;
  { const int r = tid >> 6, c4 = tid & 63; const int n = n0 + 4 * c4;
    f32x4 v[8];
#pragma unroll
    for (int i = 0; i < 8; ++i) { v[i] = (f32x4){0.f, 0.f, 0.f, 0.f}; if (n < N) v[i] = *(const f32x4*)(src + (size_t)(k0 + r + 8 * i) * N + n); }
#pragma unroll
    for (int i = 0; i < 8; ++i) { const int kk = r + 8 * i; if (rowscale) v[i] *= rowscale[k0 + kk];
      sm[kk * 257 + 4 * c4 + 0] = v[i].x; sm[kk * 257 + 4 * c4 + 1] = v[i].y; sm[kk * 257 + 4 * c4 + 2] = v[i].z; sm[kk * 257 + 4 * c4 + 3] = v[i].w; } }
  __syncthreads();
  { const int n = tid >> 1, kh = tid & 1;
#pragma unroll
    for (int j = 0; j < 4; ++j) { float f[8];
#pragma unroll
      for (int i = 0; i < 8; ++i) f[i] = sm[(32 * kh + 8 * j + i) * 257 + n];
      u32x4 pk = {pack2(f[0], f[1]), pack2(f[2], f[3]), pack2(f[4], f[5]), pack2(f[6], f[7])};
      *(u32x4*)(dst + (size_t)(n0 + n) * K + k0 + 32 * kh + 8 * j) = pk; } }
  __syncthreads();
}
constexpr int CV_T0 = 32 * 22, CV_T1 = CV_T0 + 32 * 8, CV_T2 = CV_T1 + 32 * 44, CV_T3 = CV_T2 + 88 * 8, CV_T4 = CV_T3 + 7 * 3, CV_T5 = CV_T4 + 2 * 4;
DI void convert_item(const Params& P, int l, int it, char* smem) {
  char* wb = P.ws + OFF_W;
  if (it < CV_T0) convert_tile(P.w_in + (size_t)l * 2048 * 5520, 2048, 5520, (bf16_t*)(wb + W_IN), it / 22, it % 22, nullptr, smem);
  else if (it < CV_T1) { it -= CV_T0; convert_tile(P.w_out + (size_t)l * 2048 * 2048, 2048, 2048, (bf16_t*)(wb + W_OUT), it / 8, it % 8, nullptr, smem); }
  else if (it < CV_T2) { it -= CV_T1; convert_tile(P.ffn_w_up + (size_t)l * 2048 * 11264, 2048, 11264, (bf16_t*)(wb + W_UP), it / 44, it % 44, nullptr, smem); }
  else if (it < CV_T3) { it -= CV_T2; convert_tile(P.ffn_w_down + (size_t)l * 5632 * 2048, 5632, 2048, (bf16_t*)(wb + W_DOWN), it / 8, it % 8, nullptr, smem); }
  else if (it < CV_T4) { it -= CV_T3; convert_tile(P.mla_w_uq + (size_t)l * 448 * 768, 448, 768, (bf16_t*)(wb + W_UQ), it / 3, it % 3, P.mla_q_norm + l * 448, smem); }
  else { it -= CV_T4; convert_tile(P.mla_w_ukv + (size_t)l * 128 * 1024, 128, 1024, (bf16_t*)(wb + W_UKV), it / 4, it % 4, P.mla_kv_norm + l * 128, smem); }
}

DI float mod_val(const float* modp_l, const float* ada_b_l, int idx) { float s = ada_b_l[idx];
#pragma unroll
  for (int k = 0; k < 16; ++k) s += modp_l[(size_t)k * 12288 + idx]; return s; }
DI void rownorm_phase(const Params& P, const float* xin, const bf16_t* yin, float* xout, bf16_t* hout, int lg, int gate_idx, const float* w_post,
                      int lh, int scale_idx, int shift_idx, const float* w_pre, char* smem) {
  float* A1 = (float*)smem; float* A2 = A1 + 2048; float* B2 = A2 + 2048;
  const int tid = opaque_tid(), lane = tid & 63, w = tid >> 6;
  const float* modp = (const float*)(P.ws + OFF_MODP);
  for (int cidx = tid; cidx < 2048; cidx += NT) {
    if (yin) A1[cidx] = mod_val(modp + (size_t)lg * 16 * 12288, P.ada_b + (size_t)lg * 12288, gate_idx * 2048 + cidx) * w_post[cidx];
    if (hout) { A2[cidx] = w_pre[cidx] * (1.f + mod_val(modp + (size_t)lh * 16 * 12288, P.ada_b + (size_t)lh * 12288, scale_idx * 2048 + cidx));
      B2[cidx] = mod_val(modp + (size_t)lh * 16 * 12288, P.ada_b + (size_t)lh * 12288, shift_idx * 2048 + cidx); }
  }
  __syncthreads();
  for (int row = blockIdx.x * 8 + w; row < S_; row += gridDim.x * 8) {
    f32x4 xv[8];
#pragma unroll
    for (int j = 0; j < 8; ++j) xv[j] = *(const f32x4*)(xin + (size_t)row * 2048 + (j * 64 + lane) * 4);
    if (yin) {
      f32x4 yv[8]; float ss = 0.f;
#pragma unroll
      for (int j = 0; j < 8; ++j) { const u32x2 yb = *(const u32x2*)(yin + (size_t)row * 2048 + (j * 64 + lane) * 4); yv[j] = (f32x4){bflo(yb.x), bfhi(yb.x), bflo(yb.y), bfhi(yb.y)};
        ss += yv[j].x * yv[j].x + yv[j].y * yv[j].y + yv[j].z * yv[j].z + yv[j].w * yv[j].w; }
      ss = wave_sum(ss); const float r = rsqrtf(ss * (1.f / 2048.f) + EPS);
#pragma unroll
      for (int j = 0; j < 8; ++j) { const f32x4 a = *(const f32x4*)(A1 + (j * 64 + lane) * 4); xv[j] += a * (yv[j] * r); }
    }
    if (yin || xout != xin) {
#pragma unroll
      for (int j = 0; j < 8; ++j) *(f32x4*)(xout + (size_t)row * 2048 + (j * 64 + lane) * 4) = xv[j];
    }
    if (hout) {
      float ss = 0.f;
#pragma unroll
      for (int j = 0; j < 8; ++j) ss += xv[j].x * xv[j].x + xv[j].y * xv[j].y + xv[j].z * xv[j].z + xv[j].w * xv[j].w;
      ss = wave_sum(ss); const float r = rsqrtf(ss * (1.f / 2048.f) + EPS);
#pragma unroll
      for (int j = 0; j < 8; ++j) { const f32x4 a = *(const f32x4*)(A2 + (j * 64 + lane) * 4), b = *(const f32x4*)(B2 + (j * 64 + lane) * 4);
        const f32x4 hv = xv[j] * r * a + b; u32x2 pk = {pack2(hv.x, hv.y), pack2(hv.z, hv.w)};
        *(u32x2*)(hout + (size_t)row * 2048 + (j * 64 + lane) * 4) = pk; }
    }
  }
  __syncthreads();
}

DI void mla_q_tile(const Params& P, int pm, int pn, char* smem) {
  const bf16_t* proj = (const bf16_t*)(P.ws + OFF_PROJ); const int tid = opaque_tid(), m0 = pm * 256; float* rs = (float*)(smem + 131072);
  { const int row = tid >> 1, half = tid & 1; const bf16_t* p = proj + (size_t)(m0 + row) * DINP + C_BCQ + half * 224; float ss = 0.f;
    for (int i = 0; i < 28; ++i) { const u32x4 v = *(const u32x4*)(p + i * 8); float f[8]; unpack8(v, f);
#pragma unroll
      for (int e = 0; e < 8; ++e) ss += f[e] * f[e]; }
    ss += __shfl_xor(ss, 1); if (half == 0) rs[row] = rsqrtf(ss * (1.f / 448.f) + EPS); }
  EpiMlaQ epi{(float*)(P.ws + OFF_QRAW), rs, m0};
  gemm_tile_s(proj + C_BCQ, DINP, (const bf16_t*)(P.ws + OFF_W + W_UQ), 448, 448, m0, pn * 256, smem, epi);
  __syncthreads();
}
DI void mla_kv_tile(const Params& P, int pm, int pn, char* smem) {
  const bf16_t* proj = (const bf16_t*)(P.ws + OFF_PROJ); const int tid = opaque_tid(), m0 = pm * 256; float* rs = (float*)(smem + 131072);
  { const int row = tid >> 1, half = tid & 1; const bf16_t* p = proj + (size_t)(m0 + row) * DINP + C_BCKV + half * 64; float ss = 0.f;
#pragma unroll
    for (int i = 0; i < 8; ++i) { const u32x4 v = *(const u32x4*)(p + i * 8); float f[8]; unpack8(v, f);
#pragma unroll
      for (int e = 0; e < 8; ++e) ss += f[e] * f[e]; }
    ss += __shfl_xor(ss, 1); if (half == 0) rs[row] = rsqrtf(ss * (1.f / 128.f) + EPS); }
  bf16_t* kmla = (bf16_t*)(P.ws + OFF_KMLA);
  EpiMlaKV epi{kmla, (bf16_t*)(P.ws + OFF_VT), rs, m0};
  gemm_tile_s(proj + C_BCKV, DINP, (const bf16_t*)(P.ws + OFF_W + W_UKV), 128, 128, m0, pn * 256, smem, epi);
  if (pn == 0) {
    for (int i = 0; i < 16; ++i) { const int idx = tid + NT * i, row = idx >> 5, pi = idx & 31, m = m0 + row;
      const float x1 = bflo((unsigned)proj[(size_t)m * DINP + C_BKR + pi]), x2 = bflo((unsigned)proj[(size_t)m * DINP + C_BKR + 32 + pi]);
      double fr = (double)P.pos[m] * kInvFreq2Pi[pi]; fr -= floor(fr); const float ff = (float)fr;
      const float sn = __builtin_amdgcn_sinf(ff), cs = __builtin_amdgcn_cosf(ff);
      const bf16_t o1 = f2bf(x1 * cs - x2 * sn), o2 = f2bf(x2 * cs + x1 * sn);
#pragma unroll
      for (int hd = 0; hd < 4; ++hd) { bf16_t* kp = kmla + ((size_t)hd * S_ + m) * 192 + 128; kp[pi] = o1; kp[32 + pi] = o2; } }
  }
  __syncthreads();
}

DI void gdn_prep_item(const Params& P, int l, int n, int hh, char* smem) {
  const int tid = opaque_tid(), lane = tid & 63, w = tid >> 6, lq = lane & 31, h = lane >> 5;
  const bf16_t* proj = (const bf16_t*)(P.ws + OFF_PROJ); const float* ab = (const float*)(P.ws + OFF_AB);
  char* kb16 = smem; char* qb16 = smem + 17408;
  float* kf = (float*)(smem + 34816); float* vf = kf + 8192; float* Lm = vf + 8192; float* gcs = Lm + 4096;
  const size_t tile = (size_t)hh * 256 + n; const int t0 = n * 64;
  bf16_t* Wp = (bf16_t*)(P.ws + OFF_WP) + tile * 8192; bf16_t* Qd = (bf16_t*)(P.ws + OFF_QD) + tile * 8192;
  bf16_t* Kt = (bf16_t*)(P.ws + OFF_KT) + tile * 8192; bf16_t* Zt = (bf16_t*)(P.ws + OFF_ZT) + tile * 8192;
  bf16_t* QK = (bf16_t*)(P.ws + OFF_QK) + tile * 4096; bf16_t* Ut = (bf16_t*)(P.ws + OFF_UT) + tile * 8192;
  if (w == 0) {
    const int t = lane; const float a_raw = ab[(size_t)(t0 + t) * 16 + hh], b_raw = ab[(size_t)(t0 + t) * 16 + 8 + hh];
    const float Aa = __expf(P.gdn_a_log[l * 8 + hh]); const float xb = a_raw + P.gdn_dt_bias[l * 8 + hh];
    const float ex = __expf(fminf(xb, 20.f));
    const float sp = xb > 20.f ? xb : (ex < 0.01f ? ex * (1.f - ex * (0.5f - ex * (1.f / 3.f))) : __logf(1.f + ex));
    float g = -Aa * sp;
#pragma unroll
    for (int d = 1; d < 64; d <<= 1) { const float v = __shfl_up(g, d); if (lane >= d) g += v; }
    const float bt = 1.f / (1.f + __expf(-b_raw)), eg = __expf(g); gcs[t] = g; gcs[64 + t] = bt; gcs[128 + t] = eg; gcs[192 + t] = bt * eg;
    if (t == 63) ((float*)(P.ws + OFF_GTOT))[tile] = eg;
  }
  __syncthreads();
  {
    const int t = tid >> 3, part = tid & 7, tabs = t0 + t;
    const float gct = gcs[t], egct = gcs[128 + t], ktl = __expf(gcs[63] - gct);
    const int pjt = 32 * (t >> 5) + perm32(t & 31);
#pragma unroll
    for (int X = 0; X < 3; ++X) {
      const int cb = X * 1024 + hh * 128 + part * 16;
      float y[16];
#pragma unroll
      for (int e = 0; e < 16; ++e) y[e] = 0.f;
#pragma unroll
      for (int j = 0; j < 4; ++j) { const int row = tabs - 3 + j;
        if (row >= 0) { const u32x4 v0 = *(const u32x4*)(proj + (size_t)row * DINP + cb), v1 = *(const u32x4*)(proj + (size_t)row * DINP + cb + 8);
          float xv[16]; unpack8(v0, xv); unpack8(v1, xv + 8); const float* cw = P.gdn_conv + ((size_t)l * 4 + j) * 3072 + cb;
#pragma unroll
          for (int e4 = 0; e4 < 4; ++e4) { const f32x4 wv = *(const f32x4*)(cw + 4 * e4); y[4 * e4] += wv.x * xv[4 * e4]; y[4 * e4 + 1] += wv.y * xv[4 * e4 + 1]; y[4 * e4 + 2] += wv.z * xv[4 * e4 + 2]; y[4 * e4 + 3] += wv.w * xv[4 * e4 + 3]; } } }
#pragma unroll
      for (int e = 0; e < 16; ++e) y[e] = silu_f(y[e]);
      if (X < 2) { float ss = 0.f;
#pragma unroll
        for (int e = 0; e < 16; ++e) ss += y[e] * y[e];
        ss += __shfl_xor(ss, 1); ss += __shfl_xor(ss, 2); ss += __shfl_xor(ss, 4);
        const float rn = rsqrtf(ss + EPS) * (X == 0 ? 0.08838834764831845f : 1.f);
#pragma unroll
        for (int e = 0; e < 16; ++e) y[e] *= rn; }
      if (X == 0) {
        u32x4 p0 = {pack2(y[0], y[1]), pack2(y[2], y[3]), pack2(y[4], y[5]), pack2(y[6], y[7])}, p1 = {pack2(y[8], y[9]), pack2(y[10], y[11]), pack2(y[12], y[13]), pack2(y[14], y[15])};
        *(u32x4*)(qb16 + t * 272 + part * 32) = p0; *(u32x4*)(qb16 + t * 272 + part * 32 + 16) = p1;
#pragma unroll
        for (int b = 0; b < 4; ++b) { u32x2 pk = {pack2(y[4 * b] * egct, y[4 * b + 1] * egct), pack2(y[4 * b + 2] * egct, y[4 * b + 3] * egct)};
          *(u32x2*)(Qd + t * 128 + 32 * (part >> 1) + 8 * b + 4 * (part & 1)) = pk; }
      } else if (X == 1) {
        u32x4 p0 = {pack2(y[0], y[1]), pack2(y[2], y[3]), pack2(y[4], y[5]), pack2(y[6], y[7])}, p1 = {pack2(y[8], y[9]), pack2(y[10], y[11]), pack2(y[12], y[13]), pack2(y[14], y[15])};
        *(u32x4*)(kb16 + t * 272 + part * 32) = p0; *(u32x4*)(kb16 + t * 272 + part * 32 + 16) = p1;
#pragma unroll
        for (int e4 = 0; e4 < 4; ++e4) { f32x4 v = {y[4 * e4], y[4 * e4 + 1], y[4 * e4 + 2], y[4 * e4 + 3]}; *(f32x4*)(kf + t * 128 + part * 16 + 4 * e4) = v; }
#pragma unroll
        for (int e = 0; e < 16; ++e) Kt[(part * 16 + e) * 64 + pjt] = f2bf(y[e] * ktl);
      } else {
#pragma unroll
        for (int e4 = 0; e4 < 4; ++e4) { f32x4 v = {y[4 * e4], y[4 * e4 + 1], y[4 * e4 + 2], y[4 * e4 + 3]}; *(f32x4*)(vf + t * 128 + part * 16 + 4 * e4) = v; }
      }
    }
    { const int cb = C_AZ + hh * 128 + part * 16; const u32x4 v0 = *(const u32x4*)(proj + (size_t)tabs * DINP + cb), v1 = *(const u32x4*)(proj + (size_t)tabs * DINP + cb + 8);
      float zv[16]; unpack8(v0, zv); unpack8(v1, zv + 8);
#pragma unroll
      for (int e = 0; e < 16; ++e) Zt[(part * 16 + e) * 64 + t] = f2bf(silu_f(zv[e])); }
  }
  __syncthreads();
  {
    const int which = w >> 2, ti = (w >> 1) & 1, tj = w & 1; const char* Ab = which ? qb16 : kb16;
    f32x16 acc;
#pragma unroll
    for (int r = 0; r < 16; ++r) acc[r] = 0.f;
#pragma unroll
    for (int s = 0; s < 8; ++s) { const bf16x8 a = *(const bf16x8*)(Ab + (32 * ti + lq) * 272 + (16 * s + 8 * h) * 2), b = *(const bf16x8*)(kb16 + (32 * tj + lq) * 272 + (16 * s + 8 * h) * 2);
      acc = MFMA32(a, b, acc); }
    const int j = 32 * tj + lq; const float gj = gcs[j]; const int pj = 32 * (j >> 5) + perm32(j & 31);
#pragma unroll
    for (int r = 0; r < 16; ++r) { const int i = 32 * ti + crow(r, h); const float dec = __expf(fminf(gcs[i] - gj, 0.f));
      if (which == 0) Lm[i * 64 + j] = (j < i) ? gcs[64 + i] * acc[r] * dec : 0.f;
      else QK[i * 64 + pj] = f2bf((j <= i) ? acc[r] * dec : 0.f); }
  }
  __syncthreads();
  if (tid < 256) {
    const int c = tid; const bool isu = c < 128; const int cc = c & 127;
    const float* rp = (isu ? vf : kf) + cc; const float* sp = gcs + (isu ? 64 : 192);
    float x[64];
#pragma unroll
    for (int i = 0; i < 64; ++i) {
      float r = sp[i] * rp[i * 128];
#pragma unroll
      for (int j = 0; j < i; ++j) r = fmaf(-Lm[i * 64 + j], x[j], r);
      x[i] = r;
    }
    if (isu) {
#pragma unroll
      for (int i8 = 0; i8 < 8; ++i8) { u32x4 v = {pack2(x[8 * i8], x[8 * i8 + 1]), pack2(x[8 * i8 + 2], x[8 * i8 + 3]), pack2(x[8 * i8 + 4], x[8 * i8 + 5]), pack2(x[8 * i8 + 6], x[8 * i8 + 7])}; *(u32x4*)(Ut + cc * 64 + 8 * i8) = v; }
    } else {
      const int pp = 32 * (cc >> 5) + perm32(cc & 31);
#pragma unroll
      for (int i = 0; i < 64; ++i) Wp[i * 128 + pp] = f2bf(x[i]);
    }
  }
  __syncthreads();
}

DI bf16x8 pack_tiles(const f32x4& a, const f32x4& b) { return pack8(a.x, a.y, a.z, a.w, b.x, b.y, b.z, b.w); }
template <int CTRL> DI float dppf(float v) { return __int_as_float(__builtin_amdgcn_update_dpp(0, __float_as_int(v), CTRL, 0xf, 0xf, true)); }
DI float row16_sum(float v) { v += dppf<0xB1>(v); v += dppf<0x4E>(v); v += dppf<0x141>(v); v += dppf<0x140>(v); return v; }
constexpr size_t OFF_SSQP = OFF_GTOT + 8192;
static_assert(OFF_SSQP + (size_t)2 * S_ * 8 * 4 <= OFF_UT, "overlay3");
DI void gdn_scan_item(const Params& P, int l, int hh, int half, char* smem) {
  const int tid = opaque_tid(), lane = tid & 63, w = tid >> 6, l15 = lane & 15, q4 = lane >> 4;
  constexpr int OPB = 62464;
  float* sPart = (float*)(smem + 2 * OPB);
  const size_t hb = (size_t)hh * 256;
  const bf16_t* Wp = (const bf16_t*)(P.ws + OFF_WP) + hb * 8192; const bf16_t* Qd = (const bf16_t*)(P.ws + OFF_QD) + hb * 8192;
  const bf16_t* Kt = (const bf16_t*)(P.ws + OFF_KT) + hb * 8192; const bf16_t* Zt = (const bf16_t*)(P.ws + OFF_ZT) + hb * 8192;
  const bf16_t* QK = (const bf16_t*)(P.ws + OFF_QK) + hb * 4096; const bf16_t* Ut = (const bf16_t*)(P.ws + OFF_UT) + hb * 8192;
  const float* gt = (const float*)(P.ws + OFF_GTOT) + hb;
  float* ssqp = (float*)(P.ws + OFF_SSQP) + (size_t)half * S_ * 8;
  bf16_t* mixin = (bf16_t*)(P.ws + OFF_H);
  if (w >= 4) {
    const int lt = tid - 256;
    const int g256 = (lt >> 4) * 128 + (lt & 15) * 8, l256 = (lt >> 4) * 272 + (lt & 15) * 16;
    const int g128 = (lt >> 3) * 64 + (lt & 7) * 8, l128 = (lt >> 3) * 144 + (lt & 7) * 16;
    u32x4 pw[4], pq[4], pk[4], pqk[2];
#pragma unroll
    for (int i = 0; i < 4; ++i) { pw[i] = *(const u32x4*)(Wp + g256 + i * 2048); pq[i] = *(const u32x4*)(Qd + g256 + i * 2048); pk[i] = *(const u32x4*)(Kt + g128 + i * 2048); }
#pragma unroll
    for (int i = 0; i < 2; ++i) pqk[i] = *(const u32x4*)(QK + g128 + i * 2048);
#pragma unroll
    for (int i = 0; i < 4; ++i) { *(u32x4*)(smem + l256 + i * 4352) = pw[i]; *(u32x4*)(smem + 17408 + l256 + i * 4352) = pq[i]; *(u32x4*)(smem + 34816 + l128 + i * 4608) = pk[i]; }
#pragma unroll
    for (int i = 0; i < 2; ++i) *(u32x4*)(smem + 53248 + l128 + i * 4608) = pqk[i];
#pragma unroll
    for (int i = 0; i < 4; ++i) { pw[i] = *(const u32x4*)(Wp + 8192 + g256 + i * 2048); pq[i] = *(const u32x4*)(Qd + 8192 + g256 + i * 2048); pk[i] = *(const u32x4*)(Kt + 8192 + g128 + i * 2048); }
#pragma unroll
    for (int i = 0; i < 2; ++i) pqk[i] = *(const u32x4*)(QK + 4096 + g128 + i * 2048);
    __syncthreads();
#pragma unroll 1
    for (int n = 0; n < 256; ++n) {
      char* nb = smem + ((n + 1) & 1) * OPB;
      if (n + 1 < 256) {
#pragma unroll
        for (int i = 0; i < 4; ++i) { *(u32x4*)(nb + l256 + i * 4352) = pw[i]; *(u32x4*)(nb + 17408 + l256 + i * 4352) = pq[i]; *(u32x4*)(nb + 34816 + l128 + i * 4608) = pk[i]; }
#pragma unroll
        for (int i = 0; i < 2; ++i) *(u32x4*)(nb + 53248 + l128 + i * 4608) = pqk[i];
      }
      if (n + 2 < 256) { const size_t o8 = (size_t)(n + 2) * 8192, o4 = (size_t)(n + 2) * 4096;
#pragma unroll
        for (int i = 0; i < 4; ++i) { pw[i] = *(const u32x4*)(Wp + o8 + g256 + i * 2048); pq[i] = *(const u32x4*)(Qd + o8 + g256 + i * 2048); pk[i] = *(const u32x4*)(Kt + o8 + g128 + i * 2048); }
#pragma unroll
        for (int i = 0; i < 2; ++i) pqk[i] = *(const u32x4*)(QK + o4 + g128 + i * 2048); }
      __syncthreads();
    }
  } else {
    const int dvc = 64 * half + 16 * w + l15; const float nw = P.gdn_norm[l * 128 + dvc];
    const int uoff = dvc * 64 + 4 * q4;
    f32x4 St[8];
#pragma unroll
    for (int t = 0; t < 8; ++t) St[t] = (f32x4){0.f, 0.f, 0.f, 0.f};
    u32x2 uc[4], un[4], zc[4], zn[4]; float gcur, gn = 0.f;
#pragma unroll
    for (int it = 0; it < 4; ++it) { uc[it] = *(const u32x2*)(Ut + uoff + 16 * it); zc[it] = *(const u32x2*)(Zt + uoff + 16 * it); un[it] = uc[it]; zn[it] = zc[it]; }
    gcur = gt[0];
    __syncthreads();
#pragma unroll 2
    for (int n = 0; n < 256; ++n) {
      const char* cb = smem + (n & 1) * OPB;
      const char* sWp = cb; const char* sQd = cb + 17408; const char* sKt = cb + 34816; const char* sQK = cb + 53248;
      if (n + 1 < 256) { const size_t o8 = (size_t)(n + 1) * 8192;
#pragma unroll
        for (int it = 0; it < 4; ++it) { un[it] = *(const u32x2*)(Ut + o8 + uoff + 16 * it); zn[it] = *(const u32x2*)(Zt + o8 + uoff + 16 * it); }
        gn = gt[n + 1]; }
      bf16x8 sb[4];
#pragma unroll
      for (int ks = 0; ks < 4; ++ks) sb[ks] = pack_tiles(St[2 * ks], St[2 * ks + 1]);
      f32x4 wsv[4], qs[4];
#pragma unroll
      for (int it = 0; it < 4; ++it) { wsv[it] = (f32x4){0.f, 0.f, 0.f, 0.f}; qs[it] = (f32x4){0.f, 0.f, 0.f, 0.f}; }
#pragma unroll
      for (int it = 0; it < 4; ++it)
#pragma unroll
        for (int ks = 0; ks < 4; ++ks) { const int o = (16 * it + l15) * 272 + 64 * ks + 16 * q4;
          const bf16x8 a = *(const bf16x8*)(sWp + o), a2 = *(const bf16x8*)(sQd + o);
          wsv[it] = MFMA16(a, sb[ks], wsv[it]); qs[it] = MFMA16(a2, sb[ks], qs[it]); }
      f32x4 vn[4];
#pragma unroll
      for (int it = 0; it < 4; ++it) { const f32x4 uf = {bflo(uc[it].x), bfhi(uc[it].x), bflo(uc[it].y), bfhi(uc[it].y)}; vn[it] = uf - wsv[it]; }
      bf16x8 vb[2];
#pragma unroll
      for (int ks = 0; ks < 2; ++ks) vb[ks] = pack_tiles(vn[2 * ks], vn[2 * ks + 1]);
#pragma unroll
      for (int it = 0; it < 4; ++it)
#pragma unroll
        for (int ks = 0; ks < 2; ++ks) { const bf16x8 a = *(const bf16x8*)(sQK + (16 * it + l15) * 144 + 64 * ks + 16 * q4); qs[it] = MFMA16(a, vb[ks], qs[it]); }
#pragma unroll
      for (int t = 0; t < 8; ++t) { St[t] *= gcur;
#pragma unroll
        for (int ks = 0; ks < 2; ++ks) { const bf16x8 a = *(const bf16x8*)(sKt + (16 * t + l15) * 144 + 64 * ks + 16 * q4); St[t] = MFMA16(a, vb[ks], St[t]); } }
      float* sp = sPart + (n & 1) * 256;
#pragma unroll
      for (int it = 0; it < 4; ++it) {
        f32x4 ss = qs[it] * qs[it];
        ss.x = row16_sum(ss.x); ss.y = row16_sum(ss.y); ss.z = row16_sum(ss.z); ss.w = row16_sum(ss.w);
        if (l15 == 0) *(f32x4*)(sp + w * 64 + 16 * it + 4 * q4) = ss;
      }
      __syncthreads();
      if (w == 0) ssqp[(size_t)(64 * n + lane) * 8 + hh] = (sp[lane] + sp[64 + lane]) + (sp[128 + lane] + sp[192 + lane]);
#pragma unroll
      for (int it = 0; it < 4; ++it) {
        const float z0 = bflo(zc[it].x), z1 = bfhi(zc[it].x), z2 = bflo(zc[it].y), z3 = bfhi(zc[it].y);
        bf16_t* op = mixin + (size_t)(64 * n + 16 * it + 4 * q4) * 2048 + hh * 128 + dvc;
        op[0] = f2bf(qs[it].x * nw * z0); op[2048] = f2bf(qs[it].y * nw * z1);
        op[4096] = f2bf(qs[it].z * nw * z2); op[6144] = f2bf(qs[it].w * nw * z3);
      }
#pragma unroll
      for (int it = 0; it < 4; ++it) { uc[it] = un[it]; zc[it] = zn[it]; }
      gcur = gn;
    }
  }
  __syncthreads();
}
DI void gdn_fix_phase(const Params& P) {
  const int tid = opaque_tid();
  bf16_t* mixin = (bf16_t*)(P.ws + OFF_H); const float* ssqp = (const float*)(P.ws + OFF_SSQP);
  for (int idx = blockIdx.x * NT + tid; idx < S_ * 128; idx += gridDim.x * NT) {
    const int t = idx >> 7, ck = idx & 127, h = ck >> 4;
    const float r = rsqrtf((ssqp[(size_t)t * 8 + h] + ssqp[(size_t)S_ * 8 + (size_t)t * 8 + h]) * (1.f / 128.f) + EPS);
    u32x4* p = (u32x4*)(mixin + (size_t)t * 2048 + ck * 8); const u32x4 v = *p; float f[8]; unpack8(v, f);
    u32x4 o = {pack2(f[0] * r, f[1] * r), pack2(f[2] * r, f[3] * r), pack2(f[4] * r, f[5] * r), pack2(f[6] * r, f[7] * r)}; *p = o;
  }
}

DI void mla_attn_item(const Params& P, int hd, int b, char* smem) {
  const int tid = opaque_tid(), lane = tid & 63, w = tid >> 6, wq = w & 3, hk = w >> 2, lq = lane & 31, h = lane >> 5;
  const float* qraw = (const float*)(P.ws + OFF_QRAW);
  const bf16_t* Kg = (const bf16_t*)(P.ws + OFF_KMLA) + (size_t)hd * S_ * 192;
  const bf16_t* Vg = (const bf16_t*)(P.ws + OFF_VT) + (size_t)hd * 128 * S_;
  bf16_t* mixin = (bf16_t*)(P.ws + OFF_H);
  const int q = 128 * b + 32 * wq + lq;
  bf16x8 qf[12];
  {
    const float* qp = qraw + (size_t)q * 768 + hd * 192 + 8 * h;
    const float sc = 0.07216878364870322f * LOG2E;
#pragma unroll
    for (int s = 0; s < 8; ++s) { const f32x4 a = *(const f32x4*)(qp + 16 * s), c = *(const f32x4*)(qp + 16 * s + 4);
      qf[s] = pack8(a.x * sc, a.y * sc, a.z * sc, a.w * sc, c.x * sc, c.y * sc, c.z * sc, c.w * sc); }
    const double pq = (double)P.pos[q];
#pragma unroll
    for (int s2 = 0; s2 < 2; ++s2) {
      const f32x4 a0 = *(const f32x4*)(qp + 128 + 16 * s2), a1 = *(const f32x4*)(qp + 128 + 16 * s2 + 4);
      const f32x4 b0 = *(const f32x4*)(qp + 160 + 16 * s2), b1 = *(const f32x4*)(qp + 160 + 16 * s2 + 4);
      float x1[8] = {a0.x, a0.y, a0.z, a0.w, a1.x, a1.y, a1.z, a1.w}, x2[8] = {b0.x, b0.y, b0.z, b0.w, b1.x, b1.y, b1.z, b1.w}, o1[8], o2[8];
#pragma unroll
      for (int j = 0; j < 8; ++j) { double fr = pq * kInvFreq2Pi[16 * s2 + 8 * h + j]; fr -= floor(fr); const float ff = (float)fr;
        const float sn = __builtin_amdgcn_sinf(ff), cs = __builtin_amdgcn_cosf(ff);
        o1[j] = (x1[j] * cs - x2[j] * sn) * sc; o2[j] = (x2[j] * cs + x1[j] * sn) * sc; }
      qf[8 + s2] = pack8(o1[0], o1[1], o1[2], o1[3], o1[4], o1[5], o1[6], o1[7]);
      qf[10 + s2] = pack8(o2[0], o2[1], o2[2], o2[3], o2[4], o2[5], o2[6], o2[7]);
    }
  }
  constexpr int KST = 64 * 400, VST = 128 * 144, STG = KST + VST;
  f32x16 O[4];
#pragma unroll
  for (int i = 0; i < 4; ++i)
#pragma unroll
    for (int r = 0; r < 16; ++r) O[i][r] = 0.f;
  float m_i = -1e30f, l_i = 0.f;
  const int nt = 2 * b + 2;
  u32x4 rk[3], rv[2];
  const int vrow = tid >> 3, vcc = tid & 7;
#pragma unroll
  for (int i = 0; i < 3; ++i) { const int id = tid + NT * i, row = id / 24, cc = id % 24; rk[i] = *(const u32x4*)(Kg + row * 192 + cc * 8); }
#pragma unroll
  for (int i = 0; i < 2; ++i) rv[i] = *(const u32x4*)(Vg + (size_t)(vrow + 64 * i) * S_ + vcc * 8);
#pragma unroll
  for (int i = 0; i < 3; ++i) { const int id = tid + NT * i, row = id / 24, cc = id % 24; *(u32x4*)(smem + row * 400 + cc * 16) = rk[i]; }
#pragma unroll
  for (int i = 0; i < 2; ++i) *(u32x4*)(smem + KST + (vrow + 64 * i) * 144 + vcc * 16) = rv[i];
  __syncthreads();
  for (int kt = 0; kt < nt; ++kt) {
    const char* sK = smem + (kt & 1) * STG; const char* sV = sK + KST;
    const bool more = (kt + 1 < nt);
    if (more) { const size_t ko = (size_t)(kt + 1) * 64 * 192; const int vo = (kt + 1) * 64;
#pragma unroll
      for (int i = 0; i < 3; ++i) { const int id = tid + NT * i, row = id / 24, cc = id % 24; rk[i] = *(const u32x4*)(Kg + ko + row * 192 + cc * 8); }
#pragma unroll
      for (int i = 0; i < 2; ++i) rv[i] = *(const u32x4*)(Vg + (size_t)(vrow + 64 * i) * S_ + vo + vcc * 8); }
    const int key0 = 64 * kt + 32 * hk;
    if (key0 <= 128 * b + 32 * wq) {
      f32x16 st;
#pragma unroll
      for (int r = 0; r < 16; ++r) st[r] = 0.f;
#pragma unroll
      for (int s = 0; s < 12; ++s) { const bf16x8 kf = *(const bf16x8*)(sK + (32 * hk + lq) * 400 + (2 * s + h) * 16); st = MFMA32(kf, qf[s], st); }
      if (key0 + 31 > 128 * b + 32 * wq) {
        int qrel = q - key0 - 4 * h; asm volatile("" : "+v"(qrel));
#pragma unroll
        for (int r = 0; r < 16; ++r) if ((r & 3) + 8 * (r >> 2) > qrel) st[r] = -1e30f;
      }
      float mx = st[0];
#pragma unroll
      for (int r = 1; r < 16; ++r) mx = fmaxf(mx, st[r]);
      mx = fmaxf(mx, __shfl_xor(mx, 32));
      const float m_new = fmaxf(m_i, mx), alpha = exp2f(m_i - m_new);
      float ps = 0.f;
#pragma unroll
      for (int r = 0; r < 16; ++r) { st[r] = exp2f(st[r] - m_new); ps += st[r]; }
      l_i = l_i * alpha + ps; m_i = m_new;
#pragma unroll
      for (int i = 0; i < 4; ++i)
#pragma unroll
        for (int r = 0; r < 16; ++r) O[i][r] *= alpha;
      bf16x8 pf[2];
#pragma unroll
      for (int s = 0; s < 2; ++s) pf[s] = pack8(st[8 * s], st[8 * s + 1], st[8 * s + 2], st[8 * s + 3], st[8 * s + 4], st[8 * s + 5], st[8 * s + 6], st[8 * s + 7]);
#pragma unroll
      for (int i = 0; i < 4; ++i)
#pragma unroll
        for (int s = 0; s < 2; ++s) { const char* vp = sV + (32 * i + lq) * 144 + (32 * hk + 16 * s + 4 * h) * 2;
          const u32x2 lo = *(const u32x2*)vp, hi = *(const u32x2*)(vp + 16); u32x4 vv = {lo.x, lo.y, hi.x, hi.y};
          O[i] = MFMA32(__builtin_bit_cast(bf16x8, vv), pf[s], O[i]); }
    }
    if (more) { char* dK = smem + ((kt + 1) & 1) * STG;
#pragma unroll
      for (int i = 0; i < 3; ++i) { const int id = tid + NT * i, row = id / 24, cc = id % 24; *(u32x4*)(dK + row * 400 + cc * 16) = rk[i]; }
#pragma unroll
      for (int i = 0; i < 2; ++i) *(u32x4*)(dK + KST + (vrow + 64 * i) * 144 + vcc * 16) = rv[i]; }
    __syncthreads();
  }
  float* cO = (float*)smem; float* cm = cO + 4 * 4096; float* cl = cm + 256;
  if (hk == 1) {
#pragma unroll
    for (int i = 0; i < 4; ++i)
#pragma unroll
      for (int r = 0; r < 16; ++r) cO[wq * 4096 + (i * 16 + r) * 64 + lane] = O[i][r];
    cm[wq * 64 + lane] = m_i; cl[wq * 64 + lane] = l_i;
  }
  __syncthreads();
  if (hk == 0) {
    const float m1 = cm[wq * 64 + lane], l1 = cl[wq * 64 + lane];
    const float m = fmaxf(m_i, m1), a0 = exp2f(m_i - m), a1 = exp2f(m1 - m);
    float lt = l_i * a0 + l1 * a1; lt += __shfl_xor(lt, 32);
    const float inv = 1.f / lt;
    bf16_t* op = mixin + (size_t)q * 2048 + 1024 + hd * 128;
#pragma unroll
    for (int i = 0; i < 4; ++i)
#pragma unroll
      for (int rg = 0; rg < 4; ++rg) { float v[4];
#pragma unroll
        for (int e = 0; e < 4; ++e) v[e] = (O[i][4 * rg + e] * a0 + cO[wq * 4096 + (i * 16 + 4 * rg + e) * 64 + lane] * a1) * inv;
        u32x2 pk = {pack2(v[0], v[1]), pack2(v[2], v[3])}; *(u32x2*)(op + 32 * i + 8 * rg + 4 * h) = pk; }
  }
  __syncthreads();
}

DI void swa_item(const Params& P, int l, int n, int hk2, char* smem) {
  const int tid = opaque_tid(), lane = tid & 63, w = tid >> 6, lq = lane & 31, h = lane >> 5;
  const bf16_t* proj = (const bf16_t*)(P.ws + OFF_PROJ); bf16_t* mixin = (bf16_t*)(P.ws + OFF_H);
  bf16_t* sVt = (bf16_t*)smem;
#pragma unroll
  for (int i = 0; i < 4; ++i) { const int id = tid + NT * i, key = id >> 3, dc = id & 7; const int kp = 128 * (n - 1) + key;
    u32x4 v = {0u, 0u, 0u, 0u}; if (kp >= 0) v = *(const u32x4*)(proj + (size_t)kp * DINP + C_CV + hk2 * 64 + dc * 8);
    sVt[(8 * dc + 0) * 264 + key] = (bf16_t)(v.x & 0xffff); sVt[(8 * dc + 1) * 264 + key] = (bf16_t)(v.x >> 16);
    sVt[(8 * dc + 2) * 264 + key] = (bf16_t)(v.y & 0xffff); sVt[(8 * dc + 3) * 264 + key] = (bf16_t)(v.y >> 16);
    sVt[(8 * dc + 4) * 264 + key] = (bf16_t)(v.z & 0xffff); sVt[(8 * dc + 5) * 264 + key] = (bf16_t)(v.z >> 16);
    sVt[(8 * dc + 6) * 264 + key] = (bf16_t)(v.w & 0xffff); sVt[(8 * dc + 7) * 264 + key] = (bf16_t)(v.w >> 16); }
  __syncthreads();
  const int g = w >> 1, hq = hk2 * 4 + g;
  const float slope = exp2f(-(float)(hq + 1)) * LOG2E, sinkv = P.swa_sinks[l * 8 + hq] * LOG2E;
#pragma unroll 1
  for (int jj = 0; jj < 2; ++jj) {
    const int j = 2 * (w & 1) + jj; const int qrow = 128 * n + 32 * j + lq;
    bf16x8 qf[4];
#pragma unroll
    for (int s = 0; s < 4; ++s) qf[s] = *(const bf16x8*)(proj + (size_t)qrow * DINP + C_CQ + hq * 64 + 16 * s + 8 * h);
    f32x16 st[5];
    bf16x8 kf[2][4];
    { const int kp = 128 * (n - 1) + 32 * j + lq;
#pragma unroll
      for (int s = 0; s < 4; ++s) { kf[0][s] = (bf16x8){0, 0, 0, 0, 0, 0, 0, 0}; if (kp >= 0) kf[0][s] = *(const bf16x8*)(proj + (size_t)kp * DINP + C_CK + hk2 * 64 + 16 * s + 8 * h); } }
#pragma unroll
    for (int tt = 0; tt < 5; ++tt) {
      if (tt + 1 < 5) { const int kp = 128 * (n - 1) + 32 * (j + tt + 1) + lq;
#pragma unroll
        for (int s = 0; s < 4; ++s) { kf[(tt + 1) & 1][s] = (bf16x8){0, 0, 0, 0, 0, 0, 0, 0}; if (kp >= 0) kf[(tt + 1) & 1][s] = *(const bf16x8*)(proj + (size_t)kp * DINP + C_CK + hk2 * 64 + 16 * s + 8 * h); } }
      __builtin_amdgcn_sched_barrier(0);
#pragma unroll
      for (int r = 0; r < 16; ++r) st[tt][r] = 0.f;
#pragma unroll
      for (int s = 0; s < 4; ++s) st[tt] = MFMA32(kf[tt & 1][s], qf[s], st[tt]);
      __builtin_amdgcn_sched_barrier(0);
    }
    float mx = sinkv;
    int dbase = 128 + lq - 4 * h, kbase = 128 * (n - 1) + 32 * j + 4 * h;
    asm volatile("" : "+v"(dbase), "+v"(kbase));
#pragma unroll
    for (int tt = 0; tt < 5; ++tt)
#pragma unroll
      for (int r = 0; r < 16; ++r) { const int cst = 32 * tt + (r & 3) + 8 * (r >> 2); const int dist = dbase - cst; const int kpos = kbase + cst;
        const bool valid = (dist >= 0) && (dist < 128) && (kpos >= 0);
        const float sv = valid ? st[tt][r] * (0.125f * LOG2E) - slope * (float)dist : -1e30f; st[tt][r] = sv; mx = fmaxf(mx, sv); }
    mx = fmaxf(mx, __shfl_xor(mx, 32));
    float den = 0.f;
#pragma unroll
    for (int tt = 0; tt < 5; ++tt)
#pragma unroll
      for (int r = 0; r < 16; ++r) { const float p = exp2f(st[tt][r] - mx); st[tt][r] = p; den += p; }
    den += __shfl_xor(den, 32); den += exp2f(sinkv - mx);
    f32x16 O[2];
#pragma unroll
    for (int i = 0; i < 2; ++i)
#pragma unroll
      for (int r = 0; r < 16; ++r) O[i][r] = 0.f;
#pragma unroll
    for (int tt = 0; tt < 5; ++tt)
#pragma unroll
      for (int s = 0; s < 2; ++s) { const bf16x8 pf = pack8(st[tt][8 * s], st[tt][8 * s + 1], st[tt][8 * s + 2], st[tt][8 * s + 3], st[tt][8 * s + 4], st[tt][8 * s + 5], st[tt][8 * s + 6], st[tt][8 * s + 7]);
#pragma unroll
        for (int i = 0; i < 2; ++i) { const char* vp = (const char*)sVt + (32 * i + lq) * 528 + (32 * (j + tt) + 16 * s + 4 * h) * 2;
          const u32x2 lo = *(const u32x2*)vp, hi = *(const u32x2*)(vp + 16); u32x4 vv = {lo.x, lo.y, hi.x, hi.y};
          O[i] = MFMA32(__builtin_bit_cast(bf16x8, vv), pf, O[i]); }
        __builtin_amdgcn_sched_barrier(0); }
    const float inv = 1.f / den;
    bf16_t* op = mixin + (size_t)qrow * 2048 + 1536 + hq * 64;
#pragma unroll
    for (int i = 0; i < 2; ++i)
#pragma unroll
      for (int rg = 0; rg < 4; ++rg) { u32x2 pk = {pack2(O[i][4 * rg] * inv, O[i][4 * rg + 1] * inv), pack2(O[i][4 * rg + 2] * inv, O[i][4 * rg + 3] * inv)};
        *(u32x2*)(op + 32 * i + 8 * rg + 4 * h) = pk; }
  }
  __syncthreads();
}

DI float gelu_tanh(float x) { const float y = 0.7978845608028654f * (x + 0.044715f * x * x * x); const float t = 1.f - 2.f / (1.f + __expf(2.f * y)); return 0.5f * x * (1.f + t); }
DI void ffn_act_phase(const Params& P, int l) {
  const int tid = opaque_tid(), lane = tid & 63, w = tid >> 6;
  const bf16_t* u = (const bf16_t*)(P.ws + OFF_BIG); bf16_t* act = (bf16_t*)(P.ws + OFF_ACT);
  const float* cw = P.ffn_conv + (size_t)l * 3 * DFF2; const float* cb = P.ffn_conv_b + (size_t)l * DFF2;
  for (int item = blockIdx.x * 8 + w; item < 512 * 11; item += gridDim.x * 8) {
    const int cbk = item % 11, rr = item / 11; const int ch = cbk * 512 + lane * 8, r0 = rr * 32;
    float wg[3][8], wu[3][8], bg[8], bu[8];
#pragma unroll
    for (int j = 0; j < 3; ++j)
#pragma unroll
      for (int e4 = 0; e4 < 2; ++e4) { const f32x4 a = *(const f32x4*)(cw + (size_t)j * DFF2 + ch + 4 * e4), b = *(const f32x4*)(cw + (size_t)j * DFF2 + DFF + ch + 4 * e4);
        wg[j][4 * e4] = a.x; wg[j][4 * e4 + 1] = a.y; wg[j][4 * e4 + 2] = a.z; wg[j][4 * e4 + 3] = a.w; wu[j][4 * e4] = b.x; wu[j][4 * e4 + 1] = b.y; wu[j][4 * e4 + 2] = b.z; wu[j][4 * e4 + 3] = b.w; }
#pragma unroll
    for (int e4 = 0; e4 < 2; ++e4) { const f32x4 a = *(const f32x4*)(cb + ch + 4 * e4), b = *(const f32x4*)(cb + DFF + ch + 4 * e4);
      bg[4 * e4] = a.x; bg[4 * e4 + 1] = a.y; bg[4 * e4 + 2] = a.z; bg[4 * e4 + 3] = a.w; bu[4 * e4] = b.x; bu[4 * e4 + 1] = b.y; bu[4 * e4 + 2] = b.z; bu[4 * e4 + 3] = b.w; }
    float g2[8], g1[8], u2[8], u1[8];
#pragma unroll
    for (int e = 0; e < 8; ++e) { g2[e] = 0.f; g1[e] = 0.f; u2[e] = 0.f; u1[e] = 0.f; }
    if (r0 >= 2) { unpack8(*(const u32x4*)(u + (size_t)(r0 - 2) * DFF2 + ch), g2); unpack8(*(const u32x4*)(u + (size_t)(r0 - 2) * DFF2 + DFF + ch), u2);
      unpack8(*(const u32x4*)(u + (size_t)(r0 - 1) * DFF2 + ch), g1); unpack8(*(const u32x4*)(u + (size_t)(r0 - 1) * DFF2 + DFF + ch), u1); }
#pragma unroll 1
    for (int rb = 0; rb < 4; ++rb) {
      u32x4 G[8], U[8];
#pragma unroll
      for (int i = 0; i < 8; ++i) { const size_t ro = (size_t)(r0 + rb * 8 + i) * DFF2 + ch; G[i] = *(const u32x4*)(u + ro); U[i] = *(const u32x4*)(u + ro + DFF); }
#pragma unroll
      for (int i = 0; i < 8; ++i) {
        float g0[8], u0[8]; unpack8(G[i], g0); unpack8(U[i], u0);
        float o[8];
#pragma unroll
        for (int e = 0; e < 8; ++e) { const float yg = wg[0][e] * g2[e] + wg[1][e] * g1[e] + wg[2][e] * g0[e] + bg[e]; const float yu = wu[0][e] * u2[e] + wu[1][e] * u1[e] + wu[2][e] * u0[e] + bu[e];
          o[e] = gelu_tanh(yg) * yu; g2[e] = g1[e]; g1[e] = g0[e]; u2[e] = u1[e]; u1[e] = u0[e]; }
        u32x4 pk = {pack2(o[0], o[1]), pack2(o[2], o[3]), pack2(o[4], o[5]), pack2(o[6], o[7])};
        *(u32x4*)(act + (size_t)(r0 + rb * 8 + i) * DFF + ch) = pk;
      }
    }
  }
}

#define XB_TMO      128
#define XB_XCNT(j)  (256  + 64 * (j))
#define XB_XSUB(j)  (1280 + 64 * (j))
#define XB_XGEN(j)  (2304 + 64 * (j))
#define XB_TOP      3328
#define XB_TOPGEN   3392
#define XCD_BAR_WORDS 3456
#define XB_SPIN_CAP (1u << 18)
#define LAS __attribute__((address_space(3)))
DI unsigned xb_ld(unsigned* p)              { return __hip_atomic_load(p, __ATOMIC_RELAXED, __HIP_MEMORY_SCOPE_AGENT); }
DI unsigned xb_add(unsigned* p, unsigned v) { return __hip_atomic_fetch_add(p, v, __ATOMIC_RELAXED, __HIP_MEMORY_SCOPE_AGENT); }
DI unsigned xb_xcc_id() { return (unsigned)__builtin_amdgcn_s_getreg((3 << 11) | 20) & 0xFu; }
#define XB_SPIN(cond, bar) do { unsigned _sp = 0; while (cond) { __builtin_amdgcn_s_sleep(1); \
    if ((++_sp & 255u) == 0u) { if (xb_ld(&(bar)[XB_TMO])) break; if (_sp > XB_SPIN_CAP) { atomicAdd(&(bar)[XB_TMO], 1u); break; } } } } while (0)
struct XcdBarrier { unsigned* bar; unsigned x; volatile LAS unsigned* st; };
DI XcdBarrier xcd_barrier_post(unsigned* bar, volatile LAS unsigned* st) {
  XcdBarrier b; b.bar = bar; b.x = xb_xcc_id(); b.st = st;
  if (threadIdx.x == 0) (void)xb_add(&bar[XB_XCNT(b.x)], 1u);
  return b;
}
DI void xcd_barrier_complete(unsigned* bar, unsigned x, unsigned& nloc, unsigned& nx) {
  const unsigned G = gridDim.x * gridDim.y * gridDim.z;
  unsigned sum, cnt, mine, sp = 0u;
  for (;;) {
    sum = 0u; cnt = 0u; mine = 0u;
#pragma unroll
    for (unsigned j = 0; j < 16; ++j) { const unsigned c = xb_ld(&bar[XB_XCNT(j)]); sum += c; cnt += (c > 0u) ? 1u : 0u; mine = (j == x) ? c : mine; }
    if (sum == G) break;
    __builtin_amdgcn_s_sleep(1);
    if ((++sp & 255u) == 0u) { if (xb_ld(&bar[XB_TMO])) break; if (sp > XB_SPIN_CAP) { atomicAdd(&bar[XB_TMO], 1u); break; } }
  }
  nloc = mine > 0u ? mine : 1u; nx = cnt > 0u ? cnt : 1u;
}
DI void xcd_barrier(char* ws_, char* smem_) {
  XcdBarrier b; b.bar = (unsigned*)(ws_ + OFF_XBAR); b.x = xb_xcc_id(); b.st = (volatile LAS unsigned*)(smem_ + 132112);
  asm volatile("s_waitcnt vmcnt(0)" ::: "memory");
  __syncthreads();
  if (threadIdx.x == 0) {
    unsigned* bar = b.bar;
    __builtin_amdgcn_s_waitcnt(0);
    unsigned nloc = b.st[0], nx = b.st[1];
    if (nloc == 0u) { xcd_barrier_complete(bar, b.x, nloc, nx); b.st[0] = nloc; b.st[1] = nx; }
    const unsigned old = xb_add(&bar[XB_XSUB(b.x)], 1u);
    const unsigned gen = old / nloc;
    if (old + 1u == (gen + 1u) * nloc) {
      __builtin_amdgcn_fence(__ATOMIC_RELEASE, "agent");
      asm volatile("s_waitcnt vmcnt(0)" ::: "memory");
      const unsigned og = xb_add(&bar[XB_TOP], 1u);
      const unsigned tg = og / nx;
      if (og + 1u == (tg + 1u) * nx) xb_add(&bar[XB_TOPGEN], 1u);
      else XB_SPIN(xb_ld(&bar[XB_TOPGEN]) == tg, bar);
      __builtin_amdgcn_fence(__ATOMIC_ACQUIRE, "agent");
      xb_add(&bar[XB_XGEN(b.x)], 1u);
      asm volatile("s_waitcnt vmcnt(0)" ::: "memory");
    } else {
      XB_SPIN(xb_ld(&bar[XB_XGEN(b.x)]) == gen, bar);
      __builtin_amdgcn_fence(__ATOMIC_ACQUIRE, "agent");
      asm volatile("s_waitcnt vmcnt(0)" ::: "memory");
    }
  }
  __syncthreads();
}

__global__ void __launch_bounds__(NT) fwd_megakernel(Params P0) {
  cg::grid_group grid = cg::this_grid();
  __shared__ __attribute__((aligned(16))) char smem[132352];
  const int tid = threadIdx.x;
  char* ws = P0.ws;
  int* ctrl = (int*)(ws + OFF_CTRL);
  if (blockIdx.x == 0 && tid < 64) ctrl[tid] = 0;
  if (blockIdx.x == 0) for (int i = tid; i < XCD_BAR_WORDS; i += NT) ((unsigned*)(ws + OFF_XBAR))[i] = 0u;
  if (tid < 4) ((unsigned*)(smem + 132112))[tid] = 0u;
  if (blockIdx.x == 0 && tid == 0) *(Params*)(ws + OFF_CTRL + 1024) = P0;
  bf16_t* Hb = (bf16_t*)(ws + OFF_H);
  for (int it = blockIdx.x; it < 192 + CV_T5; it += gridDim.x) { if (it < 192) mod_item(P0, it); else convert_item(P0, 0, it - 192, smem); }
  grid.sync();
  (void)xcd_barrier_post((unsigned*)(ws + OFF_XBAR), (volatile LAS unsigned*)(smem + 132112));
  const Params& P = *(const Params*)(ws + OFF_CTRL + 1024);
  rownorm_phase(P, P.x, nullptr, P.out, Hb, 0, 0, nullptr, 0, 1, 0, P.mix_pre, smem);
  xcd_barrier(ws, smem);
  for (int l = 0; l < 2; ++l) {
    { EpiProj epi{(bf16_t*)(ws + OFF_PROJ), (float*)(ws + OFF_AB)}; gemm_phase(Hb, 2048, (const bf16_t*)(ws + OFF_W + W_IN), 2048, 2048, 64, 22, smem, epi); }
    xcd_barrier(ws, smem);
    for (int it = blockIdx.x; it < 448; it += gridDim.x) {
      if (it < 192) mla_q_tile(P, it / 3, it % 3, smem);
      else mla_kv_tile(P, (it - 192) >> 2, (it - 192) & 3, smem);
    }
    for (int id = (blockIdx.x + 64) % gridDim.x; id < 2048; id += gridDim.x) gdn_prep_item(P, l, id >> 3, id & 7, smem);
    xcd_barrier(ws, smem);
    {
      int* sitem = (int*)(smem + 132096);
      for (;;) {
        if (tid == 0) *sitem = atomicAdd(ctrl + 16 * l, 1);
        __syncthreads(); const int item = *sitem; __syncthreads();
        if (item >= 16 + 512 + 256) break;
        if (item < 16) gdn_scan_item(P, l, item >> 1, item & 1, smem);
        else if (item < 528) { const int idx = item - 16; mla_attn_item(P, idx & 3, 127 - (idx >> 2), smem); }
        else { const int idx = item - 528; swa_item(P, l, idx >> 1, idx & 1, smem); }
      }
    }
    xcd_barrier(ws, smem);
    gdn_fix_phase(P);
    xcd_barrier(ws, smem);
    { EpiBf epi{(bf16_t*)(ws + OFF_MIXF), 2048}; gemm_phase(Hb, 2048, (const bf16_t*)(ws + OFF_W + W_OUT), 2048, 2048, 64, 8, smem, epi); }
    xcd_barrier(ws, smem);
    rownorm_phase(P, P.out, (const bf16_t*)(ws + OFF_MIXF), P.out, Hb, l, 2, P.mix_post + l * 2048, l, 4, 3, P.ffn_pre + l * 2048, smem);
    xcd_barrier(ws, smem);
    { EpiBf epi{(bf16_t*)(ws + OFF_BIG), DFF2}; gemm_phase(Hb, 2048, (const bf16_t*)(ws + OFF_W + W_UP), 2048, 2048, 64, 44, smem, epi); }
    xcd_barrier(ws, smem);
    ffn_act_phase(P, l);
    xcd_barrier(ws, smem);
    { EpiBf epi{(bf16_t*)(ws + OFF_Y), 2048}; gemm_phase((const bf16_t*)(ws + OFF_ACT), DFF, (const bf16_t*)(ws + OFF_W + W_DOWN), DFF, DFF, 64, 8, smem, epi); }
    xcd_barrier(ws, smem);
    if (l == 0) {
      for (int it = blockIdx.x; it < CV_T5; it += gridDim.x) convert_item(P, 1, it, smem);
      rownorm_phase(P, P.out, (const bf16_t*)(ws + OFF_Y), P.out, Hb, 0, 5, P.ffn_post, 1, 1, 0, P.mix_pre + 2048, smem);
      xcd_barrier(ws, smem);
    } else {
      rownorm_phase(P, P.out, (const bf16_t*)(ws + OFF_Y), P.out, nullptr, 1, 5, P.ffn_post + 2048, 1, 1, 0, nullptr, smem);
    }
  }
}

extern "C" void kernel_launch(void* const* d_in, const int* in_sizes, int n_in, void* d_out, int out_size, void* d_ws, size_t ws_size, hipStream_t stream) {
  static int grid_blocks = 0;
  if (!grid_blocks) {
    int dev = 0, cus = 0, per = 0;
    (void)hipGetDevice(&dev); (void)hipDeviceGetAttribute(&cus, hipDeviceAttributeMultiprocessorCount, dev);
    (void)hipOccupancyMaxActiveBlocksPerMultiprocessor(&per, fwd_megakernel, NT, 0);
    if (per > 1) per = 1;
    grid_blocks = cus * per; if (grid_blocks <= 0) grid_blocks = 256;
  }
  if (ws_size < OFF_END) { fprintf(stderr, "workspace too small: %zu < %zu\n", ws_size, (size_t)OFF_END); return; }
  Params p{};
  p.x = (const float*)d_in[0]; p.c = (const float*)d_in[1]; p.pos = (const int*)d_in[2];
  p.ada_w = (const float*)d_in[3]; p.ada_b = (const float*)d_in[4]; p.mix_pre = (const float*)d_in[5]; p.mix_post = (const float*)d_in[6];
  p.w_in = (const float*)d_in[7]; p.w_out = (const float*)d_in[8]; p.gdn_conv = (const float*)d_in[9]; p.gdn_a_log = (const float*)d_in[10];
  p.gdn_dt_bias = (const float*)d_in[11]; p.gdn_norm = (const float*)d_in[12]; p.mla_q_norm = (const float*)d_in[13]; p.mla_w_uq = (const float*)d_in[14];
  p.mla_kv_norm = (const float*)d_in[15]; p.mla_w_ukv = (const float*)d_in[16]; p.swa_sinks = (const float*)d_in[17]; p.ffn_pre = (const float*)d_in[18];
  p.ffn_post = (const float*)d_in[19]; p.ffn_w_up = (const float*)d_in[20]; p.ffn_conv = (const float*)d_in[21]; p.ffn_conv_b = (const float*)d_in[22];
  p.ffn_w_down = (const float*)d_in[23];
  p.out = (float*)d_out; p.ws = (char*)d_ws;
  void* args[] = {&p};
  hipError_t e = hipLaunchCooperativeKernel((void*)fwd_megakernel, dim3(grid_blocks), dim3(NT), args, 0, stream);
  if (e != hipSuccess) fprintf(stderr, "cooperative launch failed: %s (grid %d)\n", hipGetErrorString(e), grid_blocks);
}
```

```cpp
#include <hip/hip_runtime.h>
#include <hip/hip_cooperative_groups.h>
#include <cstdio>
#include <cstdint>
namespace cg = cooperative_groups;

#define DI __device__ __forceinline__
typedef unsigned short bf16_t;
typedef short bf16x8 __attribute__((ext_vector_type(8)));
typedef float f32x2 __attribute__((ext_vector_type(2)));
typedef float f32x4 __attribute__((ext_vector_type(4)));
typedef float f32x16 __attribute__((ext_vector_type(16)));
typedef unsigned u32x2 __attribute__((ext_vector_type(2)));
typedef unsigned u32x4 __attribute__((ext_vector_type(4)));
typedef __bf16 bf2_t __attribute__((ext_vector_type(2)));

constexpr int S_ = 16384, D_ = 2048, DINP = 5632, DFF = 5632, DFF2 = 11264;
constexpr int NT = 512;
constexpr float EPS = 1e-6f;
constexpr float LOG2E = 1.4426950408889634f;

constexpr size_t OFF_CTRL = 0;
constexpr size_t OFF_MODP = 4096;
constexpr size_t OFF_XBAR = OFF_MODP + (size_t)2 * 16 * 12288 * 4;
constexpr size_t OFF_W = 2097152;
static_assert(OFF_XBAR + 3456 * 4 <= OFF_W, "xbar");
constexpr size_t W_IN = 0, W_OUT = W_IN + (size_t)5632 * 2048 * 2, W_UP = W_OUT + (size_t)2048 * 2048 * 2,
                 W_DOWN = W_UP + (size_t)11264 * 2048 * 2, W_UQ = W_DOWN + (size_t)2048 * 5632 * 2,
                 W_UKV = W_UQ + (size_t)768 * 448 * 2, W_END = W_UKV + (size_t)1024 * 128 * 2;
constexpr size_t OFF_H = OFF_W + W_END;
constexpr size_t OFF_MIXF = OFF_H + (size_t)S_ * 2048 * 2;
constexpr size_t OFF_QRAW = OFF_MIXF;
constexpr size_t OFF_KMLA = OFF_QRAW + (size_t)S_ * 768 * 4;
constexpr size_t OFF_VT = OFF_KMLA + (size_t)4 * S_ * 192 * 2;
constexpr size_t OFF_BIG = OFF_MIXF + (size_t)S_ * 2048 * 4;
constexpr size_t OFF_PROJ = OFF_BIG;
constexpr size_t OFF_WP = OFF_PROJ + (size_t)S_ * DINP * 2;
constexpr size_t OFF_QD = OFF_WP + (size_t)S_ * 1024 * 2;
constexpr size_t OFF_KT = OFF_QD + (size_t)S_ * 1024 * 2;
constexpr size_t OFF_ZT = OFF_KT + (size_t)S_ * 1024 * 2;
constexpr size_t OFF_QK = OFF_ZT + (size_t)S_ * 1024 * 2;
constexpr size_t OFF_AB = OFF_QK + (size_t)S_ * 512 * 2;
constexpr size_t OFF_GTOT = OFF_AB + (size_t)S_ * 16 * 4;
constexpr size_t OFF_Y = OFF_BIG;
constexpr size_t OFF_ACT = OFF_H;
constexpr size_t OFF_UT = OFF_BIG + (size_t)S_ * DFF2 * 2;
constexpr size_t OFF_END = OFF_UT + (size_t)S_ * 1024 * 4;
static_assert(OFF_GTOT + 8192 <= OFF_UT, "overlay");
static_assert(OFF_VT + (size_t)4 * 128 * S_ * 2 <= OFF_BIG, "overlay2");

constexpr int C_AQ = 0, C_AK = 1024, C_AV = 2048, C_AZ = 3072, C_AA = 4096, C_BCQ = 4112, C_BCKV = 4560,
              C_BKR = 4688, C_CQ = 4752, C_CK = 5264, C_CV = 5392;

__constant__ double kInvFreq2Pi[32] = {
    0.15915494309189535, 0.11934937021124886, 0.08949940160889101, 0.06711508300522726, 0.050329212104487035, 0.03774158471741977,
    0.0283021958306234, 0.02122365276477766, 0.015915494309189534, 0.011934937021124886, 0.008949940160889102, 0.006711508300522725,
    0.005032921210448704, 0.003774158471741977, 0.00283021958306234, 0.0021223652764777662, 0.0015915494309189536, 0.0011934937021124885,
    0.0008949940160889102, 0.0006711508300522726, 0.0005032921210448703, 0.00037741584717419774, 0.00028302195830623395, 0.0002122365276477766,
    0.00015915494309189535, 0.00011934937021124886, 8.949940160889102e-05, 6.711508300522725e-05, 5.0329212104487035e-05, 3.774158471741978e-05,
    2.8302195830623396e-05, 2.122365276477766e-05};

struct Params {
  const float* x; const float* c; const int* pos;
  const float *ada_w, *ada_b, *mix_pre, *mix_post, *w_in, *w_out, *gdn_conv, *gdn_a_log, *gdn_dt_bias, *gdn_norm, *mla_q_norm, *mla_w_uq,
      *mla_kv_norm, *mla_w_ukv, *swa_sinks, *ffn_pre, *ffn_post, *ffn_w_up, *ffn_conv, *ffn_conv_b, *ffn_w_down;
  float* out; char* ws;
};

DI unsigned pack2(float lo, float hi) { f32x2 v = {lo, hi}; bf2_t b = __builtin_convertvector(v, bf2_t); return __builtin_bit_cast(unsigned, b); }
DI bf16_t f2bf(float x) { return (bf16_t)(pack2(x, 0.f) & 0xffffu); }
DI float bflo(unsigned u) { return __uint_as_float(u << 16); }
DI float bfhi(unsigned u) { return __uint_as_float(u & 0xffff0000u); }
DI void unpack8(const u32x4& v, float* f) { f[0] = bflo(v.x); f[1] = bfhi(v.x); f[2] = bflo(v.y); f[3] = bfhi(v.y); f[4] = bflo(v.z); f[5] = bfhi(v.z); f[6] = bflo(v.w); f[7] = bfhi(v.w); }
DI bf16x8 pack8(float a0, float a1, float a2, float a3, float a4, float a5, float a6, float a7) {
  u32x4 p = {pack2(a0, a1), pack2(a2, a3), pack2(a4, a5), pack2(a6, a7)}; return __builtin_bit_cast(bf16x8, p); }
DI float silu_f(float x) { return x / (1.f + __expf(-x)); }
DI float wave_sum(float v) { v += __shfl_xor(v, 32); v += __shfl_xor(v, 16); v += __shfl_xor(v, 8); v += __shfl_xor(v, 4); v += __shfl_xor(v, 2); v += __shfl_xor(v, 1); return v; }
DI int opaque_tid() { int t = threadIdx.x; asm volatile("" : "+v"(t)); return t; }
DI int crow(int r, int h) { return (r & 3) + 8 * (r >> 2) + 4 * h; }
DI int perm32(int k) { return 8 * ((k >> 2) & 3) + 4 * (k >> 4) + (k & 3); }
#define MFMA32(a, b, c) __builtin_amdgcn_mfma_f32_32x32x16_bf16((a), (b), (c), 0, 0, 0)
#define MFMA16(a, b, c) __builtin_amdgcn_mfma_f32_16x16x32_bf16((a), (b), (c), 0, 0, 0)

template <class Epi>
DI void gemm_tile(const bf16_t* __restrict__ A, int lda, const bf16_t* __restrict__ Bt, int ldb, int K, int m0, int n0, char* smem, const Epi& epi) {
  const int tid = opaque_tid(), lane = tid & 63, w = tid >> 6, wm = w >> 2, wn = w & 3, lq = lane & 31, h = lane >> 5;
  f32x16 acc[2][4];
#pragma unroll
  for (int i = 0; i < 2; ++i)
#pragma unroll
    for (int j = 0; j < 4; ++j)
#pragma unroll
      for (int r = 0; r < 16; ++r) acc[i][j][r] = 0.f;
  const int r0 = tid >> 3, c0 = tid & 7;
  const bf16_t* ag = A + (size_t)(m0 + r0) * lda + c0 * 8;
  const bf16_t* bg = Bt + (size_t)(n0 + r0) * ldb + c0 * 8;
  const int wofs = r0 * 128 + ((c0 ^ ((r0 >> 1) & 7)) << 4);
  char* sA = smem; char* sB = smem + 65536;
  u32x4 ra0[4], rb0[4], ra1[4], rb1[4];
  const int nk = K >> 6, swz = (lane >> 1) & 7;
  const int aoff = (64 * wn + lq) * 128, boff = (128 * wm + lq) * 128;
#define GLOAD(RA, RB, KT) { _Pragma("unroll") for (int i = 0; i < 4; ++i) { RA[i] = *(const u32x4*)(ag + (size_t)(KT) * 64 + (size_t)i * 64 * lda); RB[i] = *(const u32x4*)(bg + (size_t)(KT) * 64 + (size_t)i * 64 * ldb); } }
#define LWRITE(RA, RB, ST) { _Pragma("unroll") for (int i = 0; i < 4; ++i) { *(u32x4*)(sA + (ST) * 32768 + wofs + i * 8192) = RA[i]; *(u32x4*)(sB + (ST) * 32768 + wofs + i * 8192) = RB[i]; } }
#define KSTEP(ST, RA, RB, KN) { const char* cA = sA + (ST) * 32768; const char* cB = sB + (ST) * 32768; char* dA = sA + (1 - (ST)) * 32768; char* dB = sB + (1 - (ST)) * 32768; \
    const bf16_t* agn = ag + (size_t)(KN) * 64; const bf16_t* bgn = bg + (size_t)(KN) * 64; \
    _Pragma("unroll") for (int s = 0; s < 4; ++s) { const int co = (((2 * s + h) ^ swz) << 4); bf16x8 fa[2], fb[4]; \
      _Pragma("unroll") for (int ni = 0; ni < 2; ++ni) fa[ni] = *(const bf16x8*)(cB + aoff + ni * 4096 + co); \
      _Pragma("unroll") for (int mi = 0; mi < 4; ++mi) fb[mi] = *(const bf16x8*)(cA + boff + mi * 4096 + co); \
      *(u32x4*)(dA + wofs + s * 8192) = RA[s]; *(u32x4*)(dB + wofs + s * 8192) = RB[s]; \
      RA[s] = *(const u32x4*)(agn + (size_t)s * 64 * lda); RB[s] = *(const u32x4*)(bgn + (size_t)s * 64 * ldb); \
      _Pragma("unroll") for (int ni = 0; ni < 2; ++ni) _Pragma("unroll") for (int mi = 0; mi < 4; ++mi) acc[ni][mi] = MFMA32(fa[ni], fb[mi], acc[ni][mi]); \
      __builtin_amdgcn_sched_barrier(0); } }
  const int kl = nk - 1;
  GLOAD(ra0, rb0, 0);
  GLOAD(ra1, rb1, (1 < kl ? 1 : kl));
  LWRITE(ra0, rb0, 0);
  GLOAD(ra0, rb0, (2 < kl ? 2 : kl));
  __syncthreads();
  for (int kt = 0; kt < nk; kt += 2) {
    KSTEP(0, ra1, rb1, (kt + 3 < kl ? kt + 3 : kl));
    __syncthreads();
    if (kt + 1 < nk) {
      KSTEP(1, ra0, rb0, (kt + 4 < kl ? kt + 4 : kl));
      __syncthreads();
    }
  }
#undef GLOAD
#undef LWRITE
#undef KSTEP
#pragma unroll
  for (int ni = 0; ni < 2; ++ni)
#pragma unroll
    for (int mi = 0; mi < 4; ++mi)
#pragma unroll
      for (int rg = 0; rg < 4; ++rg) {
        const int m = m0 + 128 * wm + 32 * mi + lq, n = n0 + 64 * wn + 32 * ni + 8 * rg + 4 * h;
        epi(m, n, acc[ni][mi][4 * rg], acc[ni][mi][4 * rg + 1], acc[ni][mi][4 * rg + 2], acc[ni][mi][4 * rg + 3]);
      }
}

template <class Epi>
DI void gemm_tile_s(const bf16_t* __restrict__ A, int lda, const bf16_t* __restrict__ Bt, int ldb, int K, int m0, int n0, char* smem, const Epi& epi) {
  const int tid = opaque_tid(), lane = tid & 63, w = tid >> 6, wm = w >> 2, wn = w & 3, lq = lane & 31, h = lane >> 5;
  f32x16 acc[2][4];
#pragma unroll
  for (int i = 0; i < 2; ++i)
#pragma unroll
    for (int j = 0; j < 4; ++j)
#pragma unroll
      for (int r = 0; r < 16; ++r) acc[i][j][r] = 0.f;
  const int r0 = tid >> 3, c0 = tid & 7;
  const bf16_t* ag = A + (size_t)(m0 + r0) * lda + c0 * 8;
  const bf16_t* bg = Bt + (size_t)(n0 + r0) * ldb + c0 * 8;
  const int wofs = r0 * 128 + ((c0 ^ ((r0 >> 1) & 7)) << 4);
  char* sA = smem; char* sB = smem + 32768;
  u32x4 ra[4], rb[4];
#pragma unroll
  for (int i = 0; i < 4; ++i) { ra[i] = *(const u32x4*)(ag + (size_t)i * 64 * lda); rb[i] = *(const u32x4*)(bg + (size_t)i * 64 * ldb); }
#pragma unroll
  for (int i = 0; i < 4; ++i) { *(u32x4*)(sA + wofs + i * 8192) = ra[i]; *(u32x4*)(sB + wofs + i * 8192) = rb[i]; }
  __syncthreads();
  const int nk = K >> 6, swz = (lane >> 1) & 7;
  const int aoff = (64 * wn + lq) * 128, boff = (128 * wm + lq) * 128;
  for (int kt = 0; kt < nk; ++kt) {
    const char* cA = sA + (kt & 1) * 65536; const char* cB = sB + (kt & 1) * 65536;
    const bool more = (kt + 1 < nk);
    if (more) { ag += 64; bg += 64;
#pragma unroll
      for (int i = 0; i < 4; ++i) { ra[i] = *(const u32x4*)(ag + (size_t)i * 64 * lda); rb[i] = *(const u32x4*)(bg + (size_t)i * 64 * ldb); } }
#pragma unroll
    for (int s = 0; s < 4; ++s) {
      const int co = (((2 * s + h) ^ swz) << 4);
      bf16x8 fa[2], fb[4];
#pragma unroll
      for (int ni = 0; ni < 2; ++ni) fa[ni] = *(const bf16x8*)(cB + aoff + ni * 4096 + co);
#pragma unroll
      for (int mi = 0; mi < 4; ++mi) fb[mi] = *(const bf16x8*)(cA + boff + mi * 4096 + co);
#pragma unroll
      for (int ni = 0; ni < 2; ++ni)
#pragma unroll
        for (int mi = 0; mi < 4; ++mi) acc[ni][mi] = MFMA32(fa[ni], fb[mi], acc[ni][mi]);
    }
    if (more) { char* dA = sA + ((kt + 1) & 1) * 65536; char* dB = sB + ((kt + 1) & 1) * 65536;
#pragma unroll
      for (int i = 0; i < 4; ++i) { *(u32x4*)(dA + wofs + i * 8192) = ra[i]; *(u32x4*)(dB + wofs + i * 8192) = rb[i]; } }
    __syncthreads();
  }
#pragma unroll
  for (int ni = 0; ni < 2; ++ni)
#pragma unroll
    for (int mi = 0; mi < 4; ++mi)
#pragma unroll
      for (int rg = 0; rg < 4; ++rg) {
        const int m = m0 + 128 * wm + 32 * mi + lq, n = n0 + 64 * wn + 32 * ni + 8 * rg + 4 * h;
        epi(m, n, acc[ni][mi][4 * rg], acc[ni][mi][4 * rg + 1], acc[ni][mi][4 * rg + 2], acc[ni][mi][4 * rg + 3]);
      }
}

DI void tile_coord(int t, int npn, int& pm, int& pn) { const int g = t / (16 * npn), r = t % (16 * npn); pn = r >> 4; pm = g * 16 + (r & 15); }

struct EpiProj { bf16_t* proj; float* ab;
  DI void operator()(int m, int n, float v0, float v1, float v2, float v3) const {
    u32x2 pk = {pack2(v0, v1), pack2(v2, v3)}; *(u32x2*)(proj + (size_t)m * DINP + n) = pk;
    if (n >= C_AA && n < C_AA + 16) { f32x4 v = {v0, v1, v2, v3}; *(f32x4*)(ab + (size_t)m * 16 + (n - C_AA)) = v; } } };
struct EpiF32 { float* out; int ldc;
  DI void operator()(int m, int n, float v0, float v1, float v2, float v3) const { f32x4 v = {v0, v1, v2, v3}; *(f32x4*)(out + (size_t)m * ldc + n) = v; } };
struct EpiBf { bf16_t* out; int ldc;
  DI void operator()(int m, int n, float v0, float v1, float v2, float v3) const { u32x2 pk = {pack2(v0, v1), pack2(v2, v3)}; *(u32x2*)(out + (size_t)m * ldc + n) = pk; } };
struct EpiMlaQ { float* qraw; const float* rs; int m0;
  DI void operator()(int m, int n, float v0, float v1, float v2, float v3) const { const float r = rs[m - m0]; f32x4 v = {v0 * r, v1 * r, v2 * r, v3 * r}; *(f32x4*)(qraw + (size_t)m * 768 + n) = v; } };
struct EpiMlaKV { bf16_t* kmla; bf16_t* vt; const float* rs; int m0;
  DI void operator()(int m, int n, float v0, float v1, float v2, float v3) const {
    const float r = rs[m - m0]; const int hd = n >> 8, wi = n & 255;
    if (wi < 128) { u32x2 pk = {pack2(v0 * r, v1 * r), pack2(v2 * r, v3 * r)}; *(u32x2*)(kmla + ((size_t)hd * S_ + m) * 192 + wi) = pk; }
    else { bf16_t* p = vt + ((size_t)hd * 128 + (wi - 128)) * S_ + m; p[0] = f2bf(v0 * r); p[S_] = f2bf(v1 * r); p[2 * (size_t)S_] = f2bf(v2 * r); p[3 * (size_t)S_] = f2bf(v3 * r); } } };

template <class Epi>
DI void gemm_phase(const bf16_t* A, int lda, const bf16_t* Bt, int ldb, int K, int npm, int npn, char* smem, const Epi& epi) {
  if (gridDim.x == 256 && npm == 64) {
    const int b = blockIdx.x, pm = 8 * (b & 7) + ((b >> 3) & 7), pj = b >> 6;
    for (int pn = pj; pn < npn; pn += 4) gemm_tile(A, lda, Bt, ldb, K, pm * 256, pn * 256, smem, epi);
  } else {
    for (int t = blockIdx.x; t < npm * npn; t += gridDim.x) { int pm, pn; tile_coord(t, npn, pm, pn); gemm_tile(A, lda, Bt, ldb, K, pm * 256, pn * 256, smem, epi); }
  }
}

DI void mod_item(const Params& P, int item) {
  const int tid = opaque_tid(); const int l = item / 96, r = item % 96, ks = r / 6, nc = r % 6;
  const int n = nc * 2048 + tid * 4;
  const float* wp = P.ada_w + ((size_t)l * 2048 + ks * 128) * 12288 + n;
  f32x4 acc = {0.f, 0.f, 0.f, 0.f};
#pragma unroll 8
  for (int k = 0; k < 128; ++k) { const float cv = P.c[ks * 128 + k]; const float ca = silu_f(cv); const f32x4 wv = *(const f32x4*)(wp + (size_t)k * 12288); acc += wv * ca; }
  float* modp = (float*)(P.ws + OFF_MODP);
  *(f32x4*)(modp + ((size_t)l * 16 + ks) * 12288 + n) = acc;
}
DI void convert_tile(const float* __restrict__ src, int K, int N, bf16_t* __restrict__ dst, int tk, int tn, const float* rowscale, char* smem) {
  float* sm = (float*)smem; const int tid = opaque_tid(); const int k0 = tk * 64, n0 = tn * 256;
  { const int r = tid >> 6, c4 = tid & 63; const int n = n0 + 4 * c4;
    f32x4 v[8];
#pragma unroll
    for (int i = 0; i < 8; ++i) { v[i] = (f32x4){0.f, 0.f, 0.f, 0.f}; if (n < N) v[i] = *(const f32x4*)(src + (size_t)(k0 + r + 8 * i) * N + n); }
#pragma unroll
    for (int i = 0; i < 8; ++i) { const int kk = r + 8 * i; if (rowscale) v[i] *= rowscale[k0 + kk];
      sm[kk * 257 + 4 * c4 + 0] = v[i].x; sm[kk * 257 + 4 * c4 + 1] = v[i].y; sm[kk * 257 + 4 * c4 + 2] = v[i].z; sm[kk * 257 + 4 * c4 + 3] = v[i].w; } }
  __syncthreads();
  { const int n = tid >> 1, kh = tid & 1;
#pragma unroll
    for (int j = 0; j < 4; ++j) { float f[8];
#pragma unroll
      for (int i = 0; i < 8; ++i) f[i] = sm[(32 * kh + 8 * j + i) * 257 + n];
      u32x4 pk = {pack2(f[0], f[1]), pack2(f[2], f[3]), pack2(f[4], f[5]), pack2(f[6], f[7])};
      *(u32x4*)(dst + (size_t)(n0 + n) * K + k0 + 32 * kh + 8 * j) = pk; } }
  __syncthreads();
}
constexpr int CV_T0 = 32 * 22, CV_T1 = CV_T0 + 32 * 8, CV_T2 = CV_T1 + 32 * 44, CV_T3 = CV_T2 + 88 * 8, CV_T4 = CV_T3 + 7 * 3, CV_T5 = CV_T4 + 2 * 4;
DI void convert_item(const Params& P, int l, int it, char* smem) {
  char* wb = P.ws + OFF_W;
  if (it < CV_T0) convert_tile(P.w_in + (size_t)l * 2048 * 5520, 2048, 5520, (bf16_t*)(wb + W_IN), it / 22, it % 22, nullptr, smem);
  else if (it < CV_T1) { it -= CV_T0; convert_tile(P.w_out + (size_t)l * 2048 * 2048, 2048, 2048, (bf16_t*)(wb + W_OUT), it / 8, it % 8, nullptr, smem); }
  else if (it < CV_T2) { it -= CV_T1; convert_tile(P.ffn_w_up + (size_t)l * 2048 * 11264, 2048, 11264, (bf16_t*)(wb + W_UP), it / 44, it % 44, nullptr, smem); }
  else if (it < CV_T3) { it -= CV_T2; convert_tile(P.ffn_w_down + (size_t)l * 5632 * 2048, 5632, 2048, (bf16_t*)(wb + W_DOWN), it / 8, it % 8, nullptr, smem); }
  else if (it < CV_T4) { it -= CV_T3; convert_tile(P.mla_w_uq + (size_t)l * 448 * 768, 448, 768, (bf16_t*)(wb + W_UQ), it / 3, it % 3, P.mla_q_norm + l * 448, smem); }
  else { it -= CV_T4; convert_tile(P.mla_w_ukv + (size_t)l * 128 * 1024, 128, 1024, (bf16_t*)(wb + W_UKV), it / 4, it % 4, P.mla_kv_norm + l * 128, smem); }
}

DI float mod_val(const float* modp_l, const float* ada_b_l, int idx) { float s = ada_b_l[idx];
#pragma unroll
  for (int k = 0; k < 16; ++k) s += modp_l[(size_t)k * 12288 + idx]; return s; }
DI void rownorm_phase(const Params& P, const float* xin, const bf16_t* yin, float* xout, bf16_t* hout, int lg, int gate_idx, const float* w_post,
                      int lh, int scale_idx, int shift_idx, const float* w_pre, char* smem) {
  float* A1 = (float*)smem; float* A2 = A1 + 2048; float* B2 = A2 + 2048;
  const int tid = opaque_tid(), lane = tid & 63, w = tid >> 6;
  const float* modp = (const float*)(P.ws + OFF_MODP);
  for (int cidx = tid; cidx < 2048; cidx += NT) {
    if (yin) A1[cidx] = mod_val(modp + (size_t)lg * 16 * 12288, P.ada_b + (size_t)lg * 12288, gate_idx * 2048 + cidx) * w_post[cidx];
    if (hout) { A2[cidx] = w_pre[cidx] * (1.f + mod_val(modp + (size_t)lh * 16 * 12288, P.ada_b + (size_t)lh * 12288, scale_idx * 2048 + cidx));
      B2[cidx] = mod_val(modp + (size_t)lh * 16 * 12288, P.ada_b + (size_t)lh * 12288, shift_idx * 2048 + cidx); }
  }
  __syncthreads();
  for (int row = blockIdx.x * 8 + w; row < S_; row += gridDim.x * 8) {
    f32x4 xv[8];
#pragma unroll
    for (int j = 0; j < 8; ++j) xv[j] = *(const f32x4*)(xin + (size_t)row * 2048 + (j * 64 + lane) * 4);
    if (yin) {
      f32x4 yv[8]; float ss = 0.f;
#pragma unroll
      for (int j = 0; j < 8; ++j) { const u32x2 yb = *(const u32x2*)(yin + (size_t)row * 2048 + (j * 64 + lane) * 4); yv[j] = (f32x4){bflo(yb.x), bfhi(yb.x), bflo(yb.y), bfhi(yb.y)};
        ss += yv[j].x * yv[j].x + yv[j].y * yv[j].y + yv[j].z * yv[j].z + yv[j].w * yv[j].w; }
      ss = wave_sum(ss); const float r = rsqrtf(ss * (1.f / 2048.f) + EPS);
#pragma unroll
      for (int j = 0; j < 8; ++j) { const f32x4 a = *(const f32x4*)(A1 + (j * 64 + lane) * 4); xv[j] += a * (yv[j] * r); }
    }
    if (yin || xout != xin) {
#pragma unroll
      for (int j = 0; j < 8; ++j) *(f32x4*)(xout + (size_t)row * 2048 + (j * 64 + lane) * 4) = xv[j];
    }
    if (hout) {
      float ss = 0.f;
#pragma unroll
      for (int j = 0; j < 8; ++j) ss += xv[j].x * xv[j].x + xv[j].y * xv[j].y + xv[j].z * xv[j].z + xv[j].w * xv[j].w;
      ss = wave_sum(ss); const float r = rsqrtf(ss * (1.f / 2048.f) + EPS);
#pragma unroll
      for (int j = 0; j < 8; ++j) { const f32x4 a = *(const f32x4*)(A2 + (j * 64 + lane) * 4), b = *(const f32x4*)(B2 + (j * 64 + lane) * 4);
        const f32x4 hv = xv[j] * r * a + b; u32x2 pk = {pack2(hv.x, hv.y), pack2(hv.z, hv.w)};
        *(u32x2*)(hout + (size_t)row * 2048 + (j * 64 + lane) * 4) = pk; }
    }
  }
  __syncthreads();
}

DI void mla_q_tile(const Params& P, int pm, int pn, char* smem) {
  const bf16_t* proj = (const bf16_t*)(P.ws + OFF_PROJ); const int tid = opaque_tid(), m0 = pm * 256; float* rs = (float*)(smem + 131072);
  { const int row = tid >> 1, half = tid & 1; const bf16_t* p = proj + (size_t)(m0 + row) * DINP + C_BCQ + half * 224; float ss = 0.f;
    for (int i = 0; i < 28; ++i) { const u32x4 v = *(const u32x4*)(p + i * 8); float f[8]; unpack8(v, f);
#pragma unroll
      for (int e = 0; e < 8; ++e) ss += f[e] * f[e]; }
    ss += __shfl_xor(ss, 1); if (half == 0) rs[row] = rsqrtf(ss * (1.f / 448.f) + EPS); }
  EpiMlaQ epi{(float*)(P.ws + OFF_QRAW), rs, m0};
  gemm_tile_s(proj + C_BCQ, DINP, (const bf16_t*)(P.ws + OFF_W + W_UQ), 448, 448, m0, pn * 256, smem, epi);
  __syncthreads();
}
DI void mla_kv_tile(const Params& P, int pm, int pn, char* smem) {
  const bf16_t* proj = (const bf16_t*)(P.ws + OFF_PROJ); const int tid = opaque_tid(), m0 = pm * 256; float* rs = (float*)(smem + 131072);
  { const int row = tid >> 1, half = tid & 1; const bf16_t* p = proj + (size_t)(m0 + row) * DINP + C_BCKV + half * 64; float ss = 0.f;
#pragma unroll
    for (int i = 0; i < 8; ++i) { const u32x4 v = *(const u32x4*)(p + i * 8); float f[8]; unpack8(v, f);
#pragma unroll
      for (int e = 0; e < 8; ++e) ss += f[e] * f[e]; }
    ss += __shfl_xor(ss, 1); if (half == 0) rs[row] = rsqrtf(ss * (1.f / 128.f) + EPS); }
  bf16_t* kmla = (bf16_t*)(P.ws + OFF_KMLA);
  EpiMlaKV epi{kmla, (bf16_t*)(P.ws + OFF_VT), rs, m0};
  gemm_tile_s(proj + C_BCKV, DINP, (const bf16_t*)(P.ws + OFF_W + W_UKV), 128, 128, m0, pn * 256, smem, epi);
  if (pn == 0) {
    for (int i = 0; i < 16; ++i) { const int idx = tid + NT * i, row = idx >> 5, pi = idx & 31, m = m0 + row;
      const float x1 = bflo((unsigned)proj[(size_t)m * DINP + C_BKR + pi]), x2 = bflo((unsigned)proj[(size_t)m * DINP + C_BKR + 32 + pi]);
      double fr = (double)P.pos[m] * kInvFreq2Pi[pi]; fr -= floor(fr); const float ff = (float)fr;
      const float sn = __builtin_amdgcn_sinf(ff), cs = __builtin_amdgcn_cosf(ff);
      const bf16_t o1 = f2bf(x1 * cs - x2 * sn), o2 = f2bf(x2 * cs + x1 * sn);
#pragma unroll
      for (int hd = 0; hd < 4; ++hd) { bf16_t* kp = kmla + ((size_t)hd * S_ + m) * 192 + 128; kp[pi] = o1; kp[32 + pi] = o2; } }
  }
  __syncthreads();
}

DI void gdn_prep_item(const Params& P, int l, int n, int hh, char* smem) {
  const int tid = opaque_tid(), lane = tid & 63, w = tid >> 6, lq = lane & 31, h = lane >> 5;
  const bf16_t* proj = (const bf16_t*)(P.ws + OFF_PROJ); const float* ab = (const float*)(P.ws + OFF_AB);
  char* kb16 = smem; char* qb16 = smem + 17408;
  float* kf = (float*)(smem + 34816); float* vf = kf + 8192; float* Lm = vf + 8192; float* gcs = Lm + 4096;
  const size_t tile = (size_t)hh * 256 + n; const int t0 = n * 64;
  bf16_t* Wp = (bf16_t*)(P.ws + OFF_WP) + tile * 8192; bf16_t* Qd = (bf16_t*)(P.ws + OFF_QD) + tile * 8192;
  bf16_t* Kt = (bf16_t*)(P.ws + OFF_KT) + tile * 8192; bf16_t* Zt = (bf16_t*)(P.ws + OFF_ZT) + tile * 8192;
  bf16_t* QK = (bf16_t*)(P.ws + OFF_QK) + tile * 4096; bf16_t* Ut = (bf16_t*)(P.ws + OFF_UT) + tile * 8192;
  if (w == 0) {
    const int t = lane; const float a_raw = ab[(size_t)(t0 + t) * 16 + hh], b_raw = ab[(size_t)(t0 + t) * 16 + 8 + hh];
    const float Aa = __expf(P.gdn_a_log[l * 8 + hh]); const float xb = a_raw + P.gdn_dt_bias[l * 8 + hh];
    const float ex = __expf(fminf(xb, 20.f));
    const float sp = xb > 20.f ? xb : (ex < 0.01f ? ex * (1.f - ex * (0.5f - ex * (1.f / 3.f))) : __logf(1.f + ex));
    float g = -Aa * sp;
#pragma unroll
    for (int d = 1; d < 64; d <<= 1) { const float v = __shfl_up(g, d); if (lane >= d) g += v; }
    const float bt = 1.f / (1.f + __expf(-b_raw)), eg = __expf(g); gcs[t] = g; gcs[64 + t] = bt; gcs[128 + t] = eg; gcs[192 + t] = bt * eg;
    if (t == 63) ((float*)(P.ws + OFF_GTOT))[tile] = eg;
  }
  __syncthreads();
  {
    const int t = tid >> 3, part = tid & 7, tabs = t0 + t;
    const float gct = gcs[t], egct = gcs[128 + t], ktl = __expf(gcs[63] - gct);
    const int pjt = 32 * (t >> 5) + perm32(t & 31);
#pragma unroll
    for (int X = 0; X < 3; ++X) {
      const int cb = X * 1024 + hh * 128 + part * 16;
      float y[16];
#pragma unroll
      for (int e = 0; e < 16; ++e) y[e] = 0.f;
#pragma unroll
      for (int j = 0; j < 4; ++j) { const int row = tabs - 3 + j;
        if (row >= 0) { const u32x4 v0 = *(const u32x4*)(proj + (size_t)row * DINP + cb), v1 = *(const u32x4*)(proj + (size_t)row * DINP + cb + 8);
          float xv[16]; unpack8(v0, xv); unpack8(v1, xv + 8); const float* cw = P.gdn_conv + ((size_t)l * 4 + j) * 3072 + cb;
#pragma unroll
          for (int e4 = 0; e4 < 4; ++e4) { const f32x4 wv = *(const f32x4*)(cw + 4 * e4); y[4 * e4] += wv.x * xv[4 * e4]; y[4 * e4 + 1] += wv.y * xv[4 * e4 + 1]; y[4 * e4 + 2] += wv.z * xv[4 * e4 + 2]; y[4 * e4 + 3] += wv.w * xv[4 * e4 + 3]; } } }
#pragma unroll
      for (int e = 0; e < 16; ++e) y[e] = silu_f(y[e]);
      if (X < 2) { float ss = 0.f;
#pragma unroll
        for (int e = 0; e < 16; ++e) ss += y[e] * y[e];
        ss += __shfl_xor(ss, 1); ss += __shfl_xor(ss, 2); ss += __shfl_xor(ss, 4);
        const float rn = rsqrtf(ss + EPS) * (X == 0 ? 0.08838834764831845f : 1.f);
#pragma unroll
        for (int e = 0; e < 16; ++e) y[e] *= rn; }
      if (X == 0) {
        u32x4 p0 = {pack2(y[0], y[1]), pack2(y[2], y[3]), pack2(y[4], y[5]), pack2(y[6], y[7])}, p1 = {pack2(y[8], y[9]), pack2(y[10], y[11]), pack2(y[12], y[13]), pack2(y[14], y[15])};
        *(u32x4*)(qb16 + t * 272 + part * 32) = p0; *(u32x4*)(qb16 + t * 272 + part * 32 + 16) = p1;
#pragma unroll
        for (int b = 0; b < 4; ++b) { u32x2 pk = {pack2(y[4 * b] * egct, y[4 * b + 1] * egct), pack2(y[4 * b + 2] * egct, y[4 * b + 3] * egct)};
          *(u32x2*)(Qd + t * 128 + 32 * (part >> 1) + 8 * b + 4 * (part & 1)) = pk; }
      } else if (X == 1) {
        u32x4 p0 = {pack2(y[0], y[1]), pack2(y[2], y[3]), pack2(y[4], y[5]), pack2(y[6], y[7])}, p1 = {pack2(y[8], y[9]), pack2(y[10], y[11]), pack2(y[12], y[13]), pack2(y[14], y[15])};
        *(u32x4*)(kb16 + t * 272 + part * 32) = p0; *(u32x4*)(kb16 + t * 272 + part * 32 + 16) = p1;
#pragma unroll
        for (int e4 = 0; e4 < 4; ++e4) { f32x4 v = {y[4 * e4], y[4 * e4 + 1], y[4 * e4 + 2], y[4 * e4 + 3]}; *(f32x4*)(kf + t * 128 + part * 16 + 4 * e4) = v; }
#pragma unroll
        for (int e = 0; e < 16; ++e) Kt[(part * 16 + e) * 64 + pjt] = f2bf(y[e] * ktl);
      } else {
#pragma unroll
        for (int e4 = 0; e4 < 4; ++e4) { f32x4 v = {y[4 * e4], y[4 * e4 + 1], y[4 * e4 + 2], y[4 * e4 + 3]}; *(f32x4*)(vf + t * 128 + part * 16 + 4 * e4) = v; }
      }
    }
    { const int cb = C_AZ + hh * 128 + part * 16; const u32x4 v0 = *(const u32x4*)(proj + (size_t)tabs * DINP + cb), v1 = *(const u32x4*)(proj + (size_t)tabs * DINP + cb + 8);
      float zv[16]; unpack8(v0, zv); unpack8(v1, zv + 8);
#pragma unroll
      for (int e = 0; e < 16; ++e) Zt[(part * 16 + e) * 64 + t] = f2bf(silu_f(zv[e])); }
  }
  __syncthreads();
  {
    const int which = w >> 2, ti = (w >> 1) & 1, tj = w & 1; const char* Ab = which ? qb16 : kb16;
    f32x16 acc;
#pragma unroll
    for (int r = 0; r < 16; ++r) acc[r] = 0.f;
#pragma unroll
    for (int s = 0; s < 8; ++s) { const bf16x8 a = *(const bf16x8*)(Ab + (32 * ti + lq) * 272 + (16 * s + 8 * h) * 2), b = *(const bf16x8*)(kb16 + (32 * tj + lq) * 272 + (16 * s + 8 * h) * 2);
      acc = MFMA32(a, b, acc); }
    const int j = 32 * tj + lq; const float gj = gcs[j]; const int pj = 32 * (j >> 5) + perm32(j & 31);
#pragma unroll
    for (int r = 0; r < 16; ++r) { const int i = 32 * ti + crow(r, h); const float dec = __expf(fminf(gcs[i] - gj, 0.f));
      if (which == 0) Lm[i * 64 + j] = (j < i) ? gcs[64 + i] * acc[r] * dec : 0.f;
      else QK[i * 64 + pj] = f2bf((j <= i) ? acc[r] * dec : 0.f); }
  }
  __syncthreads();
  if (tid < 256) {
    const int c = tid; const bool isu = c < 128; const int cc = c & 127;
    const float* rp = (isu ? vf : kf) + cc; const float* sp = gcs + (isu ? 64 : 192);
    float x[64];
#pragma unroll
    for (int i = 0; i < 64; ++i) {
      float r = sp[i] * rp[i * 128];
#pragma unroll
      for (int j = 0; j < i; ++j) r = fmaf(-Lm[i * 64 + j], x[j], r);
      x[i] = r;
    }
    if (isu) {
#pragma unroll
      for (int i8 = 0; i8 < 8; ++i8) { u32x4 v = {pack2(x[8 * i8], x[8 * i8 + 1]), pack2(x[8 * i8 + 2], x[8 * i8 + 3]), pack2(x[8 * i8 + 4], x[8 * i8 + 5]), pack2(x[8 * i8 + 6], x[8 * i8 + 7])}; *(u32x4*)(Ut + cc * 64 + 8 * i8) = v; }
    } else {
      const int pp = 32 * (cc >> 5) + perm32(cc & 31);
#pragma unroll
      for (int i = 0; i < 64; ++i) Wp[i * 128 + pp] = f2bf(x[i]);
    }
  }
  __syncthreads();
}

DI bf16x8 pack_tiles(const f32x4& a, const f32x4& b) { return pack8(a.x, a.y, a.z, a.w, b.x, b.y, b.z, b.w); }
template <int CTRL> DI float dppf(float v) { return __int_as_float(__builtin_amdgcn_update_dpp(0, __float_as_int(v), CTRL, 0xf, 0xf, true)); }
DI float row16_sum(float v) { v += dppf<0xB1>(v); v += dppf<0x4E>(v); v += dppf<0x141>(v); v += dppf<0x140>(v); return v; }
constexpr size_t OFF_SSQP = OFF_GTOT + 8192;
static_assert(OFF_SSQP + (size_t)8 * S_ * 8 * 4 <= OFF_UT, "overlay3");
constexpr int SCAN_OPB = 62464;
constexpr int SCAN_SO = 2 * SCAN_OPB;
DI void gdn_scan_item(const Params& P, int l, int hh, int half, char* smem) {
  const int tid = opaque_tid(), lane = tid & 63, w = tid >> 6, l15 = lane & 15, q4 = lane >> 4;
  const size_t hb = (size_t)hh * 256;
  const bf16_t* Wp = (const bf16_t*)(P.ws + OFF_WP) + hb * 8192; const bf16_t* Qd = (const bf16_t*)(P.ws + OFF_QD) + hb * 8192;
  const bf16_t* Kt = (const bf16_t*)(P.ws + OFF_KT) + hb * 8192; const bf16_t* Zt = (const bf16_t*)(P.ws + OFF_ZT) + hb * 8192;
  const bf16_t* QK = (const bf16_t*)(P.ws + OFF_QK) + hb * 4096; const bf16_t* Ut = (const bf16_t*)(P.ws + OFF_UT) + hb * 8192;
  const float* gt = (const float*)(P.ws + OFF_GTOT) + hb;
  bf16_t* mixin = (bf16_t*)(P.ws + OFF_H);
  if (w >= 4) {
    const int lt = tid - 256, wl = w - 4;
    const int dvc = 64 * half + 16 * wl + l15; const float nw = P.gdn_norm[l * 128 + dvc];
    const int uoff = dvc * 64 + 4 * q4;
    float* ssqp = (float*)(P.ws + OFF_SSQP) + (size_t)(half * 4 + wl) * S_ * 8;
    const int g256 = (lt >> 4) * 128 + (lt & 15) * 8, l256 = (lt >> 4) * 272 + (lt & 15) * 16;
    const int g128 = (lt >> 3) * 64 + (lt & 7) * 8, l128 = (lt >> 3) * 144 + (lt & 7) * 16;
    u32x4 pw[4], pq[4], pk[4], pqk[2]; u32x2 zc[4], zn[4];
#pragma unroll
    for (int i = 0; i < 4; ++i) { pw[i] = *(const u32x4*)(Wp + g256 + i * 2048); pq[i] = *(const u32x4*)(Qd + g256 + i * 2048); pk[i] = *(const u32x4*)(Kt + g128 + i * 2048); }
#pragma unroll
    for (int i = 0; i < 2; ++i) pqk[i] = *(const u32x4*)(QK + g128 + i * 2048);
#pragma unroll
    for (int i = 0; i < 4; ++i) { *(u32x4*)(smem + l256 + i * 4352) = pw[i]; *(u32x4*)(smem + 17408 + l256 + i * 4352) = pq[i]; *(u32x4*)(smem + 34816 + l128 + i * 4608) = pk[i]; }
#pragma unroll
    for (int i = 0; i < 2; ++i) *(u32x4*)(smem + 53248 + l128 + i * 4608) = pqk[i];
#pragma unroll
    for (int i = 0; i < 4; ++i) { pw[i] = *(const u32x4*)(Wp + 8192 + g256 + i * 2048); pq[i] = *(const u32x4*)(Qd + 8192 + g256 + i * 2048); pk[i] = *(const u32x4*)(Kt + 8192 + g128 + i * 2048); }
#pragma unroll
    for (int i = 0; i < 2; ++i) pqk[i] = *(const u32x4*)(QK + 4096 + g128 + i * 2048);
#pragma unroll
    for (int it = 0; it < 4; ++it) { zc[it] = (u32x2){0u, 0u}; zn[it] = zc[it]; }
    __syncthreads();
#pragma unroll 1
    for (int n = 0; n <= 256; ++n) {
      if (n < 256) {
        char* nb = smem + ((n + 1) & 1) * SCAN_OPB;
        if (n + 1 < 256) {
#pragma unroll
          for (int i = 0; i < 4; ++i) { *(u32x4*)(nb + l256 + i * 4352) = pw[i]; *(u32x4*)(nb + 17408 + l256 + i * 4352) = pq[i]; *(u32x4*)(nb + 34816 + l128 + i * 4608) = pk[i]; }
#pragma unroll
          for (int i = 0; i < 2; ++i) *(u32x4*)(nb + 53248 + l128 + i * 4608) = pqk[i];
        }
        if (n + 2 < 256) { const size_t o8 = (size_t)(n + 2) * 8192, o4 = (size_t)(n + 2) * 4096;
#pragma unroll
          for (int i = 0; i < 4; ++i) { pw[i] = *(const u32x4*)(Wp + o8 + g256 + i * 2048); pq[i] = *(const u32x4*)(Qd + o8 + g256 + i * 2048); pk[i] = *(const u32x4*)(Kt + o8 + g128 + i * 2048); }
#pragma unroll
          for (int i = 0; i < 2; ++i) pqk[i] = *(const u32x4*)(QK + o4 + g128 + i * 2048); }
#pragma unroll
        for (int it = 0; it < 4; ++it) zn[it] = *(const u32x2*)(Zt + (size_t)n * 8192 + uoff + 16 * it);
      }
      if (n >= 1) {
        const int m = n - 1; const char* so = smem + SCAN_SO + (m & 1) * 16384 + (wl * 4) * 1024 + lane * 16;
#pragma unroll
        for (int it = 0; it < 4; ++it) {
          const f32x4 o = *(const f32x4*)(so + it * 1024);
          f32x4 ss = o * o;
          ss.x = row16_sum(ss.x); ss.y = row16_sum(ss.y); ss.z = row16_sum(ss.z); ss.w = row16_sum(ss.w);
          const int row = 64 * m + 16 * it + 4 * q4;
          if (l15 == 0) { float* sp = ssqp + (size_t)row * 8 + hh; sp[0] = ss.x; sp[8] = ss.y; sp[16] = ss.z; sp[24] = ss.w; }
          const float z0 = bflo(zc[it].x), z1 = bfhi(zc[it].x), z2 = bflo(zc[it].y), z3 = bfhi(zc[it].y);
          bf16_t* op = mixin + (size_t)row * 2048 + hh * 128 + dvc;
          op[0] = f2bf(o.x * nw * z0); op[2048] = f2bf(o.y * nw * z1); op[4096] = f2bf(o.z * nw * z2); op[6144] = f2bf(o.w * nw * z3);
        }
      }
#pragma unroll
      for (int it = 0; it < 4; ++it) zc[it] = zn[it];
      if (n < 256) __syncthreads();
    }
  } else {
    const int dvc = 64 * half + 16 * w + l15;
    const int uoff = dvc * 64 + 4 * q4;
    f32x4 St[8];
#pragma unroll
    for (int t = 0; t < 8; ++t) St[t] = (f32x4){0.f, 0.f, 0.f, 0.f};
    u32x2 uc[4], un[4]; float gcur, gn = 0.f;
#pragma unroll
    for (int it = 0; it < 4; ++it) { uc[it] = *(const u32x2*)(Ut + uoff + 16 * it); un[it] = uc[it]; }
    gcur = gt[0];
    __syncthreads();
#pragma unroll 2
    for (int n = 0; n < 256; ++n) {
      const char* cb = smem + (n & 1) * SCAN_OPB;
      const char* sWp = cb; const char* sQd = cb + 17408; const char* sKt = cb + 34816; const char* sQK = cb + 53248;
      if (n + 1 < 256) { const size_t o8 = (size_t)(n + 1) * 8192;
#pragma unroll
        for (int it = 0; it < 4; ++it) un[it] = *(const u32x2*)(Ut + o8 + uoff + 16 * it);
        gn = gt[n + 1]; }
      bf16x8 sb[4];
#pragma unroll
      for (int ks = 0; ks < 4; ++ks) sb[ks] = pack_tiles(St[2 * ks], St[2 * ks + 1]);
      f32x4 wsv[4], qs[4];
#pragma unroll
      for (int it = 0; it < 4; ++it) { wsv[it] = (f32x4){0.f, 0.f, 0.f, 0.f}; qs[it] = (f32x4){0.f, 0.f, 0.f, 0.f}; }
#pragma unroll
      for (int it = 0; it < 4; ++it)
#pragma unroll
        for (int ks = 0; ks < 4; ++ks) { const int o = (16 * it + l15) * 272 + 64 * ks + 16 * q4;
          const bf16x8 a = *(const bf16x8*)(sWp + o), a2 = *(const bf16x8*)(sQd + o);
          wsv[it] = MFMA16(a, sb[ks], wsv[it]); qs[it] = MFMA16(a2, sb[ks], qs[it]); }
      f32x4 vn[4];
#pragma unroll
      for (int it = 0; it < 4; ++it) { const f32x4 uf = {bflo(uc[it].x), bfhi(uc[it].x), bflo(uc[it].y), bfhi(uc[it].y)}; vn[it] = uf - wsv[it]; }
      bf16x8 vb[2];
#pragma unroll
      for (int ks = 0; ks < 2; ++ks) vb[ks] = pack_tiles(vn[2 * ks], vn[2 * ks + 1]);
#pragma unroll
      for (int it = 0; it < 4; ++it)
#pragma unroll
        for (int ks = 0; ks < 2; ++ks) { const bf16x8 a = *(const bf16x8*)(sQK + (16 * it + l15) * 144 + 64 * ks + 16 * q4); qs[it] = MFMA16(a, vb[ks], qs[it]); }
      { char* so = smem + SCAN_SO + (n & 1) * 16384 + (w * 4) * 1024 + lane * 16;
#pragma unroll
        for (int it = 0; it < 4; ++it) *(f32x4*)(so + it * 1024) = qs[it]; }
#pragma unroll
      for (int t = 0; t < 8; ++t) { St[t] *= gcur;
#pragma unroll
        for (int ks = 0; ks < 2; ++ks) { const bf16x8 a = *(const bf16x8*)(sKt + (16 * t + l15) * 144 + 64 * ks + 16 * q4); St[t] = MFMA16(a, vb[ks], St[t]); } }
#pragma unroll
      for (int it = 0; it < 4; ++it) uc[it] = un[it];
      gcur = gn;
      __syncthreads();
    }
  }
  __syncthreads();
}
DI void gdn_fix_phase(const Params& P) {
  const int tid = opaque_tid();
  bf16_t* mixin = (bf16_t*)(P.ws + OFF_H); const float* ssqp = (const float*)(P.ws + OFF_SSQP);
  for (int idx = blockIdx.x * NT + tid; idx < S_ * 128; idx += gridDim.x * NT) {
    const int t = idx >> 7, ck = idx & 127, h = ck >> 4;
    float sq = 0.f;
#pragma unroll
    for (int p = 0; p < 8; ++p) sq += ssqp[((size_t)p * S_ + t) * 8 + h];
    const float r = rsqrtf(sq * (1.f / 128.f) + EPS);
    u32x4* pp = (u32x4*)(mixin + (size_t)t * 2048 + ck * 8); const u32x4 v = *pp; float f[8]; unpack8(v, f);
    u32x4 o = {pack2(f[0] * r, f[1] * r), pack2(f[2] * r, f[3] * r), pack2(f[4] * r, f[5] * r), pack2(f[6] * r, f[7] * r)}; *pp = o;
  }
}

DI void mla_attn_item(const Params& P, int hd, int b, char* smem) {
  const int tid = opaque_tid(), lane = tid & 63, w = tid >> 6, wq = w & 3, hk = w >> 2, lq = lane & 31, h = lane >> 5;
  const float* qraw = (const float*)(P.ws + OFF_QRAW);
  const bf16_t* Kg = (const bf16_t*)(P.ws + OFF_KMLA) + (size_t)hd * S_ * 192;
  const bf16_t* Vg = (const bf16_t*)(P.ws + OFF_VT) + (size_t)hd * 128 * S_;
  bf16_t* mixin = (bf16_t*)(P.ws + OFF_H);
  const int q = 128 * b + 32 * wq + lq;
  bf16x8 qf[12];
  {
    const float* qp = qraw + (size_t)q * 768 + hd * 192 + 8 * h;
    const float sc = 0.07216878364870322f * LOG2E;
#pragma unroll
    for (int s = 0; s < 8; ++s) { const f32x4 a = *(const f32x4*)(qp + 16 * s), c = *(const f32x4*)(qp + 16 * s + 4);
      qf[s] = pack8(a.x * sc, a.y * sc, a.z * sc, a.w * sc, c.x * sc, c.y * sc, c.z * sc, c.w * sc); }
    const double pq = (double)P.pos[q];
#pragma unroll
    for (int s2 = 0; s2 < 2; ++s2) {
      const f32x4 a0 = *(const f32x4*)(qp + 128 + 16 * s2), a1 = *(const f32x4*)(qp + 128 + 16 * s2 + 4);
      const f32x4 b0 = *(const f32x4*)(qp + 160 + 16 * s2), b1 = *(const f32x4*)(qp + 160 + 16 * s2 + 4);
      float x1[8] = {a0.x, a0.y, a0.z, a0.w, a1.x, a1.y, a1.z, a1.w}, x2[8] = {b0.x, b0.y, b0.z, b0.w, b1.x, b1.y, b1.z, b1.w}, o1[8], o2[8];
#pragma unroll
      for (int j = 0; j < 8; ++j) { double fr = pq * kInvFreq2Pi[16 * s2 + 8 * h + j]; fr -= floor(fr); const float ff = (float)fr;
        const float sn = __builtin_amdgcn_sinf(ff), cs = __builtin_amdgcn_cosf(ff);
        o1[j] = (x1[j] * cs - x2[j] * sn) * sc; o2[j] = (x2[j] * cs + x1[j] * sn) * sc; }
      qf[8 + s2] = pack8(o1[0], o1[1], o1[2], o1[3], o1[4], o1[5], o1[6], o1[7]);
      qf[10 + s2] = pack8(o2[0], o2[1], o2[2], o2[3], o2[4], o2[5], o2[6], o2[7]);
    }
  }
  constexpr int KST = 64 * 400, VST = 128 * 144, STG = KST + VST;
  f32x16 O[4];
#pragma unroll
  for (int i = 0; i < 4; ++i)
#pragma unroll
    for (int r = 0; r < 16; ++r) O[i][r] = 0.f;
  float m_i = -1e30f, l_i = 0.f;
  const int nt = 2 * b + 2;
  u32x4 rk[3], rv[2];
  const int vrow = tid >> 3, vcc = tid & 7;
#pragma unroll
  for (int i = 0; i < 3; ++i) { const int id = tid + NT * i, row = id / 24, cc = id % 24; rk[i] = *(const u32x4*)(Kg + row * 192 + cc * 8); }
#pragma unroll
  for (int i = 0; i < 2; ++i) rv[i] = *(const u32x4*)(Vg + (size_t)(vrow + 64 * i) * S_ + vcc * 8);
#pragma unroll
  for (int i = 0; i < 3; ++i) { const int id = tid + NT * i, row = id / 24, cc = id % 24; *(u32x4*)(smem + row * 400 + cc * 16) = rk[i]; }
#pragma unroll
  for (int i = 0; i < 2; ++i) *(u32x4*)(smem + KST + (vrow + 64 * i) * 144 + vcc * 16) = rv[i];
  __syncthreads();
  for (int kt = 0; kt < nt; ++kt) {
    const char* sK = smem + (kt & 1) * STG; const char* sV = sK + KST;
    const bool more = (kt + 1 < nt);
    if (more) { const size_t ko = (size_t)(kt + 1) * 64 * 192; const int vo = (kt + 1) * 64;
#pragma unroll
      for (int i = 0; i < 3; ++i) { const int id = tid + NT * i, row = id / 24, cc = id % 24; rk[i] = *(const u32x4*)(Kg + ko + row * 192 + cc * 8); }
#pragma unroll
      for (int i = 0; i < 2; ++i) rv[i] = *(const u32x4*)(Vg + (size_t)(vrow + 64 * i) * S_ + vo + vcc * 8); }
    const int key0 = 64 * kt + 32 * hk;
    if (key0 <= 128 * b + 32 * wq) {
      f32x16 st;
#pragma unroll
      for (int r = 0; r < 16; ++r) st[r] = 0.f;
#pragma unroll
      for (int s = 0; s < 12; ++s) { const bf16x8 kf = *(const bf16x8*)(sK + (32 * hk + lq) * 400 + (2 * s + h) * 16); st = MFMA32(kf, qf[s], st); }
      if (key0 + 31 > 128 * b + 32 * wq) {
        int qrel = q - key0 - 4 * h; asm volatile("" : "+v"(qrel));
#pragma unroll
        for (int r = 0; r < 16; ++r) if ((r & 3) + 8 * (r >> 2) > qrel) st[r] = -1e30f;
      }
      float mx = st[0];
#pragma unroll
      for (int r = 1; r < 16; ++r) mx = fmaxf(mx, st[r]);
      mx = fmaxf(mx, __shfl_xor(mx, 32));
      const float m_new = fmaxf(m_i, mx), alpha = exp2f(m_i - m_new);
      float ps = 0.f;
#pragma unroll
      for (int r = 0; r < 16; ++r) { st[r] = exp2f(st[r] - m_new); ps += st[r]; }
      l_i = l_i * alpha + ps; m_i = m_new;
#pragma unroll
      for (int i = 0; i < 4; ++i)
#pragma unroll
        for (int r = 0; r < 16; ++r) O[i][r] *= alpha;
      bf16x8 pf[2];
#pragma unroll
      for (int s = 0; s < 2; ++s) pf[s] = pack8(st[8 * s], st[8 * s + 1], st[8 * s + 2], st[8 * s + 3], st[8 * s + 4], st[8 * s + 5], st[8 * s + 6], st[8 * s + 7]);
#pragma unroll
      for (int i = 0; i < 4; ++i)
#pragma unroll
        for (int s = 0; s < 2; ++s) { const char* vp = sV + (32 * i + lq) * 144 + (32 * hk + 16 * s + 4 * h) * 2;
          const u32x2 lo = *(const u32x2*)vp, hi = *(const u32x2*)(vp + 16); u32x4 vv = {lo.x, lo.y, hi.x, hi.y};
          O[i] = MFMA32(__builtin_bit_cast(bf16x8, vv), pf[s], O[i]); }
    }
    if (more) { char* dK = smem + ((kt + 1) & 1) * STG;
#pragma unroll
      for (int i = 0; i < 3; ++i) { const int id = tid + NT * i, row = id / 24, cc = id % 24; *(u32x4*)(dK + row * 400 + cc * 16) = rk[i]; }
#pragma unroll
      for (int i = 0; i < 2; ++i) *(u32x4*)(dK + KST + (vrow + 64 * i) * 144 + vcc * 16) = rv[i]; }
    __syncthreads();
  }
  float* cO = (float*)smem; float* cm = cO + 4 * 4096; float* cl = cm + 256;
  if (hk == 1) {
#pragma unroll
    for (int i = 0; i < 4; ++i)
#pragma unroll
      for (int r = 0; r < 16; ++r) cO[wq * 4096 + (i * 16 + r) * 64 + lane] = O[i][r];
    cm[wq * 64 + lane] = m_i; cl[wq * 64 + lane] = l_i;
  }
  __syncthreads();
  if (hk == 0) {
    const float m1 = cm[wq * 64 + lane], l1 = cl[wq * 64 + lane];
    const float m = fmaxf(m_i, m1), a0 = exp2f(m_i - m), a1 = exp2f(m1 - m);
    float lt = l_i * a0 + l1 * a1; lt += __shfl_xor(lt, 32);
    const float inv = 1.f / lt;
    bf16_t* op = mixin + (size_t)q * 2048 + 1024 + hd * 128;
#pragma unroll
    for (int i = 0; i < 4; ++i)
#pragma unroll
      for (int rg = 0; rg < 4; ++rg) { float v[4];
#pragma unroll
        for (int e = 0; e < 4; ++e) v[e] = (O[i][4 * rg + e] * a0 + cO[wq * 4096 + (i * 16 + 4 * rg + e) * 64 + lane] * a1) * inv;
        u32x2 pk = {pack2(v[0], v[1]), pack2(v[2], v[3])}; *(u32x2*)(op + 32 * i + 8 * rg + 4 * h) = pk; }
  }
  __syncthreads();
}

DI void swa_item(const Params& P, int l, int n, int hk2, char* smem) {
  const int tid = opaque_tid(), lane = tid & 63, w = tid >> 6, lq = lane & 31, h = lane >> 5;
  const bf16_t* proj = (const bf16_t*)(P.ws + OFF_PROJ); bf16_t* mixin = (bf16_t*)(P.ws + OFF_H);
  bf16_t* sVt = (bf16_t*)smem;
#pragma unroll
  for (int i = 0; i < 4; ++i) { const int id = tid + NT * i, key = id >> 3, dc = id & 7; const int kp = 128 * (n - 1) + key;
    u32x4 v = {0u, 0u, 0u, 0u}; if (kp >= 0) v = *(const u32x4*)(proj + (size_t)kp * DINP + C_CV + hk2 * 64 + dc * 8);
    sVt[(8 * dc + 0) * 264 + key] = (bf16_t)(v.x & 0xffff); sVt[(8 * dc + 1) * 264 + key] = (bf16_t)(v.x >> 16);
    sVt[(8 * dc + 2) * 264 + key] = (bf16_t)(v.y & 0xffff); sVt[(8 * dc + 3) * 264 + key] = (bf16_t)(v.y >> 16);
    sVt[(8 * dc + 4) * 264 + key] = (bf16_t)(v.z & 0xffff); sVt[(8 * dc + 5) * 264 + key] = (bf16_t)(v.z >> 16);
    sVt[(8 * dc + 6) * 264 + key] = (bf16_t)(v.w & 0xffff); sVt[(8 * dc + 7) * 264 + key] = (bf16_t)(v.w >> 16); }
  __syncthreads();
  const int g = w >> 1, hq = hk2 * 4 + g;
  const float slope = exp2f(-(float)(hq + 1)) * LOG2E, sinkv = P.swa_sinks[l * 8 + hq] * LOG2E;
#pragma unroll 1
  for (int jj = 0; jj < 2; ++jj) {
    const int j = 2 * (w & 1) + jj; const int qrow = 128 * n + 32 * j + lq;
    bf16x8 qf[4];
#pragma unroll
    for (int s = 0; s < 4; ++s) qf[s] = *(const bf16x8*)(proj + (size_t)qrow * DINP + C_CQ + hq * 64 + 16 * s + 8 * h);
    f32x16 st[5];
    bf16x8 kf[2][4];
    { const int kp = 128 * (n - 1) + 32 * j + lq;
#pragma unroll
      for (int s = 0; s < 4; ++s) { kf[0][s] = (bf16x8){0, 0, 0, 0, 0, 0, 0, 0}; if (kp >= 0) kf[0][s] = *(const bf16x8*)(proj + (size_t)kp * DINP + C_CK + hk2 * 64 + 16 * s + 8 * h); } }
#pragma unroll
    for (int tt = 0; tt < 5; ++tt) {
      if (tt + 1 < 5) { const int kp = 128 * (n - 1) + 32 * (j + tt + 1) + lq;
#pragma unroll
        for (int s = 0; s < 4; ++s) { kf[(tt + 1) & 1][s] = (bf16x8){0, 0, 0, 0, 0, 0, 0, 0}; if (kp >= 0) kf[(tt + 1) & 1][s] = *(const bf16x8*)(proj + (size_t)kp * DINP + C_CK + hk2 * 64 + 16 * s + 8 * h); } }
      __builtin_amdgcn_sched_barrier(0);
#pragma unroll
      for (int r = 0; r < 16; ++r) st[tt][r] = 0.f;
#pragma unroll
      for (int s = 0; s < 4; ++s) st[tt] = MFMA32(kf[tt & 1][s], qf[s], st[tt]);
      __builtin_amdgcn_sched_barrier(0);
    }
    float mx = sinkv;
    int dbase = 128 + lq - 4 * h, kbase = 128 * (n - 1) + 32 * j + 4 * h;
    asm volatile("" : "+v"(dbase), "+v"(kbase));
#pragma unroll
    for (int tt = 0; tt < 5; ++tt)
#pragma unroll
      for (int r = 0; r < 16; ++r) { const int cst = 32 * tt + (r & 3) + 8 * (r >> 2); const int dist = dbase - cst; const int kpos = kbase + cst;
        const bool valid = (dist >= 0) && (dist < 128) && (kpos >= 0);
        const float sv = valid ? st[tt][r] * (0.125f * LOG2E) - slope * (float)dist : -1e30f; st[tt][r] = sv; mx = fmaxf(mx, sv); }
    mx = fmaxf(mx, __shfl_xor(mx, 32));
    float den = 0.f;
#pragma unroll
    for (int tt = 0; tt < 5; ++tt)
#pragma unroll
      for (int r = 0; r < 16; ++r) { const float p = exp2f(st[tt][r] - mx); st[tt][r] = p; den += p; }
    den += __shfl_xor(den, 32); den += exp2f(sinkv - mx);
    f32x16 O[2];
#pragma unroll
    for (int i = 0; i < 2; ++i)
#pragma unroll
      for (int r = 0; r < 16; ++r) O[i][r] = 0.f;
#pragma unroll
    for (int tt = 0; tt < 5; ++tt)
#pragma unroll
      for (int s = 0; s < 2; ++s) { const bf16x8 pf = pack8(st[tt][8 * s], st[tt][8 * s + 1], st[tt][8 * s + 2], st[tt][8 * s + 3], st[tt][8 * s + 4], st[tt][8 * s + 5], st[tt][8 * s + 6], st[tt][8 * s + 7]);
#pragma unroll
        for (int i = 0; i < 2; ++i) { const char* vp = (const char*)sVt + (32 * i + lq) * 528 + (32 * (j + tt) + 16 * s + 4 * h) * 2;
          const u32x2 lo = *(const u32x2*)vp, hi = *(const u32x2*)(vp + 16); u32x4 vv = {lo.x, lo.y, hi.x, hi.y};
          O[i] = MFMA32(__builtin_bit_cast(bf16x8, vv), pf, O[i]); }
        __builtin_amdgcn_sched_barrier(0); }
    const float inv = 1.f / den;
    bf16_t* op = mixin + (size_t)qrow * 2048 + 1536 + hq * 64;
#pragma unroll
    for (int i = 0; i < 2; ++i)
#pragma unroll
      for (int rg = 0; rg < 4; ++rg) { u32x2 pk = {pack2(O[i][4 * rg] * inv, O[i][4 * rg + 1] * inv), pack2(O[i][4 * rg + 2] * inv, O[i][4 * rg + 3] * inv)};
        *(u32x2*)(op + 32 * i + 8 * rg + 4 * h) = pk; }
  }
  __syncthreads();
}

DI float gelu_tanh(float x) { const float y = 0.7978845608028654f * (x + 0.044715f * x * x * x); const float t = 1.f - 2.f / (1.f + __expf(2.f * y)); return 0.5f * x * (1.f + t); }
DI void ffn_act_phase(const Params& P, int l) {
  const int tid = opaque_tid(), lane = tid & 63, w = tid >> 6;
  const bf16_t* u = (const bf16_t*)(P.ws + OFF_BIG); bf16_t* act = (bf16_t*)(P.ws + OFF_ACT);
  const float* cw = P.ffn_conv + (size_t)l * 3 * DFF2; const float* cb = P.ffn_conv_b + (size_t)l * DFF2;
  for (int item = blockIdx.x * 8 + w; item < 512 * 11; item += gridDim.x * 8) {
    const int cbk = item % 11, rr = item / 11; const int ch = cbk * 512 + lane * 8, r0 = rr * 32;
    float wg[3][8], wu[3][8], bg[8], bu[8];
#pragma unroll
    for (int j = 0; j < 3; ++j)
#pragma unroll
      for (int e4 = 0; e4 < 2; ++e4) { const f32x4 a = *(const f32x4*)(cw + (size_t)j * DFF2 + ch + 4 * e4), b = *(const f32x4*)(cw + (size_t)j * DFF2 + DFF + ch + 4 * e4);
        wg[j][4 * e4] = a.x; wg[j][4 * e4 + 1] = a.y; wg[j][4 * e4 + 2] = a.z; wg[j][4 * e4 + 3] = a.w; wu[j][4 * e4] = b.x; wu[j][4 * e4 + 1] = b.y; wu[j][4 * e4 + 2] = b.z; wu[j][4 * e4 + 3] = b.w; }
#pragma unroll
    for (int e4 = 0; e4 < 2; ++e4) { const f32x4 a = *(const f32x4*)(cb + ch + 4 * e4), b = *(const f32x4*)(cb + DFF + ch + 4 * e4);
      bg[4 * e4] = a.x; bg[4 * e4 + 1] = a.y; bg[4 * e4 + 2] = a.z; bg[4 * e4 + 3] = a.w; bu[4 * e4] = b.x; bu[4 * e4 + 1] = b.y; bu[4 * e4 + 2] = b.z; bu[4 * e4 + 3] = b.w; }
    float g2[8], g1[8], u2[8], u1[8];
#pragma unroll
    for (int e = 0; e < 8; ++e) { g2[e] = 0.f; g1[e] = 0.f; u2[e] = 0.f; u1[e] = 0.f; }
    if (r0 >= 2) { unpack8(*(const u32x4*)(u + (size_t)(r0 - 2) * DFF2 + ch), g2); unpack8(*(const u32x4*)(u + (size_t)(r0 - 2) * DFF2 + DFF + ch), u2);
      unpack8(*(const u32x4*)(u + (size_t)(r0 - 1) * DFF2 + ch), g1); unpack8(*(const u32x4*)(u + (size_t)(r0 - 1) * DFF2 + DFF + ch), u1); }
#pragma unroll 1
    for (int rb = 0; rb < 4; ++rb) {
      u32x4 G[8], U[8];
#pragma unroll
      for (int i = 0; i < 8; ++i) { const size_t ro = (size_t)(r0 + rb * 8 + i) * DFF2 + ch; G[i] = *(const u32x4*)(u + ro); U[i] = *(const u32x4*)(u + ro + DFF); }
#pragma unroll
      for (int i = 0; i < 8; ++i) {
        float g0[8], u0[8]; unpack8(G[i], g0); unpack8(U[i], u0);
        float o[8];
#pragma unroll
        for (int e = 0; e < 8; ++e) { const float yg = wg[0][e] * g2[e] + wg[1][e] * g1[e] + wg[2][e] * g0[e] + bg[e]; const float yu = wu[0][e] * u2[e] + wu[1][e] * u1[e] + wu[2][e] * u0[e] + bu[e];
          o[e] = gelu_tanh(yg) * yu; g2[e] = g1[e]; g1[e] = g0[e]; u2[e] = u1[e]; u1[e] = u0[e]; }
        u32x4 pk = {pack2(o[0], o[1]), pack2(o[2], o[3]), pack2(o[4], o[5]), pack2(o[6], o[7])};
        *(u32x4*)(act + (size_t)(r0 + rb * 8 + i) * DFF + ch) = pk;
      }
    }
  }
}

#define XB_TMO      128
#define XB_XCNT(j)  (256  + 64 * (j))
#define XB_XSUB(j)  (1280 + 64 * (j))
#define XB_XGEN(j)  (2304 + 64 * (j))
#define XB_TOP      3328
#define XB_TOPGEN   3392
#define XCD_BAR_WORDS 3456
#define XB_SPIN_CAP (1u << 18)
#define LAS __attribute__((address_space(3)))
DI unsigned xb_ld(unsigned* p)              { return __hip_atomic_load(p, __ATOMIC_RELAXED, __HIP_MEMORY_SCOPE_AGENT); }
DI unsigned xb_add(unsigned* p, unsigned v) { return __hip_atomic_fetch_add(p, v, __ATOMIC_RELAXED, __HIP_MEMORY_SCOPE_AGENT); }
DI unsigned xb_xcc_id() { return (unsigned)__builtin_amdgcn_s_getreg((3 << 11) | 20) & 0xFu; }
#define XB_SPIN(cond, bar) do { unsigned _sp = 0; while (cond) { __builtin_amdgcn_s_sleep(1); \
    if ((++_sp & 255u) == 0u) { if (xb_ld(&(bar)[XB_TMO])) break; if (_sp > XB_SPIN_CAP) { atomicAdd(&(bar)[XB_TMO], 1u); break; } } } } while (0)
struct XcdBarrier { unsigned* bar; unsigned x; volatile LAS unsigned* st; };
DI XcdBarrier xcd_barrier_post(unsigned* bar, volatile LAS unsigned* st) {
  XcdBarrier b; b.bar = bar; b.x = xb_xcc_id(); b.st = st;
  if (threadIdx.x == 0) (void)xb_add(&bar[XB_XCNT(b.x)], 1u);
  return b;
}
DI void xcd_barrier_complete(unsigned* bar, unsigned x, unsigned& nloc, unsigned& nx) {
  const unsigned G = gridDim.x * gridDim.y * gridDim.z;
  unsigned sum, cnt, mine, sp = 0u;
  for (;;) {
    sum = 0u; cnt = 0u; mine = 0u;
#pragma unroll
    for (unsigned j = 0; j < 16; ++j) { const unsigned c = xb_ld(&bar[XB_XCNT(j)]); sum += c; cnt += (c > 0u) ? 1u : 0u; mine = (j == x) ? c : mine; }
    if (sum == G) break;
    __builtin_amdgcn_s_sleep(1);
    if ((++sp & 255u) == 0u) { if (xb_ld(&bar[XB_TMO])) break; if (sp > XB_SPIN_CAP) { atomicAdd(&bar[XB_TMO], 1u); break; } }
  }
  nloc = mine > 0u ? mine : 1u; nx = cnt > 0u ? cnt : 1u;
}
DI void xcd_barrier(char* ws_, char* smem_) {
  XcdBarrier b; b.bar = (unsigned*)(ws_ + OFF_XBAR); b.x = xb_xcc_id(); b.st = (volatile LAS unsigned*)(smem_ + 157712);
  asm volatile("s_waitcnt vmcnt(0)" ::: "memory");
  __syncthreads();
  if (threadIdx.x == 0) {
    unsigned* bar = b.bar;
    __builtin_amdgcn_s_waitcnt(0);
    unsigned nloc = b.st[0], nx = b.st[1];
    if (nloc == 0u) { xcd_barrier_complete(bar, b.x, nloc, nx); b.st[0] = nloc; b.st[1] = nx; }
    const unsigned old = xb_add(&bar[XB_XSUB(b.x)], 1u);
    const unsigned gen = old / nloc;
    if (old + 1u == (gen + 1u) * nloc) {
      __builtin_amdgcn_fence(__ATOMIC_RELEASE, "agent");
      asm volatile("s_waitcnt vmcnt(0)" ::: "memory");
      const unsigned og = xb_add(&bar[XB_TOP], 1u);
      const unsigned tg = og / nx;
      if (og + 1u == (tg + 1u) * nx) xb_add(&bar[XB_TOPGEN], 1u);
      else XB_SPIN(xb_ld(&bar[XB_TOPGEN]) == tg, bar);
      __builtin_amdgcn_fence(__ATOMIC_ACQUIRE, "agent");
      xb_add(&bar[XB_XGEN(b.x)], 1u);
      asm volatile("s_waitcnt vmcnt(0)" ::: "memory");
    } else {
      XB_SPIN(xb_ld(&bar[XB_XGEN(b.x)]) == gen, bar);
      __builtin_amdgcn_fence(__ATOMIC_ACQUIRE, "agent");
      asm volatile("s_waitcnt vmcnt(0)" ::: "memory");
    }
  }
  __syncthreads();
}

__global__ void __launch_bounds__(NT) fwd_megakernel(Params P0) {
  cg::grid_group grid = cg::this_grid();
  __shared__ __attribute__((aligned(16))) char smem[157952];
  const int tid = threadIdx.x;
  char* ws = P0.ws;
  int* ctrl = (int*)(ws + OFF_CTRL);
  if (blockIdx.x == 0 && tid < 64) ctrl[tid] = 0;
  if (blockIdx.x == 0) for (int i = tid; i < XCD_BAR_WORDS; i += NT) ((unsigned*)(ws + OFF_XBAR))[i] = 0u;
  if (tid < 4) ((unsigned*)(smem + 157712))[tid] = 0u;
  if (blockIdx.x == 0 && tid == 0) *(Params*)(ws + OFF_CTRL + 1024) = P0;
  bf16_t* Hb = (bf16_t*)(ws + OFF_H);
  for (int it = blockIdx.x; it < 192 + CV_T5; it += gridDim.x) { if (it < 192) mod_item(P0, it); else convert_item(P0, 0, it - 192, smem); }
  grid.sync();
  (void)xcd_barrier_post((unsigned*)(ws + OFF_XBAR), (volatile LAS unsigned*)(smem + 157712));
  const Params& P = *(const Params*)(ws + OFF_CTRL + 1024);
  rownorm_phase(P, P.x, nullptr, P.out, Hb, 0, 0, nullptr, 0, 1, 0, P.mix_pre, smem);
  xcd_barrier(ws, smem);
  for (int l = 0; l < 2; ++l) {
    { EpiProj epi{(bf16_t*)(ws + OFF_PROJ), (float*)(ws + OFF_AB)}; gemm_phase(Hb, 2048, (const bf16_t*)(ws + OFF_W + W_IN), 2048, 2048, 64, 22, smem, epi); }
    xcd_barrier(ws, smem);
    for (int it = blockIdx.x; it < 448; it += gridDim.x) {
      if (it < 192) mla_q_tile(P, it / 3, it % 3, smem);
      else mla_kv_tile(P, (it - 192) >> 2, (it - 192) & 3, smem);
    }
    for (int id = (blockIdx.x + 64) % gridDim.x; id < 2048; id += gridDim.x) gdn_prep_item(P, l, id >> 3, id & 7, smem);
    xcd_barrier(ws, smem);
    {
      int* sitem = (int*)(smem + 157696);
      for (;;) {
        if (tid == 0) *sitem = atomicAdd(ctrl + 16 * l, 1);
        __syncthreads(); const int item = *sitem; __syncthreads();
        if (item >= 16 + 512 + 256) break;
        if (item < 16) gdn_scan_item(P, l, item >> 1, item & 1, smem);
        else if (item < 528) { const int idx = item - 16; mla_attn_item(P, idx & 3, 127 - (idx >> 2), smem); }
        else { const int idx = item - 528; swa_item(P, l, idx >> 1, idx & 1, smem); }
      }
    }
    xcd_barrier(ws, smem);
    gdn_fix_phase(P);
    xcd_barrier(ws, smem);
    { EpiBf epi{(bf16_t*)(ws + OFF_MIXF), 2048}; gemm_phase(Hb, 2048, (const bf16_t*)(ws + OFF_W + W_OUT), 2048, 2048, 64, 8, smem, epi); }
    xcd_barrier(ws, smem);
    rownorm_phase(P, P.out, (const bf16_t*)(ws + OFF_MIXF), P.out, Hb, l, 2, P.mix_post + l * 2048, l, 4, 3, P.ffn_pre + l * 2048, smem);
    xcd_barrier(ws, smem);
    { EpiBf epi{(bf16_t*)(ws + OFF_BIG), DFF2}; gemm_phase(Hb, 2048, (const bf16_t*)(ws + OFF_W + W_UP), 2048, 2048, 64, 44, smem, epi); }
    xcd_barrier(ws, smem);
    ffn_act_phase(P, l);
    xcd_barrier(ws, smem);
    { EpiBf epi{(bf16_t*)(ws + OFF_Y), 2048}; gemm_phase((const bf16_t*)(ws + OFF_ACT), DFF, (const bf16_t*)(ws + OFF_W + W_DOWN), DFF, DFF, 64, 8, smem, epi); }
    xcd_barrier(ws, smem);
    if (l == 0) {
      for (int it = blockIdx.x; it < CV_T5; it += gridDim.x) convert_item(P, 1, it, smem);
      rownorm_phase(P, P.out, (const bf16_t*)(ws + OFF_Y), P.out, Hb, 0, 5, P.ffn_post, 1, 1, 0, P.mix_pre + 2048, smem);
      xcd_barrier(ws, smem);
    } else {
      rownorm_phase(P, P.out, (const bf16_t*)(ws + OFF_Y), P.out, nullptr, 1, 5, P.ffn_post + 2048, 1, 1, 0, nullptr, smem);
    }
  }
}

extern "C" void kernel_launch(void* const* d_in, const int* in_sizes, int n_in, void* d_out, int out_size, void* d_ws, size_t ws_size, hipStream_t stream) {
  static int grid_blocks = 0;
  if (!grid_blocks) {
    int dev = 0, cus = 0, per = 0;
    (void)hipGetDevice(&dev); (void)hipDeviceGetAttribute(&cus, hipDeviceAttributeMultiprocessorCount, dev);
    (void)hipOccupancyMaxActiveBlocksPerMultiprocessor(&per, fwd_megakernel, NT, 0);
    if (per > 1) per = 1;
    grid_blocks = cus * per; if (grid_blocks <= 0) grid_blocks = 256;
  }
  if (ws_size < OFF_END) { fprintf(stderr, "workspace too small: %zu < %zu\n", ws_size, (size_t)OFF_END); return; }
  Params p{};
  p.x = (const float*)d_in[0]; p.c = (const float*)d_in[1]; p.pos = (const int*)d_in[2];
  p.ada_w = (const float*)d_in[3]; p.ada_b = (const float*)d_in[4]; p.mix_pre = (const float*)d_in[5]; p.mix_post = (const float*)d_in[6];
  p.w_in = (const float*)d_in[7]; p.w_out = (const float*)d_in[8]; p.gdn_conv = (const float*)d_in[9]; p.gdn_a_log = (const float*)d_in[10];
  p.gdn_dt_bias = (const float*)d_in[11]; p.gdn_norm = (const float*)d_in[12]; p.mla_q_norm = (const float*)d_in[13]; p.mla_w_uq = (const float*)d_in[14];
  p.mla_kv_norm = (const float*)d_in[15]; p.mla_w_ukv = (const float*)d_in[16]; p.swa_sinks = (const float*)d_in[17]; p.ffn_pre = (const float*)d_in[18];
  p.ffn_post = (const float*)d_in[19]; p.ffn_w_up = (const float*)d_in[20]; p.ffn_conv = (const float*)d_in[21]; p.ffn_conv_b = (const float*)d_in[22];
  p.ffn_w_down = (const float*)d_in[23];
  p.out = (float*)d_out; p.ws = (char*)d_ws;
  void* args[] = {&p};
  hipError_t e = hipLaunchCooperativeKernel((void*)fwd_megakernel, dim3(grid_blocks), dim3(NT), args, 0, stream);
  if (e != hipSuccess) fprintf(stderr, "cooperative launch failed: %s (grid %d)\n", hipGetErrorString(e), grid_blocks);
}
```

```cpp
#include <hip/hip_runtime.h>
#include <hip/hip_cooperative_groups.h>
#include <cstdio>
#include <cstdint>
namespace cg = cooperative_groups;

#define DI __device__ __forceinline__
typedef unsigned short bf16_t;
typedef short bf16x8 __attribute__((ext_vector_type(8)));
typedef float f32x2 __attribute__((ext_vector_type(2)));
typedef float f32x4 __attribute__((ext_vector_type(4)));
typedef float f32x16 __attribute__((ext_vector_type(16)));
typedef unsigned u32x2 __attribute__((ext_vector_type(2)));
typedef unsigned u32x4 __attribute__((ext_vector_type(4)));
typedef __bf16 bf2_t __attribute__((ext_vector_type(2)));

constexpr int S_ = 16384, D_ = 2048, DINP = 5632, DFF = 5632, DFF2 = 11264;
constexpr int NT = 512;
constexpr float EPS = 1e-6f;
constexpr float LOG2E = 1.4426950408889634f;

constexpr size_t OFF_CTRL = 0;
constexpr size_t OFF_MODP = 4096;
constexpr size_t OFF_XBAR = OFF_MODP + (size_t)2 * 16 * 12288 * 4;
constexpr size_t OFF_W = 2097152;
static_assert(OFF_XBAR + 3456 * 4 <= OFF_W, "xbar");
constexpr size_t W_IN = 0, W_OUT = W_IN + (size_t)5632 * 2048 * 2, W_UP = W_OUT + (size_t)2048 * 2048 * 2,
                 W_DOWN = W_UP + (size_t)11264 * 2048 * 2, W_UQ = W_DOWN + (size_t)2048 * 5632 * 2,
                 W_UKV = W_UQ + (size_t)768 * 448 * 2, W_END = W_UKV + (size_t)1024 * 128 * 2;
constexpr size_t OFF_H = OFF_W + W_END;
constexpr size_t OFF_MIXF = OFF_H + (size_t)S_ * 2048 * 2;
constexpr size_t OFF_QRAW = OFF_MIXF;
constexpr size_t OFF_KMLA = OFF_QRAW + (size_t)S_ * 768 * 4;
constexpr size_t OFF_VT = OFF_KMLA + (size_t)4 * S_ * 192 * 2;
constexpr size_t OFF_BIG = OFF_MIXF + (size_t)S_ * 2048 * 4;
constexpr size_t OFF_PROJ = OFF_BIG;
constexpr size_t OFF_WP = OFF_PROJ + (size_t)S_ * DINP * 2;
constexpr size_t OFF_QD = OFF_WP + (size_t)S_ * 1024 * 2;
constexpr size_t OFF_KT = OFF_QD + (size_t)S_ * 1024 * 2;
constexpr size_t OFF_ZT = OFF_KT + (size_t)S_ * 1024 * 2;
constexpr size_t OFF_QK = OFF_ZT + (size_t)S_ * 1024 * 2;
constexpr size_t OFF_AB = OFF_QK + (size_t)S_ * 512 * 2;
constexpr size_t OFF_GTOT = OFF_AB + (size_t)S_ * 16 * 4;
constexpr size_t OFF_Y = OFF_BIG;
constexpr size_t OFF_ACT = OFF_H;
constexpr size_t OFF_UT = OFF_BIG + (size_t)S_ * DFF2 * 2;
constexpr size_t OFF_END = OFF_UT + (size_t)S_ * 1024 * 4;
static_assert(OFF_GTOT + 8192 <= OFF_UT, "overlay");
static_assert(OFF_VT + (size_t)4 * 128 * S_ * 2 <= OFF_BIG, "overlay2");

constexpr int C_AQ = 0, C_AK = 1024, C_AV = 2048, C_AZ = 3072, C_AA = 4096, C_BCQ = 4112, C_BCKV = 4560,
              C_BKR = 4688, C_CQ = 4752, C_CK = 5264, C_CV = 5392;

__constant__ double kInvFreq2Pi[32] = {
    0.15915494309189535, 0.11934937021124886, 0.08949940160889101, 0.06711508300522726, 0.050329212104487035, 0.03774158471741977,
    0.0283021958306234, 0.02122365276477766, 0.015915494309189534, 0.011934937021124886, 0.008949940160889102, 0.006711508300522725,
    0.005032921210448704, 0.003774158471741977, 0.00283021958306234, 0.0021223652764777662, 0.0015915494309189536, 0.0011934937021124885,
    0.0008949940160889102, 0.0006711508300522726, 0.0005032921210448703, 0.00037741584717419774, 0.00028302195830623395, 0.0002122365276477766,
    0.00015915494309189535, 0.00011934937021124886, 8.949940160889102e-05, 6.711508300522725e-05, 5.0329212104487035e-05, 3.774158471741978e-05,
    2.8302195830623396e-05, 2.122365276477766e-05};

struct Params {
  const float* x; const float* c; const int* pos;
  const float *ada_w, *ada_b, *mix_pre, *mix_post, *w_in, *w_out, *gdn_conv, *gdn_a_log, *gdn_dt_bias, *gdn_norm, *mla_q_norm, *mla_w_uq,
      *mla_kv_norm, *mla_w_ukv, *swa_sinks, *ffn_pre, *ffn_post, *ffn_w_up, *ffn_conv, *ffn_conv_b, *ffn_w_down;
  float* out; char* ws;
};

DI unsigned pack2(float lo, float hi) { f32x2 v = {lo, hi}; bf2_t b = __builtin_convertvector(v, bf2_t); return __builtin_bit_cast(unsigned, b); }
DI bf16_t f2bf(float x) { return (bf16_t)(pack2(x, 0.f) & 0xffffu); }
DI float bflo(unsigned u) { return __uint_as_float(u << 16); }
DI float bfhi(unsigned u) { return __uint_as_float(u & 0xffff0000u); }
DI void unpack8(const u32x4& v, float* f) { f[0] = bflo(v.x); f[1] = bfhi(v.x); f[2] = bflo(v.y); f[3] = bfhi(v.y); f[4] = bflo(v.z); f[5] = bfhi(v.z); f[6] = bflo(v.w); f[7] = bfhi(v.w); }
DI bf16x8 pack8(float a0, float a1, float a2, float a3, float a4, float a5, float a6, float a7) {
  u32x4 p = {pack2(a0, a1), pack2(a2, a3), pack2(a4, a5), pack2(a6, a7)}; return __builtin_bit_cast(bf16x8, p); }
DI float silu_f(float x) { return x * __builtin_amdgcn_rcpf(1.f + __expf(-x)); }
DI float wave_sum(float v) { v += __shfl_xor(v, 32); v += __shfl_xor(v, 16); v += __shfl_xor(v, 8); v += __shfl_xor(v, 4); v += __shfl_xor(v, 2); v += __shfl_xor(v, 1); return v; }
DI int opaque_tid() { int t = threadIdx.x; asm volatile("" : "+v"(t)); return t; }
DI int crow(int r, int h) { return (r & 3) + 8 * (r >> 2) + 4 * h; }
DI int perm32(int k) { return 8 * ((k >> 2) & 3) + 4 * (k >> 4) + (k & 3); }
#define MFMA32(a, b, c) __builtin_amdgcn_mfma_f32_32x32x16_bf16((a), (b), (c), 0, 0, 0)
#define MFMA16(a, b, c) __builtin_amdgcn_mfma_f32_16x16x32_bf16((a), (b), (c), 0, 0, 0)

template <class Epi>
DI void gemm_tile(const bf16_t* __restrict__ A, int lda, const bf16_t* __restrict__ Bt, int ldb, int K, int m0, int n0, char* smem, const Epi& epi) {
  const int tid = opaque_tid(), lane = tid & 63, w = tid >> 6, wm = w >> 2, wn = w & 3, lq = lane & 31, h = lane >> 5;
  f32x16 acc[2][4];
#pragma unroll
  for (int i = 0; i < 2; ++i)
#pragma unroll
    for (int j = 0; j < 4; ++j)
#pragma unroll
      for (int r = 0; r < 16; ++r) acc[i][j][r] = 0.f;
  const int r0 = tid >> 3, c0 = tid & 7;
  const bf16_t* ag = A + (size_t)(m0 + r0) * lda + c0 * 8;
  const bf16_t* bg = Bt + (size_t)(n0 + r0) * ldb + c0 * 8;
  const int wofs = r0 * 128 + ((c0 ^ ((r0 >> 1) & 7)) << 4);
  char* sA = smem; char* sB = smem + 65536;
  u32x4 ra0[4], rb0[4], ra1[4], rb1[4];
  const int nk = K >> 6, swz = (lane >> 1) & 7;
  const int aoff = (64 * wn + lq) * 128, boff = (128 * wm + lq) * 128;
#define GLOAD(RA, RB, KT) { _Pragma("unroll") for (int i = 0; i < 4; ++i) { RA[i] = *(const u32x4*)(ag + (size_t)(KT) * 64 + (size_t)i * 64 * lda); RB[i] = *(const u32x4*)(bg + (size_t)(KT) * 64 + (size_t)i * 64 * ldb); } }
#define LWRITE(RA, RB, ST) { _Pragma("unroll") for (int i = 0; i < 4; ++i) { *(u32x4*)(sA + (ST) * 32768 + wofs + i * 8192) = RA[i]; *(u32x4*)(sB + (ST) * 32768 + wofs + i * 8192) = RB[i]; } }
#define KSTEP(ST, RA, RB, KN) { const char* cA = sA + (ST) * 32768; const char* cB = sB + (ST) * 32768; char* dA = sA + (1 - (ST)) * 32768; char* dB = sB + (1 - (ST)) * 32768; \
    const bf16_t* agn = ag + (size_t)(KN) * 64; const bf16_t* bgn = bg + (size_t)(KN) * 64; \
    _Pragma("unroll") for (int s = 0; s < 4; ++s) { const int co = (((2 * s + h) ^ swz) << 4); bf16x8 fa[2], fb[4]; \
      _Pragma("unroll") for (int ni = 0; ni < 2; ++ni) fa[ni] = *(const bf16x8*)(cB + aoff + ni * 4096 + co); \
      _Pragma("unroll") for (int mi = 0; mi < 4; ++mi) fb[mi] = *(const bf16x8*)(cA + boff + mi * 4096 + co); \
      *(u32x4*)(dA + wofs + s * 8192) = RA[s]; *(u32x4*)(dB + wofs + s * 8192) = RB[s]; \
      RA[s] = *(const u32x4*)(agn + (size_t)s * 64 * lda); RB[s] = *(const u32x4*)(bgn + (size_t)s * 64 * ldb); \
      _Pragma("unroll") for (int ni = 0; ni < 2; ++ni) _Pragma("unroll") for (int mi = 0; mi < 4; ++mi) acc[ni][mi] = MFMA32(fa[ni], fb[mi], acc[ni][mi]); \
      __builtin_amdgcn_sched_barrier(0); } }
  const int kl = nk - 1;
  GLOAD(ra0, rb0, 0);
  GLOAD(ra1, rb1, (1 < kl ? 1 : kl));
  LWRITE(ra0, rb0, 0);
  GLOAD(ra0, rb0, (2 < kl ? 2 : kl));
  __syncthreads();
  for (int kt = 0; kt < nk; kt += 2) {
    KSTEP(0, ra1, rb1, (kt + 3 < kl ? kt + 3 : kl));
    __syncthreads();
    if (kt + 1 < nk) {
      KSTEP(1, ra0, rb0, (kt + 4 < kl ? kt + 4 : kl));
      __syncthreads();
    }
  }
#undef GLOAD
#undef LWRITE
#undef KSTEP
#pragma unroll
  for (int ni = 0; ni < 2; ++ni)
#pragma unroll
    for (int mi = 0; mi < 4; ++mi)
#pragma unroll
      for (int rg = 0; rg < 4; ++rg) {
        const int m = m0 + 128 * wm + 32 * mi + lq, n = n0 + 64 * wn + 32 * ni + 8 * rg + 4 * h;
        epi(m, n, acc[ni][mi][4 * rg], acc[ni][mi][4 * rg + 1], acc[ni][mi][4 * rg + 2], acc[ni][mi][4 * rg + 3]);
      }
}

template <class Epi>
DI void gemm_tile_s(const bf16_t* __restrict__ A, int lda, const bf16_t* __restrict__ Bt, int ldb, int K, int m0, int n0, char* smem, const Epi& epi) {
  const int tid = opaque_tid(), lane = tid & 63, w = tid >> 6, wm = w >> 2, wn = w & 3, lq = lane & 31, h = lane >> 5;
  f32x16 acc[2][4];
#pragma unroll
  for (int i = 0; i < 2; ++i)
#pragma unroll
    for (int j = 0; j < 4; ++j)
#pragma unroll
      for (int r = 0; r < 16; ++r) acc[i][j][r] = 0.f;
  const int r0 = tid >> 3, c0 = tid & 7;
  const bf16_t* ag = A + (size_t)(m0 + r0) * lda + c0 * 8;
  const bf16_t* bg = Bt + (size_t)(n0 + r0) * ldb + c0 * 8;
  const int wofs = r0 * 128 + ((c0 ^ ((r0 >> 1) & 7)) << 4);
  char* sA = smem; char* sB = smem + 32768;
  u32x4 ra[4], rb[4];
#pragma unroll
  for (int i = 0; i < 4; ++i) { ra[i] = *(const u32x4*)(ag + (size_t)i * 64 * lda); rb[i] = *(const u32x4*)(bg + (size_t)i * 64 * ldb); }
#pragma unroll
  for (int i = 0; i < 4; ++i) { *(u32x4*)(sA + wofs + i * 8192) = ra[i]; *(u32x4*)(sB + wofs + i * 8192) = rb[i]; }
  __syncthreads();
  const int nk = K >> 6, swz = (lane >> 1) & 7;
  const int aoff = (64 * wn + lq) * 128, boff = (128 * wm + lq) * 128;
  for (int kt = 0; kt < nk; ++kt) {
    const char* cA = sA + (kt & 1) * 65536; const char* cB = sB + (kt & 1) * 65536;
    const bool more = (kt + 1 < nk);
    if (more) { ag += 64; bg += 64;
#pragma unroll
      for (int i = 0; i < 4; ++i) { ra[i] = *(const u32x4*)(ag + (size_t)i * 64 * lda); rb[i] = *(const u32x4*)(bg + (size_t)i * 64 * ldb); } }
#pragma unroll
    for (int s = 0; s < 4; ++s) {
      const int co = (((2 * s + h) ^ swz) << 4);
      bf16x8 fa[2], fb[4];
#pragma unroll
      for (int ni = 0; ni < 2; ++ni) fa[ni] = *(const bf16x8*)(cB + aoff + ni * 4096 + co);
#pragma unroll
      for (int mi = 0; mi < 4; ++mi) fb[mi] = *(const bf16x8*)(cA + boff + mi * 4096 + co);
#pragma unroll
      for (int ni = 0; ni < 2; ++ni)
#pragma unroll
        for (int mi = 0; mi < 4; ++mi) acc[ni][mi] = MFMA32(fa[ni], fb[mi], acc[ni][mi]);
    }
    if (more) { char* dA = sA + ((kt + 1) & 1) * 65536; char* dB = sB + ((kt + 1) & 1) * 65536;
#pragma unroll
      for (int i = 0; i < 4; ++i) { *(u32x4*)(dA + wofs + i * 8192) = ra[i]; *(u32x4*)(dB + wofs + i * 8192) = rb[i]; } }
    __syncthreads();
  }
#pragma unroll
  for (int ni = 0; ni < 2; ++ni)
#pragma unroll
    for (int mi = 0; mi < 4; ++mi)
#pragma unroll
      for (int rg = 0; rg < 4; ++rg) {
        const int m = m0 + 128 * wm + 32 * mi + lq, n = n0 + 64 * wn + 32 * ni + 8 * rg + 4 * h;
        epi(m, n, acc[ni][mi][4 * rg], acc[ni][mi][4 * rg + 1], acc[ni][mi][4 * rg + 2], acc[ni][mi][4 * rg + 3]);
      }
}

DI void tile_coord(int t, int npn, int& pm, int& pn) { const int g = t / (16 * npn), r = t % (16 * npn); pn = r >> 4; pm = g * 16 + (r & 15); }

struct EpiProj { bf16_t* proj; float* ab;
  DI void operator()(int m, int n, float v0, float v1, float v2, float v3) const {
    u32x2 pk = {pack2(v0, v1), pack2(v2, v3)}; *(u32x2*)(proj + (size_t)m * DINP + n) = pk;
    if (n >= C_AA && n < C_AA + 16) { f32x4 v = {v0, v1, v2, v3}; *(f32x4*)(ab + (size_t)m * 16 + (n - C_AA)) = v; } } };
struct EpiF32 { float* out; int ldc;
  DI void operator()(int m, int n, float v0, float v1, float v2, float v3) const { f32x4 v = {v0, v1, v2, v3}; *(f32x4*)(out + (size_t)m * ldc + n) = v; } };
struct EpiBf { bf16_t* out; int ldc;
  DI void operator()(int m, int n, float v0, float v1, float v2, float v3) const { u32x2 pk = {pack2(v0, v1), pack2(v2, v3)}; *(u32x2*)(out + (size_t)m * ldc + n) = pk; } };
struct EpiMlaQ { float* qraw; const float* rs; int m0;
  DI void operator()(int m, int n, float v0, float v1, float v2, float v3) const { const float r = rs[m - m0]; f32x4 v = {v0 * r, v1 * r, v2 * r, v3 * r}; *(f32x4*)(qraw + (size_t)m * 768 + n) = v; } };
struct EpiMlaKV { bf16_t* kmla; bf16_t* vt; const float* rs; int m0;
  DI void operator()(int m, int n, float v0, float v1, float v2, float v3) const {
    const float r = rs[m - m0]; const int hd = n >> 8, wi = n & 255;
    if (wi < 128) { u32x2 pk = {pack2(v0 * r, v1 * r), pack2(v2 * r, v3 * r)}; *(u32x2*)(kmla + ((size_t)hd * S_ + m) * 192 + wi) = pk; }
    else { bf16_t* p = vt + ((size_t)hd * 128 + (wi - 128)) * S_ + m; p[0] = f2bf(v0 * r); p[S_] = f2bf(v1 * r); p[2 * (size_t)S_] = f2bf(v2 * r); p[3 * (size_t)S_] = f2bf(v3 * r); } } };

template <class Epi>
DI void gemm_phase(const bf16_t* A, int lda, const bf16_t* Bt, int ldb, int K, int npm, int npn, char* smem, const Epi& epi) {
  if (gridDim.x == 256 && npm == 64) {
    const int b = blockIdx.x, pm = 8 * (b & 7) + ((b >> 3) & 7), pj = b >> 6;
    for (int pn = pj; pn < npn; pn += 4) gemm_tile(A, lda, Bt, ldb, K, pm * 256, pn * 256, smem, epi);
  } else {
    for (int t = blockIdx.x; t < npm * npn; t += gridDim.x) { int pm, pn; tile_coord(t, npn, pm, pn); gemm_tile(A, lda, Bt, ldb, K, pm * 256, pn * 256, smem, epi); }
  }
}

DI void mod_item(const Params& P, int item) {
  const int tid = opaque_tid(); const int l = item / 96, r = item % 96, ks = r / 6, nc = r % 6;
  const int n = nc * 2048 + tid * 4;
  const float* wp = P.ada_w + ((size_t)l * 2048 + ks * 128) * 12288 + n;
  f32x4 acc = {0.f, 0.f, 0.f, 0.f};
#pragma unroll 8
  for (int k = 0; k < 128; ++k) { const float cv = P.c[ks * 128 + k]; const float ca = silu_f(cv); const f32x4 wv = *(const f32x4*)(wp + (size_t)k * 12288); acc += wv * ca; }
  float* modp = (float*)(P.ws + OFF_MODP);
  *(f32x4*)(modp + ((size_t)l * 16 + ks) * 12288 + n) = acc;
}
DI void convert_tile(const float* __restrict__ src, int K, int N, bf16_t* __restrict__ dst, int tk, int tn, const float* rowscale, char* smem) {
  float* sm = (float*)smem; const int tid = opaque_tid(); const int k0 = tk * 64, n0 = tn * 256;
  { const int r = tid >> 6, c4 = tid & 63; const int n = n0 + 4 * c4;
    f32x4 v[8];
#pragma unroll
    for (int i = 0; i < 8; ++i) { v[i] = (f32x4){0.f, 0.f, 0.f, 0.f}; if (n < N) v[i] = *(const f32x4*)(src + (size_t)(k0 + r + 8 * i) * N + n); }
#pragma unroll
    for (int i = 0; i < 8; ++i) { const int kk = r + 8 * i; if (rowscale) v[i] *= rowscale[k0 + kk];
      sm[kk * 257 + 4 * c4 + 0] = v[i].x; sm[kk * 257 + 4 * c4 + 1] = v[i].y; sm[kk * 257 + 4 * c4 + 2] = v[i].z; sm[kk * 257 + 4 * c4 + 3] = v[i].w; } }
  __syncthreads();
  { const int n = tid >> 1, kh = tid & 1;
#pragma unroll
    for (int j = 0; j < 4; ++j) { float f[8];
#pragma unroll
      for (int i = 0; i < 8; ++i) f[i] = sm[(32 * kh + 8 * j + i) * 257 + n];
      u32x4 pk = {pack2(f[0], f[1]), pack2(f[2], f[3]), pack2(f[4], f[5]), pack2(f[6], f[7])};
      *(u32x4*)(dst + (size_t)(n0 + n) * K + k0 + 32 * kh + 8 * j) = pk; } }
  __syncthreads();
}
constexpr int CV_T0 = 32 * 22, CV_T1 = CV_T0 + 32 * 8, CV_T2 = CV_T1 + 32 * 44, CV_T3 = CV_T2 + 88 * 8, CV_T4 = CV_T3 + 7 * 3, CV_T5 = CV_T4 + 2 * 4;
DI void convert_item(const Params& P, int l, int it, char* smem) {
  char* wb = P.ws + OFF_W;
  if (it < CV_T0) convert_tile(P.w_in + (size_t)l * 2048 * 5520, 2048, 5520, (bf16_t*)(wb + W_IN), it / 22, it % 22, nullptr, smem);
  else if (it < CV_T1) { it -= CV_T0; convert_tile(P.w_out + (size_t)l * 2048 * 2048, 2048, 2048, (bf16_t*)(wb + W_OUT), it / 8, it % 8, nullptr, smem); }
  else if (it < CV_T2) { it -= CV_T1; convert_tile(P.ffn_w_up + (size_t)l * 2048 * 11264, 2048, 11264, (bf16_t*)(wb + W_UP), it / 44, it % 44, nullptr, smem); }
  else if (it < CV_T3) { it -= CV_T2; convert_tile(P.ffn_w_down + (size_t)l * 5632 * 2048, 5632, 2048, (bf16_t*)(wb + W_DOWN), it / 8, it % 8, nullptr, smem); }
  else if (it < CV_T4) { it -= CV_T3; convert_tile(P.mla_w_uq + (size_t)l * 448 * 768, 448, 768, (bf16_t*)(wb + W_UQ), it / 3, it % 3, P.mla_q_norm + l * 448, smem); }
  else { it -= CV_T4; convert_tile(P.mla_w_ukv + (size_t)l * 128 * 1024, 128, 1024, (bf16_t*)(wb + W_UKV), it / 4, it % 4, P.mla_kv_norm + l * 128, smem); }
}

DI float mod_val(const float* modp_l, const float* ada_b_l, int idx) { float s = ada_b_l[idx];
#pragma unroll
  for (int k = 0; k < 16; ++k) s += modp_l[(size_t)k * 12288 + idx]; return s; }
DI void rownorm_phase(const Params& P, const float* xin, const bf16_t* yin, float* xout, bf16_t* hout, int lg, int gate_idx, const float* w_post,
                      int lh, int scale_idx, int shift_idx, const float* w_pre, char* smem) {
  float* A1 = (float*)smem; float* A2 = A1 + 2048; float* B2 = A2 + 2048;
  const int tid = opaque_tid(), lane = tid & 63, w = tid >> 6;
  const float* modp = (const float*)(P.ws + OFF_MODP);
  for (int cidx = tid; cidx < 2048; cidx += NT) {
    if (yin) A1[cidx] = mod_val(modp + (size_t)lg * 16 * 12288, P.ada_b + (size_t)lg * 12288, gate_idx * 2048 + cidx) * w_post[cidx];
    if (hout) { A2[cidx] = w_pre[cidx] * (1.f + mod_val(modp + (size_t)lh * 16 * 12288, P.ada_b + (size_t)lh * 12288, scale_idx * 2048 + cidx));
      B2[cidx] = mod_val(modp + (size_t)lh * 16 * 12288, P.ada_b + (size_t)lh * 12288, shift_idx * 2048 + cidx); }
  }
  __syncthreads();
  for (int row = blockIdx.x * 8 + w; row < S_; row += gridDim.x * 8) {
    f32x4 xv[8];
#pragma unroll
    for (int j = 0; j < 8; ++j) xv[j] = *(const f32x4*)(xin + (size_t)row * 2048 + (j * 64 + lane) * 4);
    if (yin) {
      f32x4 yv[8]; float ss = 0.f;
#pragma unroll
      for (int j = 0; j < 8; ++j) { const u32x2 yb = *(const u32x2*)(yin + (size_t)row * 2048 + (j * 64 + lane) * 4); yv[j] = (f32x4){bflo(yb.x), bfhi(yb.x), bflo(yb.y), bfhi(yb.y)};
        ss += yv[j].x * yv[j].x + yv[j].y * yv[j].y + yv[j].z * yv[j].z + yv[j].w * yv[j].w; }
      ss = wave_sum(ss); const float r = rsqrtf(ss * (1.f / 2048.f) + EPS);
#pragma unroll
      for (int j = 0; j < 8; ++j) { const f32x4 a = *(const f32x4*)(A1 + (j * 64 + lane) * 4); xv[j] += a * (yv[j] * r); }
    }
    if (yin || xout != xin) {
#pragma unroll
      for (int j = 0; j < 8; ++j) *(f32x4*)(xout + (size_t)row * 2048 + (j * 64 + lane) * 4) = xv[j];
    }
    if (hout) {
      float ss = 0.f;
#pragma unroll
      for (int j = 0; j < 8; ++j) ss += xv[j].x * xv[j].x + xv[j].y * xv[j].y + xv[j].z * xv[j].z + xv[j].w * xv[j].w;
      ss = wave_sum(ss); const float r = rsqrtf(ss * (1.f / 2048.f) + EPS);
#pragma unroll
      for (int j = 0; j < 8; ++j) { const f32x4 a = *(const f32x4*)(A2 + (j * 64 + lane) * 4), b = *(const f32x4*)(B2 + (j * 64 + lane) * 4);
        const f32x4 hv = xv[j] * r * a + b; u32x2 pk = {pack2(hv.x, hv.y), pack2(hv.z, hv.w)};
        *(u32x2*)(hout + (size_t)row * 2048 + (j * 64 + lane) * 4) = pk; }
    }
  }
  __syncthreads();
}

DI void mla_q_tile(const Params& P, int pm, int pn, char* smem) {
  const bf16_t* proj = (const bf16_t*)(P.ws + OFF_PROJ); const int tid = opaque_tid(), m0 = pm * 256; float* rs = (float*)(smem + 131072);
  { const int row = tid >> 1, half = tid & 1; const bf16_t* p = proj + (size_t)(m0 + row) * DINP + C_BCQ + half * 224; float ss = 0.f;
    for (int i = 0; i < 28; ++i) { const u32x4 v = *(const u32x4*)(p + i * 8); float f[8]; unpack8(v, f);
#pragma unroll
      for (int e = 0; e < 8; ++e) ss += f[e] * f[e]; }
    ss += __shfl_xor(ss, 1); if (half == 0) rs[row] = rsqrtf(ss * (1.f / 448.f) + EPS); }
  EpiMlaQ epi{(float*)(P.ws + OFF_QRAW), rs, m0};
  gemm_tile_s(proj + C_BCQ, DINP, (const bf16_t*)(P.ws + OFF_W + W_UQ), 448, 448, m0, pn * 256, smem, epi);
  __syncthreads();
}
DI void mla_kv_tile(const Params& P, int pm, int pn, char* smem) {
  const bf16_t* proj = (const bf16_t*)(P.ws + OFF_PROJ); const int tid = opaque_tid(), m0 = pm * 256; float* rs = (float*)(smem + 131072);
  { const int row = tid >> 1, half = tid & 1; const bf16_t* p = proj + (size_t)(m0 + row) * DINP + C_BCKV + half * 64; float ss = 0.f;
#pragma unroll
    for (int i = 0; i < 8; ++i) { const u32x4 v = *(const u32x4*)(p + i * 8); float f[8]; unpack8(v, f);
#pragma unroll
      for (int e = 0; e < 8; ++e) ss += f[e] * f[e]; }
    ss += __shfl_xor(ss, 1); if (half == 0) rs[row] = rsqrtf(ss * (1.f / 128.f) + EPS); }
  bf16_t* kmla = (bf16_t*)(P.ws + OFF_KMLA);
  EpiMlaKV epi{kmla, (bf16_t*)(P.ws + OFF_VT), rs, m0};
  gemm_tile_s(proj + C_BCKV, DINP, (const bf16_t*)(P.ws + OFF_W + W_UKV), 128, 128, m0, pn * 256, smem, epi);
  if (pn == 0) {
    for (int i = 0; i < 16; ++i) { const int idx = tid + NT * i, row = idx >> 5, pi = idx & 31, m = m0 + row;
      const float x1 = bflo((unsigned)proj[(size_t)m * DINP + C_BKR + pi]), x2 = bflo((unsigned)proj[(size_t)m * DINP + C_BKR + 32 + pi]);
      double fr = (double)P.pos[m] * kInvFreq2Pi[pi]; fr -= floor(fr); const float ff = (float)fr;
      const float sn = __builtin_amdgcn_sinf(ff), cs = __builtin_amdgcn_cosf(ff);
      const bf16_t o1 = f2bf(x1 * cs - x2 * sn), o2 = f2bf(x2 * cs + x1 * sn);
#pragma unroll
      for (int hd = 0; hd < 4; ++hd) { bf16_t* kp = kmla + ((size_t)hd * S_ + m) * 192 + 128; kp[pi] = o1; kp[32 + pi] = o2; } }
  }
  __syncthreads();
}

DI void gdn_prep_item(const Params& P, int l, int n, int hh, char* smem) {
  const int tid = opaque_tid(), lane = tid & 63, w = tid >> 6, lq = lane & 31, h = lane >> 5;
  const bf16_t* proj = (const bf16_t*)(P.ws + OFF_PROJ); const float* ab = (const float*)(P.ws + OFF_AB);
  char* kb16 = smem; char* qb16 = smem + 17408;
  float* kf = (float*)(smem + 34816); float* vf = kf + 8192; float* Lm = vf + 8192; float* gcs = Lm + 4096;
  const size_t tile = (size_t)hh * 256 + n; const int t0 = n * 64;
  bf16_t* Wp = (bf16_t*)(P.ws + OFF_WP) + tile * 8192; bf16_t* Qd = (bf16_t*)(P.ws + OFF_QD) + tile * 8192;
  bf16_t* Kt = (bf16_t*)(P.ws + OFF_KT) + tile * 8192; bf16_t* Zt = (bf16_t*)(P.ws + OFF_ZT) + tile * 8192;
  bf16_t* QK = (bf16_t*)(P.ws + OFF_QK) + tile * 4096; bf16_t* Ut = (bf16_t*)(P.ws + OFF_UT) + tile * 8192;
  if (w == 0) {
    const int t = lane; const float a_raw = ab[(size_t)(t0 + t) * 16 + hh], b_raw = ab[(size_t)(t0 + t) * 16 + 8 + hh];
    const float Aa = __expf(P.gdn_a_log[l * 8 + hh]); const float xb = a_raw + P.gdn_dt_bias[l * 8 + hh];
    const float ex = __expf(fminf(xb, 20.f));
    const float sp = xb > 20.f ? xb : (ex < 0.01f ? ex * (1.f - ex * (0.5f - ex * (1.f / 3.f))) : __logf(1.f + ex));
    float g = -Aa * sp;
#pragma unroll
    for (int d = 1; d < 64; d <<= 1) { const float v = __shfl_up(g, d); if (lane >= d) g += v; }
    const float bt = __builtin_amdgcn_rcpf(1.f + __expf(-b_raw)), eg = __expf(g); gcs[t] = g; gcs[64 + t] = bt; gcs[128 + t] = eg; gcs[192 + t] = bt * eg;
    if (t == 63) ((float*)(P.ws + OFF_GTOT))[tile] = eg;
  }
  __syncthreads();
  {
    const int t = tid >> 3, part = tid & 7, tabs = t0 + t;
    const float gct = gcs[t], egct = gcs[128 + t], ktl = __expf(gcs[63] - gct);
    const int pjt = 32 * (t >> 5) + perm32(t & 31);
#pragma unroll
    for (int X = 0; X < 3; ++X) {
      const int cb = X * 1024 + hh * 128 + part * 16;
      float y[16];
#pragma unroll
      for (int e = 0; e < 16; ++e) y[e] = 0.f;
      u32x4 pv[4][2]; f32x4 wv[4][4];
#pragma unroll
      for (int j = 0; j < 4; ++j) { const int row = tabs - 3 + j, rr = row < 0 ? 0 : row;
        pv[j][0] = *(const u32x4*)(proj + (size_t)rr * DINP + cb); pv[j][1] = *(const u32x4*)(proj + (size_t)rr * DINP + cb + 8);
        const float* cw = P.gdn_conv + ((size_t)l * 4 + j) * 3072 + cb;
#pragma unroll
        for (int e4 = 0; e4 < 4; ++e4) wv[j][e4] = *(const f32x4*)(cw + 4 * e4); }
      __builtin_amdgcn_sched_barrier(0);
#pragma unroll
      for (int j = 0; j < 4; ++j) { const float msk = (tabs - 3 + j) >= 0 ? 1.f : 0.f;
        float xv[16]; unpack8(pv[j][0], xv); unpack8(pv[j][1], xv + 8);
#pragma unroll
        for (int e4 = 0; e4 < 4; ++e4) { const f32x4 wm = wv[j][e4] * msk; y[4 * e4] += wm.x * xv[4 * e4]; y[4 * e4 + 1] += wm.y * xv[4 * e4 + 1]; y[4 * e4 + 2] += wm.z * xv[4 * e4 + 2]; y[4 * e4 + 3] += wm.w * xv[4 * e4 + 3]; } }
#pragma unroll
      for (int e = 0; e < 16; ++e) y[e] = silu_f(y[e]);
      if (X < 2) { float ss = 0.f;
#pragma unroll
        for (int e = 0; e < 16; ++e) ss += y[e] * y[e];
        ss += __shfl_xor(ss, 1); ss += __shfl_xor(ss, 2); ss += __shfl_xor(ss, 4);
        const float rn = rsqrtf(ss + EPS) * (X == 0 ? 0.08838834764831845f : 1.f);
#pragma unroll
        for (int e = 0; e < 16; ++e) y[e] *= rn; }
      if (X == 0) {
        u32x4 p0 = {pack2(y[0], y[1]), pack2(y[2], y[3]), pack2(y[4], y[5]), pack2(y[6], y[7])}, p1 = {pack2(y[8], y[9]), pack2(y[10], y[11]), pack2(y[12], y[13]), pack2(y[14], y[15])};
        *(u32x4*)(qb16 + t * 272 + part * 32) = p0; *(u32x4*)(qb16 + t * 272 + part * 32 + 16) = p1;
#pragma unroll
        for (int b = 0; b < 4; ++b) { u32x2 pk = {pack2(y[4 * b] * egct, y[4 * b + 1] * egct), pack2(y[4 * b + 2] * egct, y[4 * b + 3] * egct)};
          *(u32x2*)(Qd + t * 128 + 32 * (part >> 1) + 8 * b + 4 * (part & 1)) = pk; }
      } else if (X == 1) {
        u32x4 p0 = {pack2(y[0], y[1]), pack2(y[2], y[3]), pack2(y[4], y[5]), pack2(y[6], y[7])}, p1 = {pack2(y[8], y[9]), pack2(y[10], y[11]), pack2(y[12], y[13]), pack2(y[14], y[15])};
        *(u32x4*)(kb16 + t * 272 + part * 32) = p0; *(u32x4*)(kb16 + t * 272 + part * 32 + 16) = p1;
#pragma unroll
        for (int e4 = 0; e4 < 4; ++e4) { f32x4 v = {y[4 * e4], y[4 * e4 + 1], y[4 * e4 + 2], y[4 * e4 + 3]}; *(f32x4*)(kf + t * 128 + part * 16 + 4 * e4) = v; }
#pragma unroll
        for (int e = 0; e < 16; ++e) Kt[(part * 16 + e) * 64 + pjt] = f2bf(y[e] * ktl);
      } else {
#pragma unroll
        for (int e4 = 0; e4 < 4; ++e4) { f32x4 v = {y[4 * e4], y[4 * e4 + 1], y[4 * e4 + 2], y[4 * e4 + 3]}; *(f32x4*)(vf + t * 128 + part * 16 + 4 * e4) = v; }
      }
    }
    { const int cb = C_AZ + hh * 128 + part * 16; const u32x4 v0 = *(const u32x4*)(proj + (size_t)tabs * DINP + cb), v1 = *(const u32x4*)(proj + (size_t)tabs * DINP + cb + 8);
      float zv[16]; unpack8(v0, zv); unpack8(v1, zv + 8);
#pragma unroll
      for (int e = 0; e < 16; ++e) Zt[(part * 16 + e) * 64 + t] = f2bf(silu_f(zv[e])); }
  }
  __syncthreads();
  {
    const int which = w >> 2, ti = (w >> 1) & 1, tj = w & 1; const char* Ab = which ? qb16 : kb16;
    f32x16 acc;
#pragma unroll
    for (int r = 0; r < 16; ++r) acc[r] = 0.f;
#pragma unroll
    for (int s = 0; s < 8; ++s) { const bf16x8 a = *(const bf16x8*)(Ab + (32 * ti + lq) * 272 + (16 * s + 8 * h) * 2), b = *(const bf16x8*)(kb16 + (32 * tj + lq) * 272 + (16 * s + 8 * h) * 2);
      acc = MFMA32(a, b, acc); }
    const int j = 32 * tj + lq; const float gj = gcs[j]; const int pj = 32 * (j >> 5) + perm32(j & 31);
#pragma unroll
    for (int r = 0; r < 16; ++r) { const int i = 32 * ti + crow(r, h); const float dec = __expf(fminf(gcs[i] - gj, 0.f));
      if (which == 0) Lm[i * 64 + j] = (j < i) ? gcs[64 + i] * acc[r] * dec : 0.f;
      else QK[i * 64 + pj] = f2bf((j <= i) ? acc[r] * dec : 0.f); }
  }
  __syncthreads();
  if (tid < 256) {
    const int c = tid; const bool isu = c < 128; const int cc = c & 127;
    const float* rp = (isu ? vf : kf) + cc; const float* sp = gcs + (isu ? 64 : 192);
    float x[64];
    f32x4 LA[16], LB[16]; float rh[2];
    x[0] = sp[0] * rp[0];
    LA[0] = *(const f32x4*)(Lm + 64); rh[1] = sp[1] * rp[128];
#pragma unroll
    for (int i = 1; i < 64; ++i) {
      f32x4 (&CUR)[16] = (i & 1) ? LA : LB; f32x4 (&NXT)[16] = (i & 1) ? LB : LA;
      if (i + 1 < 64) {
#pragma unroll
        for (int c = 0; c < (i + 4) / 4; ++c) NXT[c] = *(const f32x4*)(Lm + (i + 1) * 64 + 4 * c);
        rh[(i + 1) & 1] = sp[i + 1] * rp[(i + 1) * 128];
      }
      __builtin_amdgcn_sched_barrier(0);
      float r = rh[i & 1];
#pragma unroll
      for (int j = 0; j < i; ++j) r = fmaf(-CUR[j >> 2][j & 3], x[j], r);
      x[i] = r;
      __builtin_amdgcn_sched_barrier(0);
    }
    if (isu) {
#pragma unroll
      for (int i8 = 0; i8 < 8; ++i8) { u32x4 v = {pack2(x[8 * i8], x[8 * i8 + 1]), pack2(x[8 * i8 + 2], x[8 * i8 + 3]), pack2(x[8 * i8 + 4], x[8 * i8 + 5]), pack2(x[8 * i8 + 6], x[8 * i8 + 7])}; *(u32x4*)(Ut + cc * 64 + 8 * i8) = v; }
    } else {
      const int pp = 32 * (cc >> 5) + perm32(cc & 31);
#pragma unroll
      for (int i = 0; i < 64; ++i) Wp[i * 128 + pp] = f2bf(x[i]);
    }
  }
  __syncthreads();
}

DI bf16x8 pack_tiles(const f32x4& a, const f32x4& b) { return pack8(a.x, a.y, a.z, a.w, b.x, b.y, b.z, b.w); }
template <int CTRL> DI float dppf(float v) { return __int_as_float(__builtin_amdgcn_update_dpp(0, __float_as_int(v), CTRL, 0xf, 0xf, true)); }
DI float row16_sum(float v) { v += dppf<0xB1>(v); v += dppf<0x4E>(v); v += dppf<0x141>(v); v += dppf<0x140>(v); return v; }
constexpr size_t OFF_SSQP = OFF_GTOT + 8192;
static_assert(OFF_SSQP + (size_t)8 * S_ * 8 * 4 <= OFF_UT, "overlay3");
constexpr int SCAN_OPB = 62464;
constexpr int SCAN_SO = 2 * SCAN_OPB;
DI void gdn_scan_item(const Params& P, int l, int hh, int half, char* smem) {
  const int tid = opaque_tid(), lane = tid & 63, w = tid >> 6, l15 = lane & 15, q4 = lane >> 4;
  const size_t hb = (size_t)hh * 256;
  const bf16_t* Wp = (const bf16_t*)(P.ws + OFF_WP) + hb * 8192; const bf16_t* Qd = (const bf16_t*)(P.ws + OFF_QD) + hb * 8192;
  const bf16_t* Kt = (const bf16_t*)(P.ws + OFF_KT) + hb * 8192; const bf16_t* Zt = (const bf16_t*)(P.ws + OFF_ZT) + hb * 8192;
  const bf16_t* QK = (const bf16_t*)(P.ws + OFF_QK) + hb * 4096; const bf16_t* Ut = (const bf16_t*)(P.ws + OFF_UT) + hb * 8192;
  const float* gt = (const float*)(P.ws + OFF_GTOT) + hb;
  bf16_t* mixin = (bf16_t*)(P.ws + OFF_H);
  if (w >= 4) {
    const int lt = tid - 256, wl = w - 4;
    const int dvc = 64 * half + 16 * wl + l15; const float nw = P.gdn_norm[l * 128 + dvc];
    const int uoff = dvc * 64 + 4 * q4;
    float* ssqp = (float*)(P.ws + OFF_SSQP) + (size_t)(half * 4 + wl) * S_ * 8;
    const int g256 = (lt >> 4) * 128 + (lt & 15) * 8, l256 = (lt >> 4) * 272 + (lt & 15) * 16;
    const int g128 = (lt >> 3) * 64 + (lt & 7) * 8, l128 = (lt >> 3) * 144 + (lt & 7) * 16;
    u32x4 pw[4], pq[4], pk[4], pqk[2]; u32x2 zc[4], zn[4];
#pragma unroll
    for (int i = 0; i < 4; ++i) { pw[i] = *(const u32x4*)(Wp + g256 + i * 2048); pq[i] = *(const u32x4*)(Qd + g256 + i * 2048); pk[i] = *(const u32x4*)(Kt + g128 + i * 2048); }
#pragma unroll
    for (int i = 0; i < 2; ++i) pqk[i] = *(const u32x4*)(QK + g128 + i * 2048);
#pragma unroll
    for (int i = 0; i < 4; ++i) { *(u32x4*)(smem + l256 + i * 4352) = pw[i]; *(u32x4*)(smem + 17408 + l256 + i * 4352) = pq[i]; *(u32x4*)(smem + 34816 + l128 + i * 4608) = pk[i]; }
#pragma unroll
    for (int i = 0; i < 2; ++i) *(u32x4*)(smem + 53248 + l128 + i * 4608) = pqk[i];
#pragma unroll
    for (int i = 0; i < 4; ++i) { pw[i] = *(const u32x4*)(Wp + 8192 + g256 + i * 2048); pq[i] = *(const u32x4*)(Qd + 8192 + g256 + i * 2048); pk[i] = *(const u32x4*)(Kt + 8192 + g128 + i * 2048); }
#pragma unroll
    for (int i = 0; i < 2; ++i) pqk[i] = *(const u32x4*)(QK + 4096 + g128 + i * 2048);
#pragma unroll
    for (int it = 0; it < 4; ++it) { zc[it] = (u32x2){0u, 0u}; zn[it] = zc[it]; }
    __syncthreads();
#pragma unroll 1
    for (int n = 0; n <= 256; ++n) {
      if (n < 256) {
        char* nb = smem + ((n + 1) & 1) * SCAN_OPB;
        if (n + 1 < 256) {
#pragma unroll
          for (int i = 0; i < 4; ++i) { *(u32x4*)(nb + l256 + i * 4352) = pw[i]; *(u32x4*)(nb + 17408 + l256 + i * 4352) = pq[i]; *(u32x4*)(nb + 34816 + l128 + i * 4608) = pk[i]; }
#pragma unroll
          for (int i = 0; i < 2; ++i) *(u32x4*)(nb + 53248 + l128 + i * 4608) = pqk[i];
        }
        if (n + 2 < 256) { const size_t o8 = (size_t)(n + 2) * 8192, o4 = (size_t)(n + 2) * 4096;
#pragma unroll
          for (int i = 0; i < 4; ++i) { pw[i] = *(const u32x4*)(Wp + o8 + g256 + i * 2048); pq[i] = *(const u32x4*)(Qd + o8 + g256 + i * 2048); pk[i] = *(const u32x4*)(Kt + o8 + g128 + i * 2048); }
#pragma unroll
          for (int i = 0; i < 2; ++i) pqk[i] = *(const u32x4*)(QK + o4 + g128 + i * 2048); }
#pragma unroll
        for (int it = 0; it < 4; ++it) zn[it] = *(const u32x2*)(Zt + (size_t)n * 8192 + uoff + 16 * it);
      }
      if (n >= 1) {
        const int m = n - 1; const char* so = smem + SCAN_SO + (m & 1) * 16384 + (wl * 4) * 1024 + lane * 16;
#pragma unroll
        for (int it = 0; it < 4; ++it) {
          const f32x4 o = *(const f32x4*)(so + it * 1024);
          f32x4 ss = o * o;
          ss.x = row16_sum(ss.x); ss.y = row16_sum(ss.y); ss.z = row16_sum(ss.z); ss.w = row16_sum(ss.w);
          const int row = 64 * m + 16 * it + 4 * q4;
          if (l15 == 0) { float* sp = ssqp + (size_t)row * 8 + hh; sp[0] = ss.x; sp[8] = ss.y; sp[16] = ss.z; sp[24] = ss.w; }
          const float z0 = bflo(zc[it].x), z1 = bfhi(zc[it].x), z2 = bflo(zc[it].y), z3 = bfhi(zc[it].y);
          bf16_t* op = mixin + (size_t)row * 2048 + hh * 128 + dvc;
          op[0] = f2bf(o.x * nw * z0); op[2048] = f2bf(o.y * nw * z1); op[4096] = f2bf(o.z * nw * z2); op[6144] = f2bf(o.w * nw * z3);
        }
      }
#pragma unroll
      for (int it = 0; it < 4; ++it) zc[it] = zn[it];
      if (n < 256) __syncthreads();
    }
  } else {
    const int dvc = 64 * half + 16 * w + l15;
    const int uoff = dvc * 64 + 4 * q4;
    f32x4 St[8];
#pragma unroll
    for (int t = 0; t < 8; ++t) St[t] = (f32x4){0.f, 0.f, 0.f, 0.f};
    u32x2 uc[4], un[4]; float gcur, gn = 0.f;
#pragma unroll
    for (int it = 0; it < 4; ++it) { uc[it] = *(const u32x2*)(Ut + uoff + 16 * it); un[it] = uc[it]; }
    gcur = gt[0];
    __syncthreads();
#pragma unroll 2
    for (int n = 0; n < 256; ++n) {
      const char* cb = smem + (n & 1) * SCAN_OPB;
      const char* sWp = cb; const char* sQd = cb + 17408; const char* sKt = cb + 34816; const char* sQK = cb + 53248;
      if (n + 1 < 256) { const size_t o8 = (size_t)(n + 1) * 8192;
#pragma unroll
        for (int it = 0; it < 4; ++it) un[it] = *(const u32x2*)(Ut + o8 + uoff + 16 * it);
        gn = gt[n + 1]; }
      bf16x8 sb[4];
#pragma unroll
      for (int ks = 0; ks < 4; ++ks) sb[ks] = pack_tiles(St[2 * ks], St[2 * ks + 1]);
      f32x4 wsv[4], qs[4];
#pragma unroll
      for (int it = 0; it < 4; ++it) { wsv[it] = (f32x4){0.f, 0.f, 0.f, 0.f}; qs[it] = (f32x4){0.f, 0.f, 0.f, 0.f}; }
#pragma unroll
      for (int it = 0; it < 4; ++it)
#pragma unroll
        for (int ks = 0; ks < 4; ++ks) { const int o = (16 * it + l15) * 272 + 64 * ks + 16 * q4;
          const bf16x8 a = *(const bf16x8*)(sWp + o), a2 = *(const bf16x8*)(sQd + o);
          wsv[it] = MFMA16(a, sb[ks], wsv[it]); qs[it] = MFMA16(a2, sb[ks], qs[it]); }
      f32x4 vn[4];
#pragma unroll
      for (int it = 0; it < 4; ++it) { const f32x4 uf = {bflo(uc[it].x), bfhi(uc[it].x), bflo(uc[it].y), bfhi(uc[it].y)}; vn[it] = uf - wsv[it]; }
      bf16x8 vb[2];
#pragma unroll
      for (int ks = 0; ks < 2; ++ks) vb[ks] = pack_tiles(vn[2 * ks], vn[2 * ks + 1]);
#pragma unroll
      for (int it = 0; it < 4; ++it)
#pragma unroll
        for (int ks = 0; ks < 2; ++ks) { const bf16x8 a = *(const bf16x8*)(sQK + (16 * it + l15) * 144 + 64 * ks + 16 * q4); qs[it] = MFMA16(a, vb[ks], qs[it]); }
      { char* so = smem + SCAN_SO + (n & 1) * 16384 + (w * 4) * 1024 + lane * 16;
#pragma unroll
        for (int it = 0; it < 4; ++it) *(f32x4*)(so + it * 1024) = qs[it]; }
#pragma unroll
      for (int t = 0; t < 8; ++t) { St[t] *= gcur;
#pragma unroll
        for (int ks = 0; ks < 2; ++ks) { const bf16x8 a = *(const bf16x8*)(sKt + (16 * t + l15) * 144 + 64 * ks + 16 * q4); St[t] = MFMA16(a, vb[ks], St[t]); } }
#pragma unroll
      for (int it = 0; it < 4; ++it) uc[it] = un[it];
      gcur = gn;
      __syncthreads();
    }
  }
  __syncthreads();
}
DI void gdn_fix_phase(const Params& P) {
  const int tid = opaque_tid();
  bf16_t* mixin = (bf16_t*)(P.ws + OFF_H); const float* ssqp = (const float*)(P.ws + OFF_SSQP);
  for (int idx = blockIdx.x * NT + tid; idx < S_ * 128; idx += gridDim.x * NT) {
    const int t = idx >> 7, ck = idx & 127, h = ck >> 4;
    float sq = 0.f;
#pragma unroll
    for (int p = 0; p < 8; ++p) sq += ssqp[((size_t)p * S_ + t) * 8 + h];
    const float r = rsqrtf(sq * (1.f / 128.f) + EPS);
    u32x4* pp = (u32x4*)(mixin + (size_t)t * 2048 + ck * 8); const u32x4 v = *pp; float f[8]; unpack8(v, f);
    u32x4 o = {pack2(f[0] * r, f[1] * r), pack2(f[2] * r, f[3] * r), pack2(f[4] * r, f[5] * r), pack2(f[6] * r, f[7] * r)}; *pp = o;
  }
}

DI void mla_attn_item(const Params& P, int hd, int b, char* smem) {
  const int tid = opaque_tid(), lane = tid & 63, w = tid >> 6, wq = w & 3, hk = w >> 2, lq = lane & 31, h = lane >> 5;
  const float* qraw = (const float*)(P.ws + OFF_QRAW);
  const bf16_t* Kg = (const bf16_t*)(P.ws + OFF_KMLA) + (size_t)hd * S_ * 192;
  const bf16_t* Vg = (const bf16_t*)(P.ws + OFF_VT) + (size_t)hd * 128 * S_;
  bf16_t* mixin = (bf16_t*)(P.ws + OFF_H);
  const int q = 128 * b + 32 * wq + lq;
  bf16x8 qf[12];
  {
    const float* qp = qraw + (size_t)q * 768 + hd * 192 + 8 * h;
    const float sc = 0.07216878364870322f * LOG2E;
#pragma unroll
    for (int s = 0; s < 8; ++s) { const f32x4 a = *(const f32x4*)(qp + 16 * s), c = *(const f32x4*)(qp + 16 * s + 4);
      qf[s] = pack8(a.x * sc, a.y * sc, a.z * sc, a.w * sc, c.x * sc, c.y * sc, c.z * sc, c.w * sc); }
    const double pq = (double)P.pos[q];
#pragma unroll
    for (int s2 = 0; s2 < 2; ++s2) {
      const f32x4 a0 = *(const f32x4*)(qp + 128 + 16 * s2), a1 = *(const f32x4*)(qp + 128 + 16 * s2 + 4);
      const f32x4 b0 = *(const f32x4*)(qp + 160 + 16 * s2), b1 = *(const f32x4*)(qp + 160 + 16 * s2 + 4);
      float x1[8] = {a0.x, a0.y, a0.z, a0.w, a1.x, a1.y, a1.z, a1.w}, x2[8] = {b0.x, b0.y, b0.z, b0.w, b1.x, b1.y, b1.z, b1.w}, o1[8], o2[8];
#pragma unroll
      for (int j = 0; j < 8; ++j) { double fr = pq * kInvFreq2Pi[16 * s2 + 8 * h + j]; fr -= floor(fr); const float ff = (float)fr;
        const float sn = __builtin_amdgcn_sinf(ff), cs = __builtin_amdgcn_cosf(ff);
        o1[j] = (x1[j] * cs - x2[j] * sn) * sc; o2[j] = (x2[j] * cs + x1[j] * sn) * sc; }
      qf[8 + s2] = pack8(o1[0], o1[1], o1[2], o1[3], o1[4], o1[5], o1[6], o1[7]);
      qf[10 + s2] = pack8(o2[0], o2[1], o2[2], o2[3], o2[4], o2[5], o2[6], o2[7]);
    }
  }
  constexpr int KST = 64 * 400, VST = 128 * 144, STG = KST + VST;
  f32x16 O[4];
#pragma unroll
  for (int i = 0; i < 4; ++i)
#pragma unroll
    for (int r = 0; r < 16; ++r) O[i][r] = 0.f;
  float m_i = -1e30f, l_i = 0.f;
  const int nt = 2 * b + 2;
  u32x4 rk[3], rv[2];
  const int vrow = tid >> 3, vcc = tid & 7;
#pragma unroll
  for (int i = 0; i < 3; ++i) { const int id = tid + NT * i, row = id / 24, cc = id % 24; rk[i] = *(const u32x4*)(Kg + row * 192 + cc * 8); }
#pragma unroll
  for (int i = 0; i < 2; ++i) rv[i] = *(const u32x4*)(Vg + (size_t)(vrow + 64 * i) * S_ + vcc * 8);
#pragma unroll
  for (int i = 0; i < 3; ++i) { const int id = tid + NT * i, row = id / 24, cc = id % 24; *(u32x4*)(smem + row * 400 + cc * 16) = rk[i]; }
#pragma unroll
  for (int i = 0; i < 2; ++i) *(u32x4*)(smem + KST + (vrow + 64 * i) * 144 + vcc * 16) = rv[i];
  __syncthreads();
  for (int kt = 0; kt < nt; ++kt) {
    const char* sK = smem + (kt & 1) * STG; const char* sV = sK + KST;
    const bool more = (kt + 1 < nt);
    if (more) { const size_t ko = (size_t)(kt + 1) * 64 * 192; const int vo = (kt + 1) * 64;
#pragma unroll
      for (int i = 0; i < 3; ++i) { const int id = tid + NT * i, row = id / 24, cc = id % 24; rk[i] = *(const u32x4*)(Kg + ko + row * 192 + cc * 8); }
#pragma unroll
      for (int i = 0; i < 2; ++i) rv[i] = *(const u32x4*)(Vg + (size_t)(vrow + 64 * i) * S_ + vo + vcc * 8); }
    const int key0 = 64 * kt + 32 * hk;
    if (key0 <= 128 * b + 32 * wq) {
      f32x16 st;
#pragma unroll
      for (int r = 0; r < 16; ++r) st[r] = 0.f;
#pragma unroll
      for (int s = 0; s < 12; ++s) { const bf16x8 kf = *(const bf16x8*)(sK + (32 * hk + lq) * 400 + (2 * s + h) * 16); st = MFMA32(kf, qf[s], st); }
      if (key0 + 31 > 128 * b + 32 * wq) {
        int qrel = q - key0 - 4 * h; asm volatile("" : "+v"(qrel));
#pragma unroll
        for (int r = 0; r < 16; ++r) if ((r & 3) + 8 * (r >> 2) > qrel) st[r] = -1e30f;
      }
      float mx = st[0];
#pragma unroll
      for (int r = 1; r < 16; ++r) mx = fmaxf(mx, st[r]);
      mx = fmaxf(mx, __shfl_xor(mx, 32));
      const float m_new = fmaxf(m_i, mx), alpha = exp2f(m_i - m_new);
      float ps = 0.f;
#pragma unroll
      for (int r = 0; r < 16; ++r) { st[r] = exp2f(st[r] - m_new); ps += st[r]; }
      l_i = l_i * alpha + ps; m_i = m_new;
#pragma unroll
      for (int i = 0; i < 4; ++i)
#pragma unroll
        for (int r = 0; r < 16; ++r) O[i][r] *= alpha;
      bf16x8 pf[2];
#pragma unroll
      for (int s = 0; s < 2; ++s) pf[s] = pack8(st[8 * s], st[8 * s + 1], st[8 * s + 2], st[8 * s + 3], st[8 * s + 4], st[8 * s + 5], st[8 * s + 6], st[8 * s + 7]);
#pragma unroll
      for (int i = 0; i < 4; ++i)
#pragma unroll
        for (int s = 0; s < 2; ++s) { const char* vp = sV + (32 * i + lq) * 144 + (32 * hk + 16 * s + 4 * h) * 2;
          const u32x2 lo = *(const u32x2*)vp, hi = *(const u32x2*)(vp + 16); u32x4 vv = {lo.x, lo.y, hi.x, hi.y};
          O[i] = MFMA32(__builtin_bit_cast(bf16x8, vv), pf[s], O[i]); }
    }
    if (more) { char* dK = smem + ((kt + 1) & 1) * STG;
#pragma unroll
      for (int i = 0; i < 3; ++i) { const int id = tid + NT * i, row = id / 24, cc = id % 24; *(u32x4*)(dK + row * 400 + cc * 16) = rk[i]; }
#pragma unroll
      for (int i = 0; i < 2; ++i) *(u32x4*)(dK + KST + (vrow + 64 * i) * 144 + vcc * 16) = rv[i]; }
    __syncthreads();
  }
  float* cO = (float*)smem; float* cm = cO + 4 * 4096; float* cl = cm + 256;
  if (hk == 1) {
#pragma unroll
    for (int i = 0; i < 4; ++i)
#pragma unroll
      for (int r = 0; r < 16; ++r) cO[wq * 4096 + (i * 16 + r) * 64 + lane] = O[i][r];
    cm[wq * 64 + lane] = m_i; cl[wq * 64 + lane] = l_i;
  }
  __syncthreads();
  if (hk == 0) {
    const float m1 = cm[wq * 64 + lane], l1 = cl[wq * 64 + lane];
    const float m = fmaxf(m_i, m1), a0 = exp2f(m_i - m), a1 = exp2f(m1 - m);
    float lt = l_i * a0 + l1 * a1; lt += __shfl_xor(lt, 32);
    const float inv = 1.f / lt;
    bf16_t* op = mixin + (size_t)q * 2048 + 1024 + hd * 128;
#pragma unroll
    for (int i = 0; i < 4; ++i)
#pragma unroll
      for (int rg = 0; rg < 4; ++rg) { float v[4];
#pragma unroll
        for (int e = 0; e < 4; ++e) v[e] = (O[i][4 * rg + e] * a0 + cO[wq * 4096 + (i * 16 + 4 * rg + e) * 64 + lane] * a1) * inv;
        u32x2 pk = {pack2(v[0], v[1]), pack2(v[2], v[3])}; *(u32x2*)(op + 32 * i + 8 * rg + 4 * h) = pk; }
  }
  __syncthreads();
}

DI void swa_item(const Params& P, int l, int n, int hk2, char* smem) {
  const int tid = opaque_tid(), lane = tid & 63, w = tid >> 6, lq = lane & 31, h = lane >> 5;
  const bf16_t* proj = (const bf16_t*)(P.ws + OFF_PROJ); bf16_t* mixin = (bf16_t*)(P.ws + OFF_H);
  bf16_t* sVt = (bf16_t*)smem;
#pragma unroll
  for (int i = 0; i < 4; ++i) { const int id = tid + NT * i, key = id >> 3, dc = id & 7; const int kp = 128 * (n - 1) + key;
    u32x4 v = {0u, 0u, 0u, 0u}; if (kp >= 0) v = *(const u32x4*)(proj + (size_t)kp * DINP + C_CV + hk2 * 64 + dc * 8);
    sVt[(8 * dc + 0) * 264 + key] = (bf16_t)(v.x & 0xffff); sVt[(8 * dc + 1) * 264 + key] = (bf16_t)(v.x >> 16);
    sVt[(8 * dc + 2) * 264 + key] = (bf16_t)(v.y & 0xffff); sVt[(8 * dc + 3) * 264 + key] = (bf16_t)(v.y >> 16);
    sVt[(8 * dc + 4) * 264 + key] = (bf16_t)(v.z & 0xffff); sVt[(8 * dc + 5) * 264 + key] = (bf16_t)(v.z >> 16);
    sVt[(8 * dc + 6) * 264 + key] = (bf16_t)(v.w & 0xffff); sVt[(8 * dc + 7) * 264 + key] = (bf16_t)(v.w >> 16); }
  __syncthreads();
  const int g = w >> 1, hq = hk2 * 4 + g;
  const float slope = exp2f(-(float)(hq + 1)) * LOG2E, sinkv = P.swa_sinks[l * 8 + hq] * LOG2E;
#pragma unroll 1
  for (int jj = 0; jj < 2; ++jj) {
    const int j = 2 * (w & 1) + jj; const int qrow = 128 * n + 32 * j + lq;
    bf16x8 qf[4];
#pragma unroll
    for (int s = 0; s < 4; ++s) qf[s] = *(const bf16x8*)(proj + (size_t)qrow * DINP + C_CQ + hq * 64 + 16 * s + 8 * h);
    f32x16 st[5];
    bf16x8 kf[2][4];
    { const int kp = 128 * (n - 1) + 32 * j + lq;
#pragma unroll
      for (int s = 0; s < 4; ++s) { kf[0][s] = (bf16x8){0, 0, 0, 0, 0, 0, 0, 0}; if (kp >= 0) kf[0][s] = *(const bf16x8*)(proj + (size_t)kp * DINP + C_CK + hk2 * 64 + 16 * s + 8 * h); } }
#pragma unroll
    for (int tt = 0; tt < 5; ++tt) {
      if (tt + 1 < 5) { const int kp = 128 * (n - 1) + 32 * (j + tt + 1) + lq;
#pragma unroll
        for (int s = 0; s < 4; ++s) { kf[(tt + 1) & 1][s] = (bf16x8){0, 0, 0, 0, 0, 0, 0, 0}; if (kp >= 0) kf[(tt + 1) & 1][s] = *(const bf16x8*)(proj + (size_t)kp * DINP + C_CK + hk2 * 64 + 16 * s + 8 * h); } }
      __builtin_amdgcn_sched_barrier(0);
#pragma unroll
      for (int r = 0; r < 16; ++r) st[tt][r] = 0.f;
#pragma unroll
      for (int s = 0; s < 4; ++s) st[tt] = MFMA32(kf[tt & 1][s], qf[s], st[tt]);
      __builtin_amdgcn_sched_barrier(0);
    }
    float mx = sinkv;
    int dbase = 128 + lq - 4 * h, kbase = 128 * (n - 1) + 32 * j + 4 * h;
    asm volatile("" : "+v"(dbase), "+v"(kbase));
#pragma unroll
    for (int tt = 0; tt < 5; ++tt)
#pragma unroll
      for (int r = 0; r < 16; ++r) { const int cst = 32 * tt + (r & 3) + 8 * (r >> 2); const int dist = dbase - cst; const int kpos = kbase + cst;
        const bool valid = (dist >= 0) && (dist < 128) && (kpos >= 0);
        const float sv = valid ? st[tt][r] * (0.125f * LOG2E) - slope * (float)dist : -1e30f; st[tt][r] = sv; mx = fmaxf(mx, sv); }
    mx = fmaxf(mx, __shfl_xor(mx, 32));
    float den = 0.f;
#pragma unroll
    for (int tt = 0; tt < 5; ++tt)
#pragma unroll
      for (int r = 0; r < 16; ++r) { const float p = exp2f(st[tt][r] - mx); st[tt][r] = p; den += p; }
    den += __shfl_xor(den, 32); den += exp2f(sinkv - mx);
    f32x16 O[2];
#pragma unroll
    for (int i = 0; i < 2; ++i)
#pragma unroll
      for (int r = 0; r < 16; ++r) O[i][r] = 0.f;
#pragma unroll
    for (int tt = 0; tt < 5; ++tt)
#pragma unroll
      for (int s = 0; s < 2; ++s) { const bf16x8 pf = pack8(st[tt][8 * s], st[tt][8 * s + 1], st[tt][8 * s + 2], st[tt][8 * s + 3], st[tt][8 * s + 4], st[tt][8 * s + 5], st[tt][8 * s + 6], st[tt][8 * s + 7]);
#pragma unroll
        for (int i = 0; i < 2; ++i) { const char* vp = (const char*)sVt + (32 * i + lq) * 528 + (32 * (j + tt) + 16 * s + 4 * h) * 2;
          const u32x2 lo = *(const u32x2*)vp, hi = *(const u32x2*)(vp + 16); u32x4 vv = {lo.x, lo.y, hi.x, hi.y};
          O[i] = MFMA32(__builtin_bit_cast(bf16x8, vv), pf, O[i]); }
        __builtin_amdgcn_sched_barrier(0); }
    const float inv = 1.f / den;
    bf16_t* op = mixin + (size_t)qrow * 2048 + 1536 + hq * 64;
#pragma unroll
    for (int i = 0; i < 2; ++i)
#pragma unroll
      for (int rg = 0; rg < 4; ++rg) { u32x2 pk = {pack2(O[i][4 * rg] * inv, O[i][4 * rg + 1] * inv), pack2(O[i][4 * rg + 2] * inv, O[i][4 * rg + 3] * inv)};
        *(u32x2*)(op + 32 * i + 8 * rg + 4 * h) = pk; }
  }
  __syncthreads();
}

DI float gelu_tanh(float x) { const float y = 0.7978845608028654f * (x + 0.044715f * x * x * x); const float t = 1.f - 2.f * __builtin_amdgcn_rcpf(1.f + __expf(2.f * y)); return 0.5f * x * (1.f + t); }
DI void ffn_act_phase(const Params& P, int l) {
  const int tid = opaque_tid(), lane = tid & 63, w = tid >> 6;
  const bf16_t* u = (const bf16_t*)(P.ws + OFF_BIG); bf16_t* act = (bf16_t*)(P.ws + OFF_ACT);
  const float* cw = P.ffn_conv + (size_t)l * 3 * DFF2; const float* cb = P.ffn_conv_b + (size_t)l * DFF2;
  for (int item = blockIdx.x * 8 + w; item < 512 * 11; item += gridDim.x * 8) {
    const int cbk = item % 11, rr = item / 11; const int ch = cbk * 512 + lane * 8, r0 = rr * 32;
    float wg[3][8], wu[3][8], bg[8], bu[8];
#pragma unroll
    for (int j = 0; j < 3; ++j)
#pragma unroll
      for (int e4 = 0; e4 < 2; ++e4) { const f32x4 a = *(const f32x4*)(cw + (size_t)j * DFF2 + ch + 4 * e4), b = *(const f32x4*)(cw + (size_t)j * DFF2 + DFF + ch + 4 * e4);
        wg[j][4 * e4] = a.x; wg[j][4 * e4 + 1] = a.y; wg[j][4 * e4 + 2] = a.z; wg[j][4 * e4 + 3] = a.w; wu[j][4 * e4] = b.x; wu[j][4 * e4 + 1] = b.y; wu[j][4 * e4 + 2] = b.z; wu[j][4 * e4 + 3] = b.w; }
#pragma unroll
    for (int e4 = 0; e4 < 2; ++e4) { const f32x4 a = *(const f32x4*)(cb + ch + 4 * e4), b = *(const f32x4*)(cb + DFF + ch + 4 * e4);
      bg[4 * e4] = a.x; bg[4 * e4 + 1] = a.y; bg[4 * e4 + 2] = a.z; bg[4 * e4 + 3] = a.w; bu[4 * e4] = b.x; bu[4 * e4 + 1] = b.y; bu[4 * e4 + 2] = b.z; bu[4 * e4 + 3] = b.w; }
    float g2[8], g1[8], u2[8], u1[8];
#pragma unroll
    for (int e = 0; e < 8; ++e) { g2[e] = 0.f; g1[e] = 0.f; u2[e] = 0.f; u1[e] = 0.f; }
    if (r0 >= 2) { unpack8(*(const u32x4*)(u + (size_t)(r0 - 2) * DFF2 + ch), g2); unpack8(*(const u32x4*)(u + (size_t)(r0 - 2) * DFF2 + DFF + ch), u2);
      unpack8(*(const u32x4*)(u + (size_t)(r0 - 1) * DFF2 + ch), g1); unpack8(*(const u32x4*)(u + (size_t)(r0 - 1) * DFF2 + DFF + ch), u1); }
#pragma unroll 1
    for (int rb = 0; rb < 4; ++rb) {
      u32x4 G[8], U[8];
#pragma unroll
      for (int i = 0; i < 8; ++i) { const size_t ro = (size_t)(r0 + rb * 8 + i) * DFF2 + ch; G[i] = *(const u32x4*)(u + ro); U[i] = *(const u32x4*)(u + ro + DFF); }
#pragma unroll
      for (int i = 0; i < 8; ++i) {
        float g0[8], u0[8]; unpack8(G[i], g0); unpack8(U[i], u0);
        float o[8];
#pragma unroll
        for (int e = 0; e < 8; ++e) { const float yg = wg[0][e] * g2[e] + wg[1][e] * g1[e] + wg[2][e] * g0[e] + bg[e]; const float yu = wu[0][e] * u2[e] + wu[1][e] * u1[e] + wu[2][e] * u0[e] + bu[e];
          o[e] = gelu_tanh(yg) * yu; g2[e] = g1[e]; g1[e] = g0[e]; u2[e] = u1[e]; u1[e] = u0[e]; }
        u32x4 pk = {pack2(o[0], o[1]), pack2(o[2], o[3]), pack2(o[4], o[5]), pack2(o[6], o[7])};
        *(u32x4*)(act + (size_t)(r0 + rb * 8 + i) * DFF + ch) = pk;
      }
    }
  }
}

#define XB_TMO      128
#define XB_XCNT(j)  (256  + 64 * (j))
#define XB_XSUB(j)  (1280 + 64 * (j))
#define XB_XGEN(j)  (2304 + 64 * (j))
#define XB_TOP      3328
#define XB_TOPGEN   3392
#define XCD_BAR_WORDS 3456
#define XB_SPIN_CAP (1u << 18)
#define LAS __attribute__((address_space(3)))
DI unsigned xb_ld(unsigned* p)              { return __hip_atomic_load(p, __ATOMIC_RELAXED, __HIP_MEMORY_SCOPE_AGENT); }
DI unsigned xb_add(unsigned* p, unsigned v) { return __hip_atomic_fetch_add(p, v, __ATOMIC_RELAXED, __HIP_MEMORY_SCOPE_AGENT); }
DI unsigned xb_xcc_id() { return (unsigned)__builtin_amdgcn_s_getreg((3 << 11) | 20) & 0xFu; }
#define XB_SPIN(cond, bar) do { unsigned _sp = 0; while (cond) { __builtin_amdgcn_s_sleep(1); \
    if ((++_sp & 255u) == 0u) { if (xb_ld(&(bar)[XB_TMO])) break; if (_sp > XB_SPIN_CAP) { atomicAdd(&(bar)[XB_TMO], 1u); break; } } } } while (0)
struct XcdBarrier { unsigned* bar; unsigned x; volatile LAS unsigned* st; };
DI XcdBarrier xcd_barrier_post(unsigned* bar, volatile LAS unsigned* st) {
  XcdBarrier b; b.bar = bar; b.x = xb_xcc_id(); b.st = st;
  if (threadIdx.x == 0) (void)xb_add(&bar[XB_XCNT(b.x)], 1u);
  return b;
}
DI void xcd_barrier_complete(unsigned* bar, unsigned x, unsigned& nloc, unsigned& nx) {
  const unsigned G = gridDim.x * gridDim.y * gridDim.z;
  unsigned sum, cnt, mine, sp = 0u;
  for (;;) {
    sum = 0u; cnt = 0u; mine = 0u;
#pragma unroll
    for (unsigned j = 0; j < 16; ++j) { const unsigned c = xb_ld(&bar[XB_XCNT(j)]); sum += c; cnt += (c > 0u) ? 1u : 0u; mine = (j == x) ? c : mine; }
    if (sum == G) break;
    __builtin_amdgcn_s_sleep(1);
    if ((++sp & 255u) == 0u) { if (xb_ld(&bar[XB_TMO])) break; if (sp > XB_SPIN_CAP) { atomicAdd(&bar[XB_TMO], 1u); break; } }
  }
  nloc = mine > 0u ? mine : 1u; nx = cnt > 0u ? cnt : 1u;
}
DI void xcd_barrier(char* ws_, char* smem_) {
  XcdBarrier b; b.bar = (unsigned*)(ws_ + OFF_XBAR); b.x = xb_xcc_id(); b.st = (volatile LAS unsigned*)(smem_ + 157712);
  asm volatile("s_waitcnt vmcnt(0)" ::: "memory");
  __syncthreads();
  if (threadIdx.x == 0) {
    unsigned* bar = b.bar;
    __builtin_amdgcn_s_waitcnt(0);
    unsigned nloc = b.st[0], nx = b.st[1];
    if (nloc == 0u) { xcd_barrier_complete(bar, b.x, nloc, nx); b.st[0] = nloc; b.st[1] = nx; }
    const unsigned old = xb_add(&bar[XB_XSUB(b.x)], 1u);
    const unsigned gen = old / nloc;
    if (old + 1u == (gen + 1u) * nloc) {
      __builtin_amdgcn_fence(__ATOMIC_RELEASE, "agent");
      asm volatile("s_waitcnt vmcnt(0)" ::: "memory");
      const unsigned og = xb_add(&bar[XB_TOP], 1u);
      const unsigned tg = og / nx;
      if (og + 1u == (tg + 1u) * nx) xb_add(&bar[XB_TOPGEN], 1u);
      else XB_SPIN(xb_ld(&bar[XB_TOPGEN]) == tg, bar);
      __builtin_amdgcn_fence(__ATOMIC_ACQUIRE, "agent");
      xb_add(&bar[XB_XGEN(b.x)], 1u);
      asm volatile("s_waitcnt vmcnt(0)" ::: "memory");
    } else {
      XB_SPIN(xb_ld(&bar[XB_XGEN(b.x)]) == gen, bar);
      __builtin_amdgcn_fence(__ATOMIC_ACQUIRE, "agent");
      asm volatile("s_waitcnt vmcnt(0)" ::: "memory");
    }
  }
  __syncthreads();
}

__global__ void __launch_bounds__(NT) fwd_megakernel(Params P0) {
  cg::grid_group grid = cg::this_grid();
  __shared__ __attribute__((aligned(16))) char smem[157952];
  const int tid = threadIdx.x;
  char* ws = P0.ws;
  int* ctrl = (int*)(ws + OFF_CTRL);
  if (blockIdx.x == 0 && tid < 64) ctrl[tid] = 0;
  if (blockIdx.x == 0) for (int i = tid; i < XCD_BAR_WORDS; i += NT) ((unsigned*)(ws + OFF_XBAR))[i] = 0u;
  if (tid < 4) ((unsigned*)(smem + 157712))[tid] = 0u;
  if (blockIdx.x == 0 && tid == 0) *(Params*)(ws + OFF_CTRL + 1024) = P0;
  bf16_t* Hb = (bf16_t*)(ws + OFF_H);
  for (int it = blockIdx.x; it < 192 + CV_T5; it += gridDim.x) { if (it < 192) mod_item(P0, it); else convert_item(P0, 0, it - 192, smem); }
  grid.sync();
  (void)xcd_barrier_post((unsigned*)(ws + OFF_XBAR), (volatile LAS unsigned*)(smem + 157712));
  const Params& P = *(const Params*)(ws + OFF_CTRL + 1024);
  rownorm_phase(P, P.x, nullptr, P.out, Hb, 0, 0, nullptr, 0, 1, 0, P.mix_pre, smem);
  xcd_barrier(ws, smem);
  for (int l = 0; l < 2; ++l) {
    { EpiProj epi{(bf16_t*)(ws + OFF_PROJ), (float*)(ws + OFF_AB)}; gemm_phase(Hb, 2048, (const bf16_t*)(ws + OFF_W + W_IN), 2048, 2048, 64, 22, smem, epi); }
    xcd_barrier(ws, smem);
    for (int it = blockIdx.x; it < 448; it += gridDim.x) {
      if (it < 192) mla_q_tile(P, it / 3, it % 3, smem);
      else mla_kv_tile(P, (it - 192) >> 2, (it - 192) & 3, smem);
    }
    for (int id = (blockIdx.x + 64) % gridDim.x; id < 2048; id += gridDim.x) gdn_prep_item(P, l, id >> 3, id & 7, smem);
    xcd_barrier(ws, smem);
    {
      int* sitem = (int*)(smem + 157696);
      for (;;) {
        if (tid == 0) *sitem = atomicAdd(ctrl + 16 * l, 1);
        __syncthreads(); const int item = *sitem; __syncthreads();
        if (item >= 16 + 512 + 256) break;
        if (item < 16) gdn_scan_item(P, l, item >> 1, item & 1, smem);
        else if (item < 528) { const int idx = item - 16; mla_attn_item(P, idx & 3, 127 - (idx >> 2), smem); }
        else { const int idx = item - 528; swa_item(P, l, idx >> 1, idx & 1, smem); }
      }
    }
    xcd_barrier(ws, smem);
    gdn_fix_phase(P);
    xcd_barrier(ws, smem);
    { EpiBf epi{(bf16_t*)(ws + OFF_MIXF), 2048}; gemm_phase(Hb, 2048, (const bf16_t*)(ws + OFF_W + W_OUT), 2048, 2048, 64, 8, smem, epi); }
    xcd_barrier(ws, smem);
    rownorm_phase(P, P.out, (const bf16_t*)(ws + OFF_MIXF), P.out, Hb, l, 2, P.mix_post + l * 2048, l, 4, 3, P.ffn_pre + l * 2048, smem);
    xcd_barrier(ws, smem);
    { EpiBf epi{(bf16_t*)(ws + OFF_BIG), DFF2}; gemm_phase(Hb, 2048, (const bf16_t*)(ws + OFF_W + W_UP), 2048, 2048, 64, 44, smem, epi); }
    xcd_barrier(ws, smem);
    ffn_act_phase(P, l);
    xcd_barrier(ws, smem);
    { EpiBf epi{(bf16_t*)(ws + OFF_Y), 2048}; gemm_phase((const bf16_t*)(ws + OFF_ACT), DFF, (const bf16_t*)(ws + OFF_W + W_DOWN), DFF, DFF, 64, 8, smem, epi); }
    xcd_barrier(ws, smem);
    if (l == 0) {
      for (int it = blockIdx.x; it < CV_T5; it += gridDim.x) convert_item(P, 1, it, smem);
      rownorm_phase(P, P.out, (const bf16_t*)(ws + OFF_Y), P.out, Hb, 0, 5, P.ffn_post, 1, 1, 0, P.mix_pre + 2048, smem);
      xcd_barrier(ws, smem);
    } else {
      rownorm_phase(P, P.out, (const bf16_t*)(ws + OFF_Y), P.out, nullptr, 1, 5, P.ffn_post + 2048, 1, 1, 0, nullptr, smem);
    }
  }
}

extern "C" void kernel_launch(void* const* d_in, const int* in_sizes, int n_in, void* d_out, int out_size, void* d_ws, size_t ws_size, hipStream_t stream) {
  static int grid_blocks = 0;
  if (!grid_blocks) {
    int dev = 0, cus = 0, per = 0;
    (void)hipGetDevice(&dev); (void)hipDeviceGetAttribute(&cus, hipDeviceAttributeMultiprocessorCount, dev);
    (void)hipOccupancyMaxActiveBlocksPerMultiprocessor(&per, fwd_megakernel, NT, 0);
    if (per > 1) per = 1;
    grid_blocks = cus * per; if (grid_blocks <= 0) grid_blocks = 256;
  }
  if (ws_size < OFF_END) { fprintf(stderr, "workspace too small: %zu < %zu\n", ws_size, (size_t)OFF_END); return; }
  Params p{};
  p.x = (const float*)d_in[0]; p.c = (const float*)d_in[1]; p.pos = (const int*)d_in[2];
  p.ada_w = (const float*)d_in[3]; p.ada_b = (const float*)d_in[4]; p.mix_pre = (const float*)d_in[5]; p.mix_post = (const float*)d_in[6];
  p.w_in = (const float*)d_in[7]; p.w_out = (const float*)d_in[8]; p.gdn_conv = (const float*)d_in[9]; p.gdn_a_log = (const float*)d_in[10];
  p.gdn_dt_bias = (const float*)d_in[11]; p.gdn_norm = (const float*)d_in[12]; p.mla_q_norm = (const float*)d_in[13]; p.mla_w_uq = (const float*)d_in[14];
  p.mla_kv_norm = (const float*)d_in[15]; p.mla_w_ukv = (const float*)d_in[16]; p.swa_sinks = (const float*)d_in[17]; p.ffn_pre = (const float*)d_in[18];
  p.ffn_post = (const float*)d_in[19]; p.ffn_w_up = (const float*)d_in[20]; p.ffn_conv = (const float*)d_in[21]; p.ffn_conv_b = (const float*)d_in[22];
  p.ffn_w_down = (const float*)d_in[23];
  p.out = (float*)d_out; p.ws = (char*)d_ws;
  void* args[] = {&p};
  hipError_t e = hipLaunchCooperativeKernel((void*)fwd_megakernel, dim3(grid_blocks), dim3(NT), args, 0, stream);
  if (e != hipSuccess) fprintf(stderr, "cooperative launch failed: %s (grid %d)\n", hipGetErrorString(e), grid_blocks);
}
```

```cpp
#include <hip/hip_runtime.h>
#include <hip/hip_cooperative_groups.h>
#include <cstdio>
#include <cstdint>
namespace cg = cooperative_groups;

#define DI __device__ __forceinline__
typedef unsigned short bf16_t;
typedef short bf16x8 __attribute__((ext_vector_type(8)));
typedef float f32x2 __attribute__((ext_vector_type(2)));
typedef float f32x4 __attribute__((ext_vector_type(4)));
typedef float f32x16 __attribute__((ext_vector_type(16)));
typedef unsigned u32x2 __attribute__((ext_vector_type(2)));
typedef unsigned u32x4 __attribute__((ext_vector_type(4)));
typedef __bf16 bf2_t __attribute__((ext_vector_type(2)));

constexpr int S_ = 16384, D_ = 2048, DINP = 5632, DFF = 5632, DFF2 = 11264;
constexpr int NT = 512;
constexpr float EPS = 1e-6f;
constexpr float LOG2E = 1.4426950408889634f;

constexpr size_t OFF_CTRL = 0;
constexpr size_t OFF_MODP = 4096;
constexpr size_t OFF_XBAR = OFF_MODP + (size_t)2 * 16 * 12288 * 4;
constexpr size_t OFF_W = 2097152;
static_assert(OFF_XBAR + 3456 * 4 <= OFF_W, "xbar");
constexpr size_t W_IN = 0, W_OUT = W_IN + (size_t)5632 * 2048 * 2, W_UP = W_OUT + (size_t)2048 * 2048 * 2,
                 W_DOWN = W_UP + (size_t)11264 * 2048 * 2, W_UQ = W_DOWN + (size_t)2048 * 5632 * 2,
                 W_UKV = W_UQ + (size_t)768 * 448 * 2, W_END = W_UKV + (size_t)1024 * 128 * 2;
constexpr size_t OFF_H = OFF_W + W_END;
constexpr size_t OFF_MIXF = OFF_H + (size_t)S_ * 2048 * 2;
constexpr size_t OFF_QRAW = OFF_MIXF;
constexpr size_t OFF_KMLA = OFF_QRAW + (size_t)S_ * 768 * 4;
constexpr size_t OFF_VT = OFF_KMLA + (size_t)4 * S_ * 192 * 2;
constexpr size_t OFF_BIG = OFF_MIXF + (size_t)S_ * 2048 * 4;
constexpr size_t OFF_PROJ = OFF_BIG;
constexpr size_t OFF_WP = OFF_PROJ + (size_t)S_ * DINP * 2;
constexpr size_t OFF_QD = OFF_WP + (size_t)S_ * 1024 * 2;
constexpr size_t OFF_KT = OFF_QD + (size_t)S_ * 1024 * 2;
constexpr size_t OFF_ZT = OFF_KT + (size_t)S_ * 1024 * 2;
constexpr size_t OFF_QK = OFF_ZT + (size_t)S_ * 1024 * 2;
constexpr size_t OFF_AB = OFF_QK + (size_t)S_ * 512 * 2;
constexpr size_t OFF_GTOT = OFF_AB + (size_t)S_ * 16 * 4;
constexpr size_t OFF_Y = OFF_BIG;
constexpr size_t OFF_ACT = OFF_H;
constexpr size_t OFF_UT = OFF_BIG + (size_t)S_ * DFF2 * 2;
constexpr size_t OFF_END = OFF_UT + (size_t)S_ * 1024 * 4;
static_assert(OFF_GTOT + 8192 <= OFF_UT, "overlay");
static_assert(OFF_VT + (size_t)4 * 128 * S_ * 2 <= OFF_BIG, "overlay2");

constexpr int C_AQ = 0, C_AK = 1024, C_AV = 2048, C_AZ = 3072, C_AA = 4096, C_BCQ = 4112, C_BCKV = 4560,
              C_BKR = 4688, C_CQ = 4752, C_CK = 5264, C_CV = 5392;

__constant__ double kInvFreq2Pi[32] = {
    0.15915494309189535, 0.11934937021124886, 0.08949940160889101, 0.06711508300522726, 0.050329212104487035, 0.03774158471741977,
    0.0283021958306234, 0.02122365276477766, 0.015915494309189534, 0.011934937021124886, 0.008949940160889102, 0.006711508300522725,
    0.005032921210448704, 0.003774158471741977, 0.00283021958306234, 0.0021223652764777662, 0.0015915494309189536, 0.0011934937021124885,
    0.0008949940160889102, 0.0006711508300522726, 0.0005032921210448703, 0.00037741584717419774, 0.00028302195830623395, 0.0002122365276477766,
    0.00015915494309189535, 0.00011934937021124886, 8.949940160889102e-05, 6.711508300522725e-05, 5.0329212104487035e-05, 3.774158471741978e-05,
    2.8302195830623396e-05, 2.122365276477766e-05};

struct Params {
  const float* x; const float* c; const int* pos;
  const float *ada_w, *ada_b, *mix_pre, *mix_post, *w_in, *w_out, *gdn_conv, *gdn_a_log, *gdn_dt_bias, *gdn_norm, *mla_q_norm, *mla_w_uq,
      *mla_kv_norm, *mla_w_ukv, *swa_sinks, *ffn_pre, *ffn_post, *ffn_w_up, *ffn_conv, *ffn_conv_b, *ffn_w_down;
  float* out; char* ws;
};

DI unsigned pack2(float lo, float hi) { f32x2 v = {lo, hi}; bf2_t b = __builtin_convertvector(v, bf2_t); return __builtin_bit_cast(unsigned, b); }
DI bf16_t f2bf(float x) { return (bf16_t)(pack2(x, 0.f) & 0xffffu); }
DI float bflo(unsigned u) { return __uint_as_float(u << 16); }
DI float bfhi(unsigned u) { return __uint_as_float(u & 0xffff0000u); }
DI void unpack8(const u32x4& v, float* f) { f[0] = bflo(v.x); f[1] = bfhi(v.x); f[2] = bflo(v.y); f[3] = bfhi(v.y); f[4] = bflo(v.z); f[5] = bfhi(v.z); f[6] = bflo(v.w); f[7] = bfhi(v.w); }
DI bf16x8 pack8(float a0, float a1, float a2, float a3, float a4, float a5, float a6, float a7) {
  u32x4 p = {pack2(a0, a1), pack2(a2, a3), pack2(a4, a5), pack2(a6, a7)}; return __builtin_bit_cast(bf16x8, p); }
DI float silu_f(float x) { return x * __builtin_amdgcn_rcpf(1.f + __expf(-x)); }
DI float wave_sum(float v) { v += __shfl_xor(v, 32); v += __shfl_xor(v, 16); v += __shfl_xor(v, 8); v += __shfl_xor(v, 4); v += __shfl_xor(v, 2); v += __shfl_xor(v, 1); return v; }
DI int opaque_tid() { int t = threadIdx.x; asm volatile("" : "+v"(t)); return t; }
DI int crow(int r, int h) { return (r & 3) + 8 * (r >> 2) + 4 * h; }
DI int perm32(int k) { return 8 * ((k >> 2) & 3) + 4 * (k >> 4) + (k & 3); }
#define MFMA32(a, b, c) __builtin_amdgcn_mfma_f32_32x32x16_bf16((a), (b), (c), 0, 0, 0)
#define MFMA16(a, b, c) __builtin_amdgcn_mfma_f32_16x16x32_bf16((a), (b), (c), 0, 0, 0)

template <class Epi>
DI void gemm_tile(const bf16_t* __restrict__ A, int lda, const bf16_t* __restrict__ Bt, int ldb, int K, int m0, int n0, char* smem, const Epi& epi) {
  const int tid = opaque_tid(), lane = tid & 63, w = tid >> 6, wm = w >> 2, wn = w & 3, lq = lane & 31, h = lane >> 5;
  f32x16 acc[2][4];
#pragma unroll
  for (int i = 0; i < 2; ++i)
#pragma unroll
    for (int j = 0; j < 4; ++j)
#pragma unroll
      for (int r = 0; r < 16; ++r) acc[i][j][r] = 0.f;
  const int r0 = tid >> 3, c0 = tid & 7;
  const bf16_t* ag = A + (size_t)(m0 + r0) * lda + c0 * 8;
  const bf16_t* bg = Bt + (size_t)(n0 + r0) * ldb + c0 * 8;
  const int wofs = r0 * 128 + ((c0 ^ ((r0 >> 1) & 7)) << 4);
  char* sA = smem; char* sB = smem + 65536;
  u32x4 ra0[4], rb0[4], ra1[4], rb1[4];
  const int nk = K >> 6, swz = (lane >> 1) & 7;
  const int aoff = (64 * wn + lq) * 128, boff = (128 * wm + lq) * 128;
#define GLOAD(RA, RB, KT) { _Pragma("unroll") for (int i = 0; i < 4; ++i) { RA[i] = *(const u32x4*)(ag + (size_t)(KT) * 64 + (size_t)i * 64 * lda); RB[i] = *(const u32x4*)(bg + (size_t)(KT) * 64 + (size_t)i * 64 * ldb); } }
#define LWRITE(RA, RB, ST) { _Pragma("unroll") for (int i = 0; i < 4; ++i) { *(u32x4*)(sA + (ST) * 32768 + wofs + i * 8192) = RA[i]; *(u32x4*)(sB + (ST) * 32768 + wofs + i * 8192) = RB[i]; } }
#define KSTEP(ST, RA, RB, KN) { const char* cA = sA + (ST) * 32768; const char* cB = sB + (ST) * 32768; char* dA = sA + (1 - (ST)) * 32768; char* dB = sB + (1 - (ST)) * 32768; \
    const bf16_t* agn = ag + (size_t)(KN) * 64; const bf16_t* bgn = bg + (size_t)(KN) * 64; \
    _Pragma("unroll") for (int s = 0; s < 4; ++s) { const int co = (((2 * s + h) ^ swz) << 4); bf16x8 fa[2], fb[4]; \
      _Pragma("unroll") for (int ni = 0; ni < 2; ++ni) fa[ni] = *(const bf16x8*)(cB + aoff + ni * 4096 + co); \
      _Pragma("unroll") for (int mi = 0; mi < 4; ++mi) fb[mi] = *(const bf16x8*)(cA + boff + mi * 4096 + co); \
      *(u32x4*)(dA + wofs + s * 8192) = RA[s]; *(u32x4*)(dB + wofs + s * 8192) = RB[s]; \
      RA[s] = *(const u32x4*)(agn + (size_t)s * 64 * lda); RB[s] = *(const u32x4*)(bgn + (size_t)s * 64 * ldb); \
      _Pragma("unroll") for (int ni = 0; ni < 2; ++ni) _Pragma("unroll") for (int mi = 0; mi < 4; ++mi) acc[ni][mi] = MFMA32(fa[ni], fb[mi], acc[ni][mi]); \
      __builtin_amdgcn_sched_barrier(0); } }
  const int kl = nk - 1;
  GLOAD(ra0, rb0, 0);
  GLOAD(ra1, rb1, (1 < kl ? 1 : kl));
  LWRITE(ra0, rb0, 0);
  GLOAD(ra0, rb0, (2 < kl ? 2 : kl));
  __syncthreads();
  for (int kt = 0; kt < nk; kt += 2) {
    KSTEP(0, ra1, rb1, (kt + 3 < kl ? kt + 3 : kl));
    __syncthreads();
    if (kt + 1 < nk) {
      KSTEP(1, ra0, rb0, (kt + 4 < kl ? kt + 4 : kl));
      __syncthreads();
    }
  }
#undef GLOAD
#undef LWRITE
#undef KSTEP
#pragma unroll
  for (int ni = 0; ni < 2; ++ni)
#pragma unroll
    for (int mi = 0; mi < 4; ++mi)
#pragma unroll
      for (int rg = 0; rg < 4; ++rg) {
        const int m = m0 + 128 * wm + 32 * mi + lq, n = n0 + 64 * wn + 32 * ni + 8 * rg + 4 * h;
        epi(m, n, acc[ni][mi][4 * rg], acc[ni][mi][4 * rg + 1], acc[ni][mi][4 * rg + 2], acc[ni][mi][4 * rg + 3]);
      }
}

template <class Epi>
DI void gemm_tile_s(const bf16_t* __restrict__ A, int lda, const bf16_t* __restrict__ Bt, int ldb, int K, int m0, int n0, char* smem, const Epi& epi) {
  const int tid = opaque_tid(), lane = tid & 63, w = tid >> 6, wm = w >> 2, wn = w & 3, lq = lane & 31, h = lane >> 5;
  f32x16 acc[2][4];
#pragma unroll
  for (int i = 0; i < 2; ++i)
#pragma unroll
    for (int j = 0; j < 4; ++j)
#pragma unroll
      for (int r = 0; r < 16; ++r) acc[i][j][r] = 0.f;
  const int r0 = tid >> 3, c0 = tid & 7;
  const bf16_t* ag = A + (size_t)(m0 + r0) * lda + c0 * 8;
  const bf16_t* bg = Bt + (size_t)(n0 + r0) * ldb + c0 * 8;
  const int wofs = r0 * 128 + ((c0 ^ ((r0 >> 1) & 7)) << 4);
  char* sA = smem; char* sB = smem + 32768;
  u32x4 ra[4], rb[4];
#pragma unroll
  for (int i = 0; i < 4; ++i) { ra[i] = *(const u32x4*)(ag + (size_t)i * 64 * lda); rb[i] = *(const u32x4*)(bg + (size_t)i * 64 * ldb); }
#pragma unroll
  for (int i = 0; i < 4; ++i) { *(u32x4*)(sA + wofs + i * 8192) = ra[i]; *(u32x4*)(sB + wofs + i * 8192) = rb[i]; }
  __syncthreads();
  const int nk = K >> 6, swz = (lane >> 1) & 7;
  const int aoff = (64 * wn + lq) * 128, boff = (128 * wm + lq) * 128;
  for (int kt = 0; kt < nk; ++kt) {
    const char* cA = sA + (kt & 1) * 65536; const char* cB = sB + (kt & 1) * 65536;
    const bool more = (kt + 1 < nk);
    if (more) { ag += 64; bg += 64;
#pragma unroll
      for (int i = 0; i < 4; ++i) { ra[i] = *(const u32x4*)(ag + (size_t)i * 64 * lda); rb[i] = *(const u32x4*)(bg + (size_t)i * 64 * ldb); } }
#pragma unroll
    for (int s = 0; s < 4; ++s) {
      const int co = (((2 * s + h) ^ swz) << 4);
      bf16x8 fa[2], fb[4];
#pragma unroll
      for (int ni = 0; ni < 2; ++ni) fa[ni] = *(const bf16x8*)(cB + aoff + ni * 4096 + co);
#pragma unroll
      for (int mi = 0; mi < 4; ++mi) fb[mi] = *(const bf16x8*)(cA + boff + mi * 4096 + co);
#pragma unroll
      for (int ni = 0; ni < 2; ++ni)
#pragma unroll
        for (int mi = 0; mi < 4; ++mi) acc[ni][mi] = MFMA32(fa[ni], fb[mi], acc[ni][mi]);
    }
    if (more) { char* dA = sA + ((kt + 1) & 1) * 65536; char* dB = sB + ((kt + 1) & 1) * 65536;
#pragma unroll
      for (int i = 0; i < 4; ++i) { *(u32x4*)(dA + wofs + i * 8192) = ra[i]; *(u32x4*)(dB + wofs + i * 8192) = rb[i]; } }
    __syncthreads();
  }
#pragma unroll
  for (int ni = 0; ni < 2; ++ni)
#pragma unroll
    for (int mi = 0; mi < 4; ++mi)
#pragma unroll
      for (int rg = 0; rg < 4; ++rg) {
        const int m = m0 + 128 * wm + 32 * mi + lq, n = n0 + 64 * wn + 32 * ni + 8 * rg + 4 * h;
        epi(m, n, acc[ni][mi][4 * rg], acc[ni][mi][4 * rg + 1], acc[ni][mi][4 * rg + 2], acc[ni][mi][4 * rg + 3]);
      }
}

DI void tile_coord(int t, int npn, int& pm, int& pn) { const int g = t / (16 * npn), r = t % (16 * npn); pn = r >> 4; pm = g * 16 + (r & 15); }

struct EpiProj { bf16_t* proj; float* ab;
  DI void operator()(int m, int n, float v0, float v1, float v2, float v3) const {
    u32x2 pk = {pack2(v0, v1), pack2(v2, v3)}; *(u32x2*)(proj + (size_t)m * DINP + n) = pk;
    if (n >= C_AA && n < C_AA + 16) { f32x4 v = {v0, v1, v2, v3}; *(f32x4*)(ab + (size_t)m * 16 + (n - C_AA)) = v; } } };
struct EpiF32 { float* out; int ldc;
  DI void operator()(int m, int n, float v0, float v1, float v2, float v3) const { f32x4 v = {v0, v1, v2, v3}; *(f32x4*)(out + (size_t)m * ldc + n) = v; } };
struct EpiBf { bf16_t* out; int ldc;
  DI void operator()(int m, int n, float v0, float v1, float v2, float v3) const { u32x2 pk = {pack2(v0, v1), pack2(v2, v3)}; *(u32x2*)(out + (size_t)m * ldc + n) = pk; } };
struct EpiMlaQ { float* qraw; const float* rs; int m0;
  DI void operator()(int m, int n, float v0, float v1, float v2, float v3) const { const float r = rs[m - m0]; f32x4 v = {v0 * r, v1 * r, v2 * r, v3 * r}; *(f32x4*)(qraw + (size_t)m * 768 + n) = v; } };
struct EpiMlaKV { bf16_t* kmla; bf16_t* vt; const float* rs; int m0;
  DI void operator()(int m, int n, float v0, float v1, float v2, float v3) const {
    const float r = rs[m - m0]; const int hd = n >> 8, wi = n & 255;
    if (wi < 128) { u32x2 pk = {pack2(v0 * r, v1 * r), pack2(v2 * r, v3 * r)}; *(u32x2*)(kmla + ((size_t)hd * S_ + m) * 192 + wi) = pk; }
    else { bf16_t* p = vt + ((size_t)hd * 128 + (wi - 128)) * S_ + m; p[0] = f2bf(v0 * r); p[S_] = f2bf(v1 * r); p[2 * (size_t)S_] = f2bf(v2 * r); p[3 * (size_t)S_] = f2bf(v3 * r); } } };

template <class Epi>
DI void gemm_phase(const bf16_t* A, int lda, const bf16_t* Bt, int ldb, int K, int npm, int npn, char* smem, const Epi& epi) {
  if (gridDim.x == 256 && npm == 64) {
    const int b = blockIdx.x, pm = 8 * (b & 7) + ((b >> 3) & 7), pj = b >> 6;
    for (int pn = pj; pn < npn; pn += 4) gemm_tile(A, lda, Bt, ldb, K, pm * 256, pn * 256, smem, epi);
  } else {
    for (int t = blockIdx.x; t < npm * npn; t += gridDim.x) { int pm, pn; tile_coord(t, npn, pm, pn); gemm_tile(A, lda, Bt, ldb, K, pm * 256, pn * 256, smem, epi); }
  }
}

DI void mod_item(const Params& P, int item) {
  const int tid = opaque_tid(); const int l = item / 96, r = item % 96, ks = r / 6, nc = r % 6;
  const int n = nc * 2048 + tid * 4;
  const float* wp = P.ada_w + ((size_t)l * 2048 + ks * 128) * 12288 + n;
  f32x4 acc = {0.f, 0.f, 0.f, 0.f};
#pragma unroll 8
  for (int k = 0; k < 128; ++k) { const float cv = P.c[ks * 128 + k]; const float ca = silu_f(cv); const f32x4 wv = *(const f32x4*)(wp + (size_t)k * 12288); acc += wv * ca; }
  float* modp = (float*)(P.ws + OFF_MODP);
  *(f32x4*)(modp + ((size_t)l * 16 + ks) * 12288 + n) = acc;
}
DI void convert_tile(const float* __restrict__ src, int K, int N, bf16_t* __restrict__ dst, int tk, int tn, const float* rowscale, char* smem) {
  float* sm = (float*)smem; const int tid = opaque_tid(); const int k0 = tk * 64, n0 = tn * 256;
  { const int r = tid >> 6, c4 = tid & 63; const int n = n0 + 4 * c4;
    f32x4 v[8];
#pragma unroll
    for (int i = 0; i < 8; ++i) { v[i] = (f32x4){0.f, 0.f, 0.f, 0.f}; if (n < N) v[i] = *(const f32x4*)(src + (size_t)(k0 + r + 8 * i) * N + n); }
#pragma unroll
    for (int i = 0; i < 8; ++i) { const int kk = r + 8 * i; if (rowscale) v[i] *= rowscale[k0 + kk];
      sm[kk * 257 + 4 * c4 + 0] = v[i].x; sm[kk * 257 + 4 * c4 + 1] = v[i].y; sm[kk * 257 + 4 * c4 + 2] = v[i].z; sm[kk * 257 + 4 * c4 + 3] = v[i].w; } }
  __syncthreads();
  { const int n = tid >> 1, kh = tid & 1;
#pragma unroll
    for (int j = 0; j < 4; ++j) { float f[8];
#pragma unroll
      for (int i = 0; i < 8; ++i) f[i] = sm[(32 * kh + 8 * j + i) * 257 + n];
      u32x4 pk = {pack2(f[0], f[1]), pack2(f[2], f[3]), pack2(f[4], f[5]), pack2(f[6], f[7])};
      *(u32x4*)(dst + (size_t)(n0 + n) * K + k0 + 32 * kh + 8 * j) = pk; } }
  __syncthreads();
}
constexpr int CV_T0 = 32 * 22, CV_T1 = CV_T0 + 32 * 8, CV_T2 = CV_T1 + 32 * 44, CV_T3 = CV_T2 + 88 * 8, CV_T4 = CV_T3 + 7 * 3, CV_T5 = CV_T4 + 2 * 4;
DI void convert_item(const Params& P, int l, int it, char* smem) {
  char* wb = P.ws + OFF_W;
  if (it < CV_T0) convert_tile(P.w_in + (size_t)l * 2048 * 5520, 2048, 5520, (bf16_t*)(wb + W_IN), it / 22, it % 22, nullptr, smem);
  else if (it < CV_T1) { it -= CV_T0; convert_tile(P.w_out + (size_t)l * 2048 * 2048, 2048, 2048, (bf16_t*)(wb + W_OUT), it / 8, it % 8, nullptr, smem); }
  else if (it < CV_T2) { it -= CV_T1; convert_tile(P.ffn_w_up + (size_t)l * 2048 * 11264, 2048, 11264, (bf16_t*)(wb + W_UP), it / 44, it % 44, nullptr, smem); }
  else if (it < CV_T3) { it -= CV_T2; convert_tile(P.ffn_w_down + (size_t)l * 5632 * 2048, 5632, 2048, (bf16_t*)(wb + W_DOWN), it / 8, it % 8, nullptr, smem); }
  else if (it < CV_T4) { it -= CV_T3; convert_tile(P.mla_w_uq + (size_t)l * 448 * 768, 448, 768, (bf16_t*)(wb + W_UQ), it / 3, it % 3, P.mla_q_norm + l * 448, smem); }
  else { it -= CV_T4; convert_tile(P.mla_w_ukv + (size_t)l * 128 * 1024, 128, 1024, (bf16_t*)(wb + W_UKV), it / 4, it % 4, P.mla_kv_norm + l * 128, smem); }
}

DI float mod_val(const float* modp_l, const float* ada_b_l, int idx) { float s = ada_b_l[idx];
#pragma unroll
  for (int k = 0; k < 16; ++k) s += modp_l[(size_t)k * 12288 + idx]; return s; }
DI void rownorm_phase(const Params& P, const float* xin, const bf16_t* yin, float* xout, bf16_t* hout, int lg, int gate_idx, const float* w_post,
                      int lh, int scale_idx, int shift_idx, const float* w_pre, char* smem) {
  float* A1 = (float*)smem; float* A2 = A1 + 2048; float* B2 = A2 + 2048;
  const int tid = opaque_tid(), lane = tid & 63, w = tid >> 6;
  const float* modp = (const float*)(P.ws + OFF_MODP);
  for (int cidx = tid; cidx < 2048; cidx += NT) {
    if (yin) A1[cidx] = mod_val(modp + (size_t)lg * 16 * 12288, P.ada_b + (size_t)lg * 12288, gate_idx * 2048 + cidx) * w_post[cidx];
    if (hout) { A2[cidx] = w_pre[cidx] * (1.f + mod_val(modp + (size_t)lh * 16 * 12288, P.ada_b + (size_t)lh * 12288, scale_idx * 2048 + cidx));
      B2[cidx] = mod_val(modp + (size_t)lh * 16 * 12288, P.ada_b + (size_t)lh * 12288, shift_idx * 2048 + cidx); }
  }
  __syncthreads();
  for (int row = blockIdx.x * 8 + w; row < S_; row += gridDim.x * 8) {
    f32x4 xv[8];
#pragma unroll
    for (int j = 0; j < 8; ++j) xv[j] = *(const f32x4*)(xin + (size_t)row * 2048 + (j * 64 + lane) * 4);
    if (yin) {
      f32x4 yv[8]; float ss = 0.f;
#pragma unroll
      for (int j = 0; j < 8; ++j) { const u32x2 yb = *(const u32x2*)(yin + (size_t)row * 2048 + (j * 64 + lane) * 4); yv[j] = (f32x4){bflo(yb.x), bfhi(yb.x), bflo(yb.y), bfhi(yb.y)};
        ss += yv[j].x * yv[j].x + yv[j].y * yv[j].y + yv[j].z * yv[j].z + yv[j].w * yv[j].w; }
      ss = wave_sum(ss); const float r = rsqrtf(ss * (1.f / 2048.f) + EPS);
#pragma unroll
      for (int j = 0; j < 8; ++j) { const f32x4 a = *(const f32x4*)(A1 + (j * 64 + lane) * 4); xv[j] += a * (yv[j] * r); }
    }
    if (yin || xout != xin) {
#pragma unroll
      for (int j = 0; j < 8; ++j) *(f32x4*)(xout + (size_t)row * 2048 + (j * 64 + lane) * 4) = xv[j];
    }
    if (hout) {
      float ss = 0.f;
#pragma unroll
      for (int j = 0; j < 8; ++j) ss += xv[j].x * xv[j].x + xv[j].y * xv[j].y + xv[j].z * xv[j].z + xv[j].w * xv[j].w;
      ss = wave_sum(ss); const float r = rsqrtf(ss * (1.f / 2048.f) + EPS);
#pragma unroll
      for (int j = 0; j < 8; ++j) { const f32x4 a = *(const f32x4*)(A2 + (j * 64 + lane) * 4), b = *(const f32x4*)(B2 + (j * 64 + lane) * 4);
        const f32x4 hv = xv[j] * r * a + b; u32x2 pk = {pack2(hv.x, hv.y), pack2(hv.z, hv.w)};
        *(u32x2*)(hout + (size_t)row * 2048 + (j * 64 + lane) * 4) = pk; }
    }
  }
  __syncthreads();
}

DI void mla_q_tile(const Params& P, int pm, int pn, char* smem) {
  const bf16_t* proj = (const bf16_t*)(P.ws + OFF_PROJ); const int tid = opaque_tid(), m0 = pm * 256; float* rs = (float*)(smem + 131072);
  { const int row = tid >> 1, half = tid & 1; const bf16_t* p = proj + (size_t)(m0 + row) * DINP + C_BCQ + half * 224; float ss = 0.f;
    for (int i = 0; i < 28; ++i) { const u32x4 v = *(const u32x4*)(p + i * 8); float f[8]; unpack8(v, f);
#pragma unroll
      for (int e = 0; e < 8; ++e) ss += f[e] * f[e]; }
    ss += __shfl_xor(ss, 1); if (half == 0) rs[row] = rsqrtf(ss * (1.f / 448.f) + EPS); }
  EpiMlaQ epi{(float*)(P.ws + OFF_QRAW), rs, m0};
  gemm_tile_s(proj + C_BCQ, DINP, (const bf16_t*)(P.ws + OFF_W + W_UQ), 448, 448, m0, pn * 256, smem, epi);
  __syncthreads();
}
DI void mla_kv_tile(const Params& P, int pm, int pn, char* smem) {
  const bf16_t* proj = (const bf16_t*)(P.ws + OFF_PROJ); const int tid = opaque_tid(), m0 = pm * 256; float* rs = (float*)(smem + 131072);
  { const int row = tid >> 1, half = tid & 1; const bf16_t* p = proj + (size_t)(m0 + row) * DINP + C_BCKV + half * 64; float ss = 0.f;
#pragma unroll
    for (int i = 0; i < 8; ++i) { const u32x4 v = *(const u32x4*)(p + i * 8); float f[8]; unpack8(v, f);
#pragma unroll
      for (int e = 0; e < 8; ++e) ss += f[e] * f[e]; }
    ss += __shfl_xor(ss, 1); if (half == 0) rs[row] = rsqrtf(ss * (1.f / 128.f) + EPS); }
  bf16_t* kmla = (bf16_t*)(P.ws + OFF_KMLA);
  EpiMlaKV epi{kmla, (bf16_t*)(P.ws + OFF_VT), rs, m0};
  gemm_tile_s(proj + C_BCKV, DINP, (const bf16_t*)(P.ws + OFF_W + W_UKV), 128, 128, m0, pn * 256, smem, epi);
  if (pn == 0) {
    for (int i = 0; i < 16; ++i) { const int idx = tid + NT * i, row = idx >> 5, pi = idx & 31, m = m0 + row;
      const float x1 = bflo((unsigned)proj[(size_t)m * DINP + C_BKR + pi]), x2 = bflo((unsigned)proj[(size_t)m * DINP + C_BKR + 32 + pi]);
      double fr = (double)P.pos[m] * kInvFreq2Pi[pi]; fr -= floor(fr); const float ff = (float)fr;
      const float sn = __builtin_amdgcn_sinf(ff), cs = __builtin_amdgcn_cosf(ff);
      const bf16_t o1 = f2bf(x1 * cs - x2 * sn), o2 = f2bf(x2 * cs + x1 * sn);
#pragma unroll
      for (int hd = 0; hd < 4; ++hd) { bf16_t* kp = kmla + ((size_t)hd * S_ + m) * 192 + 128; kp[pi] = o1; kp[32 + pi] = o2; } }
  }
  __syncthreads();
}

DI void gdn_prep_item(const Params& P, int l, int n, int hh, char* smem) {
  const int tid = opaque_tid(), lane = tid & 63, w = tid >> 6, lq = lane & 31, h = lane >> 5;
  const bf16_t* proj = (const bf16_t*)(P.ws + OFF_PROJ); const float* ab = (const float*)(P.ws + OFF_AB);
  char* kb16 = smem; char* qb16 = smem + 17408;
  float* kf = (float*)(smem + 34816); float* vf = kf + 8192; float* Lm = vf + 8192; float* gcs = Lm + 4096;
  const size_t tile = (size_t)hh * 256 + n; const int t0 = n * 64;
  bf16_t* Wp = (bf16_t*)(P.ws + OFF_WP) + tile * 8192; bf16_t* Qd = (bf16_t*)(P.ws + OFF_QD) + tile * 8192;
  bf16_t* Kt = (bf16_t*)(P.ws + OFF_KT) + tile * 8192; bf16_t* Zt = (bf16_t*)(P.ws + OFF_ZT) + tile * 8192;
  bf16_t* QK = (bf16_t*)(P.ws + OFF_QK) + tile * 4096; bf16_t* Ut = (bf16_t*)(P.ws + OFF_UT) + tile * 8192;
  if (w == 0) {
    const int t = lane; const float a_raw = ab[(size_t)(t0 + t) * 16 + hh], b_raw = ab[(size_t)(t0 + t) * 16 + 8 + hh];
    const float Aa = __expf(P.gdn_a_log[l * 8 + hh]); const float xb = a_raw + P.gdn_dt_bias[l * 8 + hh];
    const float ex = __expf(fminf(xb, 20.f));
    const float sp = xb > 20.f ? xb : (ex < 0.01f ? ex * (1.f - ex * (0.5f - ex * (1.f / 3.f))) : __logf(1.f + ex));
    float g = -Aa * sp;
#pragma unroll
    for (int d = 1; d < 64; d <<= 1) { const float v = __shfl_up(g, d); if (lane >= d) g += v; }
    const float bt = __builtin_amdgcn_rcpf(1.f + __expf(-b_raw)), eg = __expf(g); gcs[t] = g; gcs[64 + t] = bt; gcs[128 + t] = eg; gcs[192 + t] = bt * eg;
    if (t == 63) ((float*)(P.ws + OFF_GTOT))[tile] = eg;
  }
  __syncthreads();
  {
    const int t = tid >> 3, part = tid & 7, tabs = t0 + t;
    const float gct = gcs[t], egct = gcs[128 + t], ktl = __expf(gcs[63] - gct);
    const int pjt = 32 * (t >> 5) + perm32(t & 31);
#pragma unroll
    for (int X = 0; X < 3; ++X) {
      const int cb = X * 1024 + hh * 128 + part * 16;
      float y[16];
#pragma unroll
      for (int e = 0; e < 16; ++e) y[e] = 0.f;
      u32x4 pv[4][2]; f32x4 wv[4][4];
#pragma unroll
      for (int j = 0; j < 4; ++j) { const int row = tabs - 3 + j, rr = row < 0 ? 0 : row;
        pv[j][0] = *(const u32x4*)(proj + (size_t)rr * DINP + cb); pv[j][1] = *(const u32x4*)(proj + (size_t)rr * DINP + cb + 8);
        const float* cw = P.gdn_conv + ((size_t)l * 4 + j) * 3072 + cb;
#pragma unroll
        for (int e4 = 0; e4 < 4; ++e4) wv[j][e4] = *(const f32x4*)(cw + 4 * e4); }
      __builtin_amdgcn_sched_barrier(0);
#pragma unroll
      for (int j = 0; j < 4; ++j) { const float msk = (tabs - 3 + j) >= 0 ? 1.f : 0.f;
        float xv[16]; unpack8(pv[j][0], xv); unpack8(pv[j][1], xv + 8);
#pragma unroll
        for (int e4 = 0; e4 < 4; ++e4) { const f32x4 wm = wv[j][e4] * msk; y[4 * e4] += wm.x * xv[4 * e4]; y[4 * e4 + 1] += wm.y * xv[4 * e4 + 1]; y[4 * e4 + 2] += wm.z * xv[4 * e4 + 2]; y[4 * e4 + 3] += wm.w * xv[4 * e4 + 3]; } }
#pragma unroll
      for (int e = 0; e < 16; ++e) y[e] = silu_f(y[e]);
      if (X < 2) { float ss = 0.f;
#pragma unroll
        for (int e = 0; e < 16; ++e) ss += y[e] * y[e];
        ss += __shfl_xor(ss, 1); ss += __shfl_xor(ss, 2); ss += __shfl_xor(ss, 4);
        const float rn = rsqrtf(ss + EPS) * (X == 0 ? 0.08838834764831845f : 1.f);
#pragma unroll
        for (int e = 0; e < 16; ++e) y[e] *= rn; }
      if (X == 0) {
        u32x4 p0 = {pack2(y[0], y[1]), pack2(y[2], y[3]), pack2(y[4], y[5]), pack2(y[6], y[7])}, p1 = {pack2(y[8], y[9]), pack2(y[10], y[11]), pack2(y[12], y[13]), pack2(y[14], y[15])};
        *(u32x4*)(qb16 + t * 272 + part * 32) = p0; *(u32x4*)(qb16 + t * 272 + part * 32 + 16) = p1;
#pragma unroll
        for (int b = 0; b < 4; ++b) { u32x2 pk = {pack2(y[4 * b] * egct, y[4 * b + 1] * egct), pack2(y[4 * b + 2] * egct, y[4 * b + 3] * egct)};
          *(u32x2*)(Qd + t * 128 + 32 * (part >> 1) + 8 * b + 4 * (part & 1)) = pk; }
      } else if (X == 1) {
        u32x4 p0 = {pack2(y[0], y[1]), pack2(y[2], y[3]), pack2(y[4], y[5]), pack2(y[6], y[7])}, p1 = {pack2(y[8], y[9]), pack2(y[10], y[11]), pack2(y[12], y[13]), pack2(y[14], y[15])};
        *(u32x4*)(kb16 + t * 272 + part * 32) = p0; *(u32x4*)(kb16 + t * 272 + part * 32 + 16) = p1;
#pragma unroll
        for (int e4 = 0; e4 < 4; ++e4) { f32x4 v = {y[4 * e4], y[4 * e4 + 1], y[4 * e4 + 2], y[4 * e4 + 3]}; *(f32x4*)(kf + t * 128 + part * 16 + 4 * e4) = v; }
#pragma unroll
        for (int e = 0; e < 16; ++e) Kt[(part * 16 + e) * 64 + pjt] = f2bf(y[e] * ktl);
      } else {
#pragma unroll
        for (int e4 = 0; e4 < 4; ++e4) { f32x4 v = {y[4 * e4], y[4 * e4 + 1], y[4 * e4 + 2], y[4 * e4 + 3]}; *(f32x4*)(vf + t * 128 + part * 16 + 4 * e4) = v; }
      }
    }
    { const int cb = C_AZ + hh * 128 + part * 16; const u32x4 v0 = *(const u32x4*)(proj + (size_t)tabs * DINP + cb), v1 = *(const u32x4*)(proj + (size_t)tabs * DINP + cb + 8);
      float zv[16]; unpack8(v0, zv); unpack8(v1, zv + 8);
#pragma unroll
      for (int e = 0; e < 16; ++e) Zt[(part * 16 + e) * 64 + t] = f2bf(silu_f(zv[e])); }
  }
  __syncthreads();
  {
    const int which = w >> 2, ti = (w >> 1) & 1, tj = w & 1; const char* Ab = which ? qb16 : kb16;
    f32x16 acc;
#pragma unroll
    for (int r = 0; r < 16; ++r) acc[r] = 0.f;
#pragma unroll
    for (int s = 0; s < 8; ++s) { const bf16x8 a = *(const bf16x8*)(Ab + (32 * ti + lq) * 272 + (16 * s + 8 * h) * 2), b = *(const bf16x8*)(kb16 + (32 * tj + lq) * 272 + (16 * s + 8 * h) * 2);
      acc = MFMA32(a, b, acc); }
    const int j = 32 * tj + lq; const float gj = gcs[j]; const int pj = 32 * (j >> 5) + perm32(j & 31);
#pragma unroll
    for (int r = 0; r < 16; ++r) { const int i = 32 * ti + crow(r, h); const float dec = __expf(fminf(gcs[i] - gj, 0.f));
      if (which == 0) Lm[i * 64 + j] = (j < i) ? gcs[64 + i] * acc[r] * dec : 0.f;
      else QK[i * 64 + pj] = f2bf((j <= i) ? acc[r] * dec : 0.f); }
  }
  __syncthreads();
  if (tid < 256) {
    const int c = tid; const bool isu = c < 128; const int cc = c & 127;
    const float* rp = (isu ? vf : kf) + cc; const float* sp = gcs + (isu ? 64 : 192);
    f32x2 xx[32];
    f32x4 LA[16], LB[16]; float rh[2];
    xx[0].x = sp[0] * rp[0];
    LA[0] = *(const f32x4*)(Lm + 64); rh[1] = sp[1] * rp[128];
#pragma unroll
    for (int i = 1; i < 64; ++i) {
      f32x4 (&CUR)[16] = (i & 1) ? LA : LB; f32x4 (&NXT)[16] = (i & 1) ? LB : LA;
      if (i + 1 < 64) {
#pragma unroll
        for (int c = 0; c < (i + 4) / 4; ++c) NXT[c] = *(const f32x4*)(Lm + (i + 1) * 64 + 4 * c);
        rh[(i + 1) & 1] = sp[i + 1] * rp[(i + 1) * 128];
      }
      __builtin_amdgcn_sched_barrier(0);
      f32x2 acc = {rh[i & 1], 0.f};
#pragma unroll
      for (int p = 0; p < i / 2; ++p) { const f32x2 lp = (p & 1) ? (f32x2){CUR[p >> 1].z, CUR[p >> 1].w} : (f32x2){CUR[p >> 1].x, CUR[p >> 1].y}; acc = acc - lp * xx[p]; }
      if (i & 1) { const int j = i - 1; const float lj = ((j & 3) == 0) ? CUR[j >> 2].x : CUR[j >> 2].z; acc.x = fmaf(-lj, xx[j >> 1].x, acc.x); }
      const float xi = acc.x + acc.y;
      if (i & 1) xx[i >> 1].y = xi; else xx[i >> 1].x = xi;
      __builtin_amdgcn_sched_barrier(0);
    }
    float x[64];
#pragma unroll
    for (int p = 0; p < 32; ++p) { x[2 * p] = xx[p].x; x[2 * p + 1] = xx[p].y; }
    if (isu) {
#pragma unroll
      for (int i8 = 0; i8 < 8; ++i8) { u32x4 v = {pack2(x[8 * i8], x[8 * i8 + 1]), pack2(x[8 * i8 + 2], x[8 * i8 + 3]), pack2(x[8 * i8 + 4], x[8 * i8 + 5]), pack2(x[8 * i8 + 6], x[8 * i8 + 7])}; *(u32x4*)(Ut + cc * 64 + 8 * i8) = v; }
    } else {
      const int pp = 32 * (cc >> 5) + perm32(cc & 31);
#pragma unroll
      for (int i = 0; i < 64; ++i) Wp[i * 128 + pp] = f2bf(x[i]);
    }
  }
  __syncthreads();
}

DI bf16x8 pack_tiles(const f32x4& a, const f32x4& b) { return pack8(a.x, a.y, a.z, a.w, b.x, b.y, b.z, b.w); }
template <int CTRL> DI float dppf(float v) { return __int_as_float(__builtin_amdgcn_update_dpp(0, __float_as_int(v), CTRL, 0xf, 0xf, true)); }
DI float row16_sum(float v) { v += dppf<0xB1>(v); v += dppf<0x4E>(v); v += dppf<0x141>(v); v += dppf<0x140>(v); return v; }
constexpr size_t OFF_SSQP = OFF_GTOT + 8192;
static_assert(OFF_SSQP + (size_t)8 * S_ * 8 * 4 <= OFF_UT, "overlay3");
constexpr int SCAN_OPB = 62464;
constexpr int SCAN_SO = 2 * SCAN_OPB;
DI void gdn_scan_item(const Params& P, int l, int hh, int half, char* smem) {
  const int tid = opaque_tid(), lane = tid & 63, w = tid >> 6, l15 = lane & 15, q4 = lane >> 4;
  const size_t hb = (size_t)hh * 256;
  const bf16_t* Wp = (const bf16_t*)(P.ws + OFF_WP) + hb * 8192; const bf16_t* Qd = (const bf16_t*)(P.ws + OFF_QD) + hb * 8192;
  const bf16_t* Kt = (const bf16_t*)(P.ws + OFF_KT) + hb * 8192; const bf16_t* Zt = (const bf16_t*)(P.ws + OFF_ZT) + hb * 8192;
  const bf16_t* QK = (const bf16_t*)(P.ws + OFF_QK) + hb * 4096; const bf16_t* Ut = (const bf16_t*)(P.ws + OFF_UT) + hb * 8192;
  const float* gt = (const float*)(P.ws + OFF_GTOT) + hb;
  bf16_t* mixin = (bf16_t*)(P.ws + OFF_H);
  if (w >= 4) {
    const int lt = tid - 256, wl = w - 4;
    const int dvc = 64 * half + 16 * wl + l15; const float nw = P.gdn_norm[l * 128 + dvc];
    const int uoff = dvc * 64 + 4 * q4;
    float* ssqp = (float*)(P.ws + OFF_SSQP) + (size_t)(half * 4 + wl) * S_ * 8;
    const int g256 = (lt >> 4) * 128 + (lt & 15) * 8, l256 = (lt >> 4) * 272 + (lt & 15) * 16;
    const int g128 = (lt >> 3) * 64 + (lt & 7) * 8, l128 = (lt >> 3) * 144 + (lt & 7) * 16;
    u32x4 pw[4], pq[4], pk[4], pqk[2]; u32x2 zc[4], zn[4];
#pragma unroll
    for (int i = 0; i < 4; ++i) { pw[i] = *(const u32x4*)(Wp + g256 + i * 2048); pq[i] = *(const u32x4*)(Qd + g256 + i * 2048); pk[i] = *(const u32x4*)(Kt + g128 + i * 2048); }
#pragma unroll
    for (int i = 0; i < 2; ++i) pqk[i] = *(const u32x4*)(QK + g128 + i * 2048);
#pragma unroll
    for (int i = 0; i < 4; ++i) { *(u32x4*)(smem + l256 + i * 4352) = pw[i]; *(u32x4*)(smem + 17408 + l256 + i * 4352) = pq[i]; *(u32x4*)(smem + 34816 + l128 + i * 4608) = pk[i]; }
#pragma unroll
    for (int i = 0; i < 2; ++i) *(u32x4*)(smem + 53248 + l128 + i * 4608) = pqk[i];
#pragma unroll
    for (int i = 0; i < 4; ++i) { pw[i] = *(const u32x4*)(Wp + 8192 + g256 + i * 2048); pq[i] = *(const u32x4*)(Qd + 8192 + g256 + i * 2048); pk[i] = *(const u32x4*)(Kt + 8192 + g128 + i * 2048); }
#pragma unroll
    for (int i = 0; i < 2; ++i) pqk[i] = *(const u32x4*)(QK + 4096 + g128 + i * 2048);
#pragma unroll
    for (int it = 0; it < 4; ++it) { zc[it] = (u32x2){0u, 0u}; zn[it] = zc[it]; }
    __syncthreads();
#pragma unroll 1
    for (int n = 0; n <= 256; ++n) {
      if (n < 256) {
        char* nb = smem + ((n + 1) & 1) * SCAN_OPB;
        if (n + 1 < 256) {
#pragma unroll
          for (int i = 0; i < 4; ++i) { *(u32x4*)(nb + l256 + i * 4352) = pw[i]; *(u32x4*)(nb + 17408 + l256 + i * 4352) = pq[i]; *(u32x4*)(nb + 34816 + l128 + i * 4608) = pk[i]; }
#pragma unroll
          for (int i = 0; i < 2; ++i) *(u32x4*)(nb + 53248 + l128 + i * 4608) = pqk[i];
        }
        if (n + 2 < 256) { const size_t o8 = (size_t)(n + 2) * 8192, o4 = (size_t)(n + 2) * 4096;
#pragma unroll
          for (int i = 0; i < 4; ++i) { pw[i] = *(const u32x4*)(Wp + o8 + g256 + i * 2048); pq[i] = *(const u32x4*)(Qd + o8 + g256 + i * 2048); pk[i] = *(const u32x4*)(Kt + o8 + g128 + i * 2048); }
#pragma unroll
          for (int i = 0; i < 2; ++i) pqk[i] = *(const u32x4*)(QK + o4 + g128 + i * 2048); }
#pragma unroll
        for (int it = 0; it < 4; ++it) zn[it] = *(const u32x2*)(Zt + (size_t)n * 8192 + uoff + 16 * it);
      }
      if (n >= 1) {
        const int m = n - 1; const char* so = smem + SCAN_SO + (m & 1) * 16384 + (wl * 4) * 1024 + lane * 16;
#pragma unroll
        for (int it = 0; it < 4; ++it) {
          const f32x4 o = *(const f32x4*)(so + it * 1024);
          f32x4 ss = o * o;
          ss.x = row16_sum(ss.x); ss.y = row16_sum(ss.y); ss.z = row16_sum(ss.z); ss.w = row16_sum(ss.w);
          const int row = 64 * m + 16 * it + 4 * q4;
          if (l15 == 0) { float* sp = ssqp + (size_t)row * 8 + hh; sp[0] = ss.x; sp[8] = ss.y; sp[16] = ss.z; sp[24] = ss.w; }
          const float z0 = bflo(zc[it].x), z1 = bfhi(zc[it].x), z2 = bflo(zc[it].y), z3 = bfhi(zc[it].y);
          bf16_t* op = mixin + (size_t)row * 2048 + hh * 128 + dvc;
          op[0] = f2bf(o.x * nw * z0); op[2048] = f2bf(o.y * nw * z1); op[4096] = f2bf(o.z * nw * z2); op[6144] = f2bf(o.w * nw * z3);
        }
      }
#pragma unroll
      for (int it = 0; it < 4; ++it) zc[it] = zn[it];
      if (n < 256) __syncthreads();
    }
  } else {
    const int dvc = 64 * half + 16 * w + l15;
    const int uoff = dvc * 64 + 4 * q4;
    f32x4 St[8];
#pragma unroll
    for (int t = 0; t < 8; ++t) St[t] = (f32x4){0.f, 0.f, 0.f, 0.f};
    u32x2 uc[4], un[4]; float gcur, gn = 0.f;
#pragma unroll
    for (int it = 0; it < 4; ++it) { uc[it] = *(const u32x2*)(Ut + uoff + 16 * it); un[it] = uc[it]; }
    gcur = gt[0];
    __syncthreads();
#pragma unroll 2
    for (int n = 0; n < 256; ++n) {
      const char* cb = smem + (n & 1) * SCAN_OPB;
      const char* sWp = cb; const char* sQd = cb + 17408; const char* sKt = cb + 34816; const char* sQK = cb + 53248;
      if (n + 1 < 256) { const size_t o8 = (size_t)(n + 1) * 8192;
#pragma unroll
        for (int it = 0; it < 4; ++it) un[it] = *(const u32x2*)(Ut + o8 + uoff + 16 * it);
        gn = gt[n + 1]; }
      bf16x8 sb[4];
#pragma unroll
      for (int ks = 0; ks < 4; ++ks) sb[ks] = pack_tiles(St[2 * ks], St[2 * ks + 1]);
      f32x4 wsv[4], qs[4];
#pragma unroll
      for (int it = 0; it < 4; ++it) { wsv[it] = (f32x4){0.f, 0.f, 0.f, 0.f}; qs[it] = (f32x4){0.f, 0.f, 0.f, 0.f}; }
#pragma unroll
      for (int it = 0; it < 4; ++it)
#pragma unroll
        for (int ks = 0; ks < 4; ++ks) { const int o = (16 * it + l15) * 272 + 64 * ks + 16 * q4;
          const bf16x8 a = *(const bf16x8*)(sWp + o), a2 = *(const bf16x8*)(sQd + o);
          wsv[it] = MFMA16(a, sb[ks], wsv[it]); qs[it] = MFMA16(a2, sb[ks], qs[it]); }
      f32x4 vn[4];
#pragma unroll
      for (int it = 0; it < 4; ++it) { const f32x4 uf = {bflo(uc[it].x), bfhi(uc[it].x), bflo(uc[it].y), bfhi(uc[it].y)}; vn[it] = uf - wsv[it]; }
      bf16x8 vb[2];
#pragma unroll
      for (int ks = 0; ks < 2; ++ks) vb[ks] = pack_tiles(vn[2 * ks], vn[2 * ks + 1]);
#pragma unroll
      for (int it = 0; it < 4; ++it)
#pragma unroll
        for (int ks = 0; ks < 2; ++ks) { const bf16x8 a = *(const bf16x8*)(sQK + (16 * it + l15) * 144 + 64 * ks + 16 * q4); qs[it] = MFMA16(a, vb[ks], qs[it]); }
      { char* so = smem + SCAN_SO + (n & 1) * 16384 + (w * 4) * 1024 + lane * 16;
#pragma unroll
        for (int it = 0; it < 4; ++it) *(f32x4*)(so + it * 1024) = qs[it]; }
#pragma unroll
      for (int t = 0; t < 8; ++t) { St[t] *= gcur;
#pragma unroll
        for (int ks = 0; ks < 2; ++ks) { const bf16x8 a = *(const bf16x8*)(sKt + (16 * t + l15) * 144 + 64 * ks + 16 * q4); St[t] = MFMA16(a, vb[ks], St[t]); } }
#pragma unroll
      for (int it = 0; it < 4; ++it) uc[it] = un[it];
      gcur = gn;
      __syncthreads();
    }
  }
  __syncthreads();
}
DI void gdn_fix_phase(const Params& P) {
  const int tid = opaque_tid();
  bf16_t* mixin = (bf16_t*)(P.ws + OFF_H); const float* ssqp = (const float*)(P.ws + OFF_SSQP);
  for (int idx = blockIdx.x * NT + tid; idx < S_ * 128; idx += gridDim.x * NT) {
    const int t = idx >> 7, ck = idx & 127, h = ck >> 4;
    float sq = 0.f;
#pragma unroll
    for (int p = 0; p < 8; ++p) sq += ssqp[((size_t)p * S_ + t) * 8 + h];
    const float r = rsqrtf(sq * (1.f / 128.f) + EPS);
    u32x4* pp = (u32x4*)(mixin + (size_t)t * 2048 + ck * 8); const u32x4 v = *pp; float f[8]; unpack8(v, f);
    u32x4 o = {pack2(f[0] * r, f[1] * r), pack2(f[2] * r, f[3] * r), pack2(f[4] * r, f[5] * r), pack2(f[6] * r, f[7] * r)}; *pp = o;
  }
}

DI void mla_attn_item(const Params& P, int hd, int b, char* smem) {
  const int tid = opaque_tid(), lane = tid & 63, w = tid >> 6, wq = w & 3, hk = w >> 2, lq = lane & 31, h = lane >> 5;
  const float* qraw = (const float*)(P.ws + OFF_QRAW);
  const bf16_t* Kg = (const bf16_t*)(P.ws + OFF_KMLA) + (size_t)hd * S_ * 192;
  const bf16_t* Vg = (const bf16_t*)(P.ws + OFF_VT) + (size_t)hd * 128 * S_;
  bf16_t* mixin = (bf16_t*)(P.ws + OFF_H);
  const int q = 128 * b + 32 * wq + lq;
  bf16x8 qf[12];
  {
    const float* qp = qraw + (size_t)q * 768 + hd * 192 + 8 * h;
    const float sc = 0.07216878364870322f * LOG2E;
#pragma unroll
    for (int s = 0; s < 8; ++s) { const f32x4 a = *(const f32x4*)(qp + 16 * s), c = *(const f32x4*)(qp + 16 * s + 4);
      qf[s] = pack8(a.x * sc, a.y * sc, a.z * sc, a.w * sc, c.x * sc, c.y * sc, c.z * sc, c.w * sc); }
    const double pq = (double)P.pos[q];
#pragma unroll
    for (int s2 = 0; s2 < 2; ++s2) {
      const f32x4 a0 = *(const f32x4*)(qp + 128 + 16 * s2), a1 = *(const f32x4*)(qp + 128 + 16 * s2 + 4);
      const f32x4 b0 = *(const f32x4*)(qp + 160 + 16 * s2), b1 = *(const f32x4*)(qp + 160 + 16 * s2 + 4);
      float x1[8] = {a0.x, a0.y, a0.z, a0.w, a1.x, a1.y, a1.z, a1.w}, x2[8] = {b0.x, b0.y, b0.z, b0.w, b1.x, b1.y, b1.z, b1.w}, o1[8], o2[8];
#pragma unroll
      for (int j = 0; j < 8; ++j) { double fr = pq * kInvFreq2Pi[16 * s2 + 8 * h + j]; fr -= floor(fr); const float ff = (float)fr;
        const float sn = __builtin_amdgcn_sinf(ff), cs = __builtin_amdgcn_cosf(ff);
        o1[j] = (x1[j] * cs - x2[j] * sn) * sc; o2[j] = (x2[j] * cs + x1[j] * sn) * sc; }
      qf[8 + s2] = pack8(o1[0], o1[1], o1[2], o1[3], o1[4], o1[5], o1[6], o1[7]);
      qf[10 + s2] = pack8(o2[0], o2[1], o2[2], o2[3], o2[4], o2[5], o2[6], o2[7]);
    }
  }
  constexpr int KST = 64 * 400, VST = 128 * 144, STG = KST + VST;
  f32x16 O[4];
#pragma unroll
  for (int i = 0; i < 4; ++i)
#pragma unroll
    for (int r = 0; r < 16; ++r) O[i][r] = 0.f;
  float m_i = -1e30f, l_i = 0.f;
  const int nt = 2 * b + 2;
  u32x4 rk[3], rv[2];
  const int vrow = tid >> 3, vcc = tid & 7;
#pragma unroll
  for (int i = 0; i < 3; ++i) { const int id = tid + NT * i, row = id / 24, cc = id % 24; rk[i] = *(const u32x4*)(Kg + row * 192 + cc * 8); }
#pragma unroll
  for (int i = 0; i < 2; ++i) rv[i] = *(const u32x4*)(Vg + (size_t)(vrow + 64 * i) * S_ + vcc * 8);
#pragma unroll
  for (int i = 0; i < 3; ++i) { const int id = tid + NT * i, row = id / 24, cc = id % 24; *(u32x4*)(smem + row * 400 + cc * 16) = rk[i]; }
#pragma unroll
  for (int i = 0; i < 2; ++i) *(u32x4*)(smem + KST + (vrow + 64 * i) * 144 + vcc * 16) = rv[i];
  __syncthreads();
  for (int kt = 0; kt < nt; ++kt) {
    const char* sK = smem + (kt & 1) * STG; const char* sV = sK + KST;
    const bool more = (kt + 1 < nt);
    if (more) { const size_t ko = (size_t)(kt + 1) * 64 * 192; const int vo = (kt + 1) * 64;
#pragma unroll
      for (int i = 0; i < 3; ++i) { const int id = tid + NT * i, row = id / 24, cc = id % 24; rk[i] = *(const u32x4*)(Kg + ko + row * 192 + cc * 8); }
#pragma unroll
      for (int i = 0; i < 2; ++i) rv[i] = *(const u32x4*)(Vg + (size_t)(vrow + 64 * i) * S_ + vo + vcc * 8); }
    const int key0 = 64 * kt + 32 * hk;
    if (key0 <= 128 * b + 32 * wq) {
      f32x16 st;
#pragma unroll
      for (int r = 0; r < 16; ++r) st[r] = 0.f;
#pragma unroll
      for (int s = 0; s < 12; ++s) { const bf16x8 kf = *(const bf16x8*)(sK + (32 * hk + lq) * 400 + (2 * s + h) * 16); st = MFMA32(kf, qf[s], st); }
      if (key0 + 31 > 128 * b + 32 * wq) {
        int qrel = q - key0 - 4 * h; asm volatile("" : "+v"(qrel));
#pragma unroll
        for (int r = 0; r < 16; ++r) if ((r & 3) + 8 * (r >> 2) > qrel) st[r] = -1e30f;
      }
      float mx = st[0];
#pragma unroll
      for (int r = 1; r < 16; ++r) mx = fmaxf(mx, st[r]);
      mx = fmaxf(mx, __shfl_xor(mx, 32));
      const float m_new = fmaxf(m_i, mx), alpha = exp2f(m_i - m_new);
      float ps = 0.f;
#pragma unroll
      for (int r = 0; r < 16; ++r) { st[r] = exp2f(st[r] - m_new); ps += st[r]; }
      l_i = l_i * alpha + ps; m_i = m_new;
#pragma unroll
      for (int i = 0; i < 4; ++i)
#pragma unroll
        for (int r = 0; r < 16; ++r) O[i][r] *= alpha;
      bf16x8 pf[2];
#pragma unroll
      for (int s = 0; s < 2; ++s) pf[s] = pack8(st[8 * s], st[8 * s + 1], st[8 * s + 2], st[8 * s + 3], st[8 * s + 4], st[8 * s + 5], st[8 * s + 6], st[8 * s + 7]);
#pragma unroll
      for (int i = 0; i < 4; ++i)
#pragma unroll
        for (int s = 0; s < 2; ++s) { const char* vp = sV + (32 * i + lq) * 144 + (32 * hk + 16 * s + 4 * h) * 2;
          const u32x2 lo = *(const u32x2*)vp, hi = *(const u32x2*)(vp + 16); u32x4 vv = {lo.x, lo.y, hi.x, hi.y};
          O[i] = MFMA32(__builtin_bit_cast(bf16x8, vv), pf[s], O[i]); }
    }
    if (more) { char* dK = smem + ((kt + 1) & 1) * STG;
#pragma unroll
      for (int i = 0; i < 3; ++i) { const int id = tid + NT * i, row = id / 24, cc = id % 24; *(u32x4*)(dK + row * 400 + cc * 16) = rk[i]; }
#pragma unroll
      for (int i = 0; i < 2; ++i) *(u32x4*)(dK + KST + (vrow + 64 * i) * 144 + vcc * 16) = rv[i]; }
    __syncthreads();
  }
  float* cO = (float*)smem; float* cm = cO + 4 * 4096; float* cl = cm + 256;
  if (hk == 1) {
#pragma unroll
    for (int i = 0; i < 4; ++i)
#pragma unroll
      for (int r = 0; r < 16; ++r) cO[wq * 4096 + (i * 16 + r) * 64 + lane] = O[i][r];
    cm[wq * 64 + lane] = m_i; cl[wq * 64 + lane] = l_i;
  }
  __syncthreads();
  if (hk == 0) {
    const float m1 = cm[wq * 64 + lane], l1 = cl[wq * 64 + lane];
    const float m = fmaxf(m_i, m1), a0 = exp2f(m_i - m), a1 = exp2f(m1 - m);
    float lt = l_i * a0 + l1 * a1; lt += __shfl_xor(lt, 32);
    const float inv = 1.f / lt;
    bf16_t* op = mixin + (size_t)q * 2048 + 1024 + hd * 128;
#pragma unroll
    for (int i = 0; i < 4; ++i)
#pragma unroll
      for (int rg = 0; rg < 4; ++rg) { float v[4];
#pragma unroll
        for (int e = 0; e < 4; ++e) v[e] = (O[i][4 * rg + e] * a0 + cO[wq * 4096 + (i * 16 + 4 * rg + e) * 64 + lane] * a1) * inv;
        u32x2 pk = {pack2(v[0], v[1]), pack2(v[2], v[3])}; *(u32x2*)(op + 32 * i + 8 * rg + 4 * h) = pk; }
  }
  __syncthreads();
}

DI void swa_item(const Params& P, int l, int n, int hk2, char* smem) {
  const int tid = opaque_tid(), lane = tid & 63, w = tid >> 6, lq = lane & 31, h = lane >> 5;
  const bf16_t* proj = (const bf16_t*)(P.ws + OFF_PROJ); bf16_t* mixin = (bf16_t*)(P.ws + OFF_H);
  bf16_t* sVt = (bf16_t*)smem;
#pragma unroll
  for (int i = 0; i < 4; ++i) { const int id = tid + NT * i, key = id >> 3, dc = id & 7; const int kp = 128 * (n - 1) + key;
    u32x4 v = {0u, 0u, 0u, 0u}; if (kp >= 0) v = *(const u32x4*)(proj + (size_t)kp * DINP + C_CV + hk2 * 64 + dc * 8);
    sVt[(8 * dc + 0) * 264 + key] = (bf16_t)(v.x & 0xffff); sVt[(8 * dc + 1) * 264 + key] = (bf16_t)(v.x >> 16);
    sVt[(8 * dc + 2) * 264 + key] = (bf16_t)(v.y & 0xffff); sVt[(8 * dc + 3) * 264 + key] = (bf16_t)(v.y >> 16);
    sVt[(8 * dc + 4) * 264 + key] = (bf16_t)(v.z & 0xffff); sVt[(8 * dc + 5) * 264 + key] = (bf16_t)(v.z >> 16);
    sVt[(8 * dc + 6) * 264 + key] = (bf16_t)(v.w & 0xffff); sVt[(8 * dc + 7) * 264 + key] = (bf16_t)(v.w >> 16); }
  __syncthreads();
  const int g = w >> 1, hq = hk2 * 4 + g;
  const float slope = exp2f(-(float)(hq + 1)) * LOG2E, sinkv = P.swa_sinks[l * 8 + hq] * LOG2E;
#pragma unroll 1
  for (int jj = 0; jj < 2; ++jj) {
    const int j = 2 * (w & 1) + jj; const int qrow = 128 * n + 32 * j + lq;
    bf16x8 qf[4];
#pragma unroll
    for (int s = 0; s < 4; ++s) qf[s] = *(const bf16x8*)(proj + (size_t)qrow * DINP + C_CQ + hq * 64 + 16 * s + 8 * h);
    f32x16 st[5];
    bf16x8 kf[2][4];
    { const int kp = 128 * (n - 1) + 32 * j + lq;
#pragma unroll
      for (int s = 0; s < 4; ++s) { kf[0][s] = (bf16x8){0, 0, 0, 0, 0, 0, 0, 0}; if (kp >= 0) kf[0][s] = *(const bf16x8*)(proj + (size_t)kp * DINP + C_CK + hk2 * 64 + 16 * s + 8 * h); } }
#pragma unroll
    for (int tt = 0; tt < 5; ++tt) {
      if (tt + 1 < 5) { const int kp = 128 * (n - 1) + 32 * (j + tt + 1) + lq;
#pragma unroll
        for (int s = 0; s < 4; ++s) { kf[(tt + 1) & 1][s] = (bf16x8){0, 0, 0, 0, 0, 0, 0, 0}; if (kp >= 0) kf[(tt + 1) & 1][s] = *(const bf16x8*)(proj + (size_t)kp * DINP + C_CK + hk2 * 64 + 16 * s + 8 * h); } }
      __builtin_amdgcn_sched_barrier(0);
#pragma unroll
      for (int r = 0; r < 16; ++r) st[tt][r] = 0.f;
#pragma unroll
      for (int s = 0; s < 4; ++s) st[tt] = MFMA32(kf[tt & 1][s], qf[s], st[tt]);
      __builtin_amdgcn_sched_barrier(0);
    }
    float mx = sinkv;
    int dbase = 128 + lq - 4 * h, kbase = 128 * (n - 1) + 32 * j + 4 * h;
    asm volatile("" : "+v"(dbase), "+v"(kbase));
#pragma unroll
    for (int tt = 0; tt < 5; ++tt)
#pragma unroll
      for (int r = 0; r < 16; ++r) { const int cst = 32 * tt + (r & 3) + 8 * (r >> 2); const int dist = dbase - cst; const int kpos = kbase + cst;
        const bool valid = (dist >= 0) && (dist < 128) && (kpos >= 0);
        const float sv = valid ? st[tt][r] * (0.125f * LOG2E) - slope * (float)dist : -1e30f; st[tt][r] = sv; mx = fmaxf(mx, sv); }
    mx = fmaxf(mx, __shfl_xor(mx, 32));
    float den = 0.f;
#pragma unroll
    for (int tt = 0; tt < 5; ++tt)
#pragma unroll
      for (int r = 0; r < 16; ++r) { const float p = exp2f(st[tt][r] - mx); st[tt][r] = p; den += p; }
    den += __shfl_xor(den, 32); den += exp2f(sinkv - mx);
    f32x16 O[2];
#pragma unroll
    for (int i = 0; i < 2; ++i)
#pragma unroll
      for (int r = 0; r < 16; ++r) O[i][r] = 0.f;
#pragma unroll
    for (int tt = 0; tt < 5; ++tt)
#pragma unroll
      for (int s = 0; s < 2; ++s) { const bf16x8 pf = pack8(st[tt][8 * s], st[tt][8 * s + 1], st[tt][8 * s + 2], st[tt][8 * s + 3], st[tt][8 * s + 4], st[tt][8 * s + 5], st[tt][8 * s + 6], st[tt][8 * s + 7]);
#pragma unroll
        for (int i = 0; i < 2; ++i) { const char* vp = (const char*)sVt + (32 * i + lq) * 528 + (32 * (j + tt) + 16 * s + 4 * h) * 2;
          const u32x2 lo = *(const u32x2*)vp, hi = *(const u32x2*)(vp + 16); u32x4 vv = {lo.x, lo.y, hi.x, hi.y};
          O[i] = MFMA32(__builtin_bit_cast(bf16x8, vv), pf, O[i]); }
        __builtin_amdgcn_sched_barrier(0); }
    const float inv = 1.f / den;
    bf16_t* op = mixin + (size_t)qrow * 2048 + 1536 + hq * 64;
#pragma unroll
    for (int i = 0; i < 2; ++i)
#pragma unroll
      for (int rg = 0; rg < 4; ++rg) { u32x2 pk = {pack2(O[i][4 * rg] * inv, O[i][4 * rg + 1] * inv), pack2(O[i][4 * rg + 2] * inv, O[i][4 * rg + 3] * inv)};
        *(u32x2*)(op + 32 * i + 8 * rg + 4 * h) = pk; }
  }
  __syncthreads();
}

DI float gelu_tanh(float x) { const float y = 0.7978845608028654f * (x + 0.044715f * x * x * x); const float t = 1.f - 2.f * __builtin_amdgcn_rcpf(1.f + __expf(2.f * y)); return 0.5f * x * (1.f + t); }
DI void ffn_act_phase(const Params& P, int l) {
  const int tid = opaque_tid(), lane = tid & 63, w = tid >> 6;
  const bf16_t* u = (const bf16_t*)(P.ws + OFF_BIG); bf16_t* act = (bf16_t*)(P.ws + OFF_ACT);
  const float* cw = P.ffn_conv + (size_t)l * 3 * DFF2; const float* cb = P.ffn_conv_b + (size_t)l * DFF2;
  for (int item = blockIdx.x * 8 + w; item < 512 * 11; item += gridDim.x * 8) {
    const int cbk = item % 11, rr = item / 11; const int ch = cbk * 512 + lane * 8, r0 = rr * 32;
    float wg[3][8], wu[3][8], bg[8], bu[8];
#pragma unroll
    for (int j = 0; j < 3; ++j)
#pragma unroll
      for (int e4 = 0; e4 < 2; ++e4) { const f32x4 a = *(const f32x4*)(cw + (size_t)j * DFF2 + ch + 4 * e4), b = *(const f32x4*)(cw + (size_t)j * DFF2 + DFF + ch + 4 * e4);
        wg[j][4 * e4] = a.x; wg[j][4 * e4 + 1] = a.y; wg[j][4 * e4 + 2] = a.z; wg[j][4 * e4 + 3] = a.w; wu[j][4 * e4] = b.x; wu[j][4 * e4 + 1] = b.y; wu[j][4 * e4 + 2] = b.z; wu[j][4 * e4 + 3] = b.w; }
#pragma unroll
    for (int e4 = 0; e4 < 2; ++e4) { const f32x4 a = *(const f32x4*)(cb + ch + 4 * e4), b = *(const f32x4*)(cb + DFF + ch + 4 * e4);
      bg[4 * e4] = a.x; bg[4 * e4 + 1] = a.y; bg[4 * e4 + 2] = a.z; bg[4 * e4 + 3] = a.w; bu[4 * e4] = b.x; bu[4 * e4 + 1] = b.y; bu[4 * e4 + 2] = b.z; bu[4 * e4 + 3] = b.w; }
    float g2[8], g1[8], u2[8], u1[8];
#pragma unroll
    for (int e = 0; e < 8; ++e) { g2[e] = 0.f; g1[e] = 0.f; u2[e] = 0.f; u1[e] = 0.f; }
    if (r0 >= 2) { unpack8(*(const u32x4*)(u + (size_t)(r0 - 2) * DFF2 + ch), g2); unpack8(*(const u32x4*)(u + (size_t)(r0 - 2) * DFF2 + DFF + ch), u2);
      unpack8(*(const u32x4*)(u + (size_t)(r0 - 1) * DFF2 + ch), g1); unpack8(*(const u32x4*)(u + (size_t)(r0 - 1) * DFF2 + DFF + ch), u1); }
#pragma unroll 1
    for (int rb = 0; rb < 4; ++rb) {
      u32x4 G[8], U[8];
#pragma unroll
      for (int i = 0; i < 8; ++i) { const size_t ro = (size_t)(r0 + rb * 8 + i) * DFF2 + ch; G[i] = *(const u32x4*)(u + ro); U[i] = *(const u32x4*)(u + ro + DFF); }
#pragma unroll
      for (int i = 0; i < 8; ++i) {
        float g0[8], u0[8]; unpack8(G[i], g0); unpack8(U[i], u0);
        float o[8];
#pragma unroll
        for (int e = 0; e < 8; ++e) { const float yg = wg[0][e] * g2[e] + wg[1][e] * g1[e] + wg[2][e] * g0[e] + bg[e]; const float yu = wu[0][e] * u2[e] + wu[1][e] * u1[e] + wu[2][e] * u0[e] + bu[e];
          o[e] = gelu_tanh(yg) * yu; g2[e] = g1[e]; g1[e] = g0[e]; u2[e] = u1[e]; u1[e] = u0[e]; }
        u32x4 pk = {pack2(o[0], o[1]), pack2(o[2], o[3]), pack2(o[4], o[5]), pack2(o[6], o[7])};
        *(u32x4*)(act + (size_t)(r0 + rb * 8 + i) * DFF + ch) = pk;
      }
    }
  }
}

#define XB_TMO      128
#define XB_XCNT(j)  (256  + 64 * (j))
#define XB_XSUB(j)  (1280 + 64 * (j))
#define XB_XGEN(j)  (2304 + 64 * (j))
#define XB_TOP      3328
#define XB_TOPGEN   3392
#define XCD_BAR_WORDS 3456
#define XB_SPIN_CAP (1u << 18)
#define LAS __attribute__((address_space(3)))
DI unsigned xb_ld(unsigned* p)              { return __hip_atomic_load(p, __ATOMIC_RELAXED, __HIP_MEMORY_SCOPE_AGENT); }
DI unsigned xb_add(unsigned* p, unsigned v) { return __hip_atomic_fetch_add(p, v, __ATOMIC_RELAXED, __HIP_MEMORY_SCOPE_AGENT); }
DI unsigned xb_xcc_id() { return (unsigned)__builtin_amdgcn_s_getreg((3 << 11) | 20) & 0xFu; }
#define XB_SPIN(cond, bar) do { unsigned _sp = 0; while (cond) { __builtin_amdgcn_s_sleep(1); \
    if ((++_sp & 255u) == 0u) { if (xb_ld(&(bar)[XB_TMO])) break; if (_sp > XB_SPIN_CAP) { atomicAdd(&(bar)[XB_TMO], 1u); break; } } } } while (0)
struct XcdBarrier { unsigned* bar; unsigned x; volatile LAS unsigned* st; };
DI XcdBarrier xcd_barrier_post(unsigned* bar, volatile LAS unsigned* st) {
  XcdBarrier b; b.bar = bar; b.x = xb_xcc_id(); b.st = st;
  if (threadIdx.x == 0) (void)xb_add(&bar[XB_XCNT(b.x)], 1u);
  return b;
}
DI void xcd_barrier_complete(unsigned* bar, unsigned x, unsigned& nloc, unsigned& nx) {
  const unsigned G = gridDim.x * gridDim.y * gridDim.z;
  unsigned sum, cnt, mine, sp = 0u;
  for (;;) {
    sum = 0u; cnt = 0u; mine = 0u;
#pragma unroll
    for (unsigned j = 0; j < 16; ++j) { const unsigned c = xb_ld(&bar[XB_XCNT(j)]); sum += c; cnt += (c > 0u) ? 1u : 0u; mine = (j == x) ? c : mine; }
    if (sum == G) break;
    __builtin_amdgcn_s_sleep(1);
    if ((++sp & 255u) == 0u) { if (xb_ld(&bar[XB_TMO])) break; if (sp > XB_SPIN_CAP) { atomicAdd(&bar[XB_TMO], 1u); break; } }
  }
  nloc = mine > 0u ? mine : 1u; nx = cnt > 0u ? cnt : 1u;
}
DI void xcd_barrier(char* ws_, char* smem_) {
  XcdBarrier b; b.bar = (unsigned*)(ws_ + OFF_XBAR); b.x = xb_xcc_id(); b.st = (volatile LAS unsigned*)(smem_ + 157712);
  asm volatile("s_waitcnt vmcnt(0)" ::: "memory");
  __syncthreads();
  if (threadIdx.x == 0) {
    unsigned* bar = b.bar;
    __builtin_amdgcn_s_waitcnt(0);
    unsigned nloc = b.st[0], nx = b.st[1];
    if (nloc == 0u) { xcd_barrier_complete(bar, b.x, nloc, nx); b.st[0] = nloc; b.st[1] = nx; }
    const unsigned old = xb_add(&bar[XB_XSUB(b.x)], 1u);
    const unsigned gen = old / nloc;
    if (old + 1u == (gen + 1u) * nloc) {
      __builtin_amdgcn_fence(__ATOMIC_RELEASE, "agent");
      asm volatile("s_waitcnt vmcnt(0)" ::: "memory");
      const unsigned og = xb_add(&bar[XB_TOP], 1u);
      const unsigned tg = og / nx;
      if (og + 1u == (tg + 1u) * nx) xb_add(&bar[XB_TOPGEN], 1u);
      else XB_SPIN(xb_ld(&bar[XB_TOPGEN]) == tg, bar);
      __builtin_amdgcn_fence(__ATOMIC_ACQUIRE, "agent");
      xb_add(&bar[XB_XGEN(b.x)], 1u);
      asm volatile("s_waitcnt vmcnt(0)" ::: "memory");
    } else {
      XB_SPIN(xb_ld(&bar[XB_XGEN(b.x)]) == gen, bar);
      __builtin_amdgcn_fence(__ATOMIC_ACQUIRE, "agent");
      asm volatile("s_waitcnt vmcnt(0)" ::: "memory");
    }
  }
  __syncthreads();
}

__global__ void __launch_bounds__(NT) fwd_megakernel(Params P0) {
  cg::grid_group grid = cg::this_grid();
  __shared__ __attribute__((aligned(16))) char smem[157952];
  const int tid = threadIdx.x;
  char* ws = P0.ws;
  int* ctrl = (int*)(ws + OFF_CTRL);
  if (blockIdx.x == 0 && tid < 64) ctrl[tid] = 0;
  if (blockIdx.x == 0) for (int i = tid; i < XCD_BAR_WORDS; i += NT) ((unsigned*)(ws + OFF_XBAR))[i] = 0u;
  if (tid < 4) ((unsigned*)(smem + 157712))[tid] = 0u;
  if (blockIdx.x == 0 && tid == 0) *(Params*)(ws + OFF_CTRL + 1024) = P0;
  bf16_t* Hb = (bf16_t*)(ws + OFF_H);
  for (int it = blockIdx.x; it < 192 + CV_T5; it += gridDim.x) { if (it < 192) mod_item(P0, it); else convert_item(P0, 0, it - 192, smem); }
  grid.sync();
  (void)xcd_barrier_post((unsigned*)(ws + OFF_XBAR), (volatile LAS unsigned*)(smem + 157712));
  const Params& P = *(const Params*)(ws + OFF_CTRL + 1024);
  rownorm_phase(P, P.x, nullptr, P.out, Hb, 0, 0, nullptr, 0, 1, 0, P.mix_pre, smem);
  xcd_barrier(ws, smem);
  for (int l = 0; l < 2; ++l) {
    { EpiProj epi{(bf16_t*)(ws + OFF_PROJ), (float*)(ws + OFF_AB)}; gemm_phase(Hb, 2048, (const bf16_t*)(ws + OFF_W + W_IN), 2048, 2048, 64, 22, smem, epi); }
    xcd_barrier(ws, smem);
    for (int it = blockIdx.x; it < 448; it += gridDim.x) {
      if (it < 192) mla_q_tile(P, it / 3, it % 3, smem);
      else mla_kv_tile(P, (it - 192) >> 2, (it - 192) & 3, smem);
    }
    for (int id = (blockIdx.x + 64) % gridDim.x; id < 2048; id += gridDim.x) gdn_prep_item(P, l, id >> 3, id & 7, smem);
    xcd_barrier(ws, smem);
    {
      int* sitem = (int*)(smem + 157696);
      for (;;) {
        if (tid == 0) *sitem = atomicAdd(ctrl + 16 * l, 1);
        __syncthreads(); const int item = *sitem; __syncthreads();
        if (item >= 16 + 512 + 256) break;
        if (item < 16) gdn_scan_item(P, l, item >> 1, item & 1, smem);
        else if (item < 528) { const int idx = item - 16; mla_attn_item(P, idx & 3, 127 - (idx >> 2), smem); }
        else { const int idx = item - 528; swa_item(P, l, idx >> 1, idx & 1, smem); }
      }
    }
    xcd_barrier(ws, smem);
    gdn_fix_phase(P);
    xcd_barrier(ws, smem);
    { EpiBf epi{(bf16_t*)(ws + OFF_MIXF), 2048}; gemm_phase(Hb, 2048, (const bf16_t*)(ws + OFF_W + W_OUT), 2048, 2048, 64, 8, smem, epi); }
    xcd_barrier(ws, smem);
    rownorm_phase(P, P.out, (const bf16_t*)(ws + OFF_MIXF), P.out, Hb, l, 2, P.mix_post + l * 2048, l, 4, 3, P.ffn_pre + l * 2048, smem);
    xcd_barrier(ws, smem);
    { EpiBf epi{(bf16_t*)(ws + OFF_BIG), DFF2}; gemm_phase(Hb, 2048, (const bf16_t*)(ws + OFF_W + W_UP), 2048, 2048, 64, 44, smem, epi); }
    xcd_barrier(ws, smem);
    ffn_act_phase(P, l);
    xcd_barrier(ws, smem);
    { EpiBf epi{(bf16_t*)(ws + OFF_Y), 2048}; gemm_phase((const bf16_t*)(ws + OFF_ACT), DFF, (const bf16_t*)(ws + OFF_W + W_DOWN), DFF, DFF, 64, 8, smem, epi); }
    xcd_barrier(ws, smem);
    if (l == 0) {
      for (int it = blockIdx.x; it < CV_T5; it += gridDim.x) convert_item(P, 1, it, smem);
      rownorm_phase(P, P.out, (const bf16_t*)(ws + OFF_Y), P.out, Hb, 0, 5, P.ffn_post, 1, 1, 0, P.mix_pre + 2048, smem);
      xcd_barrier(ws, smem);
    } else {
      rownorm_phase(P, P.out, (const bf16_t*)(ws + OFF_Y), P.out, nullptr, 1, 5, P.ffn_post + 2048, 1, 1, 0, nullptr, smem);
    }
  }
}

extern "C" void kernel_launch(void* const* d_in, const int* in_sizes, int n_in, void* d_out, int out_size, void* d_ws, size_t ws_size, hipStream_t stream) {
  static int grid_blocks = 0;
  if (!grid_blocks) {
    int dev = 0, cus = 0, per = 0;
    (void)hipGetDevice(&dev); (void)hipDeviceGetAttribute(&cus, hipDeviceAttributeMultiprocessorCount, dev);
    (void)hipOccupancyMaxActiveBlocksPerMultiprocessor(&per, fwd_megakernel, NT, 0);
    if (per > 1) per = 1;
    grid_blocks = cus * per; if (grid_blocks <= 0) grid_blocks = 256;
  }
  if (ws_size < OFF_END) { fprintf(stderr, "workspace too small: %zu < %zu\n", ws_size, (size_t)OFF_END); return; }
  Params p{};
  p.x = (const float*)d_in[0]; p.c = (const float*)d_in[1]; p.pos = (const int*)d_in[2];
  p.ada_w = (const float*)d_in[3]; p.ada_b = (const float*)d_in[4]; p.mix_pre = (const float*)d_in[5]; p.mix_post = (const float*)d_in[6];
  p.w_in = (const float*)d_in[7]; p.w_out = (const float*)d_in[8]; p.gdn_conv = (const float*)d_in[9]; p.gdn_a_log = (const float*)d_in[10];
  p.gdn_dt_bias = (const float*)d_in[11]; p.gdn_norm = (const float*)d_in[12]; p.mla_q_norm = (const float*)d_in[13]; p.mla_w_uq = (const float*)d_in[14];
  p.mla_kv_norm = (const float*)d_in[15]; p.mla_w_ukv = (const float*)d_in[16]; p.swa_sinks = (const float*)d_in[17]; p.ffn_pre = (const float*)d_in[18];
  p.ffn_post = (const float*)d_in[19]; p.ffn_w_up = (const float*)d_in[20]; p.ffn_conv = (const float*)d_in[21]; p.ffn_conv_b = (const float*)d_in[22];
  p.ffn_w_down = (const float*)d_in[23];
  p.out = (float*)d_out; p.ws = (char*)d_ws;
  void* args[] = {&p};
  hipError_t e = hipLaunchCooperativeKernel((void*)fwd_megakernel, dim3(grid_blocks), dim3(NT), args, 0, stream);
  if (e != hipSuccess) fprintf(stderr, "cooperative launch failed: %s (grid %d)\n", hipGetErrorString(e), grid_blocks);
}
```

```cpp
#include <hip/hip_runtime.h>
#include <hip/hip_cooperative_groups.h>
#include <cstdio>
#include <cstdint>
namespace cg = cooperative_groups;

#define DI __device__ __forceinline__
typedef unsigned short bf16_t;
typedef short bf16x8 __attribute__((ext_vector_type(8)));
typedef float f32x2 __attribute__((ext_vector_type(2)));
typedef float f32x4 __attribute__((ext_vector_type(4)));
typedef float f32x16 __attribute__((ext_vector_type(16)));
typedef unsigned u32x2 __attribute__((ext_vector_type(2)));
typedef unsigned u32x4 __attribute__((ext_vector_type(4)));
typedef __bf16 bf2_t __attribute__((ext_vector_type(2)));

constexpr int S_ = 16384, D_ = 2048, DINP = 5632, DFF = 5632, DFF2 = 11264;
constexpr int NT = 512;
constexpr float EPS = 1e-6f;
constexpr float LOG2E = 1.4426950408889634f;

constexpr size_t OFF_CTRL = 0;
constexpr size_t OFF_MODP = 4096;
constexpr size_t OFF_XBAR = OFF_MODP + (size_t)2 * 16 * 12288 * 4;
constexpr size_t OFF_W = 2097152;
static_assert(OFF_XBAR + 3456 * 4 <= OFF_W, "xbar");
constexpr size_t W_IN = 0, W_OUT = W_IN + (size_t)5632 * 2048 * 2, W_UP = W_OUT + (size_t)2048 * 2048 * 2,
                 W_DOWN = W_UP + (size_t)11264 * 2048 * 2, W_UQ = W_DOWN + (size_t)2048 * 5632 * 2,
                 W_UKV = W_UQ + (size_t)768 * 448 * 2, W_END = W_UKV + (size_t)1024 * 128 * 2;
constexpr size_t OFF_H = OFF_W + W_END;
constexpr size_t OFF_MIXF = OFF_H + (size_t)S_ * 2048 * 2;
constexpr size_t OFF_QRAW = OFF_MIXF;
constexpr size_t OFF_KMLA = OFF_QRAW + (size_t)S_ * 768 * 4;
constexpr size_t OFF_VT = OFF_KMLA + (size_t)4 * S_ * 192 * 2;
constexpr size_t OFF_BIG = OFF_MIXF + (size_t)S_ * 2048 * 4;
constexpr size_t OFF_PROJ = OFF_BIG;
constexpr size_t OFF_WP = OFF_PROJ + (size_t)S_ * DINP * 2;
constexpr size_t OFF_QD = OFF_WP + (size_t)S_ * 1024 * 2;
constexpr size_t OFF_KT = OFF_QD + (size_t)S_ * 1024 * 2;
constexpr size_t OFF_ZT = OFF_KT + (size_t)S_ * 1024 * 2;
constexpr size_t OFF_QK = OFF_ZT + (size_t)S_ * 1024 * 2;
constexpr size_t OFF_AB = OFF_QK + (size_t)S_ * 512 * 2;
constexpr size_t OFF_GTOT = OFF_AB + (size_t)S_ * 16 * 4;
constexpr size_t OFF_Y = OFF_BIG;
constexpr size_t OFF_ACT = OFF_H;
constexpr size_t OFF_UT = OFF_BIG + (size_t)S_ * DFF2 * 2;
constexpr size_t OFF_END = OFF_UT + (size_t)S_ * 1024 * 4;
static_assert(OFF_GTOT + 8192 <= OFF_UT, "overlay");
static_assert(OFF_VT + (size_t)4 * 128 * S_ * 2 <= OFF_BIG, "overlay2");

constexpr int C_AQ = 0, C_AK = 1024, C_AV = 2048, C_AZ = 3072, C_AA = 4096, C_BCQ = 4112, C_BCKV = 4560,
              C_BKR = 4688, C_CQ = 4752, C_CK = 5264, C_CV = 5392;

__constant__ double kInvFreq2Pi[32] = {
    0.15915494309189535, 0.11934937021124886, 0.08949940160889101, 0.06711508300522726, 0.050329212104487035, 0.03774158471741977,
    0.0283021958306234, 0.02122365276477766, 0.015915494309189534, 0.011934937021124886, 0.008949940160889102, 0.006711508300522725,
    0.005032921210448704, 0.003774158471741977, 0.00283021958306234, 0.0021223652764777662, 0.0015915494309189536, 0.0011934937021124885,
    0.0008949940160889102, 0.0006711508300522726, 0.0005032921210448703, 0.00037741584717419774, 0.00028302195830623395, 0.0002122365276477766,
    0.00015915494309189535, 0.00011934937021124886, 8.949940160889102e-05, 6.711508300522725e-05, 5.0329212104487035e-05, 3.774158471741978e-05,
    2.8302195830623396e-05, 2.122365276477766e-05};

struct Params {
  const float* x; const float* c; const int* pos;
  const float *ada_w, *ada_b, *mix_pre, *mix_post, *w_in, *w_out, *gdn_conv, *gdn_a_log, *gdn_dt_bias, *gdn_norm, *mla_q_norm, *mla_w_uq,
      *mla_kv_norm, *mla_w_ukv, *swa_sinks, *ffn_pre, *ffn_post, *ffn_w_up, *ffn_conv, *ffn_conv_b, *ffn_w_down;
  float* out; char* ws;
};

DI unsigned pack2(float lo, float hi) { f32x2 v = {lo, hi}; bf2_t b = __builtin_convertvector(v, bf2_t); return __builtin_bit_cast(unsigned, b); }
DI bf16_t f2bf(float x) { return (bf16_t)(pack2(x, 0.f) & 0xffffu); }
DI float bflo(unsigned u) { return __uint_as_float(u << 16); }
DI float bfhi(unsigned u) { return __uint_as_float(u & 0xffff0000u); }
DI void unpack8(const u32x4& v, float* f) { f[0] = bflo(v.x); f[1] = bfhi(v.x); f[2] = bflo(v.y); f[3] = bfhi(v.y); f[4] = bflo(v.z); f[5] = bfhi(v.z); f[6] = bflo(v.w); f[7] = bfhi(v.w); }
DI bf16x8 pack8(float a0, float a1, float a2, float a3, float a4, float a5, float a6, float a7) {
  u32x4 p = {pack2(a0, a1), pack2(a2, a3), pack2(a4, a5), pack2(a6, a7)}; return __builtin_bit_cast(bf16x8, p); }
DI float silu_f(float x) { return x * __builtin_amdgcn_rcpf(1.f + __expf(-x)); }
DI float wave_sum(float v) { v += __shfl_xor(v, 32); v += __shfl_xor(v, 16); v += __shfl_xor(v, 8); v += __shfl_xor(v, 4); v += __shfl_xor(v, 2); v += __shfl_xor(v, 1); return v; }
DI int opaque_tid() { int t = threadIdx.x; asm volatile("" : "+v"(t)); return t; }
DI int crow(int r, int h) { return (r & 3) + 8 * (r >> 2) + 4 * h; }
DI int perm32(int k) { return 8 * ((k >> 2) & 3) + 4 * (k >> 4) + (k & 3); }
#define MFMA32(a, b, c) __builtin_amdgcn_mfma_f32_32x32x16_bf16((a), (b), (c), 0, 0, 0)
#define MFMA16(a, b, c) __builtin_amdgcn_mfma_f32_16x16x32_bf16((a), (b), (c), 0, 0, 0)

template <class Epi>
DI void gemm_tile(const bf16_t* __restrict__ A, int lda, const bf16_t* __restrict__ Bt, int ldb, int K, int m0, int n0, char* smem, const Epi& epi) {
  const int tid = opaque_tid(), lane = tid & 63, w = tid >> 6, wm = w >> 2, wn = w & 3, lq = lane & 31, h = lane >> 5;
  f32x16 acc[2][4];
#pragma unroll
  for (int i = 0; i < 2; ++i)
#pragma unroll
    for (int j = 0; j < 4; ++j)
#pragma unroll
      for (int r = 0; r < 16; ++r) acc[i][j][r] = 0.f;
  const int r0 = tid >> 3, c0 = tid & 7;
  const bf16_t* ag = A + (size_t)(m0 + r0) * lda + c0 * 8;
  const bf16_t* bg = Bt + (size_t)(n0 + r0) * ldb + c0 * 8;
  const int wofs = r0 * 128 + ((c0 ^ ((r0 >> 1) & 7)) << 4);
  char* sA = smem; char* sB = smem + 65536;
  u32x4 ra0[4], rb0[4], ra1[4], rb1[4];
  const int nk = K >> 6, swz = (lane >> 1) & 7;
  const int aoff = (64 * wn + lq) * 128, boff = (128 * wm + lq) * 128;
#define GLOAD(RA, RB, KT) { _Pragma("unroll") for (int i = 0; i < 4; ++i) { RA[i] = *(const u32x4*)(ag + (size_t)(KT) * 64 + (size_t)i * 64 * lda); RB[i] = *(const u32x4*)(bg + (size_t)(KT) * 64 + (size_t)i * 64 * ldb); } }
#define LWRITE(RA, RB, ST) { _Pragma("unroll") for (int i = 0; i < 4; ++i) { *(u32x4*)(sA + (ST) * 32768 + wofs + i * 8192) = RA[i]; *(u32x4*)(sB + (ST) * 32768 + wofs + i * 8192) = RB[i]; } }
#define KSTEP(ST, RA, RB, KN) { const char* cA = sA + (ST) * 32768; const char* cB = sB + (ST) * 32768; char* dA = sA + (1 - (ST)) * 32768; char* dB = sB + (1 - (ST)) * 32768; \
    const bf16_t* agn = ag + (size_t)(KN) * 64; const bf16_t* bgn = bg + (size_t)(KN) * 64; \
    _Pragma("unroll") for (int s = 0; s < 4; ++s) { const int co = (((2 * s + h) ^ swz) << 4); bf16x8 fa[2], fb[4]; \
      _Pragma("unroll") for (int ni = 0; ni < 2; ++ni) fa[ni] = *(const bf16x8*)(cB + aoff + ni * 4096 + co); \
      _Pragma("unroll") for (int mi = 0; mi < 4; ++mi) fb[mi] = *(const bf16x8*)(cA + boff + mi * 4096 + co); \
      *(u32x4*)(dA + wofs + s * 8192) = RA[s]; *(u32x4*)(dB + wofs + s * 8192) = RB[s]; \
      RA[s] = *(const u32x4*)(agn + (size_t)s * 64 * lda); RB[s] = *(const u32x4*)(bgn + (size_t)s * 64 * ldb); \
      _Pragma("unroll") for (int ni = 0; ni < 2; ++ni) _Pragma("unroll") for (int mi = 0; mi < 4; ++mi) acc[ni][mi] = MFMA32(fa[ni], fb[mi], acc[ni][mi]); \
      __builtin_amdgcn_sched_barrier(0); } }
  const int kl = nk - 1;
  GLOAD(ra0, rb0, 0);
  GLOAD(ra1, rb1, (1 < kl ? 1 : kl));
  LWRITE(ra0, rb0, 0);
  GLOAD(ra0, rb0, (2 < kl ? 2 : kl));
  __syncthreads();
  for (int kt = 0; kt < nk; kt += 2) {
    KSTEP(0, ra1, rb1, (kt + 3 < kl ? kt + 3 : kl));
    __syncthreads();
    if (kt + 1 < nk) {
      KSTEP(1, ra0, rb0, (kt + 4 < kl ? kt + 4 : kl));
      __syncthreads();
    }
  }
#undef GLOAD
#undef LWRITE
#undef KSTEP
#pragma unroll
  for (int ni = 0; ni < 2; ++ni)
#pragma unroll
    for (int mi = 0; mi < 4; ++mi)
#pragma unroll
      for (int rg = 0; rg < 4; ++rg) {
        const int m = m0 + 128 * wm + 32 * mi + lq, n = n0 + 64 * wn + 32 * ni + 8 * rg + 4 * h;
        epi(m, n, acc[ni][mi][4 * rg], acc[ni][mi][4 * rg + 1], acc[ni][mi][4 * rg + 2], acc[ni][mi][4 * rg + 3]);
      }
}

template <class Epi>
DI void gemm_tile_s(const bf16_t* __restrict__ A, int lda, const bf16_t* __restrict__ Bt, int ldb, int K, int m0, int n0, char* smem, const Epi& epi) {
  const int tid = opaque_tid(), lane = tid & 63, w = tid >> 6, wm = w >> 2, wn = w & 3, lq = lane & 31, h = lane >> 5;
  f32x16 acc[2][4];
#pragma unroll
  for (int i = 0; i < 2; ++i)
#pragma unroll
    for (int j = 0; j < 4; ++j)
#pragma unroll
      for (int r = 0; r < 16; ++r) acc[i][j][r] = 0.f;
  const int r0 = tid >> 3, c0 = tid & 7;
  const bf16_t* ag = A + (size_t)(m0 + r0) * lda + c0 * 8;
  const bf16_t* bg = Bt + (size_t)(n0 + r0) * ldb + c0 * 8;
  const int wofs = r0 * 128 + ((c0 ^ ((r0 >> 1) & 7)) << 4);
  char* sA = smem; char* sB = smem + 32768;
  u32x4 ra[4], rb[4];
#pragma unroll
  for (int i = 0; i < 4; ++i) { ra[i] = *(const u32x4*)(ag + (size_t)i * 64 * lda); rb[i] = *(const u32x4*)(bg + (size_t)i * 64 * ldb); }
#pragma unroll
  for (int i = 0; i < 4; ++i) { *(u32x4*)(sA + wofs + i * 8192) = ra[i]; *(u32x4*)(sB + wofs + i * 8192) = rb[i]; }
  __syncthreads();
  const int nk = K >> 6, swz = (lane >> 1) & 7;
  const int aoff = (64 * wn + lq) * 128, boff = (128 * wm + lq) * 128;
  for (int kt = 0; kt < nk; ++kt) {
    const char* cA = sA + (kt & 1) * 65536; const char* cB = sB + (kt & 1) * 65536;
    const bool more = (kt + 1 < nk);
    if (more) { ag += 64; bg += 64;
#pragma unroll
      for (int i = 0; i < 4; ++i) { ra[i] = *(const u32x4*)(ag + (size_t)i * 64 * lda); rb[i] = *(const u32x4*)(bg + (size_t)i * 64 * ldb); } }
#pragma unroll
    for (int s = 0; s < 4; ++s) {
      const int co = (((2 * s + h) ^ swz) << 4);
      bf16x8 fa[2], fb[4];
#pragma unroll
      for (int ni = 0; ni < 2; ++ni) fa[ni] = *(const bf16x8*)(cB + aoff + ni * 4096 + co);
#pragma unroll
      for (int mi = 0; mi < 4; ++mi) fb[mi] = *(const bf16x8*)(cA + boff + mi * 4096 + co);
#pragma unroll
      for (int ni = 0; ni < 2; ++ni)
#pragma unroll
        for (int mi = 0; mi < 4; ++mi) acc[ni][mi] = MFMA32(fa[ni], fb[mi], acc[ni][mi]);
    }
    if (more) { char* dA = sA + ((kt + 1) & 1) * 65536; char* dB = sB + ((kt + 1) & 1) * 65536;
#pragma unroll
      for (int i = 0; i < 4; ++i) { *(u32x4*)(dA + wofs + i * 8192) = ra[i]; *(u32x4*)(dB + wofs + i * 8192) = rb[i]; } }
    __syncthreads();
  }
#pragma unroll
  for (int ni = 0; ni < 2; ++ni)
#pragma unroll
    for (int mi = 0; mi < 4; ++mi)
#pragma unroll
      for (int rg = 0; rg < 4; ++rg) {
        const int m = m0 + 128 * wm + 32 * mi + lq, n = n0 + 64 * wn + 32 * ni + 8 * rg + 4 * h;
        epi(m, n, acc[ni][mi][4 * rg], acc[ni][mi][4 * rg + 1], acc[ni][mi][4 * rg + 2], acc[ni][mi][4 * rg + 3]);
      }
}

DI void tile_coord(int t, int npn, int& pm, int& pn) { const int g = t / (16 * npn), r = t % (16 * npn); pn = r >> 4; pm = g * 16 + (r & 15); }

struct EpiProj { bf16_t* proj; float* ab;
  DI void operator()(int m, int n, float v0, float v1, float v2, float v3) const {
    u32x2 pk = {pack2(v0, v1), pack2(v2, v3)}; *(u32x2*)(proj + (size_t)m * DINP + n) = pk;
    if (n >= C_AA && n < C_AA + 16) { f32x4 v = {v0, v1, v2, v3}; *(f32x4*)(ab + (size_t)m * 16 + (n - C_AA)) = v; } } };
struct EpiF32 { float* out; int ldc;
  DI void operator()(int m, int n, float v0, float v1, float v2, float v3) const { f32x4 v = {v0, v1, v2, v3}; *(f32x4*)(out + (size_t)m * ldc + n) = v; } };
struct EpiBf { bf16_t* out; int ldc;
  DI void operator()(int m, int n, float v0, float v1, float v2, float v3) const { u32x2 pk = {pack2(v0, v1), pack2(v2, v3)}; *(u32x2*)(out + (size_t)m * ldc + n) = pk; } };
struct EpiMlaQ { float* qraw; const float* rs; int m0;
  DI void operator()(int m, int n, float v0, float v1, float v2, float v3) const { const float r = rs[m - m0]; f32x4 v = {v0 * r, v1 * r, v2 * r, v3 * r}; *(f32x4*)(qraw + (size_t)m * 768 + n) = v; } };
struct EpiMlaKV { bf16_t* kmla; bf16_t* vt; const float* rs; int m0;
  DI void operator()(int m, int n, float v0, float v1, float v2, float v3) const {
    const float r = rs[m - m0]; const int hd = n >> 8, wi = n & 255;
    if (wi < 128) { u32x2 pk = {pack2(v0 * r, v1 * r), pack2(v2 * r, v3 * r)}; *(u32x2*)(kmla + ((size_t)hd * S_ + m) * 192 + wi) = pk; }
    else { bf16_t* p = vt + ((size_t)hd * 128 + (wi - 128)) * S_ + m; p[0] = f2bf(v0 * r); p[S_] = f2bf(v1 * r); p[2 * (size_t)S_] = f2bf(v2 * r); p[3 * (size_t)S_] = f2bf(v3 * r); } } };

template <class Epi>
DI void gemm_phase(const bf16_t* A, int lda, const bf16_t* Bt, int ldb, int K, int npm, int npn, char* smem, const Epi& epi) {
  if (gridDim.x == 256 && npm == 64) {
    const int b = blockIdx.x, pm = 8 * (b & 7) + ((b >> 3) & 7), pj = b >> 6;
    for (int pn = pj; pn < npn; pn += 4) gemm_tile(A, lda, Bt, ldb, K, pm * 256, pn * 256, smem, epi);
  } else {
    for (int t = blockIdx.x; t < npm * npn; t += gridDim.x) { int pm, pn; tile_coord(t, npn, pm, pn); gemm_tile(A, lda, Bt, ldb, K, pm * 256, pn * 256, smem, epi); }
  }
}

DI void mod_item(const Params& P, int item) {
  const int tid = opaque_tid(); const int l = item / 96, r = item % 96, ks = r / 6, nc = r % 6;
  const int n = nc * 2048 + tid * 4;
  const float* wp = P.ada_w + ((size_t)l * 2048 + ks * 128) * 12288 + n;
  f32x4 acc = {0.f, 0.f, 0.f, 0.f};
#pragma unroll 8
  for (int k = 0; k < 128; ++k) { const float cv = P.c[ks * 128 + k]; const float ca = silu_f(cv); const f32x4 wv = *(const f32x4*)(wp + (size_t)k * 12288); acc += wv * ca; }
  float* modp = (float*)(P.ws + OFF_MODP);
  *(f32x4*)(modp + ((size_t)l * 16 + ks) * 12288 + n) = acc;
}
DI void convert_tile(const float* __restrict__ src, int K, int N, bf16_t* __restrict__ dst, int tk, int tn, const float* rowscale, char* smem) {
  float* sm = (float*)smem; const int tid = opaque_tid(); const int k0 = tk * 64, n0 = tn * 256;
  { const int r = tid >> 6, c4 = tid & 63; const int n = n0 + 4 * c4;
    f32x4 v[8];
#pragma unroll
    for (int i = 0; i < 8; ++i) { v[i] = (f32x4){0.f, 0.f, 0.f, 0.f}; if (n < N) v[i] = *(const f32x4*)(src + (size_t)(k0 + r + 8 * i) * N + n); }
#pragma unroll
    for (int i = 0; i < 8; ++i) { const int kk = r + 8 * i; if (rowscale) v[i] *= rowscale[k0 + kk];
      sm[kk * 257 + 4 * c4 + 0] = v[i].x; sm[kk * 257 + 4 * c4 + 1] = v[i].y; sm[kk * 257 + 4 * c4 + 2] = v[i].z; sm[kk * 257 + 4 * c4 + 3] = v[i].w; } }
  __syncthreads();
  { const int n = tid >> 1, kh = tid & 1;
#pragma unroll
    for (int j = 0; j < 4; ++j) { float f[8];
#pragma unroll
      for (int i = 0; i < 8; ++i) f[i] = sm[(32 * kh + 8 * j + i) * 257 + n];
      u32x4 pk = {pack2(f[0], f[1]), pack2(f[2], f[3]), pack2(f[4], f[5]), pack2(f[6], f[7])};
      *(u32x4*)(dst + (size_t)(n0 + n) * K + k0 + 32 * kh + 8 * j) = pk; } }
  __syncthreads();
}
constexpr int CV_T0 = 32 * 22, CV_T1 = CV_T0 + 32 * 8, CV_T2 = CV_T1 + 32 * 44, CV_T3 = CV_T2 + 88 * 8, CV_T4 = CV_T3 + 7 * 3, CV_T5 = CV_T4 + 2 * 4;
DI void convert_item(const Params& P, int l, int it, char* smem) {
  char* wb = P.ws + OFF_W;
  if (it < CV_T0) convert_tile(P.w_in + (size_t)l * 2048 * 5520, 2048, 5520, (bf16_t*)(wb + W_IN), it / 22, it % 22, nullptr, smem);
  else if (it < CV_T1) { it -= CV_T0; convert_tile(P.w_out + (size_t)l * 2048 * 2048, 2048, 2048, (bf16_t*)(wb + W_OUT), it / 8, it % 8, nullptr, smem); }
  else if (it < CV_T2) { it -= CV_T1; convert_tile(P.ffn_w_up + (size_t)l * 2048 * 11264, 2048, 11264, (bf16_t*)(wb + W_UP), it / 44, it % 44, nullptr, smem); }
  else if (it < CV_T3) { it -= CV_T2; convert_tile(P.ffn_w_down + (size_t)l * 5632 * 2048, 5632, 2048, (bf16_t*)(wb + W_DOWN), it / 8, it % 8, nullptr, smem); }
  else if (it < CV_T4) { it -= CV_T3; convert_tile(P.mla_w_uq + (size_t)l * 448 * 768, 448, 768, (bf16_t*)(wb + W_UQ), it / 3, it % 3, P.mla_q_norm + l * 448, smem); }
  else { it -= CV_T4; convert_tile(P.mla_w_ukv + (size_t)l * 128 * 1024, 128, 1024, (bf16_t*)(wb + W_UKV), it / 4, it % 4, P.mla_kv_norm + l * 128, smem); }
}

DI float mod_val(const float* modp_l, const float* ada_b_l, int idx) { float s = ada_b_l[idx];
#pragma unroll
  for (int k = 0; k < 16; ++k) s += modp_l[(size_t)k * 12288 + idx]; return s; }
DI void rownorm_phase(const Params& P, const float* xin, const bf16_t* yin, float* xout, bf16_t* hout, int lg, int gate_idx, const float* w_post,
                      int lh, int scale_idx, int shift_idx, const float* w_pre, char* smem) {
  float* A1 = (float*)smem; float* A2 = A1 + 2048; float* B2 = A2 + 2048;
  const int tid = opaque_tid(), lane = tid & 63, w = tid >> 6;
  const float* modp = (const float*)(P.ws + OFF_MODP);
  for (int cidx = tid; cidx < 2048; cidx += NT) {
    if (yin) A1[cidx] = mod_val(modp + (size_t)lg * 16 * 12288, P.ada_b + (size_t)lg * 12288, gate_idx * 2048 + cidx) * w_post[cidx];
    if (hout) { A2[cidx] = w_pre[cidx] * (1.f + mod_val(modp + (size_t)lh * 16 * 12288, P.ada_b + (size_t)lh * 12288, scale_idx * 2048 + cidx));
      B2[cidx] = mod_val(modp + (size_t)lh * 16 * 12288, P.ada_b + (size_t)lh * 12288, shift_idx * 2048 + cidx); }
  }
  __syncthreads();
  for (int row = blockIdx.x * 8 + w; row < S_; row += gridDim.x * 8) {
    f32x4 xv[8];
#pragma unroll
    for (int j = 0; j < 8; ++j) xv[j] = *(const f32x4*)(xin + (size_t)row * 2048 + (j * 64 + lane) * 4);
    if (yin) {
      f32x4 yv[8]; float ss = 0.f;
#pragma unroll
      for (int j = 0; j < 8; ++j) { const u32x2 yb = *(const u32x2*)(yin + (size_t)row * 2048 + (j * 64 + lane) * 4); yv[j] = (f32x4){bflo(yb.x), bfhi(yb.x), bflo(yb.y), bfhi(yb.y)};
        ss += yv[j].x * yv[j].x + yv[j].y * yv[j].y + yv[j].z * yv[j].z + yv[j].w * yv[j].w; }
      ss = wave_sum(ss); const float r = rsqrtf(ss * (1.f / 2048.f) + EPS);
#pragma unroll
      for (int j = 0; j < 8; ++j) { const f32x4 a = *(const f32x4*)(A1 + (j * 64 + lane) * 4); xv[j] += a * (yv[j] * r); }
    }
    if (yin || xout != xin) {
#pragma unroll
      for (int j = 0; j < 8; ++j) *(f32x4*)(xout + (size_t)row * 2048 + (j * 64 + lane) * 4) = xv[j];
    }
    if (hout) {
      float ss = 0.f;
#pragma unroll
      for (int j = 0; j < 8; ++j) ss += xv[j].x * xv[j].x + xv[j].y * xv[j].y + xv[j].z * xv[j].z + xv[j].w * xv[j].w;
      ss = wave_sum(ss); const float r = rsqrtf(ss * (1.f / 2048.f) + EPS);
#pragma unroll
      for (int j = 0; j < 8; ++j) { const f32x4 a = *(const f32x4*)(A2 + (j * 64 + lane) * 4), b = *(const f32x4*)(B2 + (j * 64 + lane) * 4);
        const f32x4 hv = xv[j] * r * a + b; u32x2 pk = {pack2(hv.x, hv.y), pack2(hv.z, hv.w)};
        *(u32x2*)(hout + (size_t)row * 2048 + (j * 64 + lane) * 4) = pk; }
    }
  }
  __syncthreads();
}

DI void mla_q_tile(const Params& P, int pm, int pn, char* smem) {
  const bf16_t* proj = (const bf16_t*)(P.ws + OFF_PROJ); const int tid = opaque_tid(), m0 = pm * 256; float* rs = (float*)(smem + 131072);
  { const int row = tid >> 1, half = tid & 1; const bf16_t* p = proj + (size_t)(m0 + row) * DINP + C_BCQ + half * 224; float ss = 0.f;
    for (int i = 0; i < 28; ++i) { const u32x4 v = *(const u32x4*)(p + i * 8); float f[8]; unpack8(v, f);
#pragma unroll
      for (int e = 0; e < 8; ++e) ss += f[e] * f[e]; }
    ss += __shfl_xor(ss, 1); if (half == 0) rs[row] = rsqrtf(ss * (1.f / 448.f) + EPS); }
  EpiMlaQ epi{(float*)(P.ws + OFF_QRAW), rs, m0};
  gemm_tile_s(proj + C_BCQ, DINP, (const bf16_t*)(P.ws + OFF_W + W_UQ), 448, 448, m0, pn * 256, smem, epi);
  __syncthreads();
}
DI void mla_kv_tile(const Params& P, int pm, int pn, char* smem) {
  const bf16_t* proj = (const bf16_t*)(P.ws + OFF_PROJ); const int tid = opaque_tid(), m0 = pm * 256; float* rs = (float*)(smem + 131072);
  { const int row = tid >> 1, half = tid & 1; const bf16_t* p = proj + (size_t)(m0 + row) * DINP + C_BCKV + half * 64; float ss = 0.f;
#pragma unroll
    for (int i = 0; i < 8; ++i) { const u32x4 v = *(const u32x4*)(p + i * 8); float f[8]; unpack8(v, f);
#pragma unroll
      for (int e = 0; e < 8; ++e) ss += f[e] * f[e]; }
    ss += __shfl_xor(ss, 1); if (half == 0) rs[row] = rsqrtf(ss * (1.f / 128.f) + EPS); }
  bf16_t* kmla = (bf16_t*)(P.ws + OFF_KMLA);
  EpiMlaKV epi{kmla, (bf16_t*)(P.ws + OFF_VT), rs, m0};
  gemm_tile_s(proj + C_BCKV, DINP, (const bf16_t*)(P.ws + OFF_W + W_UKV), 128, 128, m0, pn * 256, smem, epi);
  if (pn == 0) {
    for (int i = 0; i < 16; ++i) { const int idx = tid + NT * i, row = idx >> 5, pi = idx & 31, m = m0 + row;
      const float x1 = bflo((unsigned)proj[(size_t)m * DINP + C_BKR + pi]), x2 = bflo((unsigned)proj[(size_t)m * DINP + C_BKR + 32 + pi]);
      double fr = (double)P.pos[m] * kInvFreq2Pi[pi]; fr -= floor(fr); const float ff = (float)fr;
      const float sn = __builtin_amdgcn_sinf(ff), cs = __builtin_amdgcn_cosf(ff);
      const bf16_t o1 = f2bf(x1 * cs - x2 * sn), o2 = f2bf(x2 * cs + x1 * sn);
#pragma unroll
      for (int hd = 0; hd < 4; ++hd) { bf16_t* kp = kmla + ((size_t)hd * S_ + m) * 192 + 128; kp[pi] = o1; kp[32 + pi] = o2; } }
  }
  __syncthreads();
}

DI void gdn_prep_item(const Params& P, int l, int n, int hh, char* smem) {
  const int tid = opaque_tid(), lane = tid & 63, w = tid >> 6, lq = lane & 31, h = lane >> 5;
  const bf16_t* proj = (const bf16_t*)(P.ws + OFF_PROJ); const float* ab = (const float*)(P.ws + OFF_AB);
  char* kb16 = smem; char* qb16 = smem + 17408;
  float* kf = (float*)(smem + 34816); float* vf = kf + 8192; float* Lm = vf + 8192; float* gcs = Lm + 4096;
  const size_t tile = (size_t)hh * 256 + n; const int t0 = n * 64;
  bf16_t* Wp = (bf16_t*)(P.ws + OFF_WP) + tile * 8192; bf16_t* Qd = (bf16_t*)(P.ws + OFF_QD) + tile * 8192;
  bf16_t* Kt = (bf16_t*)(P.ws + OFF_KT) + tile * 8192; bf16_t* Zt = (bf16_t*)(P.ws + OFF_ZT) + tile * 8192;
  bf16_t* QK = (bf16_t*)(P.ws + OFF_QK) + tile * 4096; bf16_t* Ut = (bf16_t*)(P.ws + OFF_UT) + tile * 8192;
  if (w == 0) {
    const int t = lane; const float a_raw = ab[(size_t)(t0 + t) * 16 + hh], b_raw = ab[(size_t)(t0 + t) * 16 + 8 + hh];
    const float Aa = __expf(P.gdn_a_log[l * 8 + hh]); const float xb = a_raw + P.gdn_dt_bias[l * 8 + hh];
    const float ex = __expf(fminf(xb, 20.f));
    const float sp = xb > 20.f ? xb : (ex < 0.01f ? ex * (1.f - ex * (0.5f - ex * (1.f / 3.f))) : __logf(1.f + ex));
    float g = -Aa * sp;
#pragma unroll
    for (int d = 1; d < 64; d <<= 1) { const float v = __shfl_up(g, d); if (lane >= d) g += v; }
    const float bt = __builtin_amdgcn_rcpf(1.f + __expf(-b_raw)), eg = __expf(g); gcs[t] = g; gcs[64 + t] = bt; gcs[128 + t] = eg; gcs[192 + t] = bt * eg;
    if (t == 63) ((float*)(P.ws + OFF_GTOT))[tile] = eg;
  }
  __syncthreads();
  {
    const int t = tid >> 3, part = tid & 7, tabs = t0 + t;
    const float gct = gcs[t], egct = gcs[128 + t], ktl = __expf(gcs[63] - gct);
    const int pjt = 32 * (t >> 5) + perm32(t & 31);
#pragma unroll
    for (int X = 0; X < 3; ++X) {
      const int cb = X * 1024 + hh * 128 + part * 16;
      float y[16];
#pragma unroll
      for (int e = 0; e < 16; ++e) y[e] = 0.f;
      u32x4 pv[4][2]; f32x4 wv[4][4];
#pragma unroll
      for (int j = 0; j < 4; ++j) { const int row = tabs - 3 + j, rr = row < 0 ? 0 : row;
        pv[j][0] = *(const u32x4*)(proj + (size_t)rr * DINP + cb); pv[j][1] = *(const u32x4*)(proj + (size_t)rr * DINP + cb + 8);
        const float* cw = P.gdn_conv + ((size_t)l * 4 + j) * 3072 + cb;
#pragma unroll
        for (int e4 = 0; e4 < 4; ++e4) wv[j][e4] = *(const f32x4*)(cw + 4 * e4); }
      __builtin_amdgcn_sched_barrier(0);
#pragma unroll
      for (int j = 0; j < 4; ++j) { const float msk = (tabs - 3 + j) >= 0 ? 1.f : 0.f;
        float xv[16]; unpack8(pv[j][0], xv); unpack8(pv[j][1], xv + 8);
#pragma unroll
        for (int e4 = 0; e4 < 4; ++e4) { const f32x4 wm = wv[j][e4] * msk; y[4 * e4] += wm.x * xv[4 * e4]; y[4 * e4 + 1] += wm.y * xv[4 * e4 + 1]; y[4 * e4 + 2] += wm.z * xv[4 * e4 + 2]; y[4 * e4 + 3] += wm.w * xv[4 * e4 + 3]; } }
#pragma unroll
      for (int e = 0; e < 16; ++e) y[e] = silu_f(y[e]);
      if (X < 2) { float ss = 0.f;
#pragma unroll
        for (int e = 0; e < 16; ++e) ss += y[e] * y[e];
        ss += __shfl_xor(ss, 1); ss += __shfl_xor(ss, 2); ss += __shfl_xor(ss, 4);
        const float rn = rsqrtf(ss + EPS) * (X == 0 ? 0.08838834764831845f : 1.f);
#pragma unroll
        for (int e = 0; e < 16; ++e) y[e] *= rn; }
      if (X == 0) {
        u32x4 p0 = {pack2(y[0], y[1]), pack2(y[2], y[3]), pack2(y[4], y[5]), pack2(y[6], y[7])}, p1 = {pack2(y[8], y[9]), pack2(y[10], y[11]), pack2(y[12], y[13]), pack2(y[14], y[15])};
        *(u32x4*)(qb16 + t * 272 + part * 32) = p0; *(u32x4*)(qb16 + t * 272 + part * 32 + 16) = p1;
#pragma unroll
        for (int b = 0; b < 4; ++b) { u32x2 pk = {pack2(y[4 * b] * egct, y[4 * b + 1] * egct), pack2(y[4 * b + 2] * egct, y[4 * b + 3] * egct)};
          *(u32x2*)(Qd + t * 128 + 32 * (part >> 1) + 8 * b + 4 * (part & 1)) = pk; }
      } else if (X == 1) {
        u32x4 p0 = {pack2(y[0], y[1]), pack2(y[2], y[3]), pack2(y[4], y[5]), pack2(y[6], y[7])}, p1 = {pack2(y[8], y[9]), pack2(y[10], y[11]), pack2(y[12], y[13]), pack2(y[14], y[15])};
        *(u32x4*)(kb16 + t * 272 + part * 32) = p0; *(u32x4*)(kb16 + t * 272 + part * 32 + 16) = p1;
#pragma unroll
        for (int e4 = 0; e4 < 4; ++e4) { f32x4 v = {y[4 * e4], y[4 * e4 + 1], y[4 * e4 + 2], y[4 * e4 + 3]}; *(f32x4*)(kf + t * 128 + part * 16 + 4 * e4) = v; }
#pragma unroll
        for (int e = 0; e < 16; ++e) Kt[(part * 16 + e) * 64 + pjt] = f2bf(y[e] * ktl);
      } else {
#pragma unroll
        for (int e4 = 0; e4 < 4; ++e4) { f32x4 v = {y[4 * e4], y[4 * e4 + 1], y[4 * e4 + 2], y[4 * e4 + 3]}; *(f32x4*)(vf + t * 128 + part * 16 + 4 * e4) = v; }
      }
    }
    { const int cb = C_AZ + hh * 128 + part * 16; const u32x4 v0 = *(const u32x4*)(proj + (size_t)tabs * DINP + cb), v1 = *(const u32x4*)(proj + (size_t)tabs * DINP + cb + 8);
      float zv[16]; unpack8(v0, zv); unpack8(v1, zv + 8);
#pragma unroll
      for (int e = 0; e < 16; ++e) Zt[(part * 16 + e) * 64 + t] = f2bf(silu_f(zv[e])); }
  }
  __syncthreads();
  {
    const int which = w >> 2, ti = (w >> 1) & 1, tj = w & 1; const char* Ab = which ? qb16 : kb16;
    f32x16 acc;
#pragma unroll
    for (int r = 0; r < 16; ++r) acc[r] = 0.f;
#pragma unroll
    for (int s = 0; s < 8; ++s) { const bf16x8 a = *(const bf16x8*)(Ab + (32 * ti + lq) * 272 + (16 * s + 8 * h) * 2), b = *(const bf16x8*)(kb16 + (32 * tj + lq) * 272 + (16 * s + 8 * h) * 2);
      acc = MFMA32(a, b, acc); }
    const int j = 32 * tj + lq; const float gj = gcs[j]; const int pj = 32 * (j >> 5) + perm32(j & 31);
#pragma unroll
    for (int r = 0; r < 16; ++r) { const int i = 32 * ti + crow(r, h); const float dec = __expf(fminf(gcs[i] - gj, 0.f));
      if (which == 0) Lm[i * 64 + j] = (j < i) ? gcs[64 + i] * acc[r] * dec : 0.f;
      else QK[i * 64 + pj] = f2bf((j <= i) ? acc[r] * dec : 0.f); }
  }
  __syncthreads();
  if (tid < 256) {
    const int c = tid; const bool isu = c < 128; const int cc = c & 127;
    const float* rp = (isu ? vf : kf) + cc; const float* sp = gcs + (isu ? 64 : 192);
    f32x2 xx[32];
    f32x4 LA[16], LB[16]; float rh[2];
    xx[0].x = sp[0] * rp[0];
    LA[0] = *(const f32x4*)(Lm + 64); rh[1] = sp[1] * rp[128];
#pragma unroll
    for (int i = 1; i < 64; ++i) {
      f32x4 (&CUR)[16] = (i & 1) ? LA : LB; f32x4 (&NXT)[16] = (i & 1) ? LB : LA;
      if (i + 1 < 64) {
#pragma unroll
        for (int c = 0; c < (i + 4) / 4; ++c) NXT[c] = *(const f32x4*)(Lm + (i + 1) * 64 + 4 * c);
        rh[(i + 1) & 1] = sp[i + 1] * rp[(i + 1) * 128];
      }
      __builtin_amdgcn_sched_barrier(0);
      f32x2 acc = {rh[i & 1], 0.f};
#pragma unroll
      for (int p = 0; p < i / 2; ++p) { const f32x2 lp = (p & 1) ? (f32x2){CUR[p >> 1].z, CUR[p >> 1].w} : (f32x2){CUR[p >> 1].x, CUR[p >> 1].y}; acc = acc - lp * xx[p]; }
      if (i & 1) { const int j = i - 1; const float lj = ((j & 3) == 0) ? CUR[j >> 2].x : CUR[j >> 2].z; acc.x = fmaf(-lj, xx[j >> 1].x, acc.x); }
      const float xi = acc.x + acc.y;
      if (i & 1) xx[i >> 1].y = xi; else xx[i >> 1].x = xi;
      __builtin_amdgcn_sched_barrier(0);
    }
    float x[64];
#pragma unroll
    for (int p = 0; p < 32; ++p) { x[2 * p] = xx[p].x; x[2 * p + 1] = xx[p].y; }
    if (isu) {
#pragma unroll
      for (int i8 = 0; i8 < 8; ++i8) { u32x4 v = {pack2(x[8 * i8], x[8 * i8 + 1]), pack2(x[8 * i8 + 2], x[8 * i8 + 3]), pack2(x[8 * i8 + 4], x[8 * i8 + 5]), pack2(x[8 * i8 + 6], x[8 * i8 + 7])}; *(u32x4*)(Ut + cc * 64 + 8 * i8) = v; }
    } else {
      const int pp = 32 * (cc >> 5) + perm32(cc & 31);
#pragma unroll
      for (int i = 0; i < 64; ++i) Wp[i * 128 + pp] = f2bf(x[i]);
    }
  }
  __syncthreads();
}

DI bf16x8 pack_tiles(const f32x4& a, const f32x4& b) { return pack8(a.x, a.y, a.z, a.w, b.x, b.y, b.z, b.w); }
template <int CTRL> DI float dppf(float v) { return __int_as_float(__builtin_amdgcn_update_dpp(0, __float_as_int(v), CTRL, 0xf, 0xf, true)); }
DI float row16_sum(float v) { v += dppf<0xB1>(v); v += dppf<0x4E>(v); v += dppf<0x141>(v); v += dppf<0x140>(v); return v; }
constexpr size_t OFF_SSQP = OFF_GTOT + 8192;
static_assert(OFF_SSQP + (size_t)8 * S_ * 8 * 4 <= OFF_UT, "overlay3");
constexpr int SCAN_OPB = 62464;
constexpr int SCAN_SO = 2 * SCAN_OPB;
constexpr int SCAN_OT = SCAN_SO + 16384;
DI void gdn_scan_item(const Params& P, int l, int hh, int half, char* smem) {
  const int tid = opaque_tid(), lane = tid & 63, w = tid >> 6, l15 = lane & 15, q4 = lane >> 4;
  const size_t hb = (size_t)hh * 256;
  const bf16_t* Wp = (const bf16_t*)(P.ws + OFF_WP) + hb * 8192; const bf16_t* Qd = (const bf16_t*)(P.ws + OFF_QD) + hb * 8192;
  const bf16_t* Kt = (const bf16_t*)(P.ws + OFF_KT) + hb * 8192; const bf16_t* Zt = (const bf16_t*)(P.ws + OFF_ZT) + hb * 8192;
  const bf16_t* QK = (const bf16_t*)(P.ws + OFF_QK) + hb * 4096; const bf16_t* Ut = (const bf16_t*)(P.ws + OFF_UT) + hb * 8192;
  const float* gt = (const float*)(P.ws + OFF_GTOT) + hb;
  bf16_t* mixin = (bf16_t*)(P.ws + OFF_H);
  if (w >= 4) {
    const int lt = tid - 256, wl = w - 4;
    const int dvc = 64 * half + 16 * wl + l15; const float nw = P.gdn_norm[l * 128 + dvc];
    const int uoff = dvc * 64 + 4 * q4;
    float* ssqp = (float*)(P.ws + OFF_SSQP) + (size_t)(half * 4 + wl) * S_ * 8;
    const int g256 = (lt >> 4) * 128 + (lt & 15) * 8, l256 = (lt >> 4) * 272 + (lt & 15) * 16;
    const int g128 = (lt >> 3) * 64 + (lt & 7) * 8, l128 = (lt >> 3) * 144 + (lt & 7) * 16;
    u32x4 pw[4], pq[4], pk[4], pqk[2]; u32x2 zc[4], zn[4];
#pragma unroll
    for (int i = 0; i < 4; ++i) { pw[i] = *(const u32x4*)(Wp + g256 + i * 2048); pq[i] = *(const u32x4*)(Qd + g256 + i * 2048); pk[i] = *(const u32x4*)(Kt + g128 + i * 2048); }
#pragma unroll
    for (int i = 0; i < 2; ++i) pqk[i] = *(const u32x4*)(QK + g128 + i * 2048);
#pragma unroll
    for (int i = 0; i < 4; ++i) { *(u32x4*)(smem + l256 + i * 4352) = pw[i]; *(u32x4*)(smem + 17408 + l256 + i * 4352) = pq[i]; *(u32x4*)(smem + 34816 + l128 + i * 4608) = pk[i]; }
#pragma unroll
    for (int i = 0; i < 2; ++i) *(u32x4*)(smem + 53248 + l128 + i * 4608) = pqk[i];
#pragma unroll
    for (int i = 0; i < 4; ++i) { pw[i] = *(const u32x4*)(Wp + 8192 + g256 + i * 2048); pq[i] = *(const u32x4*)(Qd + 8192 + g256 + i * 2048); pk[i] = *(const u32x4*)(Kt + 8192 + g128 + i * 2048); }
#pragma unroll
    for (int i = 0; i < 2; ++i) pqk[i] = *(const u32x4*)(QK + 4096 + g128 + i * 2048);
#pragma unroll
    for (int it = 0; it < 4; ++it) { zc[it] = (u32x2){0u, 0u}; zn[it] = zc[it]; }
    __syncthreads();
#pragma unroll 1
    for (int n = 0; n <= 257; ++n) {
      if (n == 257) __syncthreads();
      if (n < 256) {
        char* nb = smem + ((n + 1) & 1) * SCAN_OPB;
        if (n + 1 < 256) {
#pragma unroll
          for (int i = 0; i < 4; ++i) { *(u32x4*)(nb + l256 + i * 4352) = pw[i]; *(u32x4*)(nb + 17408 + l256 + i * 4352) = pq[i]; *(u32x4*)(nb + 34816 + l128 + i * 4608) = pk[i]; }
#pragma unroll
          for (int i = 0; i < 2; ++i) *(u32x4*)(nb + 53248 + l128 + i * 4608) = pqk[i];
        }
        if (n + 2 < 256) { const size_t o8 = (size_t)(n + 2) * 8192, o4 = (size_t)(n + 2) * 4096;
#pragma unroll
          for (int i = 0; i < 4; ++i) { pw[i] = *(const u32x4*)(Wp + o8 + g256 + i * 2048); pq[i] = *(const u32x4*)(Qd + o8 + g256 + i * 2048); pk[i] = *(const u32x4*)(Kt + o8 + g128 + i * 2048); }
#pragma unroll
          for (int i = 0; i < 2; ++i) pqk[i] = *(const u32x4*)(QK + o4 + g128 + i * 2048); }
#pragma unroll
        for (int it = 0; it < 4; ++it) zn[it] = *(const u32x2*)(Zt + (size_t)n * 8192 + uoff + 16 * it);
      }
      if (n >= 2) {
        const int m2 = n - 2; const char* ot = smem + SCAN_OT + (m2 & 1) * 8192;
#pragma unroll
        for (int i = 0; i < 2; ++i) { const int c = lt + 256 * i, row = c >> 3, cc = c & 7;
          *(u32x4*)(mixin + (size_t)(64 * m2 + row) * 2048 + hh * 128 + 64 * half + cc * 8) = *(const u32x4*)(ot + row * 128 + cc * 16); }
      }
      if (n >= 1 && n <= 256) {
        const int m = n - 1; const char* so = smem + SCAN_SO + (m & 1) * 8192 + (wl * 4) * 512 + lane * 8;
        bf16_t* ot = (bf16_t*)(smem + SCAN_OT + (m & 1) * 8192);
#pragma unroll
        for (int it = 0; it < 4; ++it) {
          const u32x2 ob = *(const u32x2*)(so + it * 512); const f32x4 o = {bflo(ob.x), bfhi(ob.x), bflo(ob.y), bfhi(ob.y)};
          f32x4 ss = o * o;
          ss.x = row16_sum(ss.x); ss.y = row16_sum(ss.y); ss.z = row16_sum(ss.z); ss.w = row16_sum(ss.w);
          const int rl = 16 * it + 4 * q4;
          if (l15 == 0) { float* sp = ssqp + (size_t)(64 * m + rl) * 8 + hh; sp[0] = ss.x; sp[8] = ss.y; sp[16] = ss.z; sp[24] = ss.w; }
          const float z0 = bflo(zc[it].x), z1 = bfhi(zc[it].x), z2 = bflo(zc[it].y), z3 = bfhi(zc[it].y);
          bf16_t* op = ot + rl * 64 + 16 * wl + l15;
          op[0] = f2bf(o.x * nw * z0); op[64] = f2bf(o.y * nw * z1); op[128] = f2bf(o.z * nw * z2); op[192] = f2bf(o.w * nw * z3);
        }
      }
#pragma unroll
      for (int it = 0; it < 4; ++it) zc[it] = zn[it];
      if (n < 256) __syncthreads();
    }
  } else {
    const int dvc = 64 * half + 16 * w + l15;
    const int uoff = dvc * 64 + 4 * q4;
    f32x4 St[8];
#pragma unroll
    for (int t = 0; t < 8; ++t) St[t] = (f32x4){0.f, 0.f, 0.f, 0.f};
    u32x2 uc[4], un[4]; float gcur, gn = 0.f;
#pragma unroll
    for (int it = 0; it < 4; ++it) { uc[it] = *(const u32x2*)(Ut + uoff + 16 * it); un[it] = uc[it]; }
    gcur = gt[0];
    __syncthreads();
#pragma unroll 2
    for (int n = 0; n < 256; ++n) {
      const char* cb = smem + (n & 1) * SCAN_OPB;
      const char* sWp = cb; const char* sQd = cb + 17408; const char* sKt = cb + 34816; const char* sQK = cb + 53248;
      if (n + 1 < 256) { const size_t o8 = (size_t)(n + 1) * 8192;
#pragma unroll
        for (int it = 0; it < 4; ++it) un[it] = *(const u32x2*)(Ut + o8 + uoff + 16 * it);
        gn = gt[n + 1]; }
      bf16x8 sb[4];
#pragma unroll
      for (int ks = 0; ks < 4; ++ks) sb[ks] = pack_tiles(St[2 * ks], St[2 * ks + 1]);
      f32x4 wsv[4], qs[4];
#pragma unroll
      for (int it = 0; it < 4; ++it) { wsv[it] = (f32x4){0.f, 0.f, 0.f, 0.f}; qs[it] = (f32x4){0.f, 0.f, 0.f, 0.f}; }
#pragma unroll
      for (int it = 0; it < 4; ++it)
#pragma unroll
        for (int ks = 0; ks < 4; ++ks) { const int o = (16 * it + l15) * 272 + 64 * ks + 16 * q4;
          const bf16x8 a = *(const bf16x8*)(sWp + o), a2 = *(const bf16x8*)(sQd + o);
          wsv[it] = MFMA16(a, sb[ks], wsv[it]); qs[it] = MFMA16(a2, sb[ks], qs[it]); }
      f32x4 vn[4];
#pragma unroll
      for (int it = 0; it < 4; ++it) { const f32x4 uf = {bflo(uc[it].x), bfhi(uc[it].x), bflo(uc[it].y), bfhi(uc[it].y)}; vn[it] = uf - wsv[it]; }
      bf16x8 vb[2];
#pragma unroll
      for (int ks = 0; ks < 2; ++ks) vb[ks] = pack_tiles(vn[2 * ks], vn[2 * ks + 1]);
#pragma unroll
      for (int it = 0; it < 4; ++it)
#pragma unroll
        for (int ks = 0; ks < 2; ++ks) { const bf16x8 a = *(const bf16x8*)(sQK + (16 * it + l15) * 144 + 64 * ks + 16 * q4); qs[it] = MFMA16(a, vb[ks], qs[it]); }
      { char* so = smem + SCAN_SO + (n & 1) * 8192 + (w * 4) * 512 + lane * 8;
#pragma unroll
        for (int it = 0; it < 4; ++it) { u32x2 ob = {pack2(qs[it].x, qs[it].y), pack2(qs[it].z, qs[it].w)}; *(u32x2*)(so + it * 512) = ob; } }
#pragma unroll
      for (int t = 0; t < 8; ++t) { St[t] *= gcur;
#pragma unroll
        for (int ks = 0; ks < 2; ++ks) { const bf16x8 a = *(const bf16x8*)(sKt + (16 * t + l15) * 144 + 64 * ks + 16 * q4); St[t] = MFMA16(a, vb[ks], St[t]); } }
#pragma unroll
      for (int it = 0; it < 4; ++it) uc[it] = un[it];
      gcur = gn;
      __syncthreads();
    }
    __syncthreads();
  }
  __syncthreads();
}
DI void gdn_fix_phase(const Params& P) {
  const int tid = opaque_tid();
  bf16_t* mixin = (bf16_t*)(P.ws + OFF_H); const float* ssqp = (const float*)(P.ws + OFF_SSQP);
  for (int idx = blockIdx.x * NT + tid; idx < S_ * 128; idx += gridDim.x * NT) {
    const int t = idx >> 7, ck = idx & 127, h = ck >> 4;
    float sq = 0.f;
#pragma unroll
    for (int p = 0; p < 8; ++p) sq += ssqp[((size_t)p * S_ + t) * 8 + h];
    const float r = rsqrtf(sq * (1.f / 128.f) + EPS);
    u32x4* pp = (u32x4*)(mixin + (size_t)t * 2048 + ck * 8); const u32x4 v = *pp; float f[8]; unpack8(v, f);
    u32x4 o = {pack2(f[0] * r, f[1] * r), pack2(f[2] * r, f[3] * r), pack2(f[4] * r, f[5] * r), pack2(f[6] * r, f[7] * r)}; *pp = o;
  }
}

DI void mla_attn_item(const Params& P, int hd, int b, char* smem) {
  const int tid = opaque_tid(), lane = tid & 63, w = tid >> 6, wq = w & 3, hk = w >> 2, lq = lane & 31, h = lane >> 5;
  const float* qraw = (const float*)(P.ws + OFF_QRAW);
  const bf16_t* Kg = (const bf16_t*)(P.ws + OFF_KMLA) + (size_t)hd * S_ * 192;
  const bf16_t* Vg = (const bf16_t*)(P.ws + OFF_VT) + (size_t)hd * 128 * S_;
  bf16_t* mixin = (bf16_t*)(P.ws + OFF_H);
  const int q = 128 * b + 32 * wq + lq;
  bf16x8 qf[12];
  {
    const float* qp = qraw + (size_t)q * 768 + hd * 192 + 8 * h;
    const float sc = 0.07216878364870322f * LOG2E;
#pragma unroll
    for (int s = 0; s < 8; ++s) { const f32x4 a = *(const f32x4*)(qp + 16 * s), c = *(const f32x4*)(qp + 16 * s + 4);
      qf[s] = pack8(a.x * sc, a.y * sc, a.z * sc, a.w * sc, c.x * sc, c.y * sc, c.z * sc, c.w * sc); }
    const double pq = (double)P.pos[q];
#pragma unroll
    for (int s2 = 0; s2 < 2; ++s2) {
      const f32x4 a0 = *(const f32x4*)(qp + 128 + 16 * s2), a1 = *(const f32x4*)(qp + 128 + 16 * s2 + 4);
      const f32x4 b0 = *(const f32x4*)(qp + 160 + 16 * s2), b1 = *(const f32x4*)(qp + 160 + 16 * s2 + 4);
      float x1[8] = {a0.x, a0.y, a0.z, a0.w, a1.x, a1.y, a1.z, a1.w}, x2[8] = {b0.x, b0.y, b0.z, b0.w, b1.x, b1.y, b1.z, b1.w}, o1[8], o2[8];
#pragma unroll
      for (int j = 0; j < 8; ++j) { double fr = pq * kInvFreq2Pi[16 * s2 + 8 * h + j]; fr -= floor(fr); const float ff = (float)fr;
        const float sn = __builtin_amdgcn_sinf(ff), cs = __builtin_amdgcn_cosf(ff);
        o1[j] = (x1[j] * cs - x2[j] * sn) * sc; o2[j] = (x2[j] * cs + x1[j] * sn) * sc; }
      qf[8 + s2] = pack8(o1[0], o1[1], o1[2], o1[3], o1[4], o1[5], o1[6], o1[7]);
      qf[10 + s2] = pack8(o2[0], o2[1], o2[2], o2[3], o2[4], o2[5], o2[6], o2[7]);
    }
  }
  constexpr int KST = 64 * 400, VST = 128 * 144, STG = KST + VST;
  f32x16 O[4];
#pragma unroll
  for (int i = 0; i < 4; ++i)
#pragma unroll
    for (int r = 0; r < 16; ++r) O[i][r] = 0.f;
  float m_i = -1e30f, l_i = 0.f;
  const int nt = 2 * b + 2;
  u32x4 rk[3], rv[2];
  const int vrow = tid >> 3, vcc = tid & 7;
#pragma unroll
  for (int i = 0; i < 3; ++i) { const int id = tid + NT * i, row = id / 24, cc = id % 24; rk[i] = *(const u32x4*)(Kg + row * 192 + cc * 8); }
#pragma unroll
  for (int i = 0; i < 2; ++i) rv[i] = *(const u32x4*)(Vg + (size_t)(vrow + 64 * i) * S_ + vcc * 8);
#pragma unroll
  for (int i = 0; i < 3; ++i) { const int id = tid + NT * i, row = id / 24, cc = id % 24; *(u32x4*)(smem + row * 400 + cc * 16) = rk[i]; }
#pragma unroll
  for (int i = 0; i < 2; ++i) *(u32x4*)(smem + KST + (vrow + 64 * i) * 144 + vcc * 16) = rv[i];
  __syncthreads();
  for (int kt = 0; kt < nt; ++kt) {
    const char* sK = smem + (kt & 1) * STG; const char* sV = sK + KST;
    const bool more = (kt + 1 < nt);
    if (more) { const size_t ko = (size_t)(kt + 1) * 64 * 192; const int vo = (kt + 1) * 64;
#pragma unroll
      for (int i = 0; i < 3; ++i) { const int id = tid + NT * i, row = id / 24, cc = id % 24; rk[i] = *(const u32x4*)(Kg + ko + row * 192 + cc * 8); }
#pragma unroll
      for (int i = 0; i < 2; ++i) rv[i] = *(const u32x4*)(Vg + (size_t)(vrow + 64 * i) * S_ + vo + vcc * 8); }
    const int key0 = 64 * kt + 32 * hk;
    if (key0 <= 128 * b + 32 * wq) {
      f32x16 st;
#pragma unroll
      for (int r = 0; r < 16; ++r) st[r] = 0.f;
#pragma unroll
      for (int s = 0; s < 12; ++s) { const bf16x8 kf = *(const bf16x8*)(sK + (32 * hk + lq) * 400 + (2 * s + h) * 16); st = MFMA32(kf, qf[s], st); }
      if (key0 + 31 > 128 * b + 32 * wq) {
        int qrel = q - key0 - 4 * h; asm volatile("" : "+v"(qrel));
#pragma unroll
        for (int r = 0; r < 16; ++r) if ((r & 3) + 8 * (r >> 2) > qrel) st[r] = -1e30f;
      }
      float mx = st[0];
#pragma unroll
      for (int r = 1; r < 16; ++r) mx = fmaxf(mx, st[r]);
      mx = fmaxf(mx, __shfl_xor(mx, 32));
      const float m_new = fmaxf(m_i, mx), alpha = exp2f(m_i - m_new);
      float ps = 0.f;
#pragma unroll
      for (int r = 0; r < 16; ++r) { st[r] = exp2f(st[r] - m_new); ps += st[r]; }
      l_i = l_i * alpha + ps; m_i = m_new;
#pragma unroll
      for (int i = 0; i < 4; ++i)
#pragma unroll
        for (int r = 0; r < 16; ++r) O[i][r] *= alpha;
      bf16x8 pf[2];
#pragma unroll
      for (int s = 0; s < 2; ++s) pf[s] = pack8(st[8 * s], st[8 * s + 1], st[8 * s + 2], st[8 * s + 3], st[8 * s + 4], st[8 * s + 5], st[8 * s + 6], st[8 * s + 7]);
#pragma unroll
      for (int i = 0; i < 4; ++i)
#pragma unroll
        for (int s = 0; s < 2; ++s) { const char* vp = sV + (32 * i + lq) * 144 + (32 * hk + 16 * s + 4 * h) * 2;
          const u32x2 lo = *(const u32x2*)vp, hi = *(const u32x2*)(vp + 16); u32x4 vv = {lo.x, lo.y, hi.x, hi.y};
          O[i] = MFMA32(__builtin_bit_cast(bf16x8, vv), pf[s], O[i]); }
    }
    if (more) { char* dK = smem + ((kt + 1) & 1) * STG;
#pragma unroll
      for (int i = 0; i < 3; ++i) { const int id = tid + NT * i, row = id / 24, cc = id % 24; *(u32x4*)(dK + row * 400 + cc * 16) = rk[i]; }
#pragma unroll
      for (int i = 0; i < 2; ++i) *(u32x4*)(dK + KST + (vrow + 64 * i) * 144 + vcc * 16) = rv[i]; }
    __syncthreads();
  }
  float* cO = (float*)smem; float* cm = cO + 4 * 4096; float* cl = cm + 256;
  if (hk == 1) {
#pragma unroll
    for (int i = 0; i < 4; ++i)
#pragma unroll
      for (int r = 0; r < 16; ++r) cO[wq * 4096 + (i * 16 + r) * 64 + lane] = O[i][r];
    cm[wq * 64 + lane] = m_i; cl[wq * 64 + lane] = l_i;
  }
  __syncthreads();
  if (hk == 0) {
    const float m1 = cm[wq * 64 + lane], l1 = cl[wq * 64 + lane];
    const float m = fmaxf(m_i, m1), a0 = exp2f(m_i - m), a1 = exp2f(m1 - m);
    float lt = l_i * a0 + l1 * a1; lt += __shfl_xor(lt, 32);
    const float inv = 1.f / lt;
    bf16_t* op = mixin + (size_t)q * 2048 + 1024 + hd * 128;
#pragma unroll
    for (int i = 0; i < 4; ++i)
#pragma unroll
      for (int rg = 0; rg < 4; ++rg) { float v[4];
#pragma unroll
        for (int e = 0; e < 4; ++e) v[e] = (O[i][4 * rg + e] * a0 + cO[wq * 4096 + (i * 16 + 4 * rg + e) * 64 + lane] * a1) * inv;
        u32x2 pk = {pack2(v[0], v[1]), pack2(v[2], v[3])}; *(u32x2*)(op + 32 * i + 8 * rg + 4 * h) = pk; }
  }
  __syncthreads();
}

DI void swa_item(const Params& P, int l, int n, int hk2, char* smem) {
  const int tid = opaque_tid(), lane = tid & 63, w = tid >> 6, lq = lane & 31, h = lane >> 5;
  const bf16_t* proj = (const bf16_t*)(P.ws + OFF_PROJ); bf16_t* mixin = (bf16_t*)(P.ws + OFF_H);
  bf16_t* sVt = (bf16_t*)smem;
#pragma unroll
  for (int i = 0; i < 4; ++i) { const int id = tid + NT * i, key = id >> 3, dc = id & 7; const int kp = 128 * (n - 1) + key;
    u32x4 v = {0u, 0u, 0u, 0u}; if (kp >= 0) v = *(const u32x4*)(proj + (size_t)kp * DINP + C_CV + hk2 * 64 + dc * 8);
    sVt[(8 * dc + 0) * 264 + key] = (bf16_t)(v.x & 0xffff); sVt[(8 * dc + 1) * 264 + key] = (bf16_t)(v.x >> 16);
    sVt[(8 * dc + 2) * 264 + key] = (bf16_t)(v.y & 0xffff); sVt[(8 * dc + 3) * 264 + key] = (bf16_t)(v.y >> 16);
    sVt[(8 * dc + 4) * 264 + key] = (bf16_t)(v.z & 0xffff); sVt[(8 * dc + 5) * 264 + key] = (bf16_t)(v.z >> 16);
    sVt[(8 * dc + 6) * 264 + key] = (bf16_t)(v.w & 0xffff); sVt[(8 * dc + 7) * 264 + key] = (bf16_t)(v.w >> 16); }
  __syncthreads();
  const int g = w >> 1, hq = hk2 * 4 + g;
  const float slope = exp2f(-(float)(hq + 1)) * LOG2E, sinkv = P.swa_sinks[l * 8 + hq] * LOG2E;
#pragma unroll 1
  for (int jj = 0; jj < 2; ++jj) {
    const int j = 2 * (w & 1) + jj; const int qrow = 128 * n + 32 * j + lq;
    bf16x8 qf[4];
#pragma unroll
    for (int s = 0; s < 4; ++s) qf[s] = *(const bf16x8*)(proj + (size_t)qrow * DINP + C_CQ + hq * 64 + 16 * s + 8 * h);
    f32x16 st[5];
    bf16x8 kf[2][4];
    { const int kp = 128 * (n - 1) + 32 * j + lq;
#pragma unroll
      for (int s = 0; s < 4; ++s) { kf[0][s] = (bf16x8){0, 0, 0, 0, 0, 0, 0, 0}; if (kp >= 0) kf[0][s] = *(const bf16x8*)(proj + (size_t)kp * DINP + C_CK + hk2 * 64 + 16 * s + 8 * h); } }
#pragma unroll
    for (int tt = 0; tt < 5; ++tt) {
      if (tt + 1 < 5) { const int kp = 128 * (n - 1) + 32 * (j + tt + 1) + lq;
#pragma unroll
        for (int s = 0; s < 4; ++s) { kf[(tt + 1) & 1][s] = (bf16x8){0, 0, 0, 0, 0, 0, 0, 0}; if (kp >= 0) kf[(tt + 1) & 1][s] = *(const bf16x8*)(proj + (size_t)kp * DINP + C_CK + hk2 * 64 + 16 * s + 8 * h); } }
      __builtin_amdgcn_sched_barrier(0);
#pragma unroll
      for (int r = 0; r < 16; ++r) st[tt][r] = 0.f;
#pragma unroll
      for (int s = 0; s < 4; ++s) st[tt] = MFMA32(kf[tt & 1][s], qf[s], st[tt]);
      __builtin_amdgcn_sched_barrier(0);
    }
    float mx = sinkv;
    int dbase = 128 + lq - 4 * h, kbase = 128 * (n - 1) + 32 * j + 4 * h;
    asm volatile("" : "+v"(dbase), "+v"(kbase));
#pragma unroll
    for (int tt = 0; tt < 5; ++tt)
#pragma unroll
      for (int r = 0; r < 16; ++r) { const int cst = 32 * tt + (r & 3) + 8 * (r >> 2); const int dist = dbase - cst; const int kpos = kbase + cst;
        const bool valid = (dist >= 0) && (dist < 128) && (kpos >= 0);
        const float sv = valid ? st[tt][r] * (0.125f * LOG2E) - slope * (float)dist : -1e30f; st[tt][r] = sv; mx = fmaxf(mx, sv); }
    mx = fmaxf(mx, __shfl_xor(mx, 32));
    float den = 0.f;
#pragma unroll
    for (int tt = 0; tt < 5; ++tt)
#pragma unroll
      for (int r = 0; r < 16; ++r) { const float p = exp2f(st[tt][r] - mx); st[tt][r] = p; den += p; }
    den += __shfl_xor(den, 32); den += exp2f(sinkv - mx);
    f32x16 O[2];
#pragma unroll
    for (int i = 0; i < 2; ++i)
#pragma unroll
      for (int r = 0; r < 16; ++r) O[i][r] = 0.f;
#pragma unroll
    for (int tt = 0; tt < 5; ++tt)
#pragma unroll
      for (int s = 0; s < 2; ++s) { const bf16x8 pf = pack8(st[tt][8 * s], st[tt][8 * s + 1], st[tt][8 * s + 2], st[tt][8 * s + 3], st[tt][8 * s + 4], st[tt][8 * s + 5], st[tt][8 * s + 6], st[tt][8 * s + 7]);
#pragma unroll
        for (int i = 0; i < 2; ++i) { const char* vp = (const char*)sVt + (32 * i + lq) * 528 + (32 * (j + tt) + 16 * s + 4 * h) * 2;
          const u32x2 lo = *(const u32x2*)vp, hi = *(const u32x2*)(vp + 16); u32x4 vv = {lo.x, lo.y, hi.x, hi.y};
          O[i] = MFMA32(__builtin_bit_cast(bf16x8, vv), pf, O[i]); }
        __builtin_amdgcn_sched_barrier(0); }
    const float inv = 1.f / den;
    bf16_t* op = mixin + (size_t)qrow * 2048 + 1536 + hq * 64;
#pragma unroll
    for (int i = 0; i < 2; ++i)
#pragma unroll
      for (int rg = 0; rg < 4; ++rg) { u32x2 pk = {pack2(O[i][4 * rg] * inv, O[i][4 * rg + 1] * inv), pack2(O[i][4 * rg + 2] * inv, O[i][4 * rg + 3] * inv)};
        *(u32x2*)(op + 32 * i + 8 * rg + 4 * h) = pk; }
  }
  __syncthreads();
}

DI float gelu_tanh(float x) { const float y = 0.7978845608028654f * (x + 0.044715f * x * x * x); const float t = 1.f - 2.f * __builtin_amdgcn_rcpf(1.f + __expf(2.f * y)); return 0.5f * x * (1.f + t); }
DI void ffn_act_phase(const Params& P, int l) {
  const int tid = opaque_tid(), lane = tid & 63, w = tid >> 6;
  const bf16_t* u = (const bf16_t*)(P.ws + OFF_BIG); bf16_t* act = (bf16_t*)(P.ws + OFF_ACT);
  const float* cw = P.ffn_conv + (size_t)l * 3 * DFF2; const float* cb = P.ffn_conv_b + (size_t)l * DFF2;
  for (int item = blockIdx.x * 8 + w; item < 512 * 11; item += gridDim.x * 8) {
    const int cbk = item % 11, rr = item / 11; const int ch = cbk * 512 + lane * 8, r0 = rr * 32;
    float wg[3][8], wu[3][8], bg[8], bu[8];
#pragma unroll
    for (int j = 0; j < 3; ++j)
#pragma unroll
      for (int e4 = 0; e4 < 2; ++e4) { const f32x4 a = *(const f32x4*)(cw + (size_t)j * DFF2 + ch + 4 * e4), b = *(const f32x4*)(cw + (size_t)j * DFF2 + DFF + ch + 4 * e4);
        wg[j][4 * e4] = a.x; wg[j][4 * e4 + 1] = a.y; wg[j][4 * e4 + 2] = a.z; wg[j][4 * e4 + 3] = a.w; wu[j][4 * e4] = b.x; wu[j][4 * e4 + 1] = b.y; wu[j][4 * e4 + 2] = b.z; wu[j][4 * e4 + 3] = b.w; }
#pragma unroll
    for (int e4 = 0; e4 < 2; ++e4) { const f32x4 a = *(const f32x4*)(cb + ch + 4 * e4), b = *(const f32x4*)(cb + DFF + ch + 4 * e4);
      bg[4 * e4] = a.x; bg[4 * e4 + 1] = a.y; bg[4 * e4 + 2] = a.z; bg[4 * e4 + 3] = a.w; bu[4 * e4] = b.x; bu[4 * e4 + 1] = b.y; bu[4 * e4 + 2] = b.z; bu[4 * e4 + 3] = b.w; }
    float g2[8], g1[8], u2[8], u1[8];
#pragma unroll
    for (int e = 0; e < 8; ++e) { g2[e] = 0.f; g1[e] = 0.f; u2[e] = 0.f; u1[e] = 0.f; }
    if (r0 >= 2) { unpack8(*(const u32x4*)(u + (size_t)(r0 - 2) * DFF2 + ch), g2); unpack8(*(const u32x4*)(u + (size_t)(r0 - 2) * DFF2 + DFF + ch), u2);
      unpack8(*(const u32x4*)(u + (size_t)(r0 - 1) * DFF2 + ch), g1); unpack8(*(const u32x4*)(u + (size_t)(r0 - 1) * DFF2 + DFF + ch), u1); }
#pragma unroll 1
    for (int rb = 0; rb < 4; ++rb) {
      u32x4 G[8], U[8];
#pragma unroll
      for (int i = 0; i < 8; ++i) { const size_t ro = (size_t)(r0 + rb * 8 + i) * DFF2 + ch; G[i] = *(const u32x4*)(u + ro); U[i] = *(const u32x4*)(u + ro + DFF); }
#pragma unroll
      for (int i = 0; i < 8; ++i) {
        float g0[8], u0[8]; unpack8(G[i], g0); unpack8(U[i], u0);
        float o[8];
#pragma unroll
        for (int e = 0; e < 8; ++e) { const float yg = wg[0][e] * g2[e] + wg[1][e] * g1[e] + wg[2][e] * g0[e] + bg[e]; const float yu = wu[0][e] * u2[e] + wu[1][e] * u1[e] + wu[2][e] * u0[e] + bu[e];
          o[e] = gelu_tanh(yg) * yu; g2[e] = g1[e]; g1[e] = g0[e]; u2[e] = u1[e]; u1[e] = u0[e]; }
        u32x4 pk = {pack2(o[0], o[1]), pack2(o[2], o[3]), pack2(o[4], o[5]), pack2(o[6], o[7])};
        *(u32x4*)(act + (size_t)(r0 + rb * 8 + i) * DFF + ch) = pk;
      }
    }
  }
}

#define XB_TMO      128
#define XB_XCNT(j)  (256  + 64 * (j))
#define XB_XSUB(j)  (1280 + 64 * (j))
#define XB_XGEN(j)  (2304 + 64 * (j))
#define XB_TOP      3328
#define XB_TOPGEN   3392
#define XCD_BAR_WORDS 3456
#define XB_SPIN_CAP (1u << 18)
#define LAS __attribute__((address_space(3)))
DI unsigned xb_ld(unsigned* p)              { return __hip_atomic_load(p, __ATOMIC_RELAXED, __HIP_MEMORY_SCOPE_AGENT); }
DI unsigned xb_add(unsigned* p, unsigned v) { return __hip_atomic_fetch_add(p, v, __ATOMIC_RELAXED, __HIP_MEMORY_SCOPE_AGENT); }
DI unsigned xb_xcc_id() { return (unsigned)__builtin_amdgcn_s_getreg((3 << 11) | 20) & 0xFu; }
#define XB_SPIN(cond, bar) do { unsigned _sp = 0; while (cond) { __builtin_amdgcn_s_sleep(1); \
    if ((++_sp & 255u) == 0u) { if (xb_ld(&(bar)[XB_TMO])) break; if (_sp > XB_SPIN_CAP) { atomicAdd(&(bar)[XB_TMO], 1u); break; } } } } while (0)
struct XcdBarrier { unsigned* bar; unsigned x; volatile LAS unsigned* st; };
DI XcdBarrier xcd_barrier_post(unsigned* bar, volatile LAS unsigned* st) {
  XcdBarrier b; b.bar = bar; b.x = xb_xcc_id(); b.st = st;
  if (threadIdx.x == 0) (void)xb_add(&bar[XB_XCNT(b.x)], 1u);
  return b;
}
DI void xcd_barrier_complete(unsigned* bar, unsigned x, unsigned& nloc, unsigned& nx) {
  const unsigned G = gridDim.x * gridDim.y * gridDim.z;
  unsigned sum, cnt, mine, sp = 0u;
  for (;;) {
    sum = 0u; cnt = 0u; mine = 0u;
#pragma unroll
    for (unsigned j = 0; j < 16; ++j) { const unsigned c = xb_ld(&bar[XB_XCNT(j)]); sum += c; cnt += (c > 0u) ? 1u : 0u; mine = (j == x) ? c : mine; }
    if (sum == G) break;
    __builtin_amdgcn_s_sleep(1);
    if ((++sp & 255u) == 0u) { if (xb_ld(&bar[XB_TMO])) break; if (sp > XB_SPIN_CAP) { atomicAdd(&bar[XB_TMO], 1u); break; } }
  }
  nloc = mine > 0u ? mine : 1u; nx = cnt > 0u ? cnt : 1u;
}
DI void xcd_barrier(char* ws_, char* smem_) {
  XcdBarrier b; b.bar = (unsigned*)(ws_ + OFF_XBAR); b.x = xb_xcc_id(); b.st = (volatile LAS unsigned*)(smem_ + 157712);
  asm volatile("s_waitcnt vmcnt(0)" ::: "memory");
  __syncthreads();
  if (threadIdx.x == 0) {
    unsigned* bar = b.bar;
    __builtin_amdgcn_s_waitcnt(0);
    unsigned nloc = b.st[0], nx = b.st[1];
    if (nloc == 0u) { xcd_barrier_complete(bar, b.x, nloc, nx); b.st[0] = nloc; b.st[1] = nx; }
    const unsigned old = xb_add(&bar[XB_XSUB(b.x)], 1u);
    const unsigned gen = old / nloc;
    if (old + 1u == (gen + 1u) * nloc) {
      __builtin_amdgcn_fence(__ATOMIC_RELEASE, "agent");
      asm volatile("s_waitcnt vmcnt(0)" ::: "memory");
      const unsigned og = xb_add(&bar[XB_TOP], 1u);
      const unsigned tg = og / nx;
      if (og + 1u == (tg + 1u) * nx) xb_add(&bar[XB_TOPGEN], 1u);
      else XB_SPIN(xb_ld(&bar[XB_TOPGEN]) == tg, bar);
      __builtin_amdgcn_fence(__ATOMIC_ACQUIRE, "agent");
      xb_add(&bar[XB_XGEN(b.x)], 1u);
      asm volatile("s_waitcnt vmcnt(0)" ::: "memory");
    } else {
      XB_SPIN(xb_ld(&bar[XB_XGEN(b.x)]) == gen, bar);
      __builtin_amdgcn_fence(__ATOMIC_ACQUIRE, "agent");
      asm volatile("s_waitcnt vmcnt(0)" ::: "memory");
    }
  }
  __syncthreads();
}

__global__ void __launch_bounds__(NT) fwd_megakernel(Params P0) {
  cg::grid_group grid = cg::this_grid();
  __shared__ __attribute__((aligned(16))) char smem[157952];
  const int tid = threadIdx.x;
  char* ws = P0.ws;
  int* ctrl = (int*)(ws + OFF_CTRL);
  if (blockIdx.x == 0 && tid < 64) ctrl[tid] = 0;
  if (blockIdx.x == 0) for (int i = tid; i < XCD_BAR_WORDS; i += NT) ((unsigned*)(ws + OFF_XBAR))[i] = 0u;
  if (tid < 4) ((unsigned*)(smem + 157712))[tid] = 0u;
  if (blockIdx.x == 0 && tid == 0) *(Params*)(ws + OFF_CTRL + 1024) = P0;
  bf16_t* Hb = (bf16_t*)(ws + OFF_H);
  for (int it = blockIdx.x; it < 192 + CV_T5; it += gridDim.x) { if (it < 192) mod_item(P0, it); else convert_item(P0, 0, it - 192, smem); }
  grid.sync();
  (void)xcd_barrier_post((unsigned*)(ws + OFF_XBAR), (volatile LAS unsigned*)(smem + 157712));
  const Params& P = *(const Params*)(ws + OFF_CTRL + 1024);
  rownorm_phase(P, P.x, nullptr, P.out, Hb, 0, 0, nullptr, 0, 1, 0, P.mix_pre, smem);
  xcd_barrier(ws, smem);
  for (int l = 0; l < 2; ++l) {
    { EpiProj epi{(bf16_t*)(ws + OFF_PROJ), (float*)(ws + OFF_AB)}; gemm_phase(Hb, 2048, (const bf16_t*)(ws + OFF_W + W_IN), 2048, 2048, 64, 22, smem, epi); }
    xcd_barrier(ws, smem);
    for (int it = blockIdx.x; it < 448; it += gridDim.x) {
      if (it < 192) mla_q_tile(P, it / 3, it % 3, smem);
      else mla_kv_tile(P, (it - 192) >> 2, (it - 192) & 3, smem);
    }
    for (int id = (blockIdx.x + 64) % gridDim.x; id < 2048; id += gridDim.x) gdn_prep_item(P, l, id >> 3, id & 7, smem);
    xcd_barrier(ws, smem);
    {
      int* sitem = (int*)(smem + 157696);
      for (;;) {
        if (tid == 0) *sitem = atomicAdd(ctrl + 16 * l, 1);
        __syncthreads(); const int item = *sitem; __syncthreads();
        if (item >= 16 + 512 + 256) break;
        if (item < 16) gdn_scan_item(P, l, item >> 1, item & 1, smem);
        else if (item < 528) { const int idx = item - 16; mla_attn_item(P, idx & 3, 127 - (idx >> 2), smem); }
        else { const int idx = item - 528; swa_item(P, l, idx >> 1, idx & 1, smem); }
      }
    }
    xcd_barrier(ws, smem);
    gdn_fix_phase(P);
    xcd_barrier(ws, smem);
    { EpiBf epi{(bf16_t*)(ws + OFF_MIXF), 2048}; gemm_phase(Hb, 2048, (const bf16_t*)(ws + OFF_W + W_OUT), 2048, 2048, 64, 8, smem, epi); }
    xcd_barrier(ws, smem);
    rownorm_phase(P, P.out, (const bf16_t*)(ws + OFF_MIXF), P.out, Hb, l, 2, P.mix_post + l * 2048, l, 4, 3, P.ffn_pre + l * 2048, smem);
    xcd_barrier(ws, smem);
    { EpiBf epi{(bf16_t*)(ws + OFF_BIG), DFF2}; gemm_phase(Hb, 2048, (const bf16_t*)(ws + OFF_W + W_UP), 2048, 2048, 64, 44, smem, epi); }
    xcd_barrier(ws, smem);
    ffn_act_phase(P, l);
    xcd_barrier(ws, smem);
    { EpiBf epi{(bf16_t*)(ws + OFF_Y), 2048}; gemm_phase((const bf16_t*)(ws + OFF_ACT), DFF, (const bf16_t*)(ws + OFF_W + W_DOWN), DFF, DFF, 64, 8, smem, epi); }
    xcd_barrier(ws, smem);
    if (l == 0) {
      for (int it = blockIdx.x; it < CV_T5; it += gridDim.x) convert_item(P, 1, it, smem);
      rownorm_phase(P, P.out, (const bf16_t*)(ws + OFF_Y), P.out, Hb, 0, 5, P.ffn_post, 1, 1, 0, P.mix_pre + 2048, smem);
      xcd_barrier(ws, smem);
    } else {
      rownorm_phase(P, P.out, (const bf16_t*)(ws + OFF_Y), P.out, nullptr, 1, 5, P.ffn_post + 2048, 1, 1, 0, nullptr, smem);
    }
  }
}

extern "C" void kernel_launch(void* const* d_in, const int* in_sizes, int n_in, void* d_out, int out_size, void* d_ws, size_t ws_size, hipStream_t stream) {
  static int grid_blocks = 0;
  if (!grid_blocks) {
    int dev = 0, cus = 0, per = 0;
    (void)hipGetDevice(&dev); (void)hipDeviceGetAttribute(&cus, hipDeviceAttributeMultiprocessorCount, dev);
    (void)hipOccupancyMaxActiveBlocksPerMultiprocessor(&per, fwd_megakernel, NT, 0);
    if (per > 1) per = 1;
    grid_blocks = cus * per; if (grid_blocks <= 0) grid_blocks = 256;
  }
  if (ws_size < OFF_END) { fprintf(stderr, "workspace too small: %zu < %zu\n", ws_size, (size_t)OFF_END); return; }
  Params p{};
  p.x = (const float*)d_in[0]; p.c = (const float*)d_in[1]; p.pos = (const int*)d_in[2];
  p.ada_w = (const float*)d_in[3]; p.ada_b = (const float*)d_in[4]; p.mix_pre = (const float*)d_in[5]; p.mix_post = (const float*)d_in[6];
  p.w_in = (const float*)d_in[7]; p.w_out = (const float*)d_in[8]; p.gdn_conv = (const float*)d_in[9]; p.gdn_a_log = (const float*)d_in[10];
  p.gdn_dt_bias = (const float*)d_in[11]; p.gdn_norm = (const float*)d_in[12]; p.mla_q_norm = (const float*)d_in[13]; p.mla_w_uq = (const float*)d_in[14];
  p.mla_kv_norm = (const float*)d_in[15]; p.mla_w_ukv = (const float*)d_in[16]; p.swa_sinks = (const float*)d_in[17]; p.ffn_pre = (const float*)d_in[18];
  p.ffn_post = (const float*)d_in[19]; p.ffn_w_up = (const float*)d_in[20]; p.ffn_conv = (const float*)d_in[21]; p.ffn_conv_b = (const float*)d_in[22];
  p.ffn_w_down = (const float*)d_in[23];
  p.out = (float*)d_out; p.ws = (char*)d_ws;
  void* args[] = {&p};
  hipError_t e = hipLaunchCooperativeKernel((void*)fwd_megakernel, dim3(grid_blocks), dim3(NT), args, 0, stream);
  if (e != hipSuccess) fprintf(stderr, "cooperative launch failed: %s (grid %d)\n", hipGetErrorString(e), grid_blocks);
}
```

```cpp
#include <hip/hip_runtime.h>
#include <hip/hip_cooperative_groups.h>
#include <cstdio>
#include <cstdint>
namespace cg = cooperative_groups;

#define DI __device__ __forceinline__
typedef unsigned short bf16_t;
typedef short bf16x8 __attribute__((ext_vector_type(8)));
typedef float f32x2 __attribute__((ext_vector_type(2)));
typedef float f32x4 __attribute__((ext_vector_type(4)));
typedef float f32x16 __attribute__((ext_vector_type(16)));
typedef unsigned u32x2 __attribute__((ext_vector_type(2)));
typedef unsigned u32x4 __attribute__((ext_vector_type(4)));
typedef __bf16 bf2_t __attribute__((ext_vector_type(2)));

constexpr int S_ = 16384, D_ = 2048, DINP = 5632, DFF = 5632, DFF2 = 11264;
constexpr int NT = 512;
constexpr float EPS = 1e-6f;
constexpr float LOG2E = 1.4426950408889634f;

constexpr size_t OFF_CTRL = 0;
constexpr size_t OFF_MODP = 4096;
constexpr size_t OFF_XBAR = OFF_MODP + (size_t)2 * 16 * 12288 * 4;
constexpr size_t OFF_W = 2097152;
static_assert(OFF_XBAR + 3456 * 4 <= OFF_W, "xbar");
constexpr size_t W_IN = 0, W_OUT = W_IN + (size_t)5632 * 2048 * 2, W_UP = W_OUT + (size_t)2048 * 2048 * 2,
                 W_DOWN = W_UP + (size_t)11264 * 2048 * 2, W_UQ = W_DOWN + (size_t)2048 * 5632 * 2,
                 W_UKV = W_UQ + (size_t)768 * 448 * 2, W_END = W_UKV + (size_t)1024 * 128 * 2;
constexpr size_t OFF_H = OFF_W + W_END;
constexpr size_t OFF_MIXF = OFF_H + (size_t)S_ * 2048 * 2;
constexpr size_t OFF_QRAW = OFF_MIXF;
constexpr size_t OFF_KMLA = OFF_QRAW + (size_t)S_ * 768 * 4;
constexpr size_t OFF_VT = OFF_KMLA + (size_t)4 * S_ * 192 * 2;
constexpr size_t OFF_BIG = OFF_MIXF + (size_t)S_ * 2048 * 4;
constexpr size_t OFF_PROJ = OFF_BIG;
constexpr size_t OFF_WP = OFF_PROJ + (size_t)S_ * DINP * 2;
constexpr size_t OFF_QD = OFF_WP + (size_t)S_ * 1024 * 2;
constexpr size_t OFF_KT = OFF_QD + (size_t)S_ * 1024 * 2;
constexpr size_t OFF_ZT = OFF_KT + (size_t)S_ * 1024 * 2;
constexpr size_t OFF_QK = OFF_ZT + (size_t)S_ * 1024 * 2;
constexpr size_t OFF_AB = OFF_QK + (size_t)S_ * 512 * 2;
constexpr size_t OFF_GTOT = OFF_AB + (size_t)S_ * 16 * 4;
constexpr size_t OFF_Y = OFF_BIG;
constexpr size_t OFF_ACT = OFF_H;
constexpr size_t OFF_UT = OFF_BIG + (size_t)S_ * DFF2 * 2;
constexpr size_t OFF_END = OFF_UT + (size_t)S_ * 1024 * 4;
static_assert(OFF_GTOT + 8192 <= OFF_UT, "overlay");
static_assert(OFF_VT + (size_t)4 * 128 * S_ * 2 <= OFF_BIG, "overlay2");

constexpr int C_AQ = 0, C_AK = 1024, C_AV = 2048, C_AZ = 3072, C_AA = 4096, C_BCQ = 4112, C_BCKV = 4560,
              C_BKR = 4688, C_CQ = 4752, C_CK = 5264, C_CV = 5392;

__constant__ double kInvFreq2Pi[32] = {
    0.15915494309189535, 0.11934937021124886, 0.08949940160889101, 0.06711508300522726, 0.050329212104487035, 0.03774158471741977,
    0.0283021958306234, 0.02122365276477766, 0.015915494309189534, 0.011934937021124886, 0.008949940160889102, 0.006711508300522725,
    0.005032921210448704, 0.003774158471741977, 0.00283021958306234, 0.0021223652764777662, 0.0015915494309189536, 0.0011934937021124885,
    0.0008949940160889102, 0.0006711508300522726, 0.0005032921210448703, 0.00037741584717419774, 0.00028302195830623395, 0.0002122365276477766,
    0.00015915494309189535, 0.00011934937021124886, 8.949940160889102e-05, 6.711508300522725e-05, 5.0329212104487035e-05, 3.774158471741978e-05,
    2.8302195830623396e-05, 2.122365276477766e-05};

struct Params {
  const float* x; const float* c; const int* pos;
  const float *ada_w, *ada_b, *mix_pre, *mix_post, *w_in, *w_out, *gdn_conv, *gdn_a_log, *gdn_dt_bias, *gdn_norm, *mla_q_norm, *mla_w_uq,
      *mla_kv_norm, *mla_w_ukv, *swa_sinks, *ffn_pre, *ffn_post, *ffn_w_up, *ffn_conv, *ffn_conv_b, *ffn_w_down;
  float* out; char* ws;
};

DI unsigned pack2(float lo, float hi) { f32x2 v = {lo, hi}; bf2_t b = __builtin_convertvector(v, bf2_t); return __builtin_bit_cast(unsigned, b); }
DI bf16_t f2bf(float x) { return (bf16_t)(pack2(x, 0.f) & 0xffffu); }
DI float bflo(unsigned u) { return __uint_as_float(u << 16); }
DI float bfhi(unsigned u) { return __uint_as_float(u & 0xffff0000u); }
DI void unpack8(const u32x4& v, float* f) { f[0] = bflo(v.x); f[1] = bfhi(v.x); f[2] = bflo(v.y); f[3] = bfhi(v.y); f[4] = bflo(v.z); f[5] = bfhi(v.z); f[6] = bflo(v.w); f[7] = bfhi(v.w); }
DI bf16x8 pack8(float a0, float a1, float a2, float a3, float a4, float a5, float a6, float a7) {
  u32x4 p = {pack2(a0, a1), pack2(a2, a3), pack2(a4, a5), pack2(a6, a7)}; return __builtin_bit_cast(bf16x8, p); }
DI float silu_f(float x) { return x * __builtin_amdgcn_rcpf(1.f + __expf(-x)); }
DI float wave_sum(float v) { v += __shfl_xor(v, 32); v += __shfl_xor(v, 16); v += __shfl_xor(v, 8); v += __shfl_xor(v, 4); v += __shfl_xor(v, 2); v += __shfl_xor(v, 1); return v; }
DI int opaque_tid() { int t = threadIdx.x; asm volatile("" : "+v"(t)); return t; }
DI int crow(int r, int h) { return (r & 3) + 8 * (r >> 2) + 4 * h; }
DI int perm32(int k) { return 8 * ((k >> 2) & 3) + 4 * (k >> 4) + (k & 3); }
#define MFMA32(a, b, c) __builtin_amdgcn_mfma_f32_32x32x16_bf16((a), (b), (c), 0, 0, 0)
#define MFMA16(a, b, c) __builtin_amdgcn_mfma_f32_16x16x32_bf16((a), (b), (c), 0, 0, 0)

template <class Epi>
DI void gemm_tile(const bf16_t* __restrict__ A, int lda, const bf16_t* __restrict__ Bt, int ldb, int K, int m0, int n0, char* smem, const Epi& epi) {
  const int tid = opaque_tid(), lane = tid & 63, w = tid >> 6, wm = w >> 2, wn = w & 3, lq = lane & 31, h = lane >> 5;
  f32x16 acc[2][4];
#pragma unroll
  for (int i = 0; i < 2; ++i)
#pragma unroll
    for (int j = 0; j < 4; ++j)
#pragma unroll
      for (int r = 0; r < 16; ++r) acc[i][j][r] = 0.f;
  const int r0 = tid >> 3, c0 = tid & 7;
  const bf16_t* ag = A + (size_t)(m0 + r0) * lda + c0 * 8;
  const bf16_t* bg = Bt + (size_t)(n0 + r0) * ldb + c0 * 8;
  const int wofs = r0 * 128 + ((c0 ^ ((r0 >> 1) & 7)) << 4);
  char* sA = smem; char* sB = smem + 65536;
  u32x4 ra0[4], rb0[4], ra1[4], rb1[4];
  const int nk = K >> 6, swz = (lane >> 1) & 7;
  const int aoff = (64 * wn + lq) * 128, boff = (128 * wm + lq) * 128;
#define GLOAD(RA, RB, KT) { _Pragma("unroll") for (int i = 0; i < 4; ++i) { RA[i] = *(const u32x4*)(ag + (size_t)(KT) * 64 + (size_t)i * 64 * lda); RB[i] = *(const u32x4*)(bg + (size_t)(KT) * 64 + (size_t)i * 64 * ldb); } }
#define LWRITE(RA, RB, ST) { _Pragma("unroll") for (int i = 0; i < 4; ++i) { *(u32x4*)(sA + (ST) * 32768 + wofs + i * 8192) = RA[i]; *(u32x4*)(sB + (ST) * 32768 + wofs + i * 8192) = RB[i]; } }
#define KSTEP(ST, RA, RB, KN) { const char* cA = sA + (ST) * 32768; const char* cB = sB + (ST) * 32768; char* dA = sA + (1 - (ST)) * 32768; char* dB = sB + (1 - (ST)) * 32768; \
    const bf16_t* agn = ag + (size_t)(KN) * 64; const bf16_t* bgn = bg + (size_t)(KN) * 64; \
    _Pragma("unroll") for (int s = 0; s < 4; ++s) { const int co = (((2 * s + h) ^ swz) << 4); bf16x8 fa[2], fb[4]; \
      _Pragma("unroll") for (int ni = 0; ni < 2; ++ni) fa[ni] = *(const bf16x8*)(cB + aoff + ni * 4096 + co); \
      _Pragma("unroll") for (int mi = 0; mi < 4; ++mi) fb[mi] = *(const bf16x8*)(cA + boff + mi * 4096 + co); \
      *(u32x4*)(dA + wofs + s * 8192) = RA[s]; *(u32x4*)(dB + wofs + s * 8192) = RB[s]; \
      RA[s] = *(const u32x4*)(agn + (size_t)s * 64 * lda); RB[s] = *(const u32x4*)(bgn + (size_t)s * 64 * ldb); \
      _Pragma("unroll") for (int ni = 0; ni < 2; ++ni) _Pragma("unroll") for (int mi = 0; mi < 4; ++mi) acc[ni][mi] = MFMA32(fa[ni], fb[mi], acc[ni][mi]); \
      __builtin_amdgcn_sched_barrier(0); } }
  const int kl = nk - 1;
  GLOAD(ra0, rb0, 0);
  GLOAD(ra1, rb1, (1 < kl ? 1 : kl));
  LWRITE(ra0, rb0, 0);
  GLOAD(ra0, rb0, (2 < kl ? 2 : kl));
  __syncthreads();
  for (int kt = 0; kt < nk; kt += 2) {
    KSTEP(0, ra1, rb1, (kt + 3 < kl ? kt + 3 : kl));
    __syncthreads();
    if (kt + 1 < nk) {
      KSTEP(1, ra0, rb0, (kt + 4 < kl ? kt + 4 : kl));
      __syncthreads();
    }
  }
#undef GLOAD
#undef LWRITE
#undef KSTEP
#pragma unroll
  for (int ni = 0; ni < 2; ++ni)
#pragma unroll
    for (int mi = 0; mi < 4; ++mi)
#pragma unroll
      for (int rg = 0; rg < 4; ++rg) {
        const int m = m0 + 128 * wm + 32 * mi + lq, n = n0 + 64 * wn + 32 * ni + 8 * rg + 4 * h;
        epi(m, n, acc[ni][mi][4 * rg], acc[ni][mi][4 * rg + 1], acc[ni][mi][4 * rg + 2], acc[ni][mi][4 * rg + 3]);
      }
}

template <class Epi>
DI void gemm_tile_s(const bf16_t* __restrict__ A, int lda, const bf16_t* __restrict__ Bt, int ldb, int K, int m0, int n0, char* smem, const Epi& epi) {
  const int tid = opaque_tid(), lane = tid & 63, w = tid >> 6, wm = w >> 2, wn = w & 3, lq = lane & 31, h = lane >> 5;
  f32x16 acc[2][4];
#pragma unroll
  for (int i = 0; i < 2; ++i)
#pragma unroll
    for (int j = 0; j < 4; ++j)
#pragma unroll
      for (int r = 0; r < 16; ++r) acc[i][j][r] = 0.f;
  const int r0 = tid >> 3, c0 = tid & 7;
  const bf16_t* ag = A + (size_t)(m0 + r0) * lda + c0 * 8;
  const bf16_t* bg = Bt + (size_t)(n0 + r0) * ldb + c0 * 8;
  const int wofs = r0 * 128 + ((c0 ^ ((r0 >> 1) & 7)) << 4);
  char* sA = smem; char* sB = smem + 32768;
  u32x4 ra[4], rb[4];
#pragma unroll
  for (int i = 0; i < 4; ++i) { ra[i] = *(const u32x4*)(ag + (size_t)i * 64 * lda); rb[i] = *(const u32x4*)(bg + (size_t)i * 64 * ldb); }
#pragma unroll
  for (int i = 0; i < 4; ++i) { *(u32x4*)(sA + wofs + i * 8192) = ra[i]; *(u32x4*)(sB + wofs + i * 8192) = rb[i]; }
  __syncthreads();
  const int nk = K >> 6, swz = (lane >> 1) & 7;
  const int aoff = (64 * wn + lq) * 128, boff = (128 * wm + lq) * 128;
  for (int kt = 0; kt < nk; ++kt) {
    const char* cA = sA + (kt & 1) * 65536; const char* cB = sB + (kt & 1) * 65536;
    const bool more = (kt + 1 < nk);
    if (more) { ag += 64; bg += 64;
#pragma unroll
      for (int i = 0; i < 4; ++i) { ra[i] = *(const u32x4*)(ag + (size_t)i * 64 * lda); rb[i] = *(const u32x4*)(bg + (size_t)i * 64 * ldb); } }
#pragma unroll
    for (int s = 0; s < 4; ++s) {
      const int co = (((2 * s + h) ^ swz) << 4);
      bf16x8 fa[2], fb[4];
#pragma unroll
      for (int ni = 0; ni < 2; ++ni) fa[ni] = *(const bf16x8*)(cB + aoff + ni * 4096 + co);
#pragma unroll
      for (int mi = 0; mi < 4; ++mi) fb[mi] = *(const bf16x8*)(cA + boff + mi * 4096 + co);
#pragma unroll
      for (int ni = 0; ni < 2; ++ni)
#pragma unroll
        for (int mi = 0; mi < 4; ++mi) acc[ni][mi] = MFMA32(fa[ni], fb[mi], acc[ni][mi]);
    }
    if (more) { char* dA = sA + ((kt + 1) & 1) * 65536; char* dB = sB + ((kt + 1) & 1) * 65536;
#pragma unroll
      for (int i = 0; i < 4; ++i) { *(u32x4*)(dA + wofs + i * 8192) = ra[i]; *(u32x4*)(dB + wofs + i * 8192) = rb[i]; } }
    __syncthreads();
  }
#pragma unroll
  for (int ni = 0; ni < 2; ++ni)
#pragma unroll
    for (int mi = 0; mi < 4; ++mi)
#pragma unroll
      for (int rg = 0; rg < 4; ++rg) {
        const int m = m0 + 128 * wm + 32 * mi + lq, n = n0 + 64 * wn + 32 * ni + 8 * rg + 4 * h;
        epi(m, n, acc[ni][mi][4 * rg], acc[ni][mi][4 * rg + 1], acc[ni][mi][4 * rg + 2], acc[ni][mi][4 * rg + 3]);
      }
}

DI void tile_coord(int t, int npn, int& pm, int& pn) { const int g = t / (16 * npn), r = t % (16 * npn); pn = r >> 4; pm = g * 16 + (r & 15); }

struct EpiProj { bf16_t* proj; float* ab;
  DI void operator()(int m, int n, float v0, float v1, float v2, float v3) const {
    u32x2 pk = {pack2(v0, v1), pack2(v2, v3)}; *(u32x2*)(proj + (size_t)m * DINP + n) = pk;
    if (n >= C_AA && n < C_AA + 16) { f32x4 v = {v0, v1, v2, v3}; *(f32x4*)(ab + (size_t)m * 16 + (n - C_AA)) = v; } } };
struct EpiF32 { float* out; int ldc;
  DI void operator()(int m, int n, float v0, float v1, float v2, float v3) const { f32x4 v = {v0, v1, v2, v3}; *(f32x4*)(out + (size_t)m * ldc + n) = v; } };
struct EpiBf { bf16_t* out; int ldc;
  DI void operator()(int m, int n, float v0, float v1, float v2, float v3) const { u32x2 pk = {pack2(v0, v1), pack2(v2, v3)}; *(u32x2*)(out + (size_t)m * ldc + n) = pk; } };
struct EpiMlaQ { float* qraw; const float* rs; int m0;
  DI void operator()(int m, int n, float v0, float v1, float v2, float v3) const { const float r = rs[m - m0]; f32x4 v = {v0 * r, v1 * r, v2 * r, v3 * r}; *(f32x4*)(qraw + (size_t)m * 768 + n) = v; } };
struct EpiMlaKV { bf16_t* kmla; bf16_t* vt; const float* rs; int m0;
  DI void operator()(int m, int n, float v0, float v1, float v2, float v3) const {
    const float r = rs[m - m0]; const int hd = n >> 8, wi = n & 255;
    if (wi < 128) { u32x2 pk = {pack2(v0 * r, v1 * r), pack2(v2 * r, v3 * r)}; *(u32x2*)(kmla + ((size_t)hd * S_ + m) * 192 + wi) = pk; }
    else { bf16_t* p = vt + ((size_t)hd * 128 + (wi - 128)) * S_ + m; p[0] = f2bf(v0 * r); p[S_] = f2bf(v1 * r); p[2 * (size_t)S_] = f2bf(v2 * r); p[3 * (size_t)S_] = f2bf(v3 * r); } } };

template <class Epi>
DI void gemm_phase(const bf16_t* A, int lda, const bf16_t* Bt, int ldb, int K, int npm, int npn, char* smem, const Epi& epi) {
  if (gridDim.x == 256 && npm == 64) {
    const int b = blockIdx.x, pm = 8 * (b & 7) + ((b >> 3) & 7), pj = b >> 6;
    for (int pn = pj; pn < npn; pn += 4) gemm_tile(A, lda, Bt, ldb, K, pm * 256, pn * 256, smem, epi);
  } else {
    for (int t = blockIdx.x; t < npm * npn; t += gridDim.x) { int pm, pn; tile_coord(t, npn, pm, pn); gemm_tile(A, lda, Bt, ldb, K, pm * 256, pn * 256, smem, epi); }
  }
}

DI void mod_item(const Params& P, int item) {
  const int tid = opaque_tid(); const int l = item / 96, r = item % 96, ks = r / 6, nc = r % 6;
  const int n = nc * 2048 + tid * 4;
  const float* wp = P.ada_w + ((size_t)l * 2048 + ks * 128) * 12288 + n;
  f32x4 acc = {0.f, 0.f, 0.f, 0.f};
#pragma unroll 8
  for (int k = 0; k < 128; ++k) { const float cv = P.c[ks * 128 + k]; const float ca = silu_f(cv); const f32x4 wv = *(const f32x4*)(wp + (size_t)k * 12288); acc += wv * ca; }
  float* modp = (float*)(P.ws + OFF_MODP);
  *(f32x4*)(modp + ((size_t)l * 16 + ks) * 12288 + n) = acc;
}
DI void convert_tile(const float* __restrict__ src, int K, int N, bf16_t* __restrict__ dst, int tk, int tn, const float* rowscale, char* smem) {
  float* sm = (float*)smem; const int tid = opaque_tid(); const int k0 = tk * 64, n0 = tn * 256;
  { const int r = tid >> 6, c4 = tid & 63; const int n = n0 + 4 * c4;
    f32x4 v[8];
#pragma unroll
    for (int i = 0; i < 8; ++i) { v[i] = (f32x4){0.f, 0.f, 0.f, 0.f}; if (n < N) v[i] = *(const f32x4*)(src + (size_t)(k0 + r + 8 * i) * N + n); }
#pragma unroll
    for (int i = 0; i < 8; ++i) { const int kk = r + 8 * i; if (rowscale) v[i] *= rowscale[k0 + kk];
      sm[kk * 257 + 4 * c4 + 0] = v[i].x; sm[kk * 257 + 4 * c4 + 1] = v[i].y; sm[kk * 257 + 4 * c4 + 2] = v[i].z; sm[kk * 257 + 4 * c4 + 3] = v[i].w; } }
  __syncthreads();
  { const int n = tid >> 1, kh = tid & 1;
#pragma unroll
    for (int j = 0; j < 4; ++j) { float f[8];
#pragma unroll
      for (int i = 0; i < 8; ++i) f[i] = sm[(32 * kh + 8 * j + i) * 257 + n];
      u32x4 pk = {pack2(f[0], f[1]), pack2(f[2], f[3]), pack2(f[4], f[5]), pack2(f[6], f[7])};
      *(u32x4*)(dst + (size_t)(n0 + n) * K + k0 + 32 * kh + 8 * j) = pk; } }
  __syncthreads();
}
constexpr int CV_T0 = 32 * 22, CV_T1 = CV_T0 + 32 * 8, CV_T2 = CV_T1 + 32 * 44, CV_T3 = CV_T2 + 88 * 8, CV_T4 = CV_T3 + 7 * 3, CV_T5 = CV_T4 + 2 * 4;
DI void convert_item(const Params& P, int l, int it, char* smem) {
  char* wb = P.ws + OFF_W;
  if (it < CV_T0) convert_tile(P.w_in + (size_t)l * 2048 * 5520, 2048, 5520, (bf16_t*)(wb + W_IN), it / 22, it % 22, nullptr, smem);
  else if (it < CV_T1) { it -= CV_T0; convert_tile(P.w_out + (size_t)l * 2048 * 2048, 2048, 2048, (bf16_t*)(wb + W_OUT), it / 8, it % 8, nullptr, smem); }
  else if (it < CV_T2) { it -= CV_T1; convert_tile(P.ffn_w_up + (size_t)l * 2048 * 11264, 2048, 11264, (bf16_t*)(wb + W_UP), it / 44, it % 44, nullptr, smem); }
  else if (it < CV_T3) { it -= CV_T2; convert_tile(P.ffn_w_down + (size_t)l * 5632 * 2048, 5632, 2048, (bf16_t*)(wb + W_DOWN), it / 8, it % 8, nullptr, smem); }
  else if (it < CV_T4) { it -= CV_T3; convert_tile(P.mla_w_uq + (size_t)l * 448 * 768, 448, 768, (bf16_t*)(wb + W_UQ), it / 3, it % 3, P.mla_q_norm + l * 448, smem); }
  else { it -= CV_T4; convert_tile(P.mla_w_ukv + (size_t)l * 128 * 1024, 128, 1024, (bf16_t*)(wb + W_UKV), it / 4, it % 4, P.mla_kv_norm + l * 128, smem); }
}

DI float mod_val(const float* modp_l, const float* ada_b_l, int idx) { float s = ada_b_l[idx];
#pragma unroll
  for (int k = 0; k < 16; ++k) s += modp_l[(size_t)k * 12288 + idx]; return s; }
DI void rownorm_phase(const Params& P, const float* xin, const bf16_t* yin, float* xout, bf16_t* hout, int lg, int gate_idx, const float* w_post,
                      int lh, int scale_idx, int shift_idx, const float* w_pre, char* smem) {
  float* A1 = (float*)smem; float* A2 = A1 + 2048; float* B2 = A2 + 2048;
  const int tid = opaque_tid(), lane = tid & 63, w = tid >> 6;
  const float* modp = (const float*)(P.ws + OFF_MODP);
  for (int cidx = tid; cidx < 2048; cidx += NT) {
    if (yin) A1[cidx] = mod_val(modp + (size_t)lg * 16 * 12288, P.ada_b + (size_t)lg * 12288, gate_idx * 2048 + cidx) * w_post[cidx];
    if (hout) { A2[cidx] = w_pre[cidx] * (1.f + mod_val(modp + (size_t)lh * 16 * 12288, P.ada_b + (size_t)lh * 12288, scale_idx * 2048 + cidx));
      B2[cidx] = mod_val(modp + (size_t)lh * 16 * 12288, P.ada_b + (size_t)lh * 12288, shift_idx * 2048 + cidx); }
  }
  __syncthreads();
  for (int row = blockIdx.x * 8 + w; row < S_; row += gridDim.x * 8) {
    f32x4 xv[8];
#pragma unroll
    for (int j = 0; j < 8; ++j) xv[j] = *(const f32x4*)(xin + (size_t)row * 2048 + (j * 64 + lane) * 4);
    if (yin) {
      f32x4 yv[8]; float ss = 0.f;
#pragma unroll
      for (int j = 0; j < 8; ++j) { const u32x2 yb = *(const u32x2*)(yin + (size_t)row * 2048 + (j * 64 + lane) * 4); yv[j] = (f32x4){bflo(yb.x), bfhi(yb.x), bflo(yb.y), bfhi(yb.y)};
        ss += yv[j].x * yv[j].x + yv[j].y * yv[j].y + yv[j].z * yv[j].z + yv[j].w * yv[j].w; }
      ss = wave_sum(ss); const float r = rsqrtf(ss * (1.f / 2048.f) + EPS);
#pragma unroll
      for (int j = 0; j < 8; ++j) { const f32x4 a = *(const f32x4*)(A1 + (j * 64 + lane) * 4); xv[j] += a * (yv[j] * r); }
    }
    if (yin || xout != xin) {
#pragma unroll
      for (int j = 0; j < 8; ++j) *(f32x4*)(xout + (size_t)row * 2048 + (j * 64 + lane) * 4) = xv[j];
    }
    if (hout) {
      float ss = 0.f;
#pragma unroll
      for (int j = 0; j < 8; ++j) ss += xv[j].x * xv[j].x + xv[j].y * xv[j].y + xv[j].z * xv[j].z + xv[j].w * xv[j].w;
      ss = wave_sum(ss); const float r = rsqrtf(ss * (1.f / 2048.f) + EPS);
#pragma unroll
      for (int j = 0; j < 8; ++j) { const f32x4 a = *(const f32x4*)(A2 + (j * 64 + lane) * 4), b = *(const f32x4*)(B2 + (j * 64 + lane) * 4);
        const f32x4 hv = xv[j] * r * a + b; u32x2 pk = {pack2(hv.x, hv.y), pack2(hv.z, hv.w)};
        *(u32x2*)(hout + (size_t)row * 2048 + (j * 64 + lane) * 4) = pk; }
    }
  }
  __syncthreads();
}

DI void mla_q_tile(const Params& P, int pm, int pn, char* smem) {
  const bf16_t* proj = (const bf16_t*)(P.ws + OFF_PROJ); const int tid = opaque_tid(), m0 = pm * 256; float* rs = (float*)(smem + 131072);
  { const int row = tid >> 1, half = tid & 1; const bf16_t* p = proj + (size_t)(m0 + row) * DINP + C_BCQ + half * 224; float ss = 0.f;
    for (int i = 0; i < 28; ++i) { const u32x4 v = *(const u32x4*)(p + i * 8); float f[8]; unpack8(v, f);
#pragma unroll
      for (int e = 0; e < 8; ++e) ss += f[e] * f[e]; }
    ss += __shfl_xor(ss, 1); if (half == 0) rs[row] = rsqrtf(ss * (1.f / 448.f) + EPS); }
  EpiMlaQ epi{(float*)(P.ws + OFF_QRAW), rs, m0};
  gemm_tile_s(proj + C_BCQ, DINP, (const bf16_t*)(P.ws + OFF_W + W_UQ), 448, 448, m0, pn * 256, smem, epi);
  __syncthreads();
}
DI void mla_kv_tile(const Params& P, int pm, int pn, char* smem) {
  const bf16_t* proj = (const bf16_t*)(P.ws + OFF_PROJ); const int tid = opaque_tid(), m0 = pm * 256; float* rs = (float*)(smem + 131072);
  { const int row = tid >> 1, half = tid & 1; const bf16_t* p = proj + (size_t)(m0 + row) * DINP + C_BCKV + half * 64; float ss = 0.f;
#pragma unroll
    for (int i = 0; i < 8; ++i) { const u32x4 v = *(const u32x4*)(p + i * 8); float f[8]; unpack8(v, f);
#pragma unroll
      for (int e = 0; e < 8; ++e) ss += f[e] * f[e]; }
    ss += __shfl_xor(ss, 1); if (half == 0) rs[row] = rsqrtf(ss * (1.f / 128.f) + EPS); }
  bf16_t* kmla = (bf16_t*)(P.ws + OFF_KMLA);
  EpiMlaKV epi{kmla, (bf16_t*)(P.ws + OFF_VT), rs, m0};
  gemm_tile_s(proj + C_BCKV, DINP, (const bf16_t*)(P.ws + OFF_W + W_UKV), 128, 128, m0, pn * 256, smem, epi);
  if (pn == 0) {
    for (int i = 0; i < 16; ++i) { const int idx = tid + NT * i, row = idx >> 5, pi = idx & 31, m = m0 + row;
      const float x1 = bflo((unsigned)proj[(size_t)m * DINP + C_BKR + pi]), x2 = bflo((unsigned)proj[(size_t)m * DINP + C_BKR + 32 + pi]);
      double fr = (double)P.pos[m] * kInvFreq2Pi[pi]; fr -= floor(fr); const float ff = (float)fr;
      const float sn = __builtin_amdgcn_sinf(ff), cs = __builtin_amdgcn_cosf(ff);
      const bf16_t o1 = f2bf(x1 * cs - x2 * sn), o2 = f2bf(x2 * cs + x1 * sn);
#pragma unroll
      for (int hd = 0; hd < 4; ++hd) { bf16_t* kp = kmla + ((size_t)hd * S_ + m) * 192 + 128; kp[pi] = o1; kp[32 + pi] = o2; } }
  }
  __syncthreads();
}

DI void gdn_prep_item(const Params& P, int l, int n, int hh, char* smem) {
  const int tid = opaque_tid(), lane = tid & 63, w = tid >> 6, lq = lane & 31, h = lane >> 5;
  const bf16_t* proj = (const bf16_t*)(P.ws + OFF_PROJ); const float* ab = (const float*)(P.ws + OFF_AB);
  char* kb16 = smem; char* qb16 = smem + 17408;
  float* kf = (float*)(smem + 34816); float* vf = kf + 8192; float* Lm = vf + 8192; float* gcs = Lm + 4096;
  const size_t tile = (size_t)hh * 256 + n; const int t0 = n * 64;
  bf16_t* Wp = (bf16_t*)(P.ws + OFF_WP) + tile * 8192; bf16_t* Qd = (bf16_t*)(P.ws + OFF_QD) + tile * 8192;
  bf16_t* Kt = (bf16_t*)(P.ws + OFF_KT) + tile * 8192; bf16_t* Zt = (bf16_t*)(P.ws + OFF_ZT) + tile * 8192;
  bf16_t* QK = (bf16_t*)(P.ws + OFF_QK) + tile * 4096; bf16_t* Ut = (bf16_t*)(P.ws + OFF_UT) + tile * 8192;
  if (w == 0) {
    const int t = lane; const float a_raw = ab[(size_t)(t0 + t) * 16 + hh], b_raw = ab[(size_t)(t0 + t) * 16 + 8 + hh];
    const float Aa = __expf(P.gdn_a_log[l * 8 + hh]); const float xb = a_raw + P.gdn_dt_bias[l * 8 + hh];
    const float ex = __expf(fminf(xb, 20.f));
    const float sp = xb > 20.f ? xb : (ex < 0.01f ? ex * (1.f - ex * (0.5f - ex * (1.f / 3.f))) : __logf(1.f + ex));
    float g = -Aa * sp;
#pragma unroll
    for (int d = 1; d < 64; d <<= 1) { const float v = __shfl_up(g, d); if (lane >= d) g += v; }
    const float bt = __builtin_amdgcn_rcpf(1.f + __expf(-b_raw)), eg = __expf(g); gcs[t] = g; gcs[64 + t] = bt; gcs[128 + t] = eg; gcs[192 + t] = bt * eg;
    if (t == 63) ((float*)(P.ws + OFF_GTOT))[tile] = eg;
  }
  __syncthreads();
  {
    const int t = tid >> 3, part = tid & 7, tabs = t0 + t;
    const float gct = gcs[t], egct = gcs[128 + t], ktl = __expf(gcs[63] - gct);
    const int pjt = 32 * (t >> 5) + perm32(t & 31);
#pragma unroll
    for (int X = 0; X < 3; ++X) {
      const int cb = X * 1024 + hh * 128 + part * 16;
      float y[16];
#pragma unroll
      for (int e = 0; e < 16; ++e) y[e] = 0.f;
      u32x4 pv[4][2]; f32x4 wv[4][4];
#pragma unroll
      for (int j = 0; j < 4; ++j) { const int row = tabs - 3 + j, rr = row < 0 ? 0 : row;
        pv[j][0] = *(const u32x4*)(proj + (size_t)rr * DINP + cb); pv[j][1] = *(const u32x4*)(proj + (size_t)rr * DINP + cb + 8);
        const float* cw = P.gdn_conv + ((size_t)l * 4 + j) * 3072 + cb;
#pragma unroll
        for (int e4 = 0; e4 < 4; ++e4) wv[j][e4] = *(const f32x4*)(cw + 4 * e4); }
      __builtin_amdgcn_sched_barrier(0);
#pragma unroll
      for (int j = 0; j < 4; ++j) { const float msk = (tabs - 3 + j) >= 0 ? 1.f : 0.f;
        float xv[16]; unpack8(pv[j][0], xv); unpack8(pv[j][1], xv + 8);
#pragma unroll
        for (int e4 = 0; e4 < 4; ++e4) { const f32x4 wm = wv[j][e4] * msk; y[4 * e4] += wm.x * xv[4 * e4]; y[4 * e4 + 1] += wm.y * xv[4 * e4 + 1]; y[4 * e4 + 2] += wm.z * xv[4 * e4 + 2]; y[4 * e4 + 3] += wm.w * xv[4 * e4 + 3]; } }
#pragma unroll
      for (int e = 0; e < 16; ++e) y[e] = silu_f(y[e]);
      if (X < 2) { float ss = 0.f;
#pragma unroll
        for (int e = 0; e < 16; ++e) ss += y[e] * y[e];
        ss += __shfl_xor(ss, 1); ss += __shfl_xor(ss, 2); ss += __shfl_xor(ss, 4);
        const float rn = rsqrtf(ss + EPS) * (X == 0 ? 0.08838834764831845f : 1.f);
#pragma unroll
        for (int e = 0; e < 16; ++e) y[e] *= rn; }
      if (X == 0) {
        u32x4 p0 = {pack2(y[0], y[1]), pack2(y[2], y[3]), pack2(y[4], y[5]), pack2(y[6], y[7])}, p1 = {pack2(y[8], y[9]), pack2(y[10], y[11]), pack2(y[12], y[13]), pack2(y[14], y[15])};
        *(u32x4*)(qb16 + t * 272 + part * 32) = p0; *(u32x4*)(qb16 + t * 272 + part * 32 + 16) = p1;
#pragma unroll
        for (int b = 0; b < 4; ++b) { u32x2 pk = {pack2(y[4 * b] * egct, y[4 * b + 1] * egct), pack2(y[4 * b + 2] * egct, y[4 * b + 3] * egct)};
          *(u32x2*)(Qd + t * 128 + 32 * (part >> 1) + 8 * b + 4 * (part & 1)) = pk; }
      } else if (X == 1) {
        u32x4 p0 = {pack2(y[0], y[1]), pack2(y[2], y[3]), pack2(y[4], y[5]), pack2(y[6], y[7])}, p1 = {pack2(y[8], y[9]), pack2(y[10], y[11]), pack2(y[12], y[13]), pack2(y[14], y[15])};
        *(u32x4*)(kb16 + t * 272 + part * 32) = p0; *(u32x4*)(kb16 + t * 272 + part * 32 + 16) = p1;
#pragma unroll
        for (int e4 = 0; e4 < 4; ++e4) { f32x4 v = {y[4 * e4], y[4 * e4 + 1], y[4 * e4 + 2], y[4 * e4 + 3]}; *(f32x4*)(kf + t * 128 + part * 16 + 4 * e4) = v; }
#pragma unroll
        for (int e = 0; e < 16; ++e) Kt[(part * 16 + e) * 64 + pjt] = f2bf(y[e] * ktl);
      } else {
#pragma unroll
        for (int e4 = 0; e4 < 4; ++e4) { f32x4 v = {y[4 * e4], y[4 * e4 + 1], y[4 * e4 + 2], y[4 * e4 + 3]}; *(f32x4*)(vf + t * 128 + part * 16 + 4 * e4) = v; }
      }
    }
    { const int cb = C_AZ + hh * 128 + part * 16; const u32x4 v0 = *(const u32x4*)(proj + (size_t)tabs * DINP + cb), v1 = *(const u32x4*)(proj + (size_t)tabs * DINP + cb + 8);
      float zv[16]; unpack8(v0, zv); unpack8(v1, zv + 8);
#pragma unroll
      for (int e = 0; e < 16; ++e) Zt[(part * 16 + e) * 64 + t] = f2bf(silu_f(zv[e])); }
  }
  __syncthreads();
  {
    const int which = w >> 2, ti = (w >> 1) & 1, tj = w & 1; const char* Ab = which ? qb16 : kb16;
    f32x16 acc;
#pragma unroll
    for (int r = 0; r < 16; ++r) acc[r] = 0.f;
#pragma unroll
    for (int s = 0; s < 8; ++s) { const bf16x8 a = *(const bf16x8*)(Ab + (32 * ti + lq) * 272 + (16 * s + 8 * h) * 2), b = *(const bf16x8*)(kb16 + (32 * tj + lq) * 272 + (16 * s + 8 * h) * 2);
      acc = MFMA32(a, b, acc); }
    const int j = 32 * tj + lq; const float gj = gcs[j]; const int pj = 32 * (j >> 5) + perm32(j & 31);
#pragma unroll
    for (int r = 0; r < 16; ++r) { const int i = 32 * ti + crow(r, h); const float dec = __expf(fminf(gcs[i] - gj, 0.f));
      if (which == 0) Lm[i * 64 + j] = (j < i) ? gcs[64 + i] * acc[r] * dec : 0.f;
      else QK[i * 64 + pj] = f2bf((j <= i) ? acc[r] * dec : 0.f); }
  }
  __syncthreads();
  if (tid < 256) {
    const int c = tid; const bool isu = c < 128; const int cc = c & 127;
    const float* rp = (isu ? vf : kf) + cc; const float* sp = gcs + (isu ? 64 : 192);
    f32x2 xx[32];
    f32x4 LA[16], LB[16]; float rh[2];
    xx[0].x = sp[0] * rp[0];
    LA[0] = *(const f32x4*)(Lm + 64); rh[1] = sp[1] * rp[128];
#pragma unroll
    for (int i = 1; i < 64; ++i) {
      f32x4 (&CUR)[16] = (i & 1) ? LA : LB; f32x4 (&NXT)[16] = (i & 1) ? LB : LA;
      if (i + 1 < 64) {
#pragma unroll
        for (int c = 0; c < (i + 4) / 4; ++c) NXT[c] = *(const f32x4*)(Lm + (i + 1) * 64 + 4 * c);
        rh[(i + 1) & 1] = sp[i + 1] * rp[(i + 1) * 128];
      }
      __builtin_amdgcn_sched_barrier(0);
      f32x2 acc = {rh[i & 1], 0.f};
#pragma unroll
      for (int p = 0; p < i / 2; ++p) { const f32x2 lp = (p & 1) ? (f32x2){CUR[p >> 1].z, CUR[p >> 1].w} : (f32x2){CUR[p >> 1].x, CUR[p >> 1].y}; acc = acc - lp * xx[p]; }
      if (i & 1) { const int j = i - 1; const float lj = ((j & 3) == 0) ? CUR[j >> 2].x : CUR[j >> 2].z; acc.x = fmaf(-lj, xx[j >> 1].x, acc.x); }
      const float xi = acc.x + acc.y;
      if (i & 1) xx[i >> 1].y = xi; else xx[i >> 1].x = xi;
      __builtin_amdgcn_sched_barrier(0);
    }
    float x[64];
#pragma unroll
    for (int p = 0; p < 32; ++p) { x[2 * p] = xx[p].x; x[2 * p + 1] = xx[p].y; }
    if (isu) {
#pragma unroll
      for (int i8 = 0; i8 < 8; ++i8) { u32x4 v = {pack2(x[8 * i8], x[8 * i8 + 1]), pack2(x[8 * i8 + 2], x[8 * i8 + 3]), pack2(x[8 * i8 + 4], x[8 * i8 + 5]), pack2(x[8 * i8 + 6], x[8 * i8 + 7])}; *(u32x4*)(Ut + cc * 64 + 8 * i8) = v; }
    } else {
      const int pp = 32 * (cc >> 5) + perm32(cc & 31);
#pragma unroll
      for (int i = 0; i < 64; ++i) Wp[i * 128 + pp] = f2bf(x[i]);
    }
  }
  __syncthreads();
}

DI bf16x8 pack_tiles(const f32x4& a, const f32x4& b) { return pack8(a.x, a.y, a.z, a.w, b.x, b.y, b.z, b.w); }
template <int CTRL> DI float dppf(float v) { return __int_as_float(__builtin_amdgcn_update_dpp(0, __float_as_int(v), CTRL, 0xf, 0xf, true)); }
DI float row16_sum(float v) { v += dppf<0xB1>(v); v += dppf<0x4E>(v); v += dppf<0x141>(v); v += dppf<0x140>(v); return v; }
constexpr size_t OFF_SSQP = OFF_GTOT + 8192;
static_assert(OFF_SSQP + (size_t)8 * S_ * 8 * 4 <= OFF_UT, "overlay3");
constexpr int SCAN_OPB = 62464;
constexpr int SCAN_SO = 2 * SCAN_OPB;
constexpr int SCAN_OT = SCAN_SO + 16384;
DI void gdn_scan_item(const Params& P, int l, int hh, int half, char* smem) {
  const int tid = opaque_tid(), lane = tid & 63, w = tid >> 6, l15 = lane & 15, q4 = lane >> 4;
  const size_t hb = (size_t)hh * 256;
  const bf16_t* Wp = (const bf16_t*)(P.ws + OFF_WP) + hb * 8192; const bf16_t* Qd = (const bf16_t*)(P.ws + OFF_QD) + hb * 8192;
  const bf16_t* Kt = (const bf16_t*)(P.ws + OFF_KT) + hb * 8192; const bf16_t* Zt = (const bf16_t*)(P.ws + OFF_ZT) + hb * 8192;
  const bf16_t* QK = (const bf16_t*)(P.ws + OFF_QK) + hb * 4096; const bf16_t* Ut = (const bf16_t*)(P.ws + OFF_UT) + hb * 8192;
  const float* gt = (const float*)(P.ws + OFF_GTOT) + hb;
  bf16_t* mixin = (bf16_t*)(P.ws + OFF_H);
  float* sSS = (float*)(smem + SCAN_OT + 16384);
  if (w >= 4) {
    const int lt = tid - 256, wl = w - 4;
    const int dvc = 64 * half + 16 * wl + l15; const float nw = P.gdn_norm[l * 128 + dvc];
    const int uoff = dvc * 64 + 4 * q4;
    const int g256 = (lt >> 4) * 128 + (lt & 15) * 8, l256 = (lt >> 4) * 272 + (lt & 15) * 16;
    const int g128 = (lt >> 3) * 64 + (lt & 7) * 8, l128 = (lt >> 3) * 144 + (lt & 7) * 16;
    u32x4 pwA[4], pqA[4], pkA[4], pqkA[2], pwB[4], pqB[4], pkB[4], pqkB[2]; u32x2 zA[4], zB[4];
#define LD_LOAD(PW, PQ, PK, PQK, N) { const int n__ = (N) < 255 ? (N) : 255; const size_t o8 = (size_t)n__ * 8192, o4 = (size_t)n__ * 4096; \
    _Pragma("unroll") for (int i = 0; i < 4; ++i) { PW[i] = *(const u32x4*)(Wp + o8 + g256 + i * 2048); PQ[i] = *(const u32x4*)(Qd + o8 + g256 + i * 2048); PK[i] = *(const u32x4*)(Kt + o8 + g128 + i * 2048); } \
    _Pragma("unroll") for (int i = 0; i < 2; ++i) PQK[i] = *(const u32x4*)(QK + o4 + g128 + i * 2048); }
#define LZ_LOAD(Z, N) { const int n__ = (N) < 255 ? (N) : 255; _Pragma("unroll") for (int it = 0; it < 4; ++it) Z[it] = *(const u32x2*)(Zt + (size_t)n__ * 8192 + uoff + 16 * it); }
#define LD_STAGE(PW, PQ, PK, PQK, NB) { char* nb_ = (NB); \
    _Pragma("unroll") for (int i = 0; i < 4; ++i) { *(u32x4*)(nb_ + l256 + i * 4352) = PW[i]; *(u32x4*)(nb_ + 17408 + l256 + i * 4352) = PQ[i]; *(u32x4*)(nb_ + 34816 + l128 + i * 4608) = PK[i]; } \
    _Pragma("unroll") for (int i = 0; i < 2; ++i) *(u32x4*)(nb_ + 53248 + l128 + i * 4608) = PQK[i]; }
#define LD_FINISH(M, Z) { const int m = (M); const char* so = smem + SCAN_SO + (m & 1) * 8192 + (wl * 4) * 512 + lane * 8; \
    bf16_t* ot = (bf16_t*)(smem + SCAN_OT + (m & 1) * 8192); float* sq = sSS + (m & 1) * 256 + wl * 64; \
    _Pragma("unroll") for (int it = 0; it < 4; ++it) { \
      const u32x2 ob = *(const u32x2*)(so + it * 512); const f32x4 o = {bflo(ob.x), bfhi(ob.x), bflo(ob.y), bfhi(ob.y)}; \
      f32x4 ss = o * o; ss.x = row16_sum(ss.x); ss.y = row16_sum(ss.y); ss.z = row16_sum(ss.z); ss.w = row16_sum(ss.w); \
      const int rl = 16 * it + 4 * q4; \
      if (l15 == 0) *(f32x4*)(sq + rl) = ss; \
      bf16_t* op = ot + rl * 64 + 16 * wl + l15; \
      op[0] = f2bf(o.x * nw * bflo(Z[it].x)); op[64] = f2bf(o.y * nw * bfhi(Z[it].x)); op[128] = f2bf(o.z * nw * bflo(Z[it].y)); op[192] = f2bf(o.w * nw * bfhi(Z[it].y)); } }
#define LD_STEP(PW, PQ, PK, PQK, ZU, N) { const int n_ = (N); \
    LD_STAGE(PW, PQ, PK, PQK, smem + ((n_ + 1) & 1) * SCAN_OPB); \
    LD_LOAD(PW, PQ, PK, PQK, n_ + 3); \
    if (n_ >= 1) LD_FINISH(n_ - 1, ZU); \
    LZ_LOAD(ZU, n_ + 1); \
    __syncthreads(); }
    LD_LOAD(pwA, pqA, pkA, pqkA, 0);
    LD_STAGE(pwA, pqA, pkA, pqkA, smem);
    LD_LOAD(pwA, pqA, pkA, pqkA, 1);
    LD_LOAD(pwB, pqB, pkB, pqkB, 2);
    LZ_LOAD(zB, 0);
    LZ_LOAD(zA, 0);
    __syncthreads();
#pragma unroll 1
    for (int n = 0; n < 256; n += 2) {
      LD_STEP(pwA, pqA, pkA, pqkA, zA, n);
      LD_STEP(pwB, pqB, pkB, pqkB, zB, n + 1);
    }
    LD_FINISH(255, zA);
    __syncthreads();
#undef LD_LOAD
#undef LZ_LOAD
#undef LD_STAGE
#undef LD_FINISH
#undef LD_STEP
  } else {
    const int dvc = 64 * half + 16 * w + l15;
    const int uoff = dvc * 64 + 4 * q4;
    float* ssqp = (float*)(P.ws + OFF_SSQP) + (size_t)(half * 4 + w) * S_ * 8;
    f32x4 St[8];
#pragma unroll
    for (int t = 0; t < 8; ++t) St[t] = (f32x4){0.f, 0.f, 0.f, 0.f};
    u32x2 uc[4], un[4]; float gcur, gn = 0.f;
#pragma unroll
    for (int it = 0; it < 4; ++it) { uc[it] = *(const u32x2*)(Ut + uoff + 16 * it); un[it] = uc[it]; }
    gcur = gt[0];
#define CP_OUT(M) { const int m2 = (M); const char* ot = smem + SCAN_OT + (m2 & 1) * 8192; \
      _Pragma("unroll") for (int i = 0; i < 2; ++i) { const int c = tid + 256 * i, row = c >> 3, cc = c & 7; \
        *(u32x4*)(mixin + (size_t)(64 * m2 + row) * 2048 + hh * 128 + 64 * half + cc * 8) = *(const u32x4*)(ot + row * 128 + cc * 16); } \
      ssqp[(size_t)(64 * m2 + lane) * 8 + hh] = sSS[(m2 & 1) * 256 + w * 64 + lane]; }
    __syncthreads();
#pragma unroll 2
    for (int n = 0; n < 256; ++n) {
      const char* cb = smem + (n & 1) * SCAN_OPB;
      const char* sWp = cb; const char* sQd = cb + 17408; const char* sKt = cb + 34816; const char* sQK = cb + 53248;
      if (n + 1 < 256) { const size_t o8 = (size_t)(n + 1) * 8192;
#pragma unroll
        for (int it = 0; it < 4; ++it) un[it] = *(const u32x2*)(Ut + o8 + uoff + 16 * it);
        gn = gt[n + 1]; }
      bf16x8 sb[4];
#pragma unroll
      for (int ks = 0; ks < 4; ++ks) sb[ks] = pack_tiles(St[2 * ks], St[2 * ks + 1]);
      f32x4 wsv[4], qs[4];
#pragma unroll
      for (int it = 0; it < 4; ++it) { wsv[it] = (f32x4){0.f, 0.f, 0.f, 0.f}; qs[it] = (f32x4){0.f, 0.f, 0.f, 0.f}; }
#pragma unroll
      for (int it = 0; it < 4; ++it)
#pragma unroll
        for (int ks = 0; ks < 4; ++ks) { const int o = (16 * it + l15) * 272 + 64 * ks + 16 * q4;
          const bf16x8 a = *(const bf16x8*)(sWp + o), a2 = *(const bf16x8*)(sQd + o);
          wsv[it] = MFMA16(a, sb[ks], wsv[it]); qs[it] = MFMA16(a2, sb[ks], qs[it]); }
      f32x4 vn[4];
#pragma unroll
      for (int it = 0; it < 4; ++it) { const f32x4 uf = {bflo(uc[it].x), bfhi(uc[it].x), bflo(uc[it].y), bfhi(uc[it].y)}; vn[it] = uf - wsv[it]; }
      bf16x8 vb[2];
#pragma unroll
      for (int ks = 0; ks < 2; ++ks) vb[ks] = pack_tiles(vn[2 * ks], vn[2 * ks + 1]);
#pragma unroll
      for (int it = 0; it < 4; ++it)
#pragma unroll
        for (int ks = 0; ks < 2; ++ks) { const bf16x8 a = *(const bf16x8*)(sQK + (16 * it + l15) * 144 + 64 * ks + 16 * q4); qs[it] = MFMA16(a, vb[ks], qs[it]); }
      { char* so = smem + SCAN_SO + (n & 1) * 8192 + (w * 4) * 512 + lane * 8;
#pragma unroll
        for (int it = 0; it < 4; ++it) { u32x2 ob = {pack2(qs[it].x, qs[it].y), pack2(qs[it].z, qs[it].w)}; *(u32x2*)(so + it * 512) = ob; } }
#pragma unroll
      for (int t = 0; t < 8; ++t) { St[t] *= gcur;
#pragma unroll
        for (int ks = 0; ks < 2; ++ks) { const bf16x8 a = *(const bf16x8*)(sKt + (16 * t + l15) * 144 + 64 * ks + 16 * q4); St[t] = MFMA16(a, vb[ks], St[t]); } }
#pragma unroll
      for (int it = 0; it < 4; ++it) uc[it] = un[it];
      gcur = gn;
      if (n >= 2) CP_OUT(n - 2);
      __syncthreads();
    }
    CP_OUT(254);
    __syncthreads();
    CP_OUT(255);
#undef CP_OUT
  }
  __syncthreads();
}
DI void gdn_fix_phase(const Params& P) {
  const int tid = opaque_tid();
  bf16_t* mixin = (bf16_t*)(P.ws + OFF_H); const float* ssqp = (const float*)(P.ws + OFF_SSQP);
  for (int idx = blockIdx.x * NT + tid; idx < S_ * 128; idx += gridDim.x * NT) {
    const int t = idx >> 7, ck = idx & 127, h = ck >> 4;
    float sq = 0.f;
#pragma unroll
    for (int p = 0; p < 8; ++p) sq += ssqp[((size_t)p * S_ + t) * 8 + h];
    const float r = rsqrtf(sq * (1.f / 128.f) + EPS);
    u32x4* pp = (u32x4*)(mixin + (size_t)t * 2048 + ck * 8); const u32x4 v = *pp; float f[8]; unpack8(v, f);
    u32x4 o = {pack2(f[0] * r, f[1] * r), pack2(f[2] * r, f[3] * r), pack2(f[4] * r, f[5] * r), pack2(f[6] * r, f[7] * r)}; *pp = o;
  }
}

DI void mla_attn_item(const Params& P, int hd, int b, char* smem) {
  const int tid = opaque_tid(), lane = tid & 63, w = tid >> 6, wq = w & 3, hk = w >> 2, lq = lane & 31, h = lane >> 5;
  const float* qraw = (const float*)(P.ws + OFF_QRAW);
  const bf16_t* Kg = (const bf16_t*)(P.ws + OFF_KMLA) + (size_t)hd * S_ * 192;
  const bf16_t* Vg = (const bf16_t*)(P.ws + OFF_VT) + (size_t)hd * 128 * S_;
  bf16_t* mixin = (bf16_t*)(P.ws + OFF_H);
  const int q = 128 * b + 32 * wq + lq;
  bf16x8 qf[12];
  {
    const float* qp = qraw + (size_t)q * 768 + hd * 192 + 8 * h;
    const float sc = 0.07216878364870322f * LOG2E;
#pragma unroll
    for (int s = 0; s < 8; ++s) { const f32x4 a = *(const f32x4*)(qp + 16 * s), c = *(const f32x4*)(qp + 16 * s + 4);
      qf[s] = pack8(a.x * sc, a.y * sc, a.z * sc, a.w * sc, c.x * sc, c.y * sc, c.z * sc, c.w * sc); }
    const double pq = (double)P.pos[q];
#pragma unroll
    for (int s2 = 0; s2 < 2; ++s2) {
      const f32x4 a0 = *(const f32x4*)(qp + 128 + 16 * s2), a1 = *(const f32x4*)(qp + 128 + 16 * s2 + 4);
      const f32x4 b0 = *(const f32x4*)(qp + 160 + 16 * s2), b1 = *(const f32x4*)(qp + 160 + 16 * s2 + 4);
      float x1[8] = {a0.x, a0.y, a0.z, a0.w, a1.x, a1.y, a1.z, a1.w}, x2[8] = {b0.x, b0.y, b0.z, b0.w, b1.x, b1.y, b1.z, b1.w}, o1[8], o2[8];
#pragma unroll
      for (int j = 0; j < 8; ++j) { double fr = pq * kInvFreq2Pi[16 * s2 + 8 * h + j]; fr -= floor(fr); const float ff = (float)fr;
        const float sn = __builtin_amdgcn_sinf(ff), cs = __builtin_amdgcn_cosf(ff);
        o1[j] = (x1[j] * cs - x2[j] * sn) * sc; o2[j] = (x2[j] * cs + x1[j] * sn) * sc; }
      qf[8 + s2] = pack8(o1[0], o1[1], o1[2], o1[3], o1[4], o1[5], o1[6], o1[7]);
      qf[10 + s2] = pack8(o2[0], o2[1], o2[2], o2[3], o2[4], o2[5], o2[6], o2[7]);
    }
  }
  constexpr int KST = 64 * 400, VST = 128 * 144, STG = KST + VST;
  f32x16 O[4];
#pragma unroll
  for (int i = 0; i < 4; ++i)
#pragma unroll
    for (int r = 0; r < 16; ++r) O[i][r] = 0.f;
  float m_i = -1e30f, l_i = 0.f;
  const int nt = 2 * b + 2;
  u32x4 rk0[3], rv0[2], rk1[3], rv1[2];
  const int vrow = tid >> 3, vcc = tid & 7;
  const int ntl = nt - 1;
#define AT_LOAD(RK, RV, T) { const size_t ko_ = (size_t)(T) * 64 * 192; const int vo_ = (T) * 64; \
    _Pragma("unroll") for (int i = 0; i < 3; ++i) { const int id = tid + NT * i, row = id / 24, cc = id % 24; RK[i] = *(const u32x4*)(Kg + ko_ + row * 192 + cc * 8); } \
    _Pragma("unroll") for (int i = 0; i < 2; ++i) RV[i] = *(const u32x4*)(Vg + (size_t)(vrow + 64 * i) * S_ + vo_ + vcc * 8); }
#define AT_WRITE(RK, RV, ST) { char* dK = smem + (ST) * STG; \
    _Pragma("unroll") for (int i = 0; i < 3; ++i) { const int id = tid + NT * i, row = id / 24, cc = id % 24; *(u32x4*)(dK + row * 400 + cc * 16) = RK[i]; } \
    _Pragma("unroll") for (int i = 0; i < 2; ++i) *(u32x4*)(dK + KST + (vrow + 64 * i) * 144 + vcc * 16) = RV[i]; }
#define AT_COMPUTE(ST, KT) { const char* sK = smem + (ST) * STG; const char* sV = sK + KST; const int key0 = 64 * (KT) + 32 * hk; \
    if (key0 <= 128 * b + 32 * wq) { \
      f32x16 st; _Pragma("unroll") for (int r = 0; r < 16; ++r) st[r] = 0.f; \
      _Pragma("unroll") for (int s = 0; s < 12; ++s) { const bf16x8 kf = *(const bf16x8*)(sK + (32 * hk + lq) * 400 + (2 * s + h) * 16); st = MFMA32(kf, qf[s], st); } \
      if (key0 + 31 > 128 * b + 32 * wq) { int qrel = q - key0 - 4 * h; asm volatile("" : "+v"(qrel)); \
        _Pragma("unroll") for (int r = 0; r < 16; ++r) if ((r & 3) + 8 * (r >> 2) > qrel) st[r] = -1e30f; } \
      float mx = st[0]; _Pragma("unroll") for (int r = 1; r < 16; ++r) mx = fmaxf(mx, st[r]); \
      mx = fmaxf(mx, __shfl_xor(mx, 32)); \
      const float m_new = fmaxf(m_i, mx), alpha = __builtin_amdgcn_exp2f(m_i - m_new); float ps = 0.f; \
      _Pragma("unroll") for (int r = 0; r < 16; ++r) { st[r] = __builtin_amdgcn_exp2f(st[r] - m_new); ps += st[r]; } \
      l_i = l_i * alpha + ps; \
      if (__any(m_new != m_i)) { _Pragma("unroll") for (int i = 0; i < 4; ++i) _Pragma("unroll") for (int r = 0; r < 16; ++r) O[i][r] *= alpha; } \
      m_i = m_new; \
      bf16x8 pf[2]; \
      _Pragma("unroll") for (int s = 0; s < 2; ++s) pf[s] = pack8(st[8 * s], st[8 * s + 1], st[8 * s + 2], st[8 * s + 3], st[8 * s + 4], st[8 * s + 5], st[8 * s + 6], st[8 * s + 7]); \
      _Pragma("unroll") for (int i = 0; i < 4; ++i) _Pragma("unroll") for (int s = 0; s < 2; ++s) { const char* vp = sV + (32 * i + lq) * 144 + (32 * hk + 16 * s + 4 * h) * 2; \
          const u32x2 lo = *(const u32x2*)vp, hi = *(const u32x2*)(vp + 16); u32x4 vv = {lo.x, lo.y, hi.x, hi.y}; \
          O[i] = MFMA32(__builtin_bit_cast(bf16x8, vv), pf[s], O[i]); } } }
  AT_LOAD(rk0, rv0, 0);
  AT_LOAD(rk1, rv1, 1);
  AT_WRITE(rk0, rv0, 0);
  AT_LOAD(rk0, rv0, (2 < ntl ? 2 : ntl));
  __syncthreads();
  for (int kt = 0; kt < nt; kt += 2) {
    AT_WRITE(rk1, rv1, 1);
    AT_LOAD(rk1, rv1, (kt + 3 < ntl ? kt + 3 : ntl));
    AT_COMPUTE(0, kt);
    __syncthreads();
    AT_WRITE(rk0, rv0, 0);
    AT_LOAD(rk0, rv0, (kt + 4 < ntl ? kt + 4 : ntl));
    AT_COMPUTE(1, kt + 1);
    __syncthreads();
  }
#undef AT_LOAD
#undef AT_WRITE
#undef AT_COMPUTE
  float* cO = (float*)smem; float* cm = cO + 4 * 4096; float* cl = cm + 256;
  if (hk == 1) {
#pragma unroll
    for (int i = 0; i < 4; ++i)
#pragma unroll
      for (int r = 0; r < 16; ++r) cO[wq * 4096 + (i * 16 + r) * 64 + lane] = O[i][r];
    cm[wq * 64 + lane] = m_i; cl[wq * 64 + lane] = l_i;
  }
  __syncthreads();
  if (hk == 0) {
    const float m1 = cm[wq * 64 + lane], l1 = cl[wq * 64 + lane];
    const float m = fmaxf(m_i, m1), a0 = exp2f(m_i - m), a1 = exp2f(m1 - m);
    float lt = l_i * a0 + l1 * a1; lt += __shfl_xor(lt, 32);
    const float inv = 1.f / lt;
    bf16_t* op = mixin + (size_t)q * 2048 + 1024 + hd * 128;
#pragma unroll
    for (int i = 0; i < 4; ++i)
#pragma unroll
      for (int rg = 0; rg < 4; ++rg) { float v[4];
#pragma unroll
        for (int e = 0; e < 4; ++e) v[e] = (O[i][4 * rg + e] * a0 + cO[wq * 4096 + (i * 16 + 4 * rg + e) * 64 + lane] * a1) * inv;
        u32x2 pk = {pack2(v[0], v[1]), pack2(v[2], v[3])}; *(u32x2*)(op + 32 * i + 8 * rg + 4 * h) = pk; }
  }
  __syncthreads();
}

DI void swa_item(const Params& P, int l, int n, int hk2, char* smem) {
  const int tid = opaque_tid(), lane = tid & 63, w = tid >> 6, lq = lane & 31, h = lane >> 5;
  const bf16_t* proj = (const bf16_t*)(P.ws + OFF_PROJ); bf16_t* mixin = (bf16_t*)(P.ws + OFF_H);
  bf16_t* sVt = (bf16_t*)smem;
#pragma unroll
  for (int i = 0; i < 4; ++i) { const int id = tid + NT * i, key = id >> 3, dc = id & 7; const int kp = 128 * (n - 1) + key;
    u32x4 v = {0u, 0u, 0u, 0u}; if (kp >= 0) v = *(const u32x4*)(proj + (size_t)kp * DINP + C_CV + hk2 * 64 + dc * 8);
    sVt[(8 * dc + 0) * 264 + key] = (bf16_t)(v.x & 0xffff); sVt[(8 * dc + 1) * 264 + key] = (bf16_t)(v.x >> 16);
    sVt[(8 * dc + 2) * 264 + key] = (bf16_t)(v.y & 0xffff); sVt[(8 * dc + 3) * 264 + key] = (bf16_t)(v.y >> 16);
    sVt[(8 * dc + 4) * 264 + key] = (bf16_t)(v.z & 0xffff); sVt[(8 * dc + 5) * 264 + key] = (bf16_t)(v.z >> 16);
    sVt[(8 * dc + 6) * 264 + key] = (bf16_t)(v.w & 0xffff); sVt[(8 * dc + 7) * 264 + key] = (bf16_t)(v.w >> 16); }
  __syncthreads();
  const int g = w >> 1, hq = hk2 * 4 + g;
  const float slope = exp2f(-(float)(hq + 1)) * LOG2E, sinkv = P.swa_sinks[l * 8 + hq] * LOG2E;
#pragma unroll 1
  for (int jj = 0; jj < 2; ++jj) {
    const int j = 2 * (w & 1) + jj; const int qrow = 128 * n + 32 * j + lq;
    bf16x8 qf[4];
#pragma unroll
    for (int s = 0; s < 4; ++s) qf[s] = *(const bf16x8*)(proj + (size_t)qrow * DINP + C_CQ + hq * 64 + 16 * s + 8 * h);
    f32x16 st[5];
    bf16x8 kf[2][4];
    { const int kp = 128 * (n - 1) + 32 * j + lq;
#pragma unroll
      for (int s = 0; s < 4; ++s) { kf[0][s] = (bf16x8){0, 0, 0, 0, 0, 0, 0, 0}; if (kp >= 0) kf[0][s] = *(const bf16x8*)(proj + (size_t)kp * DINP + C_CK + hk2 * 64 + 16 * s + 8 * h); } }
#pragma unroll
    for (int tt = 0; tt < 5; ++tt) {
      if (tt + 1 < 5) { const int kp = 128 * (n - 1) + 32 * (j + tt + 1) + lq;
#pragma unroll
        for (int s = 0; s < 4; ++s) { kf[(tt + 1) & 1][s] = (bf16x8){0, 0, 0, 0, 0, 0, 0, 0}; if (kp >= 0) kf[(tt + 1) & 1][s] = *(const bf16x8*)(proj + (size_t)kp * DINP + C_CK + hk2 * 64 + 16 * s + 8 * h); } }
      __builtin_amdgcn_sched_barrier(0);
#pragma unroll
      for (int r = 0; r < 16; ++r) st[tt][r] = 0.f;
#pragma unroll
      for (int s = 0; s < 4; ++s) st[tt] = MFMA32(kf[tt & 1][s], qf[s], st[tt]);
      __builtin_amdgcn_sched_barrier(0);
    }
    float mx = sinkv;
    int dbase = 128 + lq - 4 * h, kbase = 128 * (n - 1) + 32 * j + 4 * h;
    asm volatile("" : "+v"(dbase), "+v"(kbase));
#pragma unroll
    for (int tt = 0; tt < 5; ++tt)
#pragma unroll
      for (int r = 0; r < 16; ++r) { const int cst = 32 * tt + (r & 3) + 8 * (r >> 2); const int dist = dbase - cst; const int kpos = kbase + cst;
        const bool valid = (dist >= 0) && (dist < 128) && (kpos >= 0);
        const float sv = valid ? st[tt][r] * (0.125f * LOG2E) - slope * (float)dist : -1e30f; st[tt][r] = sv; mx = fmaxf(mx, sv); }
    mx = fmaxf(mx, __shfl_xor(mx, 32));
    float den = 0.f;
#pragma unroll
    for (int tt = 0; tt < 5; ++tt)
#pragma unroll
      for (int r = 0; r < 16; ++r) { const float p = exp2f(st[tt][r] - mx); st[tt][r] = p; den += p; }
    den += __shfl_xor(den, 32); den += exp2f(sinkv - mx);
    f32x16 O[2];
#pragma unroll
    for (int i = 0; i < 2; ++i)
#pragma unroll
      for (int r = 0; r < 16; ++r) O[i][r] = 0.f;
#pragma unroll
    for (int tt = 0; tt < 5; ++tt)
#pragma unroll
      for (int s = 0; s < 2; ++s) { const bf16x8 pf = pack8(st[tt][8 * s], st[tt][8 * s + 1], st[tt][8 * s + 2], st[tt][8 * s + 3], st[tt][8 * s + 4], st[tt][8 * s + 5], st[tt][8 * s + 6], st[tt][8 * s + 7]);
#pragma unroll
        for (int i = 0; i < 2; ++i) { const char* vp = (const char*)sVt + (32 * i + lq) * 528 + (32 * (j + tt) + 16 * s + 4 * h) * 2;
          const u32x2 lo = *(const u32x2*)vp, hi = *(const u32x2*)(vp + 16); u32x4 vv = {lo.x, lo.y, hi.x, hi.y};
          O[i] = MFMA32(__builtin_bit_cast(bf16x8, vv), pf, O[i]); }
        __builtin_amdgcn_sched_barrier(0); }
    const float inv = 1.f / den;
    bf16_t* op = mixin + (size_t)qrow * 2048 + 1536 + hq * 64;
#pragma unroll
    for (int i = 0; i < 2; ++i)
#pragma unroll
      for (int rg = 0; rg < 4; ++rg) { u32x2 pk = {pack2(O[i][4 * rg] * inv, O[i][4 * rg + 1] * inv), pack2(O[i][4 * rg + 2] * inv, O[i][4 * rg + 3] * inv)};
        *(u32x2*)(op + 32 * i + 8 * rg + 4 * h) = pk; }
  }
  __syncthreads();
}

DI float gelu_tanh(float x) { const float y = 0.7978845608028654f * (x + 0.044715f * x * x * x); const float t = 1.f - 2.f * __builtin_amdgcn_rcpf(1.f + __expf(2.f * y)); return 0.5f * x * (1.f + t); }
DI void ffn_act_phase(const Params& P, int l) {
  const int tid = opaque_tid(), lane = tid & 63, w = tid >> 6;
  const bf16_t* u = (const bf16_t*)(P.ws + OFF_BIG); bf16_t* act = (bf16_t*)(P.ws + OFF_ACT);
  const float* cw = P.ffn_conv + (size_t)l * 3 * DFF2; const float* cb = P.ffn_conv_b + (size_t)l * DFF2;
  for (int item = blockIdx.x * 8 + w; item < 512 * 11; item += gridDim.x * 8) {
    const int cbk = item % 11, rr = item / 11; const int ch = cbk * 512 + lane * 8, r0 = rr * 32;
    float wg[3][8], wu[3][8], bg[8], bu[8];
#pragma unroll
    for (int j = 0; j < 3; ++j)
#pragma unroll
      for (int e4 = 0; e4 < 2; ++e4) { const f32x4 a = *(const f32x4*)(cw + (size_t)j * DFF2 + ch + 4 * e4), b = *(const f32x4*)(cw + (size_t)j * DFF2 + DFF + ch + 4 * e4);
        wg[j][4 * e4] = a.x; wg[j][4 * e4 + 1] = a.y; wg[j][4 * e4 + 2] = a.z; wg[j][4 * e4 + 3] = a.w; wu[j][4 * e4] = b.x; wu[j][4 * e4 + 1] = b.y; wu[j][4 * e4 + 2] = b.z; wu[j][4 * e4 + 3] = b.w; }
#pragma unroll
    for (int e4 = 0; e4 < 2; ++e4) { const f32x4 a = *(const f32x4*)(cb + ch + 4 * e4), b = *(const f32x4*)(cb + DFF + ch + 4 * e4);
      bg[4 * e4] = a.x; bg[4 * e4 + 1] = a.y; bg[4 * e4 + 2] = a.z; bg[4 * e4 + 3] = a.w; bu[4 * e4] = b.x; bu[4 * e4 + 1] = b.y; bu[4 * e4 + 2] = b.z; bu[4 * e4 + 3] = b.w; }
    float g2[8], g1[8], u2[8], u1[8];
#pragma unroll
    for (int e = 0; e < 8; ++e) { g2[e] = 0.f; g1[e] = 0.f; u2[e] = 0.f; u1[e] = 0.f; }
    if (r0 >= 2) { unpack8(*(const u32x4*)(u + (size_t)(r0 - 2) * DFF2 + ch), g2); unpack8(*(const u32x4*)(u + (size_t)(r0 - 2) * DFF2 + DFF + ch), u2);
      unpack8(*(const u32x4*)(u + (size_t)(r0 - 1) * DFF2 + ch), g1); unpack8(*(const u32x4*)(u + (size_t)(r0 - 1) * DFF2 + DFF + ch), u1); }
#pragma unroll 1
    for (int rb = 0; rb < 4; ++rb) {
      u32x4 G[8], U[8];
#pragma unroll
      for (int i = 0; i < 8; ++i) { const size_t ro = (size_t)(r0 + rb * 8 + i) * DFF2 + ch; G[i] = *(const u32x4*)(u + ro); U[i] = *(const u32x4*)(u + ro + DFF); }
#pragma unroll
      for (int i = 0; i < 8; ++i) {
        float g0[8], u0[8]; unpack8(G[i], g0); unpack8(U[i], u0);
        float o[8];
#pragma unroll
        for (int e = 0; e < 8; ++e) { const float yg = wg[0][e] * g2[e] + wg[1][e] * g1[e] + wg[2][e] * g0[e] + bg[e]; const float yu = wu[0][e] * u2[e] + wu[1][e] * u1[e] + wu[2][e] * u0[e] + bu[e];
          o[e] = gelu_tanh(yg) * yu; g2[e] = g1[e]; g1[e] = g0[e]; u2[e] = u1[e]; u1[e] = u0[e]; }
        u32x4 pk = {pack2(o[0], o[1]), pack2(o[2], o[3]), pack2(o[4], o[5]), pack2(o[6], o[7])};
        *(u32x4*)(act + (size_t)(r0 + rb * 8 + i) * DFF + ch) = pk;
      }
    }
  }
}

#define XB_TMO      128
#define XB_XCNT(j)  (256  + 64 * (j))
#define XB_XSUB(j)  (1280 + 64 * (j))
#define XB_XGEN(j)  (2304 + 64 * (j))
#define XB_TOP      3328
#define XB_TOPGEN   3392
#define XCD_BAR_WORDS 3456
#define XB_SPIN_CAP (1u << 18)
#define LAS __attribute__((address_space(3)))
DI unsigned xb_ld(unsigned* p)              { return __hip_atomic_load(p, __ATOMIC_RELAXED, __HIP_MEMORY_SCOPE_AGENT); }
DI unsigned xb_add(unsigned* p, unsigned v) { return __hip_atomic_fetch_add(p, v, __ATOMIC_RELAXED, __HIP_MEMORY_SCOPE_AGENT); }
DI unsigned xb_xcc_id() { return (unsigned)__builtin_amdgcn_s_getreg((3 << 11) | 20) & 0xFu; }
#define XB_SPIN(cond, bar) do { unsigned _sp = 0; while (cond) { __builtin_amdgcn_s_sleep(1); \
    if ((++_sp & 255u) == 0u) { if (xb_ld(&(bar)[XB_TMO])) break; if (_sp > XB_SPIN_CAP) { atomicAdd(&(bar)[XB_TMO], 1u); break; } } } } while (0)
struct XcdBarrier { unsigned* bar; unsigned x; volatile LAS unsigned* st; };
DI XcdBarrier xcd_barrier_post(unsigned* bar, volatile LAS unsigned* st) {
  XcdBarrier b; b.bar = bar; b.x = xb_xcc_id(); b.st = st;
  if (threadIdx.x == 0) (void)xb_add(&bar[XB_XCNT(b.x)], 1u);
  return b;
}
DI void xcd_barrier_complete(unsigned* bar, unsigned x, unsigned& nloc, unsigned& nx) {
  const unsigned G = gridDim.x * gridDim.y * gridDim.z;
  unsigned sum, cnt, mine, sp = 0u;
  for (;;) {
    sum = 0u; cnt = 0u; mine = 0u;
#pragma unroll
    for (unsigned j = 0; j < 16; ++j) { const unsigned c = xb_ld(&bar[XB_XCNT(j)]); sum += c; cnt += (c > 0u) ? 1u : 0u; mine = (j == x) ? c : mine; }
    if (sum == G) break;
    __builtin_amdgcn_s_sleep(1);
    if ((++sp & 255u) == 0u) { if (xb_ld(&bar[XB_TMO])) break; if (sp > XB_SPIN_CAP) { atomicAdd(&bar[XB_TMO], 1u); break; } }
  }
  nloc = mine > 0u ? mine : 1u; nx = cnt > 0u ? cnt : 1u;
}
DI void xcd_barrier(char* ws_, char* smem_) {
  XcdBarrier b; b.bar = (unsigned*)(ws_ + OFF_XBAR); b.x = xb_xcc_id(); b.st = (volatile LAS unsigned*)(smem_ + 159760);
  asm volatile("s_waitcnt vmcnt(0)" ::: "memory");
  __syncthreads();
  if (threadIdx.x == 0) {
    unsigned* bar = b.bar;
    __builtin_amdgcn_s_waitcnt(0);
    unsigned nloc = b.st[0], nx = b.st[1];
    if (nloc == 0u) { xcd_barrier_complete(bar, b.x, nloc, nx); b.st[0] = nloc; b.st[1] = nx; }
    const unsigned old = xb_add(&bar[XB_XSUB(b.x)], 1u);
    const unsigned gen = old / nloc;
    if (old + 1u == (gen + 1u) * nloc) {
      __builtin_amdgcn_fence(__ATOMIC_RELEASE, "agent");
      asm volatile("s_waitcnt vmcnt(0)" ::: "memory");
      const unsigned og = xb_add(&bar[XB_TOP], 1u);
      const unsigned tg = og / nx;
      if (og + 1u == (tg + 1u) * nx) xb_add(&bar[XB_TOPGEN], 1u);
      else XB_SPIN(xb_ld(&bar[XB_TOPGEN]) == tg, bar);
      __builtin_amdgcn_fence(__ATOMIC_ACQUIRE, "agent");
      xb_add(&bar[XB_XGEN(b.x)], 1u);
      asm volatile("s_waitcnt vmcnt(0)" ::: "memory");
    } else {
      XB_SPIN(xb_ld(&bar[XB_XGEN(b.x)]) == gen, bar);
      __builtin_amdgcn_fence(__ATOMIC_ACQUIRE, "agent");
      asm volatile("s_waitcnt vmcnt(0)" ::: "memory");
    }
  }
  __syncthreads();
}

__global__ void __launch_bounds__(NT) fwd_megakernel(Params P0) {
  cg::grid_group grid = cg::this_grid();
  __shared__ __attribute__((aligned(16))) char smem[160512];
  const int tid = threadIdx.x;
  char* ws = P0.ws;
  int* ctrl = (int*)(ws + OFF_CTRL);
  if (blockIdx.x == 0 && tid < 64) ctrl[tid] = 0;
  if (blockIdx.x == 0) for (int i = tid; i < XCD_BAR_WORDS; i += NT) ((unsigned*)(ws + OFF_XBAR))[i] = 0u;
  if (tid < 4) ((unsigned*)(smem + 159760))[tid] = 0u;
  if (blockIdx.x == 0 && tid == 0) *(Params*)(ws + OFF_CTRL + 1024) = P0;
  bf16_t* Hb = (bf16_t*)(ws + OFF_H);
  for (int it = blockIdx.x; it < 192 + CV_T5; it += gridDim.x) { if (it < 192) mod_item(P0, it); else convert_item(P0, 0, it - 192, smem); }
  grid.sync();
  (void)xcd_barrier_post((unsigned*)(ws + OFF_XBAR), (volatile LAS unsigned*)(smem + 159760));
  const Params& P = *(const Params*)(ws + OFF_CTRL + 1024);
  rownorm_phase(P, P.x, nullptr, P.out, Hb, 0, 0, nullptr, 0, 1, 0, P.mix_pre, smem);
  xcd_barrier(ws, smem);
  for (int l = 0; l < 2; ++l) {
    { EpiProj epi{(bf16_t*)(ws + OFF_PROJ), (float*)(ws + OFF_AB)}; gemm_phase(Hb, 2048, (const bf16_t*)(ws + OFF_W + W_IN), 2048, 2048, 64, 22, smem, epi); }
    xcd_barrier(ws, smem);
    for (int it = blockIdx.x; it < 448; it += gridDim.x) {
      if (it < 192) mla_q_tile(P, it / 3, it % 3, smem);
      else mla_kv_tile(P, (it - 192) >> 2, (it - 192) & 3, smem);
    }
    for (int id = (blockIdx.x + 64) % gridDim.x; id < 2048; id += gridDim.x) gdn_prep_item(P, l, id >> 3, id & 7, smem);
    xcd_barrier(ws, smem);
    {
      int* sitem = (int*)(smem + 159744);
      for (;;) {
        if (tid == 0) *sitem = atomicAdd(ctrl + 16 * l, 1);
        __syncthreads(); const int item = *sitem; __syncthreads();
        if (item >= 16 + 512 + 256) break;
        if (item < 16) gdn_scan_item(P, l, item >> 1, item & 1, smem);
        else if (item < 528) { const int idx = item - 16; mla_attn_item(P, idx & 3, 127 - (idx >> 2), smem); }
        else { const int idx = item - 528; swa_item(P, l, idx >> 1, idx & 1, smem); }
      }
    }
    xcd_barrier(ws, smem);
    gdn_fix_phase(P);
    xcd_barrier(ws, smem);
    { EpiBf epi{(bf16_t*)(ws + OFF_MIXF), 2048}; gemm_phase(Hb, 2048, (const bf16_t*)(ws + OFF_W + W_OUT), 2048, 2048, 64, 8, smem, epi); }
    xcd_barrier(ws, smem);
    rownorm_phase(P, P.out, (const bf16_t*)(ws + OFF_MIXF), P.out, Hb, l, 2, P.mix_post + l * 2048, l, 4, 3, P.ffn_pre + l * 2048, smem);
    xcd_barrier(ws, smem);
    { EpiBf epi{(bf16_t*)(ws + OFF_BIG), DFF2}; gemm_phase(Hb, 2048, (const bf16_t*)(ws + OFF_W + W_UP), 2048, 2048, 64, 44, smem, epi); }
    xcd_barrier(ws, smem);
    ffn_act_phase(P, l);
    xcd_barrier(ws, smem);
    { EpiBf epi{(bf16_t*)(ws + OFF_Y), 2048}; gemm_phase((const bf16_t*)(ws + OFF_ACT), DFF, (const bf16_t*)(ws + OFF_W + W_DOWN), DFF, DFF, 64, 8, smem, epi); }
    xcd_barrier(ws, smem);
    if (l == 0) {
      for (int it = blockIdx.x; it < CV_T5; it += gridDim.x) convert_item(P, 1, it, smem);
      rownorm_phase(P, P.out, (const bf16_t*)(ws + OFF_Y), P.out, Hb, 0, 5, P.ffn_post, 1, 1, 0, P.mix_pre + 2048, smem);
      xcd_barrier(ws, smem);
    } else {
      rownorm_phase(P, P.out, (const bf16_t*)(ws + OFF_Y), P.out, nullptr, 1, 5, P.ffn_post + 2048, 1, 1, 0, nullptr, smem);
    }
  }
}

extern "C" void kernel_launch(void* const* d_in, const int* in_sizes, int n_in, void* d_out, int out_size, void* d_ws, size_t ws_size, hipStream_t stream) {
  static int grid_blocks = 0;
  if (!grid_blocks) {
    int dev = 0, cus = 0, per = 0;
    (void)hipGetDevice(&dev); (void)hipDeviceGetAttribute(&cus, hipDeviceAttributeMultiprocessorCount, dev);
    (void)hipOccupancyMaxActiveBlocksPerMultiprocessor(&per, fwd_megakernel, NT, 0);
    if (per > 1) per = 1;
    grid_blocks = cus * per; if (grid_blocks <= 0) grid_blocks = 256;
  }
  if (ws_size < OFF_END) { fprintf(stderr, "workspace too small: %zu < %zu\n", ws_size, (size_t)OFF_END); return; }
  Params p{};
  p.x = (const float*)d_in[0]; p.c = (const float*)d_in[1]; p.pos = (const int*)d_in[2];
  p.ada_w = (const float*)d_in[3]; p.ada_b = (const float*)d_in[4]; p.mix_pre = (const float*)d_in[5]; p.mix_post = (const float*)d_in[6];
  p.w_in = (const float*)d_in[7]; p.w_out = (const float*)d_in[8]; p.gdn_conv = (const float*)d_in[9]; p.gdn_a_log = (const float*)d_in[10];
  p.gdn_dt_bias = (const float*)d_in[11]; p.gdn_norm = (const float*)d_in[12]; p.mla_q_norm = (const float*)d_in[13]; p.mla_w_uq = (const float*)d_in[14];
  p.mla_kv_norm = (const float*)d_in[15]; p.mla_w_ukv = (const float*)d_in[16]; p.swa_sinks = (const float*)d_in[17]; p.ffn_pre = (const float*)d_in[18];
  p.ffn_post = (const float*)d_in[19]; p.ffn_w_up = (const float*)d_in[20]; p.ffn_conv = (const float*)d_in[21]; p.ffn_conv_b = (const float*)d_in[22];
  p.ffn_w_down = (const float*)d_in[23];
  p.out = (float*)d_out; p.ws = (char*)d_ws;
  void* args[] = {&p};
  hipError_t e = hipLaunchCooperativeKernel((void*)fwd_megakernel, dim3(grid_blocks), dim3(NT), args, 0, stream);
  if (e != hipSuccess) fprintf(stderr, "cooperative launch failed: %s (grid %d)\n", hipGetErrorString(e), grid_blocks);
}
```

```cpp
#include <hip/hip_runtime.h>
#include <hip/hip_cooperative_groups.h>
#include <cstdio>
#include <cstdint>
namespace cg = cooperative_groups;

#define DI __device__ __forceinline__
typedef unsigned short bf16_t;
typedef short bf16x8 __attribute__((ext_vector_type(8)));
typedef float f32x2 __attribute__((ext_vector_type(2)));
typedef float f32x4 __attribute__((ext_vector_type(4)));
typedef float f32x16 __attribute__((ext_vector_type(16)));
typedef unsigned u32x2 __attribute__((ext_vector_type(2)));
typedef unsigned u32x4 __attribute__((ext_vector_type(4)));
typedef __bf16 bf2_t __attribute__((ext_vector_type(2)));

constexpr int S_ = 16384, D_ = 2048, DINP = 5632, DFF = 5632, DFF2 = 11264;
constexpr int NT = 512;
constexpr float EPS = 1e-6f;
constexpr float LOG2E = 1.4426950408889634f;

constexpr size_t OFF_CTRL = 0;
constexpr size_t OFF_MODP = 4096;
constexpr size_t OFF_XBAR = OFF_MODP + (size_t)2 * 16 * 12288 * 4;
constexpr size_t OFF_W = 2097152;
static_assert(OFF_XBAR + 3456 * 4 <= OFF_W, "xbar");
constexpr size_t W_IN = 0, W_OUT = W_IN + (size_t)5632 * 2048 * 2, W_UP = W_OUT + (size_t)2048 * 2048 * 2,
                 W_DOWN = W_UP + (size_t)11264 * 2048 * 2, W_UQ = W_DOWN + (size_t)2048 * 5632 * 2,
                 W_UKV = W_UQ + (size_t)768 * 448 * 2, W_END = W_UKV + (size_t)1024 * 128 * 2;
constexpr size_t OFF_H = OFF_W + W_END;
constexpr size_t OFF_MIXF = OFF_H + (size_t)S_ * 2048 * 2;
constexpr size_t OFF_QRAW = OFF_MIXF;
constexpr size_t OFF_KMLA = OFF_QRAW + (size_t)S_ * 768 * 4;
constexpr size_t OFF_VT = OFF_KMLA + (size_t)4 * S_ * 192 * 2;
constexpr size_t OFF_BIG = OFF_MIXF + (size_t)S_ * 2048 * 4;
constexpr size_t OFF_PROJ = OFF_BIG;
constexpr size_t OFF_WP = OFF_PROJ + (size_t)S_ * DINP * 2;
constexpr size_t OFF_QD = OFF_WP + (size_t)S_ * 1024 * 2;
constexpr size_t OFF_KT = OFF_QD + (size_t)S_ * 1024 * 2;
constexpr size_t OFF_ZT = OFF_KT + (size_t)S_ * 1024 * 2;
constexpr size_t OFF_QK = OFF_ZT + (size_t)S_ * 1024 * 2;
constexpr size_t OFF_AB = OFF_QK + (size_t)S_ * 512 * 2;
constexpr size_t OFF_GTOT = OFF_AB + (size_t)S_ * 16 * 4;
constexpr size_t OFF_Y = OFF_BIG;
constexpr size_t OFF_ACT = OFF_H;
constexpr size_t OFF_UT = OFF_BIG + (size_t)S_ * DFF2 * 2;
constexpr size_t OFF_END = OFF_UT + (size_t)S_ * 1024 * 4;
static_assert(OFF_GTOT + 8192 <= OFF_UT, "overlay");
static_assert(OFF_VT + (size_t)4 * 128 * S_ * 2 <= OFF_BIG, "overlay2");

constexpr int C_AQ = 0, C_AK = 1024, C_AV = 2048, C_AZ = 3072, C_AA = 4096, C_BCQ = 4112, C_BCKV = 4560,
              C_BKR = 4688, C_CQ = 4752, C_CK = 5264, C_CV = 5392;

__constant__ double kInvFreq2Pi[32] = {
    0.15915494309189535, 0.11934937021124886, 0.08949940160889101, 0.06711508300522726, 0.050329212104487035, 0.03774158471741977,
    0.0283021958306234, 0.02122365276477766, 0.015915494309189534, 0.011934937021124886, 0.008949940160889102, 0.006711508300522725,
    0.005032921210448704, 0.003774158471741977, 0.00283021958306234, 0.0021223652764777662, 0.0015915494309189536, 0.0011934937021124885,
    0.0008949940160889102, 0.0006711508300522726, 0.0005032921210448703, 0.00037741584717419774, 0.00028302195830623395, 0.0002122365276477766,
    0.00015915494309189535, 0.00011934937021124886, 8.949940160889102e-05, 6.711508300522725e-05, 5.0329212104487035e-05, 3.774158471741978e-05,
    2.8302195830623396e-05, 2.122365276477766e-05};

struct Params {
  const float* x; const float* c; const int* pos;
  const float *ada_w, *ada_b, *mix_pre, *mix_post, *w_in, *w_out, *gdn_conv, *gdn_a_log, *gdn_dt_bias, *gdn_norm, *mla_q_norm, *mla_w_uq,
      *mla_kv_norm, *mla_w_ukv, *swa_sinks, *ffn_pre, *ffn_post, *ffn_w_up, *ffn_conv, *ffn_conv_b, *ffn_w_down;
  float* out; char* ws;
};

DI unsigned pack2(float lo, float hi) { f32x2 v = {lo, hi}; bf2_t b = __builtin_convertvector(v, bf2_t); return __builtin_bit_cast(unsigned, b); }
DI bf16_t f2bf(float x) { return (bf16_t)(pack2(x, 0.f) & 0xffffu); }
DI float bflo(unsigned u) { return __uint_as_float(u << 16); }
DI float bfhi(unsigned u) { return __uint_as_float(u & 0xffff0000u); }
DI void unpack8(const u32x4& v, float* f) { f[0] = bflo(v.x); f[1] = bfhi(v.x); f[2] = bflo(v.y); f[3] = bfhi(v.y); f[4] = bflo(v.z); f[5] = bfhi(v.z); f[6] = bflo(v.w); f[7] = bfhi(v.w); }
DI bf16x8 pack8(float a0, float a1, float a2, float a3, float a4, float a5, float a6, float a7) {
  u32x4 p = {pack2(a0, a1), pack2(a2, a3), pack2(a4, a5), pack2(a6, a7)}; return __builtin_bit_cast(bf16x8, p); }
DI float silu_f(float x) { return x * __builtin_amdgcn_rcpf(1.f + __expf(-x)); }
DI float wave_sum(float v) { v += __shfl_xor(v, 32); v += __shfl_xor(v, 16); v += __shfl_xor(v, 8); v += __shfl_xor(v, 4); v += __shfl_xor(v, 2); v += __shfl_xor(v, 1); return v; }
DI int opaque_tid() { int t = threadIdx.x; asm volatile("" : "+v"(t)); return t; }
DI float xhalf_max(float v) { const auto r = __builtin_amdgcn_permlane32_swap(__float_as_uint(v), __float_as_uint(v), false, false); return fmaxf(__uint_as_float(r[0]), __uint_as_float(r[1])); }
DI int crow(int r, int h) { return (r & 3) + 8 * (r >> 2) + 4 * h; }
DI int perm32(int k) { return 8 * ((k >> 2) & 3) + 4 * (k >> 4) + (k & 3); }
#define MFMA32(a, b, c) __builtin_amdgcn_mfma_f32_32x32x16_bf16((a), (b), (c), 0, 0, 0)
#define MFMA16(a, b, c) __builtin_amdgcn_mfma_f32_16x16x32_bf16((a), (b), (c), 0, 0, 0)

template <class Epi>
DI void gemm_tile(const bf16_t* __restrict__ A, int lda, const bf16_t* __restrict__ Bt, int ldb, int K, int m0, int n0, char* smem, const Epi& epi) {
  const int tid = opaque_tid(), lane = tid & 63, w = tid >> 6, wm = w >> 2, wn = w & 3, lq = lane & 31, h = lane >> 5;
  f32x16 acc[2][4];
#pragma unroll
  for (int i = 0; i < 2; ++i)
#pragma unroll
    for (int j = 0; j < 4; ++j)
#pragma unroll
      for (int r = 0; r < 16; ++r) acc[i][j][r] = 0.f;
  const int r0 = tid >> 3, c0 = tid & 7;
  const bf16_t* ag = A + (size_t)(m0 + r0) * lda + c0 * 8;
  const bf16_t* bg = Bt + (size_t)(n0 + r0) * ldb + c0 * 8;
  const int wofs = r0 * 128 + ((c0 ^ ((r0 >> 1) & 7)) << 4);
  char* sA = smem; char* sB = smem + 65536;
  u32x4 ra0[4], rb0[4], ra1[4], rb1[4];
  const int nk = K >> 6, swz = (lane >> 1) & 7;
  const int aoff = (64 * wn + lq) * 128, boff = (128 * wm + lq) * 128;
#define GLOAD(RA, RB, KT) { _Pragma("unroll") for (int i = 0; i < 4; ++i) { RA[i] = *(const u32x4*)(ag + (size_t)(KT) * 64 + (size_t)i * 64 * lda); RB[i] = *(const u32x4*)(bg + (size_t)(KT) * 64 + (size_t)i * 64 * ldb); } }
#define LWRITE(RA, RB, ST) { _Pragma("unroll") for (int i = 0; i < 4; ++i) { *(u32x4*)(sA + (ST) * 32768 + wofs + i * 8192) = RA[i]; *(u32x4*)(sB + (ST) * 32768 + wofs + i * 8192) = RB[i]; } }
#define KSTEP(ST, RA, RB, KN) { const char* cA = sA + (ST) * 32768; const char* cB = sB + (ST) * 32768; char* dA = sA + (1 - (ST)) * 32768; char* dB = sB + (1 - (ST)) * 32768; \
    const bf16_t* agn = ag + (size_t)(KN) * 64; const bf16_t* bgn = bg + (size_t)(KN) * 64; \
    _Pragma("unroll") for (int s = 0; s < 4; ++s) { const int co = (((2 * s + h) ^ swz) << 4); bf16x8 fa[2], fb[4]; \
      _Pragma("unroll") for (int ni = 0; ni < 2; ++ni) fa[ni] = *(const bf16x8*)(cB + aoff + ni * 4096 + co); \
      _Pragma("unroll") for (int mi = 0; mi < 4; ++mi) fb[mi] = *(const bf16x8*)(cA + boff + mi * 4096 + co); \
      *(u32x4*)(dA + wofs + s * 8192) = RA[s]; *(u32x4*)(dB + wofs + s * 8192) = RB[s]; \
      RA[s] = *(const u32x4*)(agn + (size_t)s * 64 * lda); RB[s] = *(const u32x4*)(bgn + (size_t)s * 64 * ldb); \
      _Pragma("unroll") for (int ni = 0; ni < 2; ++ni) _Pragma("unroll") for (int mi = 0; mi < 4; ++mi) acc[ni][mi] = MFMA32(fa[ni], fb[mi], acc[ni][mi]); \
      __builtin_amdgcn_sched_barrier(0); } }
  const int kl = nk - 1;
  GLOAD(ra0, rb0, 0);
  GLOAD(ra1, rb1, (1 < kl ? 1 : kl));
  LWRITE(ra0, rb0, 0);
  GLOAD(ra0, rb0, (2 < kl ? 2 : kl));
  __syncthreads();
  for (int kt = 0; kt < nk; kt += 2) {
    KSTEP(0, ra1, rb1, (kt + 3 < kl ? kt + 3 : kl));
    __syncthreads();
    if (kt + 1 < nk) {
      KSTEP(1, ra0, rb0, (kt + 4 < kl ? kt + 4 : kl));
      __syncthreads();
    }
  }
#undef GLOAD
#undef LWRITE
#undef KSTEP
#pragma unroll
  for (int ni = 0; ni < 2; ++ni)
#pragma unroll
    for (int mi = 0; mi < 4; ++mi)
#pragma unroll
      for (int rg = 0; rg < 4; ++rg) {
        const int m = m0 + 128 * wm + 32 * mi + lq, n = n0 + 64 * wn + 32 * ni + 8 * rg + 4 * h;
        epi(m, n, acc[ni][mi][4 * rg], acc[ni][mi][4 * rg + 1], acc[ni][mi][4 * rg + 2], acc[ni][mi][4 * rg + 3]);
      }
}

template <class Epi>
DI void gemm_tile_s(const bf16_t* __restrict__ A, int lda, const bf16_t* __restrict__ Bt, int ldb, int K, int m0, int n0, char* smem, const Epi& epi) {
  const int tid = opaque_tid(), lane = tid & 63, w = tid >> 6, wm = w >> 2, wn = w & 3, lq = lane & 31, h = lane >> 5;
  f32x16 acc[2][4];
#pragma unroll
  for (int i = 0; i < 2; ++i)
#pragma unroll
    for (int j = 0; j < 4; ++j)
#pragma unroll
      for (int r = 0; r < 16; ++r) acc[i][j][r] = 0.f;
  const int r0 = tid >> 3, c0 = tid & 7;
  const bf16_t* ag = A + (size_t)(m0 + r0) * lda + c0 * 8;
  const bf16_t* bg = Bt + (size_t)(n0 + r0) * ldb + c0 * 8;
  const int wofs = r0 * 128 + ((c0 ^ ((r0 >> 1) & 7)) << 4);
  char* sA = smem; char* sB = smem + 32768;
  u32x4 ra[4], rb[4];
#pragma unroll
  for (int i = 0; i < 4; ++i) { ra[i] = *(const u32x4*)(ag + (size_t)i * 64 * lda); rb[i] = *(const u32x4*)(bg + (size_t)i * 64 * ldb); }
#pragma unroll
  for (int i = 0; i < 4; ++i) { *(u32x4*)(sA + wofs + i * 8192) = ra[i]; *(u32x4*)(sB + wofs + i * 8192) = rb[i]; }
  __syncthreads();
  const int nk = K >> 6, swz = (lane >> 1) & 7;
  const int aoff = (64 * wn + lq) * 128, boff = (128 * wm + lq) * 128;
  for (int kt = 0; kt < nk; ++kt) {
    const char* cA = sA + (kt & 1) * 65536; const char* cB = sB + (kt & 1) * 65536;
    const bool more = (kt + 1 < nk);
    if (more) { ag += 64; bg += 64;
#pragma unroll
      for (int i = 0; i < 4; ++i) { ra[i] = *(const u32x4*)(ag + (size_t)i * 64 * lda); rb[i] = *(const u32x4*)(bg + (size_t)i * 64 * ldb); } }
#pragma unroll
    for (int s = 0; s < 4; ++s) {
      const int co = (((2 * s + h) ^ swz) << 4);
      bf16x8 fa[2], fb[4];
#pragma unroll
      for (int ni = 0; ni < 2; ++ni) fa[ni] = *(const bf16x8*)(cB + aoff + ni * 4096 + co);
#pragma unroll
      for (int mi = 0; mi < 4; ++mi) fb[mi] = *(const bf16x8*)(cA + boff + mi * 4096 + co);
#pragma unroll
      for (int ni = 0; ni < 2; ++ni)
#pragma unroll
        for (int mi = 0; mi < 4; ++mi) acc[ni][mi] = MFMA32(fa[ni], fb[mi], acc[ni][mi]);
    }
    if (more) { char* dA = sA + ((kt + 1) & 1) * 65536; char* dB = sB + ((kt + 1) & 1) * 65536;
#pragma unroll
      for (int i = 0; i < 4; ++i) { *(u32x4*)(dA + wofs + i * 8192) = ra[i]; *(u32x4*)(dB + wofs + i * 8192) = rb[i]; } }
    __syncthreads();
  }
#pragma unroll
  for (int ni = 0; ni < 2; ++ni)
#pragma unroll
    for (int mi = 0; mi < 4; ++mi)
#pragma unroll
      for (int rg = 0; rg < 4; ++rg) {
        const int m = m0 + 128 * wm + 32 * mi + lq, n = n0 + 64 * wn + 32 * ni + 8 * rg + 4 * h;
        epi(m, n, acc[ni][mi][4 * rg], acc[ni][mi][4 * rg + 1], acc[ni][mi][4 * rg + 2], acc[ni][mi][4 * rg + 3]);
      }
}

DI void tile_coord(int t, int npn, int& pm, int& pn) { const int g = t / (16 * npn), r = t % (16 * npn); pn = r >> 4; pm = g * 16 + (r & 15); }

struct EpiProj { bf16_t* proj; float* ab;
  DI void operator()(int m, int n, float v0, float v1, float v2, float v3) const {
    u32x2 pk = {pack2(v0, v1), pack2(v2, v3)}; *(u32x2*)(proj + (size_t)m * DINP + n) = pk;
    if (n >= C_AA && n < C_AA + 16) { f32x4 v = {v0, v1, v2, v3}; *(f32x4*)(ab + (size_t)m * 16 + (n - C_AA)) = v; } } };
struct EpiF32 { float* out; int ldc;
  DI void operator()(int m, int n, float v0, float v1, float v2, float v3) const { f32x4 v = {v0, v1, v2, v3}; *(f32x4*)(out + (size_t)m * ldc + n) = v; } };
struct EpiBf { bf16_t* out; int ldc;
  DI void operator()(int m, int n, float v0, float v1, float v2, float v3) const { u32x2 pk = {pack2(v0, v1), pack2(v2, v3)}; *(u32x2*)(out + (size_t)m * ldc + n) = pk; } };
struct EpiMlaQ { float* qraw; const float* rs; int m0;
  DI void operator()(int m, int n, float v0, float v1, float v2, float v3) const { const float r = rs[m - m0]; f32x4 v = {v0 * r, v1 * r, v2 * r, v3 * r}; *(f32x4*)(qraw + (size_t)m * 768 + n) = v; } };
struct EpiMlaKV { bf16_t* kmla; bf16_t* vt; const float* rs; int m0;
  DI void operator()(int m, int n, float v0, float v1, float v2, float v3) const {
    const float r = rs[m - m0]; const int hd = n >> 8, wi = n & 255;
    if (wi < 128) { u32x2 pk = {pack2(v0 * r, v1 * r), pack2(v2 * r, v3 * r)}; *(u32x2*)(kmla + ((size_t)hd * S_ + m) * 192 + wi) = pk; }
    else { bf16_t* p = vt + ((size_t)hd * 128 + (wi - 128)) * S_ + m; p[0] = f2bf(v0 * r); p[S_] = f2bf(v1 * r); p[2 * (size_t)S_] = f2bf(v2 * r); p[3 * (size_t)S_] = f2bf(v3 * r); } } };

template <class Epi>
DI void gemm_phase(const bf16_t* A, int lda, const bf16_t* Bt, int ldb, int K, int npm, int npn, char* smem, const Epi& epi) {
  if (gridDim.x == 256 && npm == 64) {
    const int b = blockIdx.x, pm = 8 * (b & 7) + ((b >> 3) & 7), pj = b >> 6;
    for (int pn = pj; pn < npn; pn += 4) gemm_tile(A, lda, Bt, ldb, K, pm * 256, pn * 256, smem, epi);
  } else {
    for (int t = blockIdx.x; t < npm * npn; t += gridDim.x) { int pm, pn; tile_coord(t, npn, pm, pn); gemm_tile(A, lda, Bt, ldb, K, pm * 256, pn * 256, smem, epi); }
  }
}

DI void mod_item(const Params& P, int item) {
  const int tid = opaque_tid(); const int l = item / 96, r = item % 96, ks = r / 6, nc = r % 6;
  const int n = nc * 2048 + tid * 4;
  const float* wp = P.ada_w + ((size_t)l * 2048 + ks * 128) * 12288 + n;
  f32x4 acc = {0.f, 0.f, 0.f, 0.f};
#pragma unroll 8
  for (int k = 0; k < 128; ++k) { const float cv = P.c[ks * 128 + k]; const float ca = silu_f(cv); const f32x4 wv = *(const f32x4*)(wp + (size_t)k * 12288); acc += wv * ca; }
  float* modp = (float*)(P.ws + OFF_MODP);
  *(f32x4*)(modp + ((size_t)l * 16 + ks) * 12288 + n) = acc;
}
DI void convert_tile(const float* __restrict__ src, int K, int N, bf16_t* __restrict__ dst, int tk, int tn, const float* rowscale, char* smem) {
  float* sm = (float*)smem; const int tid = opaque_tid(); const int k0 = tk * 64, n0 = tn * 256;
  { const int r = tid >> 6, c4 = tid & 63; const int n = n0 + 4 * c4;
    f32x4 v[8];
#pragma unroll
    for (int i = 0; i < 8; ++i) { v[i] = (f32x4){0.f, 0.f, 0.f, 0.f}; if (n < N) v[i] = *(const f32x4*)(src + (size_t)(k0 + r + 8 * i) * N + n); }
#pragma unroll
    for (int i = 0; i < 8; ++i) { const int kk = r + 8 * i; if (rowscale) v[i] *= rowscale[k0 + kk];
      sm[kk * 257 + 4 * c4 + 0] = v[i].x; sm[kk * 257 + 4 * c4 + 1] = v[i].y; sm[kk * 257 + 4 * c4 + 2] = v[i].z; sm[kk * 257 + 4 * c4 + 3] = v[i].w; } }
  __syncthreads();
  { const int n = tid >> 1, kh = tid & 1;
#pragma unroll
    for (int j = 0; j < 4; ++j) { float f[8];
#pragma unroll
      for (int i = 0; i < 8; ++i) f[i] = sm[(32 * kh + 8 * j + i) * 257 + n];
      u32x4 pk = {pack2(f[0], f[1]), pack2(f[2], f[3]), pack2(f[4], f[5]), pack2(f[6], f[7])};
      *(u32x4*)(dst + (size_t)(n0 + n) * K + k0 + 32 * kh + 8 * j) = pk; } }
  __syncthreads();
}
constexpr int CV_T0 = 32 * 22, CV_T1 = CV_T0 + 32 * 8, CV_T2 = CV_T1 + 32 * 44, CV_T3 = CV_T2 + 88 * 8, CV_T4 = CV_T3 + 7 * 3, CV_T5 = CV_T4 + 2 * 4;
DI void convert_item(const Params& P, int l, int it, char* smem) {
  char* wb = P.ws + OFF_W;
  if (it < CV_T0) convert_tile(P.w_in + (size_t)l * 2048 * 5520, 2048, 5520, (bf16_t*)(wb + W_IN), it / 22, it % 22, nullptr, smem);
  else if (it < CV_T1) { it -= CV_T0; convert_tile(P.w_out + (size_t)l * 2048 * 2048, 2048, 2048, (bf16_t*)(wb + W_OUT), it / 8, it % 8, nullptr, smem); }
  else if (it < CV_T2) { it -= CV_T1; convert_tile(P.ffn_w_up + (size_t)l * 2048 * 11264, 2048, 11264, (bf16_t*)(wb + W_UP), it / 44, it % 44, nullptr, smem); }
  else if (it < CV_T3) { it -= CV_T2; convert_tile(P.ffn_w_down + (size_t)l * 5632 * 2048, 5632, 2048, (bf16_t*)(wb + W_DOWN), it / 8, it % 8, nullptr, smem); }
  else if (it < CV_T4) { it -= CV_T3; convert_tile(P.mla_w_uq + (size_t)l * 448 * 768, 448, 768, (bf16_t*)(wb + W_UQ), it / 3, it % 3, P.mla_q_norm + l * 448, smem); }
  else { it -= CV_T4; convert_tile(P.mla_w_ukv + (size_t)l * 128 * 1024, 128, 1024, (bf16_t*)(wb + W_UKV), it / 4, it % 4, P.mla_kv_norm + l * 128, smem); }
}

DI float mod_val(const float* modp_l, const float* ada_b_l, int idx) { float s = ada_b_l[idx];
#pragma unroll
  for (int k = 0; k < 16; ++k) s += modp_l[(size_t)k * 12288 + idx]; return s; }
DI void rownorm_phase(const Params& P, const float* xin, const bf16_t* yin, float* xout, bf16_t* hout, int lg, int gate_idx, const float* w_post,
                      int lh, int scale_idx, int shift_idx, const float* w_pre, char* smem) {
  float* A1 = (float*)smem; float* A2 = A1 + 2048; float* B2 = A2 + 2048;
  const int tid = opaque_tid(), lane = tid & 63, w = tid >> 6;
  const float* modp = (const float*)(P.ws + OFF_MODP);
  for (int cidx = tid; cidx < 2048; cidx += NT) {
    if (yin) A1[cidx] = mod_val(modp + (size_t)lg * 16 * 12288, P.ada_b + (size_t)lg * 12288, gate_idx * 2048 + cidx) * w_post[cidx];
    if (hout) { A2[cidx] = w_pre[cidx] * (1.f + mod_val(modp + (size_t)lh * 16 * 12288, P.ada_b + (size_t)lh * 12288, scale_idx * 2048 + cidx));
      B2[cidx] = mod_val(modp + (size_t)lh * 16 * 12288, P.ada_b + (size_t)lh * 12288, shift_idx * 2048 + cidx); }
  }
  __syncthreads();
  for (int row = blockIdx.x * 8 + w; row < S_; row += gridDim.x * 8) {
    f32x4 xv[8];
#pragma unroll
    for (int j = 0; j < 8; ++j) xv[j] = *(const f32x4*)(xin + (size_t)row * 2048 + (j * 64 + lane) * 4);
    if (yin) {
      f32x4 yv[8]; float ss = 0.f;
#pragma unroll
      for (int j = 0; j < 8; ++j) { const u32x2 yb = *(const u32x2*)(yin + (size_t)row * 2048 + (j * 64 + lane) * 4); yv[j] = (f32x4){bflo(yb.x), bfhi(yb.x), bflo(yb.y), bfhi(yb.y)};
        ss += yv[j].x * yv[j].x + yv[j].y * yv[j].y + yv[j].z * yv[j].z + yv[j].w * yv[j].w; }
      ss = wave_sum(ss); const float r = rsqrtf(ss * (1.f / 2048.f) + EPS);
#pragma unroll
      for (int j = 0; j < 8; ++j) { const f32x4 a = *(const f32x4*)(A1 + (j * 64 + lane) * 4); xv[j] += a * (yv[j] * r); }
    }
    if (yin || xout != xin) {
#pragma unroll
      for (int j = 0; j < 8; ++j) *(f32x4*)(xout + (size_t)row * 2048 + (j * 64 + lane) * 4) = xv[j];
    }
    if (hout) {
      float ss = 0.f;
#pragma unroll
      for (int j = 0; j < 8; ++j) ss += xv[j].x * xv[j].x + xv[j].y * xv[j].y + xv[j].z * xv[j].z + xv[j].w * xv[j].w;
      ss = wave_sum(ss); const float r = rsqrtf(ss * (1.f / 2048.f) + EPS);
#pragma unroll
      for (int j = 0; j < 8; ++j) { const f32x4 a = *(const f32x4*)(A2 + (j * 64 + lane) * 4), b = *(const f32x4*)(B2 + (j * 64 + lane) * 4);
        const f32x4 hv = xv[j] * r * a + b; u32x2 pk = {pack2(hv.x, hv.y), pack2(hv.z, hv.w)};
        *(u32x2*)(hout + (size_t)row * 2048 + (j * 64 + lane) * 4) = pk; }
    }
  }
  __syncthreads();
}

DI void mla_q_tile(const Params& P, int pm, int pn, char* smem) {
  const bf16_t* proj = (const bf16_t*)(P.ws + OFF_PROJ); const int tid = opaque_tid(), m0 = pm * 256; float* rs = (float*)(smem + 131072);
  { const int row = tid >> 1, half = tid & 1; const bf16_t* p = proj + (size_t)(m0 + row) * DINP + C_BCQ + half * 224; float ss = 0.f;
    for (int i = 0; i < 28; ++i) { const u32x4 v = *(const u32x4*)(p + i * 8); float f[8]; unpack8(v, f);
#pragma unroll
      for (int e = 0; e < 8; ++e) ss += f[e] * f[e]; }
    ss += __shfl_xor(ss, 1); if (half == 0) rs[row] = rsqrtf(ss * (1.f / 448.f) + EPS); }
  EpiMlaQ epi{(float*)(P.ws + OFF_QRAW), rs, m0};
  gemm_tile_s(proj + C_BCQ, DINP, (const bf16_t*)(P.ws + OFF_W + W_UQ), 448, 448, m0, pn * 256, smem, epi);
  __syncthreads();
}
DI void mla_kv_tile(const Params& P, int pm, int pn, char* smem) {
  const bf16_t* proj = (const bf16_t*)(P.ws + OFF_PROJ); const int tid = opaque_tid(), m0 = pm * 256; float* rs = (float*)(smem + 131072);
  { const int row = tid >> 1, half = tid & 1; const bf16_t* p = proj + (size_t)(m0 + row) * DINP + C_BCKV + half * 64; float ss = 0.f;
#pragma unroll
    for (int i = 0; i < 8; ++i) { const u32x4 v = *(const u32x4*)(p + i * 8); float f[8]; unpack8(v, f);
#pragma unroll
      for (int e = 0; e < 8; ++e) ss += f[e] * f[e]; }
    ss += __shfl_xor(ss, 1); if (half == 0) rs[row] = rsqrtf(ss * (1.f / 128.f) + EPS); }
  bf16_t* kmla = (bf16_t*)(P.ws + OFF_KMLA);
  EpiMlaKV epi{kmla, (bf16_t*)(P.ws + OFF_VT), rs, m0};
  gemm_tile_s(proj + C_BCKV, DINP, (const bf16_t*)(P.ws + OFF_W + W_UKV), 128, 128, m0, pn * 256, smem, epi);
  if (pn == 0) {
    for (int i = 0; i < 16; ++i) { const int idx = tid + NT * i, row = idx >> 5, pi = idx & 31, m = m0 + row;
      const float x1 = bflo((unsigned)proj[(size_t)m * DINP + C_BKR + pi]), x2 = bflo((unsigned)proj[(size_t)m * DINP + C_BKR + 32 + pi]);
      double fr = (double)P.pos[m] * kInvFreq2Pi[pi]; fr -= floor(fr); const float ff = (float)fr;
      const float sn = __builtin_amdgcn_sinf(ff), cs = __builtin_amdgcn_cosf(ff);
      const bf16_t o1 = f2bf(x1 * cs - x2 * sn), o2 = f2bf(x2 * cs + x1 * sn);
#pragma unroll
      for (int hd = 0; hd < 4; ++hd) { bf16_t* kp = kmla + ((size_t)hd * S_ + m) * 192 + 128; kp[pi] = o1; kp[32 + pi] = o2; } }
  }
  __syncthreads();
}

DI void gdn_prep_item(const Params& P, int l, int n, int hh, char* smem) {
  const int tid = opaque_tid(), lane = tid & 63, w = tid >> 6, lq = lane & 31, h = lane >> 5;
  const bf16_t* proj = (const bf16_t*)(P.ws + OFF_PROJ); const float* ab = (const float*)(P.ws + OFF_AB);
  char* kb16 = smem; char* qb16 = smem + 17408;
  float* kf = (float*)(smem + 34816); float* vf = kf + 8192; float* Lm = vf + 8192; float* gcs = Lm + 4096;
  const size_t tile = (size_t)hh * 256 + n; const int t0 = n * 64;
  bf16_t* Wp = (bf16_t*)(P.ws + OFF_WP) + tile * 8192; bf16_t* Qd = (bf16_t*)(P.ws + OFF_QD) + tile * 8192;
  bf16_t* Kt = (bf16_t*)(P.ws + OFF_KT) + tile * 8192; bf16_t* Zt = (bf16_t*)(P.ws + OFF_ZT) + tile * 8192;
  bf16_t* QK = (bf16_t*)(P.ws + OFF_QK) + tile * 4096; bf16_t* Ut = (bf16_t*)(P.ws + OFF_UT) + tile * 8192;
  if (w == 0) {
    const int t = lane; const float a_raw = ab[(size_t)(t0 + t) * 16 + hh], b_raw = ab[(size_t)(t0 + t) * 16 + 8 + hh];
    const float Aa = __expf(P.gdn_a_log[l * 8 + hh]); const float xb = a_raw + P.gdn_dt_bias[l * 8 + hh];
    const float ex = __expf(fminf(xb, 20.f));
    const float sp = xb > 20.f ? xb : (ex < 0.01f ? ex * (1.f - ex * (0.5f - ex * (1.f / 3.f))) : __logf(1.f + ex));
    float g = -Aa * sp;
#pragma unroll
    for (int d = 1; d < 64; d <<= 1) { const float v = __shfl_up(g, d); if (lane >= d) g += v; }
    const float bt = __builtin_amdgcn_rcpf(1.f + __expf(-b_raw)), eg = __expf(g); gcs[t] = g; gcs[64 + t] = bt; gcs[128 + t] = eg; gcs[192 + t] = bt * eg;
    if (t == 63) ((float*)(P.ws + OFF_GTOT))[tile] = eg;
  }
  __syncthreads();
  {
    const int t = tid >> 3, part = tid & 7, tabs = t0 + t;
    const float gct = gcs[t], egct = gcs[128 + t], ktl = __expf(gcs[63] - gct);
    const int pjt = 32 * (t >> 5) + perm32(t & 31);
#pragma unroll
    for (int X = 0; X < 3; ++X) {
      const int cb = X * 1024 + hh * 128 + part * 16;
      float y[16];
#pragma unroll
      for (int e = 0; e < 16; ++e) y[e] = 0.f;
      u32x4 pv[4][2]; f32x4 wv[4][4];
#pragma unroll
      for (int j = 0; j < 4; ++j) { const int row = tabs - 3 + j, rr = row < 0 ? 0 : row;
        pv[j][0] = *(const u32x4*)(proj + (size_t)rr * DINP + cb); pv[j][1] = *(const u32x4*)(proj + (size_t)rr * DINP + cb + 8);
        const float* cw = P.gdn_conv + ((size_t)l * 4 + j) * 3072 + cb;
#pragma unroll
        for (int e4 = 0; e4 < 4; ++e4) wv[j][e4] = *(const f32x4*)(cw + 4 * e4); }
      __builtin_amdgcn_sched_barrier(0);
#pragma unroll
      for (int j = 0; j < 4; ++j) { const float msk = (tabs - 3 + j) >= 0 ? 1.f : 0.f;
        float xv[16]; unpack8(pv[j][0], xv); unpack8(pv[j][1], xv + 8);
#pragma unroll
        for (int e4 = 0; e4 < 4; ++e4) { const f32x4 wm = wv[j][e4] * msk; y[4 * e4] += wm.x * xv[4 * e4]; y[4 * e4 + 1] += wm.y * xv[4 * e4 + 1]; y[4 * e4 + 2] += wm.z * xv[4 * e4 + 2]; y[4 * e4 + 3] += wm.w * xv[4 * e4 + 3]; } }
#pragma unroll
      for (int e = 0; e < 16; ++e) y[e] = silu_f(y[e]);
      if (X < 2) { float ss = 0.f;
#pragma unroll
        for (int e = 0; e < 16; ++e) ss += y[e] * y[e];
        ss += __shfl_xor(ss, 1); ss += __shfl_xor(ss, 2); ss += __shfl_xor(ss, 4);
        const float rn = rsqrtf(ss + EPS) * (X == 0 ? 0.08838834764831845f : 1.f);
#pragma unroll
        for (int e = 0; e < 16; ++e) y[e] *= rn; }
      if (X == 0) {
        u32x4 p0 = {pack2(y[0], y[1]), pack2(y[2], y[3]), pack2(y[4], y[5]), pack2(y[6], y[7])}, p1 = {pack2(y[8], y[9]), pack2(y[10], y[11]), pack2(y[12], y[13]), pack2(y[14], y[15])};
        *(u32x4*)(qb16 + t * 272 + part * 32) = p0; *(u32x4*)(qb16 + t * 272 + part * 32 + 16) = p1;
#pragma unroll
        for (int b = 0; b < 4; ++b) { u32x2 pk = {pack2(y[4 * b] * egct, y[4 * b + 1] * egct), pack2(y[4 * b + 2] * egct, y[4 * b + 3] * egct)};
          *(u32x2*)(Qd + t * 128 + 32 * (part >> 1) + 8 * b + 4 * (part & 1)) = pk; }
      } else if (X == 1) {
        u32x4 p0 = {pack2(y[0], y[1]), pack2(y[2], y[3]), pack2(y[4], y[5]), pack2(y[6], y[7])}, p1 = {pack2(y[8], y[9]), pack2(y[10], y[11]), pack2(y[12], y[13]), pack2(y[14], y[15])};
        *(u32x4*)(kb16 + t * 272 + part * 32) = p0; *(u32x4*)(kb16 + t * 272 + part * 32 + 16) = p1;
#pragma unroll
        for (int e4 = 0; e4 < 4; ++e4) { f32x4 v = {y[4 * e4], y[4 * e4 + 1], y[4 * e4 + 2], y[4 * e4 + 3]}; *(f32x4*)(kf + t * 128 + part * 16 + 4 * e4) = v; }
#pragma unroll
        for (int e = 0; e < 16; ++e) Kt[(part * 16 + e) * 64 + pjt] = f2bf(y[e] * ktl);
      } else {
#pragma unroll
        for (int e4 = 0; e4 < 4; ++e4) { f32x4 v = {y[4 * e4], y[4 * e4 + 1], y[4 * e4 + 2], y[4 * e4 + 3]}; *(f32x4*)(vf + t * 128 + part * 16 + 4 * e4) = v; }
      }
    }
    { const int cb = C_AZ + hh * 128 + part * 16; const u32x4 v0 = *(const u32x4*)(proj + (size_t)tabs * DINP + cb), v1 = *(const u32x4*)(proj + (size_t)tabs * DINP + cb + 8);
      float zv[16]; unpack8(v0, zv); unpack8(v1, zv + 8);
#pragma unroll
      for (int e = 0; e < 16; ++e) Zt[(part * 16 + e) * 64 + t] = f2bf(silu_f(zv[e])); }
  }
  __syncthreads();
  {
    const int which = w >> 2, ti = (w >> 1) & 1, tj = w & 1; const char* Ab = which ? qb16 : kb16;
    f32x16 acc;
#pragma unroll
    for (int r = 0; r < 16; ++r) acc[r] = 0.f;
#pragma unroll
    for (int s = 0; s < 8; ++s) { const bf16x8 a = *(const bf16x8*)(Ab + (32 * ti + lq) * 272 + (16 * s + 8 * h) * 2), b = *(const bf16x8*)(kb16 + (32 * tj + lq) * 272 + (16 * s + 8 * h) * 2);
      acc = MFMA32(a, b, acc); }
    const int j = 32 * tj + lq; const float gj = gcs[j]; const int pj = 32 * (j >> 5) + perm32(j & 31);
#pragma unroll
    for (int r = 0; r < 16; ++r) { const int i = 32 * ti + crow(r, h); const float dec = __expf(fminf(gcs[i] - gj, 0.f));
      if (which == 0) Lm[i * 64 + j] = (j < i) ? gcs[64 + i] * acc[r] * dec : 0.f;
      else QK[i * 64 + pj] = f2bf((j <= i) ? acc[r] * dec : 0.f); }
  }
  __syncthreads();
  if (tid < 256) {
    const int c = tid; const bool isu = c < 128; const int cc = c & 127;
    const float* rp = (isu ? vf : kf) + cc; const float* sp = gcs + (isu ? 64 : 192);
    f32x2 xx[32];
    f32x4 LA[16], LB[16]; float rh[2];
    xx[0].x = sp[0] * rp[0];
    LA[0] = *(const f32x4*)(Lm + 64); rh[1] = sp[1] * rp[128];
#pragma unroll
    for (int i = 1; i < 64; ++i) {
      f32x4 (&CUR)[16] = (i & 1) ? LA : LB; f32x4 (&NXT)[16] = (i & 1) ? LB : LA;
      if (i + 1 < 64) {
#pragma unroll
        for (int c = 0; c < (i + 4) / 4; ++c) NXT[c] = *(const f32x4*)(Lm + (i + 1) * 64 + 4 * c);
        rh[(i + 1) & 1] = sp[i + 1] * rp[(i + 1) * 128];
      }
      __builtin_amdgcn_sched_barrier(0);
      f32x2 acc = {rh[i & 1], 0.f};
#pragma unroll
      for (int p = 0; p < i / 2; ++p) { const f32x2 lp = (p & 1) ? (f32x2){CUR[p >> 1].z, CUR[p >> 1].w} : (f32x2){CUR[p >> 1].x, CUR[p >> 1].y}; acc = acc - lp * xx[p]; }
      if (i & 1) { const int j = i - 1; const float lj = ((j & 3) == 0) ? CUR[j >> 2].x : CUR[j >> 2].z; acc.x = fmaf(-lj, xx[j >> 1].x, acc.x); }
      const float xi = acc.x + acc.y;
      if (i & 1) xx[i >> 1].y = xi; else xx[i >> 1].x = xi;
      __builtin_amdgcn_sched_barrier(0);
    }
    float x[64];
#pragma unroll
    for (int p = 0; p < 32; ++p) { x[2 * p] = xx[p].x; x[2 * p + 1] = xx[p].y; }
    if (isu) {
#pragma unroll
      for (int i8 = 0; i8 < 8; ++i8) { u32x4 v = {pack2(x[8 * i8], x[8 * i8 + 1]), pack2(x[8 * i8 + 2], x[8 * i8 + 3]), pack2(x[8 * i8 + 4], x[8 * i8 + 5]), pack2(x[8 * i8 + 6], x[8 * i8 + 7])}; *(u32x4*)(Ut + cc * 64 + 8 * i8) = v; }
    } else {
      const int pp = 32 * (cc >> 5) + perm32(cc & 31);
#pragma unroll
      for (int i = 0; i < 64; ++i) Wp[i * 128 + pp] = f2bf(x[i]);
    }
  }
  __syncthreads();
}

DI bf16x8 pack_tiles(const f32x4& a, const f32x4& b) { return pack8(a.x, a.y, a.z, a.w, b.x, b.y, b.z, b.w); }
template <int CTRL> DI float dppf(float v) { return __int_as_float(__builtin_amdgcn_update_dpp(0, __float_as_int(v), CTRL, 0xf, 0xf, true)); }
DI float row16_sum(float v) { v += dppf<0xB1>(v); v += dppf<0x4E>(v); v += dppf<0x141>(v); v += dppf<0x140>(v); return v; }
constexpr size_t OFF_SSQP = OFF_GTOT + 8192;
static_assert(OFF_SSQP + (size_t)8 * S_ * 8 * 4 <= OFF_UT, "overlay3");
constexpr int SCAN_OPB = 62464;
constexpr int SCAN_SO = 2 * SCAN_OPB;
constexpr int SCAN_OT = SCAN_SO + 16384;
DI void gdn_scan_item(const Params& P, int l, int hh, int half, char* smem) {
  const int tid = opaque_tid(), lane = tid & 63, w = tid >> 6, l15 = lane & 15, q4 = lane >> 4;
  const size_t hb = (size_t)hh * 256;
  const bf16_t* Wp = (const bf16_t*)(P.ws + OFF_WP) + hb * 8192; const bf16_t* Qd = (const bf16_t*)(P.ws + OFF_QD) + hb * 8192;
  const bf16_t* Kt = (const bf16_t*)(P.ws + OFF_KT) + hb * 8192; const bf16_t* Zt = (const bf16_t*)(P.ws + OFF_ZT) + hb * 8192;
  const bf16_t* QK = (const bf16_t*)(P.ws + OFF_QK) + hb * 4096; const bf16_t* Ut = (const bf16_t*)(P.ws + OFF_UT) + hb * 8192;
  const float* gt = (const float*)(P.ws + OFF_GTOT) + hb;
  bf16_t* mixin = (bf16_t*)(P.ws + OFF_H);
  float* sSS = (float*)(smem + SCAN_OT + 16384);
  if (w >= 4) {
    const int lt = tid - 256, wl = w - 4;
    const int dvc = 64 * half + 16 * wl + l15; const float nw = P.gdn_norm[l * 128 + dvc];
    const int uoff = dvc * 64 + 4 * q4;
    const int g256 = (lt >> 4) * 128 + (lt & 15) * 8, l256 = (lt >> 4) * 272 + (lt & 15) * 16;
    const int g128 = (lt >> 3) * 64 + (lt & 7) * 8, l128 = (lt >> 3) * 144 + (lt & 7) * 16;
    u32x4 pwA[4], pqA[4], pkA[4], pqkA[2], pwB[4], pqB[4], pkB[4], pqkB[2]; u32x2 zA[4], zB[4];
#define LD_LOAD(PW, PQ, PK, PQK, N) { const int n__ = (N) < 255 ? (N) : 255; const size_t o8 = (size_t)n__ * 8192, o4 = (size_t)n__ * 4096; \
    _Pragma("unroll") for (int i = 0; i < 4; ++i) { PW[i] = *(const u32x4*)(Wp + o8 + g256 + i * 2048); PQ[i] = *(const u32x4*)(Qd + o8 + g256 + i * 2048); PK[i] = *(const u32x4*)(Kt + o8 + g128 + i * 2048); } \
    _Pragma("unroll") for (int i = 0; i < 2; ++i) PQK[i] = *(const u32x4*)(QK + o4 + g128 + i * 2048); }
#define LZ_LOAD(Z, N) { const int n__ = (N) < 255 ? (N) : 255; _Pragma("unroll") for (int it = 0; it < 4; ++it) Z[it] = *(const u32x2*)(Zt + (size_t)n__ * 8192 + uoff + 16 * it); }
#define LD_STAGE(PW, PQ, PK, PQK, NB) { char* nb_ = (NB); \
    _Pragma("unroll") for (int i = 0; i < 4; ++i) { *(u32x4*)(nb_ + l256 + i * 4352) = PW[i]; *(u32x4*)(nb_ + 17408 + l256 + i * 4352) = PQ[i]; *(u32x4*)(nb_ + 34816 + l128 + i * 4608) = PK[i]; } \
    _Pragma("unroll") for (int i = 0; i < 2; ++i) *(u32x4*)(nb_ + 53248 + l128 + i * 4608) = PQK[i]; }
#define LD_FINISH(M, Z) { const int m = (M); const char* so = smem + SCAN_SO + (m & 1) * 8192 + (wl * 4) * 512 + lane * 8; \
    bf16_t* ot = (bf16_t*)(smem + SCAN_OT + (m & 1) * 8192); float* sq = sSS + (m & 1) * 256 + wl * 64; \
    _Pragma("unroll") for (int it = 0; it < 4; ++it) { \
      const u32x2 ob = *(const u32x2*)(so + it * 512); const f32x4 o = {bflo(ob.x), bfhi(ob.x), bflo(ob.y), bfhi(ob.y)}; \
      f32x4 ss = o * o; ss.x = row16_sum(ss.x); ss.y = row16_sum(ss.y); ss.z = row16_sum(ss.z); ss.w = row16_sum(ss.w); \
      const int rl = 16 * it + 4 * q4; \
      if (l15 == 0) *(f32x4*)(sq + rl) = ss; \
      bf16_t* op = ot + rl * 64 + 16 * wl + l15; \
      op[0] = f2bf(o.x * nw * bflo(Z[it].x)); op[64] = f2bf(o.y * nw * bfhi(Z[it].x)); op[128] = f2bf(o.z * nw * bflo(Z[it].y)); op[192] = f2bf(o.w * nw * bfhi(Z[it].y)); } }
#define LD_STEP(PW, PQ, PK, PQK, ZU, N) { const int n_ = (N); \
    LD_STAGE(PW, PQ, PK, PQK, smem + ((n_ + 1) & 1) * SCAN_OPB); \
    LD_LOAD(PW, PQ, PK, PQK, n_ + 3); \
    if (n_ >= 1) LD_FINISH(n_ - 1, ZU); \
    LZ_LOAD(ZU, n_ + 1); \
    __syncthreads(); }
    LD_LOAD(pwA, pqA, pkA, pqkA, 0);
    LD_STAGE(pwA, pqA, pkA, pqkA, smem);
    LD_LOAD(pwA, pqA, pkA, pqkA, 1);
    LD_LOAD(pwB, pqB, pkB, pqkB, 2);
    LZ_LOAD(zB, 0);
    LZ_LOAD(zA, 0);
    __syncthreads();
#pragma unroll 1
    for (int n = 0; n < 256; n += 2) {
      LD_STEP(pwA, pqA, pkA, pqkA, zA, n);
      LD_STEP(pwB, pqB, pkB, pqkB, zB, n + 1);
    }
    LD_FINISH(255, zA);
    __syncthreads();
#undef LD_LOAD
#undef LZ_LOAD
#undef LD_STAGE
#undef LD_FINISH
#undef LD_STEP
  } else {
    const int dvc = 64 * half + 16 * w + l15;
    const int uoff = dvc * 64 + 4 * q4;
    float* ssqp = (float*)(P.ws + OFF_SSQP) + (size_t)(half * 4 + w) * S_ * 8;
    f32x4 St[8];
#pragma unroll
    for (int t = 0; t < 8; ++t) St[t] = (f32x4){0.f, 0.f, 0.f, 0.f};
    u32x2 uc[4], un[4]; float gcur, gn = 0.f;
#pragma unroll
    for (int it = 0; it < 4; ++it) { uc[it] = *(const u32x2*)(Ut + uoff + 16 * it); un[it] = uc[it]; }
    gcur = gt[0];
#define CP_OUT(M) { const int m2 = (M); const char* ot = smem + SCAN_OT + (m2 & 1) * 8192; \
      _Pragma("unroll") for (int i = 0; i < 2; ++i) { const int c = tid + 256 * i, row = c >> 3, cc = c & 7; \
        *(u32x4*)(mixin + (size_t)(64 * m2 + row) * 2048 + hh * 128 + 64 * half + cc * 8) = *(const u32x4*)(ot + row * 128 + cc * 16); } \
      ssqp[(size_t)(64 * m2 + lane) * 8 + hh] = sSS[(m2 & 1) * 256 + w * 64 + lane]; }
    __syncthreads();
#pragma unroll 2
    for (int n = 0; n < 256; ++n) {
      const char* cb = smem + (n & 1) * SCAN_OPB;
      const char* sWp = cb; const char* sQd = cb + 17408; const char* sKt = cb + 34816; const char* sQK = cb + 53248;
      if (n + 1 < 256) { const size_t o8 = (size_t)(n + 1) * 8192;
#pragma unroll
        for (int it = 0; it < 4; ++it) un[it] = *(const u32x2*)(Ut + o8 + uoff + 16 * it);
        gn = gt[n + 1]; }
      bf16x8 sb[4];
#pragma unroll
      for (int ks = 0; ks < 4; ++ks) sb[ks] = pack_tiles(St[2 * ks], St[2 * ks + 1]);
      f32x4 wsv[4], qs[4];
#pragma unroll
      for (int it = 0; it < 4; ++it) { wsv[it] = (f32x4){0.f, 0.f, 0.f, 0.f}; qs[it] = (f32x4){0.f, 0.f, 0.f, 0.f}; }
#pragma unroll
      for (int it = 0; it < 4; ++it)
#pragma unroll
        for (int ks = 0; ks < 4; ++ks) { const int o = (16 * it + l15) * 272 + 64 * ks + 16 * q4;
          const bf16x8 a = *(const bf16x8*)(sWp + o), a2 = *(const bf16x8*)(sQd + o);
          wsv[it] = MFMA16(a, sb[ks], wsv[it]); qs[it] = MFMA16(a2, sb[ks], qs[it]); }
      f32x4 vn[4];
#pragma unroll
      for (int it = 0; it < 4; ++it) { const f32x4 uf = {bflo(uc[it].x), bfhi(uc[it].x), bflo(uc[it].y), bfhi(uc[it].y)}; vn[it] = uf - wsv[it]; }
      bf16x8 vb[2];
#pragma unroll
      for (int ks = 0; ks < 2; ++ks) vb[ks] = pack_tiles(vn[2 * ks], vn[2 * ks + 1]);
#pragma unroll
      for (int it = 0; it < 4; ++it)
#pragma unroll
        for (int ks = 0; ks < 2; ++ks) { const bf16x8 a = *(const bf16x8*)(sQK + (16 * it + l15) * 144 + 64 * ks + 16 * q4); qs[it] = MFMA16(a, vb[ks], qs[it]); }
      { char* so = smem + SCAN_SO + (n & 1) * 8192 + (w * 4) * 512 + lane * 8;
#pragma unroll
        for (int it = 0; it < 4; ++it) { u32x2 ob = {pack2(qs[it].x, qs[it].y), pack2(qs[it].z, qs[it].w)}; *(u32x2*)(so + it * 512) = ob; } }
#pragma unroll
      for (int t = 0; t < 8; ++t) { St[t] *= gcur;
#pragma unroll
        for (int ks = 0; ks < 2; ++ks) { const bf16x8 a = *(const bf16x8*)(sKt + (16 * t + l15) * 144 + 64 * ks + 16 * q4); St[t] = MFMA16(a, vb[ks], St[t]); } }
#pragma unroll
      for (int it = 0; it < 4; ++it) uc[it] = un[it];
      gcur = gn;
      if (n >= 2) CP_OUT(n - 2);
      __syncthreads();
    }
    CP_OUT(254);
    __syncthreads();
    CP_OUT(255);
#undef CP_OUT
  }
  __syncthreads();
}
DI void gdn_fix_phase(const Params& P) {
  const int tid = opaque_tid();
  bf16_t* mixin = (bf16_t*)(P.ws + OFF_H); const float* ssqp = (const float*)(P.ws + OFF_SSQP);
  for (int idx = blockIdx.x * NT + tid; idx < S_ * 128; idx += gridDim.x * NT) {
    const int t = idx >> 7, ck = idx & 127, h = ck >> 4;
    float sq = 0.f;
#pragma unroll
    for (int p = 0; p < 8; ++p) sq += ssqp[((size_t)p * S_ + t) * 8 + h];
    const float r = rsqrtf(sq * (1.f / 128.f) + EPS);
    u32x4* pp = (u32x4*)(mixin + (size_t)t * 2048 + ck * 8); const u32x4 v = *pp; float f[8]; unpack8(v, f);
    u32x4 o = {pack2(f[0] * r, f[1] * r), pack2(f[2] * r, f[3] * r), pack2(f[4] * r, f[5] * r), pack2(f[6] * r, f[7] * r)}; *pp = o;
  }
}

DI void mla_attn_item(const Params& P, int hd, int b, char* smem) {
  const int tid = opaque_tid(), lane = tid & 63, w = tid >> 6, wq = w & 3, hk = w >> 2, lq = lane & 31, h = lane >> 5;
  const float* qraw = (const float*)(P.ws + OFF_QRAW);
  const bf16_t* Kg = (const bf16_t*)(P.ws + OFF_KMLA) + (size_t)hd * S_ * 192;
  const bf16_t* Vg = (const bf16_t*)(P.ws + OFF_VT) + (size_t)hd * 128 * S_;
  bf16_t* mixin = (bf16_t*)(P.ws + OFF_H);
  const int q = 128 * b + 32 * wq + lq;
  bf16x8 qf[12];
  {
    const float* qp = qraw + (size_t)q * 768 + hd * 192 + 8 * h;
    const float sc = 0.07216878364870322f * LOG2E;
#pragma unroll
    for (int s = 0; s < 8; ++s) { const f32x4 a = *(const f32x4*)(qp + 16 * s), c = *(const f32x4*)(qp + 16 * s + 4);
      qf[s] = pack8(a.x * sc, a.y * sc, a.z * sc, a.w * sc, c.x * sc, c.y * sc, c.z * sc, c.w * sc); }
    const double pq = (double)P.pos[q];
#pragma unroll
    for (int s2 = 0; s2 < 2; ++s2) {
      const f32x4 a0 = *(const f32x4*)(qp + 128 + 16 * s2), a1 = *(const f32x4*)(qp + 128 + 16 * s2 + 4);
      const f32x4 b0 = *(const f32x4*)(qp + 160 + 16 * s2), b1 = *(const f32x4*)(qp + 160 + 16 * s2 + 4);
      float x1[8] = {a0.x, a0.y, a0.z, a0.w, a1.x, a1.y, a1.z, a1.w}, x2[8] = {b0.x, b0.y, b0.z, b0.w, b1.x, b1.y, b1.z, b1.w}, o1[8], o2[8];
#pragma unroll
      for (int j = 0; j < 8; ++j) { double fr = pq * kInvFreq2Pi[16 * s2 + 8 * h + j]; fr -= floor(fr); const float ff = (float)fr;
        const float sn = __builtin_amdgcn_sinf(ff), cs = __builtin_amdgcn_cosf(ff);
        o1[j] = (x1[j] * cs - x2[j] * sn) * sc; o2[j] = (x2[j] * cs + x1[j] * sn) * sc; }
      qf[8 + s2] = pack8(o1[0], o1[1], o1[2], o1[3], o1[4], o1[5], o1[6], o1[7]);
      qf[10 + s2] = pack8(o2[0], o2[1], o2[2], o2[3], o2[4], o2[5], o2[6], o2[7]);
    }
  }
  constexpr int KST = 64 * 400, VST = 128 * 144, STG = KST + VST;
  f32x16 O[4];
#pragma unroll
  for (int i = 0; i < 4; ++i)
#pragma unroll
    for (int r = 0; r < 16; ++r) O[i][r] = 0.f;
  float m_i = -1e30f, l_i = 0.f;
  const int nt = 2 * b + 2;
  u32x4 rk0[3], rv0[2], rk1[3], rv1[2];
  const int vrow = tid >> 3, vcc = tid & 7;
  const int ntl = nt - 1;
#define AT_LOAD(RK, RV, T) { const size_t ko_ = (size_t)(T) * 64 * 192; const int vo_ = (T) * 64; \
    _Pragma("unroll") for (int i = 0; i < 3; ++i) { const int id = tid + NT * i, row = id / 24, cc = id % 24; RK[i] = *(const u32x4*)(Kg + ko_ + row * 192 + cc * 8); } \
    _Pragma("unroll") for (int i = 0; i < 2; ++i) RV[i] = *(const u32x4*)(Vg + (size_t)(vrow + 64 * i) * S_ + vo_ + vcc * 8); }
#define AT_WRITE(RK, RV, ST) { char* dK = smem + (ST) * STG; \
    _Pragma("unroll") for (int i = 0; i < 3; ++i) { const int id = tid + NT * i, row = id / 24, cc = id % 24; *(u32x4*)(dK + row * 400 + cc * 16) = RK[i]; } \
    _Pragma("unroll") for (int i = 0; i < 2; ++i) *(u32x4*)(dK + KST + (vrow + 64 * i) * 144 + vcc * 16) = RV[i]; }
#define AT_COMPUTE(ST, KT) { const char* sK = smem + (ST) * STG; const char* sV = sK + KST; const int key0 = 64 * (KT) + 32 * hk; \
    if (key0 <= 128 * b + 32 * wq) { \
      f32x16 st; _Pragma("unroll") for (int r = 0; r < 16; ++r) st[r] = 0.f; \
      _Pragma("unroll") for (int s = 0; s < 12; ++s) { const bf16x8 kf = *(const bf16x8*)(sK + (32 * hk + lq) * 400 + (2 * s + h) * 16); st = MFMA32(kf, qf[s], st); } \
      if (key0 + 31 > 128 * b + 32 * wq) { int qrel = q - key0 - 4 * h; asm volatile("" : "+v"(qrel)); \
        _Pragma("unroll") for (int r = 0; r < 16; ++r) if ((r & 3) + 8 * (r >> 2) > qrel) st[r] = -1e30f; } \
      float mx = st[0]; _Pragma("unroll") for (int r = 1; r < 16; ++r) mx = fmaxf(mx, st[r]); \
      mx = xhalf_max(mx); \
      const float m_new = fmaxf(m_i, mx), alpha = __builtin_amdgcn_exp2f(m_i - m_new); float ps = 0.f; \
      _Pragma("unroll") for (int r = 0; r < 16; ++r) { st[r] = __builtin_amdgcn_exp2f(st[r] - m_new); ps += st[r]; } \
      l_i = l_i * alpha + ps; \
      if (__any(m_new != m_i)) { _Pragma("unroll") for (int i = 0; i < 4; ++i) _Pragma("unroll") for (int r = 0; r < 16; ++r) O[i][r] *= alpha; } \
      m_i = m_new; \
      bf16x8 pf[2]; \
      _Pragma("unroll") for (int s = 0; s < 2; ++s) pf[s] = pack8(st[8 * s], st[8 * s + 1], st[8 * s + 2], st[8 * s + 3], st[8 * s + 4], st[8 * s + 5], st[8 * s + 6], st[8 * s + 7]); \
      _Pragma("unroll") for (int i = 0; i < 4; ++i) _Pragma("unroll") for (int s = 0; s < 2; ++s) { const char* vp = sV + (32 * i + lq) * 144 + (32 * hk + 16 * s + 4 * h) * 2; \
          const u32x2 lo = *(const u32x2*)vp, hi = *(const u32x2*)(vp + 16); u32x4 vv = {lo.x, lo.y, hi.x, hi.y}; \
          O[i] = MFMA32(__builtin_bit_cast(bf16x8, vv), pf[s], O[i]); } } }
  AT_LOAD(rk0, rv0, 0);
  AT_LOAD(rk1, rv1, 1);
  AT_WRITE(rk0, rv0, 0);
  AT_LOAD(rk0, rv0, (2 < ntl ? 2 : ntl));
  __syncthreads();
  for (int kt = 0; kt < nt; kt += 2) {
    AT_WRITE(rk1, rv1, 1);
    AT_LOAD(rk1, rv1, (kt + 3 < ntl ? kt + 3 : ntl));
    AT_COMPUTE(0, kt);
    __syncthreads();
    AT_WRITE(rk0, rv0, 0);
    AT_LOAD(rk0, rv0, (kt + 4 < ntl ? kt + 4 : ntl));
    AT_COMPUTE(1, kt + 1);
    __syncthreads();
  }
#undef AT_LOAD
#undef AT_WRITE
#undef AT_COMPUTE
  float* cO = (float*)smem; float* cm = cO + 4 * 4096; float* cl = cm + 256;
  if (hk == 1) {
#pragma unroll
    for (int i = 0; i < 4; ++i)
#pragma unroll
      for (int r = 0; r < 16; ++r) cO[wq * 4096 + (i * 16 + r) * 64 + lane] = O[i][r];
    cm[wq * 64 + lane] = m_i; cl[wq * 64 + lane] = l_i;
  }
  __syncthreads();
  if (hk == 0) {
    const float m1 = cm[wq * 64 + lane], l1 = cl[wq * 64 + lane];
    const float m = fmaxf(m_i, m1), a0 = exp2f(m_i - m), a1 = exp2f(m1 - m);
    float lt = l_i * a0 + l1 * a1; lt += __shfl_xor(lt, 32);
    const float inv = 1.f / lt;
    bf16_t* op = mixin + (size_t)q * 2048 + 1024 + hd * 128;
#pragma unroll
    for (int i = 0; i < 4; ++i)
#pragma unroll
      for (int rg = 0; rg < 4; ++rg) { float v[4];
#pragma unroll
        for (int e = 0; e < 4; ++e) v[e] = (O[i][4 * rg + e] * a0 + cO[wq * 4096 + (i * 16 + 4 * rg + e) * 64 + lane] * a1) * inv;
        u32x2 pk = {pack2(v[0], v[1]), pack2(v[2], v[3])}; *(u32x2*)(op + 32 * i + 8 * rg + 4 * h) = pk; }
  }
  __syncthreads();
}

DI void swa_item(const Params& P, int l, int n, int hk2, char* smem) {
  const int tid = opaque_tid(), lane = tid & 63, w = tid >> 6, lq = lane & 31, h = lane >> 5;
  const bf16_t* proj = (const bf16_t*)(P.ws + OFF_PROJ); bf16_t* mixin = (bf16_t*)(P.ws + OFF_H);
  bf16_t* sVt = (bf16_t*)smem;
#pragma unroll
  for (int i = 0; i < 4; ++i) { const int id = tid + NT * i, key = id >> 3, dc = id & 7; const int kp = 128 * (n - 1) + key;
    u32x4 v = {0u, 0u, 0u, 0u}; if (kp >= 0) v = *(const u32x4*)(proj + (size_t)kp * DINP + C_CV + hk2 * 64 + dc * 8);
    sVt[(8 * dc + 0) * 264 + key] = (bf16_t)(v.x & 0xffff); sVt[(8 * dc + 1) * 264 + key] = (bf16_t)(v.x >> 16);
    sVt[(8 * dc + 2) * 264 + key] = (bf16_t)(v.y & 0xffff); sVt[(8 * dc + 3) * 264 + key] = (bf16_t)(v.y >> 16);
    sVt[(8 * dc + 4) * 264 + key] = (bf16_t)(v.z & 0xffff); sVt[(8 * dc + 5) * 264 + key] = (bf16_t)(v.z >> 16);
    sVt[(8 * dc + 6) * 264 + key] = (bf16_t)(v.w & 0xffff); sVt[(8 * dc + 7) * 264 + key] = (bf16_t)(v.w >> 16); }
  __syncthreads();
  const int g = w >> 1, hq = hk2 * 4 + g;
  const float slope = exp2f(-(float)(hq + 1)) * LOG2E, sinkv = P.swa_sinks[l * 8 + hq] * LOG2E;
#pragma unroll 1
  for (int jj = 0; jj < 2; ++jj) {
    const int j = 2 * (w & 1) + jj; const int qrow = 128 * n + 32 * j + lq;
    bf16x8 qf[4];
#pragma unroll
    for (int s = 0; s < 4; ++s) qf[s] = *(const bf16x8*)(proj + (size_t)qrow * DINP + C_CQ + hq * 64 + 16 * s + 8 * h);
    f32x16 st[5];
    bf16x8 kf[2][4];
    { const int kp = 128 * (n - 1) + 32 * j + lq;
#pragma unroll
      for (int s = 0; s < 4; ++s) { kf[0][s] = (bf16x8){0, 0, 0, 0, 0, 0, 0, 0}; if (kp >= 0) kf[0][s] = *(const bf16x8*)(proj + (size_t)kp * DINP + C_CK + hk2 * 64 + 16 * s + 8 * h); } }
#pragma unroll
    for (int tt = 0; tt < 5; ++tt) {
      if (tt + 1 < 5) { const int kp = 128 * (n - 1) + 32 * (j + tt + 1) + lq;
#pragma unroll
        for (int s = 0; s < 4; ++s) { kf[(tt + 1) & 1][s] = (bf16x8){0, 0, 0, 0, 0, 0, 0, 0}; if (kp >= 0) kf[(tt + 1) & 1][s] = *(const bf16x8*)(proj + (size_t)kp * DINP + C_CK + hk2 * 64 + 16 * s + 8 * h); } }
      __builtin_amdgcn_sched_barrier(0);
#pragma unroll
      for (int r = 0; r < 16; ++r) st[tt][r] = 0.f;
#pragma unroll
      for (int s = 0; s < 4; ++s) st[tt] = MFMA32(kf[tt & 1][s], qf[s], st[tt]);
      __builtin_amdgcn_sched_barrier(0);
    }
    float mx = sinkv;
    int dbase = 128 + lq - 4 * h, kbase = 128 * (n - 1) + 32 * j + 4 * h;
    asm volatile("" : "+v"(dbase), "+v"(kbase));
#pragma unroll
    for (int tt = 0; tt < 5; ++tt)
#pragma unroll
      for (int r = 0; r < 16; ++r) { const int cst = 32 * tt + (r & 3) + 8 * (r >> 2); const int dist = dbase - cst; const int kpos = kbase + cst;
        const bool valid = (dist >= 0) && (dist < 128) && (kpos >= 0);
        const float sv = valid ? st[tt][r] * (0.125f * LOG2E) - slope * (float)dist : -1e30f; st[tt][r] = sv; mx = fmaxf(mx, sv); }
    mx = fmaxf(mx, __shfl_xor(mx, 32));
    float den = 0.f;
#pragma unroll
    for (int tt = 0; tt < 5; ++tt)
#pragma unroll
      for (int r = 0; r < 16; ++r) { const float p = exp2f(st[tt][r] - mx); st[tt][r] = p; den += p; }
    den += __shfl_xor(den, 32); den += exp2f(sinkv - mx);
    f32x16 O[2];
#pragma unroll
    for (int i = 0; i < 2; ++i)
#pragma unroll
      for (int r = 0; r < 16; ++r) O[i][r] = 0.f;
#pragma unroll
    for (int tt = 0; tt < 5; ++tt)
#pragma unroll
      for (int s = 0; s < 2; ++s) { const bf16x8 pf = pack8(st[tt][8 * s], st[tt][8 * s + 1], st[tt][8 * s + 2], st[tt][8 * s + 3], st[tt][8 * s + 4], st[tt][8 * s + 5], st[tt][8 * s + 6], st[tt][8 * s + 7]);
#pragma unroll
        for (int i = 0; i < 2; ++i) { const char* vp = (const char*)sVt + (32 * i + lq) * 528 + (32 * (j + tt) + 16 * s + 4 * h) * 2;
          const u32x2 lo = *(const u32x2*)vp, hi = *(const u32x2*)(vp + 16); u32x4 vv = {lo.x, lo.y, hi.x, hi.y};
          O[i] = MFMA32(__builtin_bit_cast(bf16x8, vv), pf, O[i]); }
        __builtin_amdgcn_sched_barrier(0); }
    const float inv = 1.f / den;
    bf16_t* op = mixin + (size_t)qrow * 2048 + 1536 + hq * 64;
#pragma unroll
    for (int i = 0; i < 2; ++i)
#pragma unroll
      for (int rg = 0; rg < 4; ++rg) { u32x2 pk = {pack2(O[i][4 * rg] * inv, O[i][4 * rg + 1] * inv), pack2(O[i][4 * rg + 2] * inv, O[i][4 * rg + 3] * inv)};
        *(u32x2*)(op + 32 * i + 8 * rg + 4 * h) = pk; }
  }
  __syncthreads();
}

DI float gelu_tanh(float x) { const float y = 0.7978845608028654f * (x + 0.044715f * x * x * x); const float t = 1.f - 2.f * __builtin_amdgcn_rcpf(1.f + __expf(2.f * y)); return 0.5f * x * (1.f + t); }
DI void ffn_act_phase(const Params& P, int l) {
  const int tid = opaque_tid(), lane = tid & 63, w = tid >> 6;
  const bf16_t* u = (const bf16_t*)(P.ws + OFF_BIG); bf16_t* act = (bf16_t*)(P.ws + OFF_ACT);
  const float* cw = P.ffn_conv + (size_t)l * 3 * DFF2; const float* cb = P.ffn_conv_b + (size_t)l * DFF2;
  for (int item = blockIdx.x * 8 + w; item < 512 * 11; item += gridDim.x * 8) {
    const int cbk = item % 11, rr = item / 11; const int ch = cbk * 512 + lane * 8, r0 = rr * 32;
    float wg[3][8], wu[3][8], bg[8], bu[8];
#pragma unroll
    for (int j = 0; j < 3; ++j)
#pragma unroll
      for (int e4 = 0; e4 < 2; ++e4) { const f32x4 a = *(const f32x4*)(cw + (size_t)j * DFF2 + ch + 4 * e4), b = *(const f32x4*)(cw + (size_t)j * DFF2 + DFF + ch + 4 * e4);
        wg[j][4 * e4] = a.x; wg[j][4 * e4 + 1] = a.y; wg[j][4 * e4 + 2] = a.z; wg[j][4 * e4 + 3] = a.w; wu[j][4 * e4] = b.x; wu[j][4 * e4 + 1] = b.y; wu[j][4 * e4 + 2] = b.z; wu[j][4 * e4 + 3] = b.w; }
#pragma unroll
    for (int e4 = 0; e4 < 2; ++e4) { const f32x4 a = *(const f32x4*)(cb + ch + 4 * e4), b = *(const f32x4*)(cb + DFF + ch + 4 * e4);
      bg[4 * e4] = a.x; bg[4 * e4 + 1] = a.y; bg[4 * e4 + 2] = a.z; bg[4 * e4 + 3] = a.w; bu[4 * e4] = b.x; bu[4 * e4 + 1] = b.y; bu[4 * e4 + 2] = b.z; bu[4 * e4 + 3] = b.w; }
    float g2[8], g1[8], u2[8], u1[8];
#pragma unroll
    for (int e = 0; e < 8; ++e) { g2[e] = 0.f; g1[e] = 0.f; u2[e] = 0.f; u1[e] = 0.f; }
    if (r0 >= 2) { unpack8(*(const u32x4*)(u + (size_t)(r0 - 2) * DFF2 + ch), g2); unpack8(*(const u32x4*)(u + (size_t)(r0 - 2) * DFF2 + DFF + ch), u2);
      unpack8(*(const u32x4*)(u + (size_t)(r0 - 1) * DFF2 + ch), g1); unpack8(*(const u32x4*)(u + (size_t)(r0 - 1) * DFF2 + DFF + ch), u1); }
#pragma unroll 1
    for (int rb = 0; rb < 4; ++rb) {
      u32x4 G[8], U[8];
#pragma unroll
      for (int i = 0; i < 8; ++i) { const size_t ro = (size_t)(r0 + rb * 8 + i) * DFF2 + ch; G[i] = *(const u32x4*)(u + ro); U[i] = *(const u32x4*)(u + ro + DFF); }
#pragma unroll
      for (int i = 0; i < 8; ++i) {
        float g0[8], u0[8]; unpack8(G[i], g0); unpack8(U[i], u0);
        float o[8];
#pragma unroll
        for (int e = 0; e < 8; ++e) { const float yg = wg[0][e] * g2[e] + wg[1][e] * g1[e] + wg[2][e] * g0[e] + bg[e]; const float yu = wu[0][e] * u2[e] + wu[1][e] * u1[e] + wu[2][e] * u0[e] + bu[e];
          o[e] = gelu_tanh(yg) * yu; g2[e] = g1[e]; g1[e] = g0[e]; u2[e] = u1[e]; u1[e] = u0[e]; }
        u32x4 pk = {pack2(o[0], o[1]), pack2(o[2], o[3]), pack2(o[4], o[5]), pack2(o[6], o[7])};
        *(u32x4*)(act + (size_t)(r0 + rb * 8 + i) * DFF + ch) = pk;
      }
    }
  }
}

#define XB_TMO      128
#define XB_XCNT(j)  (256  + 64 * (j))
#define XB_XSUB(j)  (1280 + 64 * (j))
#define XB_XGEN(j)  (2304 + 64 * (j))
#define XB_TOP      3328
#define XB_TOPGEN   3392
#define XCD_BAR_WORDS 3456
#define XB_SPIN_CAP (1u << 18)
#define LAS __attribute__((address_space(3)))
DI unsigned xb_ld(unsigned* p)              { return __hip_atomic_load(p, __ATOMIC_RELAXED, __HIP_MEMORY_SCOPE_AGENT); }
DI unsigned xb_add(unsigned* p, unsigned v) { return __hip_atomic_fetch_add(p, v, __ATOMIC_RELAXED, __HIP_MEMORY_SCOPE_AGENT); }
DI unsigned xb_xcc_id() { return (unsigned)__builtin_amdgcn_s_getreg((3 << 11) | 20) & 0xFu; }
#define XB_SPIN(cond, bar) do { unsigned _sp = 0; while (cond) { __builtin_amdgcn_s_sleep(1); \
    if ((++_sp & 255u) == 0u) { if (xb_ld(&(bar)[XB_TMO])) break; if (_sp > XB_SPIN_CAP) { atomicAdd(&(bar)[XB_TMO], 1u); break; } } } } while (0)
struct XcdBarrier { unsigned* bar; unsigned x; volatile LAS unsigned* st; };
DI XcdBarrier xcd_barrier_post(unsigned* bar, volatile LAS unsigned* st) {
  XcdBarrier b; b.bar = bar; b.x = xb_xcc_id(); b.st = st;
  if (threadIdx.x == 0) (void)xb_add(&bar[XB_XCNT(b.x)], 1u);
  return b;
}
DI void xcd_barrier_complete(unsigned* bar, unsigned x, unsigned& nloc, unsigned& nx) {
  const unsigned G = gridDim.x * gridDim.y * gridDim.z;
  unsigned sum, cnt, mine, sp = 0u;
  for (;;) {
    sum = 0u; cnt = 0u; mine = 0u;
#pragma unroll
    for (unsigned j = 0; j < 16; ++j) { const unsigned c = xb_ld(&bar[XB_XCNT(j)]); sum += c; cnt += (c > 0u) ? 1u : 0u; mine = (j == x) ? c : mine; }
    if (sum == G) break;
    __builtin_amdgcn_s_sleep(1);
    if ((++sp & 255u) == 0u) { if (xb_ld(&bar[XB_TMO])) break; if (sp > XB_SPIN_CAP) { atomicAdd(&bar[XB_TMO], 1u); break; } }
  }
  nloc = mine > 0u ? mine : 1u; nx = cnt > 0u ? cnt : 1u;
}
DI void xcd_barrier(char* ws_, char* smem_) {
  XcdBarrier b; b.bar = (unsigned*)(ws_ + OFF_XBAR); b.x = xb_xcc_id(); b.st = (volatile LAS unsigned*)(smem_ + 159760);
  asm volatile("s_waitcnt vmcnt(0)" ::: "memory");
  __syncthreads();
  if (threadIdx.x == 0) {
    unsigned* bar = b.bar;
    __builtin_amdgcn_s_waitcnt(0);
    unsigned nloc = b.st[0], nx = b.st[1];
    if (nloc == 0u) { xcd_barrier_complete(bar, b.x, nloc, nx); b.st[0] = nloc; b.st[1] = nx; }
    const unsigned old = xb_add(&bar[XB_XSUB(b.x)], 1u);
    const unsigned gen = old / nloc;
    if (old + 1u == (gen + 1u) * nloc) {
      __builtin_amdgcn_fence(__ATOMIC_RELEASE, "agent");
      asm volatile("s_waitcnt vmcnt(0)" ::: "memory");
      const unsigned og = xb_add(&bar[XB_TOP], 1u);
      const unsigned tg = og / nx;
      if (og + 1u == (tg + 1u) * nx) xb_add(&bar[XB_TOPGEN], 1u);
      else XB_SPIN(xb_ld(&bar[XB_TOPGEN]) == tg, bar);
      __builtin_amdgcn_fence(__ATOMIC_ACQUIRE, "agent");
      xb_add(&bar[XB_XGEN(b.x)], 1u);
      asm volatile("s_waitcnt vmcnt(0)" ::: "memory");
    } else {
      XB_SPIN(xb_ld(&bar[XB_XGEN(b.x)]) == gen, bar);
      __builtin_amdgcn_fence(__ATOMIC_ACQUIRE, "agent");
      asm volatile("s_waitcnt vmcnt(0)" ::: "memory");
    }
  }
  __syncthreads();
}

__global__ void __launch_bounds__(NT) fwd_megakernel(Params P0) {
  cg::grid_group grid = cg::this_grid();
  __shared__ __attribute__((aligned(16))) char smem[160512];
  const int tid = threadIdx.x;
  char* ws = P0.ws;
  int* ctrl = (int*)(ws + OFF_CTRL);
  if (blockIdx.x == 0 && tid < 64) ctrl[tid] = 0;
  if (blockIdx.x == 0) for (int i = tid; i < XCD_BAR_WORDS; i += NT) ((unsigned*)(ws + OFF_XBAR))[i] = 0u;
  if (tid < 4) ((unsigned*)(smem + 159760))[tid] = 0u;
  if (blockIdx.x == 0 && tid == 0) *(Params*)(ws + OFF_CTRL + 1024) = P0;
  bf16_t* Hb = (bf16_t*)(ws + OFF_H);
  for (int it = blockIdx.x; it < 192 + CV_T5; it += gridDim.x) { if (it < 192) mod_item(P0, it); else convert_item(P0, 0, it - 192, smem); }
  grid.sync();
  (void)xcd_barrier_post((unsigned*)(ws + OFF_XBAR), (volatile LAS unsigned*)(smem + 159760));
  const Params& P = *(const Params*)(ws + OFF_CTRL + 1024);
  rownorm_phase(P, P.x, nullptr, P.out, Hb, 0, 0, nullptr, 0, 1, 0, P.mix_pre, smem);
  xcd_barrier(ws, smem);
  for (int l = 0; l < 2; ++l) {
    { EpiProj epi{(bf16_t*)(ws + OFF_PROJ), (float*)(ws + OFF_AB)}; gemm_phase(Hb, 2048, (const bf16_t*)(ws + OFF_W + W_IN), 2048, 2048, 64, 22, smem, epi); }
    xcd_barrier(ws, smem);
    for (int it = blockIdx.x; it < 448; it += gridDim.x) {
      if (it < 192) mla_q_tile(P, it / 3, it % 3, smem);
      else mla_kv_tile(P, (it - 192) >> 2, (it - 192) & 3, smem);
    }
    for (int id = (blockIdx.x + 64) % gridDim.x; id < 2048; id += gridDim.x) gdn_prep_item(P, l, id >> 3, id & 7, smem);
    xcd_barrier(ws, smem);
    {
      int* sitem = (int*)(smem + 159744);
      for (;;) {
        if (tid == 0) *sitem = atomicAdd(ctrl + 16 * l, 1);
        __syncthreads(); const int item = *sitem; __syncthreads();
        if (item >= 16 + 512 + 256) break;
        if (item < 16) gdn_scan_item(P, l, item >> 1, item & 1, smem);
        else if (item < 528) { const int idx = item - 16; mla_attn_item(P, idx & 3, 127 - (idx >> 2), smem); }
        else { const int idx = item - 528; swa_item(P, l, idx >> 1, idx & 1, smem); }
      }
    }
    xcd_barrier(ws, smem);
    gdn_fix_phase(P);
    xcd_barrier(ws, smem);
    { EpiBf epi{(bf16_t*)(ws + OFF_MIXF), 2048}; gemm_phase(Hb, 2048, (const bf16_t*)(ws + OFF_W + W_OUT), 2048, 2048, 64, 8, smem, epi); }
    xcd_barrier(ws, smem);
    rownorm_phase(P, P.out, (const bf16_t*)(ws + OFF_MIXF), P.out, Hb, l, 2, P.mix_post + l * 2048, l, 4, 3, P.ffn_pre + l * 2048, smem);
    xcd_barrier(ws, smem);
    { EpiBf epi{(bf16_t*)(ws + OFF_BIG), DFF2}; gemm_phase(Hb, 2048, (const bf16_t*)(ws + OFF_W + W_UP), 2048, 2048, 64, 44, smem, epi); }
    xcd_barrier(ws, smem);
    ffn_act_phase(P, l);
    xcd_barrier(ws, smem);
    { EpiBf epi{(bf16_t*)(ws + OFF_Y), 2048}; gemm_phase((const bf16_t*)(ws + OFF_ACT), DFF, (const bf16_t*)(ws + OFF_W + W_DOWN), DFF, DFF, 64, 8, smem, epi); }
    xcd_barrier(ws, smem);
    if (l == 0) {
      for (int it = blockIdx.x; it < CV_T5; it += gridDim.x) convert_item(P, 1, it, smem);
      rownorm_phase(P, P.out, (const bf16_t*)(ws + OFF_Y), P.out, Hb, 0, 5, P.ffn_post, 1, 1, 0, P.mix_pre + 2048, smem);
      xcd_barrier(ws, smem);
    } else {
      rownorm_phase(P, P.out, (const bf16_t*)(ws + OFF_Y), P.out, nullptr, 1, 5, P.ffn_post + 2048, 1, 1, 0, nullptr, smem);
    }
  }
}

extern "C" void kernel_launch(void* const* d_in, const int* in_sizes, int n_in, void* d_out, int out_size, void* d_ws, size_t ws_size, hipStream_t stream) {
  static int grid_blocks = 0;
  if (!grid_blocks) {
    int dev = 0, cus = 0, per = 0;
    (void)hipGetDevice(&dev); (void)hipDeviceGetAttribute(&cus, hipDeviceAttributeMultiprocessorCount, dev);
    (void)hipOccupancyMaxActiveBlocksPerMultiprocessor(&per, fwd_megakernel, NT, 0);
    if (per > 1) per = 1;
    grid_blocks = cus * per; if (grid_blocks <= 0) grid_blocks = 256;
  }
  if (ws_size < OFF_END) { fprintf(stderr, "workspace too small: %zu < %zu\n", ws_size, (size_t)OFF_END); return; }
  Params p{};
  p.x = (const float*)d_in[0]; p.c = (const float*)d_in[1]; p.pos = (const int*)d_in[2];
  p.ada_w = (const float*)d_in[3]; p.ada_b = (const float*)d_in[4]; p.mix_pre = (const float*)d_in[5]; p.mix_post = (const float*)d_in[6];
  p.w_in = (const float*)d_in[7]; p.w_out = (const float*)d_in[8]; p.gdn_conv = (const float*)d_in[9]; p.gdn_a_log = (const float*)d_in[10];
  p.gdn_dt_bias = (const float*)d_in[11]; p.gdn_norm = (const float*)d_in[12]; p.mla_q_norm = (const float*)d_in[13]; p.mla_w_uq = (const float*)d_in[14];
  p.mla_kv_norm = (const float*)d_in[15]; p.mla_w_ukv = (const float*)d_in[16]; p.swa_sinks = (const float*)d_in[17]; p.ffn_pre = (const float*)d_in[18];
  p.ffn_post = (const float*)d_in[19]; p.ffn_w_up = (const float*)d_in[20]; p.ffn_conv = (const float*)d_in[21]; p.ffn_conv_b = (const float*)d_in[22];
  p.ffn_w_down = (const float*)d_in[23];
  p.out = (float*)d_out; p.ws = (char*)d_ws;
  void* args[] = {&p};
  hipError_t e = hipLaunchCooperativeKernel((void*)fwd_megakernel, dim3(grid_blocks), dim3(NT), args, 0, stream);
  if (e != hipSuccess) fprintf(stderr, "cooperative launch failed: %s (grid %d)\n", hipGetErrorString(e), grid_blocks);
}
```

```cpp
#include <hip/hip_runtime.h>
#include <hip/hip_cooperative_groups.h>
#include <cstdio>
#include <cstdint>
namespace cg = cooperative_groups;

#define DI __device__ __forceinline__
typedef unsigned short bf16_t;
typedef short bf16x8 __attribute__((ext_vector_type(8)));
typedef float f32x2 __attribute__((ext_vector_type(2)));
typedef float f32x4 __attribute__((ext_vector_type(4)));
typedef float f32x16 __attribute__((ext_vector_type(16)));
typedef unsigned u32x2 __attribute__((ext_vector_type(2)));
typedef unsigned u32x4 __attribute__((ext_vector_type(4)));
typedef __bf16 bf2_t __attribute__((ext_vector_type(2)));

constexpr int S_ = 16384, D_ = 2048, DINP = 5632, DFF = 5632, DFF2 = 11264;
constexpr int NT = 512;
constexpr float EPS = 1e-6f;
constexpr float LOG2E = 1.4426950408889634f;

constexpr size_t OFF_CTRL = 0;
constexpr size_t OFF_MODP = 4096;
constexpr size_t OFF_XBAR = OFF_MODP + (size_t)2 * 16 * 12288 * 4;
constexpr size_t OFF_W = 2097152;
static_assert(OFF_XBAR + 3456 * 4 <= OFF_W, "xbar");
constexpr size_t W_IN = 0, W_OUT = W_IN + (size_t)5632 * 2048 * 2, W_UP = W_OUT + (size_t)2048 * 2048 * 2,
                 W_DOWN = W_UP + (size_t)11264 * 2048 * 2, W_UQ = W_DOWN + (size_t)2048 * 5632 * 2,
                 W_UKV = W_UQ + (size_t)768 * 448 * 2, W_END = W_UKV + (size_t)1024 * 128 * 2;
constexpr size_t OFF_H = OFF_W + W_END;
constexpr size_t OFF_MIXF = OFF_H + (size_t)S_ * 2048 * 2;
constexpr size_t OFF_QRAW = OFF_MIXF;
constexpr size_t OFF_KMLA = OFF_QRAW + (size_t)S_ * 768 * 4;
constexpr size_t OFF_VT = OFF_KMLA + (size_t)4 * S_ * 192 * 2;
constexpr size_t OFF_BIG = OFF_MIXF + (size_t)S_ * 2048 * 4;
constexpr size_t OFF_PROJ = OFF_BIG;
constexpr size_t OFF_WP = OFF_PROJ + (size_t)S_ * DINP * 2;
constexpr size_t OFF_QD = OFF_WP + (size_t)S_ * 1024 * 2;
constexpr size_t OFF_KT = OFF_QD + (size_t)S_ * 1024 * 2;
constexpr size_t OFF_ZT = OFF_KT + (size_t)S_ * 1024 * 2;
constexpr size_t OFF_QK = OFF_ZT + (size_t)S_ * 1024 * 2;
constexpr size_t OFF_AB = OFF_QK + (size_t)S_ * 512 * 2;
constexpr size_t OFF_GTOT = OFF_AB + (size_t)S_ * 16 * 4;
constexpr size_t OFF_Y = OFF_BIG;
constexpr size_t OFF_ACT = OFF_H;
constexpr size_t OFF_UT = OFF_BIG + (size_t)S_ * DFF2 * 2;
constexpr size_t OFF_END = OFF_UT + (size_t)S_ * 1024 * 4;
static_assert(OFF_GTOT + 8192 <= OFF_UT, "overlay");
static_assert(OFF_VT + (size_t)4 * 128 * S_ * 2 <= OFF_BIG, "overlay2");

constexpr int C_AQ = 0, C_AK = 1024, C_AV = 2048, C_AZ = 3072, C_AA = 4096, C_BCQ = 4112, C_BCKV = 4560,
              C_BKR = 4688, C_CQ = 4752, C_CK = 5264, C_CV = 5392;

__constant__ double kInvFreq2Pi[32] = {
    0.15915494309189535, 0.11934937021124886, 0.08949940160889101, 0.06711508300522726, 0.050329212104487035, 0.03774158471741977,
    0.0283021958306234, 0.02122365276477766, 0.015915494309189534, 0.011934937021124886, 0.008949940160889102, 0.006711508300522725,
    0.005032921210448704, 0.003774158471741977, 0.00283021958306234, 0.0021223652764777662, 0.0015915494309189536, 0.0011934937021124885,
    0.0008949940160889102, 0.0006711508300522726, 0.0005032921210448703, 0.00037741584717419774, 0.00028302195830623395, 0.0002122365276477766,
    0.00015915494309189535, 0.00011934937021124886, 8.949940160889102e-05, 6.711508300522725e-05, 5.0329212104487035e-05, 3.774158471741978e-05,
    2.8302195830623396e-05, 2.122365276477766e-05};

struct Params {
  const float* x; const float* c; const int* pos;
  const float *ada_w, *ada_b, *mix_pre, *mix_post, *w_in, *w_out, *gdn_conv, *gdn_a_log, *gdn_dt_bias, *gdn_norm, *mla_q_norm, *mla_w_uq,
      *mla_kv_norm, *mla_w_ukv, *swa_sinks, *ffn_pre, *ffn_post, *ffn_w_up, *ffn_conv, *ffn_conv_b, *ffn_w_down;
  float* out; char* ws;
};

DI unsigned pack2(float lo, float hi) { f32x2 v = {lo, hi}; bf2_t b = __builtin_convertvector(v, bf2_t); return __builtin_bit_cast(unsigned, b); }
DI bf16_t f2bf(float x) { return (bf16_t)(pack2(x, 0.f) & 0xffffu); }
DI float bflo(unsigned u) { return __uint_as_float(u << 16); }
DI float bfhi(unsigned u) { return __uint_as_float(u & 0xffff0000u); }
DI void unpack8(const u32x4& v, float* f) { f[0] = bflo(v.x); f[1] = bfhi(v.x); f[2] = bflo(v.y); f[3] = bfhi(v.y); f[4] = bflo(v.z); f[5] = bfhi(v.z); f[6] = bflo(v.w); f[7] = bfhi(v.w); }
DI bf16x8 pack8(float a0, float a1, float a2, float a3, float a4, float a5, float a6, float a7) {
  u32x4 p = {pack2(a0, a1), pack2(a2, a3), pack2(a4, a5), pack2(a6, a7)}; return __builtin_bit_cast(bf16x8, p); }
DI float silu_f(float x) { return x * __builtin_amdgcn_rcpf(1.f + __expf(-x)); }
DI float wave_sum(float v) { v += __shfl_xor(v, 32); v += __shfl_xor(v, 16); v += __shfl_xor(v, 8); v += __shfl_xor(v, 4); v += __shfl_xor(v, 2); v += __shfl_xor(v, 1); return v; }
DI int opaque_tid() { int t = threadIdx.x; asm volatile("" : "+v"(t)); return t; }
DI float xhalf_max(float v) { const auto r = __builtin_amdgcn_permlane32_swap(__float_as_uint(v), __float_as_uint(v), false, false); return fmaxf(__uint_as_float(r[0]), __uint_as_float(r[1])); }
DI int crow(int r, int h) { return (r & 3) + 8 * (r >> 2) + 4 * h; }
DI int perm32(int k) { return 8 * ((k >> 2) & 3) + 4 * (k >> 4) + (k & 3); }
#define MFMA32(a, b, c) __builtin_amdgcn_mfma_f32_32x32x16_bf16((a), (b), (c), 0, 0, 0)
#define MFMA16(a, b, c) __builtin_amdgcn_mfma_f32_16x16x32_bf16((a), (b), (c), 0, 0, 0)

template <class Epi>
DI void gemm_tile(const bf16_t* __restrict__ A, int lda, const bf16_t* __restrict__ Bt, int ldb, int K, int m0, int n0, char* smem, const Epi& epi) {
  const int tid = opaque_tid(), lane = tid & 63, w = tid >> 6, wm = w >> 2, wn = w & 3, lq = lane & 31, h = lane >> 5;
  f32x16 acc[2][4];
#pragma unroll
  for (int i = 0; i < 2; ++i)
#pragma unroll
    for (int j = 0; j < 4; ++j)
#pragma unroll
      for (int r = 0; r < 16; ++r) acc[i][j][r] = 0.f;
  const int r0 = tid >> 3, c0 = tid & 7;
  const bf16_t* ag = A + (size_t)(m0 + r0) * lda + c0 * 8;
  const bf16_t* bg = Bt + (size_t)(n0 + r0) * ldb + c0 * 8;
  const int wofs = r0 * 128 + ((c0 ^ ((r0 >> 1) & 7)) << 4);
  char* sA = smem; char* sB = smem + 65536;
  u32x4 ra0[4], rb0[4], ra1[4], rb1[4];
  const int nk = K >> 6, swz = (lane >> 1) & 7;
  const int aoff = (64 * wn + lq) * 128, boff = (128 * wm + lq) * 128;
#define GLOAD(RA, RB, KT) { _Pragma("unroll") for (int i = 0; i < 4; ++i) { RA[i] = *(const u32x4*)(ag + (size_t)(KT) * 64 + (size_t)i * 64 * lda); RB[i] = *(const u32x4*)(bg + (size_t)(KT) * 64 + (size_t)i * 64 * ldb); } }
#define LWRITE(RA, RB, ST) { _Pragma("unroll") for (int i = 0; i < 4; ++i) { *(u32x4*)(sA + (ST) * 32768 + wofs + i * 8192) = RA[i]; *(u32x4*)(sB + (ST) * 32768 + wofs + i * 8192) = RB[i]; } }
#define KSTEP(ST, RA, RB, KN) { const char* cA = sA + (ST) * 32768; const char* cB = sB + (ST) * 32768; char* dA = sA + (1 - (ST)) * 32768; char* dB = sB + (1 - (ST)) * 32768; \
    const bf16_t* agn = ag + (size_t)(KN) * 64; const bf16_t* bgn = bg + (size_t)(KN) * 64; \
    _Pragma("unroll") for (int s = 0; s < 4; ++s) { const int co = (((2 * s + h) ^ swz) << 4); bf16x8 fa[2], fb[4]; \
      _Pragma("unroll") for (int ni = 0; ni < 2; ++ni) fa[ni] = *(const bf16x8*)(cB + aoff + ni * 4096 + co); \
      _Pragma("unroll") for (int mi = 0; mi < 4; ++mi) fb[mi] = *(const bf16x8*)(cA + boff + mi * 4096 + co); \
      *(u32x4*)(dA + wofs + s * 8192) = RA[s]; *(u32x4*)(dB + wofs + s * 8192) = RB[s]; \
      RA[s] = *(const u32x4*)(agn + (size_t)s * 64 * lda); RB[s] = *(const u32x4*)(bgn + (size_t)s * 64 * ldb); \
      _Pragma("unroll") for (int ni = 0; ni < 2; ++ni) _Pragma("unroll") for (int mi = 0; mi < 4; ++mi) acc[ni][mi] = MFMA32(fa[ni], fb[mi], acc[ni][mi]); \
      __builtin_amdgcn_sched_barrier(0); } }
  const int kl = nk - 1;
  GLOAD(ra0, rb0, 0);
  GLOAD(ra1, rb1, (1 < kl ? 1 : kl));
  LWRITE(ra0, rb0, 0);
  GLOAD(ra0, rb0, (2 < kl ? 2 : kl));
  __syncthreads();
  for (int kt = 0; kt < nk; kt += 2) {
    KSTEP(0, ra1, rb1, (kt + 3 < kl ? kt + 3 : kl));
    __syncthreads();
    if (kt + 1 < nk) {
      KSTEP(1, ra0, rb0, (kt + 4 < kl ? kt + 4 : kl));
      __syncthreads();
    }
  }
#undef GLOAD
#undef LWRITE
#undef KSTEP
#pragma unroll
  for (int ni = 0; ni < 2; ++ni)
#pragma unroll
    for (int mi = 0; mi < 4; ++mi)
#pragma unroll
      for (int rg = 0; rg < 4; ++rg) {
        const int m = m0 + 128 * wm + 32 * mi + lq, n = n0 + 64 * wn + 32 * ni + 8 * rg + 4 * h;
        epi(m, n, acc[ni][mi][4 * rg], acc[ni][mi][4 * rg + 1], acc[ni][mi][4 * rg + 2], acc[ni][mi][4 * rg + 3]);
      }
}

template <class Epi>
DI void gemm_tile_s(const bf16_t* __restrict__ A, int lda, const bf16_t* __restrict__ Bt, int ldb, int K, int m0, int n0, char* smem, const Epi& epi) {
  const int tid = opaque_tid(), lane = tid & 63, w = tid >> 6, wm = w >> 2, wn = w & 3, lq = lane & 31, h = lane >> 5;
  f32x16 acc[2][4];
#pragma unroll
  for (int i = 0; i < 2; ++i)
#pragma unroll
    for (int j = 0; j < 4; ++j)
#pragma unroll
      for (int r = 0; r < 16; ++r) acc[i][j][r] = 0.f;
  const int r0 = tid >> 3, c0 = tid & 7;
  const bf16_t* ag = A + (size_t)(m0 + r0) * lda + c0 * 8;
  const bf16_t* bg = Bt + (size_t)(n0 + r0) * ldb + c0 * 8;
  const int wofs = r0 * 128 + ((c0 ^ ((r0 >> 1) & 7)) << 4);
  char* sA = smem; char* sB = smem + 32768;
  u32x4 ra[4], rb[4];
#pragma unroll
  for (int i = 0; i < 4; ++i) { ra[i] = *(const u32x4*)(ag + (size_t)i * 64 * lda); rb[i] = *(const u32x4*)(bg + (size_t)i * 64 * ldb); }
#pragma unroll
  for (int i = 0; i < 4; ++i) { *(u32x4*)(sA + wofs + i * 8192) = ra[i]; *(u32x4*)(sB + wofs + i * 8192) = rb[i]; }
  __syncthreads();
  const int nk = K >> 6, swz = (lane >> 1) & 7;
  const int aoff = (64 * wn + lq) * 128, boff = (128 * wm + lq) * 128;
  for (int kt = 0; kt < nk; ++kt) {
    const char* cA = sA + (kt & 1) * 65536; const char* cB = sB + (kt & 1) * 65536;
    const bool more = (kt + 1 < nk);
    if (more) { ag += 64; bg += 64;
#pragma unroll
      for (int i = 0; i < 4; ++i) { ra[i] = *(const u32x4*)(ag + (size_t)i * 64 * lda); rb[i] = *(const u32x4*)(bg + (size_t)i * 64 * ldb); } }
#pragma unroll
    for (int s = 0; s < 4; ++s) {
      const int co = (((2 * s + h) ^ swz) << 4);
      bf16x8 fa[2], fb[4];
#pragma unroll
      for (int ni = 0; ni < 2; ++ni) fa[ni] = *(const bf16x8*)(cB + aoff + ni * 4096 + co);
#pragma unroll
      for (int mi = 0; mi < 4; ++mi) fb[mi] = *(const bf16x8*)(cA + boff + mi * 4096 + co);
#pragma unroll
      for (int ni = 0; ni < 2; ++ni)
#pragma unroll
        for (int mi = 0; mi < 4; ++mi) acc[ni][mi] = MFMA32(fa[ni], fb[mi], acc[ni][mi]);
    }
    if (more) { char* dA = sA + ((kt + 1) & 1) * 65536; char* dB = sB + ((kt + 1) & 1) * 65536;
#pragma unroll
      for (int i = 0; i < 4; ++i) { *(u32x4*)(dA + wofs + i * 8192) = ra[i]; *(u32x4*)(dB + wofs + i * 8192) = rb[i]; } }
    __syncthreads();
  }
#pragma unroll
  for (int ni = 0; ni < 2; ++ni)
#pragma unroll
    for (int mi = 0; mi < 4; ++mi)
#pragma unroll
      for (int rg = 0; rg < 4; ++rg) {
        const int m = m0 + 128 * wm + 32 * mi + lq, n = n0 + 64 * wn + 32 * ni + 8 * rg + 4 * h;
        epi(m, n, acc[ni][mi][4 * rg], acc[ni][mi][4 * rg + 1], acc[ni][mi][4 * rg + 2], acc[ni][mi][4 * rg + 3]);
      }
}

DI void tile_coord(int t, int npn, int& pm, int& pn) { const int g = t / (16 * npn), r = t % (16 * npn); pn = r >> 4; pm = g * 16 + (r & 15); }

struct EpiProj { bf16_t* proj; float* ab;
  DI void operator()(int m, int n, float v0, float v1, float v2, float v3) const {
    u32x2 pk = {pack2(v0, v1), pack2(v2, v3)}; *(u32x2*)(proj + (size_t)m * DINP + n) = pk;
    if (n >= C_AA && n < C_AA + 16) { int mm = m; asm volatile("" : "+v"(mm));
      f32x4 v = {v0, v1, v2, v3}; *(f32x4*)(ab + (size_t)mm * 16 + (n - C_AA)) = v; } } };
struct EpiF32 { float* out; int ldc;
  DI void operator()(int m, int n, float v0, float v1, float v2, float v3) const { f32x4 v = {v0, v1, v2, v3}; *(f32x4*)(out + (size_t)m * ldc + n) = v; } };
struct EpiBf { bf16_t* out; int ldc;
  DI void operator()(int m, int n, float v0, float v1, float v2, float v3) const { u32x2 pk = {pack2(v0, v1), pack2(v2, v3)}; *(u32x2*)(out + (size_t)m * ldc + n) = pk; } };
struct EpiMlaQ { float* qraw; const float* rs; int m0;
  DI void operator()(int m, int n, float v0, float v1, float v2, float v3) const { const float r = rs[m - m0]; f32x4 v = {v0 * r, v1 * r, v2 * r, v3 * r}; *(f32x4*)(qraw + (size_t)m * 768 + n) = v; } };
struct EpiMlaKV { bf16_t* kmla; bf16_t* vt; const float* rs; int m0;
  DI void operator()(int m, int n, float v0, float v1, float v2, float v3) const {
    const float r = rs[m - m0]; const int hd = n >> 8, wi = n & 255;
    if (wi < 128) { u32x2 pk = {pack2(v0 * r, v1 * r), pack2(v2 * r, v3 * r)}; *(u32x2*)(kmla + ((size_t)hd * S_ + m) * 192 + wi) = pk; }
    else { bf16_t* p = vt + ((size_t)hd * 128 + (wi - 128)) * S_ + m; p[0] = f2bf(v0 * r); p[S_] = f2bf(v1 * r); p[2 * (size_t)S_] = f2bf(v2 * r); p[3 * (size_t)S_] = f2bf(v3 * r); } } };


namespace pg8 {
#define PG8_LAS __attribute__((address_space(3)))
constexpr int BM = 256, BK = 64, HALF = 128, HTB = HALF * BK * 2  , STAGE_BYTES = 8 * HTB;
DI int lds_byte(int r, int c) { const int st = (r >> 4) * 2 + (c >> 5), rr = r & 15, cc = c & 31, ob = rr * 64 + cc * 2; return st * 1024 + (ob ^ (((ob >> 9) & 1) << 5)); }
DI void stage_rc(int b, int& R, int& C) { const int st = b / 1024, sb = b % 1024, swz = sb ^ (((sb >> 9) & 1) << 5); R = (st >> 1) * 16 + swz / 64; C = (st & 1) * 32 + (swz % 64) / 2; }
DI int perm32(int rho) { const int n = rho >> 4, i = rho & 15; return 8 * (i >> 2) + 4 * n + (i & 3); }
struct Unit { int pm, pn; };
struct Gemm { const bf16_t* A; const bf16_t* Bt; int M, N, K; };
struct XcdOrder { int pm, pj, npn;
  DI bool next(int i, Unit& u) const { const int pn = pj + 4 * i; if (pn >= npn) return false; u.pm = pm; u.pn = pn; return true; }
  DI void a_ready(const Unit&) const {}
  DI void done(const Unit&) const {} };
template <class E> struct EpiAdapt { static constexpr bool PERM = false, AFTER_DRAIN = false; const E& e;
  DI void operator()(const f32x4 (&acc)[2][2][4][2], const Unit& u, int wr, int wc, int fr, int fq) const {
#pragma unroll
    for (int ai = 0; ai < 2; ++ai)
#pragma unroll
      for (int m = 0; m < 4; ++m)
#pragma unroll
        for (int bj = 0; bj < 2; ++bj)
#pragma unroll
          for (int n = 0; n < 2; ++n) { const f32x4 v = acc[ai][bj][m][n];
            e(u.pm * BM + ai * HALF + wr * 64 + m * 16 + fr, u.pn * BM + bj * HALF + wc * 32 + n * 16 + 4 * fq, v.x, v.y, v.z, v.w); } } };
template <class Epi, class Sched, bool ALIGN_EPI = false, bool SP2 = false>
__device__ __forceinline__ void gemm_phase(PG8_LAS unsigned char* lds, const Gemm g, const Sched& S, const Epi& E) {
    const int tid = opaque_tid(), wid = __builtin_amdgcn_readfirstlane(tid >> 6), lane = tid & 63, wr = wid >> 2, wc = wid & 3, fr = lane & 15, fq = lane >> 4;
    const int K = g.K, nt = K / BK;
    unsigned voffA[2], voffB[2];
#pragma unroll
    for (int i = 0; i < 2; ++i) { int R, C; stage_rc(tid * 16 + i * 8192, R, C); const int Rb = Epi::PERM ? ((R & ~31) + perm32(R & 31)) : R;
        voffA[i] = (unsigned)(R * K + C) * 2u; voffB[i] = (unsigned)(Rb * K + C) * 2u; }
    const size_t kstep = (size_t)(BK * 2);
    const size_t hstep = (size_t)HALF * K * 2;
    const size_t tstep = 2 * hstep;
    const unsigned ldsw = (unsigned)wid * 1024u;
    const int aoff = lds_byte(wr * 64 + fr, fq * 8), boff = lds_byte(wc * 32 + fr, fq * 8);
#define PG8_SA(b, h) (((b) * 2 + (h)) * HTB)
#define PG8_SB(b, h) ((4 + (b) * 2 + (h)) * HTB)
#define PG8_STAGE(bufoff, gbase, voff) do { _Pragma("unroll") for (int _i = 0; _i < 2; ++_i) \
        __builtin_amdgcn_global_load_lds((const unsigned*)((const char*)(gbase) + (voff)[_i]), (PG8_LAS unsigned*)(lds + (bufoff) + ldsw + _i * 8192), 16, 0, 0); } while (0)
#define PG8_LDA(dst, b, h) do { _Pragma("unroll") for (int m = 0; m < 4; ++m) _Pragma("unroll") for (int k = 0; k < 2; ++k) dst[m][k] = *(const PG8_LAS bf16x8*)(lds + PG8_SA(b, h) + aoff + m * 2048 + k * 1024); } while (0)
#define PG8_LDB(dst, b, h) do { _Pragma("unroll") for (int n = 0; n < 2; ++n) _Pragma("unroll") for (int k = 0; k < 2; ++k) dst[n][k] = *(const PG8_LAS bf16x8*)(lds + PG8_SB(b, h) + boff + n * 2048 + k * 1024); } while (0)
#define PG8_MMA(ai, bj, At, Bt) do { __builtin_amdgcn_s_setprio(1); _Pragma("unroll") for (int m = 0; m < 4; ++m) _Pragma("unroll") for (int n = 0; n < 2; ++n) _Pragma("unroll") for (int k = 0; k < 2; ++k) \
        acc[ai][bj][m][n] = __builtin_amdgcn_mfma_f32_16x16x32_bf16(Bt[n][k], At[m][k], acc[ai][bj][m][n], 0, 0, 0); __builtin_amdgcn_s_setprio(0); } while (0)
#define PG8_WAIT_V(n) asm volatile("s_waitcnt vmcnt(" #n ")" ::: "memory")
#define PG8_WAIT_L(n) asm volatile("s_waitcnt lgkmcnt(" #n ")" ::: "memory")
#define PG8_BAR __builtin_amdgcn_s_barrier()
#define PG8_SCHED __builtin_amdgcn_sched_barrier(0)
    Unit cur, nxt; int ui = 0;
    if (!S.next(0, cur)) return;
    f32x4 acc[2][2][4][2];
#pragma unroll
    for (int a = 0; a < 2; ++a)
#pragma unroll
        for (int b = 0; b < 2; ++b)
#pragma unroll
            for (int m = 0; m < 4; ++m)
#pragma unroll
                for (int n = 0; n < 2; ++n) acc[a][b][m][n] = (f32x4){0.f, 0.f, 0.f, 0.f};
    bf16x8 At[4][2], B0[2][2], B1[2][2];
    const char* cA = (const char*)g.A + (size_t)cur.pm * tstep; const char* cB = (const char*)g.Bt + (size_t)cur.pn * tstep;
    S.a_ready(cur);
    if constexpr (SP2) {
        PG8_STAGE(PG8_SB(0, 0), cB, voffB); PG8_STAGE(PG8_SB(0, 1), cB + hstep, voffB); PG8_STAGE(PG8_SA(0, 0), cA, voffA); PG8_STAGE(PG8_SA(0, 1), cA + hstep, voffA);
        if (wr == 1) PG8_BAR;
        PG8_WAIT_V(2); PG8_BAR;
        PG8_STAGE(PG8_SB(1, 0), cB + kstep, voffB); PG8_STAGE(PG8_SA(1, 0), cA + kstep, voffA); PG8_STAGE(PG8_SB(1, 1), cB + hstep + kstep, voffB);
        PG8_WAIT_V(6); PG8_BAR;
    } else {
        PG8_STAGE(PG8_SB(0, 0), cB, voffB); PG8_STAGE(PG8_SA(0, 0), cA, voffA); PG8_STAGE(PG8_SB(0, 1), cB + hstep, voffB); PG8_STAGE(PG8_SA(0, 1), cA + hstep, voffA);
        if (wr == 1) PG8_BAR;
        PG8_WAIT_V(4); PG8_BAR;
        PG8_STAGE(PG8_SB(1, 0), cB + kstep, voffB); PG8_STAGE(PG8_SA(1, 0), cA + kstep, voffA); PG8_STAGE(PG8_SB(1, 1), cB + hstep + kstep, voffB);
        PG8_WAIT_V(6); PG8_BAR;
    }
    for (;;) {
        const bool has_next = S.next(ui + 1, nxt);
        const char* nA = has_next ? (const char*)g.A + (size_t)nxt.pm * tstep : cA; const char* nB = has_next ? (const char*)g.Bt + (size_t)nxt.pn * tstep : cB;
        for (int t = 0; t < nt; t += 2) {
            const bool last = (t == nt - 2);
            const char* a1 = cA + (size_t)(t + 1) * kstep;
            const char* a2 = last ? nA : cA + (size_t)(t + 2) * kstep; const char* b2 = last ? nB : cB + (size_t)(t + 2) * kstep;
            const char* a3 = a2 + kstep; const char* b3 = b2 + kstep;
            if (last && has_next) S.a_ready(nxt);
            if constexpr (SP2) {
            PG8_LDB(B0, 0, 0); PG8_LDB(B1, 0, 1); PG8_SCHED; PG8_LDA(At, 0, 0); PG8_STAGE(PG8_SA(1, 1), a1 + hstep, voffA);
            PG8_WAIT_V(8); PG8_WAIT_L(0); PG8_BAR; PG8_MMA(0, 0, At, B0); PG8_MMA(0, 1, At, B1); PG8_BAR; PG8_SCHED;
            PG8_LDA(At, 0, 1); PG8_STAGE(PG8_SB(0, 0), b2, voffB); PG8_STAGE(PG8_SB(0, 1), b2 + hstep, voffB); PG8_STAGE(PG8_SA(0, 0), a2, voffA);
            PG8_WAIT_V(8); PG8_WAIT_L(0); PG8_BAR; PG8_MMA(1, 0, At, B0); PG8_MMA(1, 1, At, B1); PG8_BAR; PG8_SCHED;
            PG8_LDB(B0, 1, 0); PG8_LDB(B1, 1, 1); PG8_SCHED; PG8_LDA(At, 1, 0); PG8_STAGE(PG8_SA(0, 1), a2 + hstep, voffA);
            PG8_WAIT_V(8); PG8_WAIT_L(0); PG8_BAR; PG8_MMA(0, 0, At, B0); PG8_MMA(0, 1, At, B1); PG8_BAR; PG8_SCHED;
            PG8_LDA(At, 1, 1); PG8_STAGE(PG8_SB(1, 0), b3, voffB); PG8_STAGE(PG8_SB(1, 1), b3 + hstep, voffB); PG8_STAGE(PG8_SA(1, 0), a3, voffA);
            PG8_WAIT_V(8); PG8_WAIT_L(0); PG8_BAR; PG8_MMA(1, 0, At, B0); PG8_MMA(1, 1, At, B1); PG8_BAR; PG8_SCHED;
            } else {
            PG8_LDB(B0, 0, 0); PG8_SCHED; PG8_LDA(At, 0, 0); PG8_STAGE(PG8_SA(1, 1), a1 + hstep, voffA);
            PG8_WAIT_L(8); PG8_BAR; PG8_WAIT_L(0); PG8_MMA(0, 0, At, B0); PG8_BAR; PG8_SCHED;
            PG8_LDB(B1, 0, 1); PG8_STAGE(PG8_SB(0, 0), b2, voffB);
            PG8_BAR; PG8_WAIT_L(0); PG8_MMA(0, 1, At, B1); PG8_BAR;
            PG8_LDA(At, 0, 1); PG8_STAGE(PG8_SA(0, 0), a2, voffA);
            PG8_BAR; PG8_WAIT_L(0); PG8_MMA(1, 0, At, B0); PG8_BAR; PG8_SCHED;
            PG8_STAGE(PG8_SB(0, 1), b2 + hstep, voffB);
            PG8_WAIT_V(6); PG8_BAR; PG8_MMA(1, 1, At, B1); PG8_BAR;
            PG8_LDB(B0, 1, 0); PG8_SCHED; PG8_LDA(At, 1, 0); PG8_STAGE(PG8_SA(0, 1), a2 + hstep, voffA);
            PG8_WAIT_L(8); PG8_BAR; PG8_WAIT_L(0); PG8_MMA(0, 0, At, B0); PG8_BAR; PG8_SCHED;
            PG8_LDB(B1, 1, 1); PG8_STAGE(PG8_SB(1, 0), b3, voffB);
            PG8_BAR; PG8_WAIT_L(0); PG8_MMA(0, 1, At, B1); PG8_BAR;
            PG8_LDA(At, 1, 1); PG8_STAGE(PG8_SA(1, 0), a3, voffA);
            PG8_BAR; PG8_WAIT_L(0); PG8_MMA(1, 0, At, B0); PG8_BAR; PG8_SCHED;
            PG8_STAGE(PG8_SB(1, 1), b3 + hstep, voffB);
            PG8_WAIT_V(6); PG8_BAR; PG8_MMA(1, 1, At, B1); PG8_BAR;
            }
        }
        if constexpr (ALIGN_EPI) { if (wr == 0) PG8_BAR; }
        if constexpr (!Epi::AFTER_DRAIN) { E(acc, cur, wr, wc, fr, fq); S.done(cur); }
        if (!has_next) break;
#pragma unroll
        for (int a = 0; a < 2; ++a)
#pragma unroll
            for (int b = 0; b < 2; ++b)
#pragma unroll
                for (int m = 0; m < 4; ++m)
#pragma unroll
                    for (int n = 0; n < 2; ++n) acc[a][b][m][n] = (f32x4){0.f, 0.f, 0.f, 0.f};
        cur = nxt; cA = nA; cB = nB; ++ui;
        if constexpr (ALIGN_EPI) { if (wr == 1) PG8_BAR; }
    }
    PG8_WAIT_V(0);
    if constexpr (!ALIGN_EPI) { if (wr == 0) PG8_BAR; }
    PG8_BAR;
    if constexpr (Epi::AFTER_DRAIN) { E.fused(acc, cur, wr, wc, fr, fq, lds, wid, lane); S.done(cur); }
#undef PG8_SA
#undef PG8_SB
#undef PG8_STAGE
#undef PG8_LDA
#undef PG8_LDB
#undef PG8_MMA
#undef PG8_WAIT_V
#undef PG8_WAIT_L
#undef PG8_BAR
#undef PG8_SCHED
}
}

template <class Epi>
DI void gemm_phase(const bf16_t* A, int lda, const bf16_t* Bt, int ldb, int K, int npm, int npn, char* smem, const Epi& epi) {
  if (gridDim.x == 256 && npm == 64) {
    const int b = blockIdx.x, pm = 8 * (b & 7) + ((b >> 3) & 7), pj = b >> 6;
    if (lda == K && ldb == K && (K & 127) == 0) {
      const pg8::Gemm g{A, Bt, npm * 256, npn * 256, K}; const pg8::XcdOrder ord{pm, pj, npn}; const pg8::EpiAdapt<Epi> ea{epi};
      pg8::gemm_phase(( __attribute__((address_space(3))) unsigned char*)smem, g, ord, ea);
    } else
    for (int pn = pj; pn < npn; pn += 4) gemm_tile(A, lda, Bt, ldb, K, pm * 256, pn * 256, smem, epi);
  } else {
    for (int t = blockIdx.x; t < npm * npn; t += gridDim.x) { int pm, pn; tile_coord(t, npn, pm, pn); gemm_tile(A, lda, Bt, ldb, K, pm * 256, pn * 256, smem, epi); }
  }
}

DI void mod_item(const Params& P, int item) {
  const int tid = opaque_tid(); const int l = item / 96, r = item % 96, ks = r / 6, nc = r % 6;
  const int n = nc * 2048 + tid * 4;
  const float* wp = P.ada_w + ((size_t)l * 2048 + ks * 128) * 12288 + n;
  f32x4 acc = {0.f, 0.f, 0.f, 0.f};
#pragma unroll 8
  for (int k = 0; k < 128; ++k) { const float cv = P.c[ks * 128 + k]; const float ca = silu_f(cv); const f32x4 wv = *(const f32x4*)(wp + (size_t)k * 12288); acc += wv * ca; }
  float* modp = (float*)(P.ws + OFF_MODP);
  *(f32x4*)(modp + ((size_t)l * 16 + ks) * 12288 + n) = acc;
}
DI void convert_tile(const float* __restrict__ src, int K, int N, bf16_t* __restrict__ dst, int tk, int tn, const float* rowscale, char* smem) {
  float* sm = (float*)smem; const int tid = opaque_tid(); const int k0 = tk * 64, n0 = tn * 256;
  { const int r = tid >> 6, c4 = tid & 63; const int n = n0 + 4 * c4;
    f32x4 v[8];
#pragma unroll
    for (int i = 0; i < 8; ++i) { v[i] = (f32x4){0.f, 0.f, 0.f, 0.f}; if (n < N) v[i] = *(const f32x4*)(src + (size_t)(k0 + r + 8 * i) * N + n); }
#pragma unroll
    for (int i = 0; i < 8; ++i) { const int kk = r + 8 * i; if (rowscale) v[i] *= rowscale[k0 + kk];
      sm[kk * 257 + 4 * c4 + 0] = v[i].x; sm[kk * 257 + 4 * c4 + 1] = v[i].y; sm[kk * 257 + 4 * c4 + 2] = v[i].z; sm[kk * 257 + 4 * c4 + 3] = v[i].w; } }
  __syncthreads();
  { const int n = tid >> 1, kh = tid & 1;
#pragma unroll
    for (int j = 0; j < 4; ++j) { float f[8];
#pragma unroll
      for (int i = 0; i < 8; ++i) f[i] = sm[(32 * kh + 8 * j + i) * 257 + n];
      u32x4 pk = {pack2(f[0], f[1]), pack2(f[2], f[3]), pack2(f[4], f[5]), pack2(f[6], f[7])};
      *(u32x4*)(dst + (size_t)(n0 + n) * K + k0 + 32 * kh + 8 * j) = pk; } }
  __syncthreads();
}
constexpr int CV_T0 = 32 * 22, CV_T1 = CV_T0 + 32 * 8, CV_T2 = CV_T1 + 32 * 44, CV_T3 = CV_T2 + 88 * 8, CV_T4 = CV_T3 + 7 * 3, CV_T5 = CV_T4 + 2 * 4;
DI void convert_item(const Params& P, int l, int it, char* smem) {
  char* wb = P.ws + OFF_W;
  if (it < CV_T0) convert_tile(P.w_in + (size_t)l * 2048 * 5520, 2048, 5520, (bf16_t*)(wb + W_IN), it / 22, it % 22, nullptr, smem);
  else if (it < CV_T1) { it -= CV_T0; convert_tile(P.w_out + (size_t)l * 2048 * 2048, 2048, 2048, (bf16_t*)(wb + W_OUT), it / 8, it % 8, nullptr, smem); }
  else if (it < CV_T2) { it -= CV_T1; convert_tile(P.ffn_w_up + (size_t)l * 2048 * 11264, 2048, 11264, (bf16_t*)(wb + W_UP), it / 44, it % 44, nullptr, smem); }
  else if (it < CV_T3) { it -= CV_T2; convert_tile(P.ffn_w_down + (size_t)l * 5632 * 2048, 5632, 2048, (bf16_t*)(wb + W_DOWN), it / 8, it % 8, nullptr, smem); }
  else if (it < CV_T4) { it -= CV_T3; convert_tile(P.mla_w_uq + (size_t)l * 448 * 768, 448, 768, (bf16_t*)(wb + W_UQ), it / 3, it % 3, P.mla_q_norm + l * 448, smem); }
  else { it -= CV_T4; convert_tile(P.mla_w_ukv + (size_t)l * 128 * 1024, 128, 1024, (bf16_t*)(wb + W_UKV), it / 4, it % 4, P.mla_kv_norm + l * 128, smem); }
}

DI float mod_val(const float* modp_l, const float* ada_b_l, int idx) { float s = ada_b_l[idx];
#pragma unroll
  for (int k = 0; k < 16; ++k) s += modp_l[(size_t)k * 12288 + idx]; return s; }
DI void rownorm_phase(const Params& P, const float* xin, const bf16_t* yin, float* xout, bf16_t* hout, int lg, int gate_idx, const float* w_post,
                      int lh, int scale_idx, int shift_idx, const float* w_pre, char* smem) {
  float* A1 = (float*)smem; float* A2 = A1 + 2048; float* B2 = A2 + 2048;
  const int tid = opaque_tid(), lane = tid & 63, w = tid >> 6;
  const float* modp = (const float*)(P.ws + OFF_MODP);
  for (int cidx = tid; cidx < 2048; cidx += NT) {
    if (yin) A1[cidx] = mod_val(modp + (size_t)lg * 16 * 12288, P.ada_b + (size_t)lg * 12288, gate_idx * 2048 + cidx) * w_post[cidx];
    if (hout) { A2[cidx] = w_pre[cidx] * (1.f + mod_val(modp + (size_t)lh * 16 * 12288, P.ada_b + (size_t)lh * 12288, scale_idx * 2048 + cidx));
      B2[cidx] = mod_val(modp + (size_t)lh * 16 * 12288, P.ada_b + (size_t)lh * 12288, shift_idx * 2048 + cidx); }
  }
  __syncthreads();
  for (int row = blockIdx.x * 8 + w; row < S_; row += gridDim.x * 8) {
    f32x4 xv[8];
#pragma unroll
    for (int j = 0; j < 8; ++j) xv[j] = *(const f32x4*)(xin + (size_t)row * 2048 + (j * 64 + lane) * 4);
    if (yin) {
      f32x4 yv[8]; float ss = 0.f;
#pragma unroll
      for (int j = 0; j < 8; ++j) { const u32x2 yb = *(const u32x2*)(yin + (size_t)row * 2048 + (j * 64 + lane) * 4); yv[j] = (f32x4){bflo(yb.x), bfhi(yb.x), bflo(yb.y), bfhi(yb.y)};
        ss += yv[j].x * yv[j].x + yv[j].y * yv[j].y + yv[j].z * yv[j].z + yv[j].w * yv[j].w; }
      ss = wave_sum(ss); const float r = rsqrtf(ss * (1.f / 2048.f) + EPS);
#pragma unroll
      for (int j = 0; j < 8; ++j) { const f32x4 a = *(const f32x4*)(A1 + (j * 64 + lane) * 4); xv[j] += a * (yv[j] * r); }
    }
    if (yin || xout != xin) {
#pragma unroll
      for (int j = 0; j < 8; ++j) *(f32x4*)(xout + (size_t)row * 2048 + (j * 64 + lane) * 4) = xv[j];
    }
    if (hout) {
      float ss = 0.f;
#pragma unroll
      for (int j = 0; j < 8; ++j) ss += xv[j].x * xv[j].x + xv[j].y * xv[j].y + xv[j].z * xv[j].z + xv[j].w * xv[j].w;
      ss = wave_sum(ss); const float r = rsqrtf(ss * (1.f / 2048.f) + EPS);
#pragma unroll
      for (int j = 0; j < 8; ++j) { const f32x4 a = *(const f32x4*)(A2 + (j * 64 + lane) * 4), b = *(const f32x4*)(B2 + (j * 64 + lane) * 4);
        const f32x4 hv = xv[j] * r * a + b; u32x2 pk = {pack2(hv.x, hv.y), pack2(hv.z, hv.w)};
        *(u32x2*)(hout + (size_t)row * 2048 + (j * 64 + lane) * 4) = pk; }
    }
  }
  __syncthreads();
}

DI void mla_q_tile(const Params& P, int pm, int pn, char* smem) {
  const bf16_t* proj = (const bf16_t*)(P.ws + OFF_PROJ); const int tid = opaque_tid(), m0 = pm * 256; float* rs = (float*)(smem + 131072);
  { const int row = tid >> 1, half = tid & 1; const bf16_t* p = proj + (size_t)(m0 + row) * DINP + C_BCQ + half * 224; float ss = 0.f;
    for (int i = 0; i < 28; ++i) { const u32x4 v = *(const u32x4*)(p + i * 8); float f[8]; unpack8(v, f);
#pragma unroll
      for (int e = 0; e < 8; ++e) ss += f[e] * f[e]; }
    ss += __shfl_xor(ss, 1); if (half == 0) rs[row] = rsqrtf(ss * (1.f / 448.f) + EPS); }
  EpiMlaQ epi{(float*)(P.ws + OFF_QRAW), rs, m0};
  gemm_tile_s(proj + C_BCQ, DINP, (const bf16_t*)(P.ws + OFF_W + W_UQ), 448, 448, m0, pn * 256, smem, epi);
  __syncthreads();
}
DI void mla_kv_tile(const Params& P, int pm, int pn, char* smem) {
  const bf16_t* proj = (const bf16_t*)(P.ws + OFF_PROJ); const int tid = opaque_tid(), m0 = pm * 256; float* rs = (float*)(smem + 131072);
  { const int row = tid >> 1, half = tid & 1; const bf16_t* p = proj + (size_t)(m0 + row) * DINP + C_BCKV + half * 64; float ss = 0.f;
#pragma unroll
    for (int i = 0; i < 8; ++i) { const u32x4 v = *(const u32x4*)(p + i * 8); float f[8]; unpack8(v, f);
#pragma unroll
      for (int e = 0; e < 8; ++e) ss += f[e] * f[e]; }
    ss += __shfl_xor(ss, 1); if (half == 0) rs[row] = rsqrtf(ss * (1.f / 128.f) + EPS); }
  bf16_t* kmla = (bf16_t*)(P.ws + OFF_KMLA);
  EpiMlaKV epi{kmla, (bf16_t*)(P.ws + OFF_VT), rs, m0};
  gemm_tile_s(proj + C_BCKV, DINP, (const bf16_t*)(P.ws + OFF_W + W_UKV), 128, 128, m0, pn * 256, smem, epi);
  if (pn == 0) {
    for (int i = 0; i < 16; ++i) { const int idx = tid + NT * i, row = idx >> 5, pi = idx & 31, m = m0 + row;
      const float x1 = bflo((unsigned)proj[(size_t)m * DINP + C_BKR + pi]), x2 = bflo((unsigned)proj[(size_t)m * DINP + C_BKR + 32 + pi]);
      double fr = (double)P.pos[m] * kInvFreq2Pi[pi]; fr -= floor(fr); const float ff = (float)fr;
      const float sn = __builtin_amdgcn_sinf(ff), cs = __builtin_amdgcn_cosf(ff);
      const bf16_t o1 = f2bf(x1 * cs - x2 * sn), o2 = f2bf(x2 * cs + x1 * sn);
#pragma unroll
      for (int hd = 0; hd < 4; ++hd) { bf16_t* kp = kmla + ((size_t)hd * S_ + m) * 192 + 128; kp[pi] = o1; kp[32 + pi] = o2; } }
  }
  __syncthreads();
}

DI void gdn_prep_item(const Params& P, int l, int n, int hh, char* smem) {
  const int tid = opaque_tid(), lane = tid & 63, w = tid >> 6, lq = lane & 31, h = lane >> 5;
  const bf16_t* proj = (const bf16_t*)(P.ws + OFF_PROJ); const float* ab = (const float*)(P.ws + OFF_AB);
  char* kb16 = smem; char* qb16 = smem + 17408;
  float* kf = (float*)(smem + 34816); float* vf = kf + 8192; float* Lm = vf + 8192; float* gcs = Lm + 4096;
  const size_t tile = (size_t)hh * 256 + n; const int t0 = n * 64;
  bf16_t* Wp = (bf16_t*)(P.ws + OFF_WP) + tile * 8192; bf16_t* Qd = (bf16_t*)(P.ws + OFF_QD) + tile * 8192;
  bf16_t* Kt = (bf16_t*)(P.ws + OFF_KT) + tile * 8192; bf16_t* Zt = (bf16_t*)(P.ws + OFF_ZT) + tile * 8192;
  bf16_t* QK = (bf16_t*)(P.ws + OFF_QK) + tile * 4096; bf16_t* Ut = (bf16_t*)(P.ws + OFF_UT) + tile * 8192;
  if (w == 0) {
    const int t = lane; const float a_raw = ab[(size_t)(t0 + t) * 16 + hh], b_raw = ab[(size_t)(t0 + t) * 16 + 8 + hh];
    const float Aa = __expf(P.gdn_a_log[l * 8 + hh]); const float xb = a_raw + P.gdn_dt_bias[l * 8 + hh];
    const float ex = __expf(fminf(xb, 20.f));
    const float sp = xb > 20.f ? xb : (ex < 0.01f ? ex * (1.f - ex * (0.5f - ex * (1.f / 3.f))) : __logf(1.f + ex));
    float g = -Aa * sp;
#pragma unroll
    for (int d = 1; d < 64; d <<= 1) { const float v = __shfl_up(g, d); if (lane >= d) g += v; }
    const float bt = __builtin_amdgcn_rcpf(1.f + __expf(-b_raw)), eg = __expf(g); gcs[t] = g; gcs[64 + t] = bt; gcs[128 + t] = eg; gcs[192 + t] = bt * eg;
    if (t == 63) ((float*)(P.ws + OFF_GTOT))[tile] = eg;
  }
  __syncthreads();
  {
    const int t = tid >> 3, part = tid & 7, tabs = t0 + t;
    const float gct = gcs[t], egct = gcs[128 + t], ktl = __expf(gcs[63] - gct);
    const int pjt = 32 * (t >> 5) + perm32(t & 31);
#pragma unroll
    for (int X = 0; X < 3; ++X) {
      const int cb = X * 1024 + hh * 128 + part * 16;
      float y[16];
#pragma unroll
      for (int e = 0; e < 16; ++e) y[e] = 0.f;
      u32x4 pv[4][2]; f32x4 wv[4][4];
#pragma unroll
      for (int j = 0; j < 4; ++j) { const int row = tabs - 3 + j, rr = row < 0 ? 0 : row;
        pv[j][0] = *(const u32x4*)(proj + (size_t)rr * DINP + cb); pv[j][1] = *(const u32x4*)(proj + (size_t)rr * DINP + cb + 8);
        const float* cw = P.gdn_conv + ((size_t)l * 4 + j) * 3072 + cb;
#pragma unroll
        for (int e4 = 0; e4 < 4; ++e4) wv[j][e4] = *(const f32x4*)(cw + 4 * e4); }
      __builtin_amdgcn_sched_barrier(0);
#pragma unroll
      for (int j = 0; j < 4; ++j) { const float msk = (tabs - 3 + j) >= 0 ? 1.f : 0.f;
        float xv[16]; unpack8(pv[j][0], xv); unpack8(pv[j][1], xv + 8);
#pragma unroll
        for (int e4 = 0; e4 < 4; ++e4) { const f32x4 wm = wv[j][e4] * msk; y[4 * e4] += wm.x * xv[4 * e4]; y[4 * e4 + 1] += wm.y * xv[4 * e4 + 1]; y[4 * e4 + 2] += wm.z * xv[4 * e4 + 2]; y[4 * e4 + 3] += wm.w * xv[4 * e4 + 3]; } }
#pragma unroll
      for (int e = 0; e < 16; ++e) y[e] = silu_f(y[e]);
      if (X < 2) { float ss = 0.f;
#pragma unroll
        for (int e = 0; e < 16; ++e) ss += y[e] * y[e];
        ss += __shfl_xor(ss, 1); ss += __shfl_xor(ss, 2); ss += __shfl_xor(ss, 4);
        const float rn = rsqrtf(ss + EPS) * (X == 0 ? 0.08838834764831845f : 1.f);
#pragma unroll
        for (int e = 0; e < 16; ++e) y[e] *= rn; }
      if (X == 0) {
        u32x4 p0 = {pack2(y[0], y[1]), pack2(y[2], y[3]), pack2(y[4], y[5]), pack2(y[6], y[7])}, p1 = {pack2(y[8], y[9]), pack2(y[10], y[11]), pack2(y[12], y[13]), pack2(y[14], y[15])};
        *(u32x4*)(qb16 + t * 272 + part * 32) = p0; *(u32x4*)(qb16 + t * 272 + part * 32 + 16) = p1;
#pragma unroll
        for (int b = 0; b < 4; ++b) { u32x2 pk = {pack2(y[4 * b] * egct, y[4 * b + 1] * egct), pack2(y[4 * b + 2] * egct, y[4 * b + 3] * egct)};
          *(u32x2*)(Qd + t * 128 + 32 * (part >> 1) + 8 * b + 4 * (part & 1)) = pk; }
      } else if (X == 1) {
        u32x4 p0 = {pack2(y[0], y[1]), pack2(y[2], y[3]), pack2(y[4], y[5]), pack2(y[6], y[7])}, p1 = {pack2(y[8], y[9]), pack2(y[10], y[11]), pack2(y[12], y[13]), pack2(y[14], y[15])};
        *(u32x4*)(kb16 + t * 272 + part * 32) = p0; *(u32x4*)(kb16 + t * 272 + part * 32 + 16) = p1;
#pragma unroll
        for (int e4 = 0; e4 < 4; ++e4) { f32x4 v = {y[4 * e4], y[4 * e4 + 1], y[4 * e4 + 2], y[4 * e4 + 3]}; *(f32x4*)(kf + t * 128 + part * 16 + 4 * e4) = v; }
#pragma unroll
        for (int e = 0; e < 16; ++e) Kt[(part * 16 + e) * 64 + pjt] = f2bf(y[e] * ktl);
      } else {
#pragma unroll
        for (int e4 = 0; e4 < 4; ++e4) { f32x4 v = {y[4 * e4], y[4 * e4 + 1], y[4 * e4 + 2], y[4 * e4 + 3]}; *(f32x4*)(vf + t * 128 + part * 16 + 4 * e4) = v; }
      }
    }
    { const int cb = C_AZ + hh * 128 + part * 16; const u32x4 v0 = *(const u32x4*)(proj + (size_t)tabs * DINP + cb), v1 = *(const u32x4*)(proj + (size_t)tabs * DINP + cb + 8);
      float zv[16]; unpack8(v0, zv); unpack8(v1, zv + 8);
#pragma unroll
      for (int e = 0; e < 16; ++e) Zt[(part * 16 + e) * 64 + t] = f2bf(silu_f(zv[e])); }
  }
  __syncthreads();
  {
    const int which = w >> 2, ti = (w >> 1) & 1, tj = w & 1; const char* Ab = which ? qb16 : kb16;
    f32x16 acc;
#pragma unroll
    for (int r = 0; r < 16; ++r) acc[r] = 0.f;
#pragma unroll
    for (int s = 0; s < 8; ++s) { const bf16x8 a = *(const bf16x8*)(Ab + (32 * ti + lq) * 272 + (16 * s + 8 * h) * 2), b = *(const bf16x8*)(kb16 + (32 * tj + lq) * 272 + (16 * s + 8 * h) * 2);
      acc = MFMA32(a, b, acc); }
    const int j = 32 * tj + lq; const float gj = gcs[j]; const int pj = 32 * (j >> 5) + perm32(j & 31);
#pragma unroll
    for (int r = 0; r < 16; ++r) { const int i = 32 * ti + crow(r, h); const float dec = __expf(fminf(gcs[i] - gj, 0.f));
      if (which == 0) Lm[i * 64 + j] = (j < i) ? gcs[64 + i] * acc[r] * dec : 0.f;
      else QK[i * 64 + pj] = f2bf((j <= i) ? acc[r] * dec : 0.f); }
  }
  __syncthreads();
  if (tid < 256) {
    const int c = tid; const bool isu = c < 128; const int cc = c & 127;
    const float* rp = (isu ? vf : kf) + cc; const float* sp = gcs + (isu ? 64 : 192);
    f32x2 xx[32];
    f32x4 LA[16], LB[16]; float rh[2];
    xx[0].x = sp[0] * rp[0];
    LA[0] = *(const f32x4*)(Lm + 64); rh[1] = sp[1] * rp[128];
#pragma unroll
    for (int i = 1; i < 64; ++i) {
      f32x4 (&CUR)[16] = (i & 1) ? LA : LB; f32x4 (&NXT)[16] = (i & 1) ? LB : LA;
      if (i + 1 < 64) {
#pragma unroll
        for (int c = 0; c < (i + 4) / 4; ++c) NXT[c] = *(const f32x4*)(Lm + (i + 1) * 64 + 4 * c);
        rh[(i + 1) & 1] = sp[i + 1] * rp[(i + 1) * 128];
      }
      __builtin_amdgcn_sched_barrier(0);
      f32x2 acc = {rh[i & 1], 0.f};
#pragma unroll
      for (int p = 0; p < i / 2; ++p) { const f32x2 lp = (p & 1) ? (f32x2){CUR[p >> 1].z, CUR[p >> 1].w} : (f32x2){CUR[p >> 1].x, CUR[p >> 1].y}; acc = acc - lp * xx[p]; }
      if (i & 1) { const int j = i - 1; const float lj = ((j & 3) == 0) ? CUR[j >> 2].x : CUR[j >> 2].z; acc.x = fmaf(-lj, xx[j >> 1].x, acc.x); }
      const float xi = acc.x + acc.y;
      if (i & 1) xx[i >> 1].y = xi; else xx[i >> 1].x = xi;
      __builtin_amdgcn_sched_barrier(0);
    }
    float x[64];
#pragma unroll
    for (int p = 0; p < 32; ++p) { x[2 * p] = xx[p].x; x[2 * p + 1] = xx[p].y; }
    if (isu) {
#pragma unroll
      for (int i8 = 0; i8 < 8; ++i8) { u32x4 v = {pack2(x[8 * i8], x[8 * i8 + 1]), pack2(x[8 * i8 + 2], x[8 * i8 + 3]), pack2(x[8 * i8 + 4], x[8 * i8 + 5]), pack2(x[8 * i8 + 6], x[8 * i8 + 7])}; *(u32x4*)(Ut + cc * 64 + 8 * i8) = v; }
    } else {
      const int pp = 32 * (cc >> 5) + perm32(cc & 31);
#pragma unroll
      for (int i = 0; i < 64; ++i) Wp[i * 128 + pp] = f2bf(x[i]);
    }
  }
  __syncthreads();
}

DI bf16x8 pack_tiles(const f32x4& a, const f32x4& b) { return pack8(a.x, a.y, a.z, a.w, b.x, b.y, b.z, b.w); }
template <int CTRL> DI float dppf(float v) { return __int_as_float(__builtin_amdgcn_update_dpp(0, __float_as_int(v), CTRL, 0xf, 0xf, true)); }
DI float row16_sum(float v) { v += dppf<0xB1>(v); v += dppf<0x4E>(v); v += dppf<0x141>(v); v += dppf<0x140>(v); return v; }
constexpr size_t OFF_SSQP = OFF_GTOT + 8192;
static_assert(OFF_SSQP + (size_t)8 * S_ * 8 * 4 <= OFF_UT, "overlay3");
constexpr int SCAN_OPB = 62464;
constexpr int SCAN_SO = 2 * SCAN_OPB;
constexpr int SCAN_OT = SCAN_SO + 16384;
DI void gdn_scan_item(const Params& P, int l, int hh, int half, char* smem) {
  const int tid = opaque_tid(), lane = tid & 63, w = tid >> 6, l15 = lane & 15, q4 = lane >> 4;
  const size_t hb = (size_t)hh * 256;
  const bf16_t* Wp = (const bf16_t*)(P.ws + OFF_WP) + hb * 8192; const bf16_t* Qd = (const bf16_t*)(P.ws + OFF_QD) + hb * 8192;
  const bf16_t* Kt = (const bf16_t*)(P.ws + OFF_KT) + hb * 8192; const bf16_t* Zt = (const bf16_t*)(P.ws + OFF_ZT) + hb * 8192;
  const bf16_t* QK = (const bf16_t*)(P.ws + OFF_QK) + hb * 4096; const bf16_t* Ut = (const bf16_t*)(P.ws + OFF_UT) + hb * 8192;
  const float* gt = (const float*)(P.ws + OFF_GTOT) + hb;
  bf16_t* mixin = (bf16_t*)(P.ws + OFF_H);
  float* sSS = (float*)(smem + SCAN_OT + 16384);
  if (w >= 4) {
    const int lt = tid - 256, wl = w - 4;
    const int dvc = 64 * half + 16 * wl + l15; const float nw = P.gdn_norm[l * 128 + dvc];
    const int uoff = dvc * 64 + 4 * q4;
    const int g256 = (lt >> 4) * 128 + (lt & 15) * 8, l256 = (lt >> 4) * 272 + (lt & 15) * 16;
    const int g128 = (lt >> 3) * 64 + (lt & 7) * 8, l128 = (lt >> 3) * 144 + (lt & 7) * 16;
    u32x4 pwA[4], pqA[4], pkA[4], pqkA[2], pwB[4], pqB[4], pkB[4], pqkB[2]; u32x2 zA[4], zB[4];
#define LD_LOAD(PW, PQ, PK, PQK, N) { const int n__ = (N) < 255 ? (N) : 255; const size_t o8 = (size_t)n__ * 8192, o4 = (size_t)n__ * 4096; \
    _Pragma("unroll") for (int i = 0; i < 4; ++i) { PW[i] = *(const u32x4*)(Wp + o8 + g256 + i * 2048); PQ[i] = *(const u32x4*)(Qd + o8 + g256 + i * 2048); PK[i] = *(const u32x4*)(Kt + o8 + g128 + i * 2048); } \
    _Pragma("unroll") for (int i = 0; i < 2; ++i) PQK[i] = *(const u32x4*)(QK + o4 + g128 + i * 2048); }
#define LZ_LOAD(Z, N) { const int n__ = (N) < 255 ? (N) : 255; _Pragma("unroll") for (int it = 0; it < 4; ++it) Z[it] = *(const u32x2*)(Zt + (size_t)n__ * 8192 + uoff + 16 * it); }
#define LD_STAGE(PW, PQ, PK, PQK, NB) { char* nb_ = (NB); \
    _Pragma("unroll") for (int i = 0; i < 4; ++i) { *(u32x4*)(nb_ + l256 + i * 4352) = PW[i]; *(u32x4*)(nb_ + 17408 + l256 + i * 4352) = PQ[i]; *(u32x4*)(nb_ + 34816 + l128 + i * 4608) = PK[i]; } \
    _Pragma("unroll") for (int i = 0; i < 2; ++i) *(u32x4*)(nb_ + 53248 + l128 + i * 4608) = PQK[i]; }
#define LD_FINISH(M, Z) { const int m = (M); const char* so = smem + SCAN_SO + (m & 1) * 8192 + (wl * 4) * 512 + lane * 8; \
    bf16_t* ot = (bf16_t*)(smem + SCAN_OT + (m & 1) * 8192); float* sq = sSS + (m & 1) * 256 + wl * 64; \
    _Pragma("unroll") for (int it = 0; it < 4; ++it) { \
      const u32x2 ob = *(const u32x2*)(so + it * 512); const f32x4 o = {bflo(ob.x), bfhi(ob.x), bflo(ob.y), bfhi(ob.y)}; \
      f32x4 ss = o * o; ss.x = row16_sum(ss.x); ss.y = row16_sum(ss.y); ss.z = row16_sum(ss.z); ss.w = row16_sum(ss.w); \
      const int rl = 16 * it + 4 * q4; \
      if (l15 == 0) *(f32x4*)(sq + rl) = ss; \
      bf16_t* op = ot + rl * 64 + 16 * wl + l15; \
      op[0] = f2bf(o.x * nw * bflo(Z[it].x)); op[64] = f2bf(o.y * nw * bfhi(Z[it].x)); op[128] = f2bf(o.z * nw * bflo(Z[it].y)); op[192] = f2bf(o.w * nw * bfhi(Z[it].y)); } }
#define LD_STEP(PW, PQ, PK, PQK, ZU, N) { const int n_ = (N); \
    LD_STAGE(PW, PQ, PK, PQK, smem + ((n_ + 1) & 1) * SCAN_OPB); \
    LD_LOAD(PW, PQ, PK, PQK, n_ + 3); \
    if (n_ >= 1) LD_FINISH(n_ - 1, ZU); \
    LZ_LOAD(ZU, n_ + 1); \
    __syncthreads(); }
    LD_LOAD(pwA, pqA, pkA, pqkA, 0);
    LD_STAGE(pwA, pqA, pkA, pqkA, smem);
    LD_LOAD(pwA, pqA, pkA, pqkA, 1);
    LD_LOAD(pwB, pqB, pkB, pqkB, 2);
    LZ_LOAD(zB, 0);
    LZ_LOAD(zA, 0);
    __syncthreads();
#pragma unroll 1
    for (int n = 0; n < 256; n += 2) {
      LD_STEP(pwA, pqA, pkA, pqkA, zA, n);
      LD_STEP(pwB, pqB, pkB, pqkB, zB, n + 1);
    }
    LD_FINISH(255, zA);
    __syncthreads();
#undef LD_LOAD
#undef LZ_LOAD
#undef LD_STAGE
#undef LD_FINISH
#undef LD_STEP
  } else {
    const int dvc = 64 * half + 16 * w + l15;
    const int uoff = dvc * 64 + 4 * q4;
    float* ssqp = (float*)(P.ws + OFF_SSQP) + (size_t)(half * 4 + w) * S_ * 8;
    f32x4 St[8];
#pragma unroll
    for (int t = 0; t < 8; ++t) St[t] = (f32x4){0.f, 0.f, 0.f, 0.f};
    u32x2 uc[4], un[4]; float gcur, gn = 0.f;
#pragma unroll
    for (int it = 0; it < 4; ++it) { uc[it] = *(const u32x2*)(Ut + uoff + 16 * it); un[it] = uc[it]; }
    gcur = gt[0];
#define CP_OUT(M) { const int m2 = (M); const char* ot = smem + SCAN_OT + (m2 & 1) * 8192; \
      _Pragma("unroll") for (int i = 0; i < 2; ++i) { const int c = tid + 256 * i, row = c >> 3, cc = c & 7; \
        *(u32x4*)(mixin + (size_t)(64 * m2 + row) * 2048 + hh * 128 + 64 * half + cc * 8) = *(const u32x4*)(ot + row * 128 + cc * 16); } \
      ssqp[(size_t)(64 * m2 + lane) * 8 + hh] = sSS[(m2 & 1) * 256 + w * 64 + lane]; }
    __syncthreads();
#pragma unroll 2
    for (int n = 0; n < 256; ++n) {
      const char* cb = smem + (n & 1) * SCAN_OPB;
      const char* sWp = cb; const char* sQd = cb + 17408; const char* sKt = cb + 34816; const char* sQK = cb + 53248;
      if (n + 1 < 256) { const size_t o8 = (size_t)(n + 1) * 8192;
#pragma unroll
        for (int it = 0; it < 4; ++it) un[it] = *(const u32x2*)(Ut + o8 + uoff + 16 * it);
        gn = gt[n + 1]; }
      bf16x8 sb[4];
#pragma unroll
      for (int ks = 0; ks < 4; ++ks) sb[ks] = pack_tiles(St[2 * ks], St[2 * ks + 1]);
      f32x4 wsv[4], qs[4];
#pragma unroll
      for (int it = 0; it < 4; ++it) { wsv[it] = (f32x4){0.f, 0.f, 0.f, 0.f}; qs[it] = (f32x4){0.f, 0.f, 0.f, 0.f}; }
#pragma unroll
      for (int it = 0; it < 4; ++it)
#pragma unroll
        for (int ks = 0; ks < 4; ++ks) { const int o = (16 * it + l15) * 272 + 64 * ks + 16 * q4;
          const bf16x8 a = *(const bf16x8*)(sWp + o), a2 = *(const bf16x8*)(sQd + o);
          wsv[it] = MFMA16(a, sb[ks], wsv[it]); qs[it] = MFMA16(a2, sb[ks], qs[it]); }
      f32x4 vn[4];
#pragma unroll
      for (int it = 0; it < 4; ++it) { const f32x4 uf = {bflo(uc[it].x), bfhi(uc[it].x), bflo(uc[it].y), bfhi(uc[it].y)}; vn[it] = uf - wsv[it]; }
      bf16x8 vb[2];
#pragma unroll
      for (int ks = 0; ks < 2; ++ks) vb[ks] = pack_tiles(vn[2 * ks], vn[2 * ks + 1]);
#pragma unroll
      for (int it = 0; it < 4; ++it)
#pragma unroll
        for (int ks = 0; ks < 2; ++ks) { const bf16x8 a = *(const bf16x8*)(sQK + (16 * it + l15) * 144 + 64 * ks + 16 * q4); qs[it] = MFMA16(a, vb[ks], qs[it]); }
      { char* so = smem + SCAN_SO + (n & 1) * 8192 + (w * 4) * 512 + lane * 8;
#pragma unroll
        for (int it = 0; it < 4; ++it) { u32x2 ob = {pack2(qs[it].x, qs[it].y), pack2(qs[it].z, qs[it].w)}; *(u32x2*)(so + it * 512) = ob; } }
#pragma unroll
      for (int t = 0; t < 8; ++t) { St[t] *= gcur;
#pragma unroll
        for (int ks = 0; ks < 2; ++ks) { const bf16x8 a = *(const bf16x8*)(sKt + (16 * t + l15) * 144 + 64 * ks + 16 * q4); St[t] = MFMA16(a, vb[ks], St[t]); } }
#pragma unroll
      for (int it = 0; it < 4; ++it) uc[it] = un[it];
      gcur = gn;
      if (n >= 2) CP_OUT(n - 2);
      __syncthreads();
    }
    CP_OUT(254);
    __syncthreads();
    CP_OUT(255);
#undef CP_OUT
  }
  __syncthreads();
}
DI void gdn_fix_phase(const Params& P) {
  const int tid = opaque_tid();
  bf16_t* mixin = (bf16_t*)(P.ws + OFF_H); const float* ssqp = (const float*)(P.ws + OFF_SSQP);
  for (int idx = blockIdx.x * NT + tid; idx < S_ * 128; idx += gridDim.x * NT) {
    const int t = idx >> 7, ck = idx & 127, h = ck >> 4;
    float sq = 0.f;
#pragma unroll
    for (int p = 0; p < 8; ++p) sq += ssqp[((size_t)p * S_ + t) * 8 + h];
    const float r = rsqrtf(sq * (1.f / 128.f) + EPS);
    u32x4* pp = (u32x4*)(mixin + (size_t)t * 2048 + ck * 8); const u32x4 v = *pp; float f[8]; unpack8(v, f);
    u32x4 o = {pack2(f[0] * r, f[1] * r), pack2(f[2] * r, f[3] * r), pack2(f[4] * r, f[5] * r), pack2(f[6] * r, f[7] * r)}; *pp = o;
  }
}

DI void mla_attn_item(const Params& P, int hd, int b, char* smem) {
  const int tid = opaque_tid(), lane = tid & 63, w = tid >> 6, wq = w & 3, hk = w >> 2, lq = lane & 31, h = lane >> 5;
  const float* qraw = (const float*)(P.ws + OFF_QRAW);
  const bf16_t* Kg = (const bf16_t*)(P.ws + OFF_KMLA) + (size_t)hd * S_ * 192;
  const bf16_t* Vg = (const bf16_t*)(P.ws + OFF_VT) + (size_t)hd * 128 * S_;
  bf16_t* mixin = (bf16_t*)(P.ws + OFF_H);
  const int q = 128 * b + 32 * wq + lq;
  bf16x8 qf[12];
  {
    const float* qp = qraw + (size_t)q * 768 + hd * 192 + 8 * h;
    const float sc = 0.07216878364870322f * LOG2E;
#pragma unroll
    for (int s = 0; s < 8; ++s) { const f32x4 a = *(const f32x4*)(qp + 16 * s), c = *(const f32x4*)(qp + 16 * s + 4);
      qf[s] = pack8(a.x * sc, a.y * sc, a.z * sc, a.w * sc, c.x * sc, c.y * sc, c.z * sc, c.w * sc); }
    const double pq = (double)P.pos[q];
#pragma unroll
    for (int s2 = 0; s2 < 2; ++s2) {
      const f32x4 a0 = *(const f32x4*)(qp + 128 + 16 * s2), a1 = *(const f32x4*)(qp + 128 + 16 * s2 + 4);
      const f32x4 b0 = *(const f32x4*)(qp + 160 + 16 * s2), b1 = *(const f32x4*)(qp + 160 + 16 * s2 + 4);
      float x1[8] = {a0.x, a0.y, a0.z, a0.w, a1.x, a1.y, a1.z, a1.w}, x2[8] = {b0.x, b0.y, b0.z, b0.w, b1.x, b1.y, b1.z, b1.w}, o1[8], o2[8];
#pragma unroll
      for (int j = 0; j < 8; ++j) { double fr = pq * kInvFreq2Pi[16 * s2 + 8 * h + j]; fr -= floor(fr); const float ff = (float)fr;
        const float sn = __builtin_amdgcn_sinf(ff), cs = __builtin_amdgcn_cosf(ff);
        o1[j] = (x1[j] * cs - x2[j] * sn) * sc; o2[j] = (x2[j] * cs + x1[j] * sn) * sc; }
      qf[8 + s2] = pack8(o1[0], o1[1], o1[2], o1[3], o1[4], o1[5], o1[6], o1[7]);
      qf[10 + s2] = pack8(o2[0], o2[1], o2[2], o2[3], o2[4], o2[5], o2[6], o2[7]);
    }
  }
  constexpr int KST = 64 * 400, VST = 128 * 144, STG = KST + VST;
  f32x16 O[4];
#pragma unroll
  for (int i = 0; i < 4; ++i)
#pragma unroll
    for (int r = 0; r < 16; ++r) O[i][r] = 0.f;
  float m_i = -1e30f, l_i = 0.f;
  const int nt = 2 * b + 2;
  u32x4 rk0[3], rv0[2], rk1[3], rv1[2];
  const int vrow = tid >> 3, vcc = tid & 7;
  const int ntl = nt - 1;
#define AT_LOAD(RK, RV, T) { const size_t ko_ = (size_t)(T) * 64 * 192; const int vo_ = (T) * 64; \
    _Pragma("unroll") for (int i = 0; i < 3; ++i) { const int id = tid + NT * i, row = id / 24, cc = id % 24; RK[i] = *(const u32x4*)(Kg + ko_ + row * 192 + cc * 8); } \
    _Pragma("unroll") for (int i = 0; i < 2; ++i) RV[i] = *(const u32x4*)(Vg + (size_t)(vrow + 64 * i) * S_ + vo_ + vcc * 8); }
#define AT_WRITE(RK, RV, ST) { char* dK = smem + (ST) * STG; \
    _Pragma("unroll") for (int i = 0; i < 3; ++i) { const int id = tid + NT * i, row = id / 24, cc = id % 24; *(u32x4*)(dK + row * 400 + cc * 16) = RK[i]; } \
    _Pragma("unroll") for (int i = 0; i < 2; ++i) *(u32x4*)(dK + KST + (vrow + 64 * i) * 144 + vcc * 16) = RV[i]; }
#define AT_COMPUTE(ST, KT) { const char* sK = smem + (ST) * STG; const char* sV = sK + KST; const int key0 = 64 * (KT) + 32 * hk; \
    if (key0 <= 128 * b + 32 * wq) { \
      f32x16 st; _Pragma("unroll") for (int r = 0; r < 16; ++r) st[r] = 0.f; \
      _Pragma("unroll") for (int s = 0; s < 12; ++s) { const bf16x8 kf = *(const bf16x8*)(sK + (32 * hk + lq) * 400 + (2 * s + h) * 16); st = MFMA32(kf, qf[s], st); } \
      if (key0 + 31 > 128 * b + 32 * wq) { int qrel = q - key0 - 4 * h; asm volatile("" : "+v"(qrel)); \
        _Pragma("unroll") for (int r = 0; r < 16; ++r) if ((r & 3) + 8 * (r >> 2) > qrel) st[r] = -1e30f; } \
      float mx = st[0]; _Pragma("unroll") for (int r = 1; r < 16; ++r) mx = fmaxf(mx, st[r]); \
      mx = xhalf_max(mx); \
      const float m_new = fmaxf(m_i, mx), alpha = __builtin_amdgcn_exp2f(m_i - m_new); float ps = 0.f; \
      _Pragma("unroll") for (int r = 0; r < 16; ++r) { st[r] = __builtin_amdgcn_exp2f(st[r] - m_new); ps += st[r]; } \
      l_i = l_i * alpha + ps; \
      if (__any(m_new != m_i)) { _Pragma("unroll") for (int i = 0; i < 4; ++i) _Pragma("unroll") for (int r = 0; r < 16; ++r) O[i][r] *= alpha; } \
      m_i = m_new; \
      bf16x8 pf[2]; \
      _Pragma("unroll") for (int s = 0; s < 2; ++s) pf[s] = pack8(st[8 * s], st[8 * s + 1], st[8 * s + 2], st[8 * s + 3], st[8 * s + 4], st[8 * s + 5], st[8 * s + 6], st[8 * s + 7]); \
      _Pragma("unroll") for (int i = 0; i < 4; ++i) _Pragma("unroll") for (int s = 0; s < 2; ++s) { const char* vp = sV + (32 * i + lq) * 144 + (32 * hk + 16 * s + 4 * h) * 2; \
          const u32x2 lo = *(const u32x2*)vp, hi = *(const u32x2*)(vp + 16); u32x4 vv = {lo.x, lo.y, hi.x, hi.y}; \
          O[i] = MFMA32(__builtin_bit_cast(bf16x8, vv), pf[s], O[i]); } } }
  AT_LOAD(rk0, rv0, 0);
  AT_LOAD(rk1, rv1, 1);
  AT_WRITE(rk0, rv0, 0);
  AT_LOAD(rk0, rv0, (2 < ntl ? 2 : ntl));
  __syncthreads();
  for (int kt = 0; kt < nt; kt += 2) {
    AT_WRITE(rk1, rv1, 1);
    AT_LOAD(rk1, rv1, (kt + 3 < ntl ? kt + 3 : ntl));
    AT_COMPUTE(0, kt);
    __syncthreads();
    AT_WRITE(rk0, rv0, 0);
    AT_LOAD(rk0, rv0, (kt + 4 < ntl ? kt + 4 : ntl));
    AT_COMPUTE(1, kt + 1);
    __syncthreads();
  }
#undef AT_LOAD
#undef AT_WRITE
#undef AT_COMPUTE
  float* cO = (float*)smem; float* cm = cO + 4 * 4096; float* cl = cm + 256;
  if (hk == 1) {
#pragma unroll
    for (int i = 0; i < 4; ++i)
#pragma unroll
      for (int r = 0; r < 16; ++r) cO[wq * 4096 + (i * 16 + r) * 64 + lane] = O[i][r];
    cm[wq * 64 + lane] = m_i; cl[wq * 64 + lane] = l_i;
  }
  __syncthreads();
  if (hk == 0) {
    const float m1 = cm[wq * 64 + lane], l1 = cl[wq * 64 + lane];
    const float m = fmaxf(m_i, m1), a0 = exp2f(m_i - m), a1 = exp2f(m1 - m);
    float lt = l_i * a0 + l1 * a1; lt += __shfl_xor(lt, 32);
    const float inv = 1.f / lt;
    bf16_t* op = mixin + (size_t)q * 2048 + 1024 + hd * 128;
#pragma unroll
    for (int i = 0; i < 4; ++i)
#pragma unroll
      for (int rg = 0; rg < 4; ++rg) { float v[4];
#pragma unroll
        for (int e = 0; e < 4; ++e) v[e] = (O[i][4 * rg + e] * a0 + cO[wq * 4096 + (i * 16 + 4 * rg + e) * 64 + lane] * a1) * inv;
        u32x2 pk = {pack2(v[0], v[1]), pack2(v[2], v[3])}; *(u32x2*)(op + 32 * i + 8 * rg + 4 * h) = pk; }
  }
  __syncthreads();
}

DI void swa_item(const Params& P, int l, int n, int hk2, char* smem) {
  const int tid = opaque_tid(), lane = tid & 63, w = tid >> 6, lq = lane & 31, h = lane >> 5;
  const bf16_t* proj = (const bf16_t*)(P.ws + OFF_PROJ); bf16_t* mixin = (bf16_t*)(P.ws + OFF_H);
  bf16_t* sVt = (bf16_t*)smem;
#pragma unroll
  for (int i = 0; i < 4; ++i) { const int id = tid + NT * i, key = id >> 3, dc = id & 7; const int kp = 128 * (n - 1) + key;
    u32x4 v = {0u, 0u, 0u, 0u}; if (kp >= 0) v = *(const u32x4*)(proj + (size_t)kp * DINP + C_CV + hk2 * 64 + dc * 8);
    sVt[(8 * dc + 0) * 264 + key] = (bf16_t)(v.x & 0xffff); sVt[(8 * dc + 1) * 264 + key] = (bf16_t)(v.x >> 16);
    sVt[(8 * dc + 2) * 264 + key] = (bf16_t)(v.y & 0xffff); sVt[(8 * dc + 3) * 264 + key] = (bf16_t)(v.y >> 16);
    sVt[(8 * dc + 4) * 264 + key] = (bf16_t)(v.z & 0xffff); sVt[(8 * dc + 5) * 264 + key] = (bf16_t)(v.z >> 16);
    sVt[(8 * dc + 6) * 264 + key] = (bf16_t)(v.w & 0xffff); sVt[(8 * dc + 7) * 264 + key] = (bf16_t)(v.w >> 16); }
  __syncthreads();
  const int g = w >> 1, hq = hk2 * 4 + g;
  const float slope = exp2f(-(float)(hq + 1)) * LOG2E, sinkv = P.swa_sinks[l * 8 + hq] * LOG2E;
#pragma unroll 1
  for (int jj = 0; jj < 2; ++jj) {
    const int j = 2 * (w & 1) + jj; const int qrow = 128 * n + 32 * j + lq;
    bf16x8 qf[4];
#pragma unroll
    for (int s = 0; s < 4; ++s) qf[s] = *(const bf16x8*)(proj + (size_t)qrow * DINP + C_CQ + hq * 64 + 16 * s + 8 * h);
    f32x16 st[5];
    bf16x8 kf[2][4];
    { const int kp = 128 * (n - 1) + 32 * j + lq;
#pragma unroll
      for (int s = 0; s < 4; ++s) { kf[0][s] = (bf16x8){0, 0, 0, 0, 0, 0, 0, 0}; if (kp >= 0) kf[0][s] = *(const bf16x8*)(proj + (size_t)kp * DINP + C_CK + hk2 * 64 + 16 * s + 8 * h); } }
#pragma unroll
    for (int tt = 0; tt < 5; ++tt) {
      if (tt + 1 < 5) { const int kp = 128 * (n - 1) + 32 * (j + tt + 1) + lq;
#pragma unroll
        for (int s = 0; s < 4; ++s) { kf[(tt + 1) & 1][s] = (bf16x8){0, 0, 0, 0, 0, 0, 0, 0}; if (kp >= 0) kf[(tt + 1) & 1][s] = *(const bf16x8*)(proj + (size_t)kp * DINP + C_CK + hk2 * 64 + 16 * s + 8 * h); } }
      __builtin_amdgcn_sched_barrier(0);
#pragma unroll
      for (int r = 0; r < 16; ++r) st[tt][r] = 0.f;
#pragma unroll
      for (int s = 0; s < 4; ++s) st[tt] = MFMA32(kf[tt & 1][s], qf[s], st[tt]);
      __builtin_amdgcn_sched_barrier(0);
    }
    float mx = sinkv;
    int dbase = 128 + lq - 4 * h, kbase = 128 * (n - 1) + 32 * j + 4 * h;
    asm volatile("" : "+v"(dbase), "+v"(kbase));
#pragma unroll
    for (int tt = 0; tt < 5; ++tt)
#pragma unroll
      for (int r = 0; r < 16; ++r) { const int cst = 32 * tt + (r & 3) + 8 * (r >> 2); const int dist = dbase - cst; const int kpos = kbase + cst;
        const bool valid = (dist >= 0) && (dist < 128) && (kpos >= 0);
        const float sv = valid ? st[tt][r] * (0.125f * LOG2E) - slope * (float)dist : -1e30f; st[tt][r] = sv; mx = fmaxf(mx, sv); }
    mx = fmaxf(mx, __shfl_xor(mx, 32));
    float den = 0.f;
#pragma unroll
    for (int tt = 0; tt < 5; ++tt)
#pragma unroll
      for (int r = 0; r < 16; ++r) { const float p = exp2f(st[tt][r] - mx); st[tt][r] = p; den += p; }
    den += __shfl_xor(den, 32); den += exp2f(sinkv - mx);
    f32x16 O[2];
#pragma unroll
    for (int i = 0; i < 2; ++i)
#pragma unroll
      for (int r = 0; r < 16; ++r) O[i][r] = 0.f;
#pragma unroll
    for (int tt = 0; tt < 5; ++tt)
#pragma unroll
      for (int s = 0; s < 2; ++s) { const bf16x8 pf = pack8(st[tt][8 * s], st[tt][8 * s + 1], st[tt][8 * s + 2], st[tt][8 * s + 3], st[tt][8 * s + 4], st[tt][8 * s + 5], st[tt][8 * s + 6], st[tt][8 * s + 7]);
#pragma unroll
        for (int i = 0; i < 2; ++i) { const char* vp = (const char*)sVt + (32 * i + lq) * 528 + (32 * (j + tt) + 16 * s + 4 * h) * 2;
          const u32x2 lo = *(const u32x2*)vp, hi = *(const u32x2*)(vp + 16); u32x4 vv = {lo.x, lo.y, hi.x, hi.y};
          O[i] = MFMA32(__builtin_bit_cast(bf16x8, vv), pf, O[i]); }
        __builtin_amdgcn_sched_barrier(0); }
    const float inv = 1.f / den;
    bf16_t* op = mixin + (size_t)qrow * 2048 + 1536 + hq * 64;
#pragma unroll
    for (int i = 0; i < 2; ++i)
#pragma unroll
      for (int rg = 0; rg < 4; ++rg) { u32x2 pk = {pack2(O[i][4 * rg] * inv, O[i][4 * rg + 1] * inv), pack2(O[i][4 * rg + 2] * inv, O[i][4 * rg + 3] * inv)};
        *(u32x2*)(op + 32 * i + 8 * rg + 4 * h) = pk; }
  }
  __syncthreads();
}

DI float gelu_tanh(float x) { const float y = 0.7978845608028654f * (x + 0.044715f * x * x * x); const float t = 1.f - 2.f * __builtin_amdgcn_rcpf(1.f + __expf(2.f * y)); return 0.5f * x * (1.f + t); }
DI void ffn_act_phase(const Params& P, int l) {
  const int tid = opaque_tid(), lane = tid & 63, w = tid >> 6;
  const bf16_t* u = (const bf16_t*)(P.ws + OFF_BIG); bf16_t* act = (bf16_t*)(P.ws + OFF_ACT);
  const float* cw = P.ffn_conv + (size_t)l * 3 * DFF2; const float* cb = P.ffn_conv_b + (size_t)l * DFF2;
  for (int item = blockIdx.x * 8 + w; item < 512 * 11; item += gridDim.x * 8) {
    const int cbk = item % 11, rr = item / 11; const int ch = cbk * 512 + lane * 8, r0 = rr * 32;
    float wg[3][8], wu[3][8], bg[8], bu[8];
#pragma unroll
    for (int j = 0; j < 3; ++j)
#pragma unroll
      for (int e4 = 0; e4 < 2; ++e4) { const f32x4 a = *(const f32x4*)(cw + (size_t)j * DFF2 + ch + 4 * e4), b = *(const f32x4*)(cw + (size_t)j * DFF2 + DFF + ch + 4 * e4);
        wg[j][4 * e4] = a.x; wg[j][4 * e4 + 1] = a.y; wg[j][4 * e4 + 2] = a.z; wg[j][4 * e4 + 3] = a.w; wu[j][4 * e4] = b.x; wu[j][4 * e4 + 1] = b.y; wu[j][4 * e4 + 2] = b.z; wu[j][4 * e4 + 3] = b.w; }
#pragma unroll
    for (int e4 = 0; e4 < 2; ++e4) { const f32x4 a = *(const f32x4*)(cb + ch + 4 * e4), b = *(const f32x4*)(cb + DFF + ch + 4 * e4);
      bg[4 * e4] = a.x; bg[4 * e4 + 1] = a.y; bg[4 * e4 + 2] = a.z; bg[4 * e4 + 3] = a.w; bu[4 * e4] = b.x; bu[4 * e4 + 1] = b.y; bu[4 * e4 + 2] = b.z; bu[4 * e4 + 3] = b.w; }
    float g2[8], g1[8], u2[8], u1[8];
#pragma unroll
    for (int e = 0; e < 8; ++e) { g2[e] = 0.f; g1[e] = 0.f; u2[e] = 0.f; u1[e] = 0.f; }
    if (r0 >= 2) { unpack8(*(const u32x4*)(u + (size_t)(r0 - 2) * DFF2 + ch), g2); unpack8(*(const u32x4*)(u + (size_t)(r0 - 2) * DFF2 + DFF + ch), u2);
      unpack8(*(const u32x4*)(u + (size_t)(r0 - 1) * DFF2 + ch), g1); unpack8(*(const u32x4*)(u + (size_t)(r0 - 1) * DFF2 + DFF + ch), u1); }
#pragma unroll 1
    for (int rb = 0; rb < 4; ++rb) {
      u32x4 G[8], U[8];
#pragma unroll
      for (int i = 0; i < 8; ++i) { const size_t ro = (size_t)(r0 + rb * 8 + i) * DFF2 + ch; G[i] = *(const u32x4*)(u + ro); U[i] = *(const u32x4*)(u + ro + DFF); }
#pragma unroll
      for (int i = 0; i < 8; ++i) {
        float g0[8], u0[8]; unpack8(G[i], g0); unpack8(U[i], u0);
        float o[8];
#pragma unroll
        for (int e = 0; e < 8; ++e) { const float yg = wg[0][e] * g2[e] + wg[1][e] * g1[e] + wg[2][e] * g0[e] + bg[e]; const float yu = wu[0][e] * u2[e] + wu[1][e] * u1[e] + wu[2][e] * u0[e] + bu[e];
          o[e] = gelu_tanh(yg) * yu; g2[e] = g1[e]; g1[e] = g0[e]; u2[e] = u1[e]; u1[e] = u0[e]; }
        u32x4 pk = {pack2(o[0], o[1]), pack2(o[2], o[3]), pack2(o[4], o[5]), pack2(o[6], o[7])};
        *(u32x4*)(act + (size_t)(r0 + rb * 8 + i) * DFF + ch) = pk;
      }
    }
  }
}

#define XB_TMO      128
#define XB_XCNT(j)  (256  + 64 * (j))
#define XB_XSUB(j)  (1280 + 64 * (j))
#define XB_XGEN(j)  (2304 + 64 * (j))
#define XB_TOP      3328
#define XB_TOPGEN   3392
#define XCD_BAR_WORDS 3456
#define XB_SPIN_CAP (1u << 18)
#define LAS __attribute__((address_space(3)))
DI unsigned xb_ld(unsigned* p)              { return __hip_atomic_load(p, __ATOMIC_RELAXED, __HIP_MEMORY_SCOPE_AGENT); }
DI unsigned xb_add(unsigned* p, unsigned v) { return __hip_atomic_fetch_add(p, v, __ATOMIC_RELAXED, __HIP_MEMORY_SCOPE_AGENT); }
DI unsigned xb_xcc_id() { return (unsigned)__builtin_amdgcn_s_getreg((3 << 11) | 20) & 0xFu; }
#define XB_SPIN(cond, bar) do { unsigned _sp = 0; while (cond) { __builtin_amdgcn_s_sleep(1); \
    if ((++_sp & 255u) == 0u) { if (xb_ld(&(bar)[XB_TMO])) break; if (_sp > XB_SPIN_CAP) { atomicAdd(&(bar)[XB_TMO], 1u); break; } } } } while (0)
struct XcdBarrier { unsigned* bar; unsigned x; volatile LAS unsigned* st; };
DI XcdBarrier xcd_barrier_post(unsigned* bar, volatile LAS unsigned* st) {
  XcdBarrier b; b.bar = bar; b.x = xb_xcc_id(); b.st = st;
  if (threadIdx.x == 0) (void)xb_add(&bar[XB_XCNT(b.x)], 1u);
  return b;
}
DI void xcd_barrier_complete(unsigned* bar, unsigned x, unsigned& nloc, unsigned& nx) {
  const unsigned G = gridDim.x * gridDim.y * gridDim.z;
  unsigned sum, cnt, mine, sp = 0u;
  for (;;) {
    sum = 0u; cnt = 0u; mine = 0u;
#pragma unroll
    for (unsigned j = 0; j < 16; ++j) { const unsigned c = xb_ld(&bar[XB_XCNT(j)]); sum += c; cnt += (c > 0u) ? 1u : 0u; mine = (j == x) ? c : mine; }
    if (sum == G) break;
    __builtin_amdgcn_s_sleep(1);
    if ((++sp & 255u) == 0u) { if (xb_ld(&bar[XB_TMO])) break; if (sp > XB_SPIN_CAP) { atomicAdd(&bar[XB_TMO], 1u); break; } }
  }
  nloc = mine > 0u ? mine : 1u; nx = cnt > 0u ? cnt : 1u;
}
DI void xcd_barrier(char* ws_, char* smem_) {
  XcdBarrier b; b.bar = (unsigned*)(ws_ + OFF_XBAR); b.x = xb_xcc_id(); b.st = (volatile LAS unsigned*)(smem_ + 159760);
  asm volatile("s_waitcnt vmcnt(0)" ::: "memory");
  __syncthreads();
  if (threadIdx.x == 0) {
    unsigned* bar = b.bar;
    __builtin_amdgcn_s_waitcnt(0);
    unsigned nloc = b.st[0], nx = b.st[1];
    if (nloc == 0u) { xcd_barrier_complete(bar, b.x, nloc, nx); b.st[0] = nloc; b.st[1] = nx; }
    const unsigned old = xb_add(&bar[XB_XSUB(b.x)], 1u);
    const unsigned gen = old / nloc;
    if (old + 1u == (gen + 1u) * nloc) {
      __builtin_amdgcn_fence(__ATOMIC_RELEASE, "agent");
      asm volatile("s_waitcnt vmcnt(0)" ::: "memory");
      const unsigned og = xb_add(&bar[XB_TOP], 1u);
      const unsigned tg = og / nx;
      if (og + 1u == (tg + 1u) * nx) xb_add(&bar[XB_TOPGEN], 1u);
      else XB_SPIN(xb_ld(&bar[XB_TOPGEN]) == tg, bar);
      __builtin_amdgcn_fence(__ATOMIC_ACQUIRE, "agent");
      xb_add(&bar[XB_XGEN(b.x)], 1u);
      asm volatile("s_waitcnt vmcnt(0)" ::: "memory");
    } else {
      XB_SPIN(xb_ld(&bar[XB_XGEN(b.x)]) == gen, bar);
      __builtin_amdgcn_fence(__ATOMIC_ACQUIRE, "agent");
      asm volatile("s_waitcnt vmcnt(0)" ::: "memory");
    }
  }
  __syncthreads();
}

__global__ void __launch_bounds__(NT) fwd_megakernel(Params P0) {
  cg::grid_group grid = cg::this_grid();
  __shared__ __attribute__((aligned(16))) char smem[160512];
  const int tid = threadIdx.x;
  char* ws = P0.ws;
  int* ctrl = (int*)(ws + OFF_CTRL);
  if (blockIdx.x == 0 && tid < 64) ctrl[tid] = 0;
  if (blockIdx.x == 0) for (int i = tid; i < XCD_BAR_WORDS; i += NT) ((unsigned*)(ws + OFF_XBAR))[i] = 0u;
  if (tid < 4) ((unsigned*)(smem + 159760))[tid] = 0u;
  if (blockIdx.x == 0 && tid == 0) *(Params*)(ws + OFF_CTRL + 1024) = P0;
  bf16_t* Hb = (bf16_t*)(ws + OFF_H);
  for (int it = blockIdx.x; it < 192 + CV_T5; it += gridDim.x) { if (it < 192) mod_item(P0, it); else convert_item(P0, 0, it - 192, smem); }
  grid.sync();
  (void)xcd_barrier_post((unsigned*)(ws + OFF_XBAR), (volatile LAS unsigned*)(smem + 159760));
  const Params& P = *(const Params*)(ws + OFF_CTRL + 1024);
  rownorm_phase(P, P.x, nullptr, P.out, Hb, 0, 0, nullptr, 0, 1, 0, P.mix_pre, smem);
  xcd_barrier(ws, smem);
  for (int l = 0; l < 2; ++l) {
    { EpiProj epi{(bf16_t*)(ws + OFF_PROJ), (float*)(ws + OFF_AB)}; gemm_phase(Hb, 2048, (const bf16_t*)(ws + OFF_W + W_IN), 2048, 2048, 64, 22, smem, epi); }
    xcd_barrier(ws, smem);
    for (int it = blockIdx.x; it < 448; it += gridDim.x) {
      if (it < 192) mla_q_tile(P, it / 3, it % 3, smem);
      else mla_kv_tile(P, (it - 192) >> 2, (it - 192) & 3, smem);
    }
    for (int id = (blockIdx.x + 64) % gridDim.x; id < 2048; id += gridDim.x) gdn_prep_item(P, l, id >> 3, id & 7, smem);
    xcd_barrier(ws, smem);
    {
      int* sitem = (int*)(smem + 159744);
      for (;;) {
        if (tid == 0) *sitem = atomicAdd(ctrl + 16 * l, 1);
        __syncthreads(); const int item = *sitem; __syncthreads();
        if (item >= 16 + 512 + 256) break;
        if (item < 16) gdn_scan_item(P, l, item >> 1, item & 1, smem);
        else if (item < 528) { const int idx = item - 16; mla_attn_item(P, idx & 3, 127 - (idx >> 2), smem); }
        else { const int idx = item - 528; swa_item(P, l, idx >> 1, idx & 1, smem); }
      }
    }
    xcd_barrier(ws, smem);
    gdn_fix_phase(P);
    xcd_barrier(ws, smem);
    { EpiBf epi{(bf16_t*)(ws + OFF_MIXF), 2048}; gemm_phase(Hb, 2048, (const bf16_t*)(ws + OFF_W + W_OUT), 2048, 2048, 64, 8, smem, epi); }
    xcd_barrier(ws, smem);
    rownorm_phase(P, P.out, (const bf16_t*)(ws + OFF_MIXF), P.out, Hb, l, 2, P.mix_post + l * 2048, l, 4, 3, P.ffn_pre + l * 2048, smem);
    xcd_barrier(ws, smem);
    { EpiBf epi{(bf16_t*)(ws + OFF_BIG), DFF2}; gemm_phase(Hb, 2048, (const bf16_t*)(ws + OFF_W + W_UP), 2048, 2048, 64, 44, smem, epi); }
    xcd_barrier(ws, smem);
    ffn_act_phase(P, l);
    xcd_barrier(ws, smem);
    { EpiBf epi{(bf16_t*)(ws + OFF_Y), 2048}; gemm_phase((const bf16_t*)(ws + OFF_ACT), DFF, (const bf16_t*)(ws + OFF_W + W_DOWN), DFF, DFF, 64, 8, smem, epi); }
    xcd_barrier(ws, smem);
    if (l == 0) {
      for (int it = blockIdx.x; it < CV_T5; it += gridDim.x) convert_item(P, 1, it, smem);
      rownorm_phase(P, P.out, (const bf16_t*)(ws + OFF_Y), P.out, Hb, 0, 5, P.ffn_post, 1, 1, 0, P.mix_pre + 2048, smem);
      xcd_barrier(ws, smem);
    } else {
      rownorm_phase(P, P.out, (const bf16_t*)(ws + OFF_Y), P.out, nullptr, 1, 5, P.ffn_post + 2048, 1, 1, 0, nullptr, smem);
    }
  }
}

extern "C" void kernel_launch(void* const* d_in, const int* in_sizes, int n_in, void* d_out, int out_size, void* d_ws, size_t ws_size, hipStream_t stream) {
  static int grid_blocks = 0;
  if (!grid_blocks) {
    int dev = 0, cus = 0, per = 0;
    (void)hipGetDevice(&dev); (void)hipDeviceGetAttribute(&cus, hipDeviceAttributeMultiprocessorCount, dev);
    (void)hipOccupancyMaxActiveBlocksPerMultiprocessor(&per, fwd_megakernel, NT, 0);
    if (per > 1) per = 1;
    grid_blocks = cus * per; if (grid_blocks <= 0) grid_blocks = 256;
  }
  if (ws_size < OFF_END) { fprintf(stderr, "workspace too small: %zu < %zu\n", ws_size, (size_t)OFF_END); return; }
  Params p{};
  p.x = (const float*)d_in[0]; p.c = (const float*)d_in[1]; p.pos = (const int*)d_in[2];
  p.ada_w = (const float*)d_in[3]; p.ada_b = (const float*)d_in[4]; p.mix_pre = (const float*)d_in[5]; p.mix_post = (const float*)d_in[6];
  p.w_in = (const float*)d_in[7]; p.w_out = (const float*)d_in[8]; p.gdn_conv = (const float*)d_in[9]; p.gdn_a_log = (const float*)d_in[10];
  p.gdn_dt_bias = (const float*)d_in[11]; p.gdn_norm = (const float*)d_in[12]; p.mla_q_norm = (const float*)d_in[13]; p.mla_w_uq = (const float*)d_in[14];
  p.mla_kv_norm = (const float*)d_in[15]; p.mla_w_ukv = (const float*)d_in[16]; p.swa_sinks = (const float*)d_in[17]; p.ffn_pre = (const float*)d_in[18];
  p.ffn_post = (const float*)d_in[19]; p.ffn_w_up = (const float*)d_in[20]; p.ffn_conv = (const float*)d_in[21]; p.ffn_conv_b = (const float*)d_in[22];
  p.ffn_w_down = (const float*)d_in[23];
  p.out = (float*)d_out; p.ws = (char*)d_ws;
  void* args[] = {&p};
  hipError_t e = hipLaunchCooperativeKernel((void*)fwd_megakernel, dim3(grid_blocks), dim3(NT), args, 0, stream);
  if (e != hipSuccess) fprintf(stderr, "cooperative launch failed: %s (grid %d)\n", hipGetErrorString(e), grid_blocks);
}
```

```cpp
#include <hip/hip_runtime.h>
#include <hip/hip_cooperative_groups.h>
#include <cstdio>
#include <cstdint>
namespace cg = cooperative_groups;

#define DI __device__ __forceinline__
typedef unsigned short bf16_t;
typedef short bf16x8 __attribute__((ext_vector_type(8)));
typedef float f32x2 __attribute__((ext_vector_type(2)));
typedef float f32x4 __attribute__((ext_vector_type(4)));
typedef float f32x16 __attribute__((ext_vector_type(16)));
typedef unsigned u32x2 __attribute__((ext_vector_type(2)));
typedef unsigned u32x4 __attribute__((ext_vector_type(4)));
typedef __bf16 bf2_t __attribute__((ext_vector_type(2)));

constexpr int S_ = 16384, D_ = 2048, DINP = 5632, DFF = 5632, DFF2 = 11264;
constexpr int NT = 512;
constexpr float EPS = 1e-6f;
constexpr float LOG2E = 1.4426950408889634f;

constexpr size_t OFF_CTRL = 0;
constexpr size_t OFF_MODP = 4096;
constexpr size_t OFF_XBAR = OFF_MODP + (size_t)2 * 16 * 12288 * 4;
constexpr size_t OFF_W = 2097152;
static_assert(OFF_XBAR + 3456 * 4 <= OFF_W, "xbar");
constexpr size_t W_IN = 0, W_OUT = W_IN + (size_t)5632 * 2048 * 2, W_UP = W_OUT + (size_t)2048 * 2048 * 2,
                 W_DOWN = W_UP + (size_t)11264 * 2048 * 2, W_UQ = W_DOWN + (size_t)2048 * 5632 * 2,
                 W_UKV = W_UQ + (size_t)768 * 448 * 2, W_END = W_UKV + (size_t)1024 * 128 * 2;
constexpr size_t OFF_H = OFF_W + W_END;
constexpr size_t OFF_MIXF = OFF_H + (size_t)S_ * 2048 * 2;
constexpr size_t OFF_QRAW = OFF_MIXF;
constexpr size_t OFF_KMLA = OFF_QRAW + (size_t)S_ * 768 * 4;
constexpr size_t OFF_VT = OFF_KMLA + (size_t)4 * S_ * 192 * 2;
constexpr size_t OFF_BIG = OFF_MIXF + (size_t)S_ * 2048 * 4;
constexpr size_t OFF_PROJ = OFF_BIG;
constexpr size_t OFF_WP = OFF_PROJ + (size_t)S_ * DINP * 2;
constexpr size_t OFF_QD = OFF_WP + (size_t)S_ * 1024 * 2;
constexpr size_t OFF_KT = OFF_QD + (size_t)S_ * 1024 * 2;
constexpr size_t OFF_ZT = OFF_KT + (size_t)S_ * 1024 * 2;
constexpr size_t OFF_QK = OFF_ZT + (size_t)S_ * 1024 * 2;
constexpr size_t OFF_AB = OFF_QK + (size_t)S_ * 512 * 2;
constexpr size_t OFF_GTOT = OFF_AB + (size_t)S_ * 16 * 4;
constexpr size_t OFF_Y = OFF_BIG;
constexpr size_t OFF_ACT = OFF_H;
constexpr size_t OFF_UT = OFF_BIG + (size_t)S_ * DFF2 * 2;
constexpr size_t OFF_END = OFF_UT + (size_t)S_ * 1024 * 4;
static_assert(OFF_GTOT + 8192 <= OFF_UT, "overlay");
static_assert(OFF_VT + (size_t)4 * 128 * S_ * 2 <= OFF_BIG, "overlay2");

constexpr int C_AQ = 0, C_AK = 1024, C_AV = 2048, C_AZ = 3072, C_AA = 4096, C_BCQ = 4112, C_BCKV = 4560,
              C_BKR = 4688, C_CQ = 4752, C_CK = 5264, C_CV = 5392;

__constant__ double kInvFreq2Pi[32] = {
    0.15915494309189535, 0.11934937021124886, 0.08949940160889101, 0.06711508300522726, 0.050329212104487035, 0.03774158471741977,
    0.0283021958306234, 0.02122365276477766, 0.015915494309189534, 0.011934937021124886, 0.008949940160889102, 0.006711508300522725,
    0.005032921210448704, 0.003774158471741977, 0.00283021958306234, 0.0021223652764777662, 0.0015915494309189536, 0.0011934937021124885,
    0.0008949940160889102, 0.0006711508300522726, 0.0005032921210448703, 0.00037741584717419774, 0.00028302195830623395, 0.0002122365276477766,
    0.00015915494309189535, 0.00011934937021124886, 8.949940160889102e-05, 6.711508300522725e-05, 5.0329212104487035e-05, 3.774158471741978e-05,
    2.8302195830623396e-05, 2.122365276477766e-05};

struct Params {
  const float* x; const float* c; const int* pos;
  const float *ada_w, *ada_b, *mix_pre, *mix_post, *w_in, *w_out, *gdn_conv, *gdn_a_log, *gdn_dt_bias, *gdn_norm, *mla_q_norm, *mla_w_uq,
      *mla_kv_norm, *mla_w_ukv, *swa_sinks, *ffn_pre, *ffn_post, *ffn_w_up, *ffn_conv, *ffn_conv_b, *ffn_w_down;
  float* out; char* ws;
};

DI unsigned pack2(float lo, float hi) { f32x2 v = {lo, hi}; bf2_t b = __builtin_convertvector(v, bf2_t); return __builtin_bit_cast(unsigned, b); }
DI bf16_t f2bf(float x) { return (bf16_t)(pack2(x, 0.f) & 0xffffu); }
DI float bflo(unsigned u) { return __uint_as_float(u << 16); }
DI float bfhi(unsigned u) { return __uint_as_float(u & 0xffff0000u); }
DI void unpack8(const u32x4& v, float* f) { f[0] = bflo(v.x); f[1] = bfhi(v.x); f[2] = bflo(v.y); f[3] = bfhi(v.y); f[4] = bflo(v.z); f[5] = bfhi(v.z); f[6] = bflo(v.w); f[7] = bfhi(v.w); }
DI bf16x8 pack8(float a0, float a1, float a2, float a3, float a4, float a5, float a6, float a7) {
  u32x4 p = {pack2(a0, a1), pack2(a2, a3), pack2(a4, a5), pack2(a6, a7)}; return __builtin_bit_cast(bf16x8, p); }
DI float silu_f(float x) { return x * __builtin_amdgcn_rcpf(1.f + __expf(-x)); }
DI float wave_sum(float v) { v += __shfl_xor(v, 32); v += __shfl_xor(v, 16); v += __shfl_xor(v, 8); v += __shfl_xor(v, 4); v += __shfl_xor(v, 2); v += __shfl_xor(v, 1); return v; }
DI int opaque_tid() { int t = threadIdx.x; asm volatile("" : "+v"(t)); return t; }
DI float xhalf_max(float v) { const auto r = __builtin_amdgcn_permlane32_swap(__float_as_uint(v), __float_as_uint(v), false, false); return fmaxf(__uint_as_float(r[0]), __uint_as_float(r[1])); }
DI int crow(int r, int h) { return (r & 3) + 8 * (r >> 2) + 4 * h; }
DI int perm32(int k) { return 8 * ((k >> 2) & 3) + 4 * (k >> 4) + (k & 3); }
#define MFMA32(a, b, c) __builtin_amdgcn_mfma_f32_32x32x16_bf16((a), (b), (c), 0, 0, 0)
#define MFMA16(a, b, c) __builtin_amdgcn_mfma_f32_16x16x32_bf16((a), (b), (c), 0, 0, 0)

template <class Epi>
DI void gemm_tile(const bf16_t* __restrict__ A, int lda, const bf16_t* __restrict__ Bt, int ldb, int K, int m0, int n0, char* smem, const Epi& epi) {
  const int tid = opaque_tid(), lane = tid & 63, w = tid >> 6, wm = w >> 2, wn = w & 3, lq = lane & 31, h = lane >> 5;
  f32x16 acc[2][4];
#pragma unroll
  for (int i = 0; i < 2; ++i)
#pragma unroll
    for (int j = 0; j < 4; ++j)
#pragma unroll
      for (int r = 0; r < 16; ++r) acc[i][j][r] = 0.f;
  const int r0 = tid >> 3, c0 = tid & 7;
  const bf16_t* ag = A + (size_t)(m0 + r0) * lda + c0 * 8;
  const bf16_t* bg = Bt + (size_t)(n0 + r0) * ldb + c0 * 8;
  const int wofs = r0 * 128 + ((c0 ^ ((r0 >> 1) & 7)) << 4);
  char* sA = smem; char* sB = smem + 65536;
  u32x4 ra0[4], rb0[4], ra1[4], rb1[4];
  const int nk = K >> 6, swz = (lane >> 1) & 7;
  const int aoff = (64 * wn + lq) * 128, boff = (128 * wm + lq) * 128;
#define GLOAD(RA, RB, KT) { _Pragma("unroll") for (int i = 0; i < 4; ++i) { RA[i] = *(const u32x4*)(ag + (size_t)(KT) * 64 + (size_t)i * 64 * lda); RB[i] = *(const u32x4*)(bg + (size_t)(KT) * 64 + (size_t)i * 64 * ldb); } }
#define LWRITE(RA, RB, ST) { _Pragma("unroll") for (int i = 0; i < 4; ++i) { *(u32x4*)(sA + (ST) * 32768 + wofs + i * 8192) = RA[i]; *(u32x4*)(sB + (ST) * 32768 + wofs + i * 8192) = RB[i]; } }
#define KSTEP(ST, RA, RB, KN) { const char* cA = sA + (ST) * 32768; const char* cB = sB + (ST) * 32768; char* dA = sA + (1 - (ST)) * 32768; char* dB = sB + (1 - (ST)) * 32768; \
    const bf16_t* agn = ag + (size_t)(KN) * 64; const bf16_t* bgn = bg + (size_t)(KN) * 64; \
    _Pragma("unroll") for (int s = 0; s < 4; ++s) { const int co = (((2 * s + h) ^ swz) << 4); bf16x8 fa[2], fb[4]; \
      _Pragma("unroll") for (int ni = 0; ni < 2; ++ni) fa[ni] = *(const bf16x8*)(cB + aoff + ni * 4096 + co); \
      _Pragma("unroll") for (int mi = 0; mi < 4; ++mi) fb[mi] = *(const bf16x8*)(cA + boff + mi * 4096 + co); \
      *(u32x4*)(dA + wofs + s * 8192) = RA[s]; *(u32x4*)(dB + wofs + s * 8192) = RB[s]; \
      RA[s] = *(const u32x4*)(agn + (size_t)s * 64 * lda); RB[s] = *(const u32x4*)(bgn + (size_t)s * 64 * ldb); \
      _Pragma("unroll") for (int ni = 0; ni < 2; ++ni) _Pragma("unroll") for (int mi = 0; mi < 4; ++mi) acc[ni][mi] = MFMA32(fa[ni], fb[mi], acc[ni][mi]); \
      __builtin_amdgcn_sched_barrier(0); } }
  const int kl = nk - 1;
  GLOAD(ra0, rb0, 0);
  GLOAD(ra1, rb1, (1 < kl ? 1 : kl));
  LWRITE(ra0, rb0, 0);
  GLOAD(ra0, rb0, (2 < kl ? 2 : kl));
  __syncthreads();
  for (int kt = 0; kt < nk; kt += 2) {
    KSTEP(0, ra1, rb1, (kt + 3 < kl ? kt + 3 : kl));
    __syncthreads();
    if (kt + 1 < nk) {
      KSTEP(1, ra0, rb0, (kt + 4 < kl ? kt + 4 : kl));
      __syncthreads();
    }
  }
#undef GLOAD
#undef LWRITE
#undef KSTEP
#pragma unroll
  for (int ni = 0; ni < 2; ++ni)
#pragma unroll
    for (int mi = 0; mi < 4; ++mi)
#pragma unroll
      for (int rg = 0; rg < 4; ++rg) {
        const int m = m0 + 128 * wm + 32 * mi + lq, n = n0 + 64 * wn + 32 * ni + 8 * rg + 4 * h;
        epi(m, n, acc[ni][mi][4 * rg], acc[ni][mi][4 * rg + 1], acc[ni][mi][4 * rg + 2], acc[ni][mi][4 * rg + 3]);
      }
}

template <class Epi>
DI void gemm_tile_s(const bf16_t* __restrict__ A, int lda, const bf16_t* __restrict__ Bt, int ldb, int K, int m0, int n0, char* smem, const Epi& epi) {
  const int tid = opaque_tid(), lane = tid & 63, w = tid >> 6, wm = w >> 2, wn = w & 3, lq = lane & 31, h = lane >> 5;
  f32x16 acc[2][4];
#pragma unroll
  for (int i = 0; i < 2; ++i)
#pragma unroll
    for (int j = 0; j < 4; ++j)
#pragma unroll
      for (int r = 0; r < 16; ++r) acc[i][j][r] = 0.f;
  const int r0 = tid >> 3, c0 = tid & 7;
  const bf16_t* ag = A + (size_t)(m0 + r0) * lda + c0 * 8;
  const bf16_t* bg = Bt + (size_t)(n0 + r0) * ldb + c0 * 8;
  const int wofs = r0 * 128 + ((c0 ^ ((r0 >> 1) & 7)) << 4);
  char* sA = smem; char* sB = smem + 32768;
  u32x4 ra[4], rb[4];
#pragma unroll
  for (int i = 0; i < 4; ++i) { ra[i] = *(const u32x4*)(ag + (size_t)i * 64 * lda); rb[i] = *(const u32x4*)(bg + (size_t)i * 64 * ldb); }
#pragma unroll
  for (int i = 0; i < 4; ++i) { *(u32x4*)(sA + wofs + i * 8192) = ra[i]; *(u32x4*)(sB + wofs + i * 8192) = rb[i]; }
  __syncthreads();
  const int nk = K >> 6, swz = (lane >> 1) & 7;
  const int aoff = (64 * wn + lq) * 128, boff = (128 * wm + lq) * 128;
  for (int kt = 0; kt < nk; ++kt) {
    const char* cA = sA + (kt & 1) * 65536; const char* cB = sB + (kt & 1) * 65536;
    const bool more = (kt + 1 < nk);
    if (more) { ag += 64; bg += 64;
#pragma unroll
      for (int i = 0; i < 4; ++i) { ra[i] = *(const u32x4*)(ag + (size_t)i * 64 * lda); rb[i] = *(const u32x4*)(bg + (size_t)i * 64 * ldb); } }
#pragma unroll
    for (int s = 0; s < 4; ++s) {
      const int co = (((2 * s + h) ^ swz) << 4);
      bf16x8 fa[2], fb[4];
#pragma unroll
      for (int ni = 0; ni < 2; ++ni) fa[ni] = *(const bf16x8*)(cB + aoff + ni * 4096 + co);
#pragma unroll
      for (int mi = 0; mi < 4; ++mi) fb[mi] = *(const bf16x8*)(cA + boff + mi * 4096 + co);
#pragma unroll
      for (int ni = 0; ni < 2; ++ni)
#pragma unroll
        for (int mi = 0; mi < 4; ++mi) acc[ni][mi] = MFMA32(fa[ni], fb[mi], acc[ni][mi]);
    }
    if (more) { char* dA = sA + ((kt + 1) & 1) * 65536; char* dB = sB + ((kt + 1) & 1) * 65536;
#pragma unroll
      for (int i = 0; i < 4; ++i) { *(u32x4*)(dA + wofs + i * 8192) = ra[i]; *(u32x4*)(dB + wofs + i * 8192) = rb[i]; } }
    __syncthreads();
  }
#pragma unroll
  for (int ni = 0; ni < 2; ++ni)
#pragma unroll
    for (int mi = 0; mi < 4; ++mi)
#pragma unroll
      for (int rg = 0; rg < 4; ++rg) {
        const int m = m0 + 128 * wm + 32 * mi + lq, n = n0 + 64 * wn + 32 * ni + 8 * rg + 4 * h;
        epi(m, n, acc[ni][mi][4 * rg], acc[ni][mi][4 * rg + 1], acc[ni][mi][4 * rg + 2], acc[ni][mi][4 * rg + 3]);
      }
}

DI void tile_coord(int t, int npn, int& pm, int& pn) { const int g = t / (16 * npn), r = t % (16 * npn); pn = r >> 4; pm = g * 16 + (r & 15); }

struct EpiProj { bf16_t* proj; float* ab;
  DI void operator()(int m, int n, float v0, float v1, float v2, float v3) const {
    u32x2 pk = {pack2(v0, v1), pack2(v2, v3)}; *(u32x2*)(proj + (size_t)m * DINP + n) = pk;
    if (n >= C_AA && n < C_AA + 16) { int mm = m; asm volatile("" : "+v"(mm));
      f32x4 v = {v0, v1, v2, v3}; *(f32x4*)(ab + (size_t)mm * 16 + (n - C_AA)) = v; } } };
struct EpiF32 { float* out; int ldc;
  DI void operator()(int m, int n, float v0, float v1, float v2, float v3) const { f32x4 v = {v0, v1, v2, v3}; *(f32x4*)(out + (size_t)m * ldc + n) = v; } };
struct EpiBf { bf16_t* out; int ldc;
  DI void operator()(int m, int n, float v0, float v1, float v2, float v3) const { u32x2 pk = {pack2(v0, v1), pack2(v2, v3)}; *(u32x2*)(out + (size_t)m * ldc + n) = pk; } };
struct EpiMlaQ { float* qraw; const float* rs; int m0;
  DI void operator()(int m, int n, float v0, float v1, float v2, float v3) const { const float r = rs[m - m0]; f32x4 v = {v0 * r, v1 * r, v2 * r, v3 * r}; *(f32x4*)(qraw + (size_t)m * 768 + n) = v; } };
struct EpiMlaKV { bf16_t* kmla; bf16_t* vt; const float* rs; int m0;
  DI void operator()(int m, int n, float v0, float v1, float v2, float v3) const {
    const float r = rs[m - m0]; const int hd = n >> 8, wi = n & 255;
    if (wi < 128) { u32x2 pk = {pack2(v0 * r, v1 * r), pack2(v2 * r, v3 * r)}; *(u32x2*)(kmla + ((size_t)hd * S_ + m) * 192 + wi) = pk; }
    else { bf16_t* p = vt + ((size_t)hd * 128 + (wi - 128)) * S_ + m; p[0] = f2bf(v0 * r); p[S_] = f2bf(v1 * r); p[2 * (size_t)S_] = f2bf(v2 * r); p[3 * (size_t)S_] = f2bf(v3 * r); } } };


namespace pg8 {
#define PG8_LAS __attribute__((address_space(3)))
constexpr int BM = 256, BK = 64, HALF = 128, HTB = HALF * BK * 2  , STAGE_BYTES = 8 * HTB;
DI int lds_byte(int r, int c) { const int st = (r >> 4) * 2 + (c >> 5), rr = r & 15, cc = c & 31, ob = rr * 64 + cc * 2; return st * 1024 + (ob ^ (((ob >> 9) & 1) << 5)); }
DI void stage_rc(int b, int& R, int& C) { const int st = b / 1024, sb = b % 1024, swz = sb ^ (((sb >> 9) & 1) << 5); R = (st >> 1) * 16 + swz / 64; C = (st & 1) * 32 + (swz % 64) / 2; }
DI int perm32(int rho) { const int n = rho >> 4, i = rho & 15; return 8 * (i >> 2) + 4 * n + (i & 3); }
struct Unit { int pm, pn; };
struct Gemm { const bf16_t* A; const bf16_t* Bt; int M, N, K; };
struct XcdOrder { int pm, pj, npn;
  DI bool next(int i, Unit& u) const { const int pn = pj + 4 * i; if (pn >= npn) return false; u.pm = pm; u.pn = pn; return true; }
  DI void a_ready(const Unit&) const {}
  DI void done(const Unit&) const {} };
template <class E> struct EpiAdapt { static constexpr bool PERM = false, AFTER_DRAIN = false; const E& e;
  DI void operator()(const f32x4 (&acc)[2][2][4][2], const Unit& u, int wr, int wc, int fr, int fq) const {
#pragma unroll
    for (int ai = 0; ai < 2; ++ai)
#pragma unroll
      for (int m = 0; m < 4; ++m)
#pragma unroll
        for (int bj = 0; bj < 2; ++bj)
#pragma unroll
          for (int n = 0; n < 2; ++n) { const f32x4 v = acc[ai][bj][m][n];
            e(u.pm * BM + ai * HALF + wr * 64 + m * 16 + fr, u.pn * BM + bj * HALF + wc * 32 + n * 16 + 4 * fq, v.x, v.y, v.z, v.w); } } };
template <class Epi, class Sched, bool ALIGN_EPI = false, bool SP2 = false>
__device__ __forceinline__ void gemm_phase(PG8_LAS unsigned char* lds, const Gemm g, const Sched& S, const Epi& E) {
    const int tid = opaque_tid(), wid = __builtin_amdgcn_readfirstlane(tid >> 6), lane = tid & 63, wr = wid >> 2, wc = wid & 3, fr = lane & 15, fq = lane >> 4;
    const int K = g.K, nt = K / BK;
    unsigned voffA[2], voffB[2];
#pragma unroll
    for (int i = 0; i < 2; ++i) { int R, C; stage_rc(tid * 16 + i * 8192, R, C); const int Rb = Epi::PERM ? ((R & ~31) + perm32(R & 31)) : R;
        voffA[i] = (unsigned)(R * K + C) * 2u; voffB[i] = (unsigned)(Rb * K + C) * 2u; }
    const size_t kstep = (size_t)(BK * 2);
    const size_t hstep = (size_t)HALF * K * 2;
    const size_t tstep = 2 * hstep;
    const unsigned ldsw = (unsigned)wid * 1024u;
    const int aoff = lds_byte(wr * 64 + fr, fq * 8), boff = lds_byte(wc * 32 + fr, fq * 8);
#define PG8_SA(b, h) (((b) * 2 + (h)) * HTB)
#define PG8_SB(b, h) ((4 + (b) * 2 + (h)) * HTB)
#define PG8_STAGE(bufoff, gbase, voff) do { _Pragma("unroll") for (int _i = 0; _i < 2; ++_i) \
        __builtin_amdgcn_global_load_lds((const unsigned*)((const char*)(gbase) + (voff)[_i]), (PG8_LAS unsigned*)(lds + (bufoff) + ldsw + _i * 8192), 16, 0, 0); } while (0)
#define PG8_LDA(dst, b, h) do { _Pragma("unroll") for (int m = 0; m < 4; ++m) _Pragma("unroll") for (int k = 0; k < 2; ++k) dst[m][k] = *(const PG8_LAS bf16x8*)(lds + PG8_SA(b, h) + aoff + m * 2048 + k * 1024); } while (0)
#define PG8_LDB(dst, b, h) do { _Pragma("unroll") for (int n = 0; n < 2; ++n) _Pragma("unroll") for (int k = 0; k < 2; ++k) dst[n][k] = *(const PG8_LAS bf16x8*)(lds + PG8_SB(b, h) + boff + n * 2048 + k * 1024); } while (0)
#define PG8_MMA(ai, bj, At, Bt) do { __builtin_amdgcn_s_setprio(1); _Pragma("unroll") for (int m = 0; m < 4; ++m) _Pragma("unroll") for (int n = 0; n < 2; ++n) _Pragma("unroll") for (int k = 0; k < 2; ++k) \
        acc[ai][bj][m][n] = __builtin_amdgcn_mfma_f32_16x16x32_bf16(Bt[n][k], At[m][k], acc[ai][bj][m][n], 0, 0, 0); __builtin_amdgcn_s_setprio(0); } while (0)
#define PG8_WAIT_V(n) asm volatile("s_waitcnt vmcnt(" #n ")" ::: "memory")
#define PG8_WAIT_L(n) asm volatile("s_waitcnt lgkmcnt(" #n ")" ::: "memory")
#define PG8_BAR __builtin_amdgcn_s_barrier()
#define PG8_SCHED __builtin_amdgcn_sched_barrier(0)
    Unit cur, nxt; int ui = 0;
    if (!S.next(0, cur)) return;
    f32x4 acc[2][2][4][2];
#pragma unroll
    for (int a = 0; a < 2; ++a)
#pragma unroll
        for (int b = 0; b < 2; ++b)
#pragma unroll
            for (int m = 0; m < 4; ++m)
#pragma unroll
                for (int n = 0; n < 2; ++n) acc[a][b][m][n] = (f32x4){0.f, 0.f, 0.f, 0.f};
    bf16x8 At[4][2], B0[2][2], B1[2][2];
    const char* cA = (const char*)g.A + (size_t)cur.pm * tstep; const char* cB = (const char*)g.Bt + (size_t)cur.pn * tstep;
    S.a_ready(cur);
    if constexpr (SP2) {
        PG8_STAGE(PG8_SB(0, 0), cB, voffB); PG8_STAGE(PG8_SB(0, 1), cB + hstep, voffB); PG8_STAGE(PG8_SA(0, 0), cA, voffA); PG8_STAGE(PG8_SA(0, 1), cA + hstep, voffA);
        if (wr == 1) PG8_BAR;
        PG8_WAIT_V(2); PG8_BAR;
        PG8_STAGE(PG8_SB(1, 0), cB + kstep, voffB); PG8_STAGE(PG8_SA(1, 0), cA + kstep, voffA); PG8_STAGE(PG8_SB(1, 1), cB + hstep + kstep, voffB);
        PG8_WAIT_V(6); PG8_BAR;
    } else {
        PG8_STAGE(PG8_SB(0, 0), cB, voffB); PG8_STAGE(PG8_SA(0, 0), cA, voffA); PG8_STAGE(PG8_SB(0, 1), cB + hstep, voffB); PG8_STAGE(PG8_SA(0, 1), cA + hstep, voffA);
        if (wr == 1) PG8_BAR;
        PG8_WAIT_V(4); PG8_BAR;
        PG8_STAGE(PG8_SB(1, 0), cB + kstep, voffB); PG8_STAGE(PG8_SA(1, 0), cA + kstep, voffA); PG8_STAGE(PG8_SB(1, 1), cB + hstep + kstep, voffB);
        PG8_WAIT_V(6); PG8_BAR;
    }
    for (;;) {
        const bool has_next = S.next(ui + 1, nxt);
        const char* nA = has_next ? (const char*)g.A + (size_t)nxt.pm * tstep : cA; const char* nB = has_next ? (const char*)g.Bt + (size_t)nxt.pn * tstep : cB;
        for (int t = 0; t < nt; t += 2) {
            const bool last = (t == nt - 2);
            const char* a1 = cA + (size_t)(t + 1) * kstep;
            const char* a2 = last ? nA : cA + (size_t)(t + 2) * kstep; const char* b2 = last ? nB : cB + (size_t)(t + 2) * kstep;
            const char* a3 = a2 + kstep; const char* b3 = b2 + kstep;
            if (last && has_next) S.a_ready(nxt);
            if constexpr (SP2) {
            PG8_LDB(B0, 0, 0); PG8_LDB(B1, 0, 1); PG8_SCHED; PG8_LDA(At, 0, 0); PG8_STAGE(PG8_SA(1, 1), a1 + hstep, voffA);
            PG8_WAIT_V(8); PG8_WAIT_L(0); PG8_BAR; PG8_MMA(0, 0, At, B0); PG8_MMA(0, 1, At, B1); PG8_BAR; PG8_SCHED;
            PG8_LDA(At, 0, 1); PG8_STAGE(PG8_SB(0, 0), b2, voffB); PG8_STAGE(PG8_SB(0, 1), b2 + hstep, voffB); PG8_STAGE(PG8_SA(0, 0), a2, voffA);
            PG8_WAIT_V(8); PG8_WAIT_L(0); PG8_BAR; PG8_MMA(1, 0, At, B0); PG8_MMA(1, 1, At, B1); PG8_BAR; PG8_SCHED;
            PG8_LDB(B0, 1, 0); PG8_LDB(B1, 1, 1); PG8_SCHED; PG8_LDA(At, 1, 0); PG8_STAGE(PG8_SA(0, 1), a2 + hstep, voffA);
            PG8_WAIT_V(8); PG8_WAIT_L(0); PG8_BAR; PG8_MMA(0, 0, At, B0); PG8_MMA(0, 1, At, B1); PG8_BAR; PG8_SCHED;
            PG8_LDA(At, 1, 1); PG8_STAGE(PG8_SB(1, 0), b3, voffB); PG8_STAGE(PG8_SB(1, 1), b3 + hstep, voffB); PG8_STAGE(PG8_SA(1, 0), a3, voffA);
            PG8_WAIT_V(8); PG8_WAIT_L(0); PG8_BAR; PG8_MMA(1, 0, At, B0); PG8_MMA(1, 1, At, B1); PG8_BAR; PG8_SCHED;
            } else {
            PG8_LDB(B0, 0, 0); PG8_SCHED; PG8_LDA(At, 0, 0); PG8_STAGE(PG8_SA(1, 1), a1 + hstep, voffA);
            PG8_WAIT_L(8); PG8_BAR; PG8_WAIT_L(0); PG8_MMA(0, 0, At, B0); PG8_BAR; PG8_SCHED;
            PG8_LDB(B1, 0, 1); PG8_STAGE(PG8_SB(0, 0), b2, voffB);
            PG8_BAR; PG8_WAIT_L(0); PG8_MMA(0, 1, At, B1); PG8_BAR;
            PG8_LDA(At, 0, 1); PG8_STAGE(PG8_SA(0, 0), a2, voffA);
            PG8_BAR; PG8_WAIT_L(0); PG8_MMA(1, 0, At, B0); PG8_BAR; PG8_SCHED;
            PG8_STAGE(PG8_SB(0, 1), b2 + hstep, voffB);
            PG8_WAIT_V(6); PG8_BAR; PG8_MMA(1, 1, At, B1); PG8_BAR;
            PG8_LDB(B0, 1, 0); PG8_SCHED; PG8_LDA(At, 1, 0); PG8_STAGE(PG8_SA(0, 1), a2 + hstep, voffA);
            PG8_WAIT_L(8); PG8_BAR; PG8_WAIT_L(0); PG8_MMA(0, 0, At, B0); PG8_BAR; PG8_SCHED;
            PG8_LDB(B1, 1, 1); PG8_STAGE(PG8_SB(1, 0), b3, voffB);
            PG8_BAR; PG8_WAIT_L(0); PG8_MMA(0, 1, At, B1); PG8_BAR;
            PG8_LDA(At, 1, 1); PG8_STAGE(PG8_SA(1, 0), a3, voffA);
            PG8_BAR; PG8_WAIT_L(0); PG8_MMA(1, 0, At, B0); PG8_BAR; PG8_SCHED;
            PG8_STAGE(PG8_SB(1, 1), b3 + hstep, voffB);
            PG8_WAIT_V(6); PG8_BAR; PG8_MMA(1, 1, At, B1); PG8_BAR;
            }
        }
        if constexpr (ALIGN_EPI) { if (wr == 0) PG8_BAR; }
        if constexpr (!Epi::AFTER_DRAIN) { E(acc, cur, wr, wc, fr, fq); S.done(cur); }
        if (!has_next) break;
#pragma unroll
        for (int a = 0; a < 2; ++a)
#pragma unroll
            for (int b = 0; b < 2; ++b)
#pragma unroll
                for (int m = 0; m < 4; ++m)
#pragma unroll
                    for (int n = 0; n < 2; ++n) acc[a][b][m][n] = (f32x4){0.f, 0.f, 0.f, 0.f};
        cur = nxt; cA = nA; cB = nB; ++ui;
        if constexpr (ALIGN_EPI) { if (wr == 1) PG8_BAR; }
    }
    PG8_WAIT_V(0);
    if constexpr (!ALIGN_EPI) { if (wr == 0) PG8_BAR; }
    PG8_BAR;
    if constexpr (Epi::AFTER_DRAIN) { E.fused(acc, cur, wr, wc, fr, fq, lds, wid, lane); S.done(cur); }
#undef PG8_SA
#undef PG8_SB
#undef PG8_STAGE
#undef PG8_LDA
#undef PG8_LDB
#undef PG8_MMA
#undef PG8_WAIT_V
#undef PG8_WAIT_L
#undef PG8_BAR
#undef PG8_SCHED
}
}

template <class Epi>
DI void gemm_phase(const bf16_t* A, int lda, const bf16_t* Bt, int ldb, int K, int npm, int npn, char* smem, const Epi& epi) {
  if (gridDim.x == 256 && npm == 64) {
    const int b = blockIdx.x, pm = 8 * (b & 7) + ((b >> 3) & 7), pj = b >> 6;
    if (lda == K && ldb == K && (K & 127) == 0) {
      const pg8::Gemm g{A, Bt, npm * 256, npn * 256, K}; const pg8::XcdOrder ord{pm, pj, npn}; const pg8::EpiAdapt<Epi> ea{epi};
      pg8::gemm_phase<pg8::EpiAdapt<Epi>, pg8::XcdOrder, true, true>(( __attribute__((address_space(3))) unsigned char*)smem, g, ord, ea);
    } else
    for (int pn = pj; pn < npn; pn += 4) gemm_tile(A, lda, Bt, ldb, K, pm * 256, pn * 256, smem, epi);
  } else {
    for (int t = blockIdx.x; t < npm * npn; t += gridDim.x) { int pm, pn; tile_coord(t, npn, pm, pn); gemm_tile(A, lda, Bt, ldb, K, pm * 256, pn * 256, smem, epi); }
  }
}

DI void mod_item(const Params& P, int item) {
  const int tid = opaque_tid(); const int l = item / 96, r = item % 96, ks = r / 6, nc = r % 6;
  const int n = nc * 2048 + tid * 4;
  const float* wp = P.ada_w + ((size_t)l * 2048 + ks * 128) * 12288 + n;
  f32x4 acc = {0.f, 0.f, 0.f, 0.f};
#pragma unroll 8
  for (int k = 0; k < 128; ++k) { const float cv = P.c[ks * 128 + k]; const float ca = silu_f(cv); const f32x4 wv = *(const f32x4*)(wp + (size_t)k * 12288); acc += wv * ca; }
  float* modp = (float*)(P.ws + OFF_MODP);
  *(f32x4*)(modp + ((size_t)l * 16 + ks) * 12288 + n) = acc;
}
DI void convert_tile(const float* __restrict__ src, int K, int N, bf16_t* __restrict__ dst, int tk, int tn, const float* rowscale, char* smem) {
  float* sm = (float*)smem; const int tid = opaque_tid(); const int k0 = tk * 64, n0 = tn * 256;
  { const int r = tid >> 6, c4 = tid & 63; const int n = n0 + 4 * c4;
    f32x4 v[8];
#pragma unroll
    for (int i = 0; i < 8; ++i) { v[i] = (f32x4){0.f, 0.f, 0.f, 0.f}; if (n < N) v[i] = *(const f32x4*)(src + (size_t)(k0 + r + 8 * i) * N + n); }
#pragma unroll
    for (int i = 0; i < 8; ++i) { const int kk = r + 8 * i; if (rowscale) v[i] *= rowscale[k0 + kk];
      sm[kk * 257 + 4 * c4 + 0] = v[i].x; sm[kk * 257 + 4 * c4 + 1] = v[i].y; sm[kk * 257 + 4 * c4 + 2] = v[i].z; sm[kk * 257 + 4 * c4 + 3] = v[i].w; } }
  __syncthreads();
  { const int n = tid >> 1, kh = tid & 1;
#pragma unroll
    for (int j = 0; j < 4; ++j) { float f[8];
#pragma unroll
      for (int i = 0; i < 8; ++i) f[i] = sm[(32 * kh + 8 * j + i) * 257 + n];
      u32x4 pk = {pack2(f[0], f[1]), pack2(f[2], f[3]), pack2(f[4], f[5]), pack2(f[6], f[7])};
      *(u32x4*)(dst + (size_t)(n0 + n) * K + k0 + 32 * kh + 8 * j) = pk; } }
  __syncthreads();
}
constexpr int CV_T0 = 32 * 22, CV_T1 = CV_T0 + 32 * 8, CV_T2 = CV_T1 + 32 * 44, CV_T3 = CV_T2 + 88 * 8, CV_T4 = CV_T3 + 7 * 3, CV_T5 = CV_T4 + 2 * 4;
DI void convert_item(const Params& P, int l, int it, char* smem) {
  char* wb = P.ws + OFF_W;
  if (it < CV_T0) convert_tile(P.w_in + (size_t)l * 2048 * 5520, 2048, 5520, (bf16_t*)(wb + W_IN), it / 22, it % 22, nullptr, smem);
  else if (it < CV_T1) { it -= CV_T0; convert_tile(P.w_out + (size_t)l * 2048 * 2048, 2048, 2048, (bf16_t*)(wb + W_OUT), it / 8, it % 8, nullptr, smem); }
  else if (it < CV_T2) { it -= CV_T1; convert_tile(P.ffn_w_up + (size_t)l * 2048 * 11264, 2048, 11264, (bf16_t*)(wb + W_UP), it / 44, it % 44, nullptr, smem); }
  else if (it < CV_T3) { it -= CV_T2; convert_tile(P.ffn_w_down + (size_t)l * 5632 * 2048, 5632, 2048, (bf16_t*)(wb + W_DOWN), it / 8, it % 8, nullptr, smem); }
  else if (it < CV_T4) { it -= CV_T3; convert_tile(P.mla_w_uq + (size_t)l * 448 * 768, 448, 768, (bf16_t*)(wb + W_UQ), it / 3, it % 3, P.mla_q_norm + l * 448, smem); }
  else { it -= CV_T4; convert_tile(P.mla_w_ukv + (size_t)l * 128 * 1024, 128, 1024, (bf16_t*)(wb + W_UKV), it / 4, it % 4, P.mla_kv_norm + l * 128, smem); }
}

DI float mod_val(const float* modp_l, const float* ada_b_l, int idx) { float s = ada_b_l[idx];
#pragma unroll
  for (int k = 0; k < 16; ++k) s += modp_l[(size_t)k * 12288 + idx]; return s; }
DI void rownorm_phase(const Params& P, const float* xin, const bf16_t* yin, float* xout, bf16_t* hout, int lg, int gate_idx, const float* w_post,
                      int lh, int scale_idx, int shift_idx, const float* w_pre, char* smem) {
  float* A1 = (float*)smem; float* A2 = A1 + 2048; float* B2 = A2 + 2048;
  const int tid = opaque_tid(), lane = tid & 63, w = tid >> 6;
  const float* modp = (const float*)(P.ws + OFF_MODP);
  for (int cidx = tid; cidx < 2048; cidx += NT) {
    if (yin) A1[cidx] = mod_val(modp + (size_t)lg * 16 * 12288, P.ada_b + (size_t)lg * 12288, gate_idx * 2048 + cidx) * w_post[cidx];
    if (hout) { A2[cidx] = w_pre[cidx] * (1.f + mod_val(modp + (size_t)lh * 16 * 12288, P.ada_b + (size_t)lh * 12288, scale_idx * 2048 + cidx));
      B2[cidx] = mod_val(modp + (size_t)lh * 16 * 12288, P.ada_b + (size_t)lh * 12288, shift_idx * 2048 + cidx); }
  }
  __syncthreads();
  for (int row = blockIdx.x * 8 + w; row < S_; row += gridDim.x * 8) {
    f32x4 xv[8];
#pragma unroll
    for (int j = 0; j < 8; ++j) xv[j] = *(const f32x4*)(xin + (size_t)row * 2048 + (j * 64 + lane) * 4);
    if (yin) {
      f32x4 yv[8]; float ss = 0.f;
#pragma unroll
      for (int j = 0; j < 8; ++j) { const u32x2 yb = *(const u32x2*)(yin + (size_t)row * 2048 + (j * 64 + lane) * 4); yv[j] = (f32x4){bflo(yb.x), bfhi(yb.x), bflo(yb.y), bfhi(yb.y)};
        ss += yv[j].x * yv[j].x + yv[j].y * yv[j].y + yv[j].z * yv[j].z + yv[j].w * yv[j].w; }
      ss = wave_sum(ss); const float r = rsqrtf(ss * (1.f / 2048.f) + EPS);
#pragma unroll
      for (int j = 0; j < 8; ++j) { const f32x4 a = *(const f32x4*)(A1 + (j * 64 + lane) * 4); xv[j] += a * (yv[j] * r); }
    }
    if (yin || xout != xin) {
#pragma unroll
      for (int j = 0; j < 8; ++j) *(f32x4*)(xout + (size_t)row * 2048 + (j * 64 + lane) * 4) = xv[j];
    }
    if (hout) {
      float ss = 0.f;
#pragma unroll
      for (int j = 0; j < 8; ++j) ss += xv[j].x * xv[j].x + xv[j].y * xv[j].y + xv[j].z * xv[j].z + xv[j].w * xv[j].w;
      ss = wave_sum(ss); const float r = rsqrtf(ss * (1.f / 2048.f) + EPS);
#pragma unroll
      for (int j = 0; j < 8; ++j) { const f32x4 a = *(const f32x4*)(A2 + (j * 64 + lane) * 4), b = *(const f32x4*)(B2 + (j * 64 + lane) * 4);
        const f32x4 hv = xv[j] * r * a + b; u32x2 pk = {pack2(hv.x, hv.y), pack2(hv.z, hv.w)};
        *(u32x2*)(hout + (size_t)row * 2048 + (j * 64 + lane) * 4) = pk; }
    }
  }
  __syncthreads();
}

DI void mla_q_tile(const Params& P, int pm, int pn, char* smem) {
  const bf16_t* proj = (const bf16_t*)(P.ws + OFF_PROJ); const int tid = opaque_tid(), m0 = pm * 256; float* rs = (float*)(smem + 131072);
  { const int row = tid >> 1, half = tid & 1; const bf16_t* p = proj + (size_t)(m0 + row) * DINP + C_BCQ + half * 224; float ss = 0.f;
    for (int i = 0; i < 28; ++i) { const u32x4 v = *(const u32x4*)(p + i * 8); float f[8]; unpack8(v, f);
#pragma unroll
      for (int e = 0; e < 8; ++e) ss += f[e] * f[e]; }
    ss += __shfl_xor(ss, 1); if (half == 0) rs[row] = rsqrtf(ss * (1.f / 448.f) + EPS); }
  EpiMlaQ epi{(float*)(P.ws + OFF_QRAW), rs, m0};
  gemm_tile_s(proj + C_BCQ, DINP, (const bf16_t*)(P.ws + OFF_W + W_UQ), 448, 448, m0, pn * 256, smem, epi);
  __syncthreads();
}
DI void mla_kv_tile(const Params& P, int pm, int pn, char* smem) {
  const bf16_t* proj = (const bf16_t*)(P.ws + OFF_PROJ); const int tid = opaque_tid(), m0 = pm * 256; float* rs = (float*)(smem + 131072);
  { const int row = tid >> 1, half = tid & 1; const bf16_t* p = proj + (size_t)(m0 + row) * DINP + C_BCKV + half * 64; float ss = 0.f;
#pragma unroll
    for (int i = 0; i < 8; ++i) { const u32x4 v = *(const u32x4*)(p + i * 8); float f[8]; unpack8(v, f);
#pragma unroll
      for (int e = 0; e < 8; ++e) ss += f[e] * f[e]; }
    ss += __shfl_xor(ss, 1); if (half == 0) rs[row] = rsqrtf(ss * (1.f / 128.f) + EPS); }
  bf16_t* kmla = (bf16_t*)(P.ws + OFF_KMLA);
  EpiMlaKV epi{kmla, (bf16_t*)(P.ws + OFF_VT), rs, m0};
  gemm_tile_s(proj + C_BCKV, DINP, (const bf16_t*)(P.ws + OFF_W + W_UKV), 128, 128, m0, pn * 256, smem, epi);
  if (pn == 0) {
    for (int i = 0; i < 16; ++i) { const int idx = tid + NT * i, row = idx >> 5, pi = idx & 31, m = m0 + row;
      const float x1 = bflo((unsigned)proj[(size_t)m * DINP + C_BKR + pi]), x2 = bflo((unsigned)proj[(size_t)m * DINP + C_BKR + 32 + pi]);
      double fr = (double)P.pos[m] * kInvFreq2Pi[pi]; fr -= floor(fr); const float ff = (float)fr;
      const float sn = __builtin_amdgcn_sinf(ff), cs = __builtin_amdgcn_cosf(ff);
      const bf16_t o1 = f2bf(x1 * cs - x2 * sn), o2 = f2bf(x2 * cs + x1 * sn);
#pragma unroll
      for (int hd = 0; hd < 4; ++hd) { bf16_t* kp = kmla + ((size_t)hd * S_ + m) * 192 + 128; kp[pi] = o1; kp[32 + pi] = o2; } }
  }
  __syncthreads();
}

DI void gdn_prep_item(const Params& P, int l, int n, int hh, char* smem) {
  const int tid = opaque_tid(), lane = tid & 63, w = tid >> 6, lq = lane & 31, h = lane >> 5;
  const bf16_t* proj = (const bf16_t*)(P.ws + OFF_PROJ); const float* ab = (const float*)(P.ws + OFF_AB);
  char* kb16 = smem; char* qb16 = smem + 17408;
  float* kf = (float*)(smem + 34816); float* vf = kf + 8192; float* Lm = vf + 8192; float* gcs = Lm + 4096;
  const size_t tile = (size_t)hh * 256 + n; const int t0 = n * 64;
  bf16_t* Wp = (bf16_t*)(P.ws + OFF_WP) + tile * 8192; bf16_t* Qd = (bf16_t*)(P.ws + OFF_QD) + tile * 8192;
  bf16_t* Kt = (bf16_t*)(P.ws + OFF_KT) + tile * 8192; bf16_t* Zt = (bf16_t*)(P.ws + OFF_ZT) + tile * 8192;
  bf16_t* QK = (bf16_t*)(P.ws + OFF_QK) + tile * 4096; bf16_t* Ut = (bf16_t*)(P.ws + OFF_UT) + tile * 8192;
  if (w == 0) {
    const int t = lane; const float a_raw = ab[(size_t)(t0 + t) * 16 + hh], b_raw = ab[(size_t)(t0 + t) * 16 + 8 + hh];
    const float Aa = __expf(P.gdn_a_log[l * 8 + hh]); const float xb = a_raw + P.gdn_dt_bias[l * 8 + hh];
    const float ex = __expf(fminf(xb, 20.f));
    const float sp = xb > 20.f ? xb : (ex < 0.01f ? ex * (1.f - ex * (0.5f - ex * (1.f / 3.f))) : __logf(1.f + ex));
    float g = -Aa * sp;
#pragma unroll
    for (int d = 1; d < 64; d <<= 1) { const float v = __shfl_up(g, d); if (lane >= d) g += v; }
    const float bt = __builtin_amdgcn_rcpf(1.f + __expf(-b_raw)), eg = __expf(g); gcs[t] = g; gcs[64 + t] = bt; gcs[128 + t] = eg; gcs[192 + t] = bt * eg;
    if (t == 63) ((float*)(P.ws + OFF_GTOT))[tile] = eg;
  }
  __syncthreads();
  {
    const int t = tid >> 3, part = tid & 7, tabs = t0 + t;
    const float gct = gcs[t], egct = gcs[128 + t], ktl = __expf(gcs[63] - gct);
    const int pjt = 32 * (t >> 5) + perm32(t & 31);
#pragma unroll
    for (int X = 0; X < 3; ++X) {
      const int cb = X * 1024 + hh * 128 + part * 16;
      float y[16];
#pragma unroll
      for (int e = 0; e < 16; ++e) y[e] = 0.f;
      u32x4 pv[4][2]; f32x4 wv[4][4];
#pragma unroll
      for (int j = 0; j < 4; ++j) { const int row = tabs - 3 + j, rr = row < 0 ? 0 : row;
        pv[j][0] = *(const u32x4*)(proj + (size_t)rr * DINP + cb); pv[j][1] = *(const u32x4*)(proj + (size_t)rr * DINP + cb + 8);
        const float* cw = P.gdn_conv + ((size_t)l * 4 + j) * 3072 + cb;
#pragma unroll
        for (int e4 = 0; e4 < 4; ++e4) wv[j][e4] = *(const f32x4*)(cw + 4 * e4); }
      __builtin_amdgcn_sched_barrier(0);
#pragma unroll
      for (int j = 0; j < 4; ++j) { const float msk = (tabs - 3 + j) >= 0 ? 1.f : 0.f;
        float xv[16]; unpack8(pv[j][0], xv); unpack8(pv[j][1], xv + 8);
#pragma unroll
        for (int e4 = 0; e4 < 4; ++e4) { const f32x4 wm = wv[j][e4] * msk; y[4 * e4] += wm.x * xv[4 * e4]; y[4 * e4 + 1] += wm.y * xv[4 * e4 + 1]; y[4 * e4 + 2] += wm.z * xv[4 * e4 + 2]; y[4 * e4 + 3] += wm.w * xv[4 * e4 + 3]; } }
#pragma unroll
      for (int e = 0; e < 16; ++e) y[e] = silu_f(y[e]);
      if (X < 2) { float ss = 0.f;
#pragma unroll
        for (int e = 0; e < 16; ++e) ss += y[e] * y[e];
        ss += __shfl_xor(ss, 1); ss += __shfl_xor(ss, 2); ss += __shfl_xor(ss, 4);
        const float rn = rsqrtf(ss + EPS) * (X == 0 ? 0.08838834764831845f : 1.f);
#pragma unroll
        for (int e = 0; e < 16; ++e) y[e] *= rn; }
      if (X == 0) {
        u32x4 p0 = {pack2(y[0], y[1]), pack2(y[2], y[3]), pack2(y[4], y[5]), pack2(y[6], y[7])}, p1 = {pack2(y[8], y[9]), pack2(y[10], y[11]), pack2(y[12], y[13]), pack2(y[14], y[15])};
        *(u32x4*)(qb16 + t * 272 + part * 32) = p0; *(u32x4*)(qb16 + t * 272 + part * 32 + 16) = p1;
#pragma unroll
        for (int b = 0; b < 4; ++b) { u32x2 pk = {pack2(y[4 * b] * egct, y[4 * b + 1] * egct), pack2(y[4 * b + 2] * egct, y[4 * b + 3] * egct)};
          *(u32x2*)(Qd + t * 128 + 32 * (part >> 1) + 8 * b + 4 * (part & 1)) = pk; }
      } else if (X == 1) {
        u32x4 p0 = {pack2(y[0], y[1]), pack2(y[2], y[3]), pack2(y[4], y[5]), pack2(y[6], y[7])}, p1 = {pack2(y[8], y[9]), pack2(y[10], y[11]), pack2(y[12], y[13]), pack2(y[14], y[15])};
        *(u32x4*)(kb16 + t * 272 + part * 32) = p0; *(u32x4*)(kb16 + t * 272 + part * 32 + 16) = p1;
#pragma unroll
        for (int e4 = 0; e4 < 4; ++e4) { f32x4 v = {y[4 * e4], y[4 * e4 + 1], y[4 * e4 + 2], y[4 * e4 + 3]}; *(f32x4*)(kf + t * 128 + part * 16 + 4 * e4) = v; }
#pragma unroll
        for (int e = 0; e < 16; ++e) Kt[(part * 16 + e) * 64 + pjt] = f2bf(y[e] * ktl);
      } else {
#pragma unroll
        for (int e4 = 0; e4 < 4; ++e4) { f32x4 v = {y[4 * e4], y[4 * e4 + 1], y[4 * e4 + 2], y[4 * e4 + 3]}; *(f32x4*)(vf + t * 128 + part * 16 + 4 * e4) = v; }
      }
    }
    { const int cb = C_AZ + hh * 128 + part * 16; const u32x4 v0 = *(const u32x4*)(proj + (size_t)tabs * DINP + cb), v1 = *(const u32x4*)(proj + (size_t)tabs * DINP + cb + 8);
      float zv[16]; unpack8(v0, zv); unpack8(v1, zv + 8);
#pragma unroll
      for (int e = 0; e < 16; ++e) Zt[(part * 16 + e) * 64 + t] = f2bf(silu_f(zv[e])); }
  }
  __syncthreads();
  {
    const int which = w >> 2, ti = (w >> 1) & 1, tj = w & 1; const char* Ab = which ? qb16 : kb16;
    f32x16 acc;
#pragma unroll
    for (int r = 0; r < 16; ++r) acc[r] = 0.f;
#pragma unroll
    for (int s = 0; s < 8; ++s) { const bf16x8 a = *(const bf16x8*)(Ab + (32 * ti + lq) * 272 + (16 * s + 8 * h) * 2), b = *(const bf16x8*)(kb16 + (32 * tj + lq) * 272 + (16 * s + 8 * h) * 2);
      acc = MFMA32(a, b, acc); }
    const int j = 32 * tj + lq; const float gj = gcs[j]; const int pj = 32 * (j >> 5) + perm32(j & 31);
#pragma unroll
    for (int r = 0; r < 16; ++r) { const int i = 32 * ti + crow(r, h); const float dec = __expf(fminf(gcs[i] - gj, 0.f));
      if (which == 0) Lm[i * 64 + j] = (j < i) ? gcs[64 + i] * acc[r] * dec : 0.f;
      else QK[i * 64 + pj] = f2bf((j <= i) ? acc[r] * dec : 0.f); }
  }
  __syncthreads();
  if (tid < 256) {
    const int c = tid; const bool isu = c < 128; const int cc = c & 127;
    const float* rp = (isu ? vf : kf) + cc; const float* sp = gcs + (isu ? 64 : 192);
    f32x2 xx[32];
    f32x4 LA[16], LB[16]; float rh[2];
    xx[0].x = sp[0] * rp[0];
    LA[0] = *(const f32x4*)(Lm + 64); rh[1] = sp[1] * rp[128];
#pragma unroll
    for (int i = 1; i < 64; ++i) {
      f32x4 (&CUR)[16] = (i & 1) ? LA : LB; f32x4 (&NXT)[16] = (i & 1) ? LB : LA;
      if (i + 1 < 64) {
#pragma unroll
        for (int c = 0; c < (i + 4) / 4; ++c) NXT[c] = *(const f32x4*)(Lm + (i + 1) * 64 + 4 * c);
        rh[(i + 1) & 1] = sp[i + 1] * rp[(i + 1) * 128];
      }
      __builtin_amdgcn_sched_barrier(0);
      f32x2 acc = {rh[i & 1], 0.f};
#pragma unroll
      for (int p = 0; p < i / 2; ++p) { const f32x2 lp = (p & 1) ? (f32x2){CUR[p >> 1].z, CUR[p >> 1].w} : (f32x2){CUR[p >> 1].x, CUR[p >> 1].y}; acc = acc - lp * xx[p]; }
      if (i & 1) { const int j = i - 1; const float lj = ((j & 3) == 0) ? CUR[j >> 2].x : CUR[j >> 2].z; acc.x = fmaf(-lj, xx[j >> 1].x, acc.x); }
      const float xi = acc.x + acc.y;
      if (i & 1) xx[i >> 1].y = xi; else xx[i >> 1].x = xi;
      __builtin_amdgcn_sched_barrier(0);
    }
    float x[64];
#pragma unroll
    for (int p = 0; p < 32; ++p) { x[2 * p] = xx[p].x; x[2 * p + 1] = xx[p].y; }
    if (isu) {
#pragma unroll
      for (int i8 = 0; i8 < 8; ++i8) { u32x4 v = {pack2(x[8 * i8], x[8 * i8 + 1]), pack2(x[8 * i8 + 2], x[8 * i8 + 3]), pack2(x[8 * i8 + 4], x[8 * i8 + 5]), pack2(x[8 * i8 + 6], x[8 * i8 + 7])}; *(u32x4*)(Ut + cc * 64 + 8 * i8) = v; }
    } else {
      const int pp = 32 * (cc >> 5) + perm32(cc & 31);
#pragma unroll
      for (int i = 0; i < 64; ++i) Wp[i * 128 + pp] = f2bf(x[i]);
    }
  }
  __syncthreads();
}

DI bf16x8 pack_tiles(const f32x4& a, const f32x4& b) { return pack8(a.x, a.y, a.z, a.w, b.x, b.y, b.z, b.w); }
template <int CTRL> DI float dppf(float v) { return __int_as_float(__builtin_amdgcn_update_dpp(0, __float_as_int(v), CTRL, 0xf, 0xf, true)); }
DI float row16_sum(float v) { v += dppf<0xB1>(v); v += dppf<0x4E>(v); v += dppf<0x141>(v); v += dppf<0x140>(v); return v; }
constexpr size_t OFF_SSQP = OFF_GTOT + 8192;
static_assert(OFF_SSQP + (size_t)8 * S_ * 8 * 4 <= OFF_UT, "overlay3");
constexpr int SCAN_OPB = 62464;
constexpr int SCAN_SO = 2 * SCAN_OPB;
constexpr int SCAN_OT = SCAN_SO + 16384;
DI void gdn_scan_item(const Params& P, int l, int hh, int half, char* smem) {
  const int tid = opaque_tid(), lane = tid & 63, w = tid >> 6, l15 = lane & 15, q4 = lane >> 4;
  const size_t hb = (size_t)hh * 256;
  const bf16_t* Wp = (const bf16_t*)(P.ws + OFF_WP) + hb * 8192; const bf16_t* Qd = (const bf16_t*)(P.ws + OFF_QD) + hb * 8192;
  const bf16_t* Kt = (const bf16_t*)(P.ws + OFF_KT) + hb * 8192; const bf16_t* Zt = (const bf16_t*)(P.ws + OFF_ZT) + hb * 8192;
  const bf16_t* QK = (const bf16_t*)(P.ws + OFF_QK) + hb * 4096; const bf16_t* Ut = (const bf16_t*)(P.ws + OFF_UT) + hb * 8192;
  const float* gt = (const float*)(P.ws + OFF_GTOT) + hb;
  bf16_t* mixin = (bf16_t*)(P.ws + OFF_H);
  float* sSS = (float*)(smem + SCAN_OT + 16384);
  if (w >= 4) {
    const int lt = tid - 256, wl = w - 4;
    const int dvc = 64 * half + 16 * wl + l15; const float nw = P.gdn_norm[l * 128 + dvc];
    const int uoff = dvc * 64 + 4 * q4;
    const int g256 = (lt >> 4) * 128 + (lt & 15) * 8, l256 = (lt >> 4) * 272 + (lt & 15) * 16;
    const int g128 = (lt >> 3) * 64 + (lt & 7) * 8, l128 = (lt >> 3) * 144 + (lt & 7) * 16;
    u32x4 pwA[4], pqA[4], pkA[4], pqkA[2], pwB[4], pqB[4], pkB[4], pqkB[2]; u32x2 zA[4], zB[4];
#define LD_LOAD(PW, PQ, PK, PQK, N) { const int n__ = (N) < 255 ? (N) : 255; const size_t o8 = (size_t)n__ * 8192, o4 = (size_t)n__ * 4096; \
    _Pragma("unroll") for (int i = 0; i < 4; ++i) { PW[i] = *(const u32x4*)(Wp + o8 + g256 + i * 2048); PQ[i] = *(const u32x4*)(Qd + o8 + g256 + i * 2048); PK[i] = *(const u32x4*)(Kt + o8 + g128 + i * 2048); } \
    _Pragma("unroll") for (int i = 0; i < 2; ++i) PQK[i] = *(const u32x4*)(QK + o4 + g128 + i * 2048); }
#define LZ_LOAD(Z, N) { const int n__ = (N) < 255 ? (N) : 255; _Pragma("unroll") for (int it = 0; it < 4; ++it) Z[it] = *(const u32x2*)(Zt + (size_t)n__ * 8192 + uoff + 16 * it); }
#define LD_STAGE(PW, PQ, PK, PQK, NB) { char* nb_ = (NB); \
    _Pragma("unroll") for (int i = 0; i < 4; ++i) { *(u32x4*)(nb_ + l256 + i * 4352) = PW[i]; *(u32x4*)(nb_ + 17408 + l256 + i * 4352) = PQ[i]; *(u32x4*)(nb_ + 34816 + l128 + i * 4608) = PK[i]; } \
    _Pragma("unroll") for (int i = 0; i < 2; ++i) *(u32x4*)(nb_ + 53248 + l128 + i * 4608) = PQK[i]; }
#define LD_FINISH(M, Z) { const int m = (M); const char* so = smem + SCAN_SO + (m & 1) * 8192 + (wl * 4) * 512 + lane * 8; \
    bf16_t* ot = (bf16_t*)(smem + SCAN_OT + (m & 1) * 8192); float* sq = sSS + (m & 1) * 256 + wl * 64; \
    _Pragma("unroll") for (int it = 0; it < 4; ++it) { \
      const u32x2 ob = *(const u32x2*)(so + it * 512); const f32x4 o = {bflo(ob.x), bfhi(ob.x), bflo(ob.y), bfhi(ob.y)}; \
      f32x4 ss = o * o; ss.x = row16_sum(ss.x); ss.y = row16_sum(ss.y); ss.z = row16_sum(ss.z); ss.w = row16_sum(ss.w); \
      const int rl = 16 * it + 4 * q4; \
      if (l15 == 0) *(f32x4*)(sq + rl) = ss; \
      bf16_t* op = ot + rl * 64 + 16 * wl + l15; \
      op[0] = f2bf(o.x * nw * bflo(Z[it].x)); op[64] = f2bf(o.y * nw * bfhi(Z[it].x)); op[128] = f2bf(o.z * nw * bflo(Z[it].y)); op[192] = f2bf(o.w * nw * bfhi(Z[it].y)); } }
#define LD_STEP(PW, PQ, PK, PQK, ZU, N) { const int n_ = (N); \
    LD_STAGE(PW, PQ, PK, PQK, smem + ((n_ + 1) & 1) * SCAN_OPB); \
    LD_LOAD(PW, PQ, PK, PQK, n_ + 3); \
    if (n_ >= 1) LD_FINISH(n_ - 1, ZU); \
    LZ_LOAD(ZU, n_ + 1); \
    __syncthreads(); }
    LD_LOAD(pwA, pqA, pkA, pqkA, 0);
    LD_STAGE(pwA, pqA, pkA, pqkA, smem);
    LD_LOAD(pwA, pqA, pkA, pqkA, 1);
    LD_LOAD(pwB, pqB, pkB, pqkB, 2);
    LZ_LOAD(zB, 0);
    LZ_LOAD(zA, 0);
    __syncthreads();
#pragma unroll 1
    for (int n = 0; n < 256; n += 2) {
      LD_STEP(pwA, pqA, pkA, pqkA, zA, n);
      LD_STEP(pwB, pqB, pkB, pqkB, zB, n + 1);
    }
    LD_FINISH(255, zA);
    __syncthreads();
#undef LD_LOAD
#undef LZ_LOAD
#undef LD_STAGE
#undef LD_FINISH
#undef LD_STEP
  } else {
    const int dvc = 64 * half + 16 * w + l15;
    const int uoff = dvc * 64 + 4 * q4;
    float* ssqp = (float*)(P.ws + OFF_SSQP) + (size_t)(half * 4 + w) * S_ * 8;
    f32x4 St[8];
#pragma unroll
    for (int t = 0; t < 8; ++t) St[t] = (f32x4){0.f, 0.f, 0.f, 0.f};
    u32x2 uc[4], un[4]; float gcur, gn = 0.f;
#pragma unroll
    for (int it = 0; it < 4; ++it) { uc[it] = *(const u32x2*)(Ut + uoff + 16 * it); un[it] = uc[it]; }
    gcur = gt[0];
#define CP_OUT(M) { const int m2 = (M); const char* ot = smem + SCAN_OT + (m2 & 1) * 8192; \
      _Pragma("unroll") for (int i = 0; i < 2; ++i) { const int c = tid + 256 * i, row = c >> 3, cc = c & 7; \
        *(u32x4*)(mixin + (size_t)(64 * m2 + row) * 2048 + hh * 128 + 64 * half + cc * 8) = *(const u32x4*)(ot + row * 128 + cc * 16); } \
      ssqp[(size_t)(64 * m2 + lane) * 8 + hh] = sSS[(m2 & 1) * 256 + w * 64 + lane]; }
    __syncthreads();
#pragma unroll 2
    for (int n = 0; n < 256; ++n) {
      const char* cb = smem + (n & 1) * SCAN_OPB;
      const char* sWp = cb; const char* sQd = cb + 17408; const char* sKt = cb + 34816; const char* sQK = cb + 53248;
      if (n + 1 < 256) { const size_t o8 = (size_t)(n + 1) * 8192;
#pragma unroll
        for (int it = 0; it < 4; ++it) un[it] = *(const u32x2*)(Ut + o8 + uoff + 16 * it);
        gn = gt[n + 1]; }
      bf16x8 sb[4];
#pragma unroll
      for (int ks = 0; ks < 4; ++ks) sb[ks] = pack_tiles(St[2 * ks], St[2 * ks + 1]);
      f32x4 wsv[4], qs[4];
#pragma unroll
      for (int it = 0; it < 4; ++it) { wsv[it] = (f32x4){0.f, 0.f, 0.f, 0.f}; qs[it] = (f32x4){0.f, 0.f, 0.f, 0.f}; }
#pragma unroll
      for (int it = 0; it < 4; ++it)
#pragma unroll
        for (int ks = 0; ks < 4; ++ks) { const int o = (16 * it + l15) * 272 + 64 * ks + 16 * q4;
          const bf16x8 a = *(const bf16x8*)(sWp + o), a2 = *(const bf16x8*)(sQd + o);
          wsv[it] = MFMA16(a, sb[ks], wsv[it]); qs[it] = MFMA16(a2, sb[ks], qs[it]); }
      f32x4 vn[4];
#pragma unroll
      for (int it = 0; it < 4; ++it) { const f32x4 uf = {bflo(uc[it].x), bfhi(uc[it].x), bflo(uc[it].y), bfhi(uc[it].y)}; vn[it] = uf - wsv[it]; }
      bf16x8 vb[2];
#pragma unroll
      for (int ks = 0; ks < 2; ++ks) vb[ks] = pack_tiles(vn[2 * ks], vn[2 * ks + 1]);
#pragma unroll
      for (int it = 0; it < 4; ++it)
#pragma unroll
        for (int ks = 0; ks < 2; ++ks) { const bf16x8 a = *(const bf16x8*)(sQK + (16 * it + l15) * 144 + 64 * ks + 16 * q4); qs[it] = MFMA16(a, vb[ks], qs[it]); }
      { char* so = smem + SCAN_SO + (n & 1) * 8192 + (w * 4) * 512 + lane * 8;
#pragma unroll
        for (int it = 0; it < 4; ++it) { u32x2 ob = {pack2(qs[it].x, qs[it].y), pack2(qs[it].z, qs[it].w)}; *(u32x2*)(so + it * 512) = ob; } }
#pragma unroll
      for (int t = 0; t < 8; ++t) { St[t] *= gcur;
#pragma unroll
        for (int ks = 0; ks < 2; ++ks) { const bf16x8 a = *(const bf16x8*)(sKt + (16 * t + l15) * 144 + 64 * ks + 16 * q4); St[t] = MFMA16(a, vb[ks], St[t]); } }
#pragma unroll
      for (int it = 0; it < 4; ++it) uc[it] = un[it];
      gcur = gn;
      if (n >= 2) CP_OUT(n - 2);
      __syncthreads();
    }
    CP_OUT(254);
    __syncthreads();
    CP_OUT(255);
#undef CP_OUT
  }
  __syncthreads();
}
DI void gdn_fix_phase(const Params& P) {
  const int tid = opaque_tid();
  bf16_t* mixin = (bf16_t*)(P.ws + OFF_H); const float* ssqp = (const float*)(P.ws + OFF_SSQP);
  for (int idx = blockIdx.x * NT + tid; idx < S_ * 128; idx += gridDim.x * NT) {
    const int t = idx >> 7, ck = idx & 127, h = ck >> 4;
    float sq = 0.f;
#pragma unroll
    for (int p = 0; p < 8; ++p) sq += ssqp[((size_t)p * S_ + t) * 8 + h];
    const float r = rsqrtf(sq * (1.f / 128.f) + EPS);
    u32x4* pp = (u32x4*)(mixin + (size_t)t * 2048 + ck * 8); const u32x4 v = *pp; float f[8]; unpack8(v, f);
    u32x4 o = {pack2(f[0] * r, f[1] * r), pack2(f[2] * r, f[3] * r), pack2(f[4] * r, f[5] * r), pack2(f[6] * r, f[7] * r)}; *pp = o;
  }
}

DI void mla_attn_item(const Params& P, int hd, int b, char* smem) {
  const int tid = opaque_tid(), lane = tid & 63, w = tid >> 6, wq = w & 3, hk = w >> 2, lq = lane & 31, h = lane >> 5;
  const float* qraw = (const float*)(P.ws + OFF_QRAW);
  const bf16_t* Kg = (const bf16_t*)(P.ws + OFF_KMLA) + (size_t)hd * S_ * 192;
  const bf16_t* Vg = (const bf16_t*)(P.ws + OFF_VT) + (size_t)hd * 128 * S_;
  bf16_t* mixin = (bf16_t*)(P.ws + OFF_H);
  const int q = 128 * b + 32 * wq + lq;
  bf16x8 qf[12];
  {
    const float* qp = qraw + (size_t)q * 768 + hd * 192 + 8 * h;
    const float sc = 0.07216878364870322f * LOG2E;
#pragma unroll
    for (int s = 0; s < 8; ++s) { const f32x4 a = *(const f32x4*)(qp + 16 * s), c = *(const f32x4*)(qp + 16 * s + 4);
      qf[s] = pack8(a.x * sc, a.y * sc, a.z * sc, a.w * sc, c.x * sc, c.y * sc, c.z * sc, c.w * sc); }
    const double pq = (double)P.pos[q];
#pragma unroll
    for (int s2 = 0; s2 < 2; ++s2) {
      const f32x4 a0 = *(const f32x4*)(qp + 128 + 16 * s2), a1 = *(const f32x4*)(qp + 128 + 16 * s2 + 4);
      const f32x4 b0 = *(const f32x4*)(qp + 160 + 16 * s2), b1 = *(const f32x4*)(qp + 160 + 16 * s2 + 4);
      float x1[8] = {a0.x, a0.y, a0.z, a0.w, a1.x, a1.y, a1.z, a1.w}, x2[8] = {b0.x, b0.y, b0.z, b0.w, b1.x, b1.y, b1.z, b1.w}, o1[8], o2[8];
#pragma unroll
      for (int j = 0; j < 8; ++j) { double fr = pq * kInvFreq2Pi[16 * s2 + 8 * h + j]; fr -= floor(fr); const float ff = (float)fr;
        const float sn = __builtin_amdgcn_sinf(ff), cs = __builtin_amdgcn_cosf(ff);
        o1[j] = (x1[j] * cs - x2[j] * sn) * sc; o2[j] = (x2[j] * cs + x1[j] * sn) * sc; }
      qf[8 + s2] = pack8(o1[0], o1[1], o1[2], o1[3], o1[4], o1[5], o1[6], o1[7]);
      qf[10 + s2] = pack8(o2[0], o2[1], o2[2], o2[3], o2[4], o2[5], o2[6], o2[7]);
    }
  }
  constexpr int KST = 64 * 400, VST = 128 * 144, STG = KST + VST;
  f32x16 O[4];
#pragma unroll
  for (int i = 0; i < 4; ++i)
#pragma unroll
    for (int r = 0; r < 16; ++r) O[i][r] = 0.f;
  float m_i = -1e30f, l_i = 0.f;
  const int nt = 2 * b + 2;
  u32x4 rk0[3], rv0[2], rk1[3], rv1[2];
  const int vrow = tid >> 3, vcc = tid & 7;
  const int ntl = nt - 1;
#define AT_LOAD(RK, RV, T) { const size_t ko_ = (size_t)(T) * 64 * 192; const int vo_ = (T) * 64; \
    _Pragma("unroll") for (int i = 0; i < 3; ++i) { const int id = tid + NT * i, row = id / 24, cc = id % 24; RK[i] = *(const u32x4*)(Kg + ko_ + row * 192 + cc * 8); } \
    _Pragma("unroll") for (int i = 0; i < 2; ++i) RV[i] = *(const u32x4*)(Vg + (size_t)(vrow + 64 * i) * S_ + vo_ + vcc * 8); }
#define AT_WRITE(RK, RV, ST) { char* dK = smem + (ST) * STG; \
    _Pragma("unroll") for (int i = 0; i < 3; ++i) { const int id = tid + NT * i, row = id / 24, cc = id % 24; *(u32x4*)(dK + row * 400 + cc * 16) = RK[i]; } \
    _Pragma("unroll") for (int i = 0; i < 2; ++i) *(u32x4*)(dK + KST + (vrow + 64 * i) * 144 + vcc * 16) = RV[i]; }
#define AT_COMPUTE(ST, KT) { const char* sK = smem + (ST) * STG; const char* sV = sK + KST; const int key0 = 64 * (KT) + 32 * hk; \
    if (key0 <= 128 * b + 32 * wq) { \
      f32x16 st; _Pragma("unroll") for (int r = 0; r < 16; ++r) st[r] = 0.f; \
      _Pragma("unroll") for (int s = 0; s < 12; ++s) { const bf16x8 kf = *(const bf16x8*)(sK + (32 * hk + lq) * 400 + (2 * s + h) * 16); st = MFMA32(kf, qf[s], st); } \
      if (key0 + 31 > 128 * b + 32 * wq) { int qrel = q - key0 - 4 * h; asm volatile("" : "+v"(qrel)); \
        _Pragma("unroll") for (int r = 0; r < 16; ++r) if ((r & 3) + 8 * (r >> 2) > qrel) st[r] = -1e30f; } \
      float mx = st[0]; _Pragma("unroll") for (int r = 1; r < 16; ++r) mx = fmaxf(mx, st[r]); \
      mx = xhalf_max(mx); \
      const float m_new = fmaxf(m_i, mx), alpha = __builtin_amdgcn_exp2f(m_i - m_new); float ps = 0.f; \
      _Pragma("unroll") for (int r = 0; r < 16; ++r) { st[r] = __builtin_amdgcn_exp2f(st[r] - m_new); ps += st[r]; } \
      l_i = l_i * alpha + ps; \
      if (__any(m_new != m_i)) { _Pragma("unroll") for (int i = 0; i < 4; ++i) _Pragma("unroll") for (int r = 0; r < 16; ++r) O[i][r] *= alpha; } \
      m_i = m_new; \
      bf16x8 pf[2]; \
      _Pragma("unroll") for (int s = 0; s < 2; ++s) pf[s] = pack8(st[8 * s], st[8 * s + 1], st[8 * s + 2], st[8 * s + 3], st[8 * s + 4], st[8 * s + 5], st[8 * s + 6], st[8 * s + 7]); \
      _Pragma("unroll") for (int i = 0; i < 4; ++i) _Pragma("unroll") for (int s = 0; s < 2; ++s) { const char* vp = sV + (32 * i + lq) * 144 + (32 * hk + 16 * s + 4 * h) * 2; \
          const u32x2 lo = *(const u32x2*)vp, hi = *(const u32x2*)(vp + 16); u32x4 vv = {lo.x, lo.y, hi.x, hi.y}; \
          O[i] = MFMA32(__builtin_bit_cast(bf16x8, vv), pf[s], O[i]); } } }
  AT_LOAD(rk0, rv0, 0);
  AT_LOAD(rk1, rv1, 1);
  AT_WRITE(rk0, rv0, 0);
  AT_LOAD(rk0, rv0, (2 < ntl ? 2 : ntl));
  __syncthreads();
  for (int kt = 0; kt < nt; kt += 2) {
    AT_WRITE(rk1, rv1, 1);
    AT_LOAD(rk1, rv1, (kt + 3 < ntl ? kt + 3 : ntl));
    AT_COMPUTE(0, kt);
    __syncthreads();
    AT_WRITE(rk0, rv0, 0);
    AT_LOAD(rk0, rv0, (kt + 4 < ntl ? kt + 4 : ntl));
    AT_COMPUTE(1, kt + 1);
    __syncthreads();
  }
#undef AT_LOAD
#undef AT_WRITE
#undef AT_COMPUTE
  float* cO = (float*)smem; float* cm = cO + 4 * 4096; float* cl = cm + 256;
  if (hk == 1) {
#pragma unroll
    for (int i = 0; i < 4; ++i)
#pragma unroll
      for (int r = 0; r < 16; ++r) cO[wq * 4096 + (i * 16 + r) * 64 + lane] = O[i][r];
    cm[wq * 64 + lane] = m_i; cl[wq * 64 + lane] = l_i;
  }
  __syncthreads();
  if (hk == 0) {
    const float m1 = cm[wq * 64 + lane], l1 = cl[wq * 64 + lane];
    const float m = fmaxf(m_i, m1), a0 = exp2f(m_i - m), a1 = exp2f(m1 - m);
    float lt = l_i * a0 + l1 * a1; lt += __shfl_xor(lt, 32);
    const float inv = 1.f / lt;
    bf16_t* op = mixin + (size_t)q * 2048 + 1024 + hd * 128;
#pragma unroll
    for (int i = 0; i < 4; ++i)
#pragma unroll
      for (int rg = 0; rg < 4; ++rg) { float v[4];
#pragma unroll
        for (int e = 0; e < 4; ++e) v[e] = (O[i][4 * rg + e] * a0 + cO[wq * 4096 + (i * 16 + 4 * rg + e) * 64 + lane] * a1) * inv;
        u32x2 pk = {pack2(v[0], v[1]), pack2(v[2], v[3])}; *(u32x2*)(op + 32 * i + 8 * rg + 4 * h) = pk; }
  }
  __syncthreads();
}

DI void swa_item(const Params& P, int l, int n, int hk2, char* smem) {
  const int tid = opaque_tid(), lane = tid & 63, w = tid >> 6, lq = lane & 31, h = lane >> 5;
  const bf16_t* proj = (const bf16_t*)(P.ws + OFF_PROJ); bf16_t* mixin = (bf16_t*)(P.ws + OFF_H);
  bf16_t* sVt = (bf16_t*)smem;
#pragma unroll
  for (int i = 0; i < 4; ++i) { const int id = tid + NT * i, key = id >> 3, dc = id & 7; const int kp = 128 * (n - 1) + key;
    u32x4 v = {0u, 0u, 0u, 0u}; if (kp >= 0) v = *(const u32x4*)(proj + (size_t)kp * DINP + C_CV + hk2 * 64 + dc * 8);
    sVt[(8 * dc + 0) * 264 + key] = (bf16_t)(v.x & 0xffff); sVt[(8 * dc + 1) * 264 + key] = (bf16_t)(v.x >> 16);
    sVt[(8 * dc + 2) * 264 + key] = (bf16_t)(v.y & 0xffff); sVt[(8 * dc + 3) * 264 + key] = (bf16_t)(v.y >> 16);
    sVt[(8 * dc + 4) * 264 + key] = (bf16_t)(v.z & 0xffff); sVt[(8 * dc + 5) * 264 + key] = (bf16_t)(v.z >> 16);
    sVt[(8 * dc + 6) * 264 + key] = (bf16_t)(v.w & 0xffff); sVt[(8 * dc + 7) * 264 + key] = (bf16_t)(v.w >> 16); }
  __syncthreads();
  const int g = w >> 1, hq = hk2 * 4 + g;
  const float slope = exp2f(-(float)(hq + 1)) * LOG2E, sinkv = P.swa_sinks[l * 8 + hq] * LOG2E;
#pragma unroll 1
  for (int jj = 0; jj < 2; ++jj) {
    const int j = 2 * (w & 1) + jj; const int qrow = 128 * n + 32 * j + lq;
    bf16x8 qf[4];
#pragma unroll
    for (int s = 0; s < 4; ++s) qf[s] = *(const bf16x8*)(proj + (size_t)qrow * DINP + C_CQ + hq * 64 + 16 * s + 8 * h);
    f32x16 st[5];
    bf16x8 kf[2][4];
    { const int kp = 128 * (n - 1) + 32 * j + lq;
#pragma unroll
      for (int s = 0; s < 4; ++s) { kf[0][s] = (bf16x8){0, 0, 0, 0, 0, 0, 0, 0}; if (kp >= 0) kf[0][s] = *(const bf16x8*)(proj + (size_t)kp * DINP + C_CK + hk2 * 64 + 16 * s + 8 * h); } }
#pragma unroll
    for (int tt = 0; tt < 5; ++tt) {
      if (tt + 1 < 5) { const int kp = 128 * (n - 1) + 32 * (j + tt + 1) + lq;
#pragma unroll
        for (int s = 0; s < 4; ++s) { kf[(tt + 1) & 1][s] = (bf16x8){0, 0, 0, 0, 0, 0, 0, 0}; if (kp >= 0) kf[(tt + 1) & 1][s] = *(const bf16x8*)(proj + (size_t)kp * DINP + C_CK + hk2 * 64 + 16 * s + 8 * h); } }
      __builtin_amdgcn_sched_barrier(0);
#pragma unroll
      for (int r = 0; r < 16; ++r) st[tt][r] = 0.f;
#pragma unroll
      for (int s = 0; s < 4; ++s) st[tt] = MFMA32(kf[tt & 1][s], qf[s], st[tt]);
      __builtin_amdgcn_sched_barrier(0);
    }
    float mx = sinkv;
    int dbase = 128 + lq - 4 * h, kbase = 128 * (n - 1) + 32 * j + 4 * h;
    asm volatile("" : "+v"(dbase), "+v"(kbase));
#pragma unroll
    for (int tt = 0; tt < 5; ++tt)
#pragma unroll
      for (int r = 0; r < 16; ++r) { const int cst = 32 * tt + (r & 3) + 8 * (r >> 2); const int dist = dbase - cst; const int kpos = kbase + cst;
        const bool valid = (dist >= 0) && (dist < 128) && (kpos >= 0);
        const float sv = valid ? st[tt][r] * (0.125f * LOG2E) - slope * (float)dist : -1e30f; st[tt][r] = sv; mx = fmaxf(mx, sv); }
    mx = fmaxf(mx, __shfl_xor(mx, 32));
    float den = 0.f;
#pragma unroll
    for (int tt = 0; tt < 5; ++tt)
#pragma unroll
      for (int r = 0; r < 16; ++r) { const float p = exp2f(st[tt][r] - mx); st[tt][r] = p; den += p; }
    den += __shfl_xor(den, 32); den += exp2f(sinkv - mx);
    f32x16 O[2];
#pragma unroll
    for (int i = 0; i < 2; ++i)
#pragma unroll
      for (int r = 0; r < 16; ++r) O[i][r] = 0.f;
#pragma unroll
    for (int tt = 0; tt < 5; ++tt)
#pragma unroll
      for (int s = 0; s < 2; ++s) { const bf16x8 pf = pack8(st[tt][8 * s], st[tt][8 * s + 1], st[tt][8 * s + 2], st[tt][8 * s + 3], st[tt][8 * s + 4], st[tt][8 * s + 5], st[tt][8 * s + 6], st[tt][8 * s + 7]);
#pragma unroll
        for (int i = 0; i < 2; ++i) { const char* vp = (const char*)sVt + (32 * i + lq) * 528 + (32 * (j + tt) + 16 * s + 4 * h) * 2;
          const u32x2 lo = *(const u32x2*)vp, hi = *(const u32x2*)(vp + 16); u32x4 vv = {lo.x, lo.y, hi.x, hi.y};
          O[i] = MFMA32(__builtin_bit_cast(bf16x8, vv), pf, O[i]); }
        __builtin_amdgcn_sched_barrier(0); }
    const float inv = 1.f / den;
    bf16_t* op = mixin + (size_t)qrow * 2048 + 1536 + hq * 64;
#pragma unroll
    for (int i = 0; i < 2; ++i)
#pragma unroll
      for (int rg = 0; rg < 4; ++rg) { u32x2 pk = {pack2(O[i][4 * rg] * inv, O[i][4 * rg + 1] * inv), pack2(O[i][4 * rg + 2] * inv, O[i][4 * rg + 3] * inv)};
        *(u32x2*)(op + 32 * i + 8 * rg + 4 * h) = pk; }
  }
  __syncthreads();
}

DI float gelu_tanh(float x) { const float y = 0.7978845608028654f * (x + 0.044715f * x * x * x); const float t = 1.f - 2.f * __builtin_amdgcn_rcpf(1.f + __expf(2.f * y)); return 0.5f * x * (1.f + t); }
DI void ffn_act_phase(const Params& P, int l) {
  const int tid = opaque_tid(), lane = tid & 63, w = tid >> 6;
  const bf16_t* u = (const bf16_t*)(P.ws + OFF_BIG); bf16_t* act = (bf16_t*)(P.ws + OFF_ACT);
  const float* cw = P.ffn_conv + (size_t)l * 3 * DFF2; const float* cb = P.ffn_conv_b + (size_t)l * DFF2;
  for (int item = blockIdx.x * 8 + w; item < 512 * 11; item += gridDim.x * 8) {
    const int cbk = item % 11, rr = item / 11; const int ch = cbk * 512 + lane * 8, r0 = rr * 32;
    float wg[3][8], wu[3][8], bg[8], bu[8];
#pragma unroll
    for (int j = 0; j < 3; ++j)
#pragma unroll
      for (int e4 = 0; e4 < 2; ++e4) { const f32x4 a = *(const f32x4*)(cw + (size_t)j * DFF2 + ch + 4 * e4), b = *(const f32x4*)(cw + (size_t)j * DFF2 + DFF + ch + 4 * e4);
        wg[j][4 * e4] = a.x; wg[j][4 * e4 + 1] = a.y; wg[j][4 * e4 + 2] = a.z; wg[j][4 * e4 + 3] = a.w; wu[j][4 * e4] = b.x; wu[j][4 * e4 + 1] = b.y; wu[j][4 * e4 + 2] = b.z; wu[j][4 * e4 + 3] = b.w; }
#pragma unroll
    for (int e4 = 0; e4 < 2; ++e4) { const f32x4 a = *(const f32x4*)(cb + ch + 4 * e4), b = *(const f32x4*)(cb + DFF + ch + 4 * e4);
      bg[4 * e4] = a.x; bg[4 * e4 + 1] = a.y; bg[4 * e4 + 2] = a.z; bg[4 * e4 + 3] = a.w; bu[4 * e4] = b.x; bu[4 * e4 + 1] = b.y; bu[4 * e4 + 2] = b.z; bu[4 * e4 + 3] = b.w; }
    float g2[8], g1[8], u2[8], u1[8];
#pragma unroll
    for (int e = 0; e < 8; ++e) { g2[e] = 0.f; g1[e] = 0.f; u2[e] = 0.f; u1[e] = 0.f; }
    if (r0 >= 2) { unpack8(*(const u32x4*)(u + (size_t)(r0 - 2) * DFF2 + ch), g2); unpack8(*(const u32x4*)(u + (size_t)(r0 - 2) * DFF2 + DFF + ch), u2);
      unpack8(*(const u32x4*)(u + (size_t)(r0 - 1) * DFF2 + ch), g1); unpack8(*(const u32x4*)(u + (size_t)(r0 - 1) * DFF2 + DFF + ch), u1); }
#pragma unroll 1
    for (int rb = 0; rb < 4; ++rb) {
      u32x4 G[8], U[8];
#pragma unroll
      for (int i = 0; i < 8; ++i) { const size_t ro = (size_t)(r0 + rb * 8 + i) * DFF2 + ch; G[i] = *(const u32x4*)(u + ro); U[i] = *(const u32x4*)(u + ro + DFF); }
#pragma unroll
      for (int i = 0; i < 8; ++i) {
        float g0[8], u0[8]; unpack8(G[i], g0); unpack8(U[i], u0);
        float o[8];
#pragma unroll
        for (int e = 0; e < 8; ++e) { const float yg = wg[0][e] * g2[e] + wg[1][e] * g1[e] + wg[2][e] * g0[e] + bg[e]; const float yu = wu[0][e] * u2[e] + wu[1][e] * u1[e] + wu[2][e] * u0[e] + bu[e];
          o[e] = gelu_tanh(yg) * yu; g2[e] = g1[e]; g1[e] = g0[e]; u2[e] = u1[e]; u1[e] = u0[e]; }
        u32x4 pk = {pack2(o[0], o[1]), pack2(o[2], o[3]), pack2(o[4], o[5]), pack2(o[6], o[7])};
        *(u32x4*)(act + (size_t)(r0 + rb * 8 + i) * DFF + ch) = pk;
      }
    }
  }
}

#define XB_TMO      128
#define XB_XCNT(j)  (256  + 64 * (j))
#define XB_XSUB(j)  (1280 + 64 * (j))
#define XB_XGEN(j)  (2304 + 64 * (j))
#define XB_TOP      3328
#define XB_TOPGEN   3392
#define XCD_BAR_WORDS 3456
#define XB_SPIN_CAP (1u << 18)
#define LAS __attribute__((address_space(3)))
DI unsigned xb_ld(unsigned* p)              { return __hip_atomic_load(p, __ATOMIC_RELAXED, __HIP_MEMORY_SCOPE_AGENT); }
DI unsigned xb_add(unsigned* p, unsigned v) { return __hip_atomic_fetch_add(p, v, __ATOMIC_RELAXED, __HIP_MEMORY_SCOPE_AGENT); }
DI unsigned xb_xcc_id() { return (unsigned)__builtin_amdgcn_s_getreg((3 << 11) | 20) & 0xFu; }
#define XB_SPIN(cond, bar) do { unsigned _sp = 0; while (cond) { __builtin_amdgcn_s_sleep(1); \
    if ((++_sp & 255u) == 0u) { if (xb_ld(&(bar)[XB_TMO])) break; if (_sp > XB_SPIN_CAP) { atomicAdd(&(bar)[XB_TMO], 1u); break; } } } } while (0)
struct XcdBarrier { unsigned* bar; unsigned x; volatile LAS unsigned* st; };
DI XcdBarrier xcd_barrier_post(unsigned* bar, volatile LAS unsigned* st) {
  XcdBarrier b; b.bar = bar; b.x = xb_xcc_id(); b.st = st;
  if (threadIdx.x == 0) (void)xb_add(&bar[XB_XCNT(b.x)], 1u);
  return b;
}
DI void xcd_barrier_complete(unsigned* bar, unsigned x, unsigned& nloc, unsigned& nx) {
  const unsigned G = gridDim.x * gridDim.y * gridDim.z;
  unsigned sum, cnt, mine, sp = 0u;
  for (;;) {
    sum = 0u; cnt = 0u; mine = 0u;
#pragma unroll
    for (unsigned j = 0; j < 16; ++j) { const unsigned c = xb_ld(&bar[XB_XCNT(j)]); sum += c; cnt += (c > 0u) ? 1u : 0u; mine = (j == x) ? c : mine; }
    if (sum == G) break;
    __builtin_amdgcn_s_sleep(1);
    if ((++sp & 255u) == 0u) { if (xb_ld(&bar[XB_TMO])) break; if (sp > XB_SPIN_CAP) { atomicAdd(&bar[XB_TMO], 1u); break; } }
  }
  nloc = mine > 0u ? mine : 1u; nx = cnt > 0u ? cnt : 1u;
}
DI void xcd_barrier(char* ws_, char* smem_) {
  XcdBarrier b; b.bar = (unsigned*)(ws_ + OFF_XBAR); b.x = xb_xcc_id(); b.st = (volatile LAS unsigned*)(smem_ + 159760);
  asm volatile("s_waitcnt vmcnt(0)" ::: "memory");
  __syncthreads();
  if (threadIdx.x == 0) {
    unsigned* bar = b.bar;
    __builtin_amdgcn_s_waitcnt(0);
    unsigned nloc = b.st[0], nx = b.st[1];
    if (nloc == 0u) { xcd_barrier_complete(bar, b.x, nloc, nx); b.st[0] = nloc; b.st[1] = nx; }
    const unsigned old = xb_add(&bar[XB_XSUB(b.x)], 1u);
    const unsigned gen = old / nloc;
    if (old + 1u == (gen + 1u) * nloc) {
      __builtin_amdgcn_fence(__ATOMIC_RELEASE, "agent");
      asm volatile("s_waitcnt vmcnt(0)" ::: "memory");
      const unsigned og = xb_add(&bar[XB_TOP], 1u);
      const unsigned tg = og / nx;
      if (og + 1u == (tg + 1u) * nx) xb_add(&bar[XB_TOPGEN], 1u);
      else XB_SPIN(xb_ld(&bar[XB_TOPGEN]) == tg, bar);
      __builtin_amdgcn_fence(__ATOMIC_ACQUIRE, "agent");
      xb_add(&bar[XB_XGEN(b.x)], 1u);
      asm volatile("s_waitcnt vmcnt(0)" ::: "memory");
    } else {
      XB_SPIN(xb_ld(&bar[XB_XGEN(b.x)]) == gen, bar);
      __builtin_amdgcn_fence(__ATOMIC_ACQUIRE, "agent");
      asm volatile("s_waitcnt vmcnt(0)" ::: "memory");
    }
  }
  __syncthreads();
}

__global__ void __launch_bounds__(NT) fwd_megakernel(Params P0) {
  cg::grid_group grid = cg::this_grid();
  __shared__ __attribute__((aligned(16))) char smem[160512];
  const int tid = threadIdx.x;
  char* ws = P0.ws;
  int* ctrl = (int*)(ws + OFF_CTRL);
  if (blockIdx.x == 0 && tid < 64) ctrl[tid] = 0;
  if (blockIdx.x == 0) for (int i = tid; i < XCD_BAR_WORDS; i += NT) ((unsigned*)(ws + OFF_XBAR))[i] = 0u;
  if (tid < 4) ((unsigned*)(smem + 159760))[tid] = 0u;
  if (blockIdx.x == 0 && tid == 0) *(Params*)(ws + OFF_CTRL + 1024) = P0;
  bf16_t* Hb = (bf16_t*)(ws + OFF_H);
  for (int it = blockIdx.x; it < 192 + CV_T5; it += gridDim.x) { if (it < 192) mod_item(P0, it); else convert_item(P0, 0, it - 192, smem); }
  grid.sync();
  (void)xcd_barrier_post((unsigned*)(ws + OFF_XBAR), (volatile LAS unsigned*)(smem + 159760));
  const Params& P = *(const Params*)(ws + OFF_CTRL + 1024);
  rownorm_phase(P, P.x, nullptr, P.out, Hb, 0, 0, nullptr, 0, 1, 0, P.mix_pre, smem);
  xcd_barrier(ws, smem);
  for (int l = 0; l < 2; ++l) {
    { EpiProj epi{(bf16_t*)(ws + OFF_PROJ), (float*)(ws + OFF_AB)}; gemm_phase(Hb, 2048, (const bf16_t*)(ws + OFF_W + W_IN), 2048, 2048, 64, 22, smem, epi); }
    xcd_barrier(ws, smem);
    for (int it = blockIdx.x; it < 448; it += gridDim.x) {
      if (it < 192) mla_q_tile(P, it / 3, it % 3, smem);
      else mla_kv_tile(P, (it - 192) >> 2, (it - 192) & 3, smem);
    }
    for (int id = (blockIdx.x + 64) % gridDim.x; id < 2048; id += gridDim.x) gdn_prep_item(P, l, id >> 3, id & 7, smem);
    xcd_barrier(ws, smem);
    {
      int* sitem = (int*)(smem + 159744);
      for (;;) {
        if (tid == 0) *sitem = atomicAdd(ctrl + 16 * l, 1);
        __syncthreads(); const int item = *sitem; __syncthreads();
        if (item >= 16 + 512 + 256) break;
        if (item < 16) gdn_scan_item(P, l, item >> 1, item & 1, smem);
        else if (item < 528) { const int idx = item - 16; mla_attn_item(P, idx & 3, 127 - (idx >> 2), smem); }
        else { const int idx = item - 528; swa_item(P, l, idx >> 1, idx & 1, smem); }
      }
    }
    xcd_barrier(ws, smem);
    gdn_fix_phase(P);
    xcd_barrier(ws, smem);
    { EpiBf epi{(bf16_t*)(ws + OFF_MIXF), 2048}; gemm_phase(Hb, 2048, (const bf16_t*)(ws + OFF_W + W_OUT), 2048, 2048, 64, 8, smem, epi); }
    xcd_barrier(ws, smem);
    rownorm_phase(P, P.out, (const bf16_t*)(ws + OFF_MIXF), P.out, Hb, l, 2, P.mix_post + l * 2048, l, 4, 3, P.ffn_pre + l * 2048, smem);
    xcd_barrier(ws, smem);
    { EpiBf epi{(bf16_t*)(ws + OFF_BIG), DFF2}; gemm_phase(Hb, 2048, (const bf16_t*)(ws + OFF_W + W_UP), 2048, 2048, 64, 44, smem, epi); }
    xcd_barrier(ws, smem);
    ffn_act_phase(P, l);
    xcd_barrier(ws, smem);
    { EpiBf epi{(bf16_t*)(ws + OFF_Y), 2048}; gemm_phase((const bf16_t*)(ws + OFF_ACT), DFF, (const bf16_t*)(ws + OFF_W + W_DOWN), DFF, DFF, 64, 8, smem, epi); }
    xcd_barrier(ws, smem);
    if (l == 0) {
      for (int it = blockIdx.x; it < CV_T5; it += gridDim.x) convert_item(P, 1, it, smem);
      rownorm_phase(P, P.out, (const bf16_t*)(ws + OFF_Y), P.out, Hb, 0, 5, P.ffn_post, 1, 1, 0, P.mix_pre + 2048, smem);
      xcd_barrier(ws, smem);
    } else {
      rownorm_phase(P, P.out, (const bf16_t*)(ws + OFF_Y), P.out, nullptr, 1, 5, P.ffn_post + 2048, 1, 1, 0, nullptr, smem);
    }
  }
}

extern "C" void kernel_launch(void* const* d_in, const int* in_sizes, int n_in, void* d_out, int out_size, void* d_ws, size_t ws_size, hipStream_t stream) {
  static int grid_blocks = 0;
  if (!grid_blocks) {
    int dev = 0, cus = 0, per = 0;
    (void)hipGetDevice(&dev); (void)hipDeviceGetAttribute(&cus, hipDeviceAttributeMultiprocessorCount, dev);
    (void)hipOccupancyMaxActiveBlocksPerMultiprocessor(&per, fwd_megakernel, NT, 0);
    if (per > 1) per = 1;
    grid_blocks = cus * per; if (grid_blocks <= 0) grid_blocks = 256;
  }
  if (ws_size < OFF_END) { fprintf(stderr, "workspace too small: %zu < %zu\n", ws_size, (size_t)OFF_END); return; }
  Params p{};
  p.x = (const float*)d_in[0]; p.c = (const float*)d_in[1]; p.pos = (const int*)d_in[2];
  p.ada_w = (const float*)d_in[3]; p.ada_b = (const float*)d_in[4]; p.mix_pre = (const float*)d_in[5]; p.mix_post = (const float*)d_in[6];
  p.w_in = (const float*)d_in[7]; p.w_out = (const float*)d_in[8]; p.gdn_conv = (const float*)d_in[9]; p.gdn_a_log = (const float*)d_in[10];
  p.gdn_dt_bias = (const float*)d_in[11]; p.gdn_norm = (const float*)d_in[12]; p.mla_q_norm = (const float*)d_in[13]; p.mla_w_uq = (const float*)d_in[14];
  p.mla_kv_norm = (const float*)d_in[15]; p.mla_w_ukv = (const float*)d_in[16]; p.swa_sinks = (const float*)d_in[17]; p.ffn_pre = (const float*)d_in[18];
  p.ffn_post = (const float*)d_in[19]; p.ffn_w_up = (const float*)d_in[20]; p.ffn_conv = (const float*)d_in[21]; p.ffn_conv_b = (const float*)d_in[22];
  p.ffn_w_down = (const float*)d_in[23];
  p.out = (float*)d_out; p.ws = (char*)d_ws;
  void* args[] = {&p};
  hipError_t e = hipLaunchCooperativeKernel((void*)fwd_megakernel, dim3(grid_blocks), dim3(NT), args, 0, stream);
  if (e != hipSuccess) fprintf(stderr, "cooperative launch failed: %s (grid %d)\n", hipGetErrorString(e), grid_blocks);
}
```

```cpp
#include <hip/hip_runtime.h>
#include <hip/hip_cooperative_groups.h>
#include <cstdio>
#include <cstdint>
namespace cg = cooperative_groups;

#define DI __device__ __forceinline__
typedef unsigned short bf16_t;
typedef short bf16x8 __attribute__((ext_vector_type(8)));
typedef float f32x2 __attribute__((ext_vector_type(2)));
typedef float f32x4 __attribute__((ext_vector_type(4)));
typedef float f32x16 __attribute__((ext_vector_type(16)));
typedef unsigned u32x2 __attribute__((ext_vector_type(2)));
typedef unsigned u32x4 __attribute__((ext_vector_type(4)));
typedef __bf16 bf2_t __attribute__((ext_vector_type(2)));

constexpr int S_ = 16384, D_ = 2048, DINP = 5632, DFF = 5632, DFF2 = 11264;
constexpr int NT = 512;
constexpr float EPS = 1e-6f;
constexpr float LOG2E = 1.4426950408889634f;

constexpr size_t OFF_CTRL = 0;
constexpr size_t OFF_MODP = 4096;
constexpr size_t OFF_XBAR = OFF_MODP + (size_t)2 * 16 * 12288 * 4;
constexpr size_t OFF_W = 2097152;
static_assert(OFF_XBAR + 3456 * 4 <= OFF_W, "xbar");
constexpr size_t W_IN = 0, W_OUT = W_IN + (size_t)5632 * 2048 * 2, W_UP = W_OUT + (size_t)2048 * 2048 * 2,
                 W_DOWN = W_UP + (size_t)11264 * 2048 * 2, W_UQ = W_DOWN + (size_t)2048 * 5632 * 2,
                 W_UKV = W_UQ + (size_t)768 * 448 * 2, W_END = W_UKV + (size_t)1024 * 128 * 2;
constexpr size_t OFF_H = OFF_W + W_END;
constexpr size_t OFF_MIXF = OFF_H + (size_t)S_ * 2048 * 2;
constexpr size_t OFF_QRAW = OFF_MIXF;
constexpr size_t OFF_KMLA = OFF_QRAW + (size_t)S_ * 768 * 4;
constexpr size_t OFF_VT = OFF_KMLA + (size_t)4 * S_ * 192 * 2;
constexpr size_t OFF_BIG = OFF_MIXF + (size_t)S_ * 2048 * 4;
constexpr size_t OFF_PROJ = OFF_BIG;
constexpr size_t OFF_WP = OFF_PROJ + (size_t)S_ * DINP * 2;
constexpr size_t OFF_QD = OFF_WP + (size_t)S_ * 1024 * 2;
constexpr size_t OFF_KT = OFF_QD + (size_t)S_ * 1024 * 2;
constexpr size_t OFF_ZT = OFF_KT + (size_t)S_ * 1024 * 2;
constexpr size_t OFF_QK = OFF_ZT + (size_t)S_ * 1024 * 2;
constexpr size_t OFF_AB = OFF_QK + (size_t)S_ * 512 * 2;
constexpr size_t OFF_GTOT = OFF_AB + (size_t)S_ * 16 * 4;
constexpr size_t OFF_Y = OFF_BIG;
constexpr size_t OFF_ACT = OFF_H;
constexpr size_t OFF_UT = OFF_BIG + (size_t)S_ * DFF2 * 2;
constexpr size_t OFF_END = OFF_UT + (size_t)S_ * 1024 * 4;
static_assert(OFF_GTOT + 8192 <= OFF_UT, "overlay");
static_assert(OFF_VT + (size_t)4 * 128 * S_ * 2 <= OFF_BIG, "overlay2");

constexpr int C_AQ = 0, C_AK = 1024, C_AV = 2048, C_AZ = 3072, C_AA = 4096, C_BCQ = 4112, C_BCKV = 4560,
              C_BKR = 4688, C_CQ = 4752, C_CK = 5264, C_CV = 5392;

__constant__ double kInvFreq2Pi[32] = {
    0.15915494309189535, 0.11934937021124886, 0.08949940160889101, 0.06711508300522726, 0.050329212104487035, 0.03774158471741977,
    0.0283021958306234, 0.02122365276477766, 0.015915494309189534, 0.011934937021124886, 0.008949940160889102, 0.006711508300522725,
    0.005032921210448704, 0.003774158471741977, 0.00283021958306234, 0.0021223652764777662, 0.0015915494309189536, 0.0011934937021124885,
    0.0008949940160889102, 0.0006711508300522726, 0.0005032921210448703, 0.00037741584717419774, 0.00028302195830623395, 0.0002122365276477766,
    0.00015915494309189535, 0.00011934937021124886, 8.949940160889102e-05, 6.711508300522725e-05, 5.0329212104487035e-05, 3.774158471741978e-05,
    2.8302195830623396e-05, 2.122365276477766e-05};

struct Params {
  const float* x; const float* c; const int* pos;
  const float *ada_w, *ada_b, *mix_pre, *mix_post, *w_in, *w_out, *gdn_conv, *gdn_a_log, *gdn_dt_bias, *gdn_norm, *mla_q_norm, *mla_w_uq,
      *mla_kv_norm, *mla_w_ukv, *swa_sinks, *ffn_pre, *ffn_post, *ffn_w_up, *ffn_conv, *ffn_conv_b, *ffn_w_down;
  float* out; char* ws;
};

DI unsigned pack2(float lo, float hi) { f32x2 v = {lo, hi}; bf2_t b = __builtin_convertvector(v, bf2_t); return __builtin_bit_cast(unsigned, b); }
DI bf16_t f2bf(float x) { return (bf16_t)(pack2(x, 0.f) & 0xffffu); }
DI float bflo(unsigned u) { return __uint_as_float(u << 16); }
DI float bfhi(unsigned u) { return __uint_as_float(u & 0xffff0000u); }
DI void unpack8(const u32x4& v, float* f) { f[0] = bflo(v.x); f[1] = bfhi(v.x); f[2] = bflo(v.y); f[3] = bfhi(v.y); f[4] = bflo(v.z); f[5] = bfhi(v.z); f[6] = bflo(v.w); f[7] = bfhi(v.w); }
DI bf16x8 pack8(float a0, float a1, float a2, float a3, float a4, float a5, float a6, float a7) {
  u32x4 p = {pack2(a0, a1), pack2(a2, a3), pack2(a4, a5), pack2(a6, a7)}; return __builtin_bit_cast(bf16x8, p); }
DI float silu_f(float x) { return x * __builtin_amdgcn_rcpf(1.f + __expf(-x)); }
DI float wave_sum(float v) { v += __shfl_xor(v, 32); v += __shfl_xor(v, 16); v += __shfl_xor(v, 8); v += __shfl_xor(v, 4); v += __shfl_xor(v, 2); v += __shfl_xor(v, 1); return v; }
DI int opaque_tid() { int t = threadIdx.x; asm volatile("" : "+v"(t)); return t; }
DI float xhalf_max(float v) { const auto r = __builtin_amdgcn_permlane32_swap(__float_as_uint(v), __float_as_uint(v), false, false); return fmaxf(__uint_as_float(r[0]), __uint_as_float(r[1])); }
DI int crow(int r, int h) { return (r & 3) + 8 * (r >> 2) + 4 * h; }
DI int perm32(int k) { return 8 * ((k >> 2) & 3) + 4 * (k >> 4) + (k & 3); }
#define MFMA32(a, b, c) __builtin_amdgcn_mfma_f32_32x32x16_bf16((a), (b), (c), 0, 0, 0)
#define MFMA16(a, b, c) __builtin_amdgcn_mfma_f32_16x16x32_bf16((a), (b), (c), 0, 0, 0)

template <class Epi>
DI void gemm_tile(const bf16_t* __restrict__ A, int lda, const bf16_t* __restrict__ Bt, int ldb, int K, int m0, int n0, char* smem, const Epi& epi) {
  const int tid = opaque_tid(), lane = tid & 63, w = tid >> 6, wm = w >> 2, wn = w & 3, lq = lane & 31, h = lane >> 5;
  f32x16 acc[2][4];
#pragma unroll
  for (int i = 0; i < 2; ++i)
#pragma unroll
    for (int j = 0; j < 4; ++j)
#pragma unroll
      for (int r = 0; r < 16; ++r) acc[i][j][r] = 0.f;
  const int r0 = tid >> 3, c0 = tid & 7;
  const bf16_t* ag = A + (size_t)(m0 + r0) * lda + c0 * 8;
  const bf16_t* bg = Bt + (size_t)(n0 + r0) * ldb + c0 * 8;
  const int wofs = r0 * 128 + ((c0 ^ ((r0 >> 1) & 7)) << 4);
  char* sA = smem; char* sB = smem + 65536;
  u32x4 ra0[4], rb0[4], ra1[4], rb1[4];
  const int nk = K >> 6, swz = (lane >> 1) & 7;
  const int aoff = (64 * wn + lq) * 128, boff = (128 * wm + lq) * 128;
#define GLOAD(RA, RB, KT) { _Pragma("unroll") for (int i = 0; i < 4; ++i) { RA[i] = *(const u32x4*)(ag + (size_t)(KT) * 64 + (size_t)i * 64 * lda); RB[i] = *(const u32x4*)(bg + (size_t)(KT) * 64 + (size_t)i * 64 * ldb); } }
#define LWRITE(RA, RB, ST) { _Pragma("unroll") for (int i = 0; i < 4; ++i) { *(u32x4*)(sA + (ST) * 32768 + wofs + i * 8192) = RA[i]; *(u32x4*)(sB + (ST) * 32768 + wofs + i * 8192) = RB[i]; } }
#define KSTEP(ST, RA, RB, KN) { const char* cA = sA + (ST) * 32768; const char* cB = sB + (ST) * 32768; char* dA = sA + (1 - (ST)) * 32768; char* dB = sB + (1 - (ST)) * 32768; \
    const bf16_t* agn = ag + (size_t)(KN) * 64; const bf16_t* bgn = bg + (size_t)(KN) * 64; \
    _Pragma("unroll") for (int s = 0; s < 4; ++s) { const int co = (((2 * s + h) ^ swz) << 4); bf16x8 fa[2], fb[4]; \
      _Pragma("unroll") for (int ni = 0; ni < 2; ++ni) fa[ni] = *(const bf16x8*)(cB + aoff + ni * 4096 + co); \
      _Pragma("unroll") for (int mi = 0; mi < 4; ++mi) fb[mi] = *(const bf16x8*)(cA + boff + mi * 4096 + co); \
      *(u32x4*)(dA + wofs + s * 8192) = RA[s]; *(u32x4*)(dB + wofs + s * 8192) = RB[s]; \
      RA[s] = *(const u32x4*)(agn + (size_t)s * 64 * lda); RB[s] = *(const u32x4*)(bgn + (size_t)s * 64 * ldb); \
      _Pragma("unroll") for (int ni = 0; ni < 2; ++ni) _Pragma("unroll") for (int mi = 0; mi < 4; ++mi) acc[ni][mi] = MFMA32(fa[ni], fb[mi], acc[ni][mi]); \
      __builtin_amdgcn_sched_barrier(0); } }
  const int kl = nk - 1;
  GLOAD(ra0, rb0, 0);
  GLOAD(ra1, rb1, (1 < kl ? 1 : kl));
  LWRITE(ra0, rb0, 0);
  GLOAD(ra0, rb0, (2 < kl ? 2 : kl));
  __syncthreads();
  for (int kt = 0; kt < nk; kt += 2) {
    KSTEP(0, ra1, rb1, (kt + 3 < kl ? kt + 3 : kl));
    __syncthreads();
    if (kt + 1 < nk) {
      KSTEP(1, ra0, rb0, (kt + 4 < kl ? kt + 4 : kl));
      __syncthreads();
    }
  }
#undef GLOAD
#undef LWRITE
#undef KSTEP
#pragma unroll
  for (int ni = 0; ni < 2; ++ni)
#pragma unroll
    for (int mi = 0; mi < 4; ++mi)
#pragma unroll
      for (int rg = 0; rg < 4; ++rg) {
        const int m = m0 + 128 * wm + 32 * mi + lq, n = n0 + 64 * wn + 32 * ni + 8 * rg + 4 * h;
        epi(m, n, acc[ni][mi][4 * rg], acc[ni][mi][4 * rg + 1], acc[ni][mi][4 * rg + 2], acc[ni][mi][4 * rg + 3]);
      }
}

template <class Epi>
DI void gemm_tile_s(const bf16_t* __restrict__ A, int lda, const bf16_t* __restrict__ Bt, int ldb, int K, int m0, int n0, char* smem, const Epi& epi) {
  const int tid = opaque_tid(), lane = tid & 63, w = tid >> 6, wm = w >> 2, wn = w & 3, lq = lane & 31, h = lane >> 5;
  f32x16 acc[2][4];
#pragma unroll
  for (int i = 0; i < 2; ++i)
#pragma unroll
    for (int j = 0; j < 4; ++j)
#pragma unroll
      for (int r = 0; r < 16; ++r) acc[i][j][r] = 0.f;
  const int r0 = tid >> 3, c0 = tid & 7;
  const bf16_t* ag = A + (size_t)(m0 + r0) * lda + c0 * 8;
  const bf16_t* bg = Bt + (size_t)(n0 + r0) * ldb + c0 * 8;
  const int wofs = r0 * 128 + ((c0 ^ ((r0 >> 1) & 7)) << 4);
  char* sA = smem; char* sB = smem + 32768;
  u32x4 ra[4], rb[4];
#pragma unroll
  for (int i = 0; i < 4; ++i) { ra[i] = *(const u32x4*)(ag + (size_t)i * 64 * lda); rb[i] = *(const u32x4*)(bg + (size_t)i * 64 * ldb); }
#pragma unroll
  for (int i = 0; i < 4; ++i) { *(u32x4*)(sA + wofs + i * 8192) = ra[i]; *(u32x4*)(sB + wofs + i * 8192) = rb[i]; }
  __syncthreads();
  const int nk = K >> 6, swz = (lane >> 1) & 7;
  const int aoff = (64 * wn + lq) * 128, boff = (128 * wm + lq) * 128;
  for (int kt = 0; kt < nk; ++kt) {
    const char* cA = sA + (kt & 1) * 65536; const char* cB = sB + (kt & 1) * 65536;
    const bool more = (kt + 1 < nk);
    if (more) { ag += 64; bg += 64;
#pragma unroll
      for (int i = 0; i < 4; ++i) { ra[i] = *(const u32x4*)(ag + (size_t)i * 64 * lda); rb[i] = *(const u32x4*)(bg + (size_t)i * 64 * ldb); } }
#pragma unroll
    for (int s = 0; s < 4; ++s) {
      const int co = (((2 * s + h) ^ swz) << 4);
      bf16x8 fa[2], fb[4];
#pragma unroll
      for (int ni = 0; ni < 2; ++ni) fa[ni] = *(const bf16x8*)(cB + aoff + ni * 4096 + co);
#pragma unroll
      for (int mi = 0; mi < 4; ++mi) fb[mi] = *(const bf16x8*)(cA + boff + mi * 4096 + co);
#pragma unroll
      for (int ni = 0; ni < 2; ++ni)
#pragma unroll
        for (int mi = 0; mi < 4; ++mi) acc[ni][mi] = MFMA32(fa[ni], fb[mi], acc[ni][mi]);
    }
    if (more) { char* dA = sA + ((kt + 1) & 1) * 65536; char* dB = sB + ((kt + 1) & 1) * 65536;
#pragma unroll
      for (int i = 0; i < 4; ++i) { *(u32x4*)(dA + wofs + i * 8192) = ra[i]; *(u32x4*)(dB + wofs + i * 8192) = rb[i]; } }
    __syncthreads();
  }
#pragma unroll
  for (int ni = 0; ni < 2; ++ni)
#pragma unroll
    for (int mi = 0; mi < 4; ++mi)
#pragma unroll
      for (int rg = 0; rg < 4; ++rg) {
        const int m = m0 + 128 * wm + 32 * mi + lq, n = n0 + 64 * wn + 32 * ni + 8 * rg + 4 * h;
        epi(m, n, acc[ni][mi][4 * rg], acc[ni][mi][4 * rg + 1], acc[ni][mi][4 * rg + 2], acc[ni][mi][4 * rg + 3]);
      }
}

DI void tile_coord(int t, int npn, int& pm, int& pn) { const int g = t / (16 * npn), r = t % (16 * npn); pn = r >> 4; pm = g * 16 + (r & 15); }

struct EpiProj { bf16_t* proj; float* ab;
  DI void operator()(int m, int n, float v0, float v1, float v2, float v3) const {
    u32x2 pk = {pack2(v0, v1), pack2(v2, v3)}; *(u32x2*)(proj + (size_t)m * DINP + n) = pk;
    if (n >= C_AA && n < C_AA + 16) { int mm = m; asm volatile("" : "+v"(mm));
      f32x4 v = {v0, v1, v2, v3}; *(f32x4*)(ab + (size_t)mm * 16 + (n - C_AA)) = v; } }
  DI void store8(int m, int n, const f32x4& a, const f32x4& b) const {
    u32x4 pk = {pack2(a.x, a.y), pack2(a.z, a.w), pack2(b.x, b.y), pack2(b.z, b.w)}; *(u32x4*)(proj + (size_t)m * DINP + n) = pk;
    if (n >= C_AA && n < C_AA + 16) { int mm = m; asm volatile("" : "+v"(mm)); float* p = ab + (size_t)mm * 16 + (n - C_AA); *(f32x4*)p = a; *(f32x4*)(p + 4) = b; } } };
struct EpiF32 { float* out; int ldc;
  DI void operator()(int m, int n, float v0, float v1, float v2, float v3) const { f32x4 v = {v0, v1, v2, v3}; *(f32x4*)(out + (size_t)m * ldc + n) = v; } };
struct EpiBf { bf16_t* out; int ldc;
  DI void operator()(int m, int n, float v0, float v1, float v2, float v3) const { u32x2 pk = {pack2(v0, v1), pack2(v2, v3)}; *(u32x2*)(out + (size_t)m * ldc + n) = pk; }
  DI void store8(int m, int n, const f32x4& a, const f32x4& b) const { u32x4 pk = {pack2(a.x, a.y), pack2(a.z, a.w), pack2(b.x, b.y), pack2(b.z, b.w)}; *(u32x4*)(out + (size_t)m * ldc + n) = pk; } };
struct EpiMlaQ { float* qraw; const float* rs; int m0;
  DI void operator()(int m, int n, float v0, float v1, float v2, float v3) const { const float r = rs[m - m0]; f32x4 v = {v0 * r, v1 * r, v2 * r, v3 * r}; *(f32x4*)(qraw + (size_t)m * 768 + n) = v; } };
struct EpiMlaKV { bf16_t* kmla; bf16_t* vt; const float* rs; int m0;
  DI void operator()(int m, int n, float v0, float v1, float v2, float v3) const {
    const float r = rs[m - m0]; const int hd = n >> 8, wi = n & 255;
    if (wi < 128) { u32x2 pk = {pack2(v0 * r, v1 * r), pack2(v2 * r, v3 * r)}; *(u32x2*)(kmla + ((size_t)hd * S_ + m) * 192 + wi) = pk; }
    else { bf16_t* p = vt + ((size_t)hd * 128 + (wi - 128)) * S_ + m; p[0] = f2bf(v0 * r); p[S_] = f2bf(v1 * r); p[2 * (size_t)S_] = f2bf(v2 * r); p[3 * (size_t)S_] = f2bf(v3 * r); } } };


namespace pg8 {
#define PG8_LAS __attribute__((address_space(3)))
constexpr int BM = 256, BK = 64, HALF = 128, HTB = HALF * BK * 2  , STAGE_BYTES = 8 * HTB;
DI int lds_byte(int r, int c) { const int st = (r >> 4) * 2 + (c >> 5), rr = r & 15, cc = c & 31, ob = rr * 64 + cc * 2; return st * 1024 + (ob ^ (((ob >> 9) & 1) << 5)); }
DI void stage_rc(int b, int& R, int& C) { const int st = b / 1024, sb = b % 1024, swz = sb ^ (((sb >> 9) & 1) << 5); R = (st >> 1) * 16 + swz / 64; C = (st & 1) * 32 + (swz % 64) / 2; }
DI int perm32(int rho) { const int n = rho >> 4, i = rho & 15; return 8 * (i >> 2) + 4 * n + (i & 3); }
struct Unit { int pm, pn; };
struct Gemm { const bf16_t* A; const bf16_t* Bt; int M, N, K; };
struct XcdOrder { int pm, pj, npn;
  DI bool next(int i, Unit& u) const { const int pn = pj + 4 * i; if (pn >= npn) return false; u.pm = pm; u.pn = pn; return true; }
  DI void a_ready(const Unit&) const {}
  DI void done(const Unit&) const {} };
template <class E> struct EpiAdapt8 { static constexpr bool PERM = true, AFTER_DRAIN = false; const E& e;
  DI void operator()(const f32x4 (&acc)[2][2][4][2], const Unit& u, int wr, int wc, int fr, int fq) const {
#pragma unroll
    for (int ai = 0; ai < 2; ++ai)
#pragma unroll
      for (int m = 0; m < 4; ++m)
#pragma unroll
        for (int bj = 0; bj < 2; ++bj)
          e.store8(u.pm * BM + ai * HALF + wr * 64 + m * 16 + fr, u.pn * BM + bj * HALF + wc * 32 + 8 * fq, acc[ai][bj][m][0], acc[ai][bj][m][1]); } };
template <class E> struct EpiAdapt { static constexpr bool PERM = false, AFTER_DRAIN = false; const E& e;
  DI void operator()(const f32x4 (&acc)[2][2][4][2], const Unit& u, int wr, int wc, int fr, int fq) const {
#pragma unroll
    for (int ai = 0; ai < 2; ++ai)
#pragma unroll
      for (int m = 0; m < 4; ++m)
#pragma unroll
        for (int bj = 0; bj < 2; ++bj)
#pragma unroll
          for (int n = 0; n < 2; ++n) { const f32x4 v = acc[ai][bj][m][n];
            e(u.pm * BM + ai * HALF + wr * 64 + m * 16 + fr, u.pn * BM + bj * HALF + wc * 32 + n * 16 + 4 * fq, v.x, v.y, v.z, v.w); } } };
template <class Epi, class Sched, bool ALIGN_EPI = false, bool SP2 = false>
__device__ __forceinline__ void gemm_phase(PG8_LAS unsigned char* lds, const Gemm g, const Sched& S, const Epi& E) {
    const int tid = opaque_tid(), wid = __builtin_amdgcn_readfirstlane(tid >> 6), lane = tid & 63, wr = wid >> 2, wc = wid & 3, fr = lane & 15, fq = lane >> 4;
    const int K = g.K, nt = K / BK;
    unsigned voffA[2], voffB[2];
#pragma unroll
    for (int i = 0; i < 2; ++i) { int R, C; stage_rc(tid * 16 + i * 8192, R, C); const int Rb = Epi::PERM ? ((R & ~31) + perm32(R & 31)) : R;
        voffA[i] = (unsigned)(R * K + C) * 2u; voffB[i] = (unsigned)(Rb * K + C) * 2u; }
    const size_t kstep = (size_t)(BK * 2);
    const size_t hstep = (size_t)HALF * K * 2;
    const size_t tstep = 2 * hstep;
    const unsigned ldsw = (unsigned)wid * 1024u;
    const int aoff = lds_byte(wr * 64 + fr, fq * 8), boff = lds_byte(wc * 32 + fr, fq * 8);
#define PG8_SA(b, h) (((b) * 2 + (h)) * HTB)
#define PG8_SB(b, h) ((4 + (b) * 2 + (h)) * HTB)
#define PG8_STAGE(bufoff, gbase, voff) do { _Pragma("unroll") for (int _i = 0; _i < 2; ++_i) \
        __builtin_amdgcn_global_load_lds((const unsigned*)((const char*)(gbase) + (voff)[_i]), (PG8_LAS unsigned*)(lds + (bufoff) + ldsw + _i * 8192), 16, 0, 0); } while (0)
#define PG8_LDA(dst, b, h) do { _Pragma("unroll") for (int m = 0; m < 4; ++m) _Pragma("unroll") for (int k = 0; k < 2; ++k) dst[m][k] = *(const PG8_LAS bf16x8*)(lds + PG8_SA(b, h) + aoff + m * 2048 + k * 1024); } while (0)
#define PG8_LDB(dst, b, h) do { _Pragma("unroll") for (int n = 0; n < 2; ++n) _Pragma("unroll") for (int k = 0; k < 2; ++k) dst[n][k] = *(const PG8_LAS bf16x8*)(lds + PG8_SB(b, h) + boff + n * 2048 + k * 1024); } while (0)
#define PG8_MMA(ai, bj, At, Bt) do { __builtin_amdgcn_s_setprio(1); _Pragma("unroll") for (int m = 0; m < 4; ++m) _Pragma("unroll") for (int n = 0; n < 2; ++n) _Pragma("unroll") for (int k = 0; k < 2; ++k) \
        acc[ai][bj][m][n] = __builtin_amdgcn_mfma_f32_16x16x32_bf16(Bt[n][k], At[m][k], acc[ai][bj][m][n], 0, 0, 0); __builtin_amdgcn_s_setprio(0); } while (0)
#define PG8_WAIT_V(n) asm volatile("s_waitcnt vmcnt(" #n ")" ::: "memory")
#define PG8_WAIT_L(n) asm volatile("s_waitcnt lgkmcnt(" #n ")" ::: "memory")
#define PG8_BAR __builtin_amdgcn_s_barrier()
#define PG8_SCHED __builtin_amdgcn_sched_barrier(0)
    Unit cur, nxt; int ui = 0;
    if (!S.next(0, cur)) return;
    f32x4 acc[2][2][4][2];
#pragma unroll
    for (int a = 0; a < 2; ++a)
#pragma unroll
        for (int b = 0; b < 2; ++b)
#pragma unroll
            for (int m = 0; m < 4; ++m)
#pragma unroll
                for (int n = 0; n < 2; ++n) acc[a][b][m][n] = (f32x4){0.f, 0.f, 0.f, 0.f};
    bf16x8 At[4][2], B0[2][2], B1[2][2];
    const char* cA = (const char*)g.A + (size_t)cur.pm * tstep; const char* cB = (const char*)g.Bt + (size_t)cur.pn * tstep;
    S.a_ready(cur);
    if constexpr (SP2) {
        PG8_STAGE(PG8_SB(0, 0), cB, voffB); PG8_STAGE(PG8_SB(0, 1), cB + hstep, voffB); PG8_STAGE(PG8_SA(0, 0), cA, voffA); PG8_STAGE(PG8_SA(0, 1), cA + hstep, voffA);
        if (wr == 1) PG8_BAR;
        PG8_WAIT_V(2); PG8_BAR;
        PG8_STAGE(PG8_SB(1, 0), cB + kstep, voffB); PG8_STAGE(PG8_SA(1, 0), cA + kstep, voffA); PG8_STAGE(PG8_SB(1, 1), cB + hstep + kstep, voffB);
        PG8_WAIT_V(6); PG8_BAR;
    } else {
        PG8_STAGE(PG8_SB(0, 0), cB, voffB); PG8_STAGE(PG8_SA(0, 0), cA, voffA); PG8_STAGE(PG8_SB(0, 1), cB + hstep, voffB); PG8_STAGE(PG8_SA(0, 1), cA + hstep, voffA);
        if (wr == 1) PG8_BAR;
        PG8_WAIT_V(4); PG8_BAR;
        PG8_STAGE(PG8_SB(1, 0), cB + kstep, voffB); PG8_STAGE(PG8_SA(1, 0), cA + kstep, voffA); PG8_STAGE(PG8_SB(1, 1), cB + hstep + kstep, voffB);
        PG8_WAIT_V(6); PG8_BAR;
    }
    for (;;) {
        const bool has_next = S.next(ui + 1, nxt);
        const char* nA = has_next ? (const char*)g.A + (size_t)nxt.pm * tstep : cA; const char* nB = has_next ? (const char*)g.Bt + (size_t)nxt.pn * tstep : cB;
        for (int t = 0; t < nt; t += 2) {
            const bool last = (t == nt - 2);
            const char* a1 = cA + (size_t)(t + 1) * kstep;
            const char* a2 = last ? nA : cA + (size_t)(t + 2) * kstep; const char* b2 = last ? nB : cB + (size_t)(t + 2) * kstep;
            const char* a3 = a2 + kstep; const char* b3 = b2 + kstep;
            if (last && has_next) S.a_ready(nxt);
            if constexpr (SP2) {
            PG8_LDB(B0, 0, 0); PG8_LDB(B1, 0, 1); PG8_SCHED; PG8_LDA(At, 0, 0); PG8_STAGE(PG8_SA(1, 1), a1 + hstep, voffA);
            PG8_WAIT_V(8); PG8_WAIT_L(0); PG8_BAR; PG8_MMA(0, 0, At, B0); PG8_MMA(0, 1, At, B1); PG8_BAR; PG8_SCHED;
            PG8_LDA(At, 0, 1); PG8_STAGE(PG8_SB(0, 0), b2, voffB); PG8_STAGE(PG8_SB(0, 1), b2 + hstep, voffB); PG8_STAGE(PG8_SA(0, 0), a2, voffA);
            PG8_WAIT_V(8); PG8_WAIT_L(0); PG8_BAR; PG8_MMA(1, 0, At, B0); PG8_MMA(1, 1, At, B1); PG8_BAR; PG8_SCHED;
            PG8_LDB(B0, 1, 0); PG8_LDB(B1, 1, 1); PG8_SCHED; PG8_LDA(At, 1, 0); PG8_STAGE(PG8_SA(0, 1), a2 + hstep, voffA);
            PG8_WAIT_V(8); PG8_WAIT_L(0); PG8_BAR; PG8_MMA(0, 0, At, B0); PG8_MMA(0, 1, At, B1); PG8_BAR; PG8_SCHED;
            PG8_LDA(At, 1, 1); PG8_STAGE(PG8_SB(1, 0), b3, voffB); PG8_STAGE(PG8_SB(1, 1), b3 + hstep, voffB); PG8_STAGE(PG8_SA(1, 0), a3, voffA);
            PG8_WAIT_V(8); PG8_WAIT_L(0); PG8_BAR; PG8_MMA(1, 0, At, B0); PG8_MMA(1, 1, At, B1); PG8_BAR; PG8_SCHED;
            } else {
            PG8_LDB(B0, 0, 0); PG8_SCHED; PG8_LDA(At, 0, 0); PG8_STAGE(PG8_SA(1, 1), a1 + hstep, voffA);
            PG8_WAIT_L(8); PG8_BAR; PG8_WAIT_L(0); PG8_MMA(0, 0, At, B0); PG8_BAR; PG8_SCHED;
            PG8_LDB(B1, 0, 1); PG8_STAGE(PG8_SB(0, 0), b2, voffB);
            PG8_BAR; PG8_WAIT_L(0); PG8_MMA(0, 1, At, B1); PG8_BAR;
            PG8_LDA(At, 0, 1); PG8_STAGE(PG8_SA(0, 0), a2, voffA);
            PG8_BAR; PG8_WAIT_L(0); PG8_MMA(1, 0, At, B0); PG8_BAR; PG8_SCHED;
            PG8_STAGE(PG8_SB(0, 1), b2 + hstep, voffB);
            PG8_WAIT_V(6); PG8_BAR; PG8_MMA(1, 1, At, B1); PG8_BAR;
            PG8_LDB(B0, 1, 0); PG8_SCHED; PG8_LDA(At, 1, 0); PG8_STAGE(PG8_SA(0, 1), a2 + hstep, voffA);
            PG8_WAIT_L(8); PG8_BAR; PG8_WAIT_L(0); PG8_MMA(0, 0, At, B0); PG8_BAR; PG8_SCHED;
            PG8_LDB(B1, 1, 1); PG8_STAGE(PG8_SB(1, 0), b3, voffB);
            PG8_BAR; PG8_WAIT_L(0); PG8_MMA(0, 1, At, B1); PG8_BAR;
            PG8_LDA(At, 1, 1); PG8_STAGE(PG8_SA(1, 0), a3, voffA);
            PG8_BAR; PG8_WAIT_L(0); PG8_MMA(1, 0, At, B0); PG8_BAR; PG8_SCHED;
            PG8_STAGE(PG8_SB(1, 1), b3 + hstep, voffB);
            PG8_WAIT_V(6); PG8_BAR; PG8_MMA(1, 1, At, B1); PG8_BAR;
            }
        }
        if constexpr (ALIGN_EPI) { if (wr == 0) PG8_BAR; }
        if constexpr (!Epi::AFTER_DRAIN) { E(acc, cur, wr, wc, fr, fq); S.done(cur); }
        if (!has_next) break;
#pragma unroll
        for (int a = 0; a < 2; ++a)
#pragma unroll
            for (int b = 0; b < 2; ++b)
#pragma unroll
                for (int m = 0; m < 4; ++m)
#pragma unroll
                    for (int n = 0; n < 2; ++n) acc[a][b][m][n] = (f32x4){0.f, 0.f, 0.f, 0.f};
        cur = nxt; cA = nA; cB = nB; ++ui;
        if constexpr (ALIGN_EPI) { if (wr == 1) PG8_BAR; }
    }
    PG8_WAIT_V(0);
    if constexpr (!ALIGN_EPI) { if (wr == 0) PG8_BAR; }
    PG8_BAR;
    if constexpr (Epi::AFTER_DRAIN) { E.fused(acc, cur, wr, wc, fr, fq, lds, wid, lane); S.done(cur); }
#undef PG8_SA
#undef PG8_SB
#undef PG8_STAGE
#undef PG8_LDA
#undef PG8_LDB
#undef PG8_MMA
#undef PG8_WAIT_V
#undef PG8_WAIT_L
#undef PG8_BAR
#undef PG8_SCHED
}
}

template <class Epi>
DI void gemm_phase(const bf16_t* A, int lda, const bf16_t* Bt, int ldb, int K, int npm, int npn, char* smem, const Epi& epi) {
  if (gridDim.x == 256 && npm == 64) {
    const int b = blockIdx.x, pm = 8 * (b & 7) + ((b >> 3) & 7), pj = b >> 6;
    if (lda == K && ldb == K && (K & 127) == 0) {
      const pg8::Gemm g{A, Bt, npm * 256, npn * 256, K}; const pg8::XcdOrder ord{pm, pj, npn}; const pg8::EpiAdapt8<Epi> ea{epi};
      pg8::gemm_phase<pg8::EpiAdapt8<Epi>, pg8::XcdOrder, true, true>(( __attribute__((address_space(3))) unsigned char*)smem, g, ord, ea);
    } else
    for (int pn = pj; pn < npn; pn += 4) gemm_tile(A, lda, Bt, ldb, K, pm * 256, pn * 256, smem, epi);
  } else {
    for (int t = blockIdx.x; t < npm * npn; t += gridDim.x) { int pm, pn; tile_coord(t, npn, pm, pn); gemm_tile(A, lda, Bt, ldb, K, pm * 256, pn * 256, smem, epi); }
  }
}

DI void mod_item(const Params& P, int item) {
  const int tid = opaque_tid(); const int l = item / 96, r = item % 96, ks = r / 6, nc = r % 6;
  const int n = nc * 2048 + tid * 4;
  const float* wp = P.ada_w + ((size_t)l * 2048 + ks * 128) * 12288 + n;
  f32x4 acc = {0.f, 0.f, 0.f, 0.f};
#pragma unroll 8
  for (int k = 0; k < 128; ++k) { const float cv = P.c[ks * 128 + k]; const float ca = silu_f(cv); const f32x4 wv = *(const f32x4*)(wp + (size_t)k * 12288); acc += wv * ca; }
  float* modp = (float*)(P.ws + OFF_MODP);
  *(f32x4*)(modp + ((size_t)l * 16 + ks) * 12288 + n) = acc;
}
DI void convert_tile(const float* __restrict__ src, int K, int N, bf16_t* __restrict__ dst, int tk, int tn, const float* rowscale, char* smem) {
  float* sm = (float*)smem; const int tid = opaque_tid(); const int k0 = tk * 64, n0 = tn * 256;
  { const int r = tid >> 6, c4 = tid & 63; const int n = n0 + 4 * c4;
    f32x4 v[8];
#pragma unroll
    for (int i = 0; i < 8; ++i) { v[i] = (f32x4){0.f, 0.f, 0.f, 0.f}; if (n < N) v[i] = *(const f32x4*)(src + (size_t)(k0 + r + 8 * i) * N + n); }
#pragma unroll
    for (int i = 0; i < 8; ++i) { const int kk = r + 8 * i; if (rowscale) v[i] *= rowscale[k0 + kk];
      sm[kk * 257 + 4 * c4 + 0] = v[i].x; sm[kk * 257 + 4 * c4 + 1] = v[i].y; sm[kk * 257 + 4 * c4 + 2] = v[i].z; sm[kk * 257 + 4 * c4 + 3] = v[i].w; } }
  __syncthreads();
  { const int n = tid >> 1, kh = tid & 1;
#pragma unroll
    for (int j = 0; j < 4; ++j) { float f[8];
#pragma unroll
      for (int i = 0; i < 8; ++i) f[i] = sm[(32 * kh + 8 * j + i) * 257 + n];
      u32x4 pk = {pack2(f[0], f[1]), pack2(f[2], f[3]), pack2(f[4], f[5]), pack2(f[6], f[7])};
      *(u32x4*)(dst + (size_t)(n0 + n) * K + k0 + 32 * kh + 8 * j) = pk; } }
  __syncthreads();
}
constexpr int CV_T0 = 32 * 22, CV_T1 = CV_T0 + 32 * 8, CV_T2 = CV_T1 + 32 * 44, CV_T3 = CV_T2 + 88 * 8, CV_T4 = CV_T3 + 7 * 3, CV_T5 = CV_T4 + 2 * 4;
DI void convert_item(const Params& P, int l, int it, char* smem) {
  char* wb = P.ws + OFF_W;
  if (it < CV_T0) convert_tile(P.w_in + (size_t)l * 2048 * 5520, 2048, 5520, (bf16_t*)(wb + W_IN), it / 22, it % 22, nullptr, smem);
  else if (it < CV_T1) { it -= CV_T0; convert_tile(P.w_out + (size_t)l * 2048 * 2048, 2048, 2048, (bf16_t*)(wb + W_OUT), it / 8, it % 8, nullptr, smem); }
  else if (it < CV_T2) { it -= CV_T1; convert_tile(P.ffn_w_up + (size_t)l * 2048 * 11264, 2048, 11264, (bf16_t*)(wb + W_UP), it / 44, it % 44, nullptr, smem); }
  else if (it < CV_T3) { it -= CV_T2; convert_tile(P.ffn_w_down + (size_t)l * 5632 * 2048, 5632, 2048, (bf16_t*)(wb + W_DOWN), it / 8, it % 8, nullptr, smem); }
  else if (it < CV_T4) { it -= CV_T3; convert_tile(P.mla_w_uq + (size_t)l * 448 * 768, 448, 768, (bf16_t*)(wb + W_UQ), it / 3, it % 3, P.mla_q_norm + l * 448, smem); }
  else { it -= CV_T4; convert_tile(P.mla_w_ukv + (size_t)l * 128 * 1024, 128, 1024, (bf16_t*)(wb + W_UKV), it / 4, it % 4, P.mla_kv_norm + l * 128, smem); }
}

DI float mod_val(const float* modp_l, const float* ada_b_l, int idx) { float s = ada_b_l[idx];
#pragma unroll
  for (int k = 0; k < 16; ++k) s += modp_l[(size_t)k * 12288 + idx]; return s; }
DI void rownorm_phase(const Params& P, const float* xin, const bf16_t* yin, float* xout, bf16_t* hout, int lg, int gate_idx, const float* w_post,
                      int lh, int scale_idx, int shift_idx, const float* w_pre, char* smem) {
  float* A1 = (float*)smem; float* A2 = A1 + 2048; float* B2 = A2 + 2048;
  const int tid = opaque_tid(), lane = tid & 63, w = tid >> 6;
  const float* modp = (const float*)(P.ws + OFF_MODP);
  for (int cidx = tid; cidx < 2048; cidx += NT) {
    if (yin) A1[cidx] = mod_val(modp + (size_t)lg * 16 * 12288, P.ada_b + (size_t)lg * 12288, gate_idx * 2048 + cidx) * w_post[cidx];
    if (hout) { A2[cidx] = w_pre[cidx] * (1.f + mod_val(modp + (size_t)lh * 16 * 12288, P.ada_b + (size_t)lh * 12288, scale_idx * 2048 + cidx));
      B2[cidx] = mod_val(modp + (size_t)lh * 16 * 12288, P.ada_b + (size_t)lh * 12288, shift_idx * 2048 + cidx); }
  }
  __syncthreads();
  for (int row = blockIdx.x * 8 + w; row < S_; row += gridDim.x * 8) {
    f32x4 xv[8];
#pragma unroll
    for (int j = 0; j < 8; ++j) xv[j] = *(const f32x4*)(xin + (size_t)row * 2048 + (j * 64 + lane) * 4);
    if (yin) {
      f32x4 yv[8]; float ss = 0.f;
#pragma unroll
      for (int j = 0; j < 8; ++j) { const u32x2 yb = *(const u32x2*)(yin + (size_t)row * 2048 + (j * 64 + lane) * 4); yv[j] = (f32x4){bflo(yb.x), bfhi(yb.x), bflo(yb.y), bfhi(yb.y)};
        ss += yv[j].x * yv[j].x + yv[j].y * yv[j].y + yv[j].z * yv[j].z + yv[j].w * yv[j].w; }
      ss = wave_sum(ss); const float r = rsqrtf(ss * (1.f / 2048.f) + EPS);
#pragma unroll
      for (int j = 0; j < 8; ++j) { const f32x4 a = *(const f32x4*)(A1 + (j * 64 + lane) * 4); xv[j] += a * (yv[j] * r); }
    }
    if (yin || xout != xin) {
#pragma unroll
      for (int j = 0; j < 8; ++j) *(f32x4*)(xout + (size_t)row * 2048 + (j * 64 + lane) * 4) = xv[j];
    }
    if (hout) {
      float ss = 0.f;
#pragma unroll
      for (int j = 0; j < 8; ++j) ss += xv[j].x * xv[j].x + xv[j].y * xv[j].y + xv[j].z * xv[j].z + xv[j].w * xv[j].w;
      ss = wave_sum(ss); const float r = rsqrtf(ss * (1.f / 2048.f) + EPS);
#pragma unroll
      for (int j = 0; j < 8; ++j) { const f32x4 a = *(const f32x4*)(A2 + (j * 64 + lane) * 4), b = *(const f32x4*)(B2 + (j * 64 + lane) * 4);
        const f32x4 hv = xv[j] * r * a + b; u32x2 pk = {pack2(hv.x, hv.y), pack2(hv.z, hv.w)};
        *(u32x2*)(hout + (size_t)row * 2048 + (j * 64 + lane) * 4) = pk; }
    }
  }
  __syncthreads();
}

DI void mla_q_tile(const Params& P, int pm, int pn, char* smem) {
  const bf16_t* proj = (const bf16_t*)(P.ws + OFF_PROJ); const int tid = opaque_tid(), m0 = pm * 256; float* rs = (float*)(smem + 131072);
  { const int row = tid >> 1, half = tid & 1; const bf16_t* p = proj + (size_t)(m0 + row) * DINP + C_BCQ + half * 224; float ss = 0.f;
    for (int i = 0; i < 28; ++i) { const u32x4 v = *(const u32x4*)(p + i * 8); float f[8]; unpack8(v, f);
#pragma unroll
      for (int e = 0; e < 8; ++e) ss += f[e] * f[e]; }
    ss += __shfl_xor(ss, 1); if (half == 0) rs[row] = rsqrtf(ss * (1.f / 448.f) + EPS); }
  EpiMlaQ epi{(float*)(P.ws + OFF_QRAW), rs, m0};
  gemm_tile_s(proj + C_BCQ, DINP, (const bf16_t*)(P.ws + OFF_W + W_UQ), 448, 448, m0, pn * 256, smem, epi);
  __syncthreads();
}
DI void mla_kv_tile(const Params& P, int pm, int pn, char* smem) {
  const bf16_t* proj = (const bf16_t*)(P.ws + OFF_PROJ); const int tid = opaque_tid(), m0 = pm * 256; float* rs = (float*)(smem + 131072);
  { const int row = tid >> 1, half = tid & 1; const bf16_t* p = proj + (size_t)(m0 + row) * DINP + C_BCKV + half * 64; float ss = 0.f;
#pragma unroll
    for (int i = 0; i < 8; ++i) { const u32x4 v = *(const u32x4*)(p + i * 8); float f[8]; unpack8(v, f);
#pragma unroll
      for (int e = 0; e < 8; ++e) ss += f[e] * f[e]; }
    ss += __shfl_xor(ss, 1); if (half == 0) rs[row] = rsqrtf(ss * (1.f / 128.f) + EPS); }
  bf16_t* kmla = (bf16_t*)(P.ws + OFF_KMLA);
  EpiMlaKV epi{kmla, (bf16_t*)(P.ws + OFF_VT), rs, m0};
  gemm_tile_s(proj + C_BCKV, DINP, (const bf16_t*)(P.ws + OFF_W + W_UKV), 128, 128, m0, pn * 256, smem, epi);
  if (pn == 0) {
    for (int i = 0; i < 16; ++i) { const int idx = tid + NT * i, row = idx >> 5, pi = idx & 31, m = m0 + row;
      const float x1 = bflo((unsigned)proj[(size_t)m * DINP + C_BKR + pi]), x2 = bflo((unsigned)proj[(size_t)m * DINP + C_BKR + 32 + pi]);
      double fr = (double)P.pos[m] * kInvFreq2Pi[pi]; fr -= floor(fr); const float ff = (float)fr;
      const float sn = __builtin_amdgcn_sinf(ff), cs = __builtin_amdgcn_cosf(ff);
      const bf16_t o1 = f2bf(x1 * cs - x2 * sn), o2 = f2bf(x2 * cs + x1 * sn);
#pragma unroll
      for (int hd = 0; hd < 4; ++hd) { bf16_t* kp = kmla + ((size_t)hd * S_ + m) * 192 + 128; kp[pi] = o1; kp[32 + pi] = o2; } }
  }
  __syncthreads();
}

DI void gdn_prep_item(const Params& P, int l, int n, int hh, char* smem) {
  const int tid = opaque_tid(), lane = tid & 63, w = tid >> 6, lq = lane & 31, h = lane >> 5;
  const bf16_t* proj = (const bf16_t*)(P.ws + OFF_PROJ); const float* ab = (const float*)(P.ws + OFF_AB);
  char* kb16 = smem; char* qb16 = smem + 17408;
  float* kf = (float*)(smem + 34816); float* vf = kf + 8192; float* Lm = vf + 8192; float* gcs = Lm + 4096;
  const size_t tile = (size_t)hh * 256 + n; const int t0 = n * 64;
  bf16_t* Wp = (bf16_t*)(P.ws + OFF_WP) + tile * 8192; bf16_t* Qd = (bf16_t*)(P.ws + OFF_QD) + tile * 8192;
  bf16_t* Kt = (bf16_t*)(P.ws + OFF_KT) + tile * 8192; bf16_t* Zt = (bf16_t*)(P.ws + OFF_ZT) + tile * 8192;
  bf16_t* QK = (bf16_t*)(P.ws + OFF_QK) + tile * 4096; bf16_t* Ut = (bf16_t*)(P.ws + OFF_UT) + tile * 8192;
  if (w == 0) {
    const int t = lane; const float a_raw = ab[(size_t)(t0 + t) * 16 + hh], b_raw = ab[(size_t)(t0 + t) * 16 + 8 + hh];
    const float Aa = __expf(P.gdn_a_log[l * 8 + hh]); const float xb = a_raw + P.gdn_dt_bias[l * 8 + hh];
    const float ex = __expf(fminf(xb, 20.f));
    const float sp = xb > 20.f ? xb : (ex < 0.01f ? ex * (1.f - ex * (0.5f - ex * (1.f / 3.f))) : __logf(1.f + ex));
    float g = -Aa * sp;
#pragma unroll
    for (int d = 1; d < 64; d <<= 1) { const float v = __shfl_up(g, d); if (lane >= d) g += v; }
    const float bt = __builtin_amdgcn_rcpf(1.f + __expf(-b_raw)), eg = __expf(g); gcs[t] = g; gcs[64 + t] = bt; gcs[128 + t] = eg; gcs[192 + t] = bt * eg;
    if (t == 63) ((float*)(P.ws + OFF_GTOT))[tile] = eg;
  }
  __syncthreads();
  {
    const int t = tid >> 3, part = tid & 7, tabs = t0 + t;
    const float gct = gcs[t], egct = gcs[128 + t], ktl = __expf(gcs[63] - gct);
    const int pjt = 32 * (t >> 5) + perm32(t & 31);
#pragma unroll
    for (int X = 0; X < 3; ++X) {
      const int cb = X * 1024 + hh * 128 + part * 16;
      float y[16];
#pragma unroll
      for (int e = 0; e < 16; ++e) y[e] = 0.f;
      u32x4 pv[4][2]; f32x4 wv[4][4];
#pragma unroll
      for (int j = 0; j < 4; ++j) { const int row = tabs - 3 + j, rr = row < 0 ? 0 : row;
        pv[j][0] = *(const u32x4*)(proj + (size_t)rr * DINP + cb); pv[j][1] = *(const u32x4*)(proj + (size_t)rr * DINP + cb + 8);
        const float* cw = P.gdn_conv + ((size_t)l * 4 + j) * 3072 + cb;
#pragma unroll
        for (int e4 = 0; e4 < 4; ++e4) wv[j][e4] = *(const f32x4*)(cw + 4 * e4); }
      __builtin_amdgcn_sched_barrier(0);
#pragma unroll
      for (int j = 0; j < 4; ++j) { const float msk = (tabs - 3 + j) >= 0 ? 1.f : 0.f;
        float xv[16]; unpack8(pv[j][0], xv); unpack8(pv[j][1], xv + 8);
#pragma unroll
        for (int e4 = 0; e4 < 4; ++e4) { const f32x4 wm = wv[j][e4] * msk; y[4 * e4] += wm.x * xv[4 * e4]; y[4 * e4 + 1] += wm.y * xv[4 * e4 + 1]; y[4 * e4 + 2] += wm.z * xv[4 * e4 + 2]; y[4 * e4 + 3] += wm.w * xv[4 * e4 + 3]; } }
#pragma unroll
      for (int e = 0; e < 16; ++e) y[e] = silu_f(y[e]);
      if (X < 2) { float ss = 0.f;
#pragma unroll
        for (int e = 0; e < 16; ++e) ss += y[e] * y[e];
        ss += __shfl_xor(ss, 1); ss += __shfl_xor(ss, 2); ss += __shfl_xor(ss, 4);
        const float rn = rsqrtf(ss + EPS) * (X == 0 ? 0.08838834764831845f : 1.f);
#pragma unroll
        for (int e = 0; e < 16; ++e) y[e] *= rn; }
      if (X == 0) {
        u32x4 p0 = {pack2(y[0], y[1]), pack2(y[2], y[3]), pack2(y[4], y[5]), pack2(y[6], y[7])}, p1 = {pack2(y[8], y[9]), pack2(y[10], y[11]), pack2(y[12], y[13]), pack2(y[14], y[15])};
        *(u32x4*)(qb16 + t * 272 + part * 32) = p0; *(u32x4*)(qb16 + t * 272 + part * 32 + 16) = p1;
#pragma unroll
        for (int b = 0; b < 4; ++b) { u32x2 pk = {pack2(y[4 * b] * egct, y[4 * b + 1] * egct), pack2(y[4 * b + 2] * egct, y[4 * b + 3] * egct)};
          *(u32x2*)(Qd + t * 128 + 32 * (part >> 1) + 8 * b + 4 * (part & 1)) = pk; }
      } else if (X == 1) {
        u32x4 p0 = {pack2(y[0], y[1]), pack2(y[2], y[3]), pack2(y[4], y[5]), pack2(y[6], y[7])}, p1 = {pack2(y[8], y[9]), pack2(y[10], y[11]), pack2(y[12], y[13]), pack2(y[14], y[15])};
        *(u32x4*)(kb16 + t * 272 + part * 32) = p0; *(u32x4*)(kb16 + t * 272 + part * 32 + 16) = p1;
#pragma unroll
        for (int e4 = 0; e4 < 4; ++e4) { f32x4 v = {y[4 * e4], y[4 * e4 + 1], y[4 * e4 + 2], y[4 * e4 + 3]}; *(f32x4*)(kf + t * 128 + part * 16 + 4 * e4) = v; }
#pragma unroll
        for (int e = 0; e < 16; ++e) Kt[(part * 16 + e) * 64 + pjt] = f2bf(y[e] * ktl);
      } else {
#pragma unroll
        for (int e4 = 0; e4 < 4; ++e4) { f32x4 v = {y[4 * e4], y[4 * e4 + 1], y[4 * e4 + 2], y[4 * e4 + 3]}; *(f32x4*)(vf + t * 128 + part * 16 + 4 * e4) = v; }
      }
    }
    { const int cb = C_AZ + hh * 128 + part * 16; const u32x4 v0 = *(const u32x4*)(proj + (size_t)tabs * DINP + cb), v1 = *(const u32x4*)(proj + (size_t)tabs * DINP + cb + 8);
      float zv[16]; unpack8(v0, zv); unpack8(v1, zv + 8);
#pragma unroll
      for (int e = 0; e < 16; ++e) Zt[(part * 16 + e) * 64 + t] = f2bf(silu_f(zv[e])); }
  }
  __syncthreads();
  {
    const int which = w >> 2, ti = (w >> 1) & 1, tj = w & 1; const char* Ab = which ? qb16 : kb16;
    f32x16 acc;
#pragma unroll
    for (int r = 0; r < 16; ++r) acc[r] = 0.f;
#pragma unroll
    for (int s = 0; s < 8; ++s) { const bf16x8 a = *(const bf16x8*)(Ab + (32 * ti + lq) * 272 + (16 * s + 8 * h) * 2), b = *(const bf16x8*)(kb16 + (32 * tj + lq) * 272 + (16 * s + 8 * h) * 2);
      acc = MFMA32(a, b, acc); }
    const int j = 32 * tj + lq; const float gj = gcs[j]; const int pj = 32 * (j >> 5) + perm32(j & 31);
#pragma unroll
    for (int r = 0; r < 16; ++r) { const int i = 32 * ti + crow(r, h); const float dec = __expf(fminf(gcs[i] - gj, 0.f));
      if (which == 0) Lm[i * 64 + j] = (j < i) ? gcs[64 + i] * acc[r] * dec : 0.f;
      else QK[i * 64 + pj] = f2bf((j <= i) ? acc[r] * dec : 0.f); }
  }
  __syncthreads();
  if (tid < 256) {
    const int c = tid; const bool isu = c < 128; const int cc = c & 127;
    const float* rp = (isu ? vf : kf) + cc; const float* sp = gcs + (isu ? 64 : 192);
    f32x2 xx[32];
    f32x4 LA[16], LB[16]; float rh[2];
    xx[0].x = sp[0] * rp[0];
    LA[0] = *(const f32x4*)(Lm + 64); rh[1] = sp[1] * rp[128];
#pragma unroll
    for (int i = 1; i < 64; ++i) {
      f32x4 (&CUR)[16] = (i & 1) ? LA : LB; f32x4 (&NXT)[16] = (i & 1) ? LB : LA;
      if (i + 1 < 64) {
#pragma unroll
        for (int c = 0; c < (i + 4) / 4; ++c) NXT[c] = *(const f32x4*)(Lm + (i + 1) * 64 + 4 * c);
        rh[(i + 1) & 1] = sp[i + 1] * rp[(i + 1) * 128];
      }
      __builtin_amdgcn_sched_barrier(0);
      f32x2 acc = {rh[i & 1], 0.f};
#pragma unroll
      for (int p = 0; p < i / 2; ++p) { const f32x2 lp = (p & 1) ? (f32x2){CUR[p >> 1].z, CUR[p >> 1].w} : (f32x2){CUR[p >> 1].x, CUR[p >> 1].y}; acc = acc - lp * xx[p]; }
      if (i & 1) { const int j = i - 1; const float lj = ((j & 3) == 0) ? CUR[j >> 2].x : CUR[j >> 2].z; acc.x = fmaf(-lj, xx[j >> 1].x, acc.x); }
      const float xi = acc.x + acc.y;
      if (i & 1) xx[i >> 1].y = xi; else xx[i >> 1].x = xi;
      __builtin_amdgcn_sched_barrier(0);
    }
    float x[64];
#pragma unroll
    for (int p = 0; p < 32; ++p) { x[2 * p] = xx[p].x; x[2 * p + 1] = xx[p].y; }
    if (isu) {
#pragma unroll
      for (int i8 = 0; i8 < 8; ++i8) { u32x4 v = {pack2(x[8 * i8], x[8 * i8 + 1]), pack2(x[8 * i8 + 2], x[8 * i8 + 3]), pack2(x[8 * i8 + 4], x[8 * i8 + 5]), pack2(x[8 * i8 + 6], x[8 * i8 + 7])}; *(u32x4*)(Ut + cc * 64 + 8 * i8) = v; }
    } else {
      const int pp = 32 * (cc >> 5) + perm32(cc & 31);
#pragma unroll
      for (int i = 0; i < 64; ++i) Wp[i * 128 + pp] = f2bf(x[i]);
    }
  }
  __syncthreads();
}

DI bf16x8 pack_tiles(const f32x4& a, const f32x4& b) { return pack8(a.x, a.y, a.z, a.w, b.x, b.y, b.z, b.w); }
template <int CTRL> DI float dppf(float v) { return __int_as_float(__builtin_amdgcn_update_dpp(0, __float_as_int(v), CTRL, 0xf, 0xf, true)); }
DI float row16_sum(float v) { v += dppf<0xB1>(v); v += dppf<0x4E>(v); v += dppf<0x141>(v); v += dppf<0x140>(v); return v; }
constexpr size_t OFF_SSQP = OFF_GTOT + 8192;
static_assert(OFF_SSQP + (size_t)8 * S_ * 8 * 4 <= OFF_UT, "overlay3");
constexpr int SCAN_OPB = 62464;
constexpr int SCAN_SO = 2 * SCAN_OPB;
constexpr int SCAN_OT = SCAN_SO + 16384;
DI void gdn_scan_item(const Params& P, int l, int hh, int half, char* smem) {
  const int tid = opaque_tid(), lane = tid & 63, w = tid >> 6, l15 = lane & 15, q4 = lane >> 4;
  const size_t hb = (size_t)hh * 256;
  const bf16_t* Wp = (const bf16_t*)(P.ws + OFF_WP) + hb * 8192; const bf16_t* Qd = (const bf16_t*)(P.ws + OFF_QD) + hb * 8192;
  const bf16_t* Kt = (const bf16_t*)(P.ws + OFF_KT) + hb * 8192; const bf16_t* Zt = (const bf16_t*)(P.ws + OFF_ZT) + hb * 8192;
  const bf16_t* QK = (const bf16_t*)(P.ws + OFF_QK) + hb * 4096; const bf16_t* Ut = (const bf16_t*)(P.ws + OFF_UT) + hb * 8192;
  const float* gt = (const float*)(P.ws + OFF_GTOT) + hb;
  bf16_t* mixin = (bf16_t*)(P.ws + OFF_H);
  float* sSS = (float*)(smem + SCAN_OT + 16384);
  if (w >= 4) {
    const int lt = tid - 256, wl = w - 4;
    const int dvc = 64 * half + 16 * wl + l15; const float nw = P.gdn_norm[l * 128 + dvc];
    const int uoff = dvc * 64 + 4 * q4;
    const int g256 = (lt >> 4) * 128 + (lt & 15) * 8, l256 = (lt >> 4) * 272 + (lt & 15) * 16;
    const int g128 = (lt >> 3) * 64 + (lt & 7) * 8, l128 = (lt >> 3) * 144 + (lt & 7) * 16;
    u32x4 pwA[4], pqA[4], pkA[4], pqkA[2], pwB[4], pqB[4], pkB[4], pqkB[2]; u32x2 zA[4], zB[4];
#define LD_LOAD(PW, PQ, PK, PQK, N) { const int n__ = (N) < 255 ? (N) : 255; const size_t o8 = (size_t)n__ * 8192, o4 = (size_t)n__ * 4096; \
    _Pragma("unroll") for (int i = 0; i < 4; ++i) { PW[i] = *(const u32x4*)(Wp + o8 + g256 + i * 2048); PQ[i] = *(const u32x4*)(Qd + o8 + g256 + i * 2048); PK[i] = *(const u32x4*)(Kt + o8 + g128 + i * 2048); } \
    _Pragma("unroll") for (int i = 0; i < 2; ++i) PQK[i] = *(const u32x4*)(QK + o4 + g128 + i * 2048); }
#define LZ_LOAD(Z, N) { const int n__ = (N) < 255 ? (N) : 255; _Pragma("unroll") for (int it = 0; it < 4; ++it) Z[it] = *(const u32x2*)(Zt + (size_t)n__ * 8192 + uoff + 16 * it); }
#define LD_STAGE(PW, PQ, PK, PQK, NB) { char* nb_ = (NB); \
    _Pragma("unroll") for (int i = 0; i < 4; ++i) { *(u32x4*)(nb_ + l256 + i * 4352) = PW[i]; *(u32x4*)(nb_ + 17408 + l256 + i * 4352) = PQ[i]; *(u32x4*)(nb_ + 34816 + l128 + i * 4608) = PK[i]; } \
    _Pragma("unroll") for (int i = 0; i < 2; ++i) *(u32x4*)(nb_ + 53248 + l128 + i * 4608) = PQK[i]; }
#define LD_FINISH(M, Z) { const int m = (M); const char* so = smem + SCAN_SO + (m & 1) * 8192 + (wl * 4) * 512 + lane * 8; \
    bf16_t* ot = (bf16_t*)(smem + SCAN_OT + (m & 1) * 8192); float* sq = sSS + (m & 1) * 256 + wl * 64; \
    _Pragma("unroll") for (int it = 0; it < 4; ++it) { \
      const u32x2 ob = *(const u32x2*)(so + it * 512); const f32x4 o = {bflo(ob.x), bfhi(ob.x), bflo(ob.y), bfhi(ob.y)}; \
      f32x4 ss = o * o; ss.x = row16_sum(ss.x); ss.y = row16_sum(ss.y); ss.z = row16_sum(ss.z); ss.w = row16_sum(ss.w); \
      const int rl = 16 * it + 4 * q4; \
      if (l15 == 0) *(f32x4*)(sq + rl) = ss; \
      bf16_t* op = ot + rl * 64 + 16 * wl + l15; \
      op[0] = f2bf(o.x * nw * bflo(Z[it].x)); op[64] = f2bf(o.y * nw * bfhi(Z[it].x)); op[128] = f2bf(o.z * nw * bflo(Z[it].y)); op[192] = f2bf(o.w * nw * bfhi(Z[it].y)); } }
#define LD_STEP(PW, PQ, PK, PQK, ZU, N) { const int n_ = (N); \
    LD_STAGE(PW, PQ, PK, PQK, smem + ((n_ + 1) & 1) * SCAN_OPB); \
    LD_LOAD(PW, PQ, PK, PQK, n_ + 3); \
    if (n_ >= 1) LD_FINISH(n_ - 1, ZU); \
    LZ_LOAD(ZU, n_ + 1); \
    __syncthreads(); }
    LD_LOAD(pwA, pqA, pkA, pqkA, 0);
    LD_STAGE(pwA, pqA, pkA, pqkA, smem);
    LD_LOAD(pwA, pqA, pkA, pqkA, 1);
    LD_LOAD(pwB, pqB, pkB, pqkB, 2);
    LZ_LOAD(zB, 0);
    LZ_LOAD(zA, 0);
    __syncthreads();
#pragma unroll 1
    for (int n = 0; n < 256; n += 2) {
      LD_STEP(pwA, pqA, pkA, pqkA, zA, n);
      LD_STEP(pwB, pqB, pkB, pqkB, zB, n + 1);
    }
    LD_FINISH(255, zA);
    __syncthreads();
#undef LD_LOAD
#undef LZ_LOAD
#undef LD_STAGE
#undef LD_FINISH
#undef LD_STEP
  } else {
    const int dvc = 64 * half + 16 * w + l15;
    const int uoff = dvc * 64 + 4 * q4;
    float* ssqp = (float*)(P.ws + OFF_SSQP) + (size_t)(half * 4 + w) * S_ * 8;
    f32x4 St[8];
#pragma unroll
    for (int t = 0; t < 8; ++t) St[t] = (f32x4){0.f, 0.f, 0.f, 0.f};
    u32x2 uc[4], un[4]; float gcur, gn = 0.f;
#pragma unroll
    for (int it = 0; it < 4; ++it) { uc[it] = *(const u32x2*)(Ut + uoff + 16 * it); un[it] = uc[it]; }
    gcur = gt[0];
#define CP_OUT(M) { const int m2 = (M); const char* ot = smem + SCAN_OT + (m2 & 1) * 8192; \
      _Pragma("unroll") for (int i = 0; i < 2; ++i) { const int c = tid + 256 * i, row = c >> 3, cc = c & 7; \
        *(u32x4*)(mixin + (size_t)(64 * m2 + row) * 2048 + hh * 128 + 64 * half + cc * 8) = *(const u32x4*)(ot + row * 128 + cc * 16); } \
      ssqp[(size_t)(64 * m2 + lane) * 8 + hh] = sSS[(m2 & 1) * 256 + w * 64 + lane]; }
    __syncthreads();
#pragma unroll 2
    for (int n = 0; n < 256; ++n) {
      const char* cb = smem + (n & 1) * SCAN_OPB;
      const char* sWp = cb; const char* sQd = cb + 17408; const char* sKt = cb + 34816; const char* sQK = cb + 53248;
      if (n + 1 < 256) { const size_t o8 = (size_t)(n + 1) * 8192;
#pragma unroll
        for (int it = 0; it < 4; ++it) un[it] = *(const u32x2*)(Ut + o8 + uoff + 16 * it);
        gn = gt[n + 1]; }
      bf16x8 sb[4];
#pragma unroll
      for (int ks = 0; ks < 4; ++ks) sb[ks] = pack_tiles(St[2 * ks], St[2 * ks + 1]);
      f32x4 wsv[4], qs[4];
#pragma unroll
      for (int it = 0; it < 4; ++it) { wsv[it] = (f32x4){0.f, 0.f, 0.f, 0.f}; qs[it] = (f32x4){0.f, 0.f, 0.f, 0.f}; }
#pragma unroll
      for (int it = 0; it < 4; ++it)
#pragma unroll
        for (int ks = 0; ks < 4; ++ks) { const int o = (16 * it + l15) * 272 + 64 * ks + 16 * q4;
          const bf16x8 a = *(const bf16x8*)(sWp + o), a2 = *(const bf16x8*)(sQd + o);
          wsv[it] = MFMA16(a, sb[ks], wsv[it]); qs[it] = MFMA16(a2, sb[ks], qs[it]); }
      f32x4 vn[4];
#pragma unroll
      for (int it = 0; it < 4; ++it) { const f32x4 uf = {bflo(uc[it].x), bfhi(uc[it].x), bflo(uc[it].y), bfhi(uc[it].y)}; vn[it] = uf - wsv[it]; }
      bf16x8 vb[2];
#pragma unroll
      for (int ks = 0; ks < 2; ++ks) vb[ks] = pack_tiles(vn[2 * ks], vn[2 * ks + 1]);
#pragma unroll
      for (int it = 0; it < 4; ++it)
#pragma unroll
        for (int ks = 0; ks < 2; ++ks) { const bf16x8 a = *(const bf16x8*)(sQK + (16 * it + l15) * 144 + 64 * ks + 16 * q4); qs[it] = MFMA16(a, vb[ks], qs[it]); }
      { char* so = smem + SCAN_SO + (n & 1) * 8192 + (w * 4) * 512 + lane * 8;
#pragma unroll
        for (int it = 0; it < 4; ++it) { u32x2 ob = {pack2(qs[it].x, qs[it].y), pack2(qs[it].z, qs[it].w)}; *(u32x2*)(so + it * 512) = ob; } }
#pragma unroll
      for (int t = 0; t < 8; ++t) { St[t] *= gcur;
#pragma unroll
        for (int ks = 0; ks < 2; ++ks) { const bf16x8 a = *(const bf16x8*)(sKt + (16 * t + l15) * 144 + 64 * ks + 16 * q4); St[t] = MFMA16(a, vb[ks], St[t]); } }
#pragma unroll
      for (int it = 0; it < 4; ++it) uc[it] = un[it];
      gcur = gn;
      if (n >= 2) CP_OUT(n - 2);
      __syncthreads();
    }
    CP_OUT(254);
    __syncthreads();
    CP_OUT(255);
#undef CP_OUT
  }
  __syncthreads();
}
DI void gdn_fix_phase(const Params& P) {
  const int tid = opaque_tid();
  bf16_t* mixin = (bf16_t*)(P.ws + OFF_H); const float* ssqp = (const float*)(P.ws + OFF_SSQP);
  for (int idx = blockIdx.x * NT + tid; idx < S_ * 128; idx += gridDim.x * NT) {
    const int t = idx >> 7, ck = idx & 127, h = ck >> 4;
    float sq = 0.f;
#pragma unroll
    for (int p = 0; p < 8; ++p) sq += ssqp[((size_t)p * S_ + t) * 8 + h];
    const float r = rsqrtf(sq * (1.f / 128.f) + EPS);
    u32x4* pp = (u32x4*)(mixin + (size_t)t * 2048 + ck * 8); const u32x4 v = *pp; float f[8]; unpack8(v, f);
    u32x4 o = {pack2(f[0] * r, f[1] * r), pack2(f[2] * r, f[3] * r), pack2(f[4] * r, f[5] * r), pack2(f[6] * r, f[7] * r)}; *pp = o;
  }
}

DI void mla_attn_item(const Params& P, int hd, int b, char* smem) {
  const int tid = opaque_tid(), lane = tid & 63, w = tid >> 6, wq = w & 3, hk = w >> 2, lq = lane & 31, h = lane >> 5;
  const float* qraw = (const float*)(P.ws + OFF_QRAW);
  const bf16_t* Kg = (const bf16_t*)(P.ws + OFF_KMLA) + (size_t)hd * S_ * 192;
  const bf16_t* Vg = (const bf16_t*)(P.ws + OFF_VT) + (size_t)hd * 128 * S_;
  bf16_t* mixin = (bf16_t*)(P.ws + OFF_H);
  const int q = 128 * b + 32 * wq + lq;
  bf16x8 qf[12];
  {
    const float* qp = qraw + (size_t)q * 768 + hd * 192 + 8 * h;
    const float sc = 0.07216878364870322f * LOG2E;
#pragma unroll
    for (int s = 0; s < 8; ++s) { const f32x4 a = *(const f32x4*)(qp + 16 * s), c = *(const f32x4*)(qp + 16 * s + 4);
      qf[s] = pack8(a.x * sc, a.y * sc, a.z * sc, a.w * sc, c.x * sc, c.y * sc, c.z * sc, c.w * sc); }
    const double pq = (double)P.pos[q];
#pragma unroll
    for (int s2 = 0; s2 < 2; ++s2) {
      const f32x4 a0 = *(const f32x4*)(qp + 128 + 16 * s2), a1 = *(const f32x4*)(qp + 128 + 16 * s2 + 4);
      const f32x4 b0 = *(const f32x4*)(qp + 160 + 16 * s2), b1 = *(const f32x4*)(qp + 160 + 16 * s2 + 4);
      float x1[8] = {a0.x, a0.y, a0.z, a0.w, a1.x, a1.y, a1.z, a1.w}, x2[8] = {b0.x, b0.y, b0.z, b0.w, b1.x, b1.y, b1.z, b1.w}, o1[8], o2[8];
#pragma unroll
      for (int j = 0; j < 8; ++j) { double fr = pq * kInvFreq2Pi[16 * s2 + 8 * h + j]; fr -= floor(fr); const float ff = (float)fr;
        const float sn = __builtin_amdgcn_sinf(ff), cs = __builtin_amdgcn_cosf(ff);
        o1[j] = (x1[j] * cs - x2[j] * sn) * sc; o2[j] = (x2[j] * cs + x1[j] * sn) * sc; }
      qf[8 + s2] = pack8(o1[0], o1[1], o1[2], o1[3], o1[4], o1[5], o1[6], o1[7]);
      qf[10 + s2] = pack8(o2[0], o2[1], o2[2], o2[3], o2[4], o2[5], o2[6], o2[7]);
    }
  }
  constexpr int KST = 64 * 400, VST = 128 * 144, STG = KST + VST;
  f32x16 O[4];
#pragma unroll
  for (int i = 0; i < 4; ++i)
#pragma unroll
    for (int r = 0; r < 16; ++r) O[i][r] = 0.f;
  float m_i = -1e30f, l_i = 0.f;
  const int nt = 2 * b + 2;
  u32x4 rk0[3], rv0[2], rk1[3], rv1[2];
  const int vrow = tid >> 3, vcc = tid & 7;
  const int ntl = nt - 1;
#define AT_LOAD(RK, RV, T) { const size_t ko_ = (size_t)(T) * 64 * 192; const int vo_ = (T) * 64; \
    _Pragma("unroll") for (int i = 0; i < 3; ++i) { const int id = tid + NT * i, row = id / 24, cc = id % 24; RK[i] = *(const u32x4*)(Kg + ko_ + row * 192 + cc * 8); } \
    _Pragma("unroll") for (int i = 0; i < 2; ++i) RV[i] = *(const u32x4*)(Vg + (size_t)(vrow + 64 * i) * S_ + vo_ + vcc * 8); }
#define AT_WRITE(RK, RV, ST) { char* dK = smem + (ST) * STG; \
    _Pragma("unroll") for (int i = 0; i < 3; ++i) { const int id = tid + NT * i, row = id / 24, cc = id % 24; *(u32x4*)(dK + row * 400 + cc * 16) = RK[i]; } \
    _Pragma("unroll") for (int i = 0; i < 2; ++i) *(u32x4*)(dK + KST + (vrow + 64 * i) * 144 + vcc * 16) = RV[i]; }
#define AT_COMPUTE(ST, KT) { const char* sK = smem + (ST) * STG; const char* sV = sK + KST; const int key0 = 64 * (KT) + 32 * hk; \
    if (key0 <= 128 * b + 32 * wq) { \
      f32x16 st; _Pragma("unroll") for (int r = 0; r < 16; ++r) st[r] = 0.f; \
      _Pragma("unroll") for (int s = 0; s < 12; ++s) { const bf16x8 kf = *(const bf16x8*)(sK + (32 * hk + lq) * 400 + (2 * s + h) * 16); st = MFMA32(kf, qf[s], st); } \
      if (key0 + 31 > 128 * b + 32 * wq) { int qrel = q - key0 - 4 * h; asm volatile("" : "+v"(qrel)); \
        _Pragma("unroll") for (int r = 0; r < 16; ++r) if ((r & 3) + 8 * (r >> 2) > qrel) st[r] = -1e30f; } \
      float mx = st[0]; _Pragma("unroll") for (int r = 1; r < 16; ++r) mx = fmaxf(mx, st[r]); \
      mx = xhalf_max(mx); \
      const float m_new = fmaxf(m_i, mx), alpha = __builtin_amdgcn_exp2f(m_i - m_new); float ps = 0.f; \
      _Pragma("unroll") for (int r = 0; r < 16; ++r) { st[r] = __builtin_amdgcn_exp2f(st[r] - m_new); ps += st[r]; } \
      l_i = l_i * alpha + ps; \
      if (__any(m_new != m_i)) { _Pragma("unroll") for (int i = 0; i < 4; ++i) _Pragma("unroll") for (int r = 0; r < 16; ++r) O[i][r] *= alpha; } \
      m_i = m_new; \
      bf16x8 pf[2]; \
      _Pragma("unroll") for (int s = 0; s < 2; ++s) pf[s] = pack8(st[8 * s], st[8 * s + 1], st[8 * s + 2], st[8 * s + 3], st[8 * s + 4], st[8 * s + 5], st[8 * s + 6], st[8 * s + 7]); \
      _Pragma("unroll") for (int i = 0; i < 4; ++i) _Pragma("unroll") for (int s = 0; s < 2; ++s) { const char* vp = sV + (32 * i + lq) * 144 + (32 * hk + 16 * s + 4 * h) * 2; \
          const u32x2 lo = *(const u32x2*)vp, hi = *(const u32x2*)(vp + 16); u32x4 vv = {lo.x, lo.y, hi.x, hi.y}; \
          O[i] = MFMA32(__builtin_bit_cast(bf16x8, vv), pf[s], O[i]); } } }
  AT_LOAD(rk0, rv0, 0);
  AT_LOAD(rk1, rv1, 1);
  AT_WRITE(rk0, rv0, 0);
  AT_LOAD(rk0, rv0, (2 < ntl ? 2 : ntl));
  __syncthreads();
  for (int kt = 0; kt < nt; kt += 2) {
    AT_WRITE(rk1, rv1, 1);
    AT_LOAD(rk1, rv1, (kt + 3 < ntl ? kt + 3 : ntl));
    AT_COMPUTE(0, kt);
    __syncthreads();
    AT_WRITE(rk0, rv0, 0);
    AT_LOAD(rk0, rv0, (kt + 4 < ntl ? kt + 4 : ntl));
    AT_COMPUTE(1, kt + 1);
    __syncthreads();
  }
#undef AT_LOAD
#undef AT_WRITE
#undef AT_COMPUTE
  float* cO = (float*)smem; float* cm = cO + 4 * 4096; float* cl = cm + 256;
  if (hk == 1) {
#pragma unroll
    for (int i = 0; i < 4; ++i)
#pragma unroll
      for (int r = 0; r < 16; ++r) cO[wq * 4096 + (i * 16 + r) * 64 + lane] = O[i][r];
    cm[wq * 64 + lane] = m_i; cl[wq * 64 + lane] = l_i;
  }
  __syncthreads();
  if (hk == 0) {
    const float m1 = cm[wq * 64 + lane], l1 = cl[wq * 64 + lane];
    const float m = fmaxf(m_i, m1), a0 = exp2f(m_i - m), a1 = exp2f(m1 - m);
    float lt = l_i * a0 + l1 * a1; lt += __shfl_xor(lt, 32);
    const float inv = 1.f / lt;
    bf16_t* op = mixin + (size_t)q * 2048 + 1024 + hd * 128;
#pragma unroll
    for (int i = 0; i < 4; ++i)
#pragma unroll
      for (int rg = 0; rg < 4; ++rg) { float v[4];
#pragma unroll
        for (int e = 0; e < 4; ++e) v[e] = (O[i][4 * rg + e] * a0 + cO[wq * 4096 + (i * 16 + 4 * rg + e) * 64 + lane] * a1) * inv;
        u32x2 pk = {pack2(v[0], v[1]), pack2(v[2], v[3])}; *(u32x2*)(op + 32 * i + 8 * rg + 4 * h) = pk; }
  }
  __syncthreads();
}

DI void swa_item(const Params& P, int l, int n, int hk2, char* smem) {
  const int tid = opaque_tid(), lane = tid & 63, w = tid >> 6, lq = lane & 31, h = lane >> 5;
  const bf16_t* proj = (const bf16_t*)(P.ws + OFF_PROJ); bf16_t* mixin = (bf16_t*)(P.ws + OFF_H);
  bf16_t* sVt = (bf16_t*)smem;
#pragma unroll
  for (int i = 0; i < 4; ++i) { const int id = tid + NT * i, key = id >> 3, dc = id & 7; const int kp = 128 * (n - 1) + key;
    u32x4 v = {0u, 0u, 0u, 0u}; if (kp >= 0) v = *(const u32x4*)(proj + (size_t)kp * DINP + C_CV + hk2 * 64 + dc * 8);
    sVt[(8 * dc + 0) * 264 + key] = (bf16_t)(v.x & 0xffff); sVt[(8 * dc + 1) * 264 + key] = (bf16_t)(v.x >> 16);
    sVt[(8 * dc + 2) * 264 + key] = (bf16_t)(v.y & 0xffff); sVt[(8 * dc + 3) * 264 + key] = (bf16_t)(v.y >> 16);
    sVt[(8 * dc + 4) * 264 + key] = (bf16_t)(v.z & 0xffff); sVt[(8 * dc + 5) * 264 + key] = (bf16_t)(v.z >> 16);
    sVt[(8 * dc + 6) * 264 + key] = (bf16_t)(v.w & 0xffff); sVt[(8 * dc + 7) * 264 + key] = (bf16_t)(v.w >> 16); }
  __syncthreads();
  const int g = w >> 1, hq = hk2 * 4 + g;
  const float slope = exp2f(-(float)(hq + 1)) * LOG2E, sinkv = P.swa_sinks[l * 8 + hq] * LOG2E;
#pragma unroll 1
  for (int jj = 0; jj < 2; ++jj) {
    const int j = 2 * (w & 1) + jj; const int qrow = 128 * n + 32 * j + lq;
    bf16x8 qf[4];
#pragma unroll
    for (int s = 0; s < 4; ++s) qf[s] = *(const bf16x8*)(proj + (size_t)qrow * DINP + C_CQ + hq * 64 + 16 * s + 8 * h);
    f32x16 st[5];
    bf16x8 kf[2][4];
    { const int kp = 128 * (n - 1) + 32 * j + lq;
#pragma unroll
      for (int s = 0; s < 4; ++s) { kf[0][s] = (bf16x8){0, 0, 0, 0, 0, 0, 0, 0}; if (kp >= 0) kf[0][s] = *(const bf16x8*)(proj + (size_t)kp * DINP + C_CK + hk2 * 64 + 16 * s + 8 * h); } }
#pragma unroll
    for (int tt = 0; tt < 5; ++tt) {
      if (tt + 1 < 5) { const int kp = 128 * (n - 1) + 32 * (j + tt + 1) + lq;
#pragma unroll
        for (int s = 0; s < 4; ++s) { kf[(tt + 1) & 1][s] = (bf16x8){0, 0, 0, 0, 0, 0, 0, 0}; if (kp >= 0) kf[(tt + 1) & 1][s] = *(const bf16x8*)(proj + (size_t)kp * DINP + C_CK + hk2 * 64 + 16 * s + 8 * h); } }
      __builtin_amdgcn_sched_barrier(0);
#pragma unroll
      for (int r = 0; r < 16; ++r) st[tt][r] = 0.f;
#pragma unroll
      for (int s = 0; s < 4; ++s) st[tt] = MFMA32(kf[tt & 1][s], qf[s], st[tt]);
      __builtin_amdgcn_sched_barrier(0);
    }
    float mx = sinkv;
    int dbase = 128 + lq - 4 * h, kbase = 128 * (n - 1) + 32 * j + 4 * h;
    asm volatile("" : "+v"(dbase), "+v"(kbase));
#pragma unroll
    for (int tt = 0; tt < 5; ++tt)
#pragma unroll
      for (int r = 0; r < 16; ++r) { const int cst = 32 * tt + (r & 3) + 8 * (r >> 2); const int dist = dbase - cst; const int kpos = kbase + cst;
        const bool valid = (dist >= 0) && (dist < 128) && (kpos >= 0);
        const float sv = valid ? st[tt][r] * (0.125f * LOG2E) - slope * (float)dist : -1e30f; st[tt][r] = sv; mx = fmaxf(mx, sv); }
    mx = fmaxf(mx, __shfl_xor(mx, 32));
    float den = 0.f;
#pragma unroll
    for (int tt = 0; tt < 5; ++tt)
#pragma unroll
      for (int r = 0; r < 16; ++r) { const float p = exp2f(st[tt][r] - mx); st[tt][r] = p; den += p; }
    den += __shfl_xor(den, 32); den += exp2f(sinkv - mx);
    f32x16 O[2];
#pragma unroll
    for (int i = 0; i < 2; ++i)
#pragma unroll
      for (int r = 0; r < 16; ++r) O[i][r] = 0.f;
#pragma unroll
    for (int tt = 0; tt < 5; ++tt)
#pragma unroll
      for (int s = 0; s < 2; ++s) { const bf16x8 pf = pack8(st[tt][8 * s], st[tt][8 * s + 1], st[tt][8 * s + 2], st[tt][8 * s + 3], st[tt][8 * s + 4], st[tt][8 * s + 5], st[tt][8 * s + 6], st[tt][8 * s + 7]);
#pragma unroll
        for (int i = 0; i < 2; ++i) { const char* vp = (const char*)sVt + (32 * i + lq) * 528 + (32 * (j + tt) + 16 * s + 4 * h) * 2;
          const u32x2 lo = *(const u32x2*)vp, hi = *(const u32x2*)(vp + 16); u32x4 vv = {lo.x, lo.y, hi.x, hi.y};
          O[i] = MFMA32(__builtin_bit_cast(bf16x8, vv), pf, O[i]); }
        __builtin_amdgcn_sched_barrier(0); }
    const float inv = 1.f / den;
    bf16_t* op = mixin + (size_t)qrow * 2048 + 1536 + hq * 64;
#pragma unroll
    for (int i = 0; i < 2; ++i)
#pragma unroll
      for (int rg = 0; rg < 4; ++rg) { u32x2 pk = {pack2(O[i][4 * rg] * inv, O[i][4 * rg + 1] * inv), pack2(O[i][4 * rg + 2] * inv, O[i][4 * rg + 3] * inv)};
        *(u32x2*)(op + 32 * i + 8 * rg + 4 * h) = pk; }
  }
  __syncthreads();
}

DI float gelu_tanh(float x) { const float y = 0.7978845608028654f * (x + 0.044715f * x * x * x); const float t = 1.f - 2.f * __builtin_amdgcn_rcpf(1.f + __expf(2.f * y)); return 0.5f * x * (1.f + t); }
DI void ffn_act_phase(const Params& P, int l) {
  const int tid = opaque_tid(), lane = tid & 63, w = tid >> 6;
  const bf16_t* u = (const bf16_t*)(P.ws + OFF_BIG); bf16_t* act = (bf16_t*)(P.ws + OFF_ACT);
  const float* cw = P.ffn_conv + (size_t)l * 3 * DFF2; const float* cb = P.ffn_conv_b + (size_t)l * DFF2;
  for (int item = blockIdx.x * 8 + w; item < 512 * 11; item += gridDim.x * 8) {
    const int cbk = item % 11, rr = item / 11; const int ch = cbk * 512 + lane * 8, r0 = rr * 32;
    float wg[3][8], wu[3][8], bg[8], bu[8];
#pragma unroll
    for (int j = 0; j < 3; ++j)
#pragma unroll
      for (int e4 = 0; e4 < 2; ++e4) { const f32x4 a = *(const f32x4*)(cw + (size_t)j * DFF2 + ch + 4 * e4), b = *(const f32x4*)(cw + (size_t)j * DFF2 + DFF + ch + 4 * e4);
        wg[j][4 * e4] = a.x; wg[j][4 * e4 + 1] = a.y; wg[j][4 * e4 + 2] = a.z; wg[j][4 * e4 + 3] = a.w; wu[j][4 * e4] = b.x; wu[j][4 * e4 + 1] = b.y; wu[j][4 * e4 + 2] = b.z; wu[j][4 * e4 + 3] = b.w; }
#pragma unroll
    for (int e4 = 0; e4 < 2; ++e4) { const f32x4 a = *(const f32x4*)(cb + ch + 4 * e4), b = *(const f32x4*)(cb + DFF + ch + 4 * e4);
      bg[4 * e4] = a.x; bg[4 * e4 + 1] = a.y; bg[4 * e4 + 2] = a.z; bg[4 * e4 + 3] = a.w; bu[4 * e4] = b.x; bu[4 * e4 + 1] = b.y; bu[4 * e4 + 2] = b.z; bu[4 * e4 + 3] = b.w; }
    float g2[8], g1[8], u2[8], u1[8];
#pragma unroll
    for (int e = 0; e < 8; ++e) { g2[e] = 0.f; g1[e] = 0.f; u2[e] = 0.f; u1[e] = 0.f; }
    if (r0 >= 2) { unpack8(*(const u32x4*)(u + (size_t)(r0 - 2) * DFF2 + ch), g2); unpack8(*(const u32x4*)(u + (size_t)(r0 - 2) * DFF2 + DFF + ch), u2);
      unpack8(*(const u32x4*)(u + (size_t)(r0 - 1) * DFF2 + ch), g1); unpack8(*(const u32x4*)(u + (size_t)(r0 - 1) * DFF2 + DFF + ch), u1); }
#pragma unroll 1
    for (int rb = 0; rb < 4; ++rb) {
      u32x4 G[8], U[8];
#pragma unroll
      for (int i = 0; i < 8; ++i) { const size_t ro = (size_t)(r0 + rb * 8 + i) * DFF2 + ch; G[i] = *(const u32x4*)(u + ro); U[i] = *(const u32x4*)(u + ro + DFF); }
#pragma unroll
      for (int i = 0; i < 8; ++i) {
        float g0[8], u0[8]; unpack8(G[i], g0); unpack8(U[i], u0);
        float o[8];
#pragma unroll
        for (int e = 0; e < 8; ++e) { const float yg = wg[0][e] * g2[e] + wg[1][e] * g1[e] + wg[2][e] * g0[e] + bg[e]; const float yu = wu[0][e] * u2[e] + wu[1][e] * u1[e] + wu[2][e] * u0[e] + bu[e];
          o[e] = gelu_tanh(yg) * yu; g2[e] = g1[e]; g1[e] = g0[e]; u2[e] = u1[e]; u1[e] = u0[e]; }
        u32x4 pk = {pack2(o[0], o[1]), pack2(o[2], o[3]), pack2(o[4], o[5]), pack2(o[6], o[7])};
        *(u32x4*)(act + (size_t)(r0 + rb * 8 + i) * DFF + ch) = pk;
      }
    }
  }
}

#define XB_TMO      128
#define XB_XCNT(j)  (256  + 64 * (j))
#define XB_XSUB(j)  (1280 + 64 * (j))
#define XB_XGEN(j)  (2304 + 64 * (j))
#define XB_TOP      3328
#define XB_TOPGEN   3392
#define XCD_BAR_WORDS 3456
#define XB_SPIN_CAP (1u << 18)
#define LAS __attribute__((address_space(3)))
DI unsigned xb_ld(unsigned* p)              { return __hip_atomic_load(p, __ATOMIC_RELAXED, __HIP_MEMORY_SCOPE_AGENT); }
DI unsigned xb_add(unsigned* p, unsigned v) { return __hip_atomic_fetch_add(p, v, __ATOMIC_RELAXED, __HIP_MEMORY_SCOPE_AGENT); }
DI unsigned xb_xcc_id() { return (unsigned)__builtin_amdgcn_s_getreg((3 << 11) | 20) & 0xFu; }
#define XB_SPIN(cond, bar) do { unsigned _sp = 0; while (cond) { __builtin_amdgcn_s_sleep(1); \
    if ((++_sp & 255u) == 0u) { if (xb_ld(&(bar)[XB_TMO])) break; if (_sp > XB_SPIN_CAP) { atomicAdd(&(bar)[XB_TMO], 1u); break; } } } } while (0)
struct XcdBarrier { unsigned* bar; unsigned x; volatile LAS unsigned* st; };
DI XcdBarrier xcd_barrier_post(unsigned* bar, volatile LAS unsigned* st) {
  XcdBarrier b; b.bar = bar; b.x = xb_xcc_id(); b.st = st;
  if (threadIdx.x == 0) (void)xb_add(&bar[XB_XCNT(b.x)], 1u);
  return b;
}
DI void xcd_barrier_complete(unsigned* bar, unsigned x, unsigned& nloc, unsigned& nx) {
  const unsigned G = gridDim.x * gridDim.y * gridDim.z;
  unsigned sum, cnt, mine, sp = 0u;
  for (;;) {
    sum = 0u; cnt = 0u; mine = 0u;
#pragma unroll
    for (unsigned j = 0; j < 16; ++j) { const unsigned c = xb_ld(&bar[XB_XCNT(j)]); sum += c; cnt += (c > 0u) ? 1u : 0u; mine = (j == x) ? c : mine; }
    if (sum == G) break;
    __builtin_amdgcn_s_sleep(1);
    if ((++sp & 255u) == 0u) { if (xb_ld(&bar[XB_TMO])) break; if (sp > XB_SPIN_CAP) { atomicAdd(&bar[XB_TMO], 1u); break; } }
  }
  nloc = mine > 0u ? mine : 1u; nx = cnt > 0u ? cnt : 1u;
}
DI void xcd_barrier(char* ws_, char* smem_) {
  XcdBarrier b; b.bar = (unsigned*)(ws_ + OFF_XBAR); b.x = xb_xcc_id(); b.st = (volatile LAS unsigned*)(smem_ + 159760);
  asm volatile("s_waitcnt vmcnt(0)" ::: "memory");
  __syncthreads();
  if (threadIdx.x == 0) {
    unsigned* bar = b.bar;
    __builtin_amdgcn_s_waitcnt(0);
    unsigned nloc = b.st[0], nx = b.st[1];
    if (nloc == 0u) { xcd_barrier_complete(bar, b.x, nloc, nx); b.st[0] = nloc; b.st[1] = nx; }
    const unsigned old = xb_add(&bar[XB_XSUB(b.x)], 1u);
    const unsigned gen = old / nloc;
    if (old + 1u == (gen + 1u) * nloc) {
      __builtin_amdgcn_fence(__ATOMIC_RELEASE, "agent");
      asm volatile("s_waitcnt vmcnt(0)" ::: "memory");
      const unsigned og = xb_add(&bar[XB_TOP], 1u);
      const unsigned tg = og / nx;
      if (og + 1u == (tg + 1u) * nx) xb_add(&bar[XB_TOPGEN], 1u);
      else XB_SPIN(xb_ld(&bar[XB_TOPGEN]) == tg, bar);
      __builtin_amdgcn_fence(__ATOMIC_ACQUIRE, "agent");
      xb_add(&bar[XB_XGEN(b.x)], 1u);
      asm volatile("s_waitcnt vmcnt(0)" ::: "memory");
    } else {
      XB_SPIN(xb_ld(&bar[XB_XGEN(b.x)]) == gen, bar);
      __builtin_amdgcn_fence(__ATOMIC_ACQUIRE, "agent");
      asm volatile("s_waitcnt vmcnt(0)" ::: "memory");
    }
  }
  __syncthreads();
}

__global__ void __launch_bounds__(NT) fwd_megakernel(Params P0) {
  cg::grid_group grid = cg::this_grid();
  __shared__ __attribute__((aligned(16))) char smem[160512];
  const int tid = threadIdx.x;
  char* ws = P0.ws;
  int* ctrl = (int*)(ws + OFF_CTRL);
  if (blockIdx.x == 0 && tid < 64) ctrl[tid] = 0;
  if (blockIdx.x == 0) for (int i = tid; i < XCD_BAR_WORDS; i += NT) ((unsigned*)(ws + OFF_XBAR))[i] = 0u;
  if (tid < 4) ((unsigned*)(smem + 159760))[tid] = 0u;
  if (blockIdx.x == 0 && tid == 0) *(Params*)(ws + OFF_CTRL + 1024) = P0;
  bf16_t* Hb = (bf16_t*)(ws + OFF_H);
  for (int it = blockIdx.x; it < 192 + CV_T5; it += gridDim.x) { if (it < 192) mod_item(P0, it); else convert_item(P0, 0, it - 192, smem); }
  grid.sync();
  (void)xcd_barrier_post((unsigned*)(ws + OFF_XBAR), (volatile LAS unsigned*)(smem + 159760));
  const Params& P = *(const Params*)(ws + OFF_CTRL + 1024);
  rownorm_phase(P, P.x, nullptr, P.out, Hb, 0, 0, nullptr, 0, 1, 0, P.mix_pre, smem);
  xcd_barrier(ws, smem);
  for (int l = 0; l < 2; ++l) {
    { EpiProj epi{(bf16_t*)(ws + OFF_PROJ), (float*)(ws + OFF_AB)}; gemm_phase(Hb, 2048, (const bf16_t*)(ws + OFF_W + W_IN), 2048, 2048, 64, 22, smem, epi); }
    xcd_barrier(ws, smem);
    for (int it = blockIdx.x; it < 448; it += gridDim.x) {
      if (it < 192) mla_q_tile(P, it / 3, it % 3, smem);
      else mla_kv_tile(P, (it - 192) >> 2, (it - 192) & 3, smem);
    }
    for (int id = (blockIdx.x + 64) % gridDim.x; id < 2048; id += gridDim.x) gdn_prep_item(P, l, id >> 3, id & 7, smem);
    xcd_barrier(ws, smem);
    {
      int* sitem = (int*)(smem + 159744);
      for (;;) {
        if (tid == 0) *sitem = atomicAdd(ctrl + 16 * l, 1);
        __syncthreads(); const int item = *sitem; __syncthreads();
        if (item >= 16 + 512 + 256) break;
        if (item < 16) gdn_scan_item(P, l, item >> 1, item & 1, smem);
        else if (item < 528) { const int idx = item - 16; mla_attn_item(P, idx & 3, 127 - (idx >> 2), smem); }
        else { const int idx = item - 528; swa_item(P, l, idx >> 1, idx & 1, smem); }
      }
    }
    xcd_barrier(ws, smem);
    gdn_fix_phase(P);
    xcd_barrier(ws, smem);
    { EpiBf epi{(bf16_t*)(ws + OFF_MIXF), 2048}; gemm_phase(Hb, 2048, (const bf16_t*)(ws + OFF_W + W_OUT), 2048, 2048, 64, 8, smem, epi); }
    xcd_barrier(ws, smem);
    rownorm_phase(P, P.out, (const bf16_t*)(ws + OFF_MIXF), P.out, Hb, l, 2, P.mix_post + l * 2048, l, 4, 3, P.ffn_pre + l * 2048, smem);
    xcd_barrier(ws, smem);
    { EpiBf epi{(bf16_t*)(ws + OFF_BIG), DFF2}; gemm_phase(Hb, 2048, (const bf16_t*)(ws + OFF_W + W_UP), 2048, 2048, 64, 44, smem, epi); }
    xcd_barrier(ws, smem);
    ffn_act_phase(P, l);
    xcd_barrier(ws, smem);
    { EpiBf epi{(bf16_t*)(ws + OFF_Y), 2048}; gemm_phase((const bf16_t*)(ws + OFF_ACT), DFF, (const bf16_t*)(ws + OFF_W + W_DOWN), DFF, DFF, 64, 8, smem, epi); }
    xcd_barrier(ws, smem);
    if (l == 0) {
      for (int it = blockIdx.x; it < CV_T5; it += gridDim.x) convert_item(P, 1, it, smem);
      rownorm_phase(P, P.out, (const bf16_t*)(ws + OFF_Y), P.out, Hb, 0, 5, P.ffn_post, 1, 1, 0, P.mix_pre + 2048, smem);
      xcd_barrier(ws, smem);
    } else {
      rownorm_phase(P, P.out, (const bf16_t*)(ws + OFF_Y), P.out, nullptr, 1, 5, P.ffn_post + 2048, 1, 1, 0, nullptr, smem);
    }
  }
}

extern "C" void kernel_launch(void* const* d_in, const int* in_sizes, int n_in, void* d_out, int out_size, void* d_ws, size_t ws_size, hipStream_t stream) {
  static int grid_blocks = 0;
  if (!grid_blocks) {
    int dev = 0, cus = 0, per = 0;
    (void)hipGetDevice(&dev); (void)hipDeviceGetAttribute(&cus, hipDeviceAttributeMultiprocessorCount, dev);
    (void)hipOccupancyMaxActiveBlocksPerMultiprocessor(&per, fwd_megakernel, NT, 0);
    if (per > 1) per = 1;
    grid_blocks = cus * per; if (grid_blocks <= 0) grid_blocks = 256;
  }
  if (ws_size < OFF_END) { fprintf(stderr, "workspace too small: %zu < %zu\n", ws_size, (size_t)OFF_END); return; }
  Params p{};
  p.x = (const float*)d_in[0]; p.c = (const float*)d_in[1]; p.pos = (const int*)d_in[2];
  p.ada_w = (const float*)d_in[3]; p.ada_b = (const float*)d_in[4]; p.mix_pre = (const float*)d_in[5]; p.mix_post = (const float*)d_in[6];
  p.w_in = (const float*)d_in[7]; p.w_out = (const float*)d_in[8]; p.gdn_conv = (const float*)d_in[9]; p.gdn_a_log = (const float*)d_in[10];
  p.gdn_dt_bias = (const float*)d_in[11]; p.gdn_norm = (const float*)d_in[12]; p.mla_q_norm = (const float*)d_in[13]; p.mla_w_uq = (const float*)d_in[14];
  p.mla_kv_norm = (const float*)d_in[15]; p.mla_w_ukv = (const float*)d_in[16]; p.swa_sinks = (const float*)d_in[17]; p.ffn_pre = (const float*)d_in[18];
  p.ffn_post = (const float*)d_in[19]; p.ffn_w_up = (const float*)d_in[20]; p.ffn_conv = (const float*)d_in[21]; p.ffn_conv_b = (const float*)d_in[22];
  p.ffn_w_down = (const float*)d_in[23];
  p.out = (float*)d_out; p.ws = (char*)d_ws;
  void* args[] = {&p};
  hipError_t e = hipLaunchCooperativeKernel((void*)fwd_megakernel, dim3(grid_blocks), dim3(NT), args, 0, stream);
  if (e != hipSuccess) fprintf(stderr, "cooperative launch failed: %s (grid %d)\n", hipGetErrorString(e), grid_blocks);
}
```

```cpp
#include <hip/hip_runtime.h>
#include <hip/hip_cooperative_groups.h>
#include <cstdio>
#include <cstdint>
namespace cg = cooperative_groups;

#define DI __device__ __forceinline__
typedef unsigned short bf16_t;
typedef short bf16x8 __attribute__((ext_vector_type(8)));
typedef float f32x2 __attribute__((ext_vector_type(2)));
typedef float f32x4 __attribute__((ext_vector_type(4)));
typedef float f32x16 __attribute__((ext_vector_type(16)));
typedef unsigned u32x2 __attribute__((ext_vector_type(2)));
typedef unsigned u32x4 __attribute__((ext_vector_type(4)));
typedef __bf16 bf2_t __attribute__((ext_vector_type(2)));

constexpr int S_ = 16384, D_ = 2048, DINP = 5632, DFF = 5632, DFF2 = 11264;
constexpr int NT = 512;
constexpr float EPS = 1e-6f;
constexpr float LOG2E = 1.4426950408889634f;

constexpr size_t OFF_CTRL = 0;
constexpr size_t OFF_MODP = 4096;
constexpr size_t OFF_XBAR = OFF_MODP + (size_t)2 * 16 * 12288 * 4;
constexpr size_t OFF_W = 2097152;
static_assert(OFF_XBAR + 3456 * 4 <= OFF_W, "xbar");
constexpr size_t W_IN = 0, W_OUT = W_IN + (size_t)5632 * 2048 * 2, W_UP = W_OUT + (size_t)2048 * 2048 * 2,
                 W_DOWN = W_UP + (size_t)11264 * 2048 * 2, W_UQ = W_DOWN + (size_t)2048 * 5632 * 2,
                 W_UKV = W_UQ + (size_t)768 * 448 * 2, W_END = W_UKV + (size_t)1024 * 128 * 2;
constexpr size_t OFF_H = OFF_W + W_END;
constexpr size_t OFF_MIXF = OFF_H + (size_t)S_ * 2048 * 2;
constexpr size_t OFF_QRAW = OFF_MIXF;
constexpr size_t OFF_KMLA = OFF_QRAW + (size_t)S_ * 768 * 4;
constexpr size_t OFF_VT = OFF_KMLA + (size_t)4 * S_ * 192 * 2;
constexpr size_t OFF_BIG = OFF_MIXF + (size_t)S_ * 2048 * 4;
constexpr size_t OFF_PROJ = OFF_BIG;
constexpr size_t OFF_WP = OFF_PROJ + (size_t)S_ * DINP * 2;
constexpr size_t OFF_QD = OFF_WP + (size_t)S_ * 1024 * 2;
constexpr size_t OFF_KT = OFF_QD + (size_t)S_ * 1024 * 2;
constexpr size_t OFF_ZT = OFF_KT + (size_t)S_ * 1024 * 2;
constexpr size_t OFF_QK = OFF_ZT + (size_t)S_ * 1024 * 2;
constexpr size_t OFF_AB = OFF_QK + (size_t)S_ * 512 * 2;
constexpr size_t OFF_GTOT = OFF_AB + (size_t)S_ * 16 * 4;
constexpr size_t OFF_Y = OFF_BIG;
constexpr size_t OFF_ACT = OFF_H;
constexpr size_t OFF_UT = OFF_BIG + (size_t)S_ * DFF2 * 2;
constexpr size_t OFF_END = OFF_UT + (size_t)S_ * 1024 * 4;
static_assert(OFF_GTOT + 8192 <= OFF_UT, "overlay");
static_assert(OFF_VT + (size_t)4 * 128 * S_ * 2 <= OFF_BIG, "overlay2");

constexpr int C_AQ = 0, C_AK = 1024, C_AV = 2048, C_AZ = 3072, C_AA = 4096, C_BCQ = 4112, C_BCKV = 4560,
              C_BKR = 4688, C_CQ = 4752, C_CK = 5264, C_CV = 5392;

__constant__ double kInvFreq2Pi[32] = {
    0.15915494309189535, 0.11934937021124886, 0.08949940160889101, 0.06711508300522726, 0.050329212104487035, 0.03774158471741977,
    0.0283021958306234, 0.02122365276477766, 0.015915494309189534, 0.011934937021124886, 0.008949940160889102, 0.006711508300522725,
    0.005032921210448704, 0.003774158471741977, 0.00283021958306234, 0.0021223652764777662, 0.0015915494309189536, 0.0011934937021124885,
    0.0008949940160889102, 0.0006711508300522726, 0.0005032921210448703, 0.00037741584717419774, 0.00028302195830623395, 0.0002122365276477766,
    0.00015915494309189535, 0.00011934937021124886, 8.949940160889102e-05, 6.711508300522725e-05, 5.0329212104487035e-05, 3.774158471741978e-05,
    2.8302195830623396e-05, 2.122365276477766e-05};

struct Params {
  const float* x; const float* c; const int* pos;
  const float *ada_w, *ada_b, *mix_pre, *mix_post, *w_in, *w_out, *gdn_conv, *gdn_a_log, *gdn_dt_bias, *gdn_norm, *mla_q_norm, *mla_w_uq,
      *mla_kv_norm, *mla_w_ukv, *swa_sinks, *ffn_pre, *ffn_post, *ffn_w_up, *ffn_conv, *ffn_conv_b, *ffn_w_down;
  float* out; char* ws;
};

DI unsigned pack2(float lo, float hi) { f32x2 v = {lo, hi}; bf2_t b = __builtin_convertvector(v, bf2_t); return __builtin_bit_cast(unsigned, b); }
DI bf16_t f2bf(float x) { return (bf16_t)(pack2(x, 0.f) & 0xffffu); }
DI float bflo(unsigned u) { return __uint_as_float(u << 16); }
DI float bfhi(unsigned u) { return __uint_as_float(u & 0xffff0000u); }
DI void unpack8(const u32x4& v, float* f) { f[0] = bflo(v.x); f[1] = bfhi(v.x); f[2] = bflo(v.y); f[3] = bfhi(v.y); f[4] = bflo(v.z); f[5] = bfhi(v.z); f[6] = bflo(v.w); f[7] = bfhi(v.w); }
DI bf16x8 pack8(float a0, float a1, float a2, float a3, float a4, float a5, float a6, float a7) {
  u32x4 p = {pack2(a0, a1), pack2(a2, a3), pack2(a4, a5), pack2(a6, a7)}; return __builtin_bit_cast(bf16x8, p); }
DI float silu_f(float x) { return x * __builtin_amdgcn_rcpf(1.f + __expf(-x)); }
DI float wave_sum(float v) { v += __shfl_xor(v, 32); v += __shfl_xor(v, 16); v += __shfl_xor(v, 8); v += __shfl_xor(v, 4); v += __shfl_xor(v, 2); v += __shfl_xor(v, 1); return v; }
DI int opaque_tid() { int t = threadIdx.x; asm volatile("" : "+v"(t)); return t; }
DI float xhalf_max(float v) { const auto r = __builtin_amdgcn_permlane32_swap(__float_as_uint(v), __float_as_uint(v), false, false); return fmaxf(__uint_as_float(r[0]), __uint_as_float(r[1])); }
DI int crow(int r, int h) { return (r & 3) + 8 * (r >> 2) + 4 * h; }
DI int perm32(int k) { return 8 * ((k >> 2) & 3) + 4 * (k >> 4) + (k & 3); }
#define MFMA32(a, b, c) __builtin_amdgcn_mfma_f32_32x32x16_bf16((a), (b), (c), 0, 0, 0)
#define MFMA16(a, b, c) __builtin_amdgcn_mfma_f32_16x16x32_bf16((a), (b), (c), 0, 0, 0)

template <class Epi>
DI void gemm_tile(const bf16_t* __restrict__ A, int lda, const bf16_t* __restrict__ Bt, int ldb, int K, int m0, int n0, char* smem, const Epi& epi) {
  const int tid = opaque_tid(), lane = tid & 63, w = tid >> 6, wm = w >> 2, wn = w & 3, lq = lane & 31, h = lane >> 5;
  f32x16 acc[2][4];
#pragma unroll
  for (int i = 0; i < 2; ++i)
#pragma unroll
    for (int j = 0; j < 4; ++j)
#pragma unroll
      for (int r = 0; r < 16; ++r) acc[i][j][r] = 0.f;
  const int r0 = tid >> 3, c0 = tid & 7;
  const bf16_t* ag = A + (size_t)(m0 + r0) * lda + c0 * 8;
  const bf16_t* bg = Bt + (size_t)(n0 + r0) * ldb + c0 * 8;
  const int wofs = r0 * 128 + ((c0 ^ ((r0 >> 1) & 7)) << 4);
  char* sA = smem; char* sB = smem + 65536;
  u32x4 ra0[4], rb0[4], ra1[4], rb1[4];
  const int nk = K >> 6, swz = (lane >> 1) & 7;
  const int aoff = (64 * wn + lq) * 128, boff = (128 * wm + lq) * 128;
#define GLOAD(RA, RB, KT) { _Pragma("unroll") for (int i = 0; i < 4; ++i) { RA[i] = *(const u32x4*)(ag + (size_t)(KT) * 64 + (size_t)i * 64 * lda); RB[i] = *(const u32x4*)(bg + (size_t)(KT) * 64 + (size_t)i * 64 * ldb); } }
#define LWRITE(RA, RB, ST) { _Pragma("unroll") for (int i = 0; i < 4; ++i) { *(u32x4*)(sA + (ST) * 32768 + wofs + i * 8192) = RA[i]; *(u32x4*)(sB + (ST) * 32768 + wofs + i * 8192) = RB[i]; } }
#define KSTEP(ST, RA, RB, KN) { const char* cA = sA + (ST) * 32768; const char* cB = sB + (ST) * 32768; char* dA = sA + (1 - (ST)) * 32768; char* dB = sB + (1 - (ST)) * 32768; \
    const bf16_t* agn = ag + (size_t)(KN) * 64; const bf16_t* bgn = bg + (size_t)(KN) * 64; \
    _Pragma("unroll") for (int s = 0; s < 4; ++s) { const int co = (((2 * s + h) ^ swz) << 4); bf16x8 fa[2], fb[4]; \
      _Pragma("unroll") for (int ni = 0; ni < 2; ++ni) fa[ni] = *(const bf16x8*)(cB + aoff + ni * 4096 + co); \
      _Pragma("unroll") for (int mi = 0; mi < 4; ++mi) fb[mi] = *(const bf16x8*)(cA + boff + mi * 4096 + co); \
      *(u32x4*)(dA + wofs + s * 8192) = RA[s]; *(u32x4*)(dB + wofs + s * 8192) = RB[s]; \
      RA[s] = *(const u32x4*)(agn + (size_t)s * 64 * lda); RB[s] = *(const u32x4*)(bgn + (size_t)s * 64 * ldb); \
      _Pragma("unroll") for (int ni = 0; ni < 2; ++ni) _Pragma("unroll") for (int mi = 0; mi < 4; ++mi) acc[ni][mi] = MFMA32(fa[ni], fb[mi], acc[ni][mi]); \
      __builtin_amdgcn_sched_barrier(0); } }
  const int kl = nk - 1;
  GLOAD(ra0, rb0, 0);
  GLOAD(ra1, rb1, (1 < kl ? 1 : kl));
  LWRITE(ra0, rb0, 0);
  GLOAD(ra0, rb0, (2 < kl ? 2 : kl));
  __syncthreads();
  for (int kt = 0; kt < nk; kt += 2) {
    KSTEP(0, ra1, rb1, (kt + 3 < kl ? kt + 3 : kl));
    __syncthreads();
    if (kt + 1 < nk) {
      KSTEP(1, ra0, rb0, (kt + 4 < kl ? kt + 4 : kl));
      __syncthreads();
    }
  }
#undef GLOAD
#undef LWRITE
#undef KSTEP
#pragma unroll
  for (int ni = 0; ni < 2; ++ni)
#pragma unroll
    for (int mi = 0; mi < 4; ++mi)
#pragma unroll
      for (int rg = 0; rg < 4; ++rg) {
        const int m = m0 + 128 * wm + 32 * mi + lq, n = n0 + 64 * wn + 32 * ni + 8 * rg + 4 * h;
        epi(m, n, acc[ni][mi][4 * rg], acc[ni][mi][4 * rg + 1], acc[ni][mi][4 * rg + 2], acc[ni][mi][4 * rg + 3]);
      }
}

template <class Epi>
DI void gemm_tile_s(const bf16_t* __restrict__ A, int lda, const bf16_t* __restrict__ Bt, int ldb, int K, int m0, int n0, char* smem, const Epi& epi) {
  const int tid = opaque_tid(), lane = tid & 63, w = tid >> 6, wm = w >> 2, wn = w & 3, lq = lane & 31, h = lane >> 5;
  f32x16 acc[2][4];
#pragma unroll
  for (int i = 0; i < 2; ++i)
#pragma unroll
    for (int j = 0; j < 4; ++j)
#pragma unroll
      for (int r = 0; r < 16; ++r) acc[i][j][r] = 0.f;
  const int r0 = tid >> 3, c0 = tid & 7;
  const bf16_t* ag = A + (size_t)(m0 + r0) * lda + c0 * 8;
  const bf16_t* bg = Bt + (size_t)(n0 + r0) * ldb + c0 * 8;
  const int wofs = r0 * 128 + ((c0 ^ ((r0 >> 1) & 7)) << 4);
  char* sA = smem; char* sB = smem + 32768;
  u32x4 ra[4], rb[4];
#pragma unroll
  for (int i = 0; i < 4; ++i) { ra[i] = *(const u32x4*)(ag + (size_t)i * 64 * lda); rb[i] = *(const u32x4*)(bg + (size_t)i * 64 * ldb); }
#pragma unroll
  for (int i = 0; i < 4; ++i) { *(u32x4*)(sA + wofs + i * 8192) = ra[i]; *(u32x4*)(sB + wofs + i * 8192) = rb[i]; }
  __syncthreads();
  const int nk = K >> 6, swz = (lane >> 1) & 7;
  const int aoff = (64 * wn + lq) * 128, boff = (128 * wm + lq) * 128;
  for (int kt = 0; kt < nk; ++kt) {
    const char* cA = sA + (kt & 1) * 65536; const char* cB = sB + (kt & 1) * 65536;
    const bool more = (kt + 1 < nk);
    if (more) { ag += 64; bg += 64;
#pragma unroll
      for (int i = 0; i < 4; ++i) { ra[i] = *(const u32x4*)(ag + (size_t)i * 64 * lda); rb[i] = *(const u32x4*)(bg + (size_t)i * 64 * ldb); } }
#pragma unroll
    for (int s = 0; s < 4; ++s) {
      const int co = (((2 * s + h) ^ swz) << 4);
      bf16x8 fa[2], fb[4];
#pragma unroll
      for (int ni = 0; ni < 2; ++ni) fa[ni] = *(const bf16x8*)(cB + aoff + ni * 4096 + co);
#pragma unroll
      for (int mi = 0; mi < 4; ++mi) fb[mi] = *(const bf16x8*)(cA + boff + mi * 4096 + co);
#pragma unroll
      for (int ni = 0; ni < 2; ++ni)
#pragma unroll
        for (int mi = 0; mi < 4; ++mi) acc[ni][mi] = MFMA32(fa[ni], fb[mi], acc[ni][mi]);
    }
    if (more) { char* dA = sA + ((kt + 1) & 1) * 65536; char* dB = sB + ((kt + 1) & 1) * 65536;
#pragma unroll
      for (int i = 0; i < 4; ++i) { *(u32x4*)(dA + wofs + i * 8192) = ra[i]; *(u32x4*)(dB + wofs + i * 8192) = rb[i]; } }
    __syncthreads();
  }
#pragma unroll
  for (int ni = 0; ni < 2; ++ni)
#pragma unroll
    for (int mi = 0; mi < 4; ++mi)
#pragma unroll
      for (int rg = 0; rg < 4; ++rg) {
        const int m = m0 + 128 * wm + 32 * mi + lq, n = n0 + 64 * wn + 32 * ni + 8 * rg + 4 * h;
        epi(m, n, acc[ni][mi][4 * rg], acc[ni][mi][4 * rg + 1], acc[ni][mi][4 * rg + 2], acc[ni][mi][4 * rg + 3]);
      }
}

DI void tile_coord(int t, int npn, int& pm, int& pn) { const int g = t / (16 * npn), r = t % (16 * npn); pn = r >> 4; pm = g * 16 + (r & 15); }

struct EpiProj { bf16_t* proj; float* ab;
  DI void operator()(int m, int n, float v0, float v1, float v2, float v3) const {
    u32x2 pk = {pack2(v0, v1), pack2(v2, v3)}; *(u32x2*)(proj + (size_t)m * DINP + n) = pk;
    if (n >= C_AA && n < C_AA + 16) { int mm = m; asm volatile("" : "+v"(mm));
      f32x4 v = {v0, v1, v2, v3}; *(f32x4*)(ab + (size_t)mm * 16 + (n - C_AA)) = v; } }
  DI void store8(int m, int n, const f32x4& a, const f32x4& b) const {
    u32x4 pk = {pack2(a.x, a.y), pack2(a.z, a.w), pack2(b.x, b.y), pack2(b.z, b.w)}; *(u32x4*)(proj + (size_t)m * DINP + n) = pk;
    if (n >= C_AA && n < C_AA + 16) { int mm = m; asm volatile("" : "+v"(mm)); float* p = ab + (size_t)mm * 16 + (n - C_AA); *(f32x4*)p = a; *(f32x4*)(p + 4) = b; } } };
struct EpiF32 { float* out; int ldc;
  DI void operator()(int m, int n, float v0, float v1, float v2, float v3) const { f32x4 v = {v0, v1, v2, v3}; *(f32x4*)(out + (size_t)m * ldc + n) = v; } };
struct EpiBf { bf16_t* out; int ldc;
  DI void operator()(int m, int n, float v0, float v1, float v2, float v3) const { u32x2 pk = {pack2(v0, v1), pack2(v2, v3)}; *(u32x2*)(out + (size_t)m * ldc + n) = pk; }
  DI void store8(int m, int n, const f32x4& a, const f32x4& b) const { u32x4 pk = {pack2(a.x, a.y), pack2(a.z, a.w), pack2(b.x, b.y), pack2(b.z, b.w)}; *(u32x4*)(out + (size_t)m * ldc + n) = pk; } };
struct EpiMlaQ { float* qraw; const float* rs; int m0;
  DI void operator()(int m, int n, float v0, float v1, float v2, float v3) const { const float r = rs[m - m0]; f32x4 v = {v0 * r, v1 * r, v2 * r, v3 * r}; *(f32x4*)(qraw + (size_t)m * 768 + n) = v; } };
struct EpiMlaKV { bf16_t* kmla; bf16_t* vt; const float* rs; int m0;
  DI void operator()(int m, int n, float v0, float v1, float v2, float v3) const {
    const float r = rs[m - m0]; const int hd = n >> 8, wi = n & 255;
    if (wi < 128) { u32x2 pk = {pack2(v0 * r, v1 * r), pack2(v2 * r, v3 * r)}; *(u32x2*)(kmla + ((size_t)hd * S_ + m) * 192 + wi) = pk; }
    else { bf16_t* p = vt + ((size_t)hd * 128 + (wi - 128)) * S_ + m; p[0] = f2bf(v0 * r); p[S_] = f2bf(v1 * r); p[2 * (size_t)S_] = f2bf(v2 * r); p[3 * (size_t)S_] = f2bf(v3 * r); } } };


namespace pg8 {
#define PG8_LAS __attribute__((address_space(3)))
constexpr int BM = 256, BK = 64, HALF = 128, HTB = HALF * BK * 2  , STAGE_BYTES = 8 * HTB;
DI int lds_byte(int r, int c) { const int st = (r >> 4) * 2 + (c >> 5), rr = r & 15, cc = c & 31, ob = rr * 64 + cc * 2; return st * 1024 + (ob ^ (((ob >> 9) & 1) << 5)); }
DI void stage_rc(int b, int& R, int& C) { const int st = b / 1024, sb = b % 1024, swz = sb ^ (((sb >> 9) & 1) << 5); R = (st >> 1) * 16 + swz / 64; C = (st & 1) * 32 + (swz % 64) / 2; }
DI int perm32(int rho) { const int n = rho >> 4, i = rho & 15; return 8 * (i >> 2) + 4 * n + (i & 3); }
struct Unit { int pm, pn; };
struct Gemm { const bf16_t* A; const bf16_t* Bt; int M, N, K; };
struct XcdOrder { int pm, pj, npn;
  DI bool next(int i, Unit& u) const { const int pn = pj + 4 * i; if (pn >= npn) return false; u.pm = pm; u.pn = pn; return true; }
  DI void a_ready(const Unit&) const {}
  DI void done(const Unit&) const {} };
template <class E> struct EpiAdapt8 { static constexpr bool PERM = true, AFTER_DRAIN = false; const E& e;
  DI void operator()(const f32x4 (&acc)[2][2][4][2], const Unit& u, int wr, int wc, int fr, int fq) const {
#pragma unroll
    for (int ai = 0; ai < 2; ++ai)
#pragma unroll
      for (int m = 0; m < 4; ++m)
#pragma unroll
        for (int bj = 0; bj < 2; ++bj)
          e.store8(u.pm * BM + ai * HALF + wr * 64 + m * 16 + fr, u.pn * BM + bj * HALF + wc * 32 + 8 * fq, acc[ai][bj][m][0], acc[ai][bj][m][1]); } };
template <class E> struct EpiAdapt { static constexpr bool PERM = false, AFTER_DRAIN = false; const E& e;
  DI void operator()(const f32x4 (&acc)[2][2][4][2], const Unit& u, int wr, int wc, int fr, int fq) const {
#pragma unroll
    for (int ai = 0; ai < 2; ++ai)
#pragma unroll
      for (int m = 0; m < 4; ++m)
#pragma unroll
        for (int bj = 0; bj < 2; ++bj)
#pragma unroll
          for (int n = 0; n < 2; ++n) { const f32x4 v = acc[ai][bj][m][n];
            e(u.pm * BM + ai * HALF + wr * 64 + m * 16 + fr, u.pn * BM + bj * HALF + wc * 32 + n * 16 + 4 * fq, v.x, v.y, v.z, v.w); } } };
template <class Epi, class Sched, bool ALIGN_EPI = false, bool SP2 = false>
__device__ __forceinline__ void gemm_phase(PG8_LAS unsigned char* lds, const Gemm g, const Sched& S, const Epi& E) {
    const int tid = opaque_tid(), wid = __builtin_amdgcn_readfirstlane(tid >> 6), lane = tid & 63, wr = wid >> 2, wc = wid & 3, fr = lane & 15, fq = lane >> 4;
    const int K = g.K, nt = K / BK;
    unsigned voffA[2], voffB[2];
#pragma unroll
    for (int i = 0; i < 2; ++i) { int R, C; stage_rc(tid * 16 + i * 8192, R, C); const int Rb = Epi::PERM ? ((R & ~31) + perm32(R & 31)) : R;
        voffA[i] = (unsigned)(R * K + C) * 2u; voffB[i] = (unsigned)(Rb * K + C) * 2u; }
    const size_t kstep = (size_t)(BK * 2);
    const size_t hstep = (size_t)HALF * K * 2;
    const size_t tstep = 2 * hstep;
    const unsigned ldsw = (unsigned)wid * 1024u;
    const int aoff = lds_byte(wr * 64 + fr, fq * 8), boff = lds_byte(wc * 32 + fr, fq * 8);
#define PG8_SA(b, h) (((b) * 2 + (h)) * HTB)
#define PG8_SB(b, h) ((4 + (b) * 2 + (h)) * HTB)
#define PG8_STAGE(bufoff, gbase, voff) do { _Pragma("unroll") for (int _i = 0; _i < 2; ++_i) \
        __builtin_amdgcn_global_load_lds((const unsigned*)((const char*)(gbase) + (voff)[_i]), (PG8_LAS unsigned*)(lds + (bufoff) + ldsw + _i * 8192), 16, 0, 0); } while (0)
#define PG8_LDA(dst, b, h) do { _Pragma("unroll") for (int m = 0; m < 4; ++m) _Pragma("unroll") for (int k = 0; k < 2; ++k) dst[m][k] = *(const PG8_LAS bf16x8*)(lds + PG8_SA(b, h) + aoff + m * 2048 + k * 1024); } while (0)
#define PG8_LDB(dst, b, h) do { _Pragma("unroll") for (int n = 0; n < 2; ++n) _Pragma("unroll") for (int k = 0; k < 2; ++k) dst[n][k] = *(const PG8_LAS bf16x8*)(lds + PG8_SB(b, h) + boff + n * 2048 + k * 1024); } while (0)
#define PG8_MMA(ai, bj, At, Bt) do { __builtin_amdgcn_s_setprio(1); _Pragma("unroll") for (int m = 0; m < 4; ++m) _Pragma("unroll") for (int n = 0; n < 2; ++n) _Pragma("unroll") for (int k = 0; k < 2; ++k) \
        acc[ai][bj][m][n] = __builtin_amdgcn_mfma_f32_16x16x32_bf16(Bt[n][k], At[m][k], acc[ai][bj][m][n], 0, 0, 0); __builtin_amdgcn_s_setprio(0); } while (0)
#define PG8_WAIT_V(n) asm volatile("s_waitcnt vmcnt(" #n ")" ::: "memory")
#define PG8_WAIT_L(n) asm volatile("s_waitcnt lgkmcnt(" #n ")" ::: "memory")
#define PG8_BAR __builtin_amdgcn_s_barrier()
#define PG8_SCHED __builtin_amdgcn_sched_barrier(0)
    Unit cur, nxt; int ui = 0;
    if (!S.next(0, cur)) return;
    f32x4 acc[2][2][4][2];
#pragma unroll
    for (int a = 0; a < 2; ++a)
#pragma unroll
        for (int b = 0; b < 2; ++b)
#pragma unroll
            for (int m = 0; m < 4; ++m)
#pragma unroll
                for (int n = 0; n < 2; ++n) acc[a][b][m][n] = (f32x4){0.f, 0.f, 0.f, 0.f};
    bf16x8 At[4][2], B0[2][2], B1[2][2];
    const char* cA = (const char*)g.A + (size_t)cur.pm * tstep; const char* cB = (const char*)g.Bt + (size_t)cur.pn * tstep;
    S.a_ready(cur);
    if constexpr (SP2) {
        PG8_STAGE(PG8_SB(0, 0), cB, voffB); PG8_STAGE(PG8_SB(0, 1), cB + hstep, voffB); PG8_STAGE(PG8_SA(0, 0), cA, voffA); PG8_STAGE(PG8_SA(0, 1), cA + hstep, voffA);
        if (wr == 1) PG8_BAR;
        PG8_WAIT_V(2); PG8_BAR;
        PG8_STAGE(PG8_SB(1, 0), cB + kstep, voffB); PG8_STAGE(PG8_SA(1, 0), cA + kstep, voffA); PG8_STAGE(PG8_SB(1, 1), cB + hstep + kstep, voffB);
        PG8_WAIT_V(6); PG8_BAR;
    } else {
        PG8_STAGE(PG8_SB(0, 0), cB, voffB); PG8_STAGE(PG8_SA(0, 0), cA, voffA); PG8_STAGE(PG8_SB(0, 1), cB + hstep, voffB); PG8_STAGE(PG8_SA(0, 1), cA + hstep, voffA);
        if (wr == 1) PG8_BAR;
        PG8_WAIT_V(4); PG8_BAR;
        PG8_STAGE(PG8_SB(1, 0), cB + kstep, voffB); PG8_STAGE(PG8_SA(1, 0), cA + kstep, voffA); PG8_STAGE(PG8_SB(1, 1), cB + hstep + kstep, voffB);
        PG8_WAIT_V(6); PG8_BAR;
    }
    for (;;) {
        const bool has_next = S.next(ui + 1, nxt);
        const char* nA = has_next ? (const char*)g.A + (size_t)nxt.pm * tstep : cA; const char* nB = has_next ? (const char*)g.Bt + (size_t)nxt.pn * tstep : cB;
        for (int t = 0; t < nt; t += 2) {
            const bool last = (t == nt - 2);
            const char* a1 = cA + (size_t)(t + 1) * kstep;
            const char* a2 = last ? nA : cA + (size_t)(t + 2) * kstep; const char* b2 = last ? nB : cB + (size_t)(t + 2) * kstep;
            const char* a3 = a2 + kstep; const char* b3 = b2 + kstep;
            if (last && has_next) S.a_ready(nxt);
            if constexpr (SP2) {
            PG8_LDB(B0, 0, 0); PG8_LDB(B1, 0, 1); PG8_SCHED; PG8_LDA(At, 0, 0); PG8_STAGE(PG8_SA(1, 1), a1 + hstep, voffA);
            PG8_WAIT_V(8); PG8_WAIT_L(0); PG8_BAR; PG8_MMA(0, 0, At, B0); PG8_MMA(0, 1, At, B1); PG8_BAR; PG8_SCHED;
            PG8_LDA(At, 0, 1); PG8_STAGE(PG8_SB(0, 0), b2, voffB); PG8_STAGE(PG8_SB(0, 1), b2 + hstep, voffB); PG8_STAGE(PG8_SA(0, 0), a2, voffA);
            PG8_WAIT_V(8); PG8_WAIT_L(0); PG8_BAR; PG8_MMA(1, 0, At, B0); PG8_MMA(1, 1, At, B1); PG8_BAR; PG8_SCHED;
            PG8_LDB(B0, 1, 0); PG8_LDB(B1, 1, 1); PG8_SCHED; PG8_LDA(At, 1, 0); PG8_STAGE(PG8_SA(0, 1), a2 + hstep, voffA);
            PG8_WAIT_V(8); PG8_WAIT_L(0); PG8_BAR; PG8_MMA(0, 0, At, B0); PG8_MMA(0, 1, At, B1); PG8_BAR; PG8_SCHED;
            PG8_LDA(At, 1, 1); PG8_STAGE(PG8_SB(1, 0), b3, voffB); PG8_STAGE(PG8_SB(1, 1), b3 + hstep, voffB); PG8_STAGE(PG8_SA(1, 0), a3, voffA);
            PG8_WAIT_V(8); PG8_WAIT_L(0); PG8_BAR; PG8_MMA(1, 0, At, B0); PG8_MMA(1, 1, At, B1); PG8_BAR; PG8_SCHED;
            } else {
            PG8_LDB(B0, 0, 0); PG8_SCHED; PG8_LDA(At, 0, 0); PG8_STAGE(PG8_SA(1, 1), a1 + hstep, voffA);
            PG8_WAIT_L(8); PG8_BAR; PG8_WAIT_L(0); PG8_MMA(0, 0, At, B0); PG8_BAR; PG8_SCHED;
            PG8_LDB(B1, 0, 1); PG8_STAGE(PG8_SB(0, 0), b2, voffB);
            PG8_BAR; PG8_WAIT_L(0); PG8_MMA(0, 1, At, B1); PG8_BAR;
            PG8_LDA(At, 0, 1); PG8_STAGE(PG8_SA(0, 0), a2, voffA);
            PG8_BAR; PG8_WAIT_L(0); PG8_MMA(1, 0, At, B0); PG8_BAR; PG8_SCHED;
            PG8_STAGE(PG8_SB(0, 1), b2 + hstep, voffB);
            PG8_WAIT_V(6); PG8_BAR; PG8_MMA(1, 1, At, B1); PG8_BAR;
            PG8_LDB(B0, 1, 0); PG8_SCHED; PG8_LDA(At, 1, 0); PG8_STAGE(PG8_SA(0, 1), a2 + hstep, voffA);
            PG8_WAIT_L(8); PG8_BAR; PG8_WAIT_L(0); PG8_MMA(0, 0, At, B0); PG8_BAR; PG8_SCHED;
            PG8_LDB(B1, 1, 1); PG8_STAGE(PG8_SB(1, 0), b3, voffB);
            PG8_BAR; PG8_WAIT_L(0); PG8_MMA(0, 1, At, B1); PG8_BAR;
            PG8_LDA(At, 1, 1); PG8_STAGE(PG8_SA(1, 0), a3, voffA);
            PG8_BAR; PG8_WAIT_L(0); PG8_MMA(1, 0, At, B0); PG8_BAR; PG8_SCHED;
            PG8_STAGE(PG8_SB(1, 1), b3 + hstep, voffB);
            PG8_WAIT_V(6); PG8_BAR; PG8_MMA(1, 1, At, B1); PG8_BAR;
            }
        }
        if constexpr (ALIGN_EPI) { if (wr == 0) PG8_BAR; }
        if constexpr (!Epi::AFTER_DRAIN) { E(acc, cur, wr, wc, fr, fq); S.done(cur); }
        if (!has_next) break;
#pragma unroll
        for (int a = 0; a < 2; ++a)
#pragma unroll
            for (int b = 0; b < 2; ++b)
#pragma unroll
                for (int m = 0; m < 4; ++m)
#pragma unroll
                    for (int n = 0; n < 2; ++n) acc[a][b][m][n] = (f32x4){0.f, 0.f, 0.f, 0.f};
        cur = nxt; cA = nA; cB = nB; ++ui;
        if constexpr (ALIGN_EPI) { if (wr == 1) PG8_BAR; }
    }
    PG8_WAIT_V(0);
    if constexpr (!ALIGN_EPI) { if (wr == 0) PG8_BAR; }
    PG8_BAR;
    if constexpr (Epi::AFTER_DRAIN) { E.fused(acc, cur, wr, wc, fr, fq, lds, wid, lane); S.done(cur); }
#undef PG8_SA
#undef PG8_SB
#undef PG8_STAGE
#undef PG8_LDA
#undef PG8_LDB
#undef PG8_MMA
#undef PG8_WAIT_V
#undef PG8_WAIT_L
#undef PG8_BAR
#undef PG8_SCHED
}
}

template <class Epi>
DI void gemm_phase(const bf16_t* A, int lda, const bf16_t* Bt, int ldb, int K, int npm, int npn, char* smem, const Epi& epi) {
  if (gridDim.x == 256 && npm == 64) {
    const int b = blockIdx.x, pm = 8 * (b & 7) + ((b >> 3) & 7), pj = b >> 6;
    if (lda == K && ldb == K && (K & 127) == 0) {
      const pg8::Gemm g{A, Bt, npm * 256, npn * 256, K}; const pg8::XcdOrder ord{pm, pj, npn}; const pg8::EpiAdapt8<Epi> ea{epi};
      pg8::gemm_phase<pg8::EpiAdapt8<Epi>, pg8::XcdOrder, true, true>(( __attribute__((address_space(3))) unsigned char*)smem, g, ord, ea);
    } else
    for (int pn = pj; pn < npn; pn += 4) gemm_tile(A, lda, Bt, ldb, K, pm * 256, pn * 256, smem, epi);
  } else {
    for (int t = blockIdx.x; t < npm * npn; t += gridDim.x) { int pm, pn; tile_coord(t, npn, pm, pn); gemm_tile(A, lda, Bt, ldb, K, pm * 256, pn * 256, smem, epi); }
  }
}

DI void mod_item(const Params& P, int item) {
  const int tid = opaque_tid(); const int l = item / 96, r = item % 96, ks = r / 6, nc = r % 6;
  const int n = nc * 2048 + tid * 4;
  const float* wp = P.ada_w + ((size_t)l * 2048 + ks * 128) * 12288 + n;
  f32x4 acc = {0.f, 0.f, 0.f, 0.f};
#pragma unroll 8
  for (int k = 0; k < 128; ++k) { const float cv = P.c[ks * 128 + k]; const float ca = silu_f(cv); const f32x4 wv = __builtin_nontemporal_load((const f32x4*)(wp + (size_t)k * 12288)); acc += wv * ca; }
  float* modp = (float*)(P.ws + OFF_MODP);
  *(f32x4*)(modp + ((size_t)l * 16 + ks) * 12288 + n) = acc;
}
DI void convert_tile(const float* __restrict__ src, int K, int N, bf16_t* __restrict__ dst, int tk, int tn, const float* rowscale, char* smem) {
  float* sm = (float*)smem; const int tid = opaque_tid(); const int k0 = tk * 64, n0 = tn * 256;
  { const int r = tid >> 6, c4 = tid & 63; const int n = n0 + 4 * c4;
    f32x4 v[8];
#pragma unroll
    for (int i = 0; i < 8; ++i) { v[i] = (f32x4){0.f, 0.f, 0.f, 0.f}; if (n < N) v[i] = __builtin_nontemporal_load((const f32x4*)(src + (size_t)(k0 + r + 8 * i) * N + n)); }
#pragma unroll
    for (int i = 0; i < 8; ++i) { const int kk = r + 8 * i; if (rowscale) v[i] *= rowscale[k0 + kk];
      sm[kk * 257 + 4 * c4 + 0] = v[i].x; sm[kk * 257 + 4 * c4 + 1] = v[i].y; sm[kk * 257 + 4 * c4 + 2] = v[i].z; sm[kk * 257 + 4 * c4 + 3] = v[i].w; } }
  __syncthreads();
  { const int n = tid >> 1, kh = tid & 1;
#pragma unroll
    for (int j = 0; j < 4; ++j) { float f[8];
#pragma unroll
      for (int i = 0; i < 8; ++i) f[i] = sm[(32 * kh + 8 * j + i) * 257 + n];
      u32x4 pk = {pack2(f[0], f[1]), pack2(f[2], f[3]), pack2(f[4], f[5]), pack2(f[6], f[7])};
      *(u32x4*)(dst + (size_t)(n0 + n) * K + k0 + 32 * kh + 8 * j) = pk; } }
  __syncthreads();
}
constexpr int CV_T0 = 32 * 22, CV_T1 = CV_T0 + 32 * 8, CV_T2 = CV_T1 + 32 * 44, CV_T3 = CV_T2 + 88 * 8, CV_T4 = CV_T3 + 7 * 3, CV_T5 = CV_T4 + 2 * 4;
DI void convert_item(const Params& P, int l, int it, char* smem) {
  char* wb = P.ws + OFF_W;
  if (it < CV_T0) convert_tile(P.w_in + (size_t)l * 2048 * 5520, 2048, 5520, (bf16_t*)(wb + W_IN), it / 22, it % 22, nullptr, smem);
  else if (it < CV_T1) { it -= CV_T0; convert_tile(P.w_out + (size_t)l * 2048 * 2048, 2048, 2048, (bf16_t*)(wb + W_OUT), it / 8, it % 8, nullptr, smem); }
  else if (it < CV_T2) { it -= CV_T1; convert_tile(P.ffn_w_up + (size_t)l * 2048 * 11264, 2048, 11264, (bf16_t*)(wb + W_UP), it / 44, it % 44, nullptr, smem); }
  else if (it < CV_T3) { it -= CV_T2; convert_tile(P.ffn_w_down + (size_t)l * 5632 * 2048, 5632, 2048, (bf16_t*)(wb + W_DOWN), it / 8, it % 8, nullptr, smem); }
  else if (it < CV_T4) { it -= CV_T3; convert_tile(P.mla_w_uq + (size_t)l * 448 * 768, 448, 768, (bf16_t*)(wb + W_UQ), it / 3, it % 3, P.mla_q_norm + l * 448, smem); }
  else { it -= CV_T4; convert_tile(P.mla_w_ukv + (size_t)l * 128 * 1024, 128, 1024, (bf16_t*)(wb + W_UKV), it / 4, it % 4, P.mla_kv_norm + l * 128, smem); }
}

DI float mod_val(const float* modp_l, const float* ada_b_l, int idx) { float s = ada_b_l[idx];
#pragma unroll
  for (int k = 0; k < 16; ++k) s += modp_l[(size_t)k * 12288 + idx]; return s; }
DI void rownorm_phase(const Params& P, const float* xin, const bf16_t* yin, float* xout, bf16_t* hout, int lg, int gate_idx, const float* w_post,
                      int lh, int scale_idx, int shift_idx, const float* w_pre, char* smem) {
  float* A1 = (float*)smem; float* A2 = A1 + 2048; float* B2 = A2 + 2048;
  const int tid = opaque_tid(), lane = tid & 63, w = tid >> 6;
  const float* modp = (const float*)(P.ws + OFF_MODP);
  for (int cidx = tid; cidx < 2048; cidx += NT) {
    if (yin) A1[cidx] = mod_val(modp + (size_t)lg * 16 * 12288, P.ada_b + (size_t)lg * 12288, gate_idx * 2048 + cidx) * w_post[cidx];
    if (hout) { A2[cidx] = w_pre[cidx] * (1.f + mod_val(modp + (size_t)lh * 16 * 12288, P.ada_b + (size_t)lh * 12288, scale_idx * 2048 + cidx));
      B2[cidx] = mod_val(modp + (size_t)lh * 16 * 12288, P.ada_b + (size_t)lh * 12288, shift_idx * 2048 + cidx); }
  }
  __syncthreads();
  for (int row = blockIdx.x * 8 + w; row < S_; row += gridDim.x * 8) {
    f32x4 xv[8];
#pragma unroll
    for (int j = 0; j < 8; ++j) xv[j] = *(const f32x4*)(xin + (size_t)row * 2048 + (j * 64 + lane) * 4);
    if (yin) {
      f32x4 yv[8]; float ss = 0.f;
#pragma unroll
      for (int j = 0; j < 8; ++j) { const u32x2 yb = __builtin_nontemporal_load((const u32x2*)(yin + (size_t)row * 2048 + (j * 64 + lane) * 4)); yv[j] = (f32x4){bflo(yb.x), bfhi(yb.x), bflo(yb.y), bfhi(yb.y)};
        ss += yv[j].x * yv[j].x + yv[j].y * yv[j].y + yv[j].z * yv[j].z + yv[j].w * yv[j].w; }
      ss = wave_sum(ss); const float r = rsqrtf(ss * (1.f / 2048.f) + EPS);
#pragma unroll
      for (int j = 0; j < 8; ++j) { const f32x4 a = *(const f32x4*)(A1 + (j * 64 + lane) * 4); xv[j] += a * (yv[j] * r); }
    }
    if (yin || xout != xin) {
#pragma unroll
      for (int j = 0; j < 8; ++j) *(f32x4*)(xout + (size_t)row * 2048 + (j * 64 + lane) * 4) = xv[j];
    }
    if (hout) {
      float ss = 0.f;
#pragma unroll
      for (int j = 0; j < 8; ++j) ss += xv[j].x * xv[j].x + xv[j].y * xv[j].y + xv[j].z * xv[j].z + xv[j].w * xv[j].w;
      ss = wave_sum(ss); const float r = rsqrtf(ss * (1.f / 2048.f) + EPS);
#pragma unroll
      for (int j = 0; j < 8; ++j) { const f32x4 a = *(const f32x4*)(A2 + (j * 64 + lane) * 4), b = *(const f32x4*)(B2 + (j * 64 + lane) * 4);
        const f32x4 hv = xv[j] * r * a + b; u32x2 pk = {pack2(hv.x, hv.y), pack2(hv.z, hv.w)};
        *(u32x2*)(hout + (size_t)row * 2048 + (j * 64 + lane) * 4) = pk; }
    }
  }
  __syncthreads();
}

DI void mla_q_tile(const Params& P, int pm, int pn, char* smem) {
  const bf16_t* proj = (const bf16_t*)(P.ws + OFF_PROJ); const int tid = opaque_tid(), m0 = pm * 256; float* rs = (float*)(smem + 131072);
  { const int row = tid >> 1, half = tid & 1; const bf16_t* p = proj + (size_t)(m0 + row) * DINP + C_BCQ + half * 224; float ss = 0.f;
    for (int i = 0; i < 28; ++i) { const u32x4 v = *(const u32x4*)(p + i * 8); float f[8]; unpack8(v, f);
#pragma unroll
      for (int e = 0; e < 8; ++e) ss += f[e] * f[e]; }
    ss += __shfl_xor(ss, 1); if (half == 0) rs[row] = rsqrtf(ss * (1.f / 448.f) + EPS); }
  EpiMlaQ epi{(float*)(P.ws + OFF_QRAW), rs, m0};
  gemm_tile_s(proj + C_BCQ, DINP, (const bf16_t*)(P.ws + OFF_W + W_UQ), 448, 448, m0, pn * 256, smem, epi);
  __syncthreads();
}
DI void mla_kv_tile(const Params& P, int pm, int pn, char* smem) {
  const bf16_t* proj = (const bf16_t*)(P.ws + OFF_PROJ); const int tid = opaque_tid(), m0 = pm * 256; float* rs = (float*)(smem + 131072);
  { const int row = tid >> 1, half = tid & 1; const bf16_t* p = proj + (size_t)(m0 + row) * DINP + C_BCKV + half * 64; float ss = 0.f;
#pragma unroll
    for (int i = 0; i < 8; ++i) { const u32x4 v = *(const u32x4*)(p + i * 8); float f[8]; unpack8(v, f);
#pragma unroll
      for (int e = 0; e < 8; ++e) ss += f[e] * f[e]; }
    ss += __shfl_xor(ss, 1); if (half == 0) rs[row] = rsqrtf(ss * (1.f / 128.f) + EPS); }
  bf16_t* kmla = (bf16_t*)(P.ws + OFF_KMLA);
  EpiMlaKV epi{kmla, (bf16_t*)(P.ws + OFF_VT), rs, m0};
  gemm_tile_s(proj + C_BCKV, DINP, (const bf16_t*)(P.ws + OFF_W + W_UKV), 128, 128, m0, pn * 256, smem, epi);
  if (pn == 0) {
    for (int i = 0; i < 16; ++i) { const int idx = tid + NT * i, row = idx >> 5, pi = idx & 31, m = m0 + row;
      const float x1 = bflo((unsigned)proj[(size_t)m * DINP + C_BKR + pi]), x2 = bflo((unsigned)proj[(size_t)m * DINP + C_BKR + 32 + pi]);
      double fr = (double)P.pos[m] * kInvFreq2Pi[pi]; fr -= floor(fr); const float ff = (float)fr;
      const float sn = __builtin_amdgcn_sinf(ff), cs = __builtin_amdgcn_cosf(ff);
      const bf16_t o1 = f2bf(x1 * cs - x2 * sn), o2 = f2bf(x2 * cs + x1 * sn);
#pragma unroll
      for (int hd = 0; hd < 4; ++hd) { bf16_t* kp = kmla + ((size_t)hd * S_ + m) * 192 + 128; kp[pi] = o1; kp[32 + pi] = o2; } }
  }
  __syncthreads();
}

DI void gdn_prep_item(const Params& P, int l, int n, int hh, char* smem) {
  const int tid = opaque_tid(), lane = tid & 63, w = tid >> 6, lq = lane & 31, h = lane >> 5;
  const bf16_t* proj = (const bf16_t*)(P.ws + OFF_PROJ); const float* ab = (const float*)(P.ws + OFF_AB);
  char* kb16 = smem; char* qb16 = smem + 17408;
  float* kf = (float*)(smem + 34816); float* vf = kf + 8192; float* Lm = vf + 8192; float* gcs = Lm + 4096;
  const size_t tile = (size_t)hh * 256 + n; const int t0 = n * 64;
  bf16_t* Wp = (bf16_t*)(P.ws + OFF_WP) + tile * 8192; bf16_t* Qd = (bf16_t*)(P.ws + OFF_QD) + tile * 8192;
  bf16_t* Kt = (bf16_t*)(P.ws + OFF_KT) + tile * 8192; bf16_t* Zt = (bf16_t*)(P.ws + OFF_ZT) + tile * 8192;
  bf16_t* QK = (bf16_t*)(P.ws + OFF_QK) + tile * 4096; bf16_t* Ut = (bf16_t*)(P.ws + OFF_UT) + tile * 8192;
  if (w == 0) {
    const int t = lane; const float a_raw = ab[(size_t)(t0 + t) * 16 + hh], b_raw = ab[(size_t)(t0 + t) * 16 + 8 + hh];
    const float Aa = __expf(P.gdn_a_log[l * 8 + hh]); const float xb = a_raw + P.gdn_dt_bias[l * 8 + hh];
    const float ex = __expf(fminf(xb, 20.f));
    const float sp = xb > 20.f ? xb : (ex < 0.01f ? ex * (1.f - ex * (0.5f - ex * (1.f / 3.f))) : __logf(1.f + ex));
    float g = -Aa * sp;
#pragma unroll
    for (int d = 1; d < 64; d <<= 1) { const float v = __shfl_up(g, d); if (lane >= d) g += v; }
    const float bt = __builtin_amdgcn_rcpf(1.f + __expf(-b_raw)), eg = __expf(g); gcs[t] = g; gcs[64 + t] = bt; gcs[128 + t] = eg; gcs[192 + t] = bt * eg;
    if (t == 63) ((float*)(P.ws + OFF_GTOT))[tile] = eg;
  }
  __syncthreads();
  {
    const int t = tid >> 3, part = tid & 7, tabs = t0 + t;
    const float gct = gcs[t], egct = gcs[128 + t], ktl = __expf(gcs[63] - gct);
    const int pjt = 32 * (t >> 5) + perm32(t & 31);
#pragma unroll
    for (int X = 0; X < 3; ++X) {
      const int cb = X * 1024 + hh * 128 + part * 16;
      float y[16];
#pragma unroll
      for (int e = 0; e < 16; ++e) y[e] = 0.f;
      u32x4 pv[4][2]; f32x4 wv[4][4];
#pragma unroll
      for (int j = 0; j < 4; ++j) { const int row = tabs - 3 + j, rr = row < 0 ? 0 : row;
        pv[j][0] = *(const u32x4*)(proj + (size_t)rr * DINP + cb); pv[j][1] = *(const u32x4*)(proj + (size_t)rr * DINP + cb + 8);
        const float* cw = P.gdn_conv + ((size_t)l * 4 + j) * 3072 + cb;
#pragma unroll
        for (int e4 = 0; e4 < 4; ++e4) wv[j][e4] = *(const f32x4*)(cw + 4 * e4); }
      __builtin_amdgcn_sched_barrier(0);
#pragma unroll
      for (int j = 0; j < 4; ++j) { const float msk = (tabs - 3 + j) >= 0 ? 1.f : 0.f;
        float xv[16]; unpack8(pv[j][0], xv); unpack8(pv[j][1], xv + 8);
#pragma unroll
        for (int e4 = 0; e4 < 4; ++e4) { const f32x4 wm = wv[j][e4] * msk; y[4 * e4] += wm.x * xv[4 * e4]; y[4 * e4 + 1] += wm.y * xv[4 * e4 + 1]; y[4 * e4 + 2] += wm.z * xv[4 * e4 + 2]; y[4 * e4 + 3] += wm.w * xv[4 * e4 + 3]; } }
#pragma unroll
      for (int e = 0; e < 16; ++e) y[e] = silu_f(y[e]);
      if (X < 2) { float ss = 0.f;
#pragma unroll
        for (int e = 0; e < 16; ++e) ss += y[e] * y[e];
        ss += __shfl_xor(ss, 1); ss += __shfl_xor(ss, 2); ss += __shfl_xor(ss, 4);
        const float rn = rsqrtf(ss + EPS) * (X == 0 ? 0.08838834764831845f : 1.f);
#pragma unroll
        for (int e = 0; e < 16; ++e) y[e] *= rn; }
      if (X == 0) {
        u32x4 p0 = {pack2(y[0], y[1]), pack2(y[2], y[3]), pack2(y[4], y[5]), pack2(y[6], y[7])}, p1 = {pack2(y[8], y[9]), pack2(y[10], y[11]), pack2(y[12], y[13]), pack2(y[14], y[15])};
        *(u32x4*)(qb16 + t * 272 + part * 32) = p0; *(u32x4*)(qb16 + t * 272 + part * 32 + 16) = p1;
#pragma unroll
        for (int b = 0; b < 4; ++b) { u32x2 pk = {pack2(y[4 * b] * egct, y[4 * b + 1] * egct), pack2(y[4 * b + 2] * egct, y[4 * b + 3] * egct)};
          *(u32x2*)(Qd + t * 128 + 32 * (part >> 1) + 8 * b + 4 * (part & 1)) = pk; }
      } else if (X == 1) {
        u32x4 p0 = {pack2(y[0], y[1]), pack2(y[2], y[3]), pack2(y[4], y[5]), pack2(y[6], y[7])}, p1 = {pack2(y[8], y[9]), pack2(y[10], y[11]), pack2(y[12], y[13]), pack2(y[14], y[15])};
        *(u32x4*)(kb16 + t * 272 + part * 32) = p0; *(u32x4*)(kb16 + t * 272 + part * 32 + 16) = p1;
#pragma unroll
        for (int e4 = 0; e4 < 4; ++e4) { f32x4 v = {y[4 * e4], y[4 * e4 + 1], y[4 * e4 + 2], y[4 * e4 + 3]}; *(f32x4*)(kf + t * 128 + part * 16 + 4 * e4) = v; }
#pragma unroll
        for (int e = 0; e < 16; ++e) Kt[(part * 16 + e) * 64 + pjt] = f2bf(y[e] * ktl);
      } else {
#pragma unroll
        for (int e4 = 0; e4 < 4; ++e4) { f32x4 v = {y[4 * e4], y[4 * e4 + 1], y[4 * e4 + 2], y[4 * e4 + 3]}; *(f32x4*)(vf + t * 128 + part * 16 + 4 * e4) = v; }
      }
    }
    { const int cb = C_AZ + hh * 128 + part * 16; const u32x4 v0 = *(const u32x4*)(proj + (size_t)tabs * DINP + cb), v1 = *(const u32x4*)(proj + (size_t)tabs * DINP + cb + 8);
      float zv[16]; unpack8(v0, zv); unpack8(v1, zv + 8);
#pragma unroll
      for (int e = 0; e < 16; ++e) Zt[(part * 16 + e) * 64 + t] = f2bf(silu_f(zv[e])); }
  }
  __syncthreads();
  {
    const int which = w >> 2, ti = (w >> 1) & 1, tj = w & 1; const char* Ab = which ? qb16 : kb16;
    f32x16 acc;
#pragma unroll
    for (int r = 0; r < 16; ++r) acc[r] = 0.f;
#pragma unroll
    for (int s = 0; s < 8; ++s) { const bf16x8 a = *(const bf16x8*)(Ab + (32 * ti + lq) * 272 + (16 * s + 8 * h) * 2), b = *(const bf16x8*)(kb16 + (32 * tj + lq) * 272 + (16 * s + 8 * h) * 2);
      acc = MFMA32(a, b, acc); }
    const int j = 32 * tj + lq; const float gj = gcs[j]; const int pj = 32 * (j >> 5) + perm32(j & 31);
#pragma unroll
    for (int r = 0; r < 16; ++r) { const int i = 32 * ti + crow(r, h); const float dec = __expf(fminf(gcs[i] - gj, 0.f));
      if (which == 0) Lm[i * 64 + j] = (j < i) ? gcs[64 + i] * acc[r] * dec : 0.f;
      else QK[i * 64 + pj] = f2bf((j <= i) ? acc[r] * dec : 0.f); }
  }
  __syncthreads();
  if (tid < 256) {
    const int c = tid; const bool isu = c < 128; const int cc = c & 127;
    const float* rp = (isu ? vf : kf) + cc; const float* sp = gcs + (isu ? 64 : 192);
    f32x2 xx[32];
    f32x4 LA[16], LB[16]; float rh[2];
    xx[0].x = sp[0] * rp[0];
    LA[0] = *(const f32x4*)(Lm + 64); rh[1] = sp[1] * rp[128];
#pragma unroll
    for (int i = 1; i < 64; ++i) {
      f32x4 (&CUR)[16] = (i & 1) ? LA : LB; f32x4 (&NXT)[16] = (i & 1) ? LB : LA;
      if (i + 1 < 64) {
#pragma unroll
        for (int c = 0; c < (i + 4) / 4; ++c) NXT[c] = *(const f32x4*)(Lm + (i + 1) * 64 + 4 * c);
        rh[(i + 1) & 1] = sp[i + 1] * rp[(i + 1) * 128];
      }
      __builtin_amdgcn_sched_barrier(0);
      f32x2 acc = {rh[i & 1], 0.f};
#pragma unroll
      for (int p = 0; p < i / 2; ++p) { const f32x2 lp = (p & 1) ? (f32x2){CUR[p >> 1].z, CUR[p >> 1].w} : (f32x2){CUR[p >> 1].x, CUR[p >> 1].y}; acc = acc - lp * xx[p]; }
      if (i & 1) { const int j = i - 1; const float lj = ((j & 3) == 0) ? CUR[j >> 2].x : CUR[j >> 2].z; acc.x = fmaf(-lj, xx[j >> 1].x, acc.x); }
      const float xi = acc.x + acc.y;
      if (i & 1) xx[i >> 1].y = xi; else xx[i >> 1].x = xi;
      __builtin_amdgcn_sched_barrier(0);
    }
    float x[64];
#pragma unroll
    for (int p = 0; p < 32; ++p) { x[2 * p] = xx[p].x; x[2 * p + 1] = xx[p].y; }
    if (isu) {
#pragma unroll
      for (int i8 = 0; i8 < 8; ++i8) { u32x4 v = {pack2(x[8 * i8], x[8 * i8 + 1]), pack2(x[8 * i8 + 2], x[8 * i8 + 3]), pack2(x[8 * i8 + 4], x[8 * i8 + 5]), pack2(x[8 * i8 + 6], x[8 * i8 + 7])}; *(u32x4*)(Ut + cc * 64 + 8 * i8) = v; }
    } else {
      const int pp = 32 * (cc >> 5) + perm32(cc & 31);
#pragma unroll
      for (int i = 0; i < 64; ++i) Wp[i * 128 + pp] = f2bf(x[i]);
    }
  }
  __syncthreads();
}

DI bf16x8 pack_tiles(const f32x4& a, const f32x4& b) { return pack8(a.x, a.y, a.z, a.w, b.x, b.y, b.z, b.w); }
template <int CTRL> DI float dppf(float v) { return __int_as_float(__builtin_amdgcn_update_dpp(0, __float_as_int(v), CTRL, 0xf, 0xf, true)); }
DI float row16_sum(float v) { v += dppf<0xB1>(v); v += dppf<0x4E>(v); v += dppf<0x141>(v); v += dppf<0x140>(v); return v; }
constexpr size_t OFF_SSQP = OFF_GTOT + 8192;
static_assert(OFF_SSQP + (size_t)8 * S_ * 8 * 4 <= OFF_UT, "overlay3");
constexpr int SCAN_OPB = 62464;
constexpr int SCAN_SO = 2 * SCAN_OPB;
constexpr int SCAN_OT = SCAN_SO + 16384;
DI void gdn_scan_item(const Params& P, int l, int hh, int half, char* smem) {
  const int tid = opaque_tid(), lane = tid & 63, w = tid >> 6, l15 = lane & 15, q4 = lane >> 4;
  const size_t hb = (size_t)hh * 256;
  const bf16_t* Wp = (const bf16_t*)(P.ws + OFF_WP) + hb * 8192; const bf16_t* Qd = (const bf16_t*)(P.ws + OFF_QD) + hb * 8192;
  const bf16_t* Kt = (const bf16_t*)(P.ws + OFF_KT) + hb * 8192; const bf16_t* Zt = (const bf16_t*)(P.ws + OFF_ZT) + hb * 8192;
  const bf16_t* QK = (const bf16_t*)(P.ws + OFF_QK) + hb * 4096; const bf16_t* Ut = (const bf16_t*)(P.ws + OFF_UT) + hb * 8192;
  const float* gt = (const float*)(P.ws + OFF_GTOT) + hb;
  bf16_t* mixin = (bf16_t*)(P.ws + OFF_H);
  float* sSS = (float*)(smem + SCAN_OT + 16384);
  if (w >= 4) {
    const int lt = tid - 256, wl = w - 4;
    const int dvc = 64 * half + 16 * wl + l15; const float nw = P.gdn_norm[l * 128 + dvc];
    const int uoff = dvc * 64 + 4 * q4;
    const int g256 = (lt >> 4) * 128 + (lt & 15) * 8, l256 = (lt >> 4) * 272 + (lt & 15) * 16;
    const int g128 = (lt >> 3) * 64 + (lt & 7) * 8, l128 = (lt >> 3) * 144 + (lt & 7) * 16;
    u32x4 pwA[4], pqA[4], pkA[4], pqkA[2], pwB[4], pqB[4], pkB[4], pqkB[2]; u32x2 zA[4], zB[4];
#define LD_LOAD(PW, PQ, PK, PQK, N) { const int n__ = (N) < 255 ? (N) : 255; const size_t o8 = (size_t)n__ * 8192, o4 = (size_t)n__ * 4096; \
    _Pragma("unroll") for (int i = 0; i < 4; ++i) { PW[i] = *(const u32x4*)(Wp + o8 + g256 + i * 2048); PQ[i] = *(const u32x4*)(Qd + o8 + g256 + i * 2048); PK[i] = *(const u32x4*)(Kt + o8 + g128 + i * 2048); } \
    _Pragma("unroll") for (int i = 0; i < 2; ++i) PQK[i] = *(const u32x4*)(QK + o4 + g128 + i * 2048); }
#define LZ_LOAD(Z, N) { const int n__ = (N) < 255 ? (N) : 255; _Pragma("unroll") for (int it = 0; it < 4; ++it) Z[it] = *(const u32x2*)(Zt + (size_t)n__ * 8192 + uoff + 16 * it); }
#define LD_STAGE(PW, PQ, PK, PQK, NB) { char* nb_ = (NB); \
    _Pragma("unroll") for (int i = 0; i < 4; ++i) { *(u32x4*)(nb_ + l256 + i * 4352) = PW[i]; *(u32x4*)(nb_ + 17408 + l256 + i * 4352) = PQ[i]; *(u32x4*)(nb_ + 34816 + l128 + i * 4608) = PK[i]; } \
    _Pragma("unroll") for (int i = 0; i < 2; ++i) *(u32x4*)(nb_ + 53248 + l128 + i * 4608) = PQK[i]; }
#define LD_FINISH(M, Z) { const int m = (M); const char* so = smem + SCAN_SO + (m & 1) * 8192 + (wl * 4) * 512 + lane * 8; \
    bf16_t* ot = (bf16_t*)(smem + SCAN_OT + (m & 1) * 8192); float* sq = sSS + (m & 1) * 256 + wl * 64; \
    _Pragma("unroll") for (int it = 0; it < 4; ++it) { \
      const u32x2 ob = *(const u32x2*)(so + it * 512); const f32x4 o = {bflo(ob.x), bfhi(ob.x), bflo(ob.y), bfhi(ob.y)}; \
      f32x4 ss = o * o; ss.x = row16_sum(ss.x); ss.y = row16_sum(ss.y); ss.z = row16_sum(ss.z); ss.w = row16_sum(ss.w); \
      const int rl = 16 * it + 4 * q4; \
      if (l15 == 0) *(f32x4*)(sq + rl) = ss; \
      bf16_t* op = ot + rl * 64 + 16 * wl + l15; \
      op[0] = f2bf(o.x * nw * bflo(Z[it].x)); op[64] = f2bf(o.y * nw * bfhi(Z[it].x)); op[128] = f2bf(o.z * nw * bflo(Z[it].y)); op[192] = f2bf(o.w * nw * bfhi(Z[it].y)); } }
#define LD_STEP(PW, PQ, PK, PQK, ZU, N) { const int n_ = (N); \
    LD_STAGE(PW, PQ, PK, PQK, smem + ((n_ + 1) & 1) * SCAN_OPB); \
    LD_LOAD(PW, PQ, PK, PQK, n_ + 3); \
    if (n_ >= 1) LD_FINISH(n_ - 1, ZU); \
    LZ_LOAD(ZU, n_ + 1); \
    __syncthreads(); }
    LD_LOAD(pwA, pqA, pkA, pqkA, 0);
    LD_STAGE(pwA, pqA, pkA, pqkA, smem);
    LD_LOAD(pwA, pqA, pkA, pqkA, 1);
    LD_LOAD(pwB, pqB, pkB, pqkB, 2);
    LZ_LOAD(zB, 0);
    LZ_LOAD(zA, 0);
    __syncthreads();
#pragma unroll 1
    for (int n = 0; n < 256; n += 2) {
      LD_STEP(pwA, pqA, pkA, pqkA, zA, n);
      LD_STEP(pwB, pqB, pkB, pqkB, zB, n + 1);
    }
    LD_FINISH(255, zA);
    __syncthreads();
#undef LD_LOAD
#undef LZ_LOAD
#undef LD_STAGE
#undef LD_FINISH
#undef LD_STEP
  } else {
    const int dvc = 64 * half + 16 * w + l15;
    const int uoff = dvc * 64 + 4 * q4;
    float* ssqp = (float*)(P.ws + OFF_SSQP) + (size_t)(half * 4 + w) * S_ * 8;
    f32x4 St[8];
#pragma unroll
    for (int t = 0; t < 8; ++t) St[t] = (f32x4){0.f, 0.f, 0.f, 0.f};
    u32x2 uc[4], un[4]; float gcur, gn = 0.f;
#pragma unroll
    for (int it = 0; it < 4; ++it) { uc[it] = *(const u32x2*)(Ut + uoff + 16 * it); un[it] = uc[it]; }
    gcur = gt[0];
#define CP_OUT(M) { const int m2 = (M); const char* ot = smem + SCAN_OT + (m2 & 1) * 8192; \
      _Pragma("unroll") for (int i = 0; i < 2; ++i) { const int c = tid + 256 * i, row = c >> 3, cc = c & 7; \
        *(u32x4*)(mixin + (size_t)(64 * m2 + row) * 2048 + hh * 128 + 64 * half + cc * 8) = *(const u32x4*)(ot + row * 128 + cc * 16); } \
      ssqp[(size_t)(64 * m2 + lane) * 8 + hh] = sSS[(m2 & 1) * 256 + w * 64 + lane]; }
    __syncthreads();
#pragma unroll 2
    for (int n = 0; n < 256; ++n) {
      const char* cb = smem + (n & 1) * SCAN_OPB;
      const char* sWp = cb; const char* sQd = cb + 17408; const char* sKt = cb + 34816; const char* sQK = cb + 53248;
      if (n + 1 < 256) { const size_t o8 = (size_t)(n + 1) * 8192;
#pragma unroll
        for (int it = 0; it < 4; ++it) un[it] = *(const u32x2*)(Ut + o8 + uoff + 16 * it);
        gn = gt[n + 1]; }
      bf16x8 sb[4];
#pragma unroll
      for (int ks = 0; ks < 4; ++ks) sb[ks] = pack_tiles(St[2 * ks], St[2 * ks + 1]);
      f32x4 wsv[4], qs[4];
#pragma unroll
      for (int it = 0; it < 4; ++it) { wsv[it] = (f32x4){0.f, 0.f, 0.f, 0.f}; qs[it] = (f32x4){0.f, 0.f, 0.f, 0.f}; }
#pragma unroll
      for (int it = 0; it < 4; ++it)
#pragma unroll
        for (int ks = 0; ks < 4; ++ks) { const int o = (16 * it + l15) * 272 + 64 * ks + 16 * q4;
          const bf16x8 a = *(const bf16x8*)(sWp + o), a2 = *(const bf16x8*)(sQd + o);
          wsv[it] = MFMA16(a, sb[ks], wsv[it]); qs[it] = MFMA16(a2, sb[ks], qs[it]); }
      f32x4 vn[4];
#pragma unroll
      for (int it = 0; it < 4; ++it) { const f32x4 uf = {bflo(uc[it].x), bfhi(uc[it].x), bflo(uc[it].y), bfhi(uc[it].y)}; vn[it] = uf - wsv[it]; }
      bf16x8 vb[2];
#pragma unroll
      for (int ks = 0; ks < 2; ++ks) vb[ks] = pack_tiles(vn[2 * ks], vn[2 * ks + 1]);
#pragma unroll
      for (int it = 0; it < 4; ++it)
#pragma unroll
        for (int ks = 0; ks < 2; ++ks) { const bf16x8 a = *(const bf16x8*)(sQK + (16 * it + l15) * 144 + 64 * ks + 16 * q4); qs[it] = MFMA16(a, vb[ks], qs[it]); }
      { char* so = smem + SCAN_SO + (n & 1) * 8192 + (w * 4) * 512 + lane * 8;
#pragma unroll
        for (int it = 0; it < 4; ++it) { u32x2 ob = {pack2(qs[it].x, qs[it].y), pack2(qs[it].z, qs[it].w)}; *(u32x2*)(so + it * 512) = ob; } }
#pragma unroll
      for (int t = 0; t < 8; ++t) { St[t] *= gcur;
#pragma unroll
        for (int ks = 0; ks < 2; ++ks) { const bf16x8 a = *(const bf16x8*)(sKt + (16 * t + l15) * 144 + 64 * ks + 16 * q4); St[t] = MFMA16(a, vb[ks], St[t]); } }
#pragma unroll
      for (int it = 0; it < 4; ++it) uc[it] = un[it];
      gcur = gn;
      if (n >= 2) CP_OUT(n - 2);
      __syncthreads();
    }
    CP_OUT(254);
    __syncthreads();
    CP_OUT(255);
#undef CP_OUT
  }
  __syncthreads();
}
DI void gdn_fix_phase(const Params& P) {
  const int tid = opaque_tid();
  bf16_t* mixin = (bf16_t*)(P.ws + OFF_H); const float* ssqp = (const float*)(P.ws + OFF_SSQP);
  for (int idx = blockIdx.x * NT + tid; idx < S_ * 128; idx += gridDim.x * NT) {
    const int t = idx >> 7, ck = idx & 127, h = ck >> 4;
    float sq = 0.f;
#pragma unroll
    for (int p = 0; p < 8; ++p) sq += ssqp[((size_t)p * S_ + t) * 8 + h];
    const float r = rsqrtf(sq * (1.f / 128.f) + EPS);
    u32x4* pp = (u32x4*)(mixin + (size_t)t * 2048 + ck * 8); const u32x4 v = *pp; float f[8]; unpack8(v, f);
    u32x4 o = {pack2(f[0] * r, f[1] * r), pack2(f[2] * r, f[3] * r), pack2(f[4] * r, f[5] * r), pack2(f[6] * r, f[7] * r)}; *pp = o;
  }
}

DI void mla_attn_item(const Params& P, int hd, int b, char* smem) {
  const int tid = opaque_tid(), lane = tid & 63, w = tid >> 6, wq = w & 3, hk = w >> 2, lq = lane & 31, h = lane >> 5;
  const float* qraw = (const float*)(P.ws + OFF_QRAW);
  const bf16_t* Kg = (const bf16_t*)(P.ws + OFF_KMLA) + (size_t)hd * S_ * 192;
  const bf16_t* Vg = (const bf16_t*)(P.ws + OFF_VT) + (size_t)hd * 128 * S_;
  bf16_t* mixin = (bf16_t*)(P.ws + OFF_H);
  const int q = 128 * b + 32 * wq + lq;
  bf16x8 qf[12];
  {
    const float* qp = qraw + (size_t)q * 768 + hd * 192 + 8 * h;
    const float sc = 0.07216878364870322f * LOG2E;
#pragma unroll
    for (int s = 0; s < 8; ++s) { const f32x4 a = *(const f32x4*)(qp + 16 * s), c = *(const f32x4*)(qp + 16 * s + 4);
      qf[s] = pack8(a.x * sc, a.y * sc, a.z * sc, a.w * sc, c.x * sc, c.y * sc, c.z * sc, c.w * sc); }
    const double pq = (double)P.pos[q];
#pragma unroll
    for (int s2 = 0; s2 < 2; ++s2) {
      const f32x4 a0 = *(const f32x4*)(qp + 128 + 16 * s2), a1 = *(const f32x4*)(qp + 128 + 16 * s2 + 4);
      const f32x4 b0 = *(const f32x4*)(qp + 160 + 16 * s2), b1 = *(const f32x4*)(qp + 160 + 16 * s2 + 4);
      float x1[8] = {a0.x, a0.y, a0.z, a0.w, a1.x, a1.y, a1.z, a1.w}, x2[8] = {b0.x, b0.y, b0.z, b0.w, b1.x, b1.y, b1.z, b1.w}, o1[8], o2[8];
#pragma unroll
      for (int j = 0; j < 8; ++j) { double fr = pq * kInvFreq2Pi[16 * s2 + 8 * h + j]; fr -= floor(fr); const float ff = (float)fr;
        const float sn = __builtin_amdgcn_sinf(ff), cs = __builtin_amdgcn_cosf(ff);
        o1[j] = (x1[j] * cs - x2[j] * sn) * sc; o2[j] = (x2[j] * cs + x1[j] * sn) * sc; }
      qf[8 + s2] = pack8(o1[0], o1[1], o1[2], o1[3], o1[4], o1[5], o1[6], o1[7]);
      qf[10 + s2] = pack8(o2[0], o2[1], o2[2], o2[3], o2[4], o2[5], o2[6], o2[7]);
    }
  }
  constexpr int KST = 64 * 400, VST = 128 * 144, STG = KST + VST;
  f32x16 O[4];
#pragma unroll
  for (int i = 0; i < 4; ++i)
#pragma unroll
    for (int r = 0; r < 16; ++r) O[i][r] = 0.f;
  float m_i = -1e30f, l_i = 0.f;
  const int nt = 2 * b + 2;
  u32x4 rk0[3], rv0[2], rk1[3], rv1[2];
  const int vrow = tid >> 3, vcc = tid & 7;
  const int ntl = nt - 1;
#define AT_LOAD(RK, RV, T) { const size_t ko_ = (size_t)(T) * 64 * 192; const int vo_ = (T) * 64; \
    _Pragma("unroll") for (int i = 0; i < 3; ++i) { const int id = tid + NT * i, row = id / 24, cc = id % 24; RK[i] = *(const u32x4*)(Kg + ko_ + row * 192 + cc * 8); } \
    _Pragma("unroll") for (int i = 0; i < 2; ++i) RV[i] = *(const u32x4*)(Vg + (size_t)(vrow + 64 * i) * S_ + vo_ + vcc * 8); }
#define AT_WRITE(RK, RV, ST) { char* dK = smem + (ST) * STG; \
    _Pragma("unroll") for (int i = 0; i < 3; ++i) { const int id = tid + NT * i, row = id / 24, cc = id % 24; *(u32x4*)(dK + row * 400 + cc * 16) = RK[i]; } \
    _Pragma("unroll") for (int i = 0; i < 2; ++i) *(u32x4*)(dK + KST + (vrow + 64 * i) * 144 + vcc * 16) = RV[i]; }
#define AT_COMPUTE(ST, KT) { const char* sK = smem + (ST) * STG; const char* sV = sK + KST; const int key0 = 64 * (KT) + 32 * hk; \
    if (key0 <= 128 * b + 32 * wq) { \
      f32x16 st; _Pragma("unroll") for (int r = 0; r < 16; ++r) st[r] = 0.f; \
      __builtin_amdgcn_s_setprio(1); \
      _Pragma("unroll") for (int s = 0; s < 12; ++s) { const bf16x8 kf = *(const bf16x8*)(sK + (32 * hk + lq) * 400 + (2 * s + h) * 16); st = MFMA32(kf, qf[s], st); } \
      __builtin_amdgcn_s_setprio(0); \
      if (key0 + 31 > 128 * b + 32 * wq) { int qrel = q - key0 - 4 * h; asm volatile("" : "+v"(qrel)); \
        _Pragma("unroll") for (int r = 0; r < 16; ++r) if ((r & 3) + 8 * (r >> 2) > qrel) st[r] = -1e30f; } \
      float mx = st[0]; _Pragma("unroll") for (int r = 1; r < 16; ++r) mx = fmaxf(mx, st[r]); \
      mx = xhalf_max(mx); \
      const float m_new = fmaxf(m_i, mx), alpha = __builtin_amdgcn_exp2f(m_i - m_new); float ps = 0.f; \
      _Pragma("unroll") for (int r = 0; r < 16; ++r) { st[r] = __builtin_amdgcn_exp2f(st[r] - m_new); ps += st[r]; } \
      l_i = l_i * alpha + ps; \
      if (__any(m_new != m_i)) { _Pragma("unroll") for (int i = 0; i < 4; ++i) _Pragma("unroll") for (int r = 0; r < 16; ++r) O[i][r] *= alpha; } \
      m_i = m_new; \
      bf16x8 pf[2]; \
      _Pragma("unroll") for (int s = 0; s < 2; ++s) pf[s] = pack8(st[8 * s], st[8 * s + 1], st[8 * s + 2], st[8 * s + 3], st[8 * s + 4], st[8 * s + 5], st[8 * s + 6], st[8 * s + 7]); \
      __builtin_amdgcn_s_setprio(1); \
      _Pragma("unroll") for (int i = 0; i < 4; ++i) _Pragma("unroll") for (int s = 0; s < 2; ++s) { const char* vp = sV + (32 * i + lq) * 144 + (32 * hk + 16 * s + 4 * h) * 2; \
          const u32x2 lo = *(const u32x2*)vp, hi = *(const u32x2*)(vp + 16); u32x4 vv = {lo.x, lo.y, hi.x, hi.y}; \
          O[i] = MFMA32(__builtin_bit_cast(bf16x8, vv), pf[s], O[i]); } \
      __builtin_amdgcn_s_setprio(0); } }
  AT_LOAD(rk0, rv0, 0);
  AT_LOAD(rk1, rv1, 1);
  AT_WRITE(rk0, rv0, 0);
  AT_LOAD(rk0, rv0, (2 < ntl ? 2 : ntl));
  __syncthreads();
  for (int kt = 0; kt < nt; kt += 2) {
    AT_WRITE(rk1, rv1, 1);
    AT_LOAD(rk1, rv1, (kt + 3 < ntl ? kt + 3 : ntl));
    AT_COMPUTE(0, kt);
    __syncthreads();
    AT_WRITE(rk0, rv0, 0);
    AT_LOAD(rk0, rv0, (kt + 4 < ntl ? kt + 4 : ntl));
    AT_COMPUTE(1, kt + 1);
    __syncthreads();
  }
#undef AT_LOAD
#undef AT_WRITE
#undef AT_COMPUTE
  float* cO = (float*)smem; float* cm = cO + 4 * 4096; float* cl = cm + 256;
  if (hk == 1) {
#pragma unroll
    for (int i = 0; i < 4; ++i)
#pragma unroll
      for (int r = 0; r < 16; ++r) cO[wq * 4096 + (i * 16 + r) * 64 + lane] = O[i][r];
    cm[wq * 64 + lane] = m_i; cl[wq * 64 + lane] = l_i;
  }
  __syncthreads();
  if (hk == 0) {
    const float m1 = cm[wq * 64 + lane], l1 = cl[wq * 64 + lane];
    const float m = fmaxf(m_i, m1), a0 = exp2f(m_i - m), a1 = exp2f(m1 - m);
    float lt = l_i * a0 + l1 * a1; lt += __shfl_xor(lt, 32);
    const float inv = 1.f / lt;
    bf16_t* op = mixin + (size_t)q * 2048 + 1024 + hd * 128;
#pragma unroll
    for (int i = 0; i < 4; ++i)
#pragma unroll
      for (int rg = 0; rg < 4; ++rg) { float v[4];
#pragma unroll
        for (int e = 0; e < 4; ++e) v[e] = (O[i][4 * rg + e] * a0 + cO[wq * 4096 + (i * 16 + 4 * rg + e) * 64 + lane] * a1) * inv;
        u32x2 pk = {pack2(v[0], v[1]), pack2(v[2], v[3])}; *(u32x2*)(op + 32 * i + 8 * rg + 4 * h) = pk; }
  }
  __syncthreads();
}

DI void swa_item(const Params& P, int l, int n, int hk2, char* smem) {
  const int tid = opaque_tid(), lane = tid & 63, w = tid >> 6, lq = lane & 31, h = lane >> 5;
  const bf16_t* proj = (const bf16_t*)(P.ws + OFF_PROJ); bf16_t* mixin = (bf16_t*)(P.ws + OFF_H);
  bf16_t* sVt = (bf16_t*)smem;
#pragma unroll
  for (int i = 0; i < 4; ++i) { const int id = tid + NT * i, key = id >> 3, dc = id & 7; const int kp = 128 * (n - 1) + key;
    u32x4 v = {0u, 0u, 0u, 0u}; if (kp >= 0) v = *(const u32x4*)(proj + (size_t)kp * DINP + C_CV + hk2 * 64 + dc * 8);
    sVt[(8 * dc + 0) * 264 + key] = (bf16_t)(v.x & 0xffff); sVt[(8 * dc + 1) * 264 + key] = (bf16_t)(v.x >> 16);
    sVt[(8 * dc + 2) * 264 + key] = (bf16_t)(v.y & 0xffff); sVt[(8 * dc + 3) * 264 + key] = (bf16_t)(v.y >> 16);
    sVt[(8 * dc + 4) * 264 + key] = (bf16_t)(v.z & 0xffff); sVt[(8 * dc + 5) * 264 + key] = (bf16_t)(v.z >> 16);
    sVt[(8 * dc + 6) * 264 + key] = (bf16_t)(v.w & 0xffff); sVt[(8 * dc + 7) * 264 + key] = (bf16_t)(v.w >> 16); }
  __syncthreads();
  const int g = w >> 1, hq = hk2 * 4 + g;
  const float slope = exp2f(-(float)(hq + 1)) * LOG2E, sinkv = P.swa_sinks[l * 8 + hq] * LOG2E;
#pragma unroll 1
  for (int jj = 0; jj < 2; ++jj) {
    const int j = 2 * (w & 1) + jj; const int qrow = 128 * n + 32 * j + lq;
    bf16x8 qf[4];
#pragma unroll
    for (int s = 0; s < 4; ++s) qf[s] = *(const bf16x8*)(proj + (size_t)qrow * DINP + C_CQ + hq * 64 + 16 * s + 8 * h);
    f32x16 st[5];
    bf16x8 kf[2][4];
    { const int kp = 128 * (n - 1) + 32 * j + lq;
#pragma unroll
      for (int s = 0; s < 4; ++s) { kf[0][s] = (bf16x8){0, 0, 0, 0, 0, 0, 0, 0}; if (kp >= 0) kf[0][s] = *(const bf16x8*)(proj + (size_t)kp * DINP + C_CK + hk2 * 64 + 16 * s + 8 * h); } }
#pragma unroll
    for (int tt = 0; tt < 5; ++tt) {
      if (tt + 1 < 5) { const int kp = 128 * (n - 1) + 32 * (j + tt + 1) + lq;
#pragma unroll
        for (int s = 0; s < 4; ++s) { kf[(tt + 1) & 1][s] = (bf16x8){0, 0, 0, 0, 0, 0, 0, 0}; if (kp >= 0) kf[(tt + 1) & 1][s] = *(const bf16x8*)(proj + (size_t)kp * DINP + C_CK + hk2 * 64 + 16 * s + 8 * h); } }
      __builtin_amdgcn_sched_barrier(0);
#pragma unroll
      for (int r = 0; r < 16; ++r) st[tt][r] = 0.f;
#pragma unroll
      for (int s = 0; s < 4; ++s) st[tt] = MFMA32(kf[tt & 1][s], qf[s], st[tt]);
      __builtin_amdgcn_sched_barrier(0);
    }
    float mx = sinkv;
    int dbase = 128 + lq - 4 * h, kbase = 128 * (n - 1) + 32 * j + 4 * h;
    asm volatile("" : "+v"(dbase), "+v"(kbase));
#pragma unroll
    for (int tt = 0; tt < 5; ++tt)
#pragma unroll
      for (int r = 0; r < 16; ++r) { const int cst = 32 * tt + (r & 3) + 8 * (r >> 2); const int dist = dbase - cst; const int kpos = kbase + cst;
        const bool valid = (dist >= 0) && (dist < 128) && (kpos >= 0);
        const float sv = valid ? st[tt][r] * (0.125f * LOG2E) - slope * (float)dist : -1e30f; st[tt][r] = sv; mx = fmaxf(mx, sv); }
    mx = fmaxf(mx, __shfl_xor(mx, 32));
    float den = 0.f;
#pragma unroll
    for (int tt = 0; tt < 5; ++tt)
#pragma unroll
      for (int r = 0; r < 16; ++r) { const float p = exp2f(st[tt][r] - mx); st[tt][r] = p; den += p; }
    den += __shfl_xor(den, 32); den += exp2f(sinkv - mx);
    f32x16 O[2];
#pragma unroll
    for (int i = 0; i < 2; ++i)
#pragma unroll
      for (int r = 0; r < 16; ++r) O[i][r] = 0.f;
#pragma unroll
    for (int tt = 0; tt < 5; ++tt)
#pragma unroll
      for (int s = 0; s < 2; ++s) { const bf16x8 pf = pack8(st[tt][8 * s], st[tt][8 * s + 1], st[tt][8 * s + 2], st[tt][8 * s + 3], st[tt][8 * s + 4], st[tt][8 * s + 5], st[tt][8 * s + 6], st[tt][8 * s + 7]);
#pragma unroll
        for (int i = 0; i < 2; ++i) { const char* vp = (const char*)sVt + (32 * i + lq) * 528 + (32 * (j + tt) + 16 * s + 4 * h) * 2;
          const u32x2 lo = *(const u32x2*)vp, hi = *(const u32x2*)(vp + 16); u32x4 vv = {lo.x, lo.y, hi.x, hi.y};
          O[i] = MFMA32(__builtin_bit_cast(bf16x8, vv), pf, O[i]); }
        __builtin_amdgcn_sched_barrier(0); }
    const float inv = 1.f / den;
    bf16_t* op = mixin + (size_t)qrow * 2048 + 1536 + hq * 64;
#pragma unroll
    for (int i = 0; i < 2; ++i)
#pragma unroll
      for (int rg = 0; rg < 4; ++rg) { u32x2 pk = {pack2(O[i][4 * rg] * inv, O[i][4 * rg + 1] * inv), pack2(O[i][4 * rg + 2] * inv, O[i][4 * rg + 3] * inv)};
        *(u32x2*)(op + 32 * i + 8 * rg + 4 * h) = pk; }
  }
  __syncthreads();
}

DI float gelu_tanh(float x) { const float y = 0.7978845608028654f * (x + 0.044715f * x * x * x); const float t = 1.f - 2.f * __builtin_amdgcn_rcpf(1.f + __expf(2.f * y)); return 0.5f * x * (1.f + t); }
DI void ffn_act_phase(const Params& P, int l) {
  const int tid = opaque_tid(), lane = tid & 63, w = tid >> 6;
  const bf16_t* u = (const bf16_t*)(P.ws + OFF_BIG); bf16_t* act = (bf16_t*)(P.ws + OFF_ACT);
  const float* cw = P.ffn_conv + (size_t)l * 3 * DFF2; const float* cb = P.ffn_conv_b + (size_t)l * DFF2;
  for (int item = blockIdx.x * 8 + w; item < 512 * 11; item += gridDim.x * 8) {
    const int cbk = item % 11, rr = item / 11; const int ch = cbk * 512 + lane * 8, r0 = rr * 32;
    float wg[3][8], wu[3][8], bg[8], bu[8];
#pragma unroll
    for (int j = 0; j < 3; ++j)
#pragma unroll
      for (int e4 = 0; e4 < 2; ++e4) { const f32x4 a = *(const f32x4*)(cw + (size_t)j * DFF2 + ch + 4 * e4), b = *(const f32x4*)(cw + (size_t)j * DFF2 + DFF + ch + 4 * e4);
        wg[j][4 * e4] = a.x; wg[j][4 * e4 + 1] = a.y; wg[j][4 * e4 + 2] = a.z; wg[j][4 * e4 + 3] = a.w; wu[j][4 * e4] = b.x; wu[j][4 * e4 + 1] = b.y; wu[j][4 * e4 + 2] = b.z; wu[j][4 * e4 + 3] = b.w; }
#pragma unroll
    for (int e4 = 0; e4 < 2; ++e4) { const f32x4 a = *(const f32x4*)(cb + ch + 4 * e4), b = *(const f32x4*)(cb + DFF + ch + 4 * e4);
      bg[4 * e4] = a.x; bg[4 * e4 + 1] = a.y; bg[4 * e4 + 2] = a.z; bg[4 * e4 + 3] = a.w; bu[4 * e4] = b.x; bu[4 * e4 + 1] = b.y; bu[4 * e4 + 2] = b.z; bu[4 * e4 + 3] = b.w; }
    float g2[8], g1[8], u2[8], u1[8];
#pragma unroll
    for (int e = 0; e < 8; ++e) { g2[e] = 0.f; g1[e] = 0.f; u2[e] = 0.f; u1[e] = 0.f; }
    if (r0 >= 2) { unpack8(*(const u32x4*)(u + (size_t)(r0 - 2) * DFF2 + ch), g2); unpack8(*(const u32x4*)(u + (size_t)(r0 - 2) * DFF2 + DFF + ch), u2);
      unpack8(*(const u32x4*)(u + (size_t)(r0 - 1) * DFF2 + ch), g1); unpack8(*(const u32x4*)(u + (size_t)(r0 - 1) * DFF2 + DFF + ch), u1); }
#pragma unroll 1
    for (int rb = 0; rb < 4; ++rb) {
      u32x4 G[8], U[8];
#pragma unroll
      for (int i = 0; i < 8; ++i) { const size_t ro = (size_t)(r0 + rb * 8 + i) * DFF2 + ch; G[i] = __builtin_nontemporal_load((const u32x4*)(u + ro)); U[i] = __builtin_nontemporal_load((const u32x4*)(u + ro + DFF)); }
#pragma unroll
      for (int i = 0; i < 8; ++i) {
        float g0[8], u0[8]; unpack8(G[i], g0); unpack8(U[i], u0);
        float o[8];
#pragma unroll
        for (int e = 0; e < 8; ++e) { const float yg = wg[0][e] * g2[e] + wg[1][e] * g1[e] + wg[2][e] * g0[e] + bg[e]; const float yu = wu[0][e] * u2[e] + wu[1][e] * u1[e] + wu[2][e] * u0[e] + bu[e];
          o[e] = gelu_tanh(yg) * yu; g2[e] = g1[e]; g1[e] = g0[e]; u2[e] = u1[e]; u1[e] = u0[e]; }
        u32x4 pk = {pack2(o[0], o[1]), pack2(o[2], o[3]), pack2(o[4], o[5]), pack2(o[6], o[7])};
        *(u32x4*)(act + (size_t)(r0 + rb * 8 + i) * DFF + ch) = pk;
      }
    }
  }
}

#define XB_TMO      128
#define XB_XCNT(j)  (256  + 64 * (j))
#define XB_XSUB(j)  (1280 + 64 * (j))
#define XB_XGEN(j)  (2304 + 64 * (j))
#define XB_TOP      3328
#define XB_TOPGEN   3392
#define XCD_BAR_WORDS 3456
#define XB_SPIN_CAP (1u << 18)
#define LAS __attribute__((address_space(3)))
DI unsigned xb_ld(unsigned* p)              { return __hip_atomic_load(p, __ATOMIC_RELAXED, __HIP_MEMORY_SCOPE_AGENT); }
DI unsigned xb_add(unsigned* p, unsigned v) { return __hip_atomic_fetch_add(p, v, __ATOMIC_RELAXED, __HIP_MEMORY_SCOPE_AGENT); }
DI unsigned xb_xcc_id() { return (unsigned)__builtin_amdgcn_s_getreg((3 << 11) | 20) & 0xFu; }
#define XB_SPIN(cond, bar) do { unsigned _sp = 0; while (cond) { __builtin_amdgcn_s_sleep(1); \
    if ((++_sp & 255u) == 0u) { if (xb_ld(&(bar)[XB_TMO])) break; if (_sp > XB_SPIN_CAP) { atomicAdd(&(bar)[XB_TMO], 1u); break; } } } } while (0)
struct XcdBarrier { unsigned* bar; unsigned x; volatile LAS unsigned* st; };
DI XcdBarrier xcd_barrier_post(unsigned* bar, volatile LAS unsigned* st) {
  XcdBarrier b; b.bar = bar; b.x = xb_xcc_id(); b.st = st;
  if (threadIdx.x == 0) (void)xb_add(&bar[XB_XCNT(b.x)], 1u);
  return b;
}
DI void xcd_barrier_complete(unsigned* bar, unsigned x, unsigned& nloc, unsigned& nx) {
  const unsigned G = gridDim.x * gridDim.y * gridDim.z;
  unsigned sum, cnt, mine, sp = 0u;
  for (;;) {
    sum = 0u; cnt = 0u; mine = 0u;
#pragma unroll
    for (unsigned j = 0; j < 16; ++j) { const unsigned c = xb_ld(&bar[XB_XCNT(j)]); sum += c; cnt += (c > 0u) ? 1u : 0u; mine = (j == x) ? c : mine; }
    if (sum == G) break;
    __builtin_amdgcn_s_sleep(1);
    if ((++sp & 255u) == 0u) { if (xb_ld(&bar[XB_TMO])) break; if (sp > XB_SPIN_CAP) { atomicAdd(&bar[XB_TMO], 1u); break; } }
  }
  nloc = mine > 0u ? mine : 1u; nx = cnt > 0u ? cnt : 1u;
}
DI void xcd_barrier(char* ws_, char* smem_) {
  XcdBarrier b; b.bar = (unsigned*)(ws_ + OFF_XBAR); b.x = xb_xcc_id(); b.st = (volatile LAS unsigned*)(smem_ + 159760);
  asm volatile("s_waitcnt vmcnt(0)" ::: "memory");
  __syncthreads();
  if (threadIdx.x == 0) {
    unsigned* bar = b.bar;
    __builtin_amdgcn_s_waitcnt(0);
    unsigned nloc = b.st[0], nx = b.st[1];
    if (nloc == 0u) { xcd_barrier_complete(bar, b.x, nloc, nx); b.st[0] = nloc; b.st[1] = nx; }
    const unsigned old = xb_add(&bar[XB_XSUB(b.x)], 1u);
    const unsigned gen = old / nloc;
    if (old + 1u == (gen + 1u) * nloc) {
      __builtin_amdgcn_fence(__ATOMIC_RELEASE, "agent");
      asm volatile("s_waitcnt vmcnt(0)" ::: "memory");
      const unsigned og = xb_add(&bar[XB_TOP], 1u);
      const unsigned tg = og / nx;
      if (og + 1u == (tg + 1u) * nx) xb_add(&bar[XB_TOPGEN], 1u);
      else XB_SPIN(xb_ld(&bar[XB_TOPGEN]) == tg, bar);
      __builtin_amdgcn_fence(__ATOMIC_ACQUIRE, "agent");
      xb_add(&bar[XB_XGEN(b.x)], 1u);
      asm volatile("s_waitcnt vmcnt(0)" ::: "memory");
    } else {
      XB_SPIN(xb_ld(&bar[XB_XGEN(b.x)]) == gen, bar);
      __builtin_amdgcn_fence(__ATOMIC_ACQUIRE, "agent");
      asm volatile("s_waitcnt vmcnt(0)" ::: "memory");
    }
  }
  __syncthreads();
}

__global__ void __launch_bounds__(NT) fwd_megakernel(Params P0) {
  cg::grid_group grid = cg::this_grid();
  __shared__ __attribute__((aligned(16))) char smem[160512];
  const int tid = threadIdx.x;
  char* ws = P0.ws;
  int* ctrl = (int*)(ws + OFF_CTRL);
  if (blockIdx.x == 0 && tid < 64) ctrl[tid] = 0;
  if (blockIdx.x == 0) for (int i = tid; i < XCD_BAR_WORDS; i += NT) ((unsigned*)(ws + OFF_XBAR))[i] = 0u;
  if (tid < 4) ((unsigned*)(smem + 159760))[tid] = 0u;
  if (blockIdx.x == 0 && tid == 0) *(Params*)(ws + OFF_CTRL + 1024) = P0;
  bf16_t* Hb = (bf16_t*)(ws + OFF_H);
  for (int it = blockIdx.x; it < 192 + CV_T5; it += gridDim.x) { if (it < 192) mod_item(P0, it); else convert_item(P0, 0, it - 192, smem); }
  grid.sync();
  (void)xcd_barrier_post((unsigned*)(ws + OFF_XBAR), (volatile LAS unsigned*)(smem + 159760));
  const Params& P = *(const Params*)(ws + OFF_CTRL + 1024);
  rownorm_phase(P, P.x, nullptr, P.out, Hb, 0, 0, nullptr, 0, 1, 0, P.mix_pre, smem);
  xcd_barrier(ws, smem);
  for (int l = 0; l < 2; ++l) {
    { EpiProj epi{(bf16_t*)(ws + OFF_PROJ), (float*)(ws + OFF_AB)}; gemm_phase(Hb, 2048, (const bf16_t*)(ws + OFF_W + W_IN), 2048, 2048, 64, 22, smem, epi); }
    xcd_barrier(ws, smem);
    for (int it = blockIdx.x; it < 448; it += gridDim.x) {
      if (it < 192) mla_q_tile(P, it / 3, it % 3, smem);
      else mla_kv_tile(P, (it - 192) >> 2, (it - 192) & 3, smem);
    }
    for (int id = (blockIdx.x + 64) % gridDim.x; id < 2048; id += gridDim.x) gdn_prep_item(P, l, id >> 3, id & 7, smem);
    xcd_barrier(ws, smem);
    {
      int* sitem = (int*)(smem + 159744);
      for (;;) {
        if (tid == 0) *sitem = atomicAdd(ctrl + 16 * l, 1);
        __syncthreads(); const int item = *sitem; __syncthreads();
        if (item >= 16 + 512 + 256) break;
        if (item < 16) gdn_scan_item(P, l, item >> 1, item & 1, smem);
        else if (item < 528) { const int idx = item - 16; mla_attn_item(P, idx & 3, 127 - (idx >> 2), smem); }
        else { const int idx = item - 528; swa_item(P, l, idx >> 1, idx & 1, smem); }
      }
    }
    xcd_barrier(ws, smem);
    gdn_fix_phase(P);
    xcd_barrier(ws, smem);
    { EpiBf epi{(bf16_t*)(ws + OFF_MIXF), 2048}; gemm_phase(Hb, 2048, (const bf16_t*)(ws + OFF_W + W_OUT), 2048, 2048, 64, 8, smem, epi); }
    xcd_barrier(ws, smem);
    rownorm_phase(P, P.out, (const bf16_t*)(ws + OFF_MIXF), P.out, Hb, l, 2, P.mix_post + l * 2048, l, 4, 3, P.ffn_pre + l * 2048, smem);
    xcd_barrier(ws, smem);
    { EpiBf epi{(bf16_t*)(ws + OFF_BIG), DFF2}; gemm_phase(Hb, 2048, (const bf16_t*)(ws + OFF_W + W_UP), 2048, 2048, 64, 44, smem, epi); }
    xcd_barrier(ws, smem);
    ffn_act_phase(P, l);
    xcd_barrier(ws, smem);
    { EpiBf epi{(bf16_t*)(ws + OFF_Y), 2048}; gemm_phase((const bf16_t*)(ws + OFF_ACT), DFF, (const bf16_t*)(ws + OFF_W + W_DOWN), DFF, DFF, 64, 8, smem, epi); }
    xcd_barrier(ws, smem);
    if (l == 0) {
      for (int it = blockIdx.x; it < CV_T5; it += gridDim.x) convert_item(P, 1, it, smem);
      rownorm_phase(P, P.out, (const bf16_t*)(ws + OFF_Y), P.out, Hb, 0, 5, P.ffn_post, 1, 1, 0, P.mix_pre + 2048, smem);
      xcd_barrier(ws, smem);
    } else {
      rownorm_phase(P, P.out, (const bf16_t*)(ws + OFF_Y), P.out, nullptr, 1, 5, P.ffn_post + 2048, 1, 1, 0, nullptr, smem);
    }
  }
}

extern "C" void kernel_launch(void* const* d_in, const int* in_sizes, int n_in, void* d_out, int out_size, void* d_ws, size_t ws_size, hipStream_t stream) {
  static int grid_blocks = 0;
  if (!grid_blocks) {
    int dev = 0, cus = 0, per = 0;
    (void)hipGetDevice(&dev); (void)hipDeviceGetAttribute(&cus, hipDeviceAttributeMultiprocessorCount, dev);
    (void)hipOccupancyMaxActiveBlocksPerMultiprocessor(&per, fwd_megakernel, NT, 0);
    if (per > 1) per = 1;
    grid_blocks = cus * per; if (grid_blocks <= 0) grid_blocks = 256;
  }
  if (ws_size < OFF_END) { fprintf(stderr, "workspace too small: %zu < %zu\n", ws_size, (size_t)OFF_END); return; }
  Params p{};
  p.x = (const float*)d_in[0]; p.c = (const float*)d_in[1]; p.pos = (const int*)d_in[2];
  p.ada_w = (const float*)d_in[3]; p.ada_b = (const float*)d_in[4]; p.mix_pre = (const float*)d_in[5]; p.mix_post = (const float*)d_in[6];
  p.w_in = (const float*)d_in[7]; p.w_out = (const float*)d_in[8]; p.gdn_conv = (const float*)d_in[9]; p.gdn_a_log = (const float*)d_in[10];
  p.gdn_dt_bias = (const float*)d_in[11]; p.gdn_norm = (const float*)d_in[12]; p.mla_q_norm = (const float*)d_in[13]; p.mla_w_uq = (const float*)d_in[14];
  p.mla_kv_norm = (const float*)d_in[15]; p.mla_w_ukv = (const float*)d_in[16]; p.swa_sinks = (const float*)d_in[17]; p.ffn_pre = (const float*)d_in[18];
  p.ffn_post = (const float*)d_in[19]; p.ffn_w_up = (const float*)d_in[20]; p.ffn_conv = (const float*)d_in[21]; p.ffn_conv_b = (const float*)d_in[22];
  p.ffn_w_down = (const float*)d_in[23];
  p.out = (float*)d_out; p.ws = (char*)d_ws;
  void* args[] = {&p};
  hipError_t e = hipLaunchCooperativeKernel((void*)fwd_megakernel, dim3(grid_blocks), dim3(NT), args, 0, stream);
  if (e != hipSuccess) fprintf(stderr, "cooperative launch failed: %s (grid %d)\n", hipGetErrorString(e), grid_blocks);
}
```

```cpp
#include <hip/hip_runtime.h>
#include <hip/hip_cooperative_groups.h>
#include <cstdio>
#include <cstdint>
namespace cg = cooperative_groups;

#define DI __device__ __forceinline__
typedef unsigned short bf16_t;
typedef short bf16x8 __attribute__((ext_vector_type(8)));
typedef float f32x2 __attribute__((ext_vector_type(2)));
typedef float f32x4 __attribute__((ext_vector_type(4)));
typedef float f32x16 __attribute__((ext_vector_type(16)));
typedef unsigned u32x2 __attribute__((ext_vector_type(2)));
typedef unsigned u32x4 __attribute__((ext_vector_type(4)));
typedef __bf16 bf2_t __attribute__((ext_vector_type(2)));

constexpr int S_ = 16384, D_ = 2048, DINP = 5632, DFF = 5632, DFF2 = 11264;
constexpr int NT = 512;
constexpr float EPS = 1e-6f;
constexpr float LOG2E = 1.4426950408889634f;

constexpr size_t OFF_CTRL = 0;
constexpr size_t OFF_MODP = 4096;
constexpr size_t OFF_XBAR = OFF_MODP + (size_t)2 * 16 * 12288 * 4;
constexpr size_t OFF_W = 2097152;
static_assert(OFF_XBAR + 3456 * 4 <= OFF_W, "xbar");
constexpr size_t W_IN = 0, W_OUT = W_IN + (size_t)5632 * 2048 * 2, W_UP = W_OUT + (size_t)2048 * 2048 * 2,
                 W_DOWN = W_UP + (size_t)11264 * 2048 * 2, W_UQ = W_DOWN + (size_t)2048 * 5632 * 2,
                 W_UKV = W_UQ + (size_t)768 * 448 * 2, W_END = W_UKV + (size_t)1024 * 128 * 2;
constexpr size_t OFF_H = OFF_W + W_END;
constexpr size_t OFF_MIXF = OFF_H + (size_t)S_ * 2048 * 2;
constexpr size_t OFF_QRAW = OFF_MIXF;
constexpr size_t OFF_KMLA = OFF_QRAW + (size_t)S_ * 768 * 4;
constexpr size_t OFF_VT = OFF_KMLA + (size_t)4 * S_ * 192 * 2;
constexpr size_t OFF_BIG = OFF_MIXF + (size_t)S_ * 2048 * 4;
constexpr size_t OFF_PROJ = OFF_BIG;
constexpr size_t OFF_WP = OFF_PROJ + (size_t)S_ * DINP * 2;
constexpr size_t OFF_QD = OFF_WP + (size_t)S_ * 1024 * 2;
constexpr size_t OFF_KT = OFF_QD + (size_t)S_ * 1024 * 2;
constexpr size_t OFF_ZT = OFF_KT + (size_t)S_ * 1024 * 2;
constexpr size_t OFF_QK = OFF_ZT + (size_t)S_ * 1024 * 2;
constexpr size_t OFF_AB = OFF_QK + (size_t)S_ * 512 * 2;
constexpr size_t OFF_GTOT = OFF_AB + (size_t)S_ * 16 * 4;
constexpr size_t OFF_Y = OFF_BIG;
constexpr size_t OFF_ACT = OFF_H;
constexpr size_t OFF_UT = OFF_BIG + (size_t)S_ * DFF2 * 2;
constexpr size_t OFF_END = OFF_UT + (size_t)S_ * 1024 * 4;
static_assert(OFF_GTOT + 8192 <= OFF_UT, "overlay");
static_assert(OFF_VT + (size_t)4 * 128 * S_ * 2 <= OFF_BIG, "overlay2");

constexpr int C_AQ = 0, C_AK = 1024, C_AV = 2048, C_AZ = 3072, C_AA = 4096, C_BCQ = 4112, C_BCKV = 4560,
              C_BKR = 4688, C_CQ = 4752, C_CK = 5264, C_CV = 5392;

__constant__ double kInvFreq2Pi[32] = {
    0.15915494309189535, 0.11934937021124886, 0.08949940160889101, 0.06711508300522726, 0.050329212104487035, 0.03774158471741977,
    0.0283021958306234, 0.02122365276477766, 0.015915494309189534, 0.011934937021124886, 0.008949940160889102, 0.006711508300522725,
    0.005032921210448704, 0.003774158471741977, 0.00283021958306234, 0.0021223652764777662, 0.0015915494309189536, 0.0011934937021124885,
    0.0008949940160889102, 0.0006711508300522726, 0.0005032921210448703, 0.00037741584717419774, 0.00028302195830623395, 0.0002122365276477766,
    0.00015915494309189535, 0.00011934937021124886, 8.949940160889102e-05, 6.711508300522725e-05, 5.0329212104487035e-05, 3.774158471741978e-05,
    2.8302195830623396e-05, 2.122365276477766e-05};

struct Params {
  const float* x; const float* c; const int* pos;
  const float *ada_w, *ada_b, *mix_pre, *mix_post, *w_in, *w_out, *gdn_conv, *gdn_a_log, *gdn_dt_bias, *gdn_norm, *mla_q_norm, *mla_w_uq,
      *mla_kv_norm, *mla_w_ukv, *swa_sinks, *ffn_pre, *ffn_post, *ffn_w_up, *ffn_conv, *ffn_conv_b, *ffn_w_down;
  float* out; char* ws;
};

DI unsigned pack2(float lo, float hi) { f32x2 v = {lo, hi}; bf2_t b = __builtin_convertvector(v, bf2_t); return __builtin_bit_cast(unsigned, b); }
DI bf16_t f2bf(float x) { return (bf16_t)(pack2(x, 0.f) & 0xffffu); }
DI float bflo(unsigned u) { return __uint_as_float(u << 16); }
DI float bfhi(unsigned u) { return __uint_as_float(u & 0xffff0000u); }
DI void unpack8(const u32x4& v, float* f) { f[0] = bflo(v.x); f[1] = bfhi(v.x); f[2] = bflo(v.y); f[3] = bfhi(v.y); f[4] = bflo(v.z); f[5] = bfhi(v.z); f[6] = bflo(v.w); f[7] = bfhi(v.w); }
DI bf16x8 pack8(float a0, float a1, float a2, float a3, float a4, float a5, float a6, float a7) {
  u32x4 p = {pack2(a0, a1), pack2(a2, a3), pack2(a4, a5), pack2(a6, a7)}; return __builtin_bit_cast(bf16x8, p); }
DI float silu_f(float x) { return x * __builtin_amdgcn_rcpf(1.f + __expf(-x)); }
DI float wave_sum(float v) { v += __shfl_xor(v, 32); v += __shfl_xor(v, 16); v += __shfl_xor(v, 8); v += __shfl_xor(v, 4); v += __shfl_xor(v, 2); v += __shfl_xor(v, 1); return v; }
DI int opaque_tid() { int t = threadIdx.x; asm volatile("" : "+v"(t)); return t; }
DI float xhalf_max(float v) { const auto r = __builtin_amdgcn_permlane32_swap(__float_as_uint(v), __float_as_uint(v), false, false); return fmaxf(__uint_as_float(r[0]), __uint_as_float(r[1])); }
DI int crow(int r, int h) { return (r & 3) + 8 * (r >> 2) + 4 * h; }
DI int perm32(int k) { return 8 * ((k >> 2) & 3) + 4 * (k >> 4) + (k & 3); }
#define MFMA32(a, b, c) __builtin_amdgcn_mfma_f32_32x32x16_bf16((a), (b), (c), 0, 0, 0)
#define MFMA16(a, b, c) __builtin_amdgcn_mfma_f32_16x16x32_bf16((a), (b), (c), 0, 0, 0)

template <class Epi>
DI void gemm_tile(const bf16_t* __restrict__ A, int lda, const bf16_t* __restrict__ Bt, int ldb, int K, int m0, int n0, char* smem, const Epi& epi) {
  const int tid = opaque_tid(), lane = tid & 63, w = tid >> 6, wm = w >> 2, wn = w & 3, lq = lane & 31, h = lane >> 5;
  f32x16 acc[2][4];
#pragma unroll
  for (int i = 0; i < 2; ++i)
#pragma unroll
    for (int j = 0; j < 4; ++j)
#pragma unroll
      for (int r = 0; r < 16; ++r) acc[i][j][r] = 0.f;
  const int r0 = tid >> 3, c0 = tid & 7;
  const bf16_t* ag = A + (size_t)(m0 + r0) * lda + c0 * 8;
  const bf16_t* bg = Bt + (size_t)(n0 + r0) * ldb + c0 * 8;
  const int wofs = r0 * 128 + ((c0 ^ ((r0 >> 1) & 7)) << 4);
  char* sA = smem; char* sB = smem + 65536;
  u32x4 ra0[4], rb0[4], ra1[4], rb1[4];
  const int nk = K >> 6, swz = (lane >> 1) & 7;
  const int aoff = (64 * wn + lq) * 128, boff = (128 * wm + lq) * 128;
#define GLOAD(RA, RB, KT) { _Pragma("unroll") for (int i = 0; i < 4; ++i) { RA[i] = *(const u32x4*)(ag + (size_t)(KT) * 64 + (size_t)i * 64 * lda); RB[i] = *(const u32x4*)(bg + (size_t)(KT) * 64 + (size_t)i * 64 * ldb); } }
#define LWRITE(RA, RB, ST) { _Pragma("unroll") for (int i = 0; i < 4; ++i) { *(u32x4*)(sA + (ST) * 32768 + wofs + i * 8192) = RA[i]; *(u32x4*)(sB + (ST) * 32768 + wofs + i * 8192) = RB[i]; } }
#define KSTEP(ST, RA, RB, KN) { const char* cA = sA + (ST) * 32768; const char* cB = sB + (ST) * 32768; char* dA = sA + (1 - (ST)) * 32768; char* dB = sB + (1 - (ST)) * 32768; \
    const bf16_t* agn = ag + (size_t)(KN) * 64; const bf16_t* bgn = bg + (size_t)(KN) * 64; \
    _Pragma("unroll") for (int s = 0; s < 4; ++s) { const int co = (((2 * s + h) ^ swz) << 4); bf16x8 fa[2], fb[4]; \
      _Pragma("unroll") for (int ni = 0; ni < 2; ++ni) fa[ni] = *(const bf16x8*)(cB + aoff + ni * 4096 + co); \
      _Pragma("unroll") for (int mi = 0; mi < 4; ++mi) fb[mi] = *(const bf16x8*)(cA + boff + mi * 4096 + co); \
      *(u32x4*)(dA + wofs + s * 8192) = RA[s]; *(u32x4*)(dB + wofs + s * 8192) = RB[s]; \
      RA[s] = *(const u32x4*)(agn + (size_t)s * 64 * lda); RB[s] = *(const u32x4*)(bgn + (size_t)s * 64 * ldb); \
      _Pragma("unroll") for (int ni = 0; ni < 2; ++ni) _Pragma("unroll") for (int mi = 0; mi < 4; ++mi) acc[ni][mi] = MFMA32(fa[ni], fb[mi], acc[ni][mi]); \
      __builtin_amdgcn_sched_barrier(0); } }
  const int kl = nk - 1;
  GLOAD(ra0, rb0, 0);
  GLOAD(ra1, rb1, (1 < kl ? 1 : kl));
  LWRITE(ra0, rb0, 0);
  GLOAD(ra0, rb0, (2 < kl ? 2 : kl));
  __syncthreads();
  for (int kt = 0; kt < nk; kt += 2) {
    KSTEP(0, ra1, rb1, (kt + 3 < kl ? kt + 3 : kl));
    __syncthreads();
    if (kt + 1 < nk) {
      KSTEP(1, ra0, rb0, (kt + 4 < kl ? kt + 4 : kl));
      __syncthreads();
    }
  }
#undef GLOAD
#undef LWRITE
#undef KSTEP
#pragma unroll
  for (int ni = 0; ni < 2; ++ni)
#pragma unroll
    for (int mi = 0; mi < 4; ++mi)
#pragma unroll
      for (int rg = 0; rg < 4; ++rg) {
        const int m = m0 + 128 * wm + 32 * mi + lq, n = n0 + 64 * wn + 32 * ni + 8 * rg + 4 * h;
        epi(m, n, acc[ni][mi][4 * rg], acc[ni][mi][4 * rg + 1], acc[ni][mi][4 * rg + 2], acc[ni][mi][4 * rg + 3]);
      }
}

template <class Epi>
DI void gemm_tile_s(const bf16_t* __restrict__ A, int lda, const bf16_t* __restrict__ Bt, int ldb, int K, int m0, int n0, char* smem, const Epi& epi) {
  const int tid = opaque_tid(), lane = tid & 63, w = tid >> 6, wm = w >> 2, wn = w & 3, lq = lane & 31, h = lane >> 5;
  f32x16 acc[2][4];
#pragma unroll
  for (int i = 0; i < 2; ++i)
#pragma unroll
    for (int j = 0; j < 4; ++j)
#pragma unroll
      for (int r = 0; r < 16; ++r) acc[i][j][r] = 0.f;
  const int r0 = tid >> 3, c0 = tid & 7;
  const bf16_t* ag = A + (size_t)(m0 + r0) * lda + c0 * 8;
  const bf16_t* bg = Bt + (size_t)(n0 + r0) * ldb + c0 * 8;
  const int wofs = r0 * 128 + ((c0 ^ ((r0 >> 1) & 7)) << 4);
  char* sA = smem; char* sB = smem + 32768;
  u32x4 ra[4], rb[4];
#pragma unroll
  for (int i = 0; i < 4; ++i) { ra[i] = *(const u32x4*)(ag + (size_t)i * 64 * lda); rb[i] = *(const u32x4*)(bg + (size_t)i * 64 * ldb); }
#pragma unroll
  for (int i = 0; i < 4; ++i) { *(u32x4*)(sA + wofs + i * 8192) = ra[i]; *(u32x4*)(sB + wofs + i * 8192) = rb[i]; }
  __syncthreads();
  const int nk = K >> 6, swz = (lane >> 1) & 7;
  const int aoff = (64 * wn + lq) * 128, boff = (128 * wm + lq) * 128;
  for (int kt = 0; kt < nk; ++kt) {
    const char* cA = sA + (kt & 1) * 65536; const char* cB = sB + (kt & 1) * 65536;
    const bool more = (kt + 1 < nk);
    if (more) { ag += 64; bg += 64;
#pragma unroll
      for (int i = 0; i < 4; ++i) { ra[i] = *(const u32x4*)(ag + (size_t)i * 64 * lda); rb[i] = *(const u32x4*)(bg + (size_t)i * 64 * ldb); } }
#pragma unroll
    for (int s = 0; s < 4; ++s) {
      const int co = (((2 * s + h) ^ swz) << 4);
      bf16x8 fa[2], fb[4];
#pragma unroll
      for (int ni = 0; ni < 2; ++ni) fa[ni] = *(const bf16x8*)(cB + aoff + ni * 4096 + co);
#pragma unroll
      for (int mi = 0; mi < 4; ++mi) fb[mi] = *(const bf16x8*)(cA + boff + mi * 4096 + co);
#pragma unroll
      for (int ni = 0; ni < 2; ++ni)
#pragma unroll
        for (int mi = 0; mi < 4; ++mi) acc[ni][mi] = MFMA32(fa[ni], fb[mi], acc[ni][mi]);
    }
    if (more) { char* dA = sA + ((kt + 1) & 1) * 65536; char* dB = sB + ((kt + 1) & 1) * 65536;
#pragma unroll
      for (int i = 0; i < 4; ++i) { *(u32x4*)(dA + wofs + i * 8192) = ra[i]; *(u32x4*)(dB + wofs + i * 8192) = rb[i]; } }
    __syncthreads();
  }
#pragma unroll
  for (int ni = 0; ni < 2; ++ni)
#pragma unroll
    for (int mi = 0; mi < 4; ++mi)
#pragma unroll
      for (int rg = 0; rg < 4; ++rg) {
        const int m = m0 + 128 * wm + 32 * mi + lq, n = n0 + 64 * wn + 32 * ni + 8 * rg + 4 * h;
        epi(m, n, acc[ni][mi][4 * rg], acc[ni][mi][4 * rg + 1], acc[ni][mi][4 * rg + 2], acc[ni][mi][4 * rg + 3]);
      }
}

DI void tile_coord(int t, int npn, int& pm, int& pn) { const int g = t / (16 * npn), r = t % (16 * npn); pn = r >> 4; pm = g * 16 + (r & 15); }

struct EpiProj { bf16_t* proj; float* ab;
  DI void operator()(int m, int n, float v0, float v1, float v2, float v3) const {
    u32x2 pk = {pack2(v0, v1), pack2(v2, v3)}; *(u32x2*)(proj + (size_t)m * DINP + n) = pk;
    if (n >= C_AA && n < C_AA + 16) { int mm = m; asm volatile("" : "+v"(mm));
      f32x4 v = {v0, v1, v2, v3}; *(f32x4*)(ab + (size_t)mm * 16 + (n - C_AA)) = v; } }
  DI void store8(int m, int n, const f32x4& a, const f32x4& b) const {
    u32x4 pk = {pack2(a.x, a.y), pack2(a.z, a.w), pack2(b.x, b.y), pack2(b.z, b.w)}; *(u32x4*)(proj + (size_t)m * DINP + n) = pk;
    if (n >= C_AA && n < C_AA + 16) { int mm = m; asm volatile("" : "+v"(mm)); float* p = ab + (size_t)mm * 16 + (n - C_AA); *(f32x4*)p = a; *(f32x4*)(p + 4) = b; } } };
struct EpiF32 { float* out; int ldc;
  DI void operator()(int m, int n, float v0, float v1, float v2, float v3) const { f32x4 v = {v0, v1, v2, v3}; *(f32x4*)(out + (size_t)m * ldc + n) = v; } };
struct EpiBf { bf16_t* out; int ldc;
  DI void operator()(int m, int n, float v0, float v1, float v2, float v3) const { u32x2 pk = {pack2(v0, v1), pack2(v2, v3)}; *(u32x2*)(out + (size_t)m * ldc + n) = pk; }
  DI void store8(int m, int n, const f32x4& a, const f32x4& b) const { u32x4 pk = {pack2(a.x, a.y), pack2(a.z, a.w), pack2(b.x, b.y), pack2(b.z, b.w)}; *(u32x4*)(out + (size_t)m * ldc + n) = pk; } };
struct EpiMlaQ { float* qraw; const float* rs; int m0;
  DI void operator()(int m, int n, float v0, float v1, float v2, float v3) const { const float r = rs[m - m0]; f32x4 v = {v0 * r, v1 * r, v2 * r, v3 * r}; *(f32x4*)(qraw + (size_t)m * 768 + n) = v; } };
struct EpiMlaKV { bf16_t* kmla; bf16_t* vt; const float* rs; int m0;
  DI void operator()(int m, int n, float v0, float v1, float v2, float v3) const {
    const float r = rs[m - m0]; const int hd = n >> 8, wi = n & 255;
    if (wi < 128) { u32x2 pk = {pack2(v0 * r, v1 * r), pack2(v2 * r, v3 * r)}; *(u32x2*)(kmla + ((size_t)hd * S_ + m) * 192 + wi) = pk; }
    else { bf16_t* p = vt + ((size_t)hd * 128 + (wi - 128)) * S_ + m; p[0] = f2bf(v0 * r); p[S_] = f2bf(v1 * r); p[2 * (size_t)S_] = f2bf(v2 * r); p[3 * (size_t)S_] = f2bf(v3 * r); } } };


namespace pg8 {
#define PG8_LAS __attribute__((address_space(3)))
constexpr int BM = 256, BK = 64, HALF = 128, HTB = HALF * BK * 2  , STAGE_BYTES = 8 * HTB;
DI int lds_byte(int r, int c) { const int st = (r >> 4) * 2 + (c >> 5), rr = r & 15, cc = c & 31, ob = rr * 64 + cc * 2; return st * 1024 + (ob ^ (((ob >> 9) & 1) << 5)); }
DI void stage_rc(int b, int& R, int& C) { const int st = b / 1024, sb = b % 1024, swz = sb ^ (((sb >> 9) & 1) << 5); R = (st >> 1) * 16 + swz / 64; C = (st & 1) * 32 + (swz % 64) / 2; }
DI int perm32(int rho) { const int n = rho >> 4, i = rho & 15; return 8 * (i >> 2) + 4 * n + (i & 3); }
struct Unit { int pm, pn; };
struct Gemm { const bf16_t* A; const bf16_t* Bt; int M, N, K; };
struct XcdOrder { int pm, pj, npn;
  DI bool next(int i, Unit& u) const { const int pn = pj + 4 * i; if (pn >= npn) return false; u.pm = pm; u.pn = pn; return true; }
  DI void a_ready(const Unit&) const {}
  DI void done(const Unit&) const {} };
template <class E> struct EpiAdapt8 { static constexpr bool PERM = true, AFTER_DRAIN = false; const E& e;
  DI void operator()(const f32x4 (&acc)[2][2][4][2], const Unit& u, int wr, int wc, int fr, int fq) const {
#pragma unroll
    for (int ai = 0; ai < 2; ++ai)
#pragma unroll
      for (int m = 0; m < 4; ++m)
#pragma unroll
        for (int bj = 0; bj < 2; ++bj)
          e.store8(u.pm * BM + ai * HALF + wr * 64 + m * 16 + fr, u.pn * BM + bj * HALF + wc * 32 + 8 * fq, acc[ai][bj][m][0], acc[ai][bj][m][1]); } };
template <class E> struct EpiAdapt { static constexpr bool PERM = false, AFTER_DRAIN = false; const E& e;
  DI void operator()(const f32x4 (&acc)[2][2][4][2], const Unit& u, int wr, int wc, int fr, int fq) const {
#pragma unroll
    for (int ai = 0; ai < 2; ++ai)
#pragma unroll
      for (int m = 0; m < 4; ++m)
#pragma unroll
        for (int bj = 0; bj < 2; ++bj)
#pragma unroll
          for (int n = 0; n < 2; ++n) { const f32x4 v = acc[ai][bj][m][n];
            e(u.pm * BM + ai * HALF + wr * 64 + m * 16 + fr, u.pn * BM + bj * HALF + wc * 32 + n * 16 + 4 * fq, v.x, v.y, v.z, v.w); } } };
template <class Epi, class Sched, bool ALIGN_EPI = false, bool SP2 = false>
__device__ __forceinline__ void gemm_phase(PG8_LAS unsigned char* lds, const Gemm g, const Sched& S, const Epi& E) {
    const int tid = opaque_tid(), wid = __builtin_amdgcn_readfirstlane(tid >> 6), lane = tid & 63, wr = wid >> 2, wc = wid & 3, fr = lane & 15, fq = lane >> 4;
    const int K = g.K, nt = K / BK;
    unsigned voffA[2], voffB[2];
#pragma unroll
    for (int i = 0; i < 2; ++i) { int R, C; stage_rc(tid * 16 + i * 8192, R, C); const int Rb = Epi::PERM ? ((R & ~31) + perm32(R & 31)) : R;
        voffA[i] = (unsigned)(R * K + C) * 2u; voffB[i] = (unsigned)(Rb * K + C) * 2u; }
    const size_t kstep = (size_t)(BK * 2);
    const size_t hstep = (size_t)HALF * K * 2;
    const size_t tstep = 2 * hstep;
    const unsigned ldsw = (unsigned)wid * 1024u;
    const int aoff = lds_byte(wr * 64 + fr, fq * 8), boff = lds_byte(wc * 32 + fr, fq * 8);
#define PG8_SA(b, h) (((b) * 2 + (h)) * HTB)
#define PG8_SB(b, h) ((4 + (b) * 2 + (h)) * HTB)
#define PG8_STAGE(bufoff, gbase, voff) do { _Pragma("unroll") for (int _i = 0; _i < 2; ++_i) \
        __builtin_amdgcn_global_load_lds((const unsigned*)((const char*)(gbase) + (voff)[_i]), (PG8_LAS unsigned*)(lds + (bufoff) + ldsw + _i * 8192), 16, 0, 0); } while (0)
#define PG8_LDA(dst, b, h) do { _Pragma("unroll") for (int m = 0; m < 4; ++m) _Pragma("unroll") for (int k = 0; k < 2; ++k) dst[m][k] = *(const PG8_LAS bf16x8*)(lds + PG8_SA(b, h) + aoff + m * 2048 + k * 1024); } while (0)
#define PG8_LDB(dst, b, h) do { _Pragma("unroll") for (int n = 0; n < 2; ++n) _Pragma("unroll") for (int k = 0; k < 2; ++k) dst[n][k] = *(const PG8_LAS bf16x8*)(lds + PG8_SB(b, h) + boff + n * 2048 + k * 1024); } while (0)
#define PG8_MMA(ai, bj, At, Bt) do { __builtin_amdgcn_s_setprio(1); _Pragma("unroll") for (int m = 0; m < 4; ++m) _Pragma("unroll") for (int n = 0; n < 2; ++n) _Pragma("unroll") for (int k = 0; k < 2; ++k) \
        acc[ai][bj][m][n] = __builtin_amdgcn_mfma_f32_16x16x32_bf16(Bt[n][k], At[m][k], acc[ai][bj][m][n], 0, 0, 0); __builtin_amdgcn_s_setprio(0); } while (0)
#define PG8_WAIT_V(n) asm volatile("s_waitcnt vmcnt(" #n ")" ::: "memory")
#define PG8_WAIT_L(n) asm volatile("s_waitcnt lgkmcnt(" #n ")" ::: "memory")
#define PG8_BAR __builtin_amdgcn_s_barrier()
#define PG8_SCHED __builtin_amdgcn_sched_barrier(0)
    Unit cur, nxt; int ui = 0;
    if (!S.next(0, cur)) return;
    f32x4 acc[2][2][4][2];
#pragma unroll
    for (int a = 0; a < 2; ++a)
#pragma unroll
        for (int b = 0; b < 2; ++b)
#pragma unroll
            for (int m = 0; m < 4; ++m)
#pragma unroll
                for (int n = 0; n < 2; ++n) acc[a][b][m][n] = (f32x4){0.f, 0.f, 0.f, 0.f};
    bf16x8 At[4][2], B0[2][2], B1[2][2];
    const char* cA = (const char*)g.A + (size_t)cur.pm * tstep; const char* cB = (const char*)g.Bt + (size_t)cur.pn * tstep;
    S.a_ready(cur);
    if constexpr (SP2) {
        PG8_STAGE(PG8_SB(0, 0), cB, voffB); PG8_STAGE(PG8_SB(0, 1), cB + hstep, voffB); PG8_STAGE(PG8_SA(0, 0), cA, voffA); PG8_STAGE(PG8_SA(0, 1), cA + hstep, voffA);
        if (wr == 1) PG8_BAR;
        PG8_WAIT_V(2); PG8_BAR;
        PG8_STAGE(PG8_SB(1, 0), cB + kstep, voffB); PG8_STAGE(PG8_SA(1, 0), cA + kstep, voffA); PG8_STAGE(PG8_SB(1, 1), cB + hstep + kstep, voffB);
        PG8_WAIT_V(6); PG8_BAR;
    } else {
        PG8_STAGE(PG8_SB(0, 0), cB, voffB); PG8_STAGE(PG8_SA(0, 0), cA, voffA); PG8_STAGE(PG8_SB(0, 1), cB + hstep, voffB); PG8_STAGE(PG8_SA(0, 1), cA + hstep, voffA);
        if (wr == 1) PG8_BAR;
        PG8_WAIT_V(4); PG8_BAR;
        PG8_STAGE(PG8_SB(1, 0), cB + kstep, voffB); PG8_STAGE(PG8_SA(1, 0), cA + kstep, voffA); PG8_STAGE(PG8_SB(1, 1), cB + hstep + kstep, voffB);
        PG8_WAIT_V(6); PG8_BAR;
    }
    for (;;) {
        const bool has_next = S.next(ui + 1, nxt);
        const char* nA = has_next ? (const char*)g.A + (size_t)nxt.pm * tstep : cA; const char* nB = has_next ? (const char*)g.Bt + (size_t)nxt.pn * tstep : cB;
        for (int t = 0; t < nt; t += 2) {
            const bool last = (t == nt - 2);
            const char* a1 = cA + (size_t)(t + 1) * kstep;
            const char* a2 = last ? nA : cA + (size_t)(t + 2) * kstep; const char* b2 = last ? nB : cB + (size_t)(t + 2) * kstep;
            const char* a3 = a2 + kstep; const char* b3 = b2 + kstep;
            if (last && has_next) S.a_ready(nxt);
            if constexpr (SP2) {
            PG8_LDB(B0, 0, 0); PG8_LDB(B1, 0, 1); PG8_SCHED; PG8_LDA(At, 0, 0); PG8_STAGE(PG8_SA(1, 1), a1 + hstep, voffA);
            PG8_WAIT_V(8); PG8_WAIT_L(0); PG8_BAR; PG8_MMA(0, 0, At, B0); PG8_MMA(0, 1, At, B1); PG8_BAR; PG8_SCHED;
            PG8_LDA(At, 0, 1); PG8_STAGE(PG8_SB(0, 0), b2, voffB); PG8_STAGE(PG8_SB(0, 1), b2 + hstep, voffB); PG8_STAGE(PG8_SA(0, 0), a2, voffA);
            PG8_WAIT_V(8); PG8_WAIT_L(0); PG8_BAR; PG8_MMA(1, 0, At, B0); PG8_MMA(1, 1, At, B1); PG8_BAR; PG8_SCHED;
            PG8_LDB(B0, 1, 0); PG8_LDB(B1, 1, 1); PG8_SCHED; PG8_LDA(At, 1, 0); PG8_STAGE(PG8_SA(0, 1), a2 + hstep, voffA);
            PG8_WAIT_V(8); PG8_WAIT_L(0); PG8_BAR; PG8_MMA(0, 0, At, B0); PG8_MMA(0, 1, At, B1); PG8_BAR; PG8_SCHED;
            PG8_LDA(At, 1, 1); PG8_STAGE(PG8_SB(1, 0), b3, voffB); PG8_STAGE(PG8_SB(1, 1), b3 + hstep, voffB); PG8_STAGE(PG8_SA(1, 0), a3, voffA);
            PG8_WAIT_V(8); PG8_WAIT_L(0); PG8_BAR; PG8_MMA(1, 0, At, B0); PG8_MMA(1, 1, At, B1); PG8_BAR; PG8_SCHED;
            } else {
            PG8_LDB(B0, 0, 0); PG8_SCHED; PG8_LDA(At, 0, 0); PG8_STAGE(PG8_SA(1, 1), a1 + hstep, voffA);
            PG8_WAIT_L(8); PG8_BAR; PG8_WAIT_L(0); PG8_MMA(0, 0, At, B0); PG8_BAR; PG8_SCHED;
            PG8_LDB(B1, 0, 1); PG8_STAGE(PG8_SB(0, 0), b2, voffB);
            PG8_BAR; PG8_WAIT_L(0); PG8_MMA(0, 1, At, B1); PG8_BAR;
            PG8_LDA(At, 0, 1); PG8_STAGE(PG8_SA(0, 0), a2, voffA);
            PG8_BAR; PG8_WAIT_L(0); PG8_MMA(1, 0, At, B0); PG8_BAR; PG8_SCHED;
            PG8_STAGE(PG8_SB(0, 1), b2 + hstep, voffB);
            PG8_WAIT_V(6); PG8_BAR; PG8_MMA(1, 1, At, B1); PG8_BAR;
            PG8_LDB(B0, 1, 0); PG8_SCHED; PG8_LDA(At, 1, 0); PG8_STAGE(PG8_SA(0, 1), a2 + hstep, voffA);
            PG8_WAIT_L(8); PG8_BAR; PG8_WAIT_L(0); PG8_MMA(0, 0, At, B0); PG8_BAR; PG8_SCHED;
            PG8_LDB(B1, 1, 1); PG8_STAGE(PG8_SB(1, 0), b3, voffB);
            PG8_BAR; PG8_WAIT_L(0); PG8_MMA(0, 1, At, B1); PG8_BAR;
            PG8_LDA(At, 1, 1); PG8_STAGE(PG8_SA(1, 0), a3, voffA);
            PG8_BAR; PG8_WAIT_L(0); PG8_MMA(1, 0, At, B0); PG8_BAR; PG8_SCHED;
            PG8_STAGE(PG8_SB(1, 1), b3 + hstep, voffB);
            PG8_WAIT_V(6); PG8_BAR; PG8_MMA(1, 1, At, B1); PG8_BAR;
            }
        }
        if constexpr (ALIGN_EPI) { if (wr == 0) PG8_BAR; }
        if constexpr (!Epi::AFTER_DRAIN) { E(acc, cur, wr, wc, fr, fq); S.done(cur); }
        if (!has_next) break;
#pragma unroll
        for (int a = 0; a < 2; ++a)
#pragma unroll
            for (int b = 0; b < 2; ++b)
#pragma unroll
                for (int m = 0; m < 4; ++m)
#pragma unroll
                    for (int n = 0; n < 2; ++n) acc[a][b][m][n] = (f32x4){0.f, 0.f, 0.f, 0.f};
        cur = nxt; cA = nA; cB = nB; ++ui;
        if constexpr (ALIGN_EPI) { if (wr == 1) PG8_BAR; }
    }
    PG8_WAIT_V(0);
    if constexpr (!ALIGN_EPI) { if (wr == 0) PG8_BAR; }
    PG8_BAR;
    if constexpr (Epi::AFTER_DRAIN) { E.fused(acc, cur, wr, wc, fr, fq, lds, wid, lane); S.done(cur); }
#undef PG8_SA
#undef PG8_SB
#undef PG8_STAGE
#undef PG8_LDA
#undef PG8_LDB
#undef PG8_MMA
#undef PG8_WAIT_V
#undef PG8_WAIT_L
#undef PG8_BAR
#undef PG8_SCHED
}
}

template <class Epi>
DI void gemm_phase(const bf16_t* A, int lda, const bf16_t* Bt, int ldb, int K, int npm, int npn, char* smem, const Epi& epi) {
  if (gridDim.x == 256 && npm == 64) {
    const int b = blockIdx.x, pm = 8 * (b & 7) + ((b >> 3) & 7), pj = b >> 6;
    if (lda == K && ldb == K && (K & 127) == 0) {
      const pg8::Gemm g{A, Bt, npm * 256, npn * 256, K}; const pg8::XcdOrder ord{pm, pj, npn}; const pg8::EpiAdapt8<Epi> ea{epi};
      pg8::gemm_phase<pg8::EpiAdapt8<Epi>, pg8::XcdOrder, true, true>(( __attribute__((address_space(3))) unsigned char*)smem, g, ord, ea);
    } else
    for (int pn = pj; pn < npn; pn += 4) gemm_tile(A, lda, Bt, ldb, K, pm * 256, pn * 256, smem, epi);
  } else {
    for (int t = blockIdx.x; t < npm * npn; t += gridDim.x) { int pm, pn; tile_coord(t, npn, pm, pn); gemm_tile(A, lda, Bt, ldb, K, pm * 256, pn * 256, smem, epi); }
  }
}

DI void mod_item(const Params& P, int item) {
  const int tid = opaque_tid(); const int l = item / 96, r = item % 96, ks = r / 6, nc = r % 6;
  const int n = nc * 2048 + tid * 4;
  const float* wp = P.ada_w + ((size_t)l * 2048 + ks * 128) * 12288 + n;
  f32x4 acc = {0.f, 0.f, 0.f, 0.f};
#pragma unroll 8
  for (int k = 0; k < 128; ++k) { const float cv = P.c[ks * 128 + k]; const float ca = silu_f(cv); const f32x4 wv = __builtin_nontemporal_load((const f32x4*)(wp + (size_t)k * 12288)); acc += wv * ca; }
  float* modp = (float*)(P.ws + OFF_MODP);
  *(f32x4*)(modp + ((size_t)l * 16 + ks) * 12288 + n) = acc;
}
DI void convert_tile(const float* __restrict__ src, int K, int N, bf16_t* __restrict__ dst, int tk, int tn, const float* rowscale, char* smem) {
  float* sm = (float*)smem; const int tid = opaque_tid(); const int k0 = tk * 64, n0 = tn * 256;
  { const int r = tid >> 6, c4 = tid & 63; const int n = n0 + 4 * c4;
    f32x4 v[8];
#pragma unroll
    for (int i = 0; i < 8; ++i) { v[i] = (f32x4){0.f, 0.f, 0.f, 0.f}; if (n < N) v[i] = __builtin_nontemporal_load((const f32x4*)(src + (size_t)(k0 + r + 8 * i) * N + n)); }
#pragma unroll
    for (int i = 0; i < 8; ++i) { const int kk = r + 8 * i; if (rowscale) v[i] *= rowscale[k0 + kk];
      sm[kk * 257 + 4 * c4 + 0] = v[i].x; sm[kk * 257 + 4 * c4 + 1] = v[i].y; sm[kk * 257 + 4 * c4 + 2] = v[i].z; sm[kk * 257 + 4 * c4 + 3] = v[i].w; } }
  __syncthreads();
  { const int n = tid >> 1, kh = tid & 1;
#pragma unroll
    for (int j = 0; j < 4; ++j) { float f[8];
#pragma unroll
      for (int i = 0; i < 8; ++i) f[i] = sm[(32 * kh + 8 * j + i) * 257 + n];
      u32x4 pk = {pack2(f[0], f[1]), pack2(f[2], f[3]), pack2(f[4], f[5]), pack2(f[6], f[7])};
      *(u32x4*)(dst + (size_t)(n0 + n) * K + k0 + 32 * kh + 8 * j) = pk; } }
  __syncthreads();
}
constexpr int CV_T0 = 32 * 22, CV_T1 = CV_T0 + 32 * 8, CV_T2 = CV_T1 + 32 * 44, CV_T3 = CV_T2 + 88 * 8, CV_T4 = CV_T3 + 7 * 3, CV_T5 = CV_T4 + 2 * 4;
DI void convert_item(const Params& P, int l, int it, char* smem) {
  char* wb = P.ws + OFF_W;
  if (it < CV_T0) convert_tile(P.w_in + (size_t)l * 2048 * 5520, 2048, 5520, (bf16_t*)(wb + W_IN), it / 22, it % 22, nullptr, smem);
  else if (it < CV_T1) { it -= CV_T0; convert_tile(P.w_out + (size_t)l * 2048 * 2048, 2048, 2048, (bf16_t*)(wb + W_OUT), it / 8, it % 8, nullptr, smem); }
  else if (it < CV_T2) { it -= CV_T1; convert_tile(P.ffn_w_up + (size_t)l * 2048 * 11264, 2048, 11264, (bf16_t*)(wb + W_UP), it / 44, it % 44, nullptr, smem); }
  else if (it < CV_T3) { it -= CV_T2; convert_tile(P.ffn_w_down + (size_t)l * 5632 * 2048, 5632, 2048, (bf16_t*)(wb + W_DOWN), it / 8, it % 8, nullptr, smem); }
  else if (it < CV_T4) { it -= CV_T3; convert_tile(P.mla_w_uq + (size_t)l * 448 * 768, 448, 768, (bf16_t*)(wb + W_UQ), it / 3, it % 3, P.mla_q_norm + l * 448, smem); }
  else { it -= CV_T4; convert_tile(P.mla_w_ukv + (size_t)l * 128 * 1024, 128, 1024, (bf16_t*)(wb + W_UKV), it / 4, it % 4, P.mla_kv_norm + l * 128, smem); }
}

DI float mod_val(const float* modp_l, const float* ada_b_l, int idx) { float s = ada_b_l[idx];
#pragma unroll
  for (int k = 0; k < 16; ++k) s += modp_l[(size_t)k * 12288 + idx]; return s; }
DI void rownorm_phase(const Params& P, const float* xin, const bf16_t* yin, float* xout, bf16_t* hout, int lg, int gate_idx, const float* w_post,
                      int lh, int scale_idx, int shift_idx, const float* w_pre, char* smem) {
  float* A1 = (float*)smem; float* A2 = A1 + 2048; float* B2 = A2 + 2048;
  const int tid = opaque_tid(), lane = tid & 63, w = tid >> 6;
  const float* modp = (const float*)(P.ws + OFF_MODP);
  for (int cidx = tid; cidx < 2048; cidx += NT) {
    if (yin) A1[cidx] = mod_val(modp + (size_t)lg * 16 * 12288, P.ada_b + (size_t)lg * 12288, gate_idx * 2048 + cidx) * w_post[cidx];
    if (hout) { A2[cidx] = w_pre[cidx] * (1.f + mod_val(modp + (size_t)lh * 16 * 12288, P.ada_b + (size_t)lh * 12288, scale_idx * 2048 + cidx));
      B2[cidx] = mod_val(modp + (size_t)lh * 16 * 12288, P.ada_b + (size_t)lh * 12288, shift_idx * 2048 + cidx); }
  }
  __syncthreads();
  for (int row = blockIdx.x * 8 + w; row < S_; row += gridDim.x * 8) {
    f32x4 xv[8];
#pragma unroll
    for (int j = 0; j < 8; ++j) xv[j] = __builtin_nontemporal_load((const f32x4*)(xin + (size_t)row * 2048 + (j * 64 + lane) * 4));
    if (yin) {
      f32x4 yv[8]; float ss = 0.f;
#pragma unroll
      for (int j = 0; j < 8; ++j) { const u32x2 yb = __builtin_nontemporal_load((const u32x2*)(yin + (size_t)row * 2048 + (j * 64 + lane) * 4)); yv[j] = (f32x4){bflo(yb.x), bfhi(yb.x), bflo(yb.y), bfhi(yb.y)};
        ss += yv[j].x * yv[j].x + yv[j].y * yv[j].y + yv[j].z * yv[j].z + yv[j].w * yv[j].w; }
      ss = wave_sum(ss); const float r = rsqrtf(ss * (1.f / 2048.f) + EPS);
#pragma unroll
      for (int j = 0; j < 8; ++j) { const f32x4 a = *(const f32x4*)(A1 + (j * 64 + lane) * 4); xv[j] += a * (yv[j] * r); }
    }
    if (yin || xout != xin) {
#pragma unroll
      for (int j = 0; j < 8; ++j) *(f32x4*)(xout + (size_t)row * 2048 + (j * 64 + lane) * 4) = xv[j];
    }
    if (hout) {
      float ss = 0.f;
#pragma unroll
      for (int j = 0; j < 8; ++j) ss += xv[j].x * xv[j].x + xv[j].y * xv[j].y + xv[j].z * xv[j].z + xv[j].w * xv[j].w;
      ss = wave_sum(ss); const float r = rsqrtf(ss * (1.f / 2048.f) + EPS);
#pragma unroll
      for (int j = 0; j < 8; ++j) { const f32x4 a = *(const f32x4*)(A2 + (j * 64 + lane) * 4), b = *(const f32x4*)(B2 + (j * 64 + lane) * 4);
        const f32x4 hv = xv[j] * r * a + b; u32x2 pk = {pack2(hv.x, hv.y), pack2(hv.z, hv.w)};
        *(u32x2*)(hout + (size_t)row * 2048 + (j * 64 + lane) * 4) = pk; }
    }
  }
  __syncthreads();
}

DI void mla_q_tile(const Params& P, int pm, int pn, char* smem) {
  const bf16_t* proj = (const bf16_t*)(P.ws + OFF_PROJ); const int tid = opaque_tid(), m0 = pm * 256; float* rs = (float*)(smem + 131072);
  { const int row = tid >> 1, half = tid & 1; const bf16_t* p = proj + (size_t)(m0 + row) * DINP + C_BCQ + half * 224; float ss = 0.f;
    for (int i = 0; i < 28; ++i) { const u32x4 v = *(const u32x4*)(p + i * 8); float f[8]; unpack8(v, f);
#pragma unroll
      for (int e = 0; e < 8; ++e) ss += f[e] * f[e]; }
    ss += __shfl_xor(ss, 1); if (half == 0) rs[row] = rsqrtf(ss * (1.f / 448.f) + EPS); }
  EpiMlaQ epi{(float*)(P.ws + OFF_QRAW), rs, m0};
  gemm_tile_s(proj + C_BCQ, DINP, (const bf16_t*)(P.ws + OFF_W + W_UQ), 448, 448, m0, pn * 256, smem, epi);
  __syncthreads();
}
DI void mla_kv_tile(const Params& P, int pm, int pn, char* smem) {
  const bf16_t* proj = (const bf16_t*)(P.ws + OFF_PROJ); const int tid = opaque_tid(), m0 = pm * 256; float* rs = (float*)(smem + 131072);
  { const int row = tid >> 1, half = tid & 1; const bf16_t* p = proj + (size_t)(m0 + row) * DINP + C_BCKV + half * 64; float ss = 0.f;
#pragma unroll
    for (int i = 0; i < 8; ++i) { const u32x4 v = *(const u32x4*)(p + i * 8); float f[8]; unpack8(v, f);
#pragma unroll
      for (int e = 0; e < 8; ++e) ss += f[e] * f[e]; }
    ss += __shfl_xor(ss, 1); if (half == 0) rs[row] = rsqrtf(ss * (1.f / 128.f) + EPS); }
  bf16_t* kmla = (bf16_t*)(P.ws + OFF_KMLA);
  EpiMlaKV epi{kmla, (bf16_t*)(P.ws + OFF_VT), rs, m0};
  gemm_tile_s(proj + C_BCKV, DINP, (const bf16_t*)(P.ws + OFF_W + W_UKV), 128, 128, m0, pn * 256, smem, epi);
  if (pn == 0) {
    for (int i = 0; i < 16; ++i) { const int idx = tid + NT * i, row = idx >> 5, pi = idx & 31, m = m0 + row;
      const float x1 = bflo((unsigned)proj[(size_t)m * DINP + C_BKR + pi]), x2 = bflo((unsigned)proj[(size_t)m * DINP + C_BKR + 32 + pi]);
      double fr = (double)P.pos[m] * kInvFreq2Pi[pi]; fr -= floor(fr); const float ff = (float)fr;
      const float sn = __builtin_amdgcn_sinf(ff), cs = __builtin_amdgcn_cosf(ff);
      const bf16_t o1 = f2bf(x1 * cs - x2 * sn), o2 = f2bf(x2 * cs + x1 * sn);
#pragma unroll
      for (int hd = 0; hd < 4; ++hd) { bf16_t* kp = kmla + ((size_t)hd * S_ + m) * 192 + 128; kp[pi] = o1; kp[32 + pi] = o2; } }
  }
  __syncthreads();
}

DI void gdn_prep_item(const Params& P, int l, int n, int hh, char* smem) {
  const int tid = opaque_tid(), lane = tid & 63, w = tid >> 6, lq = lane & 31, h = lane >> 5;
  const bf16_t* proj = (const bf16_t*)(P.ws + OFF_PROJ); const float* ab = (const float*)(P.ws + OFF_AB);
  char* kb16 = smem; char* qb16 = smem + 17408;
  float* kf = (float*)(smem + 34816); float* vf = kf + 8192; float* Lm = vf + 8192; float* gcs = Lm + 4096;
  const size_t tile = (size_t)hh * 256 + n; const int t0 = n * 64;
  bf16_t* Wp = (bf16_t*)(P.ws + OFF_WP) + tile * 8192; bf16_t* Qd = (bf16_t*)(P.ws + OFF_QD) + tile * 8192;
  bf16_t* Kt = (bf16_t*)(P.ws + OFF_KT) + tile * 8192; bf16_t* Zt = (bf16_t*)(P.ws + OFF_ZT) + tile * 8192;
  bf16_t* QK = (bf16_t*)(P.ws + OFF_QK) + tile * 4096; bf16_t* Ut = (bf16_t*)(P.ws + OFF_UT) + tile * 8192;
  if (w == 0) {
    const int t = lane; const float a_raw = ab[(size_t)(t0 + t) * 16 + hh], b_raw = ab[(size_t)(t0 + t) * 16 + 8 + hh];
    const float Aa = __expf(P.gdn_a_log[l * 8 + hh]); const float xb = a_raw + P.gdn_dt_bias[l * 8 + hh];
    const float ex = __expf(fminf(xb, 20.f));
    const float sp = xb > 20.f ? xb : (ex < 0.01f ? ex * (1.f - ex * (0.5f - ex * (1.f / 3.f))) : __logf(1.f + ex));
    float g = -Aa * sp;
#pragma unroll
    for (int d = 1; d < 64; d <<= 1) { const float v = __shfl_up(g, d); if (lane >= d) g += v; }
    const float bt = __builtin_amdgcn_rcpf(1.f + __expf(-b_raw)), eg = __expf(g); gcs[t] = g; gcs[64 + t] = bt; gcs[128 + t] = eg; gcs[192 + t] = bt * eg;
    if (t == 63) ((float*)(P.ws + OFF_GTOT))[tile] = eg;
  }
  __syncthreads();
  {
    const int t = tid >> 3, part = tid & 7, tabs = t0 + t;
    const float gct = gcs[t], egct = gcs[128 + t], ktl = __expf(gcs[63] - gct);
    const int pjt = 32 * (t >> 5) + perm32(t & 31);
#pragma unroll
    for (int X = 0; X < 3; ++X) {
      const int cb = X * 1024 + hh * 128 + part * 16;
      float y[16];
#pragma unroll
      for (int e = 0; e < 16; ++e) y[e] = 0.f;
      u32x4 pv[4][2]; f32x4 wv[4][4];
#pragma unroll
      for (int j = 0; j < 4; ++j) { const int row = tabs - 3 + j, rr = row < 0 ? 0 : row;
        pv[j][0] = *(const u32x4*)(proj + (size_t)rr * DINP + cb); pv[j][1] = *(const u32x4*)(proj + (size_t)rr * DINP + cb + 8);
        const float* cw = P.gdn_conv + ((size_t)l * 4 + j) * 3072 + cb;
#pragma unroll
        for (int e4 = 0; e4 < 4; ++e4) wv[j][e4] = *(const f32x4*)(cw + 4 * e4); }
      __builtin_amdgcn_sched_barrier(0);
#pragma unroll
      for (int j = 0; j < 4; ++j) { const float msk = (tabs - 3 + j) >= 0 ? 1.f : 0.f;
        float xv[16]; unpack8(pv[j][0], xv); unpack8(pv[j][1], xv + 8);
#pragma unroll
        for (int e4 = 0; e4 < 4; ++e4) { const f32x4 wm = wv[j][e4] * msk; y[4 * e4] += wm.x * xv[4 * e4]; y[4 * e4 + 1] += wm.y * xv[4 * e4 + 1]; y[4 * e4 + 2] += wm.z * xv[4 * e4 + 2]; y[4 * e4 + 3] += wm.w * xv[4 * e4 + 3]; } }
#pragma unroll
      for (int e = 0; e < 16; ++e) y[e] = silu_f(y[e]);
      if (X < 2) { float ss = 0.f;
#pragma unroll
        for (int e = 0; e < 16; ++e) ss += y[e] * y[e];
        ss += __shfl_xor(ss, 1); ss += __shfl_xor(ss, 2); ss += __shfl_xor(ss, 4);
        const float rn = rsqrtf(ss + EPS) * (X == 0 ? 0.08838834764831845f : 1.f);
#pragma unroll
        for (int e = 0; e < 16; ++e) y[e] *= rn; }
      if (X == 0) {
        u32x4 p0 = {pack2(y[0], y[1]), pack2(y[2], y[3]), pack2(y[4], y[5]), pack2(y[6], y[7])}, p1 = {pack2(y[8], y[9]), pack2(y[10], y[11]), pack2(y[12], y[13]), pack2(y[14], y[15])};
        *(u32x4*)(qb16 + t * 272 + part * 32) = p0; *(u32x4*)(qb16 + t * 272 + part * 32 + 16) = p1;
#pragma unroll
        for (int b = 0; b < 4; ++b) { u32x2 pk = {pack2(y[4 * b] * egct, y[4 * b + 1] * egct), pack2(y[4 * b + 2] * egct, y[4 * b + 3] * egct)};
          *(u32x2*)(Qd + t * 128 + 32 * (part >> 1) + 8 * b + 4 * (part & 1)) = pk; }
      } else if (X == 1) {
        u32x4 p0 = {pack2(y[0], y[1]), pack2(y[2], y[3]), pack2(y[4], y[5]), pack2(y[6], y[7])}, p1 = {pack2(y[8], y[9]), pack2(y[10], y[11]), pack2(y[12], y[13]), pack2(y[14], y[15])};
        *(u32x4*)(kb16 + t * 272 + part * 32) = p0; *(u32x4*)(kb16 + t * 272 + part * 32 + 16) = p1;
#pragma unroll
        for (int e4 = 0; e4 < 4; ++e4) { f32x4 v = {y[4 * e4], y[4 * e4 + 1], y[4 * e4 + 2], y[4 * e4 + 3]}; *(f32x4*)(kf + t * 128 + part * 16 + 4 * e4) = v; }
#pragma unroll
        for (int e = 0; e < 16; ++e) Kt[(part * 16 + e) * 64 + pjt] = f2bf(y[e] * ktl);
      } else {
#pragma unroll
        for (int e4 = 0; e4 < 4; ++e4) { f32x4 v = {y[4 * e4], y[4 * e4 + 1], y[4 * e4 + 2], y[4 * e4 + 3]}; *(f32x4*)(vf + t * 128 + part * 16 + 4 * e4) = v; }
      }
    }
    { const int cb = C_AZ + hh * 128 + part * 16; const u32x4 v0 = *(const u32x4*)(proj + (size_t)tabs * DINP + cb), v1 = *(const u32x4*)(proj + (size_t)tabs * DINP + cb + 8);
      float zv[16]; unpack8(v0, zv); unpack8(v1, zv + 8);
#pragma unroll
      for (int e = 0; e < 16; ++e) Zt[(part * 16 + e) * 64 + t] = f2bf(silu_f(zv[e])); }
  }
  __syncthreads();
  {
    const int which = w >> 2, ti = (w >> 1) & 1, tj = w & 1; const char* Ab = which ? qb16 : kb16;
    f32x16 acc;
#pragma unroll
    for (int r = 0; r < 16; ++r) acc[r] = 0.f;
#pragma unroll
    for (int s = 0; s < 8; ++s) { const bf16x8 a = *(const bf16x8*)(Ab + (32 * ti + lq) * 272 + (16 * s + 8 * h) * 2), b = *(const bf16x8*)(kb16 + (32 * tj + lq) * 272 + (16 * s + 8 * h) * 2);
      acc = MFMA32(a, b, acc); }
    const int j = 32 * tj + lq; const float gj = gcs[j]; const int pj = 32 * (j >> 5) + perm32(j & 31);
#pragma unroll
    for (int r = 0; r < 16; ++r) { const int i = 32 * ti + crow(r, h); const float dec = __expf(fminf(gcs[i] - gj, 0.f));
      if (which == 0) Lm[i * 64 + j] = (j < i) ? gcs[64 + i] * acc[r] * dec : 0.f;
      else QK[i * 64 + pj] = f2bf((j <= i) ? acc[r] * dec : 0.f); }
  }
  __syncthreads();
  if (tid < 256) {
    const int c = tid; const bool isu = c < 128; const int cc = c & 127;
    const float* rp = (isu ? vf : kf) + cc; const float* sp = gcs + (isu ? 64 : 192);
    f32x2 xx[32];
    f32x4 LA[16], LB[16]; float rh[2];
    xx[0].x = sp[0] * rp[0];
    LA[0] = *(const f32x4*)(Lm + 64); rh[1] = sp[1] * rp[128];
#pragma unroll
    for (int i = 1; i < 64; ++i) {
      f32x4 (&CUR)[16] = (i & 1) ? LA : LB; f32x4 (&NXT)[16] = (i & 1) ? LB : LA;
      if (i + 1 < 64) {
#pragma unroll
        for (int c = 0; c < (i + 4) / 4; ++c) NXT[c] = *(const f32x4*)(Lm + (i + 1) * 64 + 4 * c);
        rh[(i + 1) & 1] = sp[i + 1] * rp[(i + 1) * 128];
      }
      __builtin_amdgcn_sched_barrier(0);
      f32x2 acc = {rh[i & 1], 0.f};
#pragma unroll
      for (int p = 0; p < i / 2; ++p) { const f32x2 lp = (p & 1) ? (f32x2){CUR[p >> 1].z, CUR[p >> 1].w} : (f32x2){CUR[p >> 1].x, CUR[p >> 1].y}; acc = acc - lp * xx[p]; }
      if (i & 1) { const int j = i - 1; const float lj = ((j & 3) == 0) ? CUR[j >> 2].x : CUR[j >> 2].z; acc.x = fmaf(-lj, xx[j >> 1].x, acc.x); }
      const float xi = acc.x + acc.y;
      if (i & 1) xx[i >> 1].y = xi; else xx[i >> 1].x = xi;
      __builtin_amdgcn_sched_barrier(0);
    }
    float x[64];
#pragma unroll
    for (int p = 0; p < 32; ++p) { x[2 * p] = xx[p].x; x[2 * p + 1] = xx[p].y; }
    if (isu) {
#pragma unroll
      for (int i8 = 0; i8 < 8; ++i8) { u32x4 v = {pack2(x[8 * i8], x[8 * i8 + 1]), pack2(x[8 * i8 + 2], x[8 * i8 + 3]), pack2(x[8 * i8 + 4], x[8 * i8 + 5]), pack2(x[8 * i8 + 6], x[8 * i8 + 7])}; *(u32x4*)(Ut + cc * 64 + 8 * i8) = v; }
    } else {
      const int pp = 32 * (cc >> 5) + perm32(cc & 31);
#pragma unroll
      for (int i = 0; i < 64; ++i) Wp[i * 128 + pp] = f2bf(x[i]);
    }
  }
  __syncthreads();
}

DI bf16x8 pack_tiles(const f32x4& a, const f32x4& b) { return pack8(a.x, a.y, a.z, a.w, b.x, b.y, b.z, b.w); }
template <int CTRL> DI float dppf(float v) { return __int_as_float(__builtin_amdgcn_update_dpp(0, __float_as_int(v), CTRL, 0xf, 0xf, true)); }
DI float row16_sum(float v) { v += dppf<0xB1>(v); v += dppf<0x4E>(v); v += dppf<0x141>(v); v += dppf<0x140>(v); return v; }
constexpr size_t OFF_SSQP = OFF_GTOT + 8192;
static_assert(OFF_SSQP + (size_t)8 * S_ * 8 * 4 <= OFF_UT, "overlay3");
constexpr int SCAN_OPB = 62464;
constexpr int SCAN_SO = 2 * SCAN_OPB;
constexpr int SCAN_OT = SCAN_SO + 16384;
DI void gdn_scan_item(const Params& P, int l, int hh, int half, char* smem) {
  const int tid = opaque_tid(), lane = tid & 63, w = tid >> 6, l15 = lane & 15, q4 = lane >> 4;
  const size_t hb = (size_t)hh * 256;
  const bf16_t* Wp = (const bf16_t*)(P.ws + OFF_WP) + hb * 8192; const bf16_t* Qd = (const bf16_t*)(P.ws + OFF_QD) + hb * 8192;
  const bf16_t* Kt = (const bf16_t*)(P.ws + OFF_KT) + hb * 8192; const bf16_t* Zt = (const bf16_t*)(P.ws + OFF_ZT) + hb * 8192;
  const bf16_t* QK = (const bf16_t*)(P.ws + OFF_QK) + hb * 4096; const bf16_t* Ut = (const bf16_t*)(P.ws + OFF_UT) + hb * 8192;
  const float* gt = (const float*)(P.ws + OFF_GTOT) + hb;
  bf16_t* mixin = (bf16_t*)(P.ws + OFF_H);
  float* sSS = (float*)(smem + SCAN_OT + 16384);
  if (w >= 4) {
    const int lt = tid - 256, wl = w - 4;
    const int dvc = 64 * half + 16 * wl + l15; const float nw = P.gdn_norm[l * 128 + dvc];
    const int uoff = dvc * 64 + 4 * q4;
    const int g256 = (lt >> 4) * 128 + (lt & 15) * 8, l256 = (lt >> 4) * 272 + (lt & 15) * 16;
    const int g128 = (lt >> 3) * 64 + (lt & 7) * 8, l128 = (lt >> 3) * 144 + (lt & 7) * 16;
    u32x4 pwA[4], pqA[4], pkA[4], pqkA[2], pwB[4], pqB[4], pkB[4], pqkB[2]; u32x2 zA[4], zB[4];
#define LD_LOAD(PW, PQ, PK, PQK, N) { const int n__ = (N) < 255 ? (N) : 255; const size_t o8 = (size_t)n__ * 8192, o4 = (size_t)n__ * 4096; \
    _Pragma("unroll") for (int i = 0; i < 4; ++i) { PW[i] = __builtin_nontemporal_load((const u32x4*)(Wp + o8 + g256 + i * 2048)); PQ[i] = __builtin_nontemporal_load((const u32x4*)(Qd + o8 + g256 + i * 2048)); PK[i] = __builtin_nontemporal_load((const u32x4*)(Kt + o8 + g128 + i * 2048)); } \
    _Pragma("unroll") for (int i = 0; i < 2; ++i) PQK[i] = __builtin_nontemporal_load((const u32x4*)(QK + o4 + g128 + i * 2048)); }
#define LZ_LOAD(Z, N) { const int n__ = (N) < 255 ? (N) : 255; _Pragma("unroll") for (int it = 0; it < 4; ++it) Z[it] = __builtin_nontemporal_load((const u32x2*)(Zt + (size_t)n__ * 8192 + uoff + 16 * it)); }
#define LD_STAGE(PW, PQ, PK, PQK, NB) { char* nb_ = (NB); \
    _Pragma("unroll") for (int i = 0; i < 4; ++i) { *(u32x4*)(nb_ + l256 + i * 4352) = PW[i]; *(u32x4*)(nb_ + 17408 + l256 + i * 4352) = PQ[i]; *(u32x4*)(nb_ + 34816 + l128 + i * 4608) = PK[i]; } \
    _Pragma("unroll") for (int i = 0; i < 2; ++i) *(u32x4*)(nb_ + 53248 + l128 + i * 4608) = PQK[i]; }
#define LD_FINISH(M, Z) { const int m = (M); const char* so = smem + SCAN_SO + (m & 1) * 8192 + (wl * 4) * 512 + lane * 8; \
    bf16_t* ot = (bf16_t*)(smem + SCAN_OT + (m & 1) * 8192); float* sq = sSS + (m & 1) * 256 + wl * 64; \
    _Pragma("unroll") for (int it = 0; it < 4; ++it) { \
      const u32x2 ob = *(const u32x2*)(so + it * 512); const f32x4 o = {bflo(ob.x), bfhi(ob.x), bflo(ob.y), bfhi(ob.y)}; \
      f32x4 ss = o * o; ss.x = row16_sum(ss.x); ss.y = row16_sum(ss.y); ss.z = row16_sum(ss.z); ss.w = row16_sum(ss.w); \
      const int rl = 16 * it + 4 * q4; \
      if (l15 == 0) *(f32x4*)(sq + rl) = ss; \
      bf16_t* op = ot + rl * 64 + 16 * wl + l15; \
      op[0] = f2bf(o.x * nw * bflo(Z[it].x)); op[64] = f2bf(o.y * nw * bfhi(Z[it].x)); op[128] = f2bf(o.z * nw * bflo(Z[it].y)); op[192] = f2bf(o.w * nw * bfhi(Z[it].y)); } }
#define LD_STEP(PW, PQ, PK, PQK, ZU, N) { const int n_ = (N); \
    LD_STAGE(PW, PQ, PK, PQK, smem + ((n_ + 1) & 1) * SCAN_OPB); \
    LD_LOAD(PW, PQ, PK, PQK, n_ + 3); \
    if (n_ >= 1) LD_FINISH(n_ - 1, ZU); \
    LZ_LOAD(ZU, n_ + 1); \
    __syncthreads(); }
    LD_LOAD(pwA, pqA, pkA, pqkA, 0);
    LD_STAGE(pwA, pqA, pkA, pqkA, smem);
    LD_LOAD(pwA, pqA, pkA, pqkA, 1);
    LD_LOAD(pwB, pqB, pkB, pqkB, 2);
    LZ_LOAD(zB, 0);
    LZ_LOAD(zA, 0);
    __syncthreads();
#pragma unroll 1
    for (int n = 0; n < 256; n += 2) {
      LD_STEP(pwA, pqA, pkA, pqkA, zA, n);
      LD_STEP(pwB, pqB, pkB, pqkB, zB, n + 1);
    }
    LD_FINISH(255, zA);
    __syncthreads();
#undef LD_LOAD
#undef LZ_LOAD
#undef LD_STAGE
#undef LD_FINISH
#undef LD_STEP
  } else {
    const int dvc = 64 * half + 16 * w + l15;
    const int uoff = dvc * 64 + 4 * q4;
    float* ssqp = (float*)(P.ws + OFF_SSQP) + (size_t)(half * 4 + w) * S_ * 8;
    f32x4 St[8];
#pragma unroll
    for (int t = 0; t < 8; ++t) St[t] = (f32x4){0.f, 0.f, 0.f, 0.f};
    u32x2 uc[4], un[4]; float gcur, gn = 0.f;
#pragma unroll
    for (int it = 0; it < 4; ++it) { uc[it] = *(const u32x2*)(Ut + uoff + 16 * it); un[it] = uc[it]; }
    gcur = gt[0];
#define CP_OUT(M) { const int m2 = (M); const char* ot = smem + SCAN_OT + (m2 & 1) * 8192; \
      _Pragma("unroll") for (int i = 0; i < 2; ++i) { const int c = tid + 256 * i, row = c >> 3, cc = c & 7; \
        *(u32x4*)(mixin + (size_t)(64 * m2 + row) * 2048 + hh * 128 + 64 * half + cc * 8) = *(const u32x4*)(ot + row * 128 + cc * 16); } \
      ssqp[(size_t)(64 * m2 + lane) * 8 + hh] = sSS[(m2 & 1) * 256 + w * 64 + lane]; }
    __syncthreads();
#pragma unroll 2
    for (int n = 0; n < 256; ++n) {
      const char* cb = smem + (n & 1) * SCAN_OPB;
      const char* sWp = cb; const char* sQd = cb + 17408; const char* sKt = cb + 34816; const char* sQK = cb + 53248;
      if (n + 1 < 256) { const size_t o8 = (size_t)(n + 1) * 8192;
#pragma unroll
        for (int it = 0; it < 4; ++it) un[it] = __builtin_nontemporal_load((const u32x2*)(Ut + o8 + uoff + 16 * it));
        gn = gt[n + 1]; }
      bf16x8 sb[4];
#pragma unroll
      for (int ks = 0; ks < 4; ++ks) sb[ks] = pack_tiles(St[2 * ks], St[2 * ks + 1]);
      f32x4 wsv[4], qs[4];
#pragma unroll
      for (int it = 0; it < 4; ++it) { wsv[it] = (f32x4){0.f, 0.f, 0.f, 0.f}; qs[it] = (f32x4){0.f, 0.f, 0.f, 0.f}; }
#pragma unroll
      for (int it = 0; it < 4; ++it)
#pragma unroll
        for (int ks = 0; ks < 4; ++ks) { const int o = (16 * it + l15) * 272 + 64 * ks + 16 * q4;
          const bf16x8 a = *(const bf16x8*)(sWp + o), a2 = *(const bf16x8*)(sQd + o);
          wsv[it] = MFMA16(a, sb[ks], wsv[it]); qs[it] = MFMA16(a2, sb[ks], qs[it]); }
      f32x4 vn[4];
#pragma unroll
      for (int it = 0; it < 4; ++it) { const f32x4 uf = {bflo(uc[it].x), bfhi(uc[it].x), bflo(uc[it].y), bfhi(uc[it].y)}; vn[it] = uf - wsv[it]; }
      bf16x8 vb[2];
#pragma unroll
      for (int ks = 0; ks < 2; ++ks) vb[ks] = pack_tiles(vn[2 * ks], vn[2 * ks + 1]);
#pragma unroll
      for (int it = 0; it < 4; ++it)
#pragma unroll
        for (int ks = 0; ks < 2; ++ks) { const bf16x8 a = *(const bf16x8*)(sQK + (16 * it + l15) * 144 + 64 * ks + 16 * q4); qs[it] = MFMA16(a, vb[ks], qs[it]); }
      { char* so = smem + SCAN_SO + (n & 1) * 8192 + (w * 4) * 512 + lane * 8;
#pragma unroll
        for (int it = 0; it < 4; ++it) { u32x2 ob = {pack2(qs[it].x, qs[it].y), pack2(qs[it].z, qs[it].w)}; *(u32x2*)(so + it * 512) = ob; } }
#pragma unroll
      for (int t = 0; t < 8; ++t) { St[t] *= gcur;
#pragma unroll
        for (int ks = 0; ks < 2; ++ks) { const bf16x8 a = *(const bf16x8*)(sKt + (16 * t + l15) * 144 + 64 * ks + 16 * q4); St[t] = MFMA16(a, vb[ks], St[t]); } }
#pragma unroll
      for (int it = 0; it < 4; ++it) uc[it] = un[it];
      gcur = gn;
      if (n >= 2) CP_OUT(n - 2);
      __syncthreads();
    }
    CP_OUT(254);
    __syncthreads();
    CP_OUT(255);
#undef CP_OUT
  }
  __syncthreads();
}
DI void gdn_fix_phase(const Params& P) {
  const int tid = opaque_tid();
  bf16_t* mixin = (bf16_t*)(P.ws + OFF_H); const float* ssqp = (const float*)(P.ws + OFF_SSQP);
  for (int idx = blockIdx.x * NT + tid; idx < S_ * 128; idx += gridDim.x * NT) {
    const int t = idx >> 7, ck = idx & 127, h = ck >> 4;
    float sq = 0.f;
#pragma unroll
    for (int p = 0; p < 8; ++p) sq += ssqp[((size_t)p * S_ + t) * 8 + h];
    const float r = rsqrtf(sq * (1.f / 128.f) + EPS);
    u32x4* pp = (u32x4*)(mixin + (size_t)t * 2048 + ck * 8); const u32x4 v = *pp; float f[8]; unpack8(v, f);
    u32x4 o = {pack2(f[0] * r, f[1] * r), pack2(f[2] * r, f[3] * r), pack2(f[4] * r, f[5] * r), pack2(f[6] * r, f[7] * r)}; *pp = o;
  }
}

DI void mla_attn_item(const Params& P, int hd, int b, char* smem) {
  const int tid = opaque_tid(), lane = tid & 63, w = tid >> 6, wq = w & 3, hk = w >> 2, lq = lane & 31, h = lane >> 5;
  const float* qraw = (const float*)(P.ws + OFF_QRAW);
  const bf16_t* Kg = (const bf16_t*)(P.ws + OFF_KMLA) + (size_t)hd * S_ * 192;
  const bf16_t* Vg = (const bf16_t*)(P.ws + OFF_VT) + (size_t)hd * 128 * S_;
  bf16_t* mixin = (bf16_t*)(P.ws + OFF_H);
  const int q = 128 * b + 32 * wq + lq;
  bf16x8 qf[12];
  {
    const float* qp = qraw + (size_t)q * 768 + hd * 192 + 8 * h;
    const float sc = 0.07216878364870322f * LOG2E;
#pragma unroll
    for (int s = 0; s < 8; ++s) { const f32x4 a = *(const f32x4*)(qp + 16 * s), c = *(const f32x4*)(qp + 16 * s + 4);
      qf[s] = pack8(a.x * sc, a.y * sc, a.z * sc, a.w * sc, c.x * sc, c.y * sc, c.z * sc, c.w * sc); }
    const double pq = (double)P.pos[q];
#pragma unroll
    for (int s2 = 0; s2 < 2; ++s2) {
      const f32x4 a0 = *(const f32x4*)(qp + 128 + 16 * s2), a1 = *(const f32x4*)(qp + 128 + 16 * s2 + 4);
      const f32x4 b0 = *(const f32x4*)(qp + 160 + 16 * s2), b1 = *(const f32x4*)(qp + 160 + 16 * s2 + 4);
      float x1[8] = {a0.x, a0.y, a0.z, a0.w, a1.x, a1.y, a1.z, a1.w}, x2[8] = {b0.x, b0.y, b0.z, b0.w, b1.x, b1.y, b1.z, b1.w}, o1[8], o2[8];
#pragma unroll
      for (int j = 0; j < 8; ++j) { double fr = pq * kInvFreq2Pi[16 * s2 + 8 * h + j]; fr -= floor(fr); const float ff = (float)fr;
        const float sn = __builtin_amdgcn_sinf(ff), cs = __builtin_amdgcn_cosf(ff);
        o1[j] = (x1[j] * cs - x2[j] * sn) * sc; o2[j] = (x2[j] * cs + x1[j] * sn) * sc; }
      qf[8 + s2] = pack8(o1[0], o1[1], o1[2], o1[3], o1[4], o1[5], o1[6], o1[7]);
      qf[10 + s2] = pack8(o2[0], o2[1], o2[2], o2[3], o2[4], o2[5], o2[6], o2[7]);
    }
  }
  constexpr int KST = 64 * 400, VST = 128 * 144, STG = KST + VST;
  f32x16 O[4];
#pragma unroll
  for (int i = 0; i < 4; ++i)
#pragma unroll
    for (int r = 0; r < 16; ++r) O[i][r] = 0.f;
  float m_i = -1e30f, l_i = 0.f;
  const int nt = 2 * b + 2;
  u32x4 rk0[3], rv0[2], rk1[3], rv1[2];
  const int vrow = tid >> 3, vcc = tid & 7;
  const int ntl = nt - 1;
#define AT_LOAD(RK, RV, T) { const size_t ko_ = (size_t)(T) * 64 * 192; const int vo_ = (T) * 64; \
    _Pragma("unroll") for (int i = 0; i < 3; ++i) { const int id = tid + NT * i, row = id / 24, cc = id % 24; RK[i] = *(const u32x4*)(Kg + ko_ + row * 192 + cc * 8); } \
    _Pragma("unroll") for (int i = 0; i < 2; ++i) RV[i] = *(const u32x4*)(Vg + (size_t)(vrow + 64 * i) * S_ + vo_ + vcc * 8); }
#define AT_WRITE(RK, RV, ST) { char* dK = smem + (ST) * STG; \
    _Pragma("unroll") for (int i = 0; i < 3; ++i) { const int id = tid + NT * i, row = id / 24, cc = id % 24; *(u32x4*)(dK + row * 400 + cc * 16) = RK[i]; } \
    _Pragma("unroll") for (int i = 0; i < 2; ++i) *(u32x4*)(dK + KST + (vrow + 64 * i) * 144 + vcc * 16) = RV[i]; }
#define AT_COMPUTE(ST, KT) { const char* sK = smem + (ST) * STG; const char* sV = sK + KST; const int key0 = 64 * (KT) + 32 * hk; \
    if (key0 <= 128 * b + 32 * wq) { \
      f32x16 st; _Pragma("unroll") for (int r = 0; r < 16; ++r) st[r] = 0.f; \
      __builtin_amdgcn_s_setprio(1); \
      _Pragma("unroll") for (int s = 0; s < 12; ++s) { const bf16x8 kf = *(const bf16x8*)(sK + (32 * hk + lq) * 400 + (2 * s + h) * 16); st = MFMA32(kf, qf[s], st); } \
      __builtin_amdgcn_s_setprio(0); \
      if (key0 + 31 > 128 * b + 32 * wq) { int qrel = q - key0 - 4 * h; asm volatile("" : "+v"(qrel)); \
        _Pragma("unroll") for (int r = 0; r < 16; ++r) if ((r & 3) + 8 * (r >> 2) > qrel) st[r] = -1e30f; } \
      float mx = st[0]; _Pragma("unroll") for (int r = 1; r < 16; ++r) mx = fmaxf(mx, st[r]); \
      mx = xhalf_max(mx); \
      const float m_new = fmaxf(m_i, mx), alpha = __builtin_amdgcn_exp2f(m_i - m_new); float ps = 0.f; \
      _Pragma("unroll") for (int r = 0; r < 16; ++r) { st[r] = __builtin_amdgcn_exp2f(st[r] - m_new); ps += st[r]; } \
      l_i = l_i * alpha + ps; \
      if (__any(m_new != m_i)) { _Pragma("unroll") for (int i = 0; i < 4; ++i) _Pragma("unroll") for (int r = 0; r < 16; ++r) O[i][r] *= alpha; } \
      m_i = m_new; \
      bf16x8 pf[2]; \
      _Pragma("unroll") for (int s = 0; s < 2; ++s) pf[s] = pack8(st[8 * s], st[8 * s + 1], st[8 * s + 2], st[8 * s + 3], st[8 * s + 4], st[8 * s + 5], st[8 * s + 6], st[8 * s + 7]); \
      __builtin_amdgcn_s_setprio(1); \
      _Pragma("unroll") for (int i = 0; i < 4; ++i) _Pragma("unroll") for (int s = 0; s < 2; ++s) { const char* vp = sV + (32 * i + lq) * 144 + (32 * hk + 16 * s + 4 * h) * 2; \
          const u32x2 lo = *(const u32x2*)vp, hi = *(const u32x2*)(vp + 16); u32x4 vv = {lo.x, lo.y, hi.x, hi.y}; \
          O[i] = MFMA32(__builtin_bit_cast(bf16x8, vv), pf[s], O[i]); } \
      __builtin_amdgcn_s_setprio(0); } }
  AT_LOAD(rk0, rv0, 0);
  AT_LOAD(rk1, rv1, 1);
  AT_WRITE(rk0, rv0, 0);
  AT_LOAD(rk0, rv0, (2 < ntl ? 2 : ntl));
  __syncthreads();
  for (int kt = 0; kt < nt; kt += 2) {
    AT_WRITE(rk1, rv1, 1);
    AT_LOAD(rk1, rv1, (kt + 3 < ntl ? kt + 3 : ntl));
    AT_COMPUTE(0, kt);
    __syncthreads();
    AT_WRITE(rk0, rv0, 0);
    AT_LOAD(rk0, rv0, (kt + 4 < ntl ? kt + 4 : ntl));
    AT_COMPUTE(1, kt + 1);
    __syncthreads();
  }
#undef AT_LOAD
#undef AT_WRITE
#undef AT_COMPUTE
  float* cO = (float*)smem; float* cm = cO + 4 * 4096; float* cl = cm + 256;
  if (hk == 1) {
#pragma unroll
    for (int i = 0; i < 4; ++i)
#pragma unroll
      for (int r = 0; r < 16; ++r) cO[wq * 4096 + (i * 16 + r) * 64 + lane] = O[i][r];
    cm[wq * 64 + lane] = m_i; cl[wq * 64 + lane] = l_i;
  }
  __syncthreads();
  if (hk == 0) {
    const float m1 = cm[wq * 64 + lane], l1 = cl[wq * 64 + lane];
    const float m = fmaxf(m_i, m1), a0 = exp2f(m_i - m), a1 = exp2f(m1 - m);
    float lt = l_i * a0 + l1 * a1; lt += __shfl_xor(lt, 32);
    const float inv = 1.f / lt;
    bf16_t* op = mixin + (size_t)q * 2048 + 1024 + hd * 128;
#pragma unroll
    for (int i = 0; i < 4; ++i)
#pragma unroll
      for (int rg = 0; rg < 4; ++rg) { float v[4];
#pragma unroll
        for (int e = 0; e < 4; ++e) v[e] = (O[i][4 * rg + e] * a0 + cO[wq * 4096 + (i * 16 + 4 * rg + e) * 64 + lane] * a1) * inv;
        u32x2 pk = {pack2(v[0], v[1]), pack2(v[2], v[3])}; *(u32x2*)(op + 32 * i + 8 * rg + 4 * h) = pk; }
  }
  __syncthreads();
}

DI void swa_item(const Params& P, int l, int n, int hk2, char* smem) {
  const int tid = opaque_tid(), lane = tid & 63, w = tid >> 6, lq = lane & 31, h = lane >> 5;
  const bf16_t* proj = (const bf16_t*)(P.ws + OFF_PROJ); bf16_t* mixin = (bf16_t*)(P.ws + OFF_H);
  bf16_t* sVt = (bf16_t*)smem;
#pragma unroll
  for (int i = 0; i < 4; ++i) { const int id = tid + NT * i, key = id >> 3, dc = id & 7; const int kp = 128 * (n - 1) + key;
    u32x4 v = {0u, 0u, 0u, 0u}; if (kp >= 0) v = *(const u32x4*)(proj + (size_t)kp * DINP + C_CV + hk2 * 64 + dc * 8);
    sVt[(8 * dc + 0) * 264 + key] = (bf16_t)(v.x & 0xffff); sVt[(8 * dc + 1) * 264 + key] = (bf16_t)(v.x >> 16);
    sVt[(8 * dc + 2) * 264 + key] = (bf16_t)(v.y & 0xffff); sVt[(8 * dc + 3) * 264 + key] = (bf16_t)(v.y >> 16);
    sVt[(8 * dc + 4) * 264 + key] = (bf16_t)(v.z & 0xffff); sVt[(8 * dc + 5) * 264 + key] = (bf16_t)(v.z >> 16);
    sVt[(8 * dc + 6) * 264 + key] = (bf16_t)(v.w & 0xffff); sVt[(8 * dc + 7) * 264 + key] = (bf16_t)(v.w >> 16); }
  __syncthreads();
  const int g = w >> 1, hq = hk2 * 4 + g;
  const float slope = exp2f(-(float)(hq + 1)) * LOG2E, sinkv = P.swa_sinks[l * 8 + hq] * LOG2E;
#pragma unroll 1
  for (int jj = 0; jj < 2; ++jj) {
    const int j = 2 * (w & 1) + jj; const int qrow = 128 * n + 32 * j + lq;
    bf16x8 qf[4];
#pragma unroll
    for (int s = 0; s < 4; ++s) qf[s] = *(const bf16x8*)(proj + (size_t)qrow * DINP + C_CQ + hq * 64 + 16 * s + 8 * h);
    f32x16 st[5];
    bf16x8 kf[2][4];
    { const int kp = 128 * (n - 1) + 32 * j + lq;
#pragma unroll
      for (int s = 0; s < 4; ++s) { kf[0][s] = (bf16x8){0, 0, 0, 0, 0, 0, 0, 0}; if (kp >= 0) kf[0][s] = *(const bf16x8*)(proj + (size_t)kp * DINP + C_CK + hk2 * 64 + 16 * s + 8 * h); } }
#pragma unroll
    for (int tt = 0; tt < 5; ++tt) {
      if (tt + 1 < 5) { const int kp = 128 * (n - 1) + 32 * (j + tt + 1) + lq;
#pragma unroll
        for (int s = 0; s < 4; ++s) { kf[(tt + 1) & 1][s] = (bf16x8){0, 0, 0, 0, 0, 0, 0, 0}; if (kp >= 0) kf[(tt + 1) & 1][s] = *(const bf16x8*)(proj + (size_t)kp * DINP + C_CK + hk2 * 64 + 16 * s + 8 * h); } }
      __builtin_amdgcn_sched_barrier(0);
#pragma unroll
      for (int r = 0; r < 16; ++r) st[tt][r] = 0.f;
#pragma unroll
      for (int s = 0; s < 4; ++s) st[tt] = MFMA32(kf[tt & 1][s], qf[s], st[tt]);
      __builtin_amdgcn_sched_barrier(0);
    }
    float mx = sinkv;
    int dbase = 128 + lq - 4 * h, kbase = 128 * (n - 1) + 32 * j + 4 * h;
    asm volatile("" : "+v"(dbase), "+v"(kbase));
#pragma unroll
    for (int tt = 0; tt < 5; ++tt)
#pragma unroll
      for (int r = 0; r < 16; ++r) { const int cst = 32 * tt + (r & 3) + 8 * (r >> 2); const int dist = dbase - cst; const int kpos = kbase + cst;
        const bool valid = (dist >= 0) && (dist < 128) && (kpos >= 0);
        const float sv = valid ? st[tt][r] * (0.125f * LOG2E) - slope * (float)dist : -1e30f; st[tt][r] = sv; mx = fmaxf(mx, sv); }
    mx = fmaxf(mx, __shfl_xor(mx, 32));
    float den = 0.f;
#pragma unroll
    for (int tt = 0; tt < 5; ++tt)
#pragma unroll
      for (int r = 0; r < 16; ++r) { const float p = exp2f(st[tt][r] - mx); st[tt][r] = p; den += p; }
    den += __shfl_xor(den, 32); den += exp2f(sinkv - mx);
    f32x16 O[2];
#pragma unroll
    for (int i = 0; i < 2; ++i)
#pragma unroll
      for (int r = 0; r < 16; ++r) O[i][r] = 0.f;
#pragma unroll
    for (int tt = 0; tt < 5; ++tt)
#pragma unroll
      for (int s = 0; s < 2; ++s) { const bf16x8 pf = pack8(st[tt][8 * s], st[tt][8 * s + 1], st[tt][8 * s + 2], st[tt][8 * s + 3], st[tt][8 * s + 4], st[tt][8 * s + 5], st[tt][8 * s + 6], st[tt][8 * s + 7]);
#pragma unroll
        for (int i = 0; i < 2; ++i) { const char* vp = (const char*)sVt + (32 * i + lq) * 528 + (32 * (j + tt) + 16 * s + 4 * h) * 2;
          const u32x2 lo = *(const u32x2*)vp, hi = *(const u32x2*)(vp + 16); u32x4 vv = {lo.x, lo.y, hi.x, hi.y};
          O[i] = MFMA32(__builtin_bit_cast(bf16x8, vv), pf, O[i]); }
        __builtin_amdgcn_sched_barrier(0); }
    const float inv = 1.f / den;
    bf16_t* op = mixin + (size_t)qrow * 2048 + 1536 + hq * 64;
#pragma unroll
    for (int i = 0; i < 2; ++i)
#pragma unroll
      for (int rg = 0; rg < 4; ++rg) { u32x2 pk = {pack2(O[i][4 * rg] * inv, O[i][4 * rg + 1] * inv), pack2(O[i][4 * rg + 2] * inv, O[i][4 * rg + 3] * inv)};
        *(u32x2*)(op + 32 * i + 8 * rg + 4 * h) = pk; }
  }
  __syncthreads();
}

DI float gelu_tanh(float x) { const float y = 0.7978845608028654f * (x + 0.044715f * x * x * x); const float t = 1.f - 2.f * __builtin_amdgcn_rcpf(1.f + __expf(2.f * y)); return 0.5f * x * (1.f + t); }
DI void ffn_act_phase(const Params& P, int l) {
  const int tid = opaque_tid(), lane = tid & 63, w = tid >> 6;
  const bf16_t* u = (const bf16_t*)(P.ws + OFF_BIG); bf16_t* act = (bf16_t*)(P.ws + OFF_ACT);
  const float* cw = P.ffn_conv + (size_t)l * 3 * DFF2; const float* cb = P.ffn_conv_b + (size_t)l * DFF2;
  for (int item = blockIdx.x * 8 + w; item < 512 * 11; item += gridDim.x * 8) {
    const int cbk = item % 11, rr = item / 11; const int ch = cbk * 512 + lane * 8, r0 = rr * 32;
    float wg[3][8], wu[3][8], bg[8], bu[8];
#pragma unroll
    for (int j = 0; j < 3; ++j)
#pragma unroll
      for (int e4 = 0; e4 < 2; ++e4) { const f32x4 a = *(const f32x4*)(cw + (size_t)j * DFF2 + ch + 4 * e4), b = *(const f32x4*)(cw + (size_t)j * DFF2 + DFF + ch + 4 * e4);
        wg[j][4 * e4] = a.x; wg[j][4 * e4 + 1] = a.y; wg[j][4 * e4 + 2] = a.z; wg[j][4 * e4 + 3] = a.w; wu[j][4 * e4] = b.x; wu[j][4 * e4 + 1] = b.y; wu[j][4 * e4 + 2] = b.z; wu[j][4 * e4 + 3] = b.w; }
#pragma unroll
    for (int e4 = 0; e4 < 2; ++e4) { const f32x4 a = *(const f32x4*)(cb + ch + 4 * e4), b = *(const f32x4*)(cb + DFF + ch + 4 * e4);
      bg[4 * e4] = a.x; bg[4 * e4 + 1] = a.y; bg[4 * e4 + 2] = a.z; bg[4 * e4 + 3] = a.w; bu[4 * e4] = b.x; bu[4 * e4 + 1] = b.y; bu[4 * e4 + 2] = b.z; bu[4 * e4 + 3] = b.w; }
    float g2[8], g1[8], u2[8], u1[8];
#pragma unroll
    for (int e = 0; e < 8; ++e) { g2[e] = 0.f; g1[e] = 0.f; u2[e] = 0.f; u1[e] = 0.f; }
    if (r0 >= 2) { unpack8(*(const u32x4*)(u + (size_t)(r0 - 2) * DFF2 + ch), g2); unpack8(*(const u32x4*)(u + (size_t)(r0 - 2) * DFF2 + DFF + ch), u2);
      unpack8(*(const u32x4*)(u + (size_t)(r0 - 1) * DFF2 + ch), g1); unpack8(*(const u32x4*)(u + (size_t)(r0 - 1) * DFF2 + DFF + ch), u1); }
#pragma unroll 1
    for (int rb = 0; rb < 4; ++rb) {
      u32x4 G[8], U[8];
#pragma unroll
      for (int i = 0; i < 8; ++i) { const size_t ro = (size_t)(r0 + rb * 8 + i) * DFF2 + ch; G[i] = __builtin_nontemporal_load((const u32x4*)(u + ro)); U[i] = __builtin_nontemporal_load((const u32x4*)(u + ro + DFF)); }
#pragma unroll
      for (int i = 0; i < 8; ++i) {
        float g0[8], u0[8]; unpack8(G[i], g0); unpack8(U[i], u0);
        float o[8];
#pragma unroll
        for (int e = 0; e < 8; ++e) { const float yg = wg[0][e] * g2[e] + wg[1][e] * g1[e] + wg[2][e] * g0[e] + bg[e]; const float yu = wu[0][e] * u2[e] + wu[1][e] * u1[e] + wu[2][e] * u0[e] + bu[e];
          o[e] = gelu_tanh(yg) * yu; g2[e] = g1[e]; g1[e] = g0[e]; u2[e] = u1[e]; u1[e] = u0[e]; }
        u32x4 pk = {pack2(o[0], o[1]), pack2(o[2], o[3]), pack2(o[4], o[5]), pack2(o[6], o[7])};
        *(u32x4*)(act + (size_t)(r0 + rb * 8 + i) * DFF + ch) = pk;
      }
    }
  }
}

#define XB_TMO      128
#define XB_XCNT(j)  (256  + 64 * (j))
#define XB_XSUB(j)  (1280 + 64 * (j))
#define XB_XGEN(j)  (2304 + 64 * (j))
#define XB_TOP      3328
#define XB_TOPGEN   3392
#define XCD_BAR_WORDS 3456
#define XB_SPIN_CAP (1u << 18)
#define LAS __attribute__((address_space(3)))
DI unsigned xb_ld(unsigned* p)              { return __hip_atomic_load(p, __ATOMIC_RELAXED, __HIP_MEMORY_SCOPE_AGENT); }
DI unsigned xb_add(unsigned* p, unsigned v) { return __hip_atomic_fetch_add(p, v, __ATOMIC_RELAXED, __HIP_MEMORY_SCOPE_AGENT); }
DI unsigned xb_xcc_id() { return (unsigned)__builtin_amdgcn_s_getreg((3 << 11) | 20) & 0xFu; }
#define XB_SPIN(cond, bar) do { unsigned _sp = 0; while (cond) { __builtin_amdgcn_s_sleep(1); \
    if ((++_sp & 255u) == 0u) { if (xb_ld(&(bar)[XB_TMO])) break; if (_sp > XB_SPIN_CAP) { atomicAdd(&(bar)[XB_TMO], 1u); break; } } } } while (0)
struct XcdBarrier { unsigned* bar; unsigned x; volatile LAS unsigned* st; };
DI XcdBarrier xcd_barrier_post(unsigned* bar, volatile LAS unsigned* st) {
  XcdBarrier b; b.bar = bar; b.x = xb_xcc_id(); b.st = st;
  if (threadIdx.x == 0) (void)xb_add(&bar[XB_XCNT(b.x)], 1u);
  return b;
}
DI void xcd_barrier_complete(unsigned* bar, unsigned x, unsigned& nloc, unsigned& nx) {
  const unsigned G = gridDim.x * gridDim.y * gridDim.z;
  unsigned sum, cnt, mine, sp = 0u;
  for (;;) {
    sum = 0u; cnt = 0u; mine = 0u;
#pragma unroll
    for (unsigned j = 0; j < 16; ++j) { const unsigned c = xb_ld(&bar[XB_XCNT(j)]); sum += c; cnt += (c > 0u) ? 1u : 0u; mine = (j == x) ? c : mine; }
    if (sum == G) break;
    __builtin_amdgcn_s_sleep(1);
    if ((++sp & 255u) == 0u) { if (xb_ld(&bar[XB_TMO])) break; if (sp > XB_SPIN_CAP) { atomicAdd(&bar[XB_TMO], 1u); break; } }
  }
  nloc = mine > 0u ? mine : 1u; nx = cnt > 0u ? cnt : 1u;
}
DI void xcd_barrier(char* ws_, char* smem_) {
  XcdBarrier b; b.bar = (unsigned*)(ws_ + OFF_XBAR); b.x = xb_xcc_id(); b.st = (volatile LAS unsigned*)(smem_ + 159760);
  asm volatile("s_waitcnt vmcnt(0)" ::: "memory");
  __syncthreads();
  if (threadIdx.x == 0) {
    unsigned* bar = b.bar;
    __builtin_amdgcn_s_waitcnt(0);
    unsigned nloc = b.st[0], nx = b.st[1];
    if (nloc == 0u) { xcd_barrier_complete(bar, b.x, nloc, nx); b.st[0] = nloc; b.st[1] = nx; }
    const unsigned old = xb_add(&bar[XB_XSUB(b.x)], 1u);
    const unsigned gen = old / nloc;
    if (old + 1u == (gen + 1u) * nloc) {
      __builtin_amdgcn_fence(__ATOMIC_RELEASE, "agent");
      asm volatile("s_waitcnt vmcnt(0)" ::: "memory");
      const unsigned og = xb_add(&bar[XB_TOP], 1u);
      const unsigned tg = og / nx;
      if (og + 1u == (tg + 1u) * nx) xb_add(&bar[XB_TOPGEN], 1u);
      else XB_SPIN(xb_ld(&bar[XB_TOPGEN]) == tg, bar);
      __builtin_amdgcn_fence(__ATOMIC_ACQUIRE, "agent");
      xb_add(&bar[XB_XGEN(b.x)], 1u);
      asm volatile("s_waitcnt vmcnt(0)" ::: "memory");
    } else {
      XB_SPIN(xb_ld(&bar[XB_XGEN(b.x)]) == gen, bar);
      __builtin_amdgcn_fence(__ATOMIC_ACQUIRE, "agent");
      asm volatile("s_waitcnt vmcnt(0)" ::: "memory");
    }
  }
  __syncthreads();
}

__global__ void __launch_bounds__(NT) fwd_megakernel(Params P0) {
  cg::grid_group grid = cg::this_grid();
  __shared__ __attribute__((aligned(16))) char smem[160512];
  const int tid = threadIdx.x;
  char* ws = P0.ws;
  int* ctrl = (int*)(ws + OFF_CTRL);
  if (blockIdx.x == 0 && tid < 64) ctrl[tid] = 0;
  if (blockIdx.x == 0) for (int i = tid; i < XCD_BAR_WORDS; i += NT) ((unsigned*)(ws + OFF_XBAR))[i] = 0u;
  if (tid < 4) ((unsigned*)(smem + 159760))[tid] = 0u;
  if (blockIdx.x == 0 && tid == 0) *(Params*)(ws + OFF_CTRL + 1024) = P0;
  bf16_t* Hb = (bf16_t*)(ws + OFF_H);
  for (int it = blockIdx.x; it < 192 + CV_T5; it += gridDim.x) { if (it < 192) mod_item(P0, it); else convert_item(P0, 0, it - 192, smem); }
  grid.sync();
  (void)xcd_barrier_post((unsigned*)(ws + OFF_XBAR), (volatile LAS unsigned*)(smem + 159760));
  const Params& P = *(const Params*)(ws + OFF_CTRL + 1024);
  rownorm_phase(P, P.x, nullptr, P.out, Hb, 0, 0, nullptr, 0, 1, 0, P.mix_pre, smem);
  xcd_barrier(ws, smem);
  for (int l = 0; l < 2; ++l) {
    { EpiProj epi{(bf16_t*)(ws + OFF_PROJ), (float*)(ws + OFF_AB)}; gemm_phase(Hb, 2048, (const bf16_t*)(ws + OFF_W + W_IN), 2048, 2048, 64, 22, smem, epi); }
    xcd_barrier(ws, smem);
    for (int it = blockIdx.x; it < 448; it += gridDim.x) {
      if (it < 192) mla_q_tile(P, it / 3, it % 3, smem);
      else mla_kv_tile(P, (it - 192) >> 2, (it - 192) & 3, smem);
    }
    for (int id = (blockIdx.x + 64) % gridDim.x; id < 2048; id += gridDim.x) gdn_prep_item(P, l, id >> 3, id & 7, smem);
    xcd_barrier(ws, smem);
    {
      int* sitem = (int*)(smem + 159744);
      for (;;) {
        if (tid == 0) *sitem = atomicAdd(ctrl + 16 * l, 1);
        __syncthreads(); const int item = *sitem; __syncthreads();
        if (item >= 16 + 512 + 256) break;
        if (item < 16) gdn_scan_item(P, l, item >> 1, item & 1, smem);
        else if (item < 528) { const int idx = item - 16; mla_attn_item(P, idx & 3, 127 - (idx >> 2), smem); }
        else { const int idx = item - 528; swa_item(P, l, idx >> 1, idx & 1, smem); }
      }
    }
    xcd_barrier(ws, smem);
    gdn_fix_phase(P);
    xcd_barrier(ws, smem);
    { EpiBf epi{(bf16_t*)(ws + OFF_MIXF), 2048}; gemm_phase(Hb, 2048, (const bf16_t*)(ws + OFF_W + W_OUT), 2048, 2048, 64, 8, smem, epi); }
    xcd_barrier(ws, smem);
    rownorm_phase(P, P.out, (const bf16_t*)(ws + OFF_MIXF), P.out, Hb, l, 2, P.mix_post + l * 2048, l, 4, 3, P.ffn_pre + l * 2048, smem);
    xcd_barrier(ws, smem);
    { EpiBf epi{(bf16_t*)(ws + OFF_BIG), DFF2}; gemm_phase(Hb, 2048, (const bf16_t*)(ws + OFF_W + W_UP), 2048, 2048, 64, 44, smem, epi); }
    xcd_barrier(ws, smem);
    ffn_act_phase(P, l);
    xcd_barrier(ws, smem);
    { EpiBf epi{(bf16_t*)(ws + OFF_Y), 2048}; gemm_phase((const bf16_t*)(ws + OFF_ACT), DFF, (const bf16_t*)(ws + OFF_W + W_DOWN), DFF, DFF, 64, 8, smem, epi); }
    xcd_barrier(ws, smem);
    if (l == 0) {
      for (int it = blockIdx.x; it < CV_T5; it += gridDim.x) convert_item(P, 1, it, smem);
      rownorm_phase(P, P.out, (const bf16_t*)(ws + OFF_Y), P.out, Hb, 0, 5, P.ffn_post, 1, 1, 0, P.mix_pre + 2048, smem);
      xcd_barrier(ws, smem);
    } else {
      rownorm_phase(P, P.out, (const bf16_t*)(ws + OFF_Y), P.out, nullptr, 1, 5, P.ffn_post + 2048, 1, 1, 0, nullptr, smem);
    }
  }
}

extern "C" void kernel_launch(void* const* d_in, const int* in_sizes, int n_in, void* d_out, int out_size, void* d_ws, size_t ws_size, hipStream_t stream) {
  static int grid_blocks = 0;
  if (!grid_blocks) {
    int dev = 0, cus = 0, per = 0;
    (void)hipGetDevice(&dev); (void)hipDeviceGetAttribute(&cus, hipDeviceAttributeMultiprocessorCount, dev);
    (void)hipOccupancyMaxActiveBlocksPerMultiprocessor(&per, fwd_megakernel, NT, 0);
    if (per > 1) per = 1;
    grid_blocks = cus * per; if (grid_blocks <= 0) grid_blocks = 256;
  }
  if (ws_size < OFF_END) { fprintf(stderr, "workspace too small: %zu < %zu\n", ws_size, (size_t)OFF_END); return; }
  Params p{};
  p.x = (const float*)d_in[0]; p.c = (const float*)d_in[1]; p.pos = (const int*)d_in[2];
  p.ada_w = (const float*)d_in[3]; p.ada_b = (const float*)d_in[4]; p.mix_pre = (const float*)d_in[5]; p.mix_post = (const float*)d_in[6];
  p.w_in = (const float*)d_in[7]; p.w_out = (const float*)d_in[8]; p.gdn_conv = (const float*)d_in[9]; p.gdn_a_log = (const float*)d_in[10];
  p.gdn_dt_bias = (const float*)d_in[11]; p.gdn_norm = (const float*)d_in[12]; p.mla_q_norm = (const float*)d_in[13]; p.mla_w_uq = (const float*)d_in[14];
  p.mla_kv_norm = (const float*)d_in[15]; p.mla_w_ukv = (const float*)d_in[16]; p.swa_sinks = (const float*)d_in[17]; p.ffn_pre = (const float*)d_in[18];
  p.ffn_post = (const float*)d_in[19]; p.ffn_w_up = (const float*)d_in[20]; p.ffn_conv = (const float*)d_in[21]; p.ffn_conv_b = (const float*)d_in[22];
  p.ffn_w_down = (const float*)d_in[23];
  p.out = (float*)d_out; p.ws = (char*)d_ws;
  void* args[] = {&p};
  hipError_t e = hipLaunchCooperativeKernel((void*)fwd_megakernel, dim3(grid_blocks), dim3(NT), args, 0, stream);
  if (e != hipSuccess) fprintf(stderr, "cooperative launch failed: %s (grid %d)\n", hipGetErrorString(e), grid_blocks);
}
```
